# Optimizing an MI355X kernel written in HIP

```python
import math
import jax, jax.numpy as jnp
from jax import lax
import numpy as np

D_MODEL = 1024
BATCH = 8
SEQ = 2048
DEPTH = 4
DEC_BATCH = 128
DEC_SEQ = 8
PAST_LEN = 16384
PAGE_SIZE = 128

N_BRANCH = 4
MIX_W = D_MODEL // 4
POOL_WINDOWS = (2, 4, 8, 16)
POOL_GROUPS = len(POOL_WINDOWS)
POOL_GW = MIX_W // POOL_GROUPS
POOL_BUF = max(POOL_WINDOWS) - 1
SSM_GROUP_CH = 16
SSM_GROUPS = MIX_W // SSM_GROUP_CH
SSM_STATE = 64
SC_WIDTH = 3
CF_WIDTH = 31
FF_DIM = -(-8 * D_MODEL // (3 * 256)) * 256
OFF_POOL = 0
OFF_SSM = OFF_POOL + MIX_W
OFF_SC = OFF_SSM + MIX_W
OFF_CF = OFF_SC + 3 * MIX_W
OFF_GATE = OFF_CF + 2 * MIX_W
IN_COLS = OFF_GATE + N_BRANCH * D_MODEL
RMS_EPS = 1e-6
LN_EPS = 1e-5

kernel_name = 'hybrid_pool_s5_conv_gated_decoder_step'

f32 = jnp.float32


def rmsnorm(x, g):
    xf = x.astype(f32)
    y = xf * lax.rsqrt(jnp.mean(xf * xf, axis=-1, keepdims=True) + RMS_EPS)
    return (y * g.astype(f32)).astype(x.dtype)


def causal_dwconv(v, buf, w):
    ext = jnp.concatenate([buf.astype(v.dtype), v], axis=1)
    y = lax.conv_general_dilated(ext, w[:, None, :].astype(v.dtype), window_strides=(1,), padding='VALID',
                                 dimension_numbers=('NWC', 'WIO', 'NWC'), feature_group_count=v.shape[-1])
    return y, ext[:, ext.shape[1] - (w.shape[0] - 1):]


def pool_mixer(v, buf, pos0, w, scale):
    L = v.shape[1]
    ext = jnp.concatenate([buf.astype(v.dtype), v], axis=1)
    extf = ext.astype(f32)
    cs = jnp.concatenate([jnp.zeros_like(extf[:, :1]), jnp.cumsum(extf, axis=1)], axis=1)
    pos = jnp.arange(L, dtype=f32) + pos0
    outs = []
    for k, win in enumerate(POOL_WINDOWS):
        lo, hi = k * POOL_GW, (k + 1) * POOL_GW
        s = cs[:, POOL_BUF + 1:POOL_BUF + 1 + L, lo:hi] - cs[:, POOL_BUF + 1 - win:POOL_BUF + 1 - win + L, lo:hi]
        cnt = jnp.minimum(pos + 1.0, float(win))
        d = s / cnt[None, :, None] - extf[:, POOL_BUF:, lo:hi]
        outs.append(jnp.einsum('nlc,cd->nld', d, w[k].astype(f32)))
    out = jnp.concatenate(outs, axis=-1) * scale.astype(f32)
    return out.astype(v.dtype), ext[:, ext.shape[1] - POOL_BUF:]


def _ssm_combine(e1, e2):
    a1, b1 = e1
    a2, b2 = e2
    return a1 * a2, a2 * b1 + b2


def ssm_mixer(u, h_re, h_im, lam_re, lam_im, log_dt, b_re, b_im, c_re, c_im, d_skip, w_glu, b_glu):
    N, L, _ = u.shape
    uf = u.astype(f32).reshape(N, L, SSM_GROUPS, SSM_GROUP_CH)
    lam = lam_re.astype(f32) + 1j * lam_im.astype(f32)
    dt = jnp.exp(log_dt.astype(f32))[:, None]
    lam_bar = jnp.exp(lam * dt)
    b_bar = ((lam_bar - 1.0) / lam)[..., None] * (b_re.astype(f32) + 1j * b_im.astype(f32))
    c = c_re.astype(f32) + 1j * c_im.astype(f32)
    bu = jnp.einsum('nlgc,gpc->nlgp', uf.astype(jnp.complex64), b_bar)
    h0 = h_re.astype(f32) + 1j * h_im.astype(f32)
    bu = bu.at[:, 0].add(lam_bar[None] * h0)
    a = jnp.broadcast_to(lam_bar, (1, L) + lam_bar.shape)
    _, h = lax.associative_scan(_ssm_combine, (a, bu), axis=1)
    y = jnp.einsum('nlgp,gcp->nlgc', h, c).real + d_skip.astype(f32).reshape(SSM_GROUPS, SSM_GROUP_CH) * uf
    z = jax.nn.gelu(y.reshape(N, L, MIX_W))
    out = z * jax.nn.sigmoid(z @ w_glu.astype(f32) + b_glu.astype(f32))
    h_last = h[:, -1]
    return out.astype(u.dtype), h_last.real, h_last.imag


def shortconv_mixer(bg, cg, hx, buf, w):
    y, nb = causal_dwconv(cg * hx, buf, w)
    return bg * y, nb


def conformer_mixer(a, b, buf, w, ln_g, ln_b):
    v = a * jax.nn.sigmoid(b)
    y, nb = causal_dwconv(v, buf, w)
    yf = y.astype(f32)
    mu = jnp.mean(yf, axis=-1, keepdims=True)
    var = jnp.mean(jnp.square(yf - mu), axis=-1, keepdims=True)
    yn = (yf - mu) * lax.rsqrt(var + LN_EPS) * ln_g.astype(f32) + ln_b.astype(f32)
    return jax.nn.silu(yn).astype(v.dtype), nb


def trunk(x, pos0, st_pool, st_re, st_im, st_sc, st_cf, weights):
    (norm1_g, norm2_g, final_g, w_in, b_gate, pool_w, pool_scale, lam_re, lam_im, log_dt,
     b_re, b_im, c_re, c_im, d_skip, w_glu, b_glu, sc_w, cf_w, cf_ln_g, cf_ln_b,
     w_branch, w_out, w_ffn_in, w_ffn_out) = weights
    N, L = x.shape[0], x.shape[1]
    n_pool, n_re, n_im, n_sc, n_cf = [], [], [], [], []
    for i in range(DEPTH):
        h = rmsnorm(x, norm1_g[i])
        proj = jnp.einsum('nld,de->nle', h, w_in[i])
        ya, pb = pool_mixer(proj[..., OFF_POOL:OFF_SSM], st_pool[i], pos0, pool_w[i], pool_scale[i])
        yb, hr, hi = ssm_mixer(proj[..., OFF_SSM:OFF_SC], st_re[i], st_im[i], lam_re[i], lam_im[i], log_dt[i],
                               b_re[i], b_im[i], c_re[i], c_im[i], d_skip[i], w_glu[i], b_glu[i])
        yc, sb = shortconv_mixer(proj[..., OFF_SC:OFF_SC + MIX_W], proj[..., OFF_SC + MIX_W:OFF_SC + 2 * MIX_W],
                                 proj[..., OFF_SC + 2 * MIX_W:OFF_CF], st_sc[i], sc_w[i])
        yd, cb = conformer_mixer(proj[..., OFF_CF:OFF_CF + MIX_W], proj[..., OFF_CF + MIX_W:OFF_GATE],
                                 st_cf[i], cf_w[i], cf_ln_g[i], cf_ln_b[i])
        gates = jax.nn.sigmoid(proj[..., OFF_GATE:].reshape(N, L, N_BRANCH, D_MODEL) + b_gate[i])
        branches = jnp.stack([ya, yb, yc, yd], axis=2)
        bproj = jnp.einsum('nlkc,kcd->nlkd', branches, w_branch[i])
        merged = jnp.sum(gates * bproj, axis=2)
        x = x + merged @ w_out[i]
        h2 = rmsnorm(x, norm2_g[i])
        g, up = jnp.split(h2 @ w_ffn_in[i], 2, axis=-1)
        x = x + (jax.nn.silu(g) * up) @ w_ffn_out[i]
        n_pool.append(pb); n_re.append(hr); n_im.append(hi); n_sc.append(sb); n_cf.append(cb)
    return (rmsnorm(x, final_g), jnp.stack(n_pool), jnp.stack(n_re), jnp.stack(n_im),
            jnp.stack(n_sc), jnp.stack(n_cf))


def setup_inputs(seed: int = 0) -> dict:
    key = jax.random.key(seed)
    ks = jax.random.split(key, 40)
    nrm = lambda k, shape, s: jax.random.normal(k, shape, f32) * s
    D, C = D_MODEL, MIX_W
    G, P, GC = SSM_GROUPS, SSM_STATE, SSM_GROUP_CH
    lam_im0 = jnp.broadcast_to(math.pi * jnp.arange(P, dtype=f32), (DEPTH, G, P))
    return {
        'x_prompt': nrm(ks[0], (BATCH, SEQ, D), 1.0),
        'x_sample': nrm(ks[1], (DEC_BATCH, DEC_SEQ, D), 1.0),
        'state_pool': nrm(ks[2], (DEPTH, DEC_BATCH, POOL_BUF, C), 1.0),
        'state_ssm_re': nrm(ks[3], (DEPTH, DEC_BATCH, G, P), 0.5),
        'state_ssm_im': nrm(ks[4], (DEPTH, DEC_BATCH, G, P), 0.5),
        'state_shortconv': nrm(ks[5], (DEPTH, DEC_BATCH, SC_WIDTH - 1, C), 1.0),
        'state_conformer': nrm(ks[6], (DEPTH, DEC_BATCH, CF_WIDTH - 1, C), 0.5),
        'norm1_g': 1.0 + nrm(ks[7], (DEPTH, D), 0.01),
        'norm2_g': 1.0 + nrm(ks[8], (DEPTH, D), 0.01),
        'final_g': 1.0 + nrm(ks[9], (D,), 0.01),
        'w_in': nrm(ks[10], (DEPTH, D, IN_COLS), D ** -0.5),
        'b_gate': nrm(ks[11], (DEPTH, N_BRANCH, D), 0.01),
        'pool_w': nrm(ks[12], (DEPTH, POOL_GROUPS, POOL_GW, POOL_GW), POOL_GW ** -0.5),
        'pool_scale': 1.0 + nrm(ks[13], (DEPTH, C), 0.1),
        'lam_re': -0.5 + nrm(ks[14], (DEPTH, G, P), 0.01),
        'lam_im': lam_im0 + nrm(ks[15], (DEPTH, G, P), 0.01),
        'log_dt': jax.random.uniform(ks[16], (DEPTH, G), f32, math.log(1e-3), math.log(1e-1)),
        'b_re': nrm(ks[17], (DEPTH, G, P, GC), (2 * GC) ** -0.5),
        'b_im': nrm(ks[18], (DEPTH, G, P, GC), (2 * GC) ** -0.5),
        'c_re': nrm(ks[19], (DEPTH, G, GC, P), (2 * P) ** -0.5),
        'c_im': nrm(ks[20], (DEPTH, G, GC, P), (2 * P) ** -0.5),
        'd_skip': nrm(ks[21], (DEPTH, C), 1.0),
        'w_glu': nrm(ks[22], (DEPTH, C, C), C ** -0.5),
        'b_glu': nrm(ks[23], (DEPTH, C), 0.01),
        'sc_w': nrm(ks[24], (DEPTH, SC_WIDTH, C), SC_WIDTH ** -0.5),
        'cf_w': nrm(ks[25], (DEPTH, CF_WIDTH, C), CF_WIDTH ** -0.5),
        'cf_ln_g': 1.0 + nrm(ks[26], (DEPTH, C), 0.01),
        'cf_ln_b': nrm(ks[27], (DEPTH, C), 0.01),
        'w_branch': nrm(ks[28], (DEPTH, N_BRANCH, C, D), C ** -0.5),
        'w_out': nrm(ks[29], (DEPTH, D, D), D ** -0.5),
        'w_ffn_in': nrm(ks[30], (DEPTH, D, 2 * FF_DIM), D ** -0.5),
        'w_ffn_out': nrm(ks[31], (DEPTH, FF_DIM, D), FF_DIM ** -0.5),
    }


def reference(x_prompt, x_sample, state_pool, state_ssm_re, state_ssm_im, state_shortconv, state_conformer,
              norm1_g, norm2_g, final_g, w_in, b_gate, pool_w, pool_scale, lam_re, lam_im, log_dt,
              b_re, b_im, c_re, c_im, d_skip, w_glu, b_glu, sc_w, cf_w, cf_ln_g, cf_ln_b,
              w_branch, w_out, w_ffn_in, w_ffn_out):
    weights = (norm1_g, norm2_g, final_g, w_in, b_gate, pool_w, pool_scale, lam_re, lam_im, log_dt,
               b_re, b_im, c_re, c_im, d_skip, w_glu, b_glu, sc_w, cf_w, cf_ln_g, cf_ln_b,
               w_branch, w_out, w_ffn_in, w_ffn_out)
    nb = x_prompt.shape[0]
    sd = state_pool.dtype
    z_pool = jnp.zeros((DEPTH, nb, POOL_BUF, MIX_W), sd)
    z_ssm = jnp.zeros((DEPTH, nb, SSM_GROUPS, SSM_STATE), state_ssm_re.dtype)
    z_sc = jnp.zeros((DEPTH, nb, SC_WIDTH - 1, MIX_W), state_shortconv.dtype)
    z_cf = jnp.zeros((DEPTH, nb, CF_WIDTH - 1, MIX_W), state_conformer.dtype)
    y_prompt, pool_p, ssm_re_p, ssm_im_p, sc_p, cf_p = trunk(x_prompt, 0, z_pool, z_ssm, z_ssm, z_sc, z_cf, weights)
    y_sample, pool_s, ssm_re_s, ssm_im_s, sc_s, cf_s = trunk(x_sample, PAST_LEN, state_pool, state_ssm_re, state_ssm_im,
                                                             state_shortconv, state_conformer, weights)
    return (y_prompt, y_sample, pool_p, pool_s, ssm_re_p, ssm_re_s, ssm_im_p, ssm_im_s, sc_p, sc_s, cf_p, cf_s)
```

```cpp
#include <hip/hip_runtime.h>
#include <cstdio>
#include <cstdint>
namespace pg8 {
#define PG8_LAS __attribute__((address_space(3)))
typedef unsigned short bf16_t;
typedef short bf16x8 __attribute__((ext_vector_type(8)));
typedef float f32x4 __attribute__((ext_vector_type(4)));
typedef unsigned u32x4 __attribute__((ext_vector_type(4)));
constexpr int BM = 256, BK = 64, HALF = 128, HTB = HALF * BK * 2  , STAGE_BYTES = 8 * HTB, NXCD = 8, WGM = 8;

__host__ __device__ __forceinline__ int lds_byte(int r, int c) { const int st = (r >> 4) * 2 + (c >> 5), rr = r & 15, cc = c & 31, ob = rr * 64 + cc * 2; return st * 1024 + (ob ^ (((ob >> 9) & 1) << 5)); }
__host__ __device__ __forceinline__ void stage_rc(int b, int& R, int& C) { const int st = b / 1024, sb = b % 1024, swz = sb ^ (((sb >> 9) & 1) << 5); R = (st >> 1) * 16 + swz / 64; C = (st & 1) * 32 + (swz % 64) / 2; }
__host__ __device__ __forceinline__ int perm32(int rho) { const int n = rho >> 4, i = rho & 15; return 8 * (i >> 2) + 4 * n + (i & 3); }

struct Unit { int pm, pn; };
struct Gemm { const bf16_t* A; const bf16_t* Bt; int M, N, K; };

struct StaticOrder {
    int nM, nN, nwg, G, c;
    __host__ __device__ void init(int M, int N, int G_, int c_) { nM = M / BM; nN = N / BM; nwg = nM * nN; G = G_; c = c_; }
    __host__ __device__ bool next(int i, Unit& u) const {
        const long L = (long)i * G + c; if (L >= nwg) return false;
        int wgid = (int)L; { const int q = nwg / NXCD, r = nwg % NXCD, xcd = wgid % NXCD, off = wgid / NXCD; wgid = (xcd < r ? xcd * (q + 1) : r * (q + 1) + (xcd - r) * q) + off; }
        const int nig = WGM * nN, gid = wgid / nig, fm = gid * WGM, gsz = (nM - fm) < WGM ? (nM - fm) : WGM;
        u.pm = fm + ((wgid % nig) % gsz); u.pn = (wgid % nig) / gsz; return true;
    }
    __device__ __forceinline__ void a_ready(const Unit&) const {}
    __device__ __forceinline__ void done(const Unit&) const {}
};
typedef float f32x2 __attribute__((ext_vector_type(2)));
typedef __bf16 bf16x2_t __attribute__((ext_vector_type(2)));
__device__ __forceinline__ unsigned cvt_pk_bf16(float lo, float hi) { f32x2 v = {lo, hi}; bf16x2_t b = __builtin_convertvector(v, bf16x2_t); return __builtin_bit_cast(unsigned, b); }
__device__ __forceinline__ float sigm(float x) { return __builtin_amdgcn_rcpf(1.0f + __builtin_amdgcn_exp2f(-1.4426950408889634f * x)); }
__device__ __forceinline__ float row_rstd(const float* ssq, int row) {
    const f32x4 a = *(const f32x4*)(ssq + ((size_t)0 * 17408 + row) * 4), b = *(const f32x4*)(ssq + ((size_t)1 * 17408 + row) * 4),
                c = *(const f32x4*)(ssq + ((size_t)2 * 17408 + row) * 4), d = *(const f32x4*)(ssq + ((size_t)3 * 17408 + row) * 4);
    const float s = (((a[0] + a[1]) + (a[2] + a[3])) + ((b[0] + b[1]) + (b[2] + b[3]))) + (((c[0] + c[1]) + (c[2] + c[3])) + ((d[0] + d[1]) + (d[2] + d[3])));
    return __builtin_amdgcn_rsqf(s * (1.0f / 1024.0f) + 1e-6f);
}
__device__ __forceinline__ void rows_rstd(const float* ssq, int row0, int fq, float (&rs)[2][4]) {
#pragma unroll
    for (int ai = 0; ai < 2; ++ai)
#pragma unroll
        for (int m = 0; m < 4; ++m) { const f32x4 p = *(const f32x4*)(ssq + ((size_t)fq * 17408 + row0 + ai * HALF + m * 16) * 4); rs[ai][m] = (p[0] + p[1]) + (p[2] + p[3]); }
#pragma unroll
    for (int ai = 0; ai < 2; ++ai)
#pragma unroll
        for (int m = 0; m < 4; ++m) { float s = rs[ai][m]; s += __shfl_xor(s, 16); s += __shfl_xor(s, 32); rs[ai][m] = __builtin_amdgcn_rsqf(s * (1.0f / 1024.0f) + 1e-6f); }
}
struct EpiProj {
    static constexpr bool PERM = true, AFTER_DRAIN = false;
    bf16_t* PM; bf16_t* GT; const float* ssq; const float* bgate;
    __device__ __forceinline__ void operator()(const f32x4 (&acc)[2][2][4][2], const Unit& u, int wr, int wc, int fr, int fq) const {
        const int row0 = u.pm * BM + wr * 64 + fr;
        const bool isg = u.pn >= 7;
        const int lc0 = (isg ? (u.pn - 7) * BM : u.pn * BM) + wc * 32 + 8 * fq;
        bf16_t* base = isg ? GT : PM; const int ldc = isg ? 4096 : 1792;
        f32x4 bv[2][2];
#pragma unroll
        for (int bj = 0; bj < 2; ++bj)
#pragma unroll
            for (int n = 0; n < 2; ++n) bv[bj][n] = isg ? *(const f32x4*)(bgate + lc0 + bj * HALF + 4 * n) : (f32x4){0.f, 0.f, 0.f, 0.f};
        float rsv[2][4]; rows_rstd(ssq, row0, fq, rsv);
#pragma unroll
        for (int ai = 0; ai < 2; ++ai)
#pragma unroll
            for (int m = 0; m < 4; ++m) { const int row = row0 + ai * HALF + m * 16;
                const float rs = rsv[ai][m];
                bf16_t* rowp = base + (size_t)row * ldc + lc0;
#pragma unroll
                for (int bj = 0; bj < 2; ++bj) { f32x4 v0 = acc[ai][bj][m][0] * rs + bv[bj][0], v1 = acc[ai][bj][m][1] * rs + bv[bj][1];
                    if (isg) { v0 = (f32x4){sigm(v0[0]), sigm(v0[1]), sigm(v0[2]), sigm(v0[3])}; v1 = (f32x4){sigm(v1[0]), sigm(v1[1]), sigm(v1[2]), sigm(v1[3])}; }
                    u32x4 w; w.x = cvt_pk_bf16(v0[0], v0[1]); w.y = cvt_pk_bf16(v0[2], v0[3]); w.z = cvt_pk_bf16(v1[0], v1[1]); w.w = cvt_pk_bf16(v1[2], v1[3]);
                    *(u32x4*)(rowp + bj * HALF) = w; } }
    }
};
struct EpiResid {
    static constexpr bool PERM = true, AFTER_DRAIN = false;
    const float* xp; const float* xs; float* xo; bf16_t* XB; float* ssq;
    __device__ __forceinline__ void operator()(const f32x4 (&acc)[2][2][4][2], const Unit& u, int wr, int wc, int fr, int fq) const {
        const int row0 = u.pm * BM + wr * 64 + fr, col0 = u.pn * BM + wc * 32 + 8 * fq;
#pragma unroll
        for (int ai = 0; ai < 2; ++ai)
#pragma unroll
            for (int m = 0; m < 4; ++m) { const int row = row0 + ai * HALF + m * 16;
                const float* src = (row < 16384 ? xp + (size_t)row * 1024 : xs + (size_t)(row - 16384) * 1024) + col0;
                float* dst = xo + (size_t)row * 1024 + col0; bf16_t* dstb = XB + (size_t)row * 1024 + col0; float ss = 0.f;
#pragma unroll
                for (int bj = 0; bj < 2; ++bj) { const f32x4 o0 = *(const f32x4*)(src + bj * HALF) + acc[ai][bj][m][0], o1 = *(const f32x4*)(src + bj * HALF + 4) + acc[ai][bj][m][1];
                    *(f32x4*)(dst + bj * HALF) = o0; *(f32x4*)(dst + bj * HALF + 4) = o1;
                    u32x4 w; w.x = cvt_pk_bf16(o0[0], o0[1]); w.y = cvt_pk_bf16(o0[2], o0[3]); w.z = cvt_pk_bf16(o1[0], o1[1]); w.w = cvt_pk_bf16(o1[2], o1[3]);
                    *(u32x4*)(dstb + bj * HALF) = w;
                    ss += ((o0[0] * o0[0] + o0[1] * o0[1]) + (o0[2] * o0[2] + o0[3] * o0[3])) + ((o1[0] * o1[0] + o1[1] * o1[1]) + (o1[2] * o1[2] + o1[3] * o1[3])); }
                ss += __shfl_xor(ss, 16); ss += __shfl_xor(ss, 32);
                if (fq == 0) ssq[((size_t)u.pn * 17408 + row) * 4 + wc] = ss; }
    }
};
struct EpiSwiGLU {
    static constexpr bool PERM = true, AFTER_DRAIN = false;
    bf16_t* ACT; const float* ssq;
    __device__ __forceinline__ void operator()(const f32x4 (&acc)[2][2][4][2], const Unit& u, int wr, int wc, int fr, int fq) const {
        const int row0 = u.pm * BM + wr * 64 + fr, col0 = u.pn * HALF + wc * 32 + 8 * fq;
        float rsv[2][4]; rows_rstd(ssq, row0, fq, rsv);
#pragma unroll
        for (int ai = 0; ai < 2; ++ai)
#pragma unroll
            for (int m = 0; m < 4; ++m) { const int row = row0 + ai * HALF + m * 16;
                const float rs = rsv[ai][m];
                const f32x4 g0 = acc[ai][0][m][0] * rs, g1 = acc[ai][0][m][1] * rs, u0 = acc[ai][1][m][0] * rs, u1 = acc[ai][1][m][1] * rs;
                float o[8];
#pragma unroll
                for (int j = 0; j < 4; ++j) { o[j] = g0[j] * sigm(g0[j]) * u0[j]; o[4 + j] = g1[j] * sigm(g1[j]) * u1[j]; }
                u32x4 w; w.x = cvt_pk_bf16(o[0], o[1]); w.y = cvt_pk_bf16(o[2], o[3]); w.z = cvt_pk_bf16(o[4], o[5]); w.w = cvt_pk_bf16(o[6], o[7]);
                *(u32x4*)(ACT + (size_t)row * 2816 + col0) = w; }
    }
};

template <class Epi, class Sched, bool ALIGN_EPI = false, bool SP2 = false>
__device__ __forceinline__ void gemm_phase(PG8_LAS unsigned char* lds, const Gemm g, const Sched& S, const Epi& E) {
    int tid_ = threadIdx.x; asm volatile("" : "+v"(tid_));
    const int tid = tid_, wid = __builtin_amdgcn_readfirstlane(tid >> 6), lane = tid & 63, wr = wid >> 2, wc = wid & 3, fr = lane & 15, fq = lane >> 4;
    const int K = g.K, nt = K / BK;
    unsigned voffA[2], voffB[2];
#pragma unroll
    for (int i = 0; i < 2; ++i) { int R, C; stage_rc(tid * 16 + i * 8192, R, C); const int Rb = Epi::PERM ? ((R & ~31) + perm32(R & 31)) : R;
        voffA[i] = (unsigned)(R * K + C) * 2u; voffB[i] = (unsigned)(Rb * K + C) * 2u; }
    const size_t kstep = (size_t)(BK * 2);
    const size_t hstep = (size_t)HALF * K * 2;
    const size_t tstep = 2 * hstep;
    const unsigned ldsw = (unsigned)wid * 1024u;
    const int aoff = lds_byte(wr * 64 + fr, fq * 8), boff = lds_byte(wc * 32 + fr, fq * 8);
#define PG8_SA(b, h) (((b) * 2 + (h)) * HTB)
#define PG8_SB(b, h) ((4 + (b) * 2 + (h)) * HTB)
#define PG8_STAGE(bufoff, gbase, voff) do { _Pragma("unroll") for (int _i = 0; _i < 2; ++_i) \
        __builtin_amdgcn_global_load_lds((const unsigned*)((const char*)(gbase) + (voff)[_i]), (PG8_LAS unsigned*)(lds + (bufoff) + ldsw + _i * 8192), 16, 0, 0); } while (0)
#define PG8_LDA(dst, b, h) do { _Pragma("unroll") for (int m = 0; m < 4; ++m) _Pragma("unroll") for (int k = 0; k < 2; ++k) dst[m][k] = *(const PG8_LAS bf16x8*)(lds + PG8_SA(b, h) + aoff + m * 2048 + k * 1024); } while (0)
#define PG8_LDB(dst, b, h) do { _Pragma("unroll") for (int n = 0; n < 2; ++n) _Pragma("unroll") for (int k = 0; k < 2; ++k) dst[n][k] = *(const PG8_LAS bf16x8*)(lds + PG8_SB(b, h) + boff + n * 2048 + k * 1024); } while (0)
#define PG8_MMA(ai, bj, At, Bt) do { __builtin_amdgcn_s_setprio(1); _Pragma("unroll") for (int m = 0; m < 4; ++m) _Pragma("unroll") for (int n = 0; n < 2; ++n) _Pragma("unroll") for (int k = 0; k < 2; ++k) \
        acc[ai][bj][m][n] = __builtin_amdgcn_mfma_f32_16x16x32_bf16(Bt[n][k], At[m][k], acc[ai][bj][m][n], 0, 0, 0); __builtin_amdgcn_s_setprio(0); } while (0)
#define PG8_WAIT_V(n) asm volatile("s_waitcnt vmcnt(" #n ")" ::: "memory")
#define PG8_WAIT_L(n) asm volatile("s_waitcnt lgkmcnt(" #n ")" ::: "memory")
#define PG8_BAR __builtin_amdgcn_s_barrier()
#define PG8_SCHED __builtin_amdgcn_sched_barrier(0)
    Unit cur, nxt; int ui = 0;
    if (!S.next(0, cur)) return;
    f32x4 acc[2][2][4][2];
#pragma unroll
    for (int a = 0; a < 2; ++a)
#pragma unroll
        for (int b = 0; b < 2; ++b)
#pragma unroll
            for (int m = 0; m < 4; ++m)
#pragma unroll
                for (int n = 0; n < 2; ++n) acc[a][b][m][n] = (f32x4){0.f, 0.f, 0.f, 0.f};
    bf16x8 At[4][2], B0[2][2], B1[2][2];
    const char* cA = (const char*)g.A + (size_t)cur.pm * tstep; const char* cB = (const char*)g.Bt + (size_t)cur.pn * tstep;
    S.a_ready(cur);
    if constexpr (SP2) {
        PG8_STAGE(PG8_SB(0, 0), cB, voffB); PG8_STAGE(PG8_SB(0, 1), cB + hstep, voffB); PG8_STAGE(PG8_SA(0, 0), cA, voffA); PG8_STAGE(PG8_SA(0, 1), cA + hstep, voffA);
        if (wr == 1) PG8_BAR;
        PG8_WAIT_V(2); PG8_BAR;
        PG8_STAGE(PG8_SB(1, 0), cB + kstep, voffB); PG8_STAGE(PG8_SA(1, 0), cA + kstep, voffA); PG8_STAGE(PG8_SB(1, 1), cB + hstep + kstep, voffB);
        PG8_WAIT_V(6); PG8_BAR;
    } else {
        PG8_STAGE(PG8_SB(0, 0), cB, voffB); PG8_STAGE(PG8_SA(0, 0), cA, voffA); PG8_STAGE(PG8_SB(0, 1), cB + hstep, voffB); PG8_STAGE(PG8_SA(0, 1), cA + hstep, voffA);
        if (wr == 1) PG8_BAR;
        PG8_WAIT_V(4); PG8_BAR;
        PG8_STAGE(PG8_SB(1, 0), cB + kstep, voffB); PG8_STAGE(PG8_SA(1, 0), cA + kstep, voffA); PG8_STAGE(PG8_SB(1, 1), cB + hstep + kstep, voffB);
        PG8_WAIT_V(6); PG8_BAR;
    }
    for (;;) {
        const bool has_next = S.next(ui + 1, nxt);
        const char* nA = has_next ? (const char*)g.A + (size_t)nxt.pm * tstep : cA; const char* nB = has_next ? (const char*)g.Bt + (size_t)nxt.pn * tstep : cB;
        for (int t = 0; t < nt; t += 2) {
            const bool last = (t == nt - 2);
            const char* a1 = cA + (size_t)(t + 1) * kstep;
            const char* a2 = last ? nA : cA + (size_t)(t + 2) * kstep; const char* b2 = last ? nB : cB + (size_t)(t + 2) * kstep;
            const char* a3 = a2 + kstep; const char* b3 = b2 + kstep;
            if (last && has_next) S.a_ready(nxt);
            if constexpr (SP2) {
            PG8_LDB(B0, 0, 0); PG8_LDB(B1, 0, 1); PG8_SCHED; PG8_LDA(At, 0, 0); PG8_STAGE(PG8_SA(1, 1), a1 + hstep, voffA);
            PG8_WAIT_V(8); PG8_WAIT_L(0); PG8_BAR; PG8_MMA(0, 0, At, B0); PG8_MMA(0, 1, At, B1); PG8_BAR; PG8_SCHED;
            PG8_LDA(At, 0, 1); PG8_STAGE(PG8_SB(0, 0), b2, voffB); PG8_STAGE(PG8_SB(0, 1), b2 + hstep, voffB); PG8_STAGE(PG8_SA(0, 0), a2, voffA);
            PG8_WAIT_V(8); PG8_WAIT_L(0); PG8_BAR; PG8_MMA(1, 0, At, B0); PG8_MMA(1, 1, At, B1); PG8_BAR; PG8_SCHED;
            PG8_LDB(B0, 1, 0); PG8_LDB(B1, 1, 1); PG8_SCHED; PG8_LDA(At, 1, 0); PG8_STAGE(PG8_SA(0, 1), a2 + hstep, voffA);
            PG8_WAIT_V(8); PG8_WAIT_L(0); PG8_BAR; PG8_MMA(0, 0, At, B0); PG8_MMA(0, 1, At, B1); PG8_BAR; PG8_SCHED;
            PG8_LDA(At, 1, 1); PG8_STAGE(PG8_SB(1, 0), b3, voffB); PG8_STAGE(PG8_SB(1, 1), b3 + hstep, voffB); PG8_STAGE(PG8_SA(1, 0), a3, voffA);
            PG8_WAIT_V(8); PG8_WAIT_L(0); PG8_BAR; PG8_MMA(1, 0, At, B0); PG8_MMA(1, 1, At, B1); PG8_BAR; PG8_SCHED;
            } else {
            PG8_LDB(B0, 0, 0); PG8_SCHED; PG8_LDA(At, 0, 0); PG8_STAGE(PG8_SA(1, 1), a1 + hstep, voffA);
            PG8_WAIT_L(8); PG8_BAR; PG8_WAIT_L(0); PG8_MMA(0, 0, At, B0); PG8_BAR; PG8_SCHED;
            PG8_LDB(B1, 0, 1); PG8_STAGE(PG8_SB(0, 0), b2, voffB);
            PG8_BAR; PG8_WAIT_L(0); PG8_MMA(0, 1, At, B1); PG8_BAR;
            PG8_LDA(At, 0, 1); PG8_STAGE(PG8_SA(0, 0), a2, voffA);
            PG8_BAR; PG8_WAIT_L(0); PG8_MMA(1, 0, At, B0); PG8_BAR; PG8_SCHED;
            PG8_STAGE(PG8_SB(0, 1), b2 + hstep, voffB);
            PG8_WAIT_V(6); PG8_BAR; PG8_MMA(1, 1, At, B1); PG8_BAR;
            PG8_LDB(B0, 1, 0); PG8_SCHED; PG8_LDA(At, 1, 0); PG8_STAGE(PG8_SA(0, 1), a2 + hstep, voffA);
            PG8_WAIT_L(8); PG8_BAR; PG8_WAIT_L(0); PG8_MMA(0, 0, At, B0); PG8_BAR; PG8_SCHED;
            PG8_LDB(B1, 1, 1); PG8_STAGE(PG8_SB(1, 0), b3, voffB);
            PG8_BAR; PG8_WAIT_L(0); PG8_MMA(0, 1, At, B1); PG8_BAR;
            PG8_LDA(At, 1, 1); PG8_STAGE(PG8_SA(1, 0), a3, voffA);
            PG8_BAR; PG8_WAIT_L(0); PG8_MMA(1, 0, At, B0); PG8_BAR; PG8_SCHED;
            PG8_STAGE(PG8_SB(1, 1), b3 + hstep, voffB);
            PG8_WAIT_V(6); PG8_BAR; PG8_MMA(1, 1, At, B1); PG8_BAR;
            }
        }
        if constexpr (ALIGN_EPI) { if (wr == 0) PG8_BAR; }
        if constexpr (!Epi::AFTER_DRAIN) { E(acc, cur, wr, wc, fr, fq); S.done(cur); }
        if (!has_next) break;
#pragma unroll
        for (int a = 0; a < 2; ++a)
#pragma unroll
            for (int b = 0; b < 2; ++b)
#pragma unroll
                for (int m = 0; m < 4; ++m)
#pragma unroll
                    for (int n = 0; n < 2; ++n) acc[a][b][m][n] = (f32x4){0.f, 0.f, 0.f, 0.f};
        cur = nxt; cA = nA; cB = nB; ++ui;
        if constexpr (ALIGN_EPI) { if (wr == 1) PG8_BAR; }
    }
    PG8_WAIT_V(0);
    if constexpr (!ALIGN_EPI) { if (wr == 0) PG8_BAR; }
    PG8_BAR;
    if constexpr (Epi::AFTER_DRAIN) { E.fused(acc, cur, wr, wc, fr, fq, lds, wid, lane); S.done(cur); }
#undef PG8_SA
#undef PG8_SB
#undef PG8_STAGE
#undef PG8_LDA
#undef PG8_LDB
#undef PG8_MMA
#undef PG8_WAIT_V
#undef PG8_WAIT_L
#undef PG8_BAR
#undef PG8_SCHED
}
}
constexpr int D = 1024, MP = 16384, MS = 1024, M = MP + MS, NLAYER = 4, MIXW = 256, INC = 5888, PMC = 1792, GTC = 4096, FF = 2816;
constexpr int SEQ = 2048, NB = 8, DB = 128, DSEQ = 8, NCH = SEQ / 64;
constexpr int NPHASE = 2 + 7 * NLAYER;
#ifndef MK_PER_PHASE
#define MK_PER_PHASE 0
#endif
constexpr size_t O_Y = 0, O_POOLP = 17825792, O_POOLS = 17948672, O_SREP = 19914752, O_SRES = 19947520, O_SIMP = 20471808, O_SIMS = 20504576,
                 O_SCP = 21028864, O_SCS = 21045248, O_CFP = 21307392, O_CFS = 21553152, O_END = 25485312;
constexpr size_t MiB = 1u << 20;
constexpr size_t WS_CTL = 0, CTL_ZERO_BYTES = 64 * 1024;
constexpr size_t WS_SSQ = 1 * MiB;
constexpr size_t WS_E = 3 * MiB;
constexpr size_t WS_TAB = 5 * MiB;
constexpr size_t TAB_LB = 0, TAB_LP = 8192, TAB_BBT = 16384, TAB_CM = TAB_BBT + 65536, TAB_PW = TAB_CM + 65536, TAB_STRIDE = TAB_PW + 32768;
constexpr size_t WS_WIN = 6 * MiB;
constexpr size_t WS_WFI = WS_WIN + (size_t)NLAYER * INC * D * 2;
constexpr size_t WS_WOUT = WS_WFI + (size_t)NLAYER * 2 * FF * D * 2;
constexpr size_t WS_WFO = WS_WOUT + (size_t)NLAYER * D * D * 2;
constexpr size_t WS_WBR = WS_WFO + (size_t)NLAYER * D * FF * 2;
constexpr size_t WS_WGLU = WS_WBR + (size_t)NLAYER * 4 * D * MIXW * 2;
constexpr size_t WS_ACT1 = WS_WGLU + (size_t)NLAYER * MIXW * MIXW * 2;
constexpr size_t WS_PM = WS_ACT1 + (size_t)M * D * 2;
constexpr size_t WS_GT = WS_PM + (size_t)M * PMC * 2;
constexpr size_t WS_END = WS_GT + (size_t)M * GTC * 2;
static_assert(WS_TAB + NLAYER * TAB_STRIDE <= WS_WIN && WS_E + (size_t)NB * NCH * 1024 * 8 <= WS_TAB && WS_SSQ + (size_t)M * 64 <= WS_E, "d_ws map");
constexpr int CW_BAR = 1024;
constexpr int RING_OFF = 0, RING_BYTES = 131072;
constexpr int LDSCTL_OFF = RING_BYTES, MISC_OFF = LDSCTL_OFF + 320;
constexpr int LDS_BYTES = 147456;
constexpr int NWAVES = 8;

#define GAS __attribute__((address_space(1)))
#define LAS __attribute__((address_space(3)))
typedef unsigned short bf16;
typedef unsigned short bf16_t;
typedef unsigned v4u __attribute__((ext_vector_type(4)));
typedef unsigned v2u __attribute__((ext_vector_type(2)));
typedef float f32x4 __attribute__((ext_vector_type(4)));
typedef float f32x2 __attribute__((ext_vector_type(2)));
typedef short bf16x8 __attribute__((ext_vector_type(8)));
#define LDS_WAIT() asm volatile("s_waitcnt lgkmcnt(0)" ::: "memory")
#define VM_WAIT() asm volatile("s_waitcnt vmcnt(0)" ::: "memory")
__device__ __forceinline__ unsigned pk2(float lo, float hi) { return pg8::cvt_pk_bf16(lo, hi); }
__device__ __forceinline__ float bflo(unsigned u) { return __builtin_bit_cast(float, u << 16); }
__device__ __forceinline__ float bfhi(unsigned u) { return __builtin_bit_cast(float, u & 0xffff0000u); }
__device__ __forceinline__ float bf1(bf16_t b) { return __builtin_bit_cast(float, (unsigned)b << 16); }
__device__ __forceinline__ void unpack8(const v4u v, float (&f)[8]) { f[0] = bflo(v.x); f[1] = bfhi(v.x); f[2] = bflo(v.y); f[3] = bfhi(v.y); f[4] = bflo(v.z); f[5] = bfhi(v.z); f[6] = bflo(v.w); f[7] = bfhi(v.w); }
__device__ __forceinline__ v4u pack8(const float (&f)[8]) { v4u w; w.x = pk2(f[0], f[1]); w.y = pk2(f[2], f[3]); w.z = pk2(f[4], f[5]); w.w = pk2(f[6], f[7]); return w; }
__device__ __forceinline__ float sigm(float x) { return pg8::sigm(x); }
__device__ __forceinline__ float gelu_tanh(float y) { const float in2 = 1.5957691216057308f * (y + 0.044715f * y * y * y); const float e = __builtin_amdgcn_exp2f(1.4426950408889634f * in2); return 0.5f * y * (2.0f - 2.0f * __builtin_amdgcn_rcpf(e + 1.0f)); }
__device__ __forceinline__ float wave_sum(float v) {
#pragma unroll
    for (int o = 1; o < 64; o <<= 1) v += __shfl_xor(v, o);
    return v;
}

#define XB_TMO      128
#define XB_XCNT(j)  (256  + 64 * (j))
#define XB_XSUB(j)  (1280 + 64 * (j))
#define XB_XGEN(j)  (2304 + 64 * (j))
#define XB_TOP      3328
#define XB_TOPGEN   3392
#define XCD_BAR_WORDS 3456
#define XB_SPIN_CAP (1u << 18)

__device__ __forceinline__ unsigned xb_ld(unsigned* p)              { return __hip_atomic_load(p, __ATOMIC_RELAXED, __HIP_MEMORY_SCOPE_AGENT); }
__device__ __forceinline__ unsigned xb_add(unsigned* p, unsigned v) { return __hip_atomic_fetch_add(p, v, __ATOMIC_RELAXED, __HIP_MEMORY_SCOPE_AGENT); }
__device__ __forceinline__ unsigned xb_xcc_id() { return (unsigned)__builtin_amdgcn_s_getreg((3 << 11) | 20) & 0xFu; }
#define XB_SPIN(cond, bar) do { unsigned _sp = 0; while (cond) { __builtin_amdgcn_s_sleep(1); \
    if ((++_sp & 255u) == 0u) { if (xb_ld(&(bar)[XB_TMO])) break; if (_sp > XB_SPIN_CAP) { atomicAdd(&(bar)[XB_TMO], 1u); break; } } } } while (0)

struct XcdBarrier {
    unsigned* bar; unsigned x;
    volatile LAS unsigned* st;
};

__device__ __forceinline__ XcdBarrier xcd_barrier_post(unsigned* bar, volatile LAS unsigned* st) {
    XcdBarrier b; b.bar = bar; b.x = xb_xcc_id(); b.st = st;
    if (threadIdx.x == 0) (void)xb_add(&bar[XB_XCNT(b.x)], 1u);
    return b;
}
__device__ __forceinline__ void xcd_barrier_complete(unsigned* bar, unsigned x, unsigned& nloc, unsigned& nx) {
    const unsigned G = gridDim.x * gridDim.y * gridDim.z;
    unsigned sum, cnt, mine, sp = 0u;
    for (;;) {
        sum = 0u; cnt = 0u; mine = 0u;
#pragma unroll
        for (unsigned j = 0; j < 16; ++j) { const unsigned c = xb_ld(&bar[XB_XCNT(j)]); sum += c; cnt += (c > 0u) ? 1u : 0u; mine = (j == x) ? c : mine; }
        if (sum == G) break;
        __builtin_amdgcn_s_sleep(1);
        if ((++sp & 255u) == 0u) { if (xb_ld(&bar[XB_TMO])) break; if (sp > XB_SPIN_CAP) { atomicAdd(&bar[XB_TMO], 1u); break; } }
    }
    nloc = mine > 0u ? mine : 1u; nx = cnt > 0u ? cnt : 1u;
}

__device__ __forceinline__ void xcd_barrier(const XcdBarrier& b) {
    asm volatile("s_waitcnt vmcnt(0)" ::: "memory");
    __syncthreads();
    if (threadIdx.x == 0) {
        unsigned* bar = b.bar;
        __builtin_amdgcn_s_waitcnt(0);
        unsigned nloc = b.st[0], nx = b.st[1];
        if (nloc == 0u) { xcd_barrier_complete(bar, b.x, nloc, nx); b.st[0] = nloc; b.st[1] = nx; }
        const unsigned old = xb_add(&bar[XB_XSUB(b.x)], 1u);
        const unsigned gen = old / nloc;
        if (old + 1u == (gen + 1u) * nloc) {
            __builtin_amdgcn_fence(__ATOMIC_RELEASE, "agent");
            asm volatile("s_waitcnt vmcnt(0)" ::: "memory");
            const unsigned og = xb_add(&bar[XB_TOP], 1u);
            const unsigned tg = og / nx;
            if (og + 1u == (tg + 1u) * nx) xb_add(&bar[XB_TOPGEN], 1u);
            else XB_SPIN(xb_ld(&bar[XB_TOPGEN]) == tg, bar);
            __builtin_amdgcn_fence(__ATOMIC_ACQUIRE, "agent");
            xb_add(&bar[XB_XGEN(b.x)], 1u);
            asm volatile("s_waitcnt vmcnt(0)" ::: "memory");
        } else {
            XB_SPIN(xb_ld(&bar[XB_XGEN(b.x)]) == gen, bar);
            __builtin_amdgcn_fence(__ATOMIC_ACQUIRE, "agent");
            asm volatile("s_waitcnt vmcnt(0)" ::: "memory");
        }
    }
    __syncthreads();
}
struct Args { const float* in[32]; float* out; unsigned char* ws; int ph_lo, ph_hi; };
enum { I_XP = 0, I_XS, I_STPOOL, I_STRE, I_STIM, I_STSC, I_STCF, I_N1G, I_N2G, I_FING, I_WIN, I_BGATE, I_POOLW, I_POOLSC, I_LAMRE, I_LAMIM, I_LOGDT,
       I_BRE, I_BIM, I_CRE, I_CIM, I_DSKIP, I_WGLU, I_BGLU, I_SCW, I_CFW, I_CFLNG, I_CFLNB, I_WBR, I_WOUT, I_WFI, I_WFO };

__device__ __forceinline__ void p0_item(const float* W, int ldw, int src_col0, const float* kscale, int k0, bf16* WTrow0, int K, LAS float* scr, int lane) {
    float wv[32];
#pragma unroll
    for (int i = 0; i < 32; ++i) { const int kk = 2 * i + (lane >> 5); wv[i] = W[(size_t)(k0 + kk) * ldw + src_col0 + (lane & 31)]; }
#pragma unroll
    for (int i = 0; i < 32; ++i) { const int kk = 2 * i + (lane >> 5); scr[kk * 33 + (lane & 31)] = wv[i]; }
    LDS_WAIT(); asm volatile("" ::: "memory");
    const int c = lane & 7;
    f32x4 ks0 = (f32x4){1.f, 1.f, 1.f, 1.f}, ks1 = ks0;
    if (kscale) { ks0 = *(const f32x4*)(kscale + k0 + 8 * c); ks1 = *(const f32x4*)(kscale + k0 + 8 * c + 4); }
#pragma unroll
    for (int j = 0; j < 4; ++j) { const int n = (lane >> 3) + 8 * j; const LAS float* s = scr + (8 * c) * 33 + n;
        v4u o; o.x = pk2(s[0 * 33] * ks0[0], s[1 * 33] * ks0[1]); o.y = pk2(s[2 * 33] * ks0[2], s[3 * 33] * ks0[3]); o.z = pk2(s[4 * 33] * ks1[0], s[5 * 33] * ks1[1]); o.w = pk2(s[6 * 33] * ks1[2], s[7 * 33] * ks1[3]);
        *(GAS v4u*)(WTrow0 + (size_t)n * K + k0 + 8 * c) = o; }
    LDS_WAIT(); asm volatile("" ::: "memory");
}
__device__ __forceinline__ void p0_prologue(const Args& a, LAS unsigned char* lds, int tid, int lane, int wave, int G, int bid) {
    LAS float* scr = (LAS float*)(lds + RING_OFF + wave * 16384);
    const int gw = bid * NWAVES + wave, NGW = G * NWAVES;
    unsigned char* ws = a.ws;
    constexpr int IT_IN = 16 * (INC / 32), IT_FI = 16 * (2 * FF / 32), IT_OUT = 16 * 32, IT_FO = (FF / 64) * 32, IT_BR = 4 * 4 * 32, IT_GLU = 4 * 8;
    constexpr int IT_LAYER = IT_IN + IT_FI + IT_OUT + IT_FO + IT_BR + IT_GLU;
    for (int it = gw; it < NLAYER * IT_LAYER; it += NGW) {
        const int L = it / IT_LAYER; int r = it % IT_LAYER;
        if (r < IT_IN) { const int nblk = INC / 32, kb = r / nblk, nb = r % nblk;
            p0_item(a.in[I_WIN] + (size_t)L * D * INC, INC, 32 * nb, a.in[I_N1G] + L * D, 64 * kb, (bf16*)(ws + WS_WIN) + ((size_t)L * INC + 32 * nb) * D, D, scr, lane); continue; } r -= IT_IN;
        if (r < IT_FI) { const int nblk = 2 * FF / 32, kb = r / nblk, nb = r % nblk; const int nd = 32 * nb, pn = nd >> 8, rr = nd & 255;
            const int src = rr < 128 ? 128 * pn + rr : FF + 128 * pn + (rr - 128);
            p0_item(a.in[I_WFI] + (size_t)L * D * 2 * FF, 2 * FF, src, a.in[I_N2G] + L * D, 64 * kb, (bf16*)(ws + WS_WFI) + ((size_t)L * 2 * FF + nd) * D, D, scr, lane); continue; } r -= IT_FI;
        if (r < IT_OUT) { const int kb = r / 32, nb = r % 32;
            p0_item(a.in[I_WOUT] + (size_t)L * D * D, D, 32 * nb, nullptr, 64 * kb, (bf16*)(ws + WS_WOUT) + ((size_t)L * D + 32 * nb) * D, D, scr, lane); continue; } r -= IT_OUT;
        if (r < IT_FO) { const int kb = r / 32, nb = r % 32;
            p0_item(a.in[I_WFO] + (size_t)L * FF * D, D, 32 * nb, nullptr, 64 * kb, (bf16*)(ws + WS_WFO) + ((size_t)L * D + 32 * nb) * FF, FF, scr, lane); continue; } r -= IT_FO;
        if (r < IT_BR) { const int br = r / 128, q = r % 128, kb = q / 32, nb = q % 32;
            p0_item(a.in[I_WBR] + (size_t)(L * 4 + br) * MIXW * D, D, 32 * nb, nullptr, 64 * kb, (bf16*)(ws + WS_WBR) + ((size_t)(L * 4 + br) * D + 32 * nb) * MIXW, MIXW, scr, lane); continue; } r -= IT_BR;
        { const int kb = r / 8, nb = r % 8;
            p0_item(a.in[I_WGLU] + (size_t)L * MIXW * MIXW, MIXW, 32 * nb, nullptr, 64 * kb, (bf16*)(ws + WS_WGLU) + ((size_t)L * MIXW + 32 * nb) * MIXW, MIXW, scr, lane); }
    }
    for (int m = gw; m < M; m += NGW) {
        const float* xrow = m < MP ? a.in[I_XP] + (size_t)m * D : a.in[I_XS] + (size_t)(m - MP) * D;
        const GAS f32x4* xr = (const GAS f32x4*)xrow + lane; f32x4 v[4]; float s = 0.f;
#pragma unroll
        for (int j = 0; j < 4; ++j) { v[j] = xr[64 * j]; s += (v[j][0] * v[j][0] + v[j][1] * v[j][1]) + (v[j][2] * v[j][2] + v[j][3] * v[j][3]); }
        s = wave_sum(s);
        GAS v2u* o8 = (GAS v2u*)((bf16*)(ws + WS_ACT1) + (size_t)m * D) + lane;
#pragma unroll
        for (int j = 0; j < 4; ++j) { v2u w; w.x = pk2(v[j][0], v[j][1]); w.y = pk2(v[j][2], v[j][3]); o8[64 * j] = w; }
        if (lane < 16) ((float*)(ws + WS_SSQ))[((size_t)(lane >> 2) * M + m) * 4 + (lane & 3)] = lane == 0 ? s : 0.f;
    }
    for (int idx = bid * 512 + tid; idx < NLAYER * 1024; idx += G * 512) {
        const int L = idx >> 10, gp = idx & 1023, g = gp >> 6, p = gp & 63;
        unsigned char* tab = ws + WS_TAB + (size_t)L * TAB_STRIDE;
        const float lre = a.in[I_LAMRE][idx], lim = a.in[I_LAMIM][idx], dt = expf(a.in[I_LOGDT][L * 16 + g]);
        const float ar = lre * dt, br_ = lim * dt, ea = expf(ar), cb = cosf(br_), sb = sinf(br_), sh = sinf(0.5f * br_);
        const float lbr = ea * cb, lbi = ea * sb;
        const float m1r = expm1f(ar) * cb - 2.0f * sh * sh, m1i = lbi;
        const float den = 1.0f / (lre * lre + lim * lim);
        const float qr = (m1r * lre + m1i * lim) * den, qi = (m1i * lre - m1r * lim) * den;
        ((f32x2*)(tab + TAB_LB))[gp] = (f32x2){lbr, lbi};
        float pr = lbr, pi = lbi;
#pragma unroll
        for (int s = 0; s < 6; ++s) { const float nr = pr * pr - pi * pi, ni = 2.0f * pr * pi; pr = nr; pi = ni; }
        ((f32x2*)(tab + TAB_LP))[gp] = (f32x2){pr, pi};
        bf16* bbt = (bf16*)(tab + TAB_BBT); bf16* cm = (bf16*)(tab + TAB_CM);
        const float* bre = a.in[I_BRE] + (size_t)idx * 16; const float* bim = a.in[I_BIM] + (size_t)idx * 16;
#pragma unroll
        for (int c = 0; c < 16; ++c) { const float Br = bre[c], Bi = bim[c];
            bbt[(g * 128 + p) * 16 + c] = (bf16)(pk2(qr * Br - qi * Bi, 0.f) & 0xffffu);
            bbt[(g * 128 + 64 + p) * 16 + c] = (bf16)(pk2(qr * Bi + qi * Br, 0.f) & 0xffffu);
            cm[(g * 16 + c) * 128 + p] = (bf16)(pk2(a.in[I_CRE][((size_t)(L * 16 + g) * 16 + c) * 64 + p], 0.f) & 0xffffu);
            cm[(g * 16 + c) * 128 + 64 + p] = (bf16)(pk2(-a.in[I_CIM][((size_t)(L * 16 + g) * 16 + c) * 64 + p], 0.f) & 0xffffu); }
    }
    for (int idx = bid * 512 + tid; idx < NLAYER * 4 * 64 * 64; idx += G * 512) {
        const int L = idx >> 14, r = idx & 16383, k = r >> 12, o = (r >> 6) & 63, c = r & 63;
        ((bf16*)(ws + WS_TAB + (size_t)L * TAB_STRIDE + TAB_PW))[r] = (bf16)(pk2(a.in[I_POOLW][((size_t)(L * 4 + k) * 64 + c) * 64 + o], 0.f) & 0xffffu);
    }
}
__device__ __forceinline__ void final_norm(const Args& a, int lane, int wave, int G, int bid) {
    const int gw = bid * NWAVES + wave, NGW = G * NWAVES;
        const float* ssq = (const float*)(a.ws + WS_SSQ);
    f32x4 gv[4];
#pragma unroll
    for (int j = 0; j < 4; ++j) gv[j] = ((const f32x4*)a.in[I_FING])[lane + 64 * j];
    for (int m = gw; m < M; m += NGW) {
        float s = lane < 16 ? ssq[((size_t)(lane >> 2) * M + m) * 4 + (lane & 3)] : 0.f; s = wave_sum(s);
        const float rs = __builtin_amdgcn_rsqf(s * (1.0f / 1024.0f) + 1e-6f);
        GAS f32x4* xr = (GAS f32x4*)(a.out + (size_t)m * D) + lane;
#pragma unroll
        for (int j = 0; j < 4; ++j) { f32x4 v = xr[64 * j]; xr[64 * j] = v * rs * gv[j]; }
    }
}

typedef float f32x4_t __attribute__((ext_vector_type(4)));
__device__ __forceinline__ float fma_s(float a, float b, float c) { float r; asm("v_fma_f32 %0, %1, %2, %3" : "=v"(r) : "v"(a), "v"(b), "v"(c)); return r; }
template <bool SAMPLE>
__device__ __forceinline__ void mix_unit(const Args& a, int layer, int uidx, LAS unsigned char* lds, int tid_in, int lane_in, int wave_in) {
    int tid = tid_in; asm volatile("" : "+v"(tid));
    const int lane = tid & 63, wave = __builtin_amdgcn_readfirstlane(tid >> 6);
    constexpr int L = SAMPLE ? 8 : 64, NSEG = SAMPLE ? 2 : 1, R = NSEG * L;
    const bf16* PMb = (const bf16*)(a.ws + WS_PM); bf16* BR = (bf16*)(a.ws + WS_ACT1);
    const int s = uidx >> 5, c = uidx & 31, q0 = 2 * uidx;
    const int row0 = SAMPLE ? MP + q0 * 8 : s * SEQ + 64 * c;
    const bool last = SAMPLE || c == NCH - 1;
    LAS float* V = (LAS float*)lds;
    {
        constexpr int TR = NSEG * (30 + L);
        LAS float* WCF = (LAS float*)(lds + 96256);
        {
            constexpr int NIT = (TR * 32 + 511) / 512;
            v4u qa[NIT], qb[NIT]; int kind[NIT];
#pragma unroll
            for (int it = 0; it < NIT; ++it) {
                const int idx = tid + it * 512; kind[it] = 0; qa[it] = (v4u){0u, 0u, 0u, 0u}; qb[it] = (v4u){0u, 0u, 0u, 0u};
                if (idx < TR * 32) {
                    const int rr = idx >> 5, c8 = (idx & 31) * 8, seg = rr / (30 + L), e = rr % (30 + L);
                    int srow = -1;
                    if (SAMPLE) { if (e >= 30) srow = MP + (q0 + seg) * 8 + (e - 30); }
                    else { const int tabs = c * 64 + e - 30; if (tabs >= 0) srow = s * SEQ + tabs; }
                    if (srow >= 0) { kind[it] = 1; qa[it] = *(const v4u*)(PMb + (size_t)srow * PMC + 1280 + c8); qb[it] = *(const v4u*)(PMb + (size_t)srow * PMC + 1536 + c8); }
                    else if (SAMPLE) { kind[it] = 2; const float* st = a.in[I_STCF] + ((size_t)(layer * DB + q0 + seg) * 30 + e) * MIXW + c8; qa[it] = *(const v4u*)st; qb[it] = *(const v4u*)(st + 4); }
                }
            }
#pragma unroll
            for (int it = 0; it < NIT; ++it) {
                const int idx = tid + it * 512;
                if (idx < TR * 32) {
                    const int rr = idx >> 5, c8 = (idx & 31) * 8;
                    float v[8];
                    if (kind[it] == 1) { float av[8], bv[8]; unpack8(qa[it], av); unpack8(qb[it], bv);
#pragma unroll
                        for (int j = 0; j < 8; ++j) v[j] = av[j] * sigm(bv[j]); }
                    else { v[0] = __uint_as_float(qa[it].x); v[1] = __uint_as_float(qa[it].y); v[2] = __uint_as_float(qa[it].z); v[3] = __uint_as_float(qa[it].w);
                           v[4] = __uint_as_float(qb[it].x); v[5] = __uint_as_float(qb[it].y); v[6] = __uint_as_float(qb[it].z); v[7] = __uint_as_float(qb[it].w); }
                    *(LAS f32x4*)(V + rr * 256 + c8) = (f32x4){v[0], v[1], v[2], v[3]}; *(LAS f32x4*)(V + rr * 256 + c8 + 4) = (f32x4){v[4], v[5], v[6], v[7]};
                }
            }
        }
        for (int idx = tid; idx < 31 * 64; idx += 512) *(LAS f32x4*)(WCF + idx * 4) = *(const f32x4*)(a.in[I_CFW] + (size_t)layer * 31 * MIXW + idx * 4);
        __syncthreads();
        if (last) {
            for (int idx = tid; idx < NSEG * 30 * 64; idx += 512) { const int seg = idx / (30 * 64), r = idx % (30 * 64), j = r >> 6, c4 = (r & 63) * 4;
                float* dst = a.out + (SAMPLE ? O_CFS + ((size_t)(layer * DB + q0 + seg) * 30 + j) * MIXW : O_CFP + ((size_t)(layer * NB + s) * 30 + j) * MIXW) + c4;
                *(f32x4*)dst = *(LAS f32x4*)(V + (seg * (30 + L) + L + j) * 256 + c4); }
        }
        const f32x4 lg = *(const f32x4*)(a.in[I_CFLNG] + layer * MIXW + 4 * lane), lb = *(const f32x4*)(a.in[I_CFLNB] + layer * MIXW + 4 * lane);
        for (int tt = wave; tt < R; tt += NWAVES) {
            const int seg = tt / L, t = tt % L, base = seg * (30 + L) + t;
            f32x4 acc = (f32x4){0.f, 0.f, 0.f, 0.f};
#pragma unroll 8
            for (int j = 0; j < 31; ++j) acc += *(LAS f32x4*)(WCF + j * 256 + 4 * lane) * *(LAS f32x4*)(V + (base + j) * 256 + 4 * lane);
            const float mean = wave_sum((acc[0] + acc[1]) + (acc[2] + acc[3])) * (1.0f / 256.0f);
            const f32x4 d = acc - mean;
            const float var = wave_sum((d[0] * d[0] + d[1] * d[1]) + (d[2] * d[2] + d[3] * d[3])) * (1.0f / 256.0f);
            const float rstd = __builtin_amdgcn_rsqf(var + 1e-5f);
            const f32x4 yn = d * rstd * lg + lb;
            v2u w; w.x = pk2(yn[0] * sigm(yn[0]), yn[1] * sigm(yn[1])); w.y = pk2(yn[2] * sigm(yn[2]), yn[3] * sigm(yn[3]));
            *(v2u*)(BR + (size_t)(row0 + tt) * D + 768 + 4 * lane) = w;
        }
        __syncthreads();
    }
    {
        constexpr int TR = NSEG * (15 + L);
        LAS bf16* Dt = (LAS bf16*)(lds + 81920);
        {
            constexpr int NIT = (TR * 32 + 511) / 512;
            v4u qa[NIT], qb[NIT]; int kind[NIT];
#pragma unroll
            for (int it = 0; it < NIT; ++it) {
                const int idx = tid + it * 512; kind[it] = 0; qa[it] = (v4u){0u, 0u, 0u, 0u}; qb[it] = (v4u){0u, 0u, 0u, 0u};
                if (idx < TR * 32) {
                    const int rr = idx >> 5, c8 = (idx & 31) * 8, seg = rr / (15 + L), e = rr % (15 + L);
                    int srow = -1;
                    if (SAMPLE) { if (e >= 15) srow = MP + (q0 + seg) * 8 + (e - 15); }
                    else { const int tabs = c * 64 + e - 15; if (tabs >= 0) srow = s * SEQ + tabs; }
                    if (srow >= 0) { kind[it] = 1; qa[it] = *(const v4u*)(PMb + (size_t)srow * PMC + c8); }
                    else if (SAMPLE) { kind[it] = 2; const float* st = a.in[I_STPOOL] + ((size_t)(layer * DB + q0 + seg) * 15 + e) * MIXW + c8; qa[it] = *(const v4u*)st; qb[it] = *(const v4u*)(st + 4); }
                }
            }
#pragma unroll
            for (int it = 0; it < NIT; ++it) {
                const int idx = tid + it * 512;
                if (idx < TR * 32) {
                    const int rr = idx >> 5, c8 = (idx & 31) * 8;
                    float v[8];
                    if (kind[it] == 1) unpack8(qa[it], v);
                    else { v[0] = __uint_as_float(qa[it].x); v[1] = __uint_as_float(qa[it].y); v[2] = __uint_as_float(qa[it].z); v[3] = __uint_as_float(qa[it].w);
                           v[4] = __uint_as_float(qb[it].x); v[5] = __uint_as_float(qb[it].y); v[6] = __uint_as_float(qb[it].z); v[7] = __uint_as_float(qb[it].w); }
                    *(LAS f32x4*)(V + rr * 256 + c8) = (f32x4){v[0], v[1], v[2], v[3]}; *(LAS f32x4*)(V + rr * 256 + c8 + 4) = (f32x4){v[4], v[5], v[6], v[7]};
                }
            }
        }
        __syncthreads();
        if (last) {
            for (int idx = tid; idx < NSEG * 15 * 64; idx += 512) { const int seg = idx / (15 * 64), r = idx % (15 * 64), j = r >> 6, c4 = (r & 63) * 4;
                float* dst = a.out + (SAMPLE ? O_POOLS + ((size_t)(layer * DB + q0 + seg) * 15 + j) * MIXW : O_POOLP + ((size_t)(layer * NB + s) * 15 + j) * MIXW) + c4;
                *(f32x4*)dst = *(LAS f32x4*)(V + (seg * (15 + L) + L + j) * 256 + c4); }
        }
        for (int idx = tid; idx < R * 32; idx += 512) {
            const int tt = idx >> 5, c8 = (idx & 31) * 8, seg = tt / L, t = tt % L, base = seg * (15 + L) + t + 15, win = 2 << (c8 >> 6);
            float sm[8];
#pragma unroll
            for (int j = 0; j < 8; ++j) sm[j] = 0.f;
            for (int w = 0; w < win; ++w) { const f32x4 x0 = *(LAS f32x4*)(V + (base - w) * 256 + c8), x1 = *(LAS f32x4*)(V + (base - w) * 256 + c8 + 4);
                sm[0] += x0[0]; sm[1] += x0[1]; sm[2] += x0[2]; sm[3] += x0[3]; sm[4] += x1[0]; sm[5] += x1[1]; sm[6] += x1[2]; sm[7] += x1[3]; }
            const int cnt = SAMPLE ? win : min(c * 64 + t + 1, win);
            const float inv = 1.0f / (float)cnt;
            const f32x4 c0 = *(LAS f32x4*)(V + base * 256 + c8), c1 = *(LAS f32x4*)(V + base * 256 + c8 + 4);
            float dd[8];
#pragma unroll
            for (int j = 0; j < 4; ++j) { dd[j] = sm[j] * inv - c0[j]; dd[4 + j] = sm[4 + j] * inv - c1[j]; }
            *(LAS v4u*)(Dt + tt * 264 + c8) = pack8(dd);
        }
        __syncthreads();
        {
            const bf16* PW = (const bf16*)(a.ws + WS_TAB + (size_t)layer * TAB_STRIDE + TAB_PW);
            const int k = wave >> 1, fr = lane & 15, fq = lane >> 4;
            constexpr int NMT = R / 16;
            for (int mt = (NMT >= 4 ? (wave & 1) * 2 : (wave & 1)); mt < (NMT >= 4 ? (wave & 1) * 2 + 2 : ((wave & 1) == 0 ? NMT : 0)); ++mt) {
                const bf16x8 b0 = *(LAS bf16x8*)(Dt + (16 * mt + fr) * 264 + 64 * k + 8 * fq), b1 = *(LAS bf16x8*)(Dt + (16 * mt + fr) * 264 + 64 * k + 32 + 8 * fq);
#pragma unroll
                for (int ot = 0; ot < 4; ++ot) {
                    const bf16x8 a0 = *(const bf16x8*)(PW + ((size_t)(k * 64 + 16 * ot + fr)) * 64 + 8 * fq), a1 = *(const bf16x8*)(PW + ((size_t)(k * 64 + 16 * ot + fr)) * 64 + 32 + 8 * fq);
                    f32x4 acc = (f32x4){0.f, 0.f, 0.f, 0.f};
                    acc = __builtin_amdgcn_mfma_f32_16x16x32_bf16(a0, b0, acc, 0, 0, 0);
                    acc = __builtin_amdgcn_mfma_f32_16x16x32_bf16(a1, b1, acc, 0, 0, 0);
                    const int o = 64 * k + 16 * ot + 4 * fq, tt = 16 * mt + fr;
                    const f32x4 sc = *(const f32x4*)(a.in[I_POOLSC] + layer * MIXW + o);
                    v2u w; w.x = pk2(acc[0] * sc[0], acc[1] * sc[1]); w.y = pk2(acc[2] * sc[2], acc[3] * sc[3]);
                    *(v2u*)(BR + (size_t)(row0 + tt) * D + o) = w;
                }
            }
        }
        __syncthreads();
    }
    {
        const float* scw = a.in[I_SCW] + (size_t)layer * 3 * MIXW;
#pragma unroll
        for (int it_ = 0; it_ < R * 32 / 512; ++it_) { const int idx = tid + it_ * 512;
            const int tt = idx >> 5, c8 = (idx & 31) * 8, seg = tt / L, t = tt % L;
            float z[3][8];
#pragma unroll
            for (int dj = 0; dj < 3; ++dj) { const int tp = t - 2 + dj;
                int srow = -1;
                if (SAMPLE) { if (tp >= 0) srow = MP + (q0 + seg) * 8 + tp; } else { const int tabs = c * 64 + tp; if (tabs >= 0) srow = s * SEQ + tabs; }
                if (srow >= 0) { float cg[8], hx[8]; unpack8(*(const v4u*)(PMb + (size_t)srow * PMC + 768 + c8), cg); unpack8(*(const v4u*)(PMb + (size_t)srow * PMC + 1024 + c8), hx);
#pragma unroll
                    for (int j = 0; j < 8; ++j) z[dj][j] = cg[j] * hx[j]; }
                else if (SAMPLE) { const float* st = a.in[I_STSC] + ((size_t)(layer * DB + q0 + seg) * 2 + (2 + tp)) * MIXW + c8; const f32x4 x0 = *(const f32x4*)st, x1 = *(const f32x4*)(st + 4);
                    z[dj][0] = x0[0]; z[dj][1] = x0[1]; z[dj][2] = x0[2]; z[dj][3] = x0[3]; z[dj][4] = x1[0]; z[dj][5] = x1[1]; z[dj][6] = x1[2]; z[dj][7] = x1[3]; }
                else {
#pragma unroll
                    for (int j = 0; j < 8; ++j) z[dj][j] = 0.f; } }
            float bg[8], o[8]; unpack8(*(const v4u*)(PMb + (size_t)(row0 + tt) * PMC + 512 + c8), bg);
#pragma unroll
            for (int j = 0; j < 8; ++j) o[j] = bg[j] * (scw[c8 + j] * z[0][j] + scw[MIXW + c8 + j] * z[1][j] + scw[2 * MIXW + c8 + j] * z[2][j]);
            *(v4u*)(BR + (size_t)(row0 + tt) * D + 512 + c8) = pack8(o);
            if (last && t >= L - 2) { float* dst = a.out + (SAMPLE ? O_SCS + ((size_t)(layer * DB + q0 + seg) * 2 + (t - (L - 2))) * MIXW : O_SCP + ((size_t)(layer * NB + s) * 2 + (t - (L - 2))) * MIXW) + c8;
                *(f32x4*)dst = (f32x4){z[2][0], z[2][1], z[2][2], z[2][3]}; *(f32x4*)(dst + 4) = (f32x4){z[2][4], z[2][5], z[2][6], z[2][7]}; }
        }
    }
}

template <int MODE>
__device__ __forceinline__ void ssm_unit(const Args& a, int layer, int uidx, LAS unsigned char* lds, int tid_in, int lane_in, int wave_in) {
    int tid = tid_in; asm volatile("" : "+v"(tid));
    const int lane = tid & 63, wave = __builtin_amdgcn_readfirstlane(tid >> 6);
    const bf16* PMb = (const bf16*)(a.ws + WS_PM); bf16* BR = (bf16*)(a.ws + WS_ACT1);
    const unsigned char* tab = a.ws + WS_TAB + (size_t)layer * TAB_STRIDE;
    const f32x2* LB = (const f32x2*)(tab + TAB_LB); const f32x2* LP = (const f32x2*)(tab + TAB_LP);
    const bf16* BBT = (const bf16*)(tab + TAB_BBT); const bf16* CM = (const bf16*)(tab + TAB_CM);
    f32x2* E = (f32x2*)(a.ws + WS_E);
    const int s = uidx >> 5, c = uidx & 31;
    const int row0 = MODE == 2 ? MP + 64 * uidx : s * SEQ + 64 * c;
    const int fr = lane & 15, fq = lane >> 4;
    LAS float* BU = (LAS float*)(lds + wave * 8448);
    LAS bf16* Zt = (LAS bf16*)(lds + 67584);
    const bf16x8 zf = (bf16x8){0, 0, 0, 0, 0, 0, 0, 0};
    for (int gi = 0; gi < 2; ++gi) {
        const int g = 2 * wave + gi;
        const f32x2 lam = LB[g * 64 + lane]; const float nlam1 = -lam[1];
        float hr = 0.f, hi = 0.f;
        if (MODE == 1) { const f32x2 lp = LP[g * 64 + lane];
            const float nlp1 = -lp[1]; int j = 0;
            for (; j + 4 <= c; j += 4) { f32x2 e4[4];
#pragma unroll
                for (int q = 0; q < 4; ++q) e4[q] = E[((size_t)(s * NCH + j + q) * 16 + g) * 64 + lane];
#pragma unroll
                for (int q = 0; q < 4; ++q) { const float nr = fma_s(lp[0], hr, fma_s(nlp1, hi, e4[q][0])), ni = fma_s(lp[0], hi, fma_s(lp[1], hr, e4[q][1])); hr = nr; hi = ni; } }
            for (; j < c; ++j) { const f32x2 e = E[((size_t)(s * NCH + j) * 16 + g) * 64 + lane]; const float nr = fma_s(lp[0], hr, fma_s(nlp1, hi, e[0])), ni = fma_s(lp[0], hi, fma_s(lp[1], hr, e[1])); hr = nr; hi = ni; } }
        bf16x8 bb[8];
#pragma unroll
        for (int nt = 0; nt < 8; ++nt) bb[nt] = fq < 2 ? *(const bf16x8*)(BBT + ((size_t)(g * 128 + 16 * nt + fr)) * 16 + 8 * fq) : zf;
        bf16x8 cmf[4]; float dsk = 0.f;
        if (MODE >= 1) {
#pragma unroll
            for (int ks = 0; ks < 4; ++ks) cmf[ks] = *(const bf16x8*)(CM + ((size_t)(g * 16 + fr)) * 128 + 32 * ks + 8 * fq);
            dsk = a.in[I_DSKIP][layer * MIXW + 16 * g + fr]; }
        bf16x8 ufa[4];
#pragma unroll
        for (int sub = 0; sub < 4; ++sub) ufa[sub] = fq < 2 ? *(const bf16x8*)(PMb + (size_t)(row0 + 16 * sub + fr) * PMC + 256 + 16 * g + 8 * fq) : zf;
#pragma unroll
        for (int sub = 0; sub < 4; ++sub) {
            const int rowb = row0 + 16 * sub;
            const bf16x8 uf = ufa[sub];
#pragma unroll
            for (int nt = 0; nt < 8; ++nt) { const f32x4 d = __builtin_amdgcn_mfma_f32_16x16x32_bf16(uf, bb[nt], (f32x4){0.f, 0.f, 0.f, 0.f}, 0, 0, 0);
#pragma unroll
                for (int r = 0; r < 4; ++r) BU[(4 * fq + r) * 132 + 16 * nt + fr] = d[r]; }
            asm volatile("s_waitcnt lgkmcnt(0)" ::: "memory");
            {
                float bre_[16], bim_[16];
#pragma unroll
                for (int t = 0; t < 16; ++t) { bre_[t] = BU[t * 132 + lane]; bim_[t] = BU[t * 132 + 64 + lane]; }
                float sre_[2] = {0.f, 0.f}, sim_[2] = {0.f, 0.f};
                if (MODE == 2) {
#pragma unroll
                    for (int hq = 0; hq < 2; ++hq) { const int q = 8 * uidx + 2 * sub + hq; const size_t si = ((size_t)(layer * DB + q) * 16 + g) * 64 + lane; sre_[hq] = a.in[I_STRE][si]; sim_[hq] = a.in[I_STIM][si]; } }
                asm volatile("s_waitcnt lgkmcnt(0)" ::: "memory");
#pragma unroll
                for (int t = 0; t < 16; ++t) {
                    if (MODE == 2 && (t & 7) == 0) { hr = sre_[t >> 3]; hi = sim_[t >> 3]; }
                    const float nr = fma_s(lam[0], hr, fma_s(nlam1, hi, bre_[t])), ni = fma_s(lam[0], hi, fma_s(lam[1], hr, bim_[t])); hr = nr; hi = ni;
                    bre_[t] = hr; bim_[t] = hi;
                    if (MODE == 2 && (t & 7) == 7) { const int q = 8 * uidx + 2 * sub + (t >> 3); const size_t si = ((size_t)(layer * DB + q) * 16 + g) * 64 + lane; a.out[O_SRES + si] = hr; a.out[O_SIMS + si] = hi; }
                }
#pragma unroll
                for (int t = 0; t < 16; ++t) { BU[t * 132 + lane] = bre_[t]; BU[t * 132 + 64 + lane] = bim_[t]; }
            }
            if (MODE >= 1) {
                asm volatile("s_waitcnt lgkmcnt(0)" ::: "memory");
                f32x4 y = (f32x4){0.f, 0.f, 0.f, 0.f};
#pragma unroll
                for (int ks = 0; ks < 4; ++ks) { const f32x4 h0 = *(LAS f32x4*)(BU + fr * 132 + 32 * ks + 8 * fq), h1 = *(LAS f32x4*)(BU + fr * 132 + 32 * ks + 8 * fq + 4);
                    v4u hw; hw.x = pk2(h0[0], h0[1]); hw.y = pk2(h0[2], h0[3]); hw.z = pk2(h1[0], h1[1]); hw.w = pk2(h1[2], h1[3]);
                    y = __builtin_amdgcn_mfma_f32_16x16x32_bf16(__builtin_bit_cast(bf16x8, hw), cmf[ks], y, 0, 0, 0); }
#pragma unroll
                for (int r = 0; r < 4; ++r) { const int t = 4 * fq + r; const float uv = bf1(PMb[(size_t)(rowb + t) * PMC + 256 + 16 * g + fr]);
                    const float z = gelu_tanh(y[r] + dsk * uv);
                    Zt[(16 * sub + t) * 264 + 16 * g + fr] = (bf16)(pk2(z, 0.f) & 0xffffu); }
                asm volatile("s_waitcnt lgkmcnt(0)" ::: "memory");
            }
            if (MODE == 0) { asm volatile("s_waitcnt lgkmcnt(0)" ::: "memory"); }
        }
        if (MODE == 0) E[((size_t)(s * NCH + c) * 16 + g) * 64 + lane] = (f32x2){hr, hi};
        if (MODE == 1 && c == NCH - 1) { const size_t si = ((size_t)(layer * NB + s) * 16 + g) * 64 + lane; a.out[O_SREP + si] = hr; a.out[O_SIMP + si] = hi; }
    }
    if (MODE == 0) __syncthreads();
    if (MODE >= 1) {
        __syncthreads();
        const bf16* WG = (const bf16*)(a.ws + WS_WGLU) + (size_t)layer * MIXW * MIXW;
        f32x4 acc[4][2];
#pragma unroll
        for (int mt = 0; mt < 4; ++mt) { acc[mt][0] = (f32x4){0.f, 0.f, 0.f, 0.f}; acc[mt][1] = (f32x4){0.f, 0.f, 0.f, 0.f}; }
#pragma unroll
        for (int ks = 0; ks < 8; ++ks) {
            const bf16x8 w0 = *(const bf16x8*)(WG + (size_t)(32 * wave + fr) * MIXW + 32 * ks + 8 * fq), w1 = *(const bf16x8*)(WG + (size_t)(32 * wave + 16 + fr) * MIXW + 32 * ks + 8 * fq);
#pragma unroll
            for (int mt = 0; mt < 4; ++mt) { const bf16x8 zb = *(LAS bf16x8*)(Zt + (16 * mt + fr) * 264 + 32 * ks + 8 * fq);
                acc[mt][0] = __builtin_amdgcn_mfma_f32_16x16x32_bf16(w0, zb, acc[mt][0], 0, 0, 0);
                acc[mt][1] = __builtin_amdgcn_mfma_f32_16x16x32_bf16(w1, zb, acc[mt][1], 0, 0, 0); }
        }
#pragma unroll
        for (int nl = 0; nl < 2; ++nl) { const int n0 = 32 * wave + 16 * nl + 4 * fq; const f32x4 bgl = *(const f32x4*)(a.in[I_BGLU] + layer * MIXW + n0);
#pragma unroll
            for (int mt = 0; mt < 4; ++mt) { const int tt = 16 * mt + fr; const v2u zz = *(LAS v2u*)(Zt + tt * 264 + n0);
                const float z0 = bflo(zz.x), z1 = bfhi(zz.x), z2 = bflo(zz.y), z3 = bfhi(zz.y);
                v2u w; w.x = pk2(z0 * sigm(acc[mt][nl][0] + bgl[0]), z1 * sigm(acc[mt][nl][1] + bgl[1])); w.y = pk2(z2 * sigm(acc[mt][nl][2] + bgl[2]), z3 * sigm(acc[mt][nl][3] + bgl[3]));
                *(v2u*)(BR + (size_t)(row0 + tt) * D + 256 + n0) = w; } }
        __syncthreads();
    }
}

__device__ __forceinline__ void gemm2_phase(LAS unsigned char* lds, const bf16* BRp, const bf16* WBT, const bf16* GT, bf16* MG, int G, int bid) {
    using namespace pg8;
    int tid_ = threadIdx.x; asm volatile("" : "+v"(tid_));
    const int tid = tid_, wid = __builtin_amdgcn_readfirstlane(tid >> 6), lane = tid & 63, wr = wid >> 2, wc = wid & 3, fr = lane & 15, fq = lane >> 4;
    unsigned voffA[2], voffB[2];
#pragma unroll
    for (int i = 0; i < 2; ++i) { int R, C; stage_rc(tid * 16 + i * 8192, R, C); const int Rb = (R & ~31) + perm32(R & 31);
        voffA[i] = (unsigned)(R * D + C) * 2u; voffB[i] = (unsigned)(Rb * MIXW + C) * 2u; }
    const unsigned ldsw = (unsigned)wid * 1024u;
    const int aoff = lds_byte(wr * 64 + fr, fq * 8), boff = lds_byte(wc * 32 + fr, fq * 8);
    constexpr int STG = 49152;
#define G2_STAGE(it_, buf_) do { const int kb_ = (it_) >> 2, kt_ = (it_) & 3; \
        const char* as_ = Abase + (size_t)(kb_ * 256 + kt_ * 64) * 2; const char* bs_ = Bbase + (size_t)kb_ * (D * MIXW * 2) + (size_t)kt_ * 128; \
        _Pragma("unroll") for (int _i = 0; _i < 2; ++_i) __builtin_amdgcn_global_load_lds((const unsigned*)(as_ + voffA[_i]), (PG8_LAS unsigned*)(lds + (buf_) * STG + ldsw + _i * 8192), 16, 0, 0); \
        _Pragma("unroll") for (int _i = 0; _i < 2; ++_i) __builtin_amdgcn_global_load_lds((const unsigned*)(bs_ + voffB[_i]), (PG8_LAS unsigned*)(lds + (buf_) * STG + 16384 + ldsw + _i * 8192), 16, 0, 0); \
        _Pragma("unroll") for (int _i = 0; _i < 2; ++_i) __builtin_amdgcn_global_load_lds((const unsigned*)(bs_ + (size_t)128 * MIXW * 2 + voffB[_i]), (PG8_LAS unsigned*)(lds + (buf_) * STG + 32768 + ldsw + _i * 8192), 16, 0, 0); } while (0)
    const int vb = (G % 8 == 0) ? (bid % 8) * (G / 8) + bid / 8 : bid;
    for (int ui = vb; ui < (MP / 128) * 4; ui += G) {
        const int pm = ui >> 2, pn = ui & 3;
        const char* Abase = (const char*)BRp + (size_t)pm * 128 * D * 2;
        const char* Bbase = (const char*)WBT + (size_t)pn * 256 * MIXW * 2;
        f32x4 mg[2][4][2], acc[2][4][2];
#pragma unroll
        for (int b = 0; b < 2; ++b)
#pragma unroll
            for (int m = 0; m < 4; ++m)
#pragma unroll
                for (int n = 0; n < 2; ++n) { mg[b][m][n] = (f32x4){0.f, 0.f, 0.f, 0.f}; acc[b][m][n] = (f32x4){0.f, 0.f, 0.f, 0.f}; }
        v4u gq[2][4];
        G2_STAGE(0, 0);
#pragma unroll 1
        for (int it = 0; it < 16; ++it) {
            const int buf = it & 1;
            if (it + 1 < 16) { G2_STAGE(it + 1, buf ^ 1); asm volatile("s_waitcnt vmcnt(6)" ::: "memory"); } else { asm volatile("s_waitcnt vmcnt(0)" ::: "memory"); }
            __builtin_amdgcn_s_barrier(); asm volatile("" ::: "memory");
#pragma unroll
            for (int kk = 0; kk < 2; ++kk) {
                bf16x8 At[4], B0[2], B1[2];
#pragma unroll
                for (int m = 0; m < 4; ++m) At[m] = *(const PG8_LAS bf16x8*)(lds + buf * STG + aoff + m * 2048 + kk * 1024);
#pragma unroll
                for (int n = 0; n < 2; ++n) { B0[n] = *(const PG8_LAS bf16x8*)(lds + buf * STG + 16384 + boff + n * 2048 + kk * 1024); B1[n] = *(const PG8_LAS bf16x8*)(lds + buf * STG + 32768 + boff + n * 2048 + kk * 1024); }
                asm volatile("s_waitcnt lgkmcnt(0)" ::: "memory"); __builtin_amdgcn_sched_barrier(0);
#pragma unroll
                for (int m = 0; m < 4; ++m)
#pragma unroll
                    for (int n = 0; n < 2; ++n) { acc[0][m][n] = __builtin_amdgcn_mfma_f32_16x16x32_bf16(B0[n], At[m], acc[0][m][n], 0, 0, 0);
                                                  acc[1][m][n] = __builtin_amdgcn_mfma_f32_16x16x32_bf16(B1[n], At[m], acc[1][m][n], 0, 0, 0); }
            }
            if ((it & 3) == 2) {
                const int kb = it >> 2;
#pragma unroll
                for (int b = 0; b < 2; ++b)
#pragma unroll
                    for (int m = 0; m < 4; ++m) asm volatile("global_load_dwordx4 %0, %1, off" : "=v"(gq[b][m]) : "v"(GT + (size_t)(pm * 128 + wr * 64 + m * 16 + fr) * GTC + kb * D + pn * 256 + b * 128 + wc * 32 + 8 * fq) : "memory");
            }
            asm volatile("" ::: "memory"); __builtin_amdgcn_s_barrier(); asm volatile("" ::: "memory");
            if ((it & 3) == 3) {
                asm volatile("" : "+v"(gq[0][0]), "+v"(gq[0][1]), "+v"(gq[0][2]), "+v"(gq[0][3]), "+v"(gq[1][0]), "+v"(gq[1][1]), "+v"(gq[1][2]), "+v"(gq[1][3]));
#pragma unroll
                for (int b = 0; b < 2; ++b)
#pragma unroll
                    for (int m = 0; m < 4; ++m) { float gv[8]; unpack8(gq[b][m], gv);
#pragma unroll
                        for (int j = 0; j < 4; ++j) { mg[b][m][0][j] += gv[j] * acc[b][m][0][j]; mg[b][m][1][j] += gv[4 + j] * acc[b][m][1][j]; }
                        acc[b][m][0] = (f32x4){0.f, 0.f, 0.f, 0.f}; acc[b][m][1] = (f32x4){0.f, 0.f, 0.f, 0.f}; }
            }
        }
#pragma unroll
        for (int b = 0; b < 2; ++b)
#pragma unroll
            for (int m = 0; m < 4; ++m) { const int row = pm * 128 + wr * 64 + m * 16 + fr, col = pn * 256 + b * 128 + wc * 32 + 8 * fq;
                v4u w; w.x = pk2(mg[b][m][0][0], mg[b][m][0][1]); w.y = pk2(mg[b][m][0][2], mg[b][m][0][3]); w.z = pk2(mg[b][m][1][0], mg[b][m][1][1]); w.w = pk2(mg[b][m][1][2], mg[b][m][1][3]);
                *(v4u*)(MG + (size_t)row * D + col) = w; }
    }
#undef G2_STAGE
}


struct CappedOrder : pg8::StaticOrder {
    int cap;
    __device__ bool next(int i, pg8::Unit& u) const { if ((long)i * G + c >= cap) return false; return pg8::StaticOrder::next(i, u); }
};
__device__ __forceinline__ void proj_tail_phase(LAS unsigned char* lds, const bf16* A, const bf16* Bt, int cap, const float* ssq, const float* bgate, bf16* PMp, bf16* GTp, int G, int bid) {
    using namespace pg8;
    int tid_ = threadIdx.x; asm volatile("" : "+v"(tid_));
    const int tid = tid_, wid = __builtin_amdgcn_readfirstlane(tid >> 6), lane = tid & 63, fr = lane & 15, fq = lane >> 4, mt = wid >> 1, nh = wid & 1;
    int R, C; stage_rc(tid * 16, R, C);
    const unsigned voff = (unsigned)(R * D + C) * 2u, ldsw = (unsigned)wid * 1024u;
    const int aoff = lds_byte(mt * 16 + fr, fq * 8), boff = lds_byte(nh * 32 + fr, fq * 8);
    StaticOrder S1; S1.init(M, INC, 1, 0);
    const int nsub = (S1.nwg - cap) * 16;
    for (int t = bid; t < nsub; t += G) {
        Unit u; S1.next(cap + (t >> 4), u);
        const int rb = (t >> 2) & 3, cb = t & 3, r0 = u.pm * 256 + 64 * rb, c0 = u.pn * 256 + 64 * cb;
        const char* Ab = (const char*)A + (size_t)r0 * D * 2; const char* Bb = (const char*)Bt + (size_t)c0 * D * 2;
        f32x4 acc[2] = {(f32x4){0.f, 0.f, 0.f, 0.f}, (f32x4){0.f, 0.f, 0.f, 0.f}};
#define PT_STAGE(kt_, buf_) do { __builtin_amdgcn_global_load_lds((const unsigned*)(Ab + (size_t)(kt_) * 128 + voff), (PG8_LAS unsigned*)(lds + (buf_) * 16384 + ldsw), 16, 0, 0); \
        __builtin_amdgcn_global_load_lds((const unsigned*)(Bb + (size_t)(kt_) * 128 + voff), (PG8_LAS unsigned*)(lds + (buf_) * 16384 + 8192 + ldsw), 16, 0, 0); } while (0)
        PT_STAGE(0, 0);
#pragma unroll 1
        for (int kt = 0; kt < D / 64; ++kt) {
            const int buf = kt & 1;
            if (kt + 1 < D / 64) { PT_STAGE(kt + 1, buf ^ 1); asm volatile("s_waitcnt vmcnt(2)" ::: "memory"); } else { asm volatile("s_waitcnt vmcnt(0)" ::: "memory"); }
            __builtin_amdgcn_s_barrier(); asm volatile("" ::: "memory");
            const bf16x8 a0 = *(const PG8_LAS bf16x8*)(lds + buf * 16384 + aoff), a1 = *(const PG8_LAS bf16x8*)(lds + buf * 16384 + aoff + 1024);
            const bf16x8 b00 = *(const PG8_LAS bf16x8*)(lds + buf * 16384 + 8192 + boff), b01 = *(const PG8_LAS bf16x8*)(lds + buf * 16384 + 8192 + boff + 1024);
            const bf16x8 b10 = *(const PG8_LAS bf16x8*)(lds + buf * 16384 + 8192 + boff + 2048), b11 = *(const PG8_LAS bf16x8*)(lds + buf * 16384 + 8192 + boff + 3072);
            asm volatile("s_waitcnt lgkmcnt(0)" ::: "memory"); __builtin_amdgcn_sched_barrier(0);
            acc[0] = __builtin_amdgcn_mfma_f32_16x16x32_bf16(b00, a0, acc[0], 0, 0, 0); acc[1] = __builtin_amdgcn_mfma_f32_16x16x32_bf16(b10, a0, acc[1], 0, 0, 0);
            acc[0] = __builtin_amdgcn_mfma_f32_16x16x32_bf16(b01, a1, acc[0], 0, 0, 0); acc[1] = __builtin_amdgcn_mfma_f32_16x16x32_bf16(b11, a1, acc[1], 0, 0, 0);
            asm volatile("" ::: "memory"); __builtin_amdgcn_s_barrier(); asm volatile("" ::: "memory");
        }
#undef PT_STAGE
        const int row = r0 + 16 * mt + fr;
        const float rs = pg8::row_rstd(ssq, row);
        const bool isg = u.pn >= 7;
#pragma unroll
        for (int n = 0; n < 2; ++n) { const int col = c0 + 32 * nh + 16 * n + 4 * fq; f32x4 v = acc[n] * rs;
            if (isg) { const f32x4 bv = *(const f32x4*)(bgate + (col - PMC)); v = (f32x4){::sigm(v[0] + bv[0]), ::sigm(v[1] + bv[1]), ::sigm(v[2] + bv[2]), ::sigm(v[3] + bv[3])}; }
            v2u w; w.x = pk2(v[0], v[1]); w.y = pk2(v[2], v[3]);
            if (isg) *(v2u*)(GTp + (size_t)row * GTC + (col - PMC)) = w; else *(v2u*)(PMp + (size_t)row * PMC + col) = w; }
    }
}

__device__ __forceinline__ void gemm2_tail_phase(LAS unsigned char* lds, const bf16* BRp, const bf16* WBT, const bf16* GT, bf16* MG, int G, int bid) {
    using namespace pg8;
    int tid_ = threadIdx.x; asm volatile("" : "+v"(tid_));
    const int tid = tid_, wid = __builtin_amdgcn_readfirstlane(tid >> 6), lane = tid & 63, fr = lane & 15, fq = lane >> 4, mt = wid >> 1, nh = wid & 1;
    int R, C; stage_rc(tid * 16, R, C);
    const unsigned voffA = (unsigned)(R * D + C) * 2u, voffB = (unsigned)(R * MIXW + C) * 2u, ldsw = (unsigned)wid * 1024u;
    const int aoff = lds_byte(mt * 16 + fr, fq * 8), boff = lds_byte(nh * 32 + fr, fq * 8);
    for (int ui = bid; ui < 256; ui += G) {
        const int rb = ui >> 4, cb = ui & 15;
        const char* Ab = (const char*)BRp + (size_t)(MP + 64 * rb) * D * 2; const char* Bb = (const char*)WBT + (size_t)(64 * cb) * MIXW * 2;
        f32x4 acc[2] = {(f32x4){0.f, 0.f, 0.f, 0.f}, (f32x4){0.f, 0.f, 0.f, 0.f}}, mg[2] = {(f32x4){0.f, 0.f, 0.f, 0.f}, (f32x4){0.f, 0.f, 0.f, 0.f}};
        const int row = MP + 64 * rb + 16 * mt + fr;
#define G2T_STAGE(it_, buf_) do { const int kb_ = (it_) >> 2, kt_ = (it_) & 3; \
        __builtin_amdgcn_global_load_lds((const unsigned*)(Ab + (size_t)(kb_ * 256 + kt_ * 64) * 2 + voffA), (PG8_LAS unsigned*)(lds + (buf_) * 16384 + ldsw), 16, 0, 0); \
        __builtin_amdgcn_global_load_lds((const unsigned*)(Bb + (size_t)kb_ * (D * MIXW * 2) + (size_t)kt_ * 128 + voffB), (PG8_LAS unsigned*)(lds + (buf_) * 16384 + 8192 + ldsw), 16, 0, 0); } while (0)
        G2T_STAGE(0, 0);
#pragma unroll 1
        for (int it = 0; it < 16; ++it) {
            const int buf = it & 1;
            if (it + 1 < 16) { G2T_STAGE(it + 1, buf ^ 1); asm volatile("s_waitcnt vmcnt(2)" ::: "memory"); } else { asm volatile("s_waitcnt vmcnt(0)" ::: "memory"); }
            __builtin_amdgcn_s_barrier(); asm volatile("" ::: "memory");
            const bf16x8 a0 = *(const PG8_LAS bf16x8*)(lds + buf * 16384 + aoff), a1 = *(const PG8_LAS bf16x8*)(lds + buf * 16384 + aoff + 1024);
            const bf16x8 b00 = *(const PG8_LAS bf16x8*)(lds + buf * 16384 + 8192 + boff), b01 = *(const PG8_LAS bf16x8*)(lds + buf * 16384 + 8192 + boff + 1024);
            const bf16x8 b10 = *(const PG8_LAS bf16x8*)(lds + buf * 16384 + 8192 + boff + 2048), b11 = *(const PG8_LAS bf16x8*)(lds + buf * 16384 + 8192 + boff + 3072);
            asm volatile("s_waitcnt lgkmcnt(0)" ::: "memory"); __builtin_amdgcn_sched_barrier(0);
            acc[0] = __builtin_amdgcn_mfma_f32_16x16x32_bf16(b00, a0, acc[0], 0, 0, 0); acc[1] = __builtin_amdgcn_mfma_f32_16x16x32_bf16(b10, a0, acc[1], 0, 0, 0);
            acc[0] = __builtin_amdgcn_mfma_f32_16x16x32_bf16(b01, a1, acc[0], 0, 0, 0); acc[1] = __builtin_amdgcn_mfma_f32_16x16x32_bf16(b11, a1, acc[1], 0, 0, 0);
            asm volatile("" ::: "memory"); __builtin_amdgcn_s_barrier(); asm volatile("" ::: "memory");
            if ((it & 3) == 3) {
                const int kb = it >> 2;
#pragma unroll
                for (int n = 0; n < 2; ++n) { const v2u gw = *(const v2u*)(GT + (size_t)row * GTC + kb * D + 64 * cb + 32 * nh + 16 * n + 4 * fq);
                    mg[n][0] += bflo(gw.x) * acc[n][0]; mg[n][1] += bfhi(gw.x) * acc[n][1]; mg[n][2] += bflo(gw.y) * acc[n][2]; mg[n][3] += bfhi(gw.y) * acc[n][3];
                    acc[n] = (f32x4){0.f, 0.f, 0.f, 0.f}; }
            }
        }
#undef G2T_STAGE
#pragma unroll
        for (int n = 0; n < 2; ++n) { v2u w; w.x = pk2(mg[n][0], mg[n][1]); w.y = pk2(mg[n][2], mg[n][3]); *(v2u*)(MG + (size_t)row * D + 64 * cb + 32 * nh + 16 * n + 4 * fq) = w; }
    }
}

__device__ __forceinline__ void resid_tail_phase(LAS unsigned char* lds, const bf16* A, const bf16* Bt, int K, const float* xs_old, float* xo, bf16* XBp, float* ssq, int G, int bid) {
    using namespace pg8;
    int tid_ = threadIdx.x; asm volatile("" : "+v"(tid_));
    const int tid = tid_, wid = __builtin_amdgcn_readfirstlane(tid >> 6), lane = tid & 63, fr = lane & 15, fq = lane >> 4, mt = wid >> 1, nh = wid & 1;
    int R, C; stage_rc(tid * 16, R, C);
    const unsigned voff = (unsigned)(R * K + C) * 2u, ldsw = (unsigned)wid * 1024u;
    const int aoff = lds_byte(mt * 16 + fr, fq * 8), boff = lds_byte(nh * 32 + fr, fq * 8);
    const int nk = K / 64;
    for (int ui = bid; ui < 256; ui += G) {
        const int rb = ui >> 4, cb = ui & 15;
        const char* Ab = (const char*)A + (size_t)(MP + 64 * rb) * K * 2; const char* Bb = (const char*)Bt + (size_t)(64 * cb) * K * 2;
        f32x4 acc[2] = {(f32x4){0.f, 0.f, 0.f, 0.f}, (f32x4){0.f, 0.f, 0.f, 0.f}};
#define RT_STAGE(kt_, buf_) do { __builtin_amdgcn_global_load_lds((const unsigned*)(Ab + (size_t)(kt_) * 128 + voff), (PG8_LAS unsigned*)(lds + (buf_) * 16384 + ldsw), 16, 0, 0); \
        __builtin_amdgcn_global_load_lds((const unsigned*)(Bb + (size_t)(kt_) * 128 + voff), (PG8_LAS unsigned*)(lds + (buf_) * 16384 + 8192 + ldsw), 16, 0, 0); } while (0)
        RT_STAGE(0, 0);
        for (int kt = 0; kt < nk; ++kt) {
            const int buf = kt & 1;
            if (kt + 1 < nk) { RT_STAGE(kt + 1, buf ^ 1); asm volatile("s_waitcnt vmcnt(2)" ::: "memory"); } else { asm volatile("s_waitcnt vmcnt(0)" ::: "memory"); }
            __builtin_amdgcn_s_barrier(); asm volatile("" ::: "memory");
            const bf16x8 a0 = *(const PG8_LAS bf16x8*)(lds + buf * 16384 + aoff), a1 = *(const PG8_LAS bf16x8*)(lds + buf * 16384 + aoff + 1024);
            const bf16x8 b00 = *(const PG8_LAS bf16x8*)(lds + buf * 16384 + 8192 + boff), b01 = *(const PG8_LAS bf16x8*)(lds + buf * 16384 + 8192 + boff + 1024);
            const bf16x8 b10 = *(const PG8_LAS bf16x8*)(lds + buf * 16384 + 8192 + boff + 2048), b11 = *(const PG8_LAS bf16x8*)(lds + buf * 16384 + 8192 + boff + 3072);
            asm volatile("s_waitcnt lgkmcnt(0)" ::: "memory"); __builtin_amdgcn_sched_barrier(0);
            acc[0] = __builtin_amdgcn_mfma_f32_16x16x32_bf16(b00, a0, acc[0], 0, 0, 0); acc[1] = __builtin_amdgcn_mfma_f32_16x16x32_bf16(b10, a0, acc[1], 0, 0, 0);
            acc[0] = __builtin_amdgcn_mfma_f32_16x16x32_bf16(b01, a1, acc[0], 0, 0, 0); acc[1] = __builtin_amdgcn_mfma_f32_16x16x32_bf16(b11, a1, acc[1], 0, 0, 0);
            asm volatile("" ::: "memory"); __builtin_amdgcn_s_barrier(); asm volatile("" ::: "memory");
        }
#undef RT_STAGE
        const int rowl = 16 * mt + fr, row = MP + 64 * rb + rowl; float ss = 0.f;
#pragma unroll
        for (int n = 0; n < 2; ++n) { const int col = 64 * cb + 32 * nh + 16 * n + 4 * fq;
            const f32x4 o = *(const f32x4*)(xs_old + (size_t)(row - MP) * D + col) + acc[n];
            *(f32x4*)(xo + (size_t)row * D + col) = o;
            v2u w; w.x = pk2(o[0], o[1]); w.y = pk2(o[2], o[3]); *(v2u*)(XBp + (size_t)row * D + col) = w;
            ss += (o[0] * o[0] + o[1] * o[1]) + (o[2] * o[2] + o[3] * o[3]); }
        ss += __shfl_xor(ss, 16); ss += __shfl_xor(ss, 32);
        LAS float* red = (LAS float*)lds;
        if (fq == 0) red[rowl * 2 + nh] = ss;
        __syncthreads();
        if (tid < 64) ssq[((size_t)(cb >> 2) * M + MP + 64 * rb + tid) * 4 + (cb & 3)] = red[tid * 2] + red[tid * 2 + 1];
        __syncthreads();
    }
}

__global__ void __launch_bounds__(NWAVES * 64, 2) hybrid_fwd(Args args) {
    extern __shared__ __attribute__((aligned(16))) unsigned char lds_raw[];
    LAS unsigned char* lds = (LAS unsigned char*)lds_raw;
    volatile LAS unsigned* MISC = (volatile LAS unsigned*)(lds + MISC_OFF);
    const int tid0 = threadIdx.x;
    const int G = gridDim.x, bid = blockIdx.x;
    unsigned char* ws = args.ws;
    for (int u = tid0; u < (LDS_BYTES - LDSCTL_OFF) / 4; u += NWAVES * 64) ((LAS unsigned*)(lds + LDSCTL_OFF))[u] = 0u;
    __syncthreads();
    const int lo = args.ph_lo, hi = args.ph_hi;
    XcdBarrier bar; bar.bar = (unsigned*)(ws + WS_CTL) + CW_BAR; bar.x = 0; bar.st = nullptr;
    if (hi - lo > 1) bar = xcd_barrier_post((unsigned*)(ws + WS_CTL) + CW_BAR, MISC + 8);
    bf16* XB = (bf16*)(ws + WS_ACT1); bf16* PMb = (bf16*)(ws + WS_PM); bf16* GTb = (bf16*)(ws + WS_GT);
    bf16* MGb = (bf16*)(ws + WS_PM); bf16* ACTb = (bf16*)(ws + WS_GT);
    float* ssq = (float*)(ws + WS_SSQ);
    for (int ph_i = lo; ph_i < hi; ++ph_i) {
        int ph = ph_i; asm volatile("" : "+s"(ph));
        int tid = tid0; asm volatile("" : "+v"(tid)); const int lane = tid & 63, wave = __builtin_amdgcn_readfirstlane(tid >> 6);
        const int layer = (ph - 1) / 7, k = ph == 0 ? -1 : (ph == NPHASE - 1 ? 7 : (ph - 1) % 7);
        if (k == -1) p0_prologue(args, lds, tid, lane, wave, G, bid);
        else if (k == 7) final_norm(args, lane, wave, G, bid);
        else if (k == 0) {
            pg8::Gemm g{XB, (const bf16*)(ws + WS_WIN) + (size_t)layer * INC * D, M, INC, D}; CappedOrder S; S.init(M, INC, G, bid); S.cap = (S.nwg / G) * G;
            pg8::EpiProj E{PMb, GTb, ssq, args.in[I_BGATE] + (size_t)layer * GTC};
            pg8::gemm_phase<pg8::EpiProj, CappedOrder, true, true>(lds + RING_OFF, g, S, E);
            proj_tail_phase(lds + RING_OFF, XB, (const bf16*)(ws + WS_WIN) + (size_t)layer * INC * D, S.cap, ssq, args.in[I_BGATE] + (size_t)layer * GTC, PMb, GTb, G, bid);
        } else if (k == 1) {
            for (int u = bid; u < 256 + 16 + 256 + 64; u += G) {
                if (u < 256) { if ((u & 31) != NCH - 1) ssm_unit<0>(args, layer, u, lds, tid, lane, wave); }
                else if (u < 272) ssm_unit<2>(args, layer, u - 256, lds, tid, lane, wave);
                else if (u < 528) mix_unit<false>(args, layer, u - 272, lds, tid, lane, wave);
                else mix_unit<true>(args, layer, u - 528, lds, tid, lane, wave);
            }
        } else if (k == 2) {
            for (int u = bid; u < 256; u += G) ssm_unit<1>(args, layer, u, lds, tid, lane, wave);
        } else if (k == 3) {
            gemm2_phase(lds + RING_OFF, XB, (const bf16*)(ws + WS_WBR) + (size_t)layer * 4 * D * MIXW, GTb, MGb, G, bid);
            gemm2_tail_phase(lds + RING_OFF, XB, (const bf16*)(ws + WS_WBR) + (size_t)layer * 4 * D * MIXW, GTb, MGb, G, bid);
        } else if (k == 5) {
            pg8::Gemm g{XB, (const bf16*)(ws + WS_WFI) + (size_t)layer * 2 * FF * D, M, 2 * FF, D}; pg8::StaticOrder S; S.init(M, 2 * FF, G, bid);
            pg8::EpiSwiGLU E{ACTb, ssq};
            pg8::gemm_phase<pg8::EpiSwiGLU, pg8::StaticOrder, true, true>(lds + RING_OFF, g, S, E);
        } else {
            const bool isE = k == 4; const int K = isE ? D : FF;
            const bf16* Ap = isE ? MGb : ACTb; const bf16* Bp = isE ? (const bf16*)(ws + WS_WOUT) + (size_t)layer * D * D : (const bf16*)(ws + WS_WFO) + (size_t)layer * D * FF;
            const bool first = isE && layer == 0;
            const float* xp = first ? args.in[I_XP] : args.out; const float* xs = first ? args.in[I_XS] : args.out + (size_t)MP * D;
            pg8::Gemm g{Ap, Bp, MP, D, K}; pg8::StaticOrder S; S.init(MP, D, G, bid);
            pg8::EpiResid E{xp, xs, args.out, XB, ssq};
            pg8::gemm_phase<pg8::EpiResid, pg8::StaticOrder, true, true>(lds + RING_OFF, g, S, E);
            resid_tail_phase(lds + RING_OFF, Ap, Bp, K, xs, args.out, XB, ssq, G, bid);
        }
        if (ph_i + 1 < hi) xcd_barrier(bar);
    }
}

extern "C" void kernel_launch(void* const* d_in, const int* in_sizes, int n_in, void* d_out, int out_size, void* d_ws, size_t ws_size, hipStream_t stream) {
    static int grid = 0;
    if (grid == 0) {
        if (n_in != 32 || out_size != (int)O_END || ws_size < WS_END) { fprintf(stderr, "kernel_launch: expected 32 inputs, %zu outputs, >= %zu bytes of workspace; got %d, %d, %zu; nothing launched\n", (size_t)O_END, (size_t)WS_END, n_in, out_size, ws_size); grid = -1; return; }
        int dev = 0, cus = 0, per_cu = 0;
        if (hipGetDevice(&dev) != hipSuccess || hipDeviceGetAttribute(&cus, hipDeviceAttributeMultiprocessorCount, dev) != hipSuccess) { grid = -1; return; }
        if (hipFuncSetAttribute((const void*)hybrid_fwd, hipFuncAttributeMaxDynamicSharedMemorySize, LDS_BYTES) != hipSuccess) { fprintf(stderr, "kernel_launch: hipFuncSetAttribute failed\n"); grid = -1; return; }
        if (hipOccupancyMaxActiveBlocksPerMultiprocessor(&per_cu, (const void*)hybrid_fwd, NWAVES * 64, LDS_BYTES) != hipSuccess || per_cu < 1) { fprintf(stderr, "kernel_launch: occupancy query says %d blocks per CU; nothing launched\n", per_cu); (void)hipGetLastError(); grid = -1; return; }
        grid = cus;
    }
    if (grid < 0) return;
    (void)hipMemsetAsync((char*)d_ws + WS_CTL, 0, CTL_ZERO_BYTES, stream);
    Args a{};
    for (int i = 0; i < 32; ++i) a.in[i] = (const float*)d_in[i];
    a.out = (float*)d_out; a.ws = (unsigned char*)d_ws;
#if MK_PER_PHASE
    for (int k = 0; k < NPHASE; ++k) { a.ph_lo = k; a.ph_hi = k + 1; hipLaunchKernelGGL(hybrid_fwd, dim3(grid), dim3(NWAVES * 64), LDS_BYTES, stream, a); }
#else
    a.ph_lo = 0; a.ph_hi = NPHASE;
    hipLaunchKernelGGL(hybrid_fwd, dim3(grid), dim3(NWAVES * 64), LDS_BYTES, stream, a);
#endif
}
```

```cpp
#include <hip/hip_runtime.h>
#include <cstdio>
#include <cstdint>
namespace pg8 {
#define PG8_LAS __attribute__((address_space(3)))
typedef unsigned short bf16_t;
typedef short bf16x8 __attribute__((ext_vector_type(8)));
typedef float f32x4 __attribute__((ext_vector_type(4)));
typedef unsigned u32x4 __attribute__((ext_vector_type(4)));
constexpr int BM = 256, BK = 64, HALF = 128, HTB = HALF * BK * 2  , STAGE_BYTES = 8 * HTB, NXCD = 8, WGM = 8;

__host__ __device__ __forceinline__ int lds_byte(int r, int c) { const int st = (r >> 4) * 2 + (c >> 5), rr = r & 15, cc = c & 31, ob = rr * 64 + cc * 2; return st * 1024 + (ob ^ (((ob >> 9) & 1) << 5)); }
__host__ __device__ __forceinline__ void stage_rc(int b, int& R, int& C) { const int st = b / 1024, sb = b % 1024, swz = sb ^ (((sb >> 9) & 1) << 5); R = (st >> 1) * 16 + swz / 64; C = (st & 1) * 32 + (swz % 64) / 2; }
__host__ __device__ __forceinline__ int perm32(int rho) { const int n = rho >> 4, i = rho & 15; return 8 * (i >> 2) + 4 * n + (i & 3); }

struct Unit { int pm, pn; };
struct Gemm { const bf16_t* A; const bf16_t* Bt; int M, N, K; };

struct StaticOrder {
    int nM, nN, nwg, G, c;
    __host__ __device__ void init(int M, int N, int G_, int c_) { nM = M / BM; nN = N / BM; nwg = nM * nN; G = G_; c = c_; }
    __host__ __device__ bool next(int i, Unit& u) const {
        const long L = (long)i * G + c; if (L >= nwg) return false;
        int wgid = (int)L; { const int q = nwg / NXCD, r = nwg % NXCD, xcd = wgid % NXCD, off = wgid / NXCD; wgid = (xcd < r ? xcd * (q + 1) : r * (q + 1) + (xcd - r) * q) + off; }
        const int nig = WGM * nN, gid = wgid / nig, fm = gid * WGM, gsz = (nM - fm) < WGM ? (nM - fm) : WGM;
        u.pm = fm + ((wgid % nig) % gsz); u.pn = (wgid % nig) / gsz; return true;
    }
    __device__ __forceinline__ void a_ready(const Unit&) const {}
    __device__ __forceinline__ void done(const Unit&) const {}
};
typedef float f32x2 __attribute__((ext_vector_type(2)));
typedef __bf16 bf16x2_t __attribute__((ext_vector_type(2)));
__device__ __forceinline__ unsigned cvt_pk_bf16(float lo, float hi) { f32x2 v = {lo, hi}; bf16x2_t b = __builtin_convertvector(v, bf16x2_t); return __builtin_bit_cast(unsigned, b); }
__device__ __forceinline__ float sigm(float x) { return __builtin_amdgcn_rcpf(1.0f + __builtin_amdgcn_exp2f(-1.4426950408889634f * x)); }
__device__ __forceinline__ float row_rstd(const float* ssq, int row) {
    const f32x4 a = *(const f32x4*)(ssq + ((size_t)0 * 17408 + row) * 4), b = *(const f32x4*)(ssq + ((size_t)1 * 17408 + row) * 4),
                c = *(const f32x4*)(ssq + ((size_t)2 * 17408 + row) * 4), d = *(const f32x4*)(ssq + ((size_t)3 * 17408 + row) * 4);
    const float s = (((a[0] + a[1]) + (a[2] + a[3])) + ((b[0] + b[1]) + (b[2] + b[3]))) + (((c[0] + c[1]) + (c[2] + c[3])) + ((d[0] + d[1]) + (d[2] + d[3])));
    return __builtin_amdgcn_rsqf(s * (1.0f / 1024.0f) + 1e-6f);
}
__device__ __forceinline__ void rows_rstd(const float* ssq, int row0, int fq, float (&rs)[2][4]) {
#pragma unroll
    for (int ai = 0; ai < 2; ++ai)
#pragma unroll
        for (int m = 0; m < 4; ++m) { const f32x4 p = *(const f32x4*)(ssq + ((size_t)fq * 17408 + row0 + ai * HALF + m * 16) * 4); rs[ai][m] = (p[0] + p[1]) + (p[2] + p[3]); }
#pragma unroll
    for (int ai = 0; ai < 2; ++ai)
#pragma unroll
        for (int m = 0; m < 4; ++m) { float s = rs[ai][m]; s += __shfl_xor(s, 16); s += __shfl_xor(s, 32); rs[ai][m] = __builtin_amdgcn_rsqf(s * (1.0f / 1024.0f) + 1e-6f); }
}
struct EpiNull {
    static constexpr bool PERM = true, AFTER_DRAIN = false;
    __device__ __forceinline__ void operator()(const f32x4 (&acc)[2][2][4][2], const Unit& u, int wr, int wc, int fr, int fq) const {
#pragma unroll
        for (int ai = 0; ai < 2; ++ai)
#pragma unroll
            for (int bj = 0; bj < 2; ++bj)
#pragma unroll
                for (int m = 0; m < 4; ++m) { asm volatile("" :: "v"(acc[ai][bj][m][0]), "v"(acc[ai][bj][m][1])); }
    }
};
struct EpiProj {
    static constexpr bool PERM = true, AFTER_DRAIN = false;
    bf16_t* PM; bf16_t* GT; const float* ssq; const float* bgate;
    __device__ __forceinline__ void operator()(const f32x4 (&acc)[2][2][4][2], const Unit& u, int wr, int wc, int fr, int fq) const {
        const int row0 = u.pm * BM + wr * 64 + fr;
        const bool isg = u.pn >= 7;
        const int lc0 = (isg ? (u.pn - 7) * BM : u.pn * BM) + wc * 32 + 8 * fq;
        bf16_t* base = isg ? GT : PM; const int ldc = isg ? 4096 : 1792;
        f32x4 bv[2][2];
#pragma unroll
        for (int bj = 0; bj < 2; ++bj)
#pragma unroll
            for (int n = 0; n < 2; ++n) bv[bj][n] = isg ? *(const f32x4*)(bgate + lc0 + bj * HALF + 4 * n) : (f32x4){0.f, 0.f, 0.f, 0.f};
        float rsv[2][4]; rows_rstd(ssq, row0, fq, rsv);
#pragma unroll
        for (int ai = 0; ai < 2; ++ai)
#pragma unroll
            for (int m = 0; m < 4; ++m) { const int row = row0 + ai * HALF + m * 16;
                const float rs = rsv[ai][m];
                bf16_t* rowp = base + (size_t)row * ldc + lc0;
#pragma unroll
                for (int bj = 0; bj < 2; ++bj) { f32x4 v0 = acc[ai][bj][m][0] * rs + bv[bj][0], v1 = acc[ai][bj][m][1] * rs + bv[bj][1];
                    if (isg) { v0 = (f32x4){sigm(v0[0]), sigm(v0[1]), sigm(v0[2]), sigm(v0[3])}; v1 = (f32x4){sigm(v1[0]), sigm(v1[1]), sigm(v1[2]), sigm(v1[3])}; }
                    u32x4 w; w.x = cvt_pk_bf16(v0[0], v0[1]); w.y = cvt_pk_bf16(v0[2], v0[3]); w.z = cvt_pk_bf16(v1[0], v1[1]); w.w = cvt_pk_bf16(v1[2], v1[3]);
                    *(u32x4*)(rowp + bj * HALF) = w; } }
    }
};
struct EpiResid {
    static constexpr bool PERM = true, AFTER_DRAIN = false;
    const float* xp; const float* xs; float* xo; bf16_t* XB; float* ssq;
    __device__ __forceinline__ void operator()(const f32x4 (&acc)[2][2][4][2], const Unit& u, int wr, int wc, int fr, int fq) const {
        const int row0 = u.pm * BM + wr * 64 + fr, col0 = u.pn * BM + wc * 32 + 8 * fq;
#pragma unroll
        for (int ai = 0; ai < 2; ++ai)
#pragma unroll
            for (int m = 0; m < 4; ++m) { const int row = row0 + ai * HALF + m * 16;
                const float* src = (row < 16384 ? xp + (size_t)row * 1024 : xs + (size_t)(row - 16384) * 1024) + col0;
                float* dst = xo + (size_t)row * 1024 + col0; bf16_t* dstb = XB + (size_t)row * 1024 + col0; float ss = 0.f;
#pragma unroll
                for (int bj = 0; bj < 2; ++bj) { const f32x4 o0 = *(const f32x4*)(src + bj * HALF) + acc[ai][bj][m][0], o1 = *(const f32x4*)(src + bj * HALF + 4) + acc[ai][bj][m][1];
                    *(f32x4*)(dst + bj * HALF) = o0; *(f32x4*)(dst + bj * HALF + 4) = o1;
                    u32x4 w; w.x = cvt_pk_bf16(o0[0], o0[1]); w.y = cvt_pk_bf16(o0[2], o0[3]); w.z = cvt_pk_bf16(o1[0], o1[1]); w.w = cvt_pk_bf16(o1[2], o1[3]);
                    *(u32x4*)(dstb + bj * HALF) = w;
                    ss += ((o0[0] * o0[0] + o0[1] * o0[1]) + (o0[2] * o0[2] + o0[3] * o0[3])) + ((o1[0] * o1[0] + o1[1] * o1[1]) + (o1[2] * o1[2] + o1[3] * o1[3])); }
                ss += __shfl_xor(ss, 16); ss += __shfl_xor(ss, 32);
                if (fq == 0) ssq[((size_t)u.pn * 17408 + row) * 4 + wc] = ss; }
    }
};
struct EpiSwiGLU {
    static constexpr bool PERM = true, AFTER_DRAIN = false;
    bf16_t* ACT; const float* ssq;
    __device__ __forceinline__ void operator()(const f32x4 (&acc)[2][2][4][2], const Unit& u, int wr, int wc, int fr, int fq) const {
        const int row0 = u.pm * BM + wr * 64 + fr, col0 = u.pn * HALF + wc * 32 + 8 * fq;
        float rsv[2][4]; rows_rstd(ssq, row0, fq, rsv);
#pragma unroll
        for (int ai = 0; ai < 2; ++ai)
#pragma unroll
            for (int m = 0; m < 4; ++m) { const int row = row0 + ai * HALF + m * 16;
                const float rs = rsv[ai][m];
                const f32x4 g0 = acc[ai][0][m][0] * rs, g1 = acc[ai][0][m][1] * rs, u0 = acc[ai][1][m][0] * rs, u1 = acc[ai][1][m][1] * rs;
                float o[8];
#pragma unroll
                for (int j = 0; j < 4; ++j) { o[j] = g0[j] * sigm(g0[j]) * u0[j]; o[4 + j] = g1[j] * sigm(g1[j]) * u1[j]; }
                u32x4 w; w.x = cvt_pk_bf16(o[0], o[1]); w.y = cvt_pk_bf16(o[2], o[3]); w.z = cvt_pk_bf16(o[4], o[5]); w.w = cvt_pk_bf16(o[6], o[7]);
                *(u32x4*)(ACT + (size_t)row * 2816 + col0) = w; }
    }
};

template <class Epi, class Sched, bool ALIGN_EPI = false, bool SP2 = false>
__device__ __forceinline__ void gemm_phase(PG8_LAS unsigned char* lds, const Gemm g, const Sched& S, const Epi& E) {
    int tid_ = threadIdx.x; asm volatile("" : "+v"(tid_));
    const int tid = tid_, wid = __builtin_amdgcn_readfirstlane(tid >> 6), lane = tid & 63, wr = wid >> 2, wc = wid & 3, fr = lane & 15, fq = lane >> 4;
    const int K = g.K, nt = K / BK;
    unsigned voffA[2], voffB[2];
#pragma unroll
    for (int i = 0; i < 2; ++i) { int R, C; stage_rc(tid * 16 + i * 8192, R, C); const int Rb = Epi::PERM ? ((R & ~31) + perm32(R & 31)) : R;
        voffA[i] = (unsigned)(R * K + C) * 2u; voffB[i] = (unsigned)(Rb * K + C) * 2u; }
    const size_t kstep = (size_t)(BK * 2);
    const size_t hstep = (size_t)HALF * K * 2;
    const size_t tstep = 2 * hstep;
    const unsigned ldsw = (unsigned)wid * 1024u;
    const int aoff = lds_byte(wr * 64 + fr, fq * 8), boff = lds_byte(wc * 32 + fr, fq * 8);
#define PG8_SA(b, h) (((b) * 2 + (h)) * HTB)
#define PG8_SB(b, h) ((4 + (b) * 2 + (h)) * HTB)
#define PG8_STAGE(bufoff, gbase, voff) do { _Pragma("unroll") for (int _i = 0; _i < 2; ++_i) \
        __builtin_amdgcn_global_load_lds((const unsigned*)((const char*)(gbase) + (voff)[_i]), (PG8_LAS unsigned*)(lds + (bufoff) + ldsw + _i * 8192), 16, 0, 0); } while (0)
#define PG8_LDA(dst, b, h) do { _Pragma("unroll") for (int m = 0; m < 4; ++m) _Pragma("unroll") for (int k = 0; k < 2; ++k) dst[m][k] = *(const PG8_LAS bf16x8*)(lds + PG8_SA(b, h) + aoff + m * 2048 + k * 1024); } while (0)
#define PG8_LDB(dst, b, h) do { _Pragma("unroll") for (int n = 0; n < 2; ++n) _Pragma("unroll") for (int k = 0; k < 2; ++k) dst[n][k] = *(const PG8_LAS bf16x8*)(lds + PG8_SB(b, h) + boff + n * 2048 + k * 1024); } while (0)
#define PG8_MMA(ai, bj, At, Bt) do { __builtin_amdgcn_s_setprio(1); _Pragma("unroll") for (int m = 0; m < 4; ++m) _Pragma("unroll") for (int n = 0; n < 2; ++n) _Pragma("unroll") for (int k = 0; k < 2; ++k) \
        acc[ai][bj][m][n] = __builtin_amdgcn_mfma_f32_16x16x32_bf16(Bt[n][k], At[m][k], acc[ai][bj][m][n], 0, 0, 0); __builtin_amdgcn_s_setprio(0); } while (0)
#define PG8_WAIT_V(n) asm volatile("s_waitcnt vmcnt(" #n ")" ::: "memory")
#define PG8_WAIT_L(n) asm volatile("s_waitcnt lgkmcnt(" #n ")" ::: "memory")
#define PG8_BAR __builtin_amdgcn_s_barrier()
#define PG8_SCHED __builtin_amdgcn_sched_barrier(0)
    Unit cur, nxt; int ui = 0;
    if (!S.next(0, cur)) return;
    f32x4 acc[2][2][4][2];
#pragma unroll
    for (int a = 0; a < 2; ++a)
#pragma unroll
        for (int b = 0; b < 2; ++b)
#pragma unroll
            for (int m = 0; m < 4; ++m)
#pragma unroll
                for (int n = 0; n < 2; ++n) acc[a][b][m][n] = (f32x4){0.f, 0.f, 0.f, 0.f};
    bf16x8 At[4][2], B0[2][2], B1[2][2];
    const char* cA = (const char*)g.A + (size_t)cur.pm * tstep; const char* cB = (const char*)g.Bt + (size_t)cur.pn * tstep;
    S.a_ready(cur);
    if constexpr (SP2) {
        PG8_STAGE(PG8_SB(0, 0), cB, voffB); PG8_STAGE(PG8_SB(0, 1), cB + hstep, voffB); PG8_STAGE(PG8_SA(0, 0), cA, voffA); PG8_STAGE(PG8_SA(0, 1), cA + hstep, voffA);
        if (wr == 1) PG8_BAR;
        PG8_WAIT_V(2); PG8_BAR;
        PG8_STAGE(PG8_SB(1, 0), cB + kstep, voffB); PG8_STAGE(PG8_SA(1, 0), cA + kstep, voffA); PG8_STAGE(PG8_SB(1, 1), cB + hstep + kstep, voffB);
        PG8_WAIT_V(6); PG8_BAR;
    } else {
        PG8_STAGE(PG8_SB(0, 0), cB, voffB); PG8_STAGE(PG8_SA(0, 0), cA, voffA); PG8_STAGE(PG8_SB(0, 1), cB + hstep, voffB); PG8_STAGE(PG8_SA(0, 1), cA + hstep, voffA);
        if (wr == 1) PG8_BAR;
        PG8_WAIT_V(4); PG8_BAR;
        PG8_STAGE(PG8_SB(1, 0), cB + kstep, voffB); PG8_STAGE(PG8_SA(1, 0), cA + kstep, voffA); PG8_STAGE(PG8_SB(1, 1), cB + hstep + kstep, voffB);
        PG8_WAIT_V(6); PG8_BAR;
    }
    for (;;) {
        const bool has_next = S.next(ui + 1, nxt);
        const char* nA = has_next ? (const char*)g.A + (size_t)nxt.pm * tstep : cA; const char* nB = has_next ? (const char*)g.Bt + (size_t)nxt.pn * tstep : cB;
        for (int t = 0; t < nt; t += 2) {
            const bool last = (t == nt - 2);
            const char* a1 = cA + (size_t)(t + 1) * kstep;
            const char* a2 = last ? nA : cA + (size_t)(t + 2) * kstep; const char* b2 = last ? nB : cB + (size_t)(t + 2) * kstep;
            const char* a3 = a2 + kstep; const char* b3 = b2 + kstep;
            if (last && has_next) S.a_ready(nxt);
            if constexpr (SP2) {
            PG8_LDB(B0, 0, 0); PG8_LDB(B1, 0, 1); PG8_SCHED; PG8_LDA(At, 0, 0); PG8_STAGE(PG8_SA(1, 1), a1 + hstep, voffA);
            PG8_WAIT_V(8); PG8_WAIT_L(0); PG8_BAR; PG8_MMA(0, 0, At, B0); PG8_MMA(0, 1, At, B1); PG8_BAR; PG8_SCHED;
            PG8_LDA(At, 0, 1); PG8_STAGE(PG8_SB(0, 0), b2, voffB); PG8_STAGE(PG8_SB(0, 1), b2 + hstep, voffB); PG8_STAGE(PG8_SA(0, 0), a2, voffA);
            PG8_WAIT_V(8); PG8_WAIT_L(0); PG8_BAR; PG8_MMA(1, 0, At, B0); PG8_MMA(1, 1, At, B1); PG8_BAR; PG8_SCHED;
            PG8_LDB(B0, 1, 0); PG8_LDB(B1, 1, 1); PG8_SCHED; PG8_LDA(At, 1, 0); PG8_STAGE(PG8_SA(0, 1), a2 + hstep, voffA);
            PG8_WAIT_V(8); PG8_WAIT_L(0); PG8_BAR; PG8_MMA(0, 0, At, B0); PG8_MMA(0, 1, At, B1); PG8_BAR; PG8_SCHED;
            PG8_LDA(At, 1, 1); PG8_STAGE(PG8_SB(1, 0), b3, voffB); PG8_STAGE(PG8_SB(1, 1), b3 + hstep, voffB); PG8_STAGE(PG8_SA(1, 0), a3, voffA);
            PG8_WAIT_V(8); PG8_WAIT_L(0); PG8_BAR; PG8_MMA(1, 0, At, B0); PG8_MMA(1, 1, At, B1); PG8_BAR; PG8_SCHED;
            } else {
            PG8_LDB(B0, 0, 0); PG8_SCHED; PG8_LDA(At, 0, 0); PG8_STAGE(PG8_SA(1, 1), a1 + hstep, voffA);
            PG8_WAIT_L(8); PG8_BAR; PG8_WAIT_L(0); PG8_MMA(0, 0, At, B0); PG8_BAR; PG8_SCHED;
            PG8_LDB(B1, 0, 1); PG8_STAGE(PG8_SB(0, 0), b2, voffB);
            PG8_BAR; PG8_WAIT_L(0); PG8_MMA(0, 1, At, B1); PG8_BAR;
            PG8_LDA(At, 0, 1); PG8_STAGE(PG8_SA(0, 0), a2, voffA);
            PG8_BAR; PG8_WAIT_L(0); PG8_MMA(1, 0, At, B0); PG8_BAR; PG8_SCHED;
            PG8_STAGE(PG8_SB(0, 1), b2 + hstep, voffB);
            PG8_WAIT_V(6); PG8_BAR; PG8_MMA(1, 1, At, B1); PG8_BAR;
            PG8_LDB(B0, 1, 0); PG8_SCHED; PG8_LDA(At, 1, 0); PG8_STAGE(PG8_SA(0, 1), a2 + hstep, voffA);
            PG8_WAIT_L(8); PG8_BAR; PG8_WAIT_L(0); PG8_MMA(0, 0, At, B0); PG8_BAR; PG8_SCHED;
            PG8_LDB(B1, 1, 1); PG8_STAGE(PG8_SB(1, 0), b3, voffB);
            PG8_BAR; PG8_WAIT_L(0); PG8_MMA(0, 1, At, B1); PG8_BAR;
            PG8_LDA(At, 1, 1); PG8_STAGE(PG8_SA(1, 0), a3, voffA);
            PG8_BAR; PG8_WAIT_L(0); PG8_MMA(1, 0, At, B0); PG8_BAR; PG8_SCHED;
            PG8_STAGE(PG8_SB(1, 1), b3 + hstep, voffB);
            PG8_WAIT_V(6); PG8_BAR; PG8_MMA(1, 1, At, B1); PG8_BAR;
            }
        }
        if constexpr (ALIGN_EPI) { if (wr == 0) PG8_BAR; }
        if constexpr (!Epi::AFTER_DRAIN) { E(acc, cur, wr, wc, fr, fq); S.done(cur); }
        if (!has_next) break;
#pragma unroll
        for (int a = 0; a < 2; ++a)
#pragma unroll
            for (int b = 0; b < 2; ++b)
#pragma unroll
                for (int m = 0; m < 4; ++m)
#pragma unroll
                    for (int n = 0; n < 2; ++n) acc[a][b][m][n] = (f32x4){0.f, 0.f, 0.f, 0.f};
        cur = nxt; cA = nA; cB = nB; ++ui;
        if constexpr (ALIGN_EPI) { if (wr == 1) PG8_BAR; }
    }
    PG8_WAIT_V(0);
    if constexpr (!ALIGN_EPI) { if (wr == 0) PG8_BAR; }
    PG8_BAR;
    if constexpr (Epi::AFTER_DRAIN) { E.fused(acc, cur, wr, wc, fr, fq, lds, wid, lane); S.done(cur); }
#undef PG8_SA
#undef PG8_SB
#undef PG8_STAGE
#undef PG8_LDA
#undef PG8_LDB
#undef PG8_MMA
#undef PG8_WAIT_V
#undef PG8_WAIT_L
#undef PG8_BAR
#undef PG8_SCHED
}
}
constexpr int D = 1024, MP = 16384, MS = 1024, M = MP + MS, NLAYER = 4, MIXW = 256, INC = 5888, PMC = 1792, GTC = 4096, FF = 2816;
constexpr int SEQ = 2048, NB = 8, DB = 128, DSEQ = 8, NCH = SEQ / 64;
constexpr int NPHASE = 2 + 7 * NLAYER;
#ifndef MK_PER_PHASE
#define MK_PER_PHASE 0
#endif
constexpr size_t O_Y = 0, O_POOLP = 17825792, O_POOLS = 17948672, O_SREP = 19914752, O_SRES = 19947520, O_SIMP = 20471808, O_SIMS = 20504576,
                 O_SCP = 21028864, O_SCS = 21045248, O_CFP = 21307392, O_CFS = 21553152, O_END = 25485312;
constexpr size_t MiB = 1u << 20;
constexpr size_t WS_CTL = 0, CTL_ZERO_BYTES = 64 * 1024;
constexpr size_t WS_SSQ = 1 * MiB;
constexpr size_t WS_E = 3 * MiB;
constexpr size_t WS_TAB = 5 * MiB;
constexpr size_t TAB_LB = 0, TAB_LP = 8192, TAB_BBT = 16384, TAB_CM = TAB_BBT + 65536, TAB_PW = TAB_CM + 65536, TAB_STRIDE = TAB_PW + 32768;
constexpr size_t WS_WIN = 6 * MiB;
constexpr size_t WS_WFI = WS_WIN + (size_t)NLAYER * INC * D * 2;
constexpr size_t WS_WOUT = WS_WFI + (size_t)NLAYER * 2 * FF * D * 2;
constexpr size_t WS_WFO = WS_WOUT + (size_t)NLAYER * D * D * 2;
constexpr size_t WS_WBR = WS_WFO + (size_t)NLAYER * D * FF * 2;
constexpr size_t WS_WGLU = WS_WBR + (size_t)NLAYER * 4 * D * MIXW * 2;
constexpr size_t WS_ACT1 = WS_WGLU + (size_t)NLAYER * MIXW * MIXW * 2;
constexpr size_t WS_PM = WS_ACT1 + (size_t)M * D * 2;
constexpr size_t WS_GT = WS_PM + (size_t)M * PMC * 2;
constexpr size_t WS_END = WS_GT + (size_t)M * GTC * 2;
static_assert(WS_TAB + NLAYER * TAB_STRIDE <= WS_WIN && WS_E + (size_t)NB * NCH * 1024 * 8 <= WS_TAB && WS_SSQ + (size_t)M * 64 <= WS_E, "d_ws map");
constexpr int CW_BAR = 1024;
constexpr int RING_OFF = 0, RING_BYTES = 131072;
constexpr int LDSCTL_OFF = RING_BYTES, MISC_OFF = LDSCTL_OFF + 320;
constexpr int LDS_BYTES = 147456;
constexpr int NWAVES = 8;

#define GAS __attribute__((address_space(1)))
#define LAS __attribute__((address_space(3)))
typedef unsigned short bf16;
typedef unsigned short bf16_t;
typedef unsigned v4u __attribute__((ext_vector_type(4)));
typedef unsigned v2u __attribute__((ext_vector_type(2)));
typedef float f32x4 __attribute__((ext_vector_type(4)));
typedef float f32x2 __attribute__((ext_vector_type(2)));
typedef short bf16x8 __attribute__((ext_vector_type(8)));
#define LDS_WAIT() asm volatile("s_waitcnt lgkmcnt(0)" ::: "memory")
#define VM_WAIT() asm volatile("s_waitcnt vmcnt(0)" ::: "memory")
__device__ __forceinline__ unsigned pk2(float lo, float hi) { return pg8::cvt_pk_bf16(lo, hi); }
__device__ __forceinline__ float bflo(unsigned u) { return __builtin_bit_cast(float, u << 16); }
__device__ __forceinline__ float bfhi(unsigned u) { return __builtin_bit_cast(float, u & 0xffff0000u); }
__device__ __forceinline__ float bf1(bf16_t b) { return __builtin_bit_cast(float, (unsigned)b << 16); }
__device__ __forceinline__ void unpack8(const v4u v, float (&f)[8]) { f[0] = bflo(v.x); f[1] = bfhi(v.x); f[2] = bflo(v.y); f[3] = bfhi(v.y); f[4] = bflo(v.z); f[5] = bfhi(v.z); f[6] = bflo(v.w); f[7] = bfhi(v.w); }
__device__ __forceinline__ v4u pack8(const float (&f)[8]) { v4u w; w.x = pk2(f[0], f[1]); w.y = pk2(f[2], f[3]); w.z = pk2(f[4], f[5]); w.w = pk2(f[6], f[7]); return w; }
__device__ __forceinline__ float sigm(float x) { return pg8::sigm(x); }
__device__ __forceinline__ float gelu_tanh(float y) { const float in2 = 1.5957691216057308f * (y + 0.044715f * y * y * y); const float e = __builtin_amdgcn_exp2f(1.4426950408889634f * in2); return 0.5f * y * (2.0f - 2.0f * __builtin_amdgcn_rcpf(e + 1.0f)); }
__device__ __forceinline__ float wave_sum(float v) {
#pragma unroll
    for (int o = 1; o < 64; o <<= 1) v += __shfl_xor(v, o);
    return v;
}

#define XB_TMO      128
#define XB_XCNT(j)  (256  + 64 * (j))
#define XB_XSUB(j)  (1280 + 64 * (j))
#define XB_XGEN(j)  (2304 + 64 * (j))
#define XB_TOP      3328
#define XB_TOPGEN   3392
#define XCD_BAR_WORDS 3456
#define XB_SPIN_CAP (1u << 18)

__device__ __forceinline__ unsigned xb_ld(unsigned* p)              { return __hip_atomic_load(p, __ATOMIC_RELAXED, __HIP_MEMORY_SCOPE_AGENT); }
__device__ __forceinline__ unsigned xb_add(unsigned* p, unsigned v) { return __hip_atomic_fetch_add(p, v, __ATOMIC_RELAXED, __HIP_MEMORY_SCOPE_AGENT); }
__device__ __forceinline__ unsigned xb_xcc_id() { return (unsigned)__builtin_amdgcn_s_getreg((3 << 11) | 20) & 0xFu; }
#define XB_SPIN(cond, bar) do { unsigned _sp = 0; while (cond) { __builtin_amdgcn_s_sleep(1); \
    if ((++_sp & 255u) == 0u) { if (xb_ld(&(bar)[XB_TMO])) break; if (_sp > XB_SPIN_CAP) { atomicAdd(&(bar)[XB_TMO], 1u); break; } } } } while (0)

struct XcdBarrier {
    unsigned* bar; unsigned x;
    volatile LAS unsigned* st;
};

__device__ __forceinline__ XcdBarrier xcd_barrier_post(unsigned* bar, volatile LAS unsigned* st) {
    XcdBarrier b; b.bar = bar; b.x = xb_xcc_id(); b.st = st;
    if (threadIdx.x == 0) (void)xb_add(&bar[XB_XCNT(b.x)], 1u);
    return b;
}
__device__ __forceinline__ void xcd_barrier_complete(unsigned* bar, unsigned x, unsigned& nloc, unsigned& nx) {
    const unsigned G = gridDim.x * gridDim.y * gridDim.z;
    unsigned sum, cnt, mine, sp = 0u;
    for (;;) {
        sum = 0u; cnt = 0u; mine = 0u;
#pragma unroll
        for (unsigned j = 0; j < 16; ++j) { const unsigned c = xb_ld(&bar[XB_XCNT(j)]); sum += c; cnt += (c > 0u) ? 1u : 0u; mine = (j == x) ? c : mine; }
        if (sum == G) break;
        __builtin_amdgcn_s_sleep(1);
        if ((++sp & 255u) == 0u) { if (xb_ld(&bar[XB_TMO])) break; if (sp > XB_SPIN_CAP) { atomicAdd(&bar[XB_TMO], 1u); break; } }
    }
    nloc = mine > 0u ? mine : 1u; nx = cnt > 0u ? cnt : 1u;
}

__device__ __forceinline__ void xcd_barrier(const XcdBarrier& b) {
    asm volatile("s_waitcnt vmcnt(0)" ::: "memory");
    __syncthreads();
    if (threadIdx.x == 0) {
        unsigned* bar = b.bar;
        __builtin_amdgcn_s_waitcnt(0);
        unsigned nloc = b.st[0], nx = b.st[1];
        if (nloc == 0u) { xcd_barrier_complete(bar, b.x, nloc, nx); b.st[0] = nloc; b.st[1] = nx; }
        const unsigned old = xb_add(&bar[XB_XSUB(b.x)], 1u);
        const unsigned gen = old / nloc;
        if (old + 1u == (gen + 1u) * nloc) {
            __builtin_amdgcn_fence(__ATOMIC_RELEASE, "agent");
            asm volatile("s_waitcnt vmcnt(0)" ::: "memory");
            const unsigned og = xb_add(&bar[XB_TOP], 1u);
            const unsigned tg = og / nx;
            if (og + 1u == (tg + 1u) * nx) xb_add(&bar[XB_TOPGEN], 1u);
            else XB_SPIN(xb_ld(&bar[XB_TOPGEN]) == tg, bar);
            __builtin_amdgcn_fence(__ATOMIC_ACQUIRE, "agent");
            xb_add(&bar[XB_XGEN(b.x)], 1u);
            asm volatile("s_waitcnt vmcnt(0)" ::: "memory");
        } else {
            XB_SPIN(xb_ld(&bar[XB_XGEN(b.x)]) == gen, bar);
            __builtin_amdgcn_fence(__ATOMIC_ACQUIRE, "agent");
            asm volatile("s_waitcnt vmcnt(0)" ::: "memory");
        }
    }
    __syncthreads();
}
struct Args { const float* in[32]; float* out; unsigned char* ws; int ph_lo, ph_hi; };
enum { I_XP = 0, I_XS, I_STPOOL, I_STRE, I_STIM, I_STSC, I_STCF, I_N1G, I_N2G, I_FING, I_WIN, I_BGATE, I_POOLW, I_POOLSC, I_LAMRE, I_LAMIM, I_LOGDT,
       I_BRE, I_BIM, I_CRE, I_CIM, I_DSKIP, I_WGLU, I_BGLU, I_SCW, I_CFW, I_CFLNG, I_CFLNB, I_WBR, I_WOUT, I_WFI, I_WFO };

__device__ __forceinline__ void p0_item(const float* W, int ldw, int src_col0, const float* kscale, int k0, bf16* WTrow0, int K, LAS float* scr, int lane) {
    float wv[32];
#pragma unroll
    for (int i = 0; i < 32; ++i) { const int kk = 2 * i + (lane >> 5); wv[i] = W[(size_t)(k0 + kk) * ldw + src_col0 + (lane & 31)]; }
#pragma unroll
    for (int i = 0; i < 32; ++i) { const int kk = 2 * i + (lane >> 5); scr[kk * 33 + (lane & 31)] = wv[i]; }
    LDS_WAIT(); asm volatile("" ::: "memory");
    const int c = lane & 7;
    f32x4 ks0 = (f32x4){1.f, 1.f, 1.f, 1.f}, ks1 = ks0;
    if (kscale) { ks0 = *(const f32x4*)(kscale + k0 + 8 * c); ks1 = *(const f32x4*)(kscale + k0 + 8 * c + 4); }
#pragma unroll
    for (int j = 0; j < 4; ++j) { const int n = (lane >> 3) + 8 * j; const LAS float* s = scr + (8 * c) * 33 + n;
        v4u o; o.x = pk2(s[0 * 33] * ks0[0], s[1 * 33] * ks0[1]); o.y = pk2(s[2 * 33] * ks0[2], s[3 * 33] * ks0[3]); o.z = pk2(s[4 * 33] * ks1[0], s[5 * 33] * ks1[1]); o.w = pk2(s[6 * 33] * ks1[2], s[7 * 33] * ks1[3]);
        *(GAS v4u*)(WTrow0 + (size_t)n * K + k0 + 8 * c) = o; }
    LDS_WAIT(); asm volatile("" ::: "memory");
}
__device__ __forceinline__ void p0_prologue(const Args& a, LAS unsigned char* lds, int tid, int lane, int wave, int G, int bid) {
    LAS float* scr = (LAS float*)(lds + RING_OFF + wave * 16384);
    const int gw = bid * NWAVES + wave, NGW = G * NWAVES;
    unsigned char* ws = a.ws;
    constexpr int IT_IN = 16 * (INC / 32), IT_FI = 16 * (2 * FF / 32), IT_OUT = 16 * 32, IT_FO = (FF / 64) * 32, IT_BR = 4 * 4 * 32, IT_GLU = 4 * 8;
    constexpr int IT_LAYER = IT_IN + IT_FI + IT_OUT + IT_FO + IT_BR + IT_GLU;
    for (int it = gw; it < NLAYER * IT_LAYER; it += NGW) {
        const int L = it / IT_LAYER; int r = it % IT_LAYER;
        if (r < IT_IN) { const int nblk = INC / 32, kb = r / nblk, nb = r % nblk;
            p0_item(a.in[I_WIN] + (size_t)L * D * INC, INC, 32 * nb, a.in[I_N1G] + L * D, 64 * kb, (bf16*)(ws + WS_WIN) + ((size_t)L * INC + 32 * nb) * D, D, scr, lane); continue; } r -= IT_IN;
        if (r < IT_FI) { const int nblk = 2 * FF / 32, kb = r / nblk, nb = r % nblk; const int nd = 32 * nb, pn = nd >> 8, rr = nd & 255;
            const int src = rr < 128 ? 128 * pn + rr : FF + 128 * pn + (rr - 128);
            p0_item(a.in[I_WFI] + (size_t)L * D * 2 * FF, 2 * FF, src, a.in[I_N2G] + L * D, 64 * kb, (bf16*)(ws + WS_WFI) + ((size_t)L * 2 * FF + nd) * D, D, scr, lane); continue; } r -= IT_FI;
        if (r < IT_OUT) { const int kb = r / 32, nb = r % 32;
            p0_item(a.in[I_WOUT] + (size_t)L * D * D, D, 32 * nb, nullptr, 64 * kb, (bf16*)(ws + WS_WOUT) + ((size_t)L * D + 32 * nb) * D, D, scr, lane); continue; } r -= IT_OUT;
        if (r < IT_FO) { const int kb = r / 32, nb = r % 32;
            p0_item(a.in[I_WFO] + (size_t)L * FF * D, D, 32 * nb, nullptr, 64 * kb, (bf16*)(ws + WS_WFO) + ((size_t)L * D + 32 * nb) * FF, FF, scr, lane); continue; } r -= IT_FO;
        if (r < IT_BR) { const int br = r / 128, q = r % 128, kb = q / 32, nb = q % 32;
            p0_item(a.in[I_WBR] + (size_t)(L * 4 + br) * MIXW * D, D, 32 * nb, nullptr, 64 * kb, (bf16*)(ws + WS_WBR) + ((size_t)(L * 4 + br) * D + 32 * nb) * MIXW, MIXW, scr, lane); continue; } r -= IT_BR;
        { const int kb = r / 8, nb = r % 8;
            p0_item(a.in[I_WGLU] + (size_t)L * MIXW * MIXW, MIXW, 32 * nb, nullptr, 64 * kb, (bf16*)(ws + WS_WGLU) + ((size_t)L * MIXW + 32 * nb) * MIXW, MIXW, scr, lane); }
    }
    for (int m = gw; m < M; m += NGW) {
        const float* xrow = m < MP ? a.in[I_XP] + (size_t)m * D : a.in[I_XS] + (size_t)(m - MP) * D;
        const GAS f32x4* xr = (const GAS f32x4*)xrow + lane; f32x4 v[4]; float s = 0.f;
#pragma unroll
        for (int j = 0; j < 4; ++j) { v[j] = xr[64 * j]; s += (v[j][0] * v[j][0] + v[j][1] * v[j][1]) + (v[j][2] * v[j][2] + v[j][3] * v[j][3]); }
        s = wave_sum(s);
        GAS v2u* o8 = (GAS v2u*)((bf16*)(ws + WS_ACT1) + (size_t)m * D) + lane;
#pragma unroll
        for (int j = 0; j < 4; ++j) { v2u w; w.x = pk2(v[j][0], v[j][1]); w.y = pk2(v[j][2], v[j][3]); o8[64 * j] = w; }
        if (lane < 16) ((float*)(ws + WS_SSQ))[((size_t)(lane >> 2) * M + m) * 4 + (lane & 3)] = lane == 0 ? s : 0.f;
    }
    for (int idx = bid * 512 + tid; idx < NLAYER * 1024; idx += G * 512) {
        const int L = idx >> 10, gp = idx & 1023, g = gp >> 6, p = gp & 63;
        unsigned char* tab = ws + WS_TAB + (size_t)L * TAB_STRIDE;
        const float lre = a.in[I_LAMRE][idx], lim = a.in[I_LAMIM][idx], dt = expf(a.in[I_LOGDT][L * 16 + g]);
        const float ar = lre * dt, br_ = lim * dt, ea = expf(ar), cb = cosf(br_), sb = sinf(br_), sh = sinf(0.5f * br_);
        const float lbr = ea * cb, lbi = ea * sb;
        const float m1r = expm1f(ar) * cb - 2.0f * sh * sh, m1i = lbi;
        const float den = 1.0f / (lre * lre + lim * lim);
        const float qr = (m1r * lre + m1i * lim) * den, qi = (m1i * lre - m1r * lim) * den;
        ((f32x2*)(tab + TAB_LB))[gp] = (f32x2){lbr, lbi};
        float pr = lbr, pi = lbi;
#pragma unroll
        for (int s = 0; s < 6; ++s) { const float nr = pr * pr - pi * pi, ni = 2.0f * pr * pi; pr = nr; pi = ni; }
        ((f32x2*)(tab + TAB_LP))[gp] = (f32x2){pr, pi};
        bf16* bbt = (bf16*)(tab + TAB_BBT); bf16* cm = (bf16*)(tab + TAB_CM);
        const float* bre = a.in[I_BRE] + (size_t)idx * 16; const float* bim = a.in[I_BIM] + (size_t)idx * 16;
#pragma unroll
        for (int c = 0; c < 16; ++c) { const float Br = bre[c], Bi = bim[c];
            bbt[(g * 128 + p) * 16 + c] = (bf16)(pk2(qr * Br - qi * Bi, 0.f) & 0xffffu);
            bbt[(g * 128 + 64 + p) * 16 + c] = (bf16)(pk2(qr * Bi + qi * Br, 0.f) & 0xffffu);
            cm[(g * 16 + c) * 128 + p] = (bf16)(pk2(a.in[I_CRE][((size_t)(L * 16 + g) * 16 + c) * 64 + p], 0.f) & 0xffffu);
            cm[(g * 16 + c) * 128 + 64 + p] = (bf16)(pk2(-a.in[I_CIM][((size_t)(L * 16 + g) * 16 + c) * 64 + p], 0.f) & 0xffffu); }
    }
    for (int idx = bid * 512 + tid; idx < NLAYER * 4 * 64 * 64; idx += G * 512) {
        const int L = idx >> 14, r = idx & 16383, k = r >> 12, o = (r >> 6) & 63, c = r & 63;
        ((bf16*)(ws + WS_TAB + (size_t)L * TAB_STRIDE + TAB_PW))[r] = (bf16)(pk2(a.in[I_POOLW][((size_t)(L * 4 + k) * 64 + c) * 64 + o], 0.f) & 0xffffu);
    }
}
__device__ __forceinline__ void final_norm(const Args& a, int lane, int wave, int G, int bid) {
    const int gw = bid * NWAVES + wave, NGW = G * NWAVES;
        const float* ssq = (const float*)(a.ws + WS_SSQ);
    f32x4 gv[4];
#pragma unroll
    for (int j = 0; j < 4; ++j) gv[j] = ((const f32x4*)a.in[I_FING])[lane + 64 * j];
    for (int m = gw; m < M; m += NGW) {
        float s = lane < 16 ? ssq[((size_t)(lane >> 2) * M + m) * 4 + (lane & 3)] : 0.f; s = wave_sum(s);
        const float rs = __builtin_amdgcn_rsqf(s * (1.0f / 1024.0f) + 1e-6f);
        GAS f32x4* xr = (GAS f32x4*)(a.out + (size_t)m * D) + lane;
#pragma unroll
#ifdef DBG_HASH_Y
        for (int j = 0; j < 4; ++j) { f32x4 v = xr[64 * j]; v = v * rs * gv[j]; f32x4 h;
            for (int q = 0; q < 4; ++q) { const unsigned b = __float_as_uint(v[q]); const unsigned hh = (b * 2654435761u) ^ (b >> 15); h[q] = (float)(hh >> 8) * (1.0f / 16777216.0f); }
            xr[64 * j] = h; }
#else
        for (int j = 0; j < 4; ++j) { f32x4 v = xr[64 * j]; xr[64 * j] = v * rs * gv[j]; }
#endif
    }
}

typedef float f32x4_t __attribute__((ext_vector_type(4)));
__device__ __forceinline__ float fma_s(float a, float b, float c) { float r; asm("v_fma_f32 %0, %1, %2, %3" : "=v"(r) : "v"(a), "v"(b), "v"(c)); return r; }
template <bool SAMPLE>
__device__ __forceinline__ void mix_unit(const Args& a, int layer, int uidx, LAS unsigned char* lds, int tid_in, int lane_in, int wave_in) {
    int tid = tid_in; asm volatile("" : "+v"(tid));
    const int lane = tid & 63, wave = __builtin_amdgcn_readfirstlane(tid >> 6);
#ifdef DBG_EXTRA_SYNC
    asm volatile("s_waitcnt vmcnt(0) lgkmcnt(0)" ::: "memory"); __syncthreads();
#endif
    constexpr int L = SAMPLE ? 8 : 64, NSEG = SAMPLE ? 2 : 1, R = NSEG * L;
    const bf16* PMb = (const bf16*)(a.ws + WS_PM); bf16* BR = (bf16*)(a.ws + WS_ACT1);
    const int s = uidx >> 5, c = uidx & 31, q0 = 2 * uidx;
    const int row0 = SAMPLE ? MP + q0 * 8 : s * SEQ + 64 * c;
    const bool last = SAMPLE || c == NCH - 1;
    LAS float* V = (LAS float*)lds;
    {
        constexpr int TR = NSEG * (30 + L);
        LAS float* WCF = (LAS float*)(lds + 96256);
        {
            constexpr int NIT = (TR * 32 + 511) / 512;
            v4u qa[NIT], qb[NIT]; int kind[NIT];
#pragma unroll
            for (int it = 0; it < NIT; ++it) {
                const int idx = tid + it * 512; kind[it] = 0; qa[it] = (v4u){0u, 0u, 0u, 0u}; qb[it] = (v4u){0u, 0u, 0u, 0u};
                if (idx < TR * 32) {
                    const int rr = idx >> 5, c8 = (idx & 31) * 8, seg = rr / (30 + L), e = rr % (30 + L);
                    int srow = -1;
                    if (SAMPLE) { if (e >= 30) srow = MP + (q0 + seg) * 8 + (e - 30); }
                    else { const int tabs = c * 64 + e - 30; if (tabs >= 0) srow = s * SEQ + tabs; }
                    if (srow >= 0) { kind[it] = 1; qa[it] = *(const v4u*)(PMb + (size_t)srow * PMC + 1280 + c8); qb[it] = *(const v4u*)(PMb + (size_t)srow * PMC + 1536 + c8); }
                    else if (SAMPLE) { kind[it] = 2; const float* st = a.in[I_STCF] + ((size_t)(layer * DB + q0 + seg) * 30 + e) * MIXW + c8; qa[it] = *(const v4u*)st; qb[it] = *(const v4u*)(st + 4); }
                }
            }
#pragma unroll
            for (int it = 0; it < NIT; ++it) {
                const int idx = tid + it * 512;
                if (idx < TR * 32) {
                    const int rr = idx >> 5, c8 = (idx & 31) * 8;
                    float v[8];
                    if (kind[it] == 1) { float av[8], bv[8]; unpack8(qa[it], av); unpack8(qb[it], bv);
#pragma unroll
                        for (int j = 0; j < 8; ++j) v[j] = av[j] * sigm(bv[j]); }
                    else { v[0] = __uint_as_float(qa[it].x); v[1] = __uint_as_float(qa[it].y); v[2] = __uint_as_float(qa[it].z); v[3] = __uint_as_float(qa[it].w);
                           v[4] = __uint_as_float(qb[it].x); v[5] = __uint_as_float(qb[it].y); v[6] = __uint_as_float(qb[it].z); v[7] = __uint_as_float(qb[it].w); }
                    *(LAS f32x4*)(V + rr * 256 + c8) = (f32x4){v[0], v[1], v[2], v[3]}; *(LAS f32x4*)(V + rr * 256 + c8 + 4) = (f32x4){v[4], v[5], v[6], v[7]};
                }
            }
        }
        for (int idx = tid; idx < 31 * 64; idx += 512) *(LAS f32x4*)(WCF + idx * 4) = *(const f32x4*)(a.in[I_CFW] + (size_t)layer * 31 * MIXW + idx * 4);
        __syncthreads();
        if (last) {
            for (int idx = tid; idx < NSEG * 30 * 64; idx += 512) { const int seg = idx / (30 * 64), r = idx % (30 * 64), j = r >> 6, c4 = (r & 63) * 4;
                float* dst = a.out + (SAMPLE ? O_CFS + ((size_t)(layer * DB + q0 + seg) * 30 + j) * MIXW : O_CFP + ((size_t)(layer * NB + s) * 30 + j) * MIXW) + c4;
                *(f32x4*)dst = *(LAS f32x4*)(V + (seg * (30 + L) + L + j) * 256 + c4); }
        }
        const f32x4 lg = *(const f32x4*)(a.in[I_CFLNG] + layer * MIXW + 4 * lane), lb = *(const f32x4*)(a.in[I_CFLNB] + layer * MIXW + 4 * lane);
        for (int tt = wave; tt < R; tt += NWAVES) {
            const int seg = tt / L, t = tt % L, base = seg * (30 + L) + t;
            f32x4 acc = (f32x4){0.f, 0.f, 0.f, 0.f};
#pragma unroll 8
            for (int j = 0; j < 31; ++j) acc += *(LAS f32x4*)(WCF + j * 256 + 4 * lane) * *(LAS f32x4*)(V + (base + j) * 256 + 4 * lane);
            const float mean = wave_sum((acc[0] + acc[1]) + (acc[2] + acc[3])) * (1.0f / 256.0f);
            const f32x4 d = acc - mean;
            const float var = wave_sum((d[0] * d[0] + d[1] * d[1]) + (d[2] * d[2] + d[3] * d[3])) * (1.0f / 256.0f);
            const float rstd = __builtin_amdgcn_rsqf(var + 1e-5f);
            const f32x4 yn = d * rstd * lg + lb;
            v2u w; w.x = pk2(yn[0] * sigm(yn[0]), yn[1] * sigm(yn[1])); w.y = pk2(yn[2] * sigm(yn[2]), yn[3] * sigm(yn[3]));
            *(v2u*)(BR + (size_t)(row0 + tt) * D + 768 + 4 * lane) = w;
        }
        __syncthreads();
    }
    {
        constexpr int TR = NSEG * (15 + L);
        LAS bf16* Dt = (LAS bf16*)(lds + 81920);
        {
            constexpr int NIT = (TR * 32 + 511) / 512;
            v4u qa[NIT], qb[NIT]; int kind[NIT];
#pragma unroll
            for (int it = 0; it < NIT; ++it) {
                const int idx = tid + it * 512; kind[it] = 0; qa[it] = (v4u){0u, 0u, 0u, 0u}; qb[it] = (v4u){0u, 0u, 0u, 0u};
                if (idx < TR * 32) {
                    const int rr = idx >> 5, c8 = (idx & 31) * 8, seg = rr / (15 + L), e = rr % (15 + L);
                    int srow = -1;
                    if (SAMPLE) { if (e >= 15) srow = MP + (q0 + seg) * 8 + (e - 15); }
                    else { const int tabs = c * 64 + e - 15; if (tabs >= 0) srow = s * SEQ + tabs; }
                    if (srow >= 0) { kind[it] = 1; qa[it] = *(const v4u*)(PMb + (size_t)srow * PMC + c8); }
                    else if (SAMPLE) { kind[it] = 2; const float* st = a.in[I_STPOOL] + ((size_t)(layer * DB + q0 + seg) * 15 + e) * MIXW + c8; qa[it] = *(const v4u*)st; qb[it] = *(const v4u*)(st + 4); }
                }
            }
#pragma unroll
            for (int it = 0; it < NIT; ++it) {
                const int idx = tid + it * 512;
                if (idx < TR * 32) {
                    const int rr = idx >> 5, c8 = (idx & 31) * 8;
                    float v[8];
                    if (kind[it] == 1) unpack8(qa[it], v);
                    else { v[0] = __uint_as_float(qa[it].x); v[1] = __uint_as_float(qa[it].y); v[2] = __uint_as_float(qa[it].z); v[3] = __uint_as_float(qa[it].w);
                           v[4] = __uint_as_float(qb[it].x); v[5] = __uint_as_float(qb[it].y); v[6] = __uint_as_float(qb[it].z); v[7] = __uint_as_float(qb[it].w); }
                    *(LAS f32x4*)(V + rr * 256 + c8) = (f32x4){v[0], v[1], v[2], v[3]}; *(LAS f32x4*)(V + rr * 256 + c8 + 4) = (f32x4){v[4], v[5], v[6], v[7]};
                }
            }
        }
        __syncthreads();
        if (last) {
            for (int idx = tid; idx < NSEG * 15 * 64; idx += 512) { const int seg = idx / (15 * 64), r = idx % (15 * 64), j = r >> 6, c4 = (r & 63) * 4;
                float* dst = a.out + (SAMPLE ? O_POOLS + ((size_t)(layer * DB + q0 + seg) * 15 + j) * MIXW : O_POOLP + ((size_t)(layer * NB + s) * 15 + j) * MIXW) + c4;
                *(f32x4*)dst = *(LAS f32x4*)(V + (seg * (15 + L) + L + j) * 256 + c4); }
        }
        for (int idx = tid; idx < R * 32; idx += 512) {
            const int tt = idx >> 5, c8 = (idx & 31) * 8, seg = tt / L, t = tt % L, base = seg * (15 + L) + t + 15, win = 2 << (c8 >> 6);
            float sm[8];
#pragma unroll
            for (int j = 0; j < 8; ++j) sm[j] = 0.f;
            for (int w = 0; w < win; ++w) { const f32x4 x0 = *(LAS f32x4*)(V + (base - w) * 256 + c8), x1 = *(LAS f32x4*)(V + (base - w) * 256 + c8 + 4);
                sm[0] += x0[0]; sm[1] += x0[1]; sm[2] += x0[2]; sm[3] += x0[3]; sm[4] += x1[0]; sm[5] += x1[1]; sm[6] += x1[2]; sm[7] += x1[3]; }
            const int cnt = SAMPLE ? win : min(c * 64 + t + 1, win);
            const float inv = 1.0f / (float)cnt;
            const f32x4 c0 = *(LAS f32x4*)(V + base * 256 + c8), c1 = *(LAS f32x4*)(V + base * 256 + c8 + 4);
            float dd[8];
#pragma unroll
            for (int j = 0; j < 4; ++j) { dd[j] = sm[j] * inv - c0[j]; dd[4 + j] = sm[4 + j] * inv - c1[j]; }
            *(LAS v4u*)(Dt + tt * 264 + c8) = pack8(dd);
        }
        __syncthreads();
        {
            const bf16* PW = (const bf16*)(a.ws + WS_TAB + (size_t)layer * TAB_STRIDE + TAB_PW);
            const int k = wave >> 1, fr = lane & 15, fq = lane >> 4;
            constexpr int NMT = R / 16;
            for (int mt = (NMT >= 4 ? (wave & 1) * 2 : (wave & 1)); mt < (NMT >= 4 ? (wave & 1) * 2 + 2 : ((wave & 1) == 0 ? NMT : 0)); ++mt) {
                const bf16x8 b0 = *(LAS bf16x8*)(Dt + (16 * mt + fr) * 264 + 64 * k + 8 * fq), b1 = *(LAS bf16x8*)(Dt + (16 * mt + fr) * 264 + 64 * k + 32 + 8 * fq);
#pragma unroll
                for (int ot = 0; ot < 4; ++ot) {
                    const bf16x8 a0 = *(const bf16x8*)(PW + ((size_t)(k * 64 + 16 * ot + fr)) * 64 + 8 * fq), a1 = *(const bf16x8*)(PW + ((size_t)(k * 64 + 16 * ot + fr)) * 64 + 32 + 8 * fq);
                    f32x4 acc = (f32x4){0.f, 0.f, 0.f, 0.f};
#ifdef DBG_OPAQUE_ZERO
                    asm volatile("" : "+v"(acc));
#endif
                    acc = __builtin_amdgcn_mfma_f32_16x16x32_bf16(a0, b0, acc, 0, 0, 0);
                    acc = __builtin_amdgcn_mfma_f32_16x16x32_bf16(a1, b1, acc, 0, 0, 0);
                    const int o = 64 * k + 16 * ot + 4 * fq, tt = 16 * mt + fr;
                    const f32x4 sc = *(const f32x4*)(a.in[I_POOLSC] + layer * MIXW + o);
                    v2u w; w.x = pk2(acc[0] * sc[0], acc[1] * sc[1]); w.y = pk2(acc[2] * sc[2], acc[3] * sc[3]);
#ifdef DBG_POOL_DT
#if DBG_POOL_DT == 1
                    w = *(LAS v2u*)(Dt + tt * 264 + o);
#elif DBG_POOL_DT == 2
                    w.x = pk2(acc[0], acc[1]); w.y = pk2(acc[2], acc[3]);
#elif DBG_POOL_DT == 4
                    { const unsigned* pa = (const unsigned*)&a0; const unsigned* pb = (const unsigned*)&a1;
                      w.x = (pa[0] * 3u + pa[1] * 5u + pa[2] * 7u + pa[3] * 11u) & 0x3f803f80u; w.y = (pb[0] * 3u + pb[1] * 5u + pb[2] * 7u + pb[3] * 11u) & 0x3f803f80u; }
#elif DBG_POOL_DT == 5
                    { const unsigned* pa = (const unsigned*)&b0; const unsigned* pb = (const unsigned*)&b1;
                      w.x = (pa[0] * 3u + pa[1] * 5u + pa[2] * 7u + pa[3] * 11u) & 0x3f803f80u; w.y = (pb[0] * 3u + pb[1] * 5u + pb[2] * 7u + pb[3] * 11u) & 0x3f803f80u; }
#elif DBG_POOL_DT == 3
                    w.x = ((const unsigned*)&a0)[0] ^ ((const unsigned*)&a1)[1]; w.y = ((const unsigned*)&a0)[2] ^ ((const unsigned*)&a1)[3];
#endif
#endif
                    *(v2u*)(BR + (size_t)(row0 + tt) * D + o) = w;
                }
            }
        }
        __syncthreads();
    }
    {
        const float* scw = a.in[I_SCW] + (size_t)layer * 3 * MIXW;
#pragma unroll
        for (int it_ = 0; it_ < R * 32 / 512; ++it_) { const int idx = tid + it_ * 512;
            const int tt = idx >> 5, c8 = (idx & 31) * 8, seg = tt / L, t = tt % L;
            float z[3][8];
#pragma unroll
            for (int dj = 0; dj < 3; ++dj) { const int tp = t - 2 + dj;
                int srow = -1;
                if (SAMPLE) { if (tp >= 0) srow = MP + (q0 + seg) * 8 + tp; } else { const int tabs = c * 64 + tp; if (tabs >= 0) srow = s * SEQ + tabs; }
                if (srow >= 0) { float cg[8], hx[8]; unpack8(*(const v4u*)(PMb + (size_t)srow * PMC + 768 + c8), cg); unpack8(*(const v4u*)(PMb + (size_t)srow * PMC + 1024 + c8), hx);
#pragma unroll
                    for (int j = 0; j < 8; ++j) z[dj][j] = cg[j] * hx[j]; }
                else if (SAMPLE) { const float* st = a.in[I_STSC] + ((size_t)(layer * DB + q0 + seg) * 2 + (2 + tp)) * MIXW + c8; const f32x4 x0 = *(const f32x4*)st, x1 = *(const f32x4*)(st + 4);
                    z[dj][0] = x0[0]; z[dj][1] = x0[1]; z[dj][2] = x0[2]; z[dj][3] = x0[3]; z[dj][4] = x1[0]; z[dj][5] = x1[1]; z[dj][6] = x1[2]; z[dj][7] = x1[3]; }
                else {
#pragma unroll
                    for (int j = 0; j < 8; ++j) z[dj][j] = 0.f; } }
            float bg[8], o[8]; unpack8(*(const v4u*)(PMb + (size_t)(row0 + tt) * PMC + 512 + c8), bg);
#pragma unroll
            for (int j = 0; j < 8; ++j) o[j] = bg[j] * (scw[c8 + j] * z[0][j] + scw[MIXW + c8 + j] * z[1][j] + scw[2 * MIXW + c8 + j] * z[2][j]);
            *(v4u*)(BR + (size_t)(row0 + tt) * D + 512 + c8) = pack8(o);
            if (last && t >= L - 2) { float* dst = a.out + (SAMPLE ? O_SCS + ((size_t)(layer * DB + q0 + seg) * 2 + (t - (L - 2))) * MIXW : O_SCP + ((size_t)(layer * NB + s) * 2 + (t - (L - 2))) * MIXW) + c8;
                *(f32x4*)dst = (f32x4){z[2][0], z[2][1], z[2][2], z[2][3]}; *(f32x4*)(dst + 4) = (f32x4){z[2][4], z[2][5], z[2][6], z[2][7]}; }
        }
    }
}

template <int MODE>
__device__ __forceinline__ void ssm_unit(const Args& a, int layer, int uidx, LAS unsigned char* lds, int tid_in, int lane_in, int wave_in) {
    int tid = tid_in; asm volatile("" : "+v"(tid));
    const int lane = tid & 63, wave = __builtin_amdgcn_readfirstlane(tid >> 6);
    const bf16* PMb = (const bf16*)(a.ws + WS_PM); bf16* BR = (bf16*)(a.ws + WS_ACT1);
    const unsigned char* tab = a.ws + WS_TAB + (size_t)layer * TAB_STRIDE;
    const f32x2* LB = (const f32x2*)(tab + TAB_LB); const f32x2* LP = (const f32x2*)(tab + TAB_LP);
    const bf16* BBT = (const bf16*)(tab + TAB_BBT); const bf16* CM = (const bf16*)(tab + TAB_CM);
    f32x2* E = (f32x2*)(a.ws + WS_E);
    const int s = uidx >> 5, c = uidx & 31;
    const int row0 = MODE == 2 ? MP + 64 * uidx : s * SEQ + 64 * c;
    const int fr = lane & 15, fq = lane >> 4;
    LAS float* BU = (LAS float*)(lds + wave * 8448);
    LAS bf16* Zt = (LAS bf16*)(lds + 67584);
    const bf16x8 zf = (bf16x8){0, 0, 0, 0, 0, 0, 0, 0};
    for (int gi = 0; gi < 2; ++gi) {
        const int g = 2 * wave + gi;
        const f32x2 lam = LB[g * 64 + lane]; const float nlam1 = -lam[1];
        float hr = 0.f, hi = 0.f;
        if (MODE == 1) { const f32x2 lp = LP[g * 64 + lane];
            const float nlp1 = -lp[1]; int j = 0;
            for (; j + 4 <= c; j += 4) { f32x2 e4[4];
#pragma unroll
                for (int q = 0; q < 4; ++q) e4[q] = E[((size_t)(s * NCH + j + q) * 16 + g) * 64 + lane];
#pragma unroll
                for (int q = 0; q < 4; ++q) { const float nr = fma_s(lp[0], hr, fma_s(nlp1, hi, e4[q][0])), ni = fma_s(lp[0], hi, fma_s(lp[1], hr, e4[q][1])); hr = nr; hi = ni; } }
            for (; j < c; ++j) { const f32x2 e = E[((size_t)(s * NCH + j) * 16 + g) * 64 + lane]; const float nr = fma_s(lp[0], hr, fma_s(nlp1, hi, e[0])), ni = fma_s(lp[0], hi, fma_s(lp[1], hr, e[1])); hr = nr; hi = ni; } }
        bf16x8 bb[8];
#pragma unroll
        for (int nt = 0; nt < 8; ++nt) bb[nt] = fq < 2 ? *(const bf16x8*)(BBT + ((size_t)(g * 128 + 16 * nt + fr)) * 16 + 8 * fq) : zf;
        bf16x8 cmf[4]; float dsk = 0.f;
        if (MODE >= 1) {
#pragma unroll
            for (int ks = 0; ks < 4; ++ks) cmf[ks] = *(const bf16x8*)(CM + ((size_t)(g * 16 + fr)) * 128 + 32 * ks + 8 * fq);
            dsk = a.in[I_DSKIP][layer * MIXW + 16 * g + fr]; }
        bf16x8 ufa[4];
#pragma unroll
        for (int sub = 0; sub < 4; ++sub) ufa[sub] = fq < 2 ? *(const bf16x8*)(PMb + (size_t)(row0 + 16 * sub + fr) * PMC + 256 + 16 * g + 8 * fq) : zf;
#pragma unroll
        for (int sub = 0; sub < 4; ++sub) {
            const int rowb = row0 + 16 * sub;
            const bf16x8 uf = ufa[sub];
#pragma unroll
            for (int nt = 0; nt < 8; ++nt) { const f32x4 d = __builtin_amdgcn_mfma_f32_16x16x32_bf16(uf, bb[nt], (f32x4){0.f, 0.f, 0.f, 0.f}, 0, 0, 0);
#pragma unroll
                for (int r = 0; r < 4; ++r) BU[(4 * fq + r) * 132 + 16 * nt + fr] = d[r]; }
            asm volatile("s_waitcnt lgkmcnt(0)" ::: "memory");
            {
                float bre_[16], bim_[16];
#pragma unroll
                for (int t = 0; t < 16; ++t) { bre_[t] = BU[t * 132 + lane]; bim_[t] = BU[t * 132 + 64 + lane]; }
                float sre_[2] = {0.f, 0.f}, sim_[2] = {0.f, 0.f};
                if (MODE == 2) {
#pragma unroll
                    for (int hq = 0; hq < 2; ++hq) { const int q = 8 * uidx + 2 * sub + hq; const size_t si = ((size_t)(layer * DB + q) * 16 + g) * 64 + lane; sre_[hq] = a.in[I_STRE][si]; sim_[hq] = a.in[I_STIM][si]; } }
                asm volatile("s_waitcnt lgkmcnt(0)" ::: "memory");
#pragma unroll
                for (int t = 0; t < 16; ++t) {
                    if (MODE == 2 && (t & 7) == 0) { hr = sre_[t >> 3]; hi = sim_[t >> 3]; }
                    const float nr = fma_s(lam[0], hr, fma_s(nlam1, hi, bre_[t])), ni = fma_s(lam[0], hi, fma_s(lam[1], hr, bim_[t])); hr = nr; hi = ni;
                    bre_[t] = hr; bim_[t] = hi;
                    if (MODE == 2 && (t & 7) == 7) { const int q = 8 * uidx + 2 * sub + (t >> 3); const size_t si = ((size_t)(layer * DB + q) * 16 + g) * 64 + lane; a.out[O_SRES + si] = hr; a.out[O_SIMS + si] = hi; }
                }
#pragma unroll
                for (int t = 0; t < 16; ++t) { BU[t * 132 + lane] = bre_[t]; BU[t * 132 + 64 + lane] = bim_[t]; }
            }
            if (MODE >= 1) {
                asm volatile("s_waitcnt lgkmcnt(0)" ::: "memory");
                f32x4 y = (f32x4){0.f, 0.f, 0.f, 0.f};
#pragma unroll
                for (int ks = 0; ks < 4; ++ks) { const f32x4 h0 = *(LAS f32x4*)(BU + fr * 132 + 32 * ks + 8 * fq), h1 = *(LAS f32x4*)(BU + fr * 132 + 32 * ks + 8 * fq + 4);
                    v4u hw; hw.x = pk2(h0[0], h0[1]); hw.y = pk2(h0[2], h0[3]); hw.z = pk2(h1[0], h1[1]); hw.w = pk2(h1[2], h1[3]);
                    y = __builtin_amdgcn_mfma_f32_16x16x32_bf16(__builtin_bit_cast(bf16x8, hw), cmf[ks], y, 0, 0, 0); }
#pragma unroll
                for (int r = 0; r < 4; ++r) { const int t = 4 * fq + r; const float uv = bf1(PMb[(size_t)(rowb + t) * PMC + 256 + 16 * g + fr]);
                    const float z = gelu_tanh(y[r] + dsk * uv);
                    Zt[(16 * sub + t) * 264 + 16 * g + fr] = (bf16)(pk2(z, 0.f) & 0xffffu); }
                asm volatile("s_waitcnt lgkmcnt(0)" ::: "memory");
            }
            if (MODE == 0) { asm volatile("s_waitcnt lgkmcnt(0)" ::: "memory"); }
        }
        if (MODE == 0) E[((size_t)(s * NCH + c) * 16 + g) * 64 + lane] = (f32x2){hr, hi};
        if (MODE == 1 && c == NCH - 1) { const size_t si = ((size_t)(layer * NB + s) * 16 + g) * 64 + lane; a.out[O_SREP + si] = hr; a.out[O_SIMP + si] = hi; }
    }
    if (MODE == 0) __syncthreads();
    if (MODE >= 1) {
        __syncthreads();
        const bf16* WG = (const bf16*)(a.ws + WS_WGLU) + (size_t)layer * MIXW * MIXW;
        f32x4 acc[4][2];
#pragma unroll
        for (int mt = 0; mt < 4; ++mt) { acc[mt][0] = (f32x4){0.f, 0.f, 0.f, 0.f}; acc[mt][1] = (f32x4){0.f, 0.f, 0.f, 0.f}; }
#pragma unroll
        for (int ks = 0; ks < 8; ++ks) {
            const bf16x8 w0 = *(const bf16x8*)(WG + (size_t)(32 * wave + fr) * MIXW + 32 * ks + 8 * fq), w1 = *(const bf16x8*)(WG + (size_t)(32 * wave + 16 + fr) * MIXW + 32 * ks + 8 * fq);
#pragma unroll
            for (int mt = 0; mt < 4; ++mt) { const bf16x8 zb = *(LAS bf16x8*)(Zt + (16 * mt + fr) * 264 + 32 * ks + 8 * fq);
                acc[mt][0] = __builtin_amdgcn_mfma_f32_16x16x32_bf16(w0, zb, acc[mt][0], 0, 0, 0);
                acc[mt][1] = __builtin_amdgcn_mfma_f32_16x16x32_bf16(w1, zb, acc[mt][1], 0, 0, 0); }
        }
#pragma unroll
        for (int nl = 0; nl < 2; ++nl) { const int n0 = 32 * wave + 16 * nl + 4 * fq; const f32x4 bgl = *(const f32x4*)(a.in[I_BGLU] + layer * MIXW + n0);
#pragma unroll
            for (int mt = 0; mt < 4; ++mt) { const int tt = 16 * mt + fr; const v2u zz = *(LAS v2u*)(Zt + tt * 264 + n0);
                const float z0 = bflo(zz.x), z1 = bfhi(zz.x), z2 = bflo(zz.y), z3 = bfhi(zz.y);
                v2u w; w.x = pk2(z0 * sigm(acc[mt][nl][0] + bgl[0]), z1 * sigm(acc[mt][nl][1] + bgl[1])); w.y = pk2(z2 * sigm(acc[mt][nl][2] + bgl[2]), z3 * sigm(acc[mt][nl][3] + bgl[3]));
                *(v2u*)(BR + (size_t)(row0 + tt) * D + 256 + n0) = w; } }
        __syncthreads();
    }
}

__device__ __forceinline__ void gemm2_phase(LAS unsigned char* lds, const bf16* BRp, const bf16* WBT, const bf16* GT, bf16* MG, int G, int bid) {
    using namespace pg8;
    int tid_ = threadIdx.x; asm volatile("" : "+v"(tid_));
    const int tid = tid_, wid = __builtin_amdgcn_readfirstlane(tid >> 6), lane = tid & 63, wr = wid >> 2, wc = wid & 3, fr = lane & 15, fq = lane >> 4;
    unsigned voffA[2], voffB[2];
#pragma unroll
    for (int i = 0; i < 2; ++i) { int R, C; stage_rc(tid * 16 + i * 8192, R, C); const int Rb = (R & ~31) + perm32(R & 31);
        voffA[i] = (unsigned)(R * D + C) * 2u; voffB[i] = (unsigned)(Rb * MIXW + C) * 2u; }
    const unsigned ldsw = (unsigned)wid * 1024u;
    const int aoff = lds_byte(wr * 64 + fr, fq * 8), boff = lds_byte(wc * 32 + fr, fq * 8);
    constexpr int STG = 49152;
#define G2_STAGE(it_, buf_) do { const int kb_ = (it_) >> 2, kt_ = (it_) & 3; \
        const char* as_ = Abase + (size_t)(kb_ * 256 + kt_ * 64) * 2; const char* bs_ = Bbase + (size_t)kb_ * (D * MIXW * 2) + (size_t)kt_ * 128; \
        _Pragma("unroll") for (int _i = 0; _i < 2; ++_i) __builtin_amdgcn_global_load_lds((const unsigned*)(as_ + voffA[_i]), (PG8_LAS unsigned*)(lds + (buf_) * STG + ldsw + _i * 8192), 16, 0, 0); \
        _Pragma("unroll") for (int _i = 0; _i < 2; ++_i) __builtin_amdgcn_global_load_lds((const unsigned*)(bs_ + voffB[_i]), (PG8_LAS unsigned*)(lds + (buf_) * STG + 16384 + ldsw + _i * 8192), 16, 0, 0); \
        _Pragma("unroll") for (int _i = 0; _i < 2; ++_i) __builtin_amdgcn_global_load_lds((const unsigned*)(bs_ + (size_t)128 * MIXW * 2 + voffB[_i]), (PG8_LAS unsigned*)(lds + (buf_) * STG + 32768 + ldsw + _i * 8192), 16, 0, 0); } while (0)
    const int vb = (G % 8 == 0) ? (bid % 8) * (G / 8) + bid / 8 : bid;
    for (int ui = vb; ui < (MP / 128) * 4; ui += G) {
        const int pm = ui >> 2, pn = ui & 3;
        const char* Abase = (const char*)BRp + (size_t)pm * 128 * D * 2;
        const char* Bbase = (const char*)WBT + (size_t)pn * 256 * MIXW * 2;
        f32x4 mg[2][4][2], acc[2][4][2];
#pragma unroll
        for (int b = 0; b < 2; ++b)
#pragma unroll
            for (int m = 0; m < 4; ++m)
#pragma unroll
                for (int n = 0; n < 2; ++n) { mg[b][m][n] = (f32x4){0.f, 0.f, 0.f, 0.f}; acc[b][m][n] = (f32x4){0.f, 0.f, 0.f, 0.f}; }
        v4u gq[2][4];
        G2_STAGE(0, 0);
#pragma unroll 1
        for (int it = 0; it < 16; ++it) {
            const int buf = it & 1;
            if (it + 1 < 16) { G2_STAGE(it + 1, buf ^ 1); asm volatile("s_waitcnt vmcnt(6)" ::: "memory"); } else { asm volatile("s_waitcnt vmcnt(0)" ::: "memory"); }
            __builtin_amdgcn_s_barrier(); asm volatile("" ::: "memory");
#pragma unroll
            for (int kk = 0; kk < 2; ++kk) {
                bf16x8 At[4], B0[2], B1[2];
#pragma unroll
                for (int m = 0; m < 4; ++m) At[m] = *(const PG8_LAS bf16x8*)(lds + buf * STG + aoff + m * 2048 + kk * 1024);
#pragma unroll
                for (int n = 0; n < 2; ++n) { B0[n] = *(const PG8_LAS bf16x8*)(lds + buf * STG + 16384 + boff + n * 2048 + kk * 1024); B1[n] = *(const PG8_LAS bf16x8*)(lds + buf * STG + 32768 + boff + n * 2048 + kk * 1024); }
                asm volatile("s_waitcnt lgkmcnt(0)" ::: "memory"); __builtin_amdgcn_sched_barrier(0);
#pragma unroll
                for (int m = 0; m < 4; ++m)
#pragma unroll
                    for (int n = 0; n < 2; ++n) { acc[0][m][n] = __builtin_amdgcn_mfma_f32_16x16x32_bf16(B0[n], At[m], acc[0][m][n], 0, 0, 0);
                                                  acc[1][m][n] = __builtin_amdgcn_mfma_f32_16x16x32_bf16(B1[n], At[m], acc[1][m][n], 0, 0, 0); }
            }
            if ((it & 3) == 2) {
                const int kb = it >> 2;
#pragma unroll
                for (int b = 0; b < 2; ++b)
#pragma unroll
                    for (int m = 0; m < 4; ++m) asm volatile("global_load_dwordx4 %0, %1, off" : "=v"(gq[b][m]) : "v"(GT + (size_t)(pm * 128 + wr * 64 + m * 16 + fr) * GTC + kb * D + pn * 256 + b * 128 + wc * 32 + 8 * fq) : "memory");
            }
            asm volatile("" ::: "memory"); __builtin_amdgcn_s_barrier(); asm volatile("" ::: "memory");
            if ((it & 3) == 3) {
                asm volatile("" : "+v"(gq[0][0]), "+v"(gq[0][1]), "+v"(gq[0][2]), "+v"(gq[0][3]), "+v"(gq[1][0]), "+v"(gq[1][1]), "+v"(gq[1][2]), "+v"(gq[1][3]));
#pragma unroll
                for (int b = 0; b < 2; ++b)
#pragma unroll
                    for (int m = 0; m < 4; ++m) { float gv[8]; unpack8(gq[b][m], gv);
#pragma unroll
                        for (int j = 0; j < 4; ++j) { mg[b][m][0][j] += gv[j] * acc[b][m][0][j]; mg[b][m][1][j] += gv[4 + j] * acc[b][m][1][j]; }
                        acc[b][m][0] = (f32x4){0.f, 0.f, 0.f, 0.f}; acc[b][m][1] = (f32x4){0.f, 0.f, 0.f, 0.f}; }
            }
        }
#pragma unroll
        for (int b = 0; b < 2; ++b)
#pragma unroll
            for (int m = 0; m < 4; ++m) { const int row = pm * 128 + wr * 64 + m * 16 + fr, col = pn * 256 + b * 128 + wc * 32 + 8 * fq;
                v4u w; w.x = pk2(mg[b][m][0][0], mg[b][m][0][1]); w.y = pk2(mg[b][m][0][2], mg[b][m][0][3]); w.z = pk2(mg[b][m][1][0], mg[b][m][1][1]); w.w = pk2(mg[b][m][1][2], mg[b][m][1][3]);
                *(v4u*)(MG + (size_t)row * D + col) = w; }
    }
#undef G2_STAGE
}


#define TL_GLDS(src_, dst_) __builtin_amdgcn_global_load_lds((const unsigned*)(src_), (PG8_LAS unsigned*)(dst_), 16, 0, 0)
#define TL_STAGE(kt_, A_PTR, B_PTR) do { const int s_ = (kt_) % 3; const char* ap_ = A_PTR(kt_); const char* bp_ = B_PTR(kt_); \
        TL_GLDS(ap_ + voffA, lds + s_ * 32768 + ldsw); TL_GLDS(ap_ + voffA + 128, lds + s_ * 32768 + 8192 + ldsw); \
        TL_GLDS(bp_ + voffB, lds + s_ * 32768 + 16384 + ldsw); TL_GLDS(bp_ + voffB + 128, lds + s_ * 32768 + 24576 + ldsw); } while (0)
#define TL_LOOP(NK, A_PTR, B_PTR, AFTER_STEP) do { \
        TL_STAGE(0, A_PTR, B_PTR); if ((NK) > 1) TL_STAGE(1, A_PTR, B_PTR); \
        _Pragma("unroll 1") for (int kt = 0; kt < (NK); ++kt) { \
            if (kt + 1 < (NK)) asm volatile("s_waitcnt vmcnt(4)" ::: "memory"); else asm volatile("s_waitcnt vmcnt(0)" ::: "memory"); \
            __builtin_amdgcn_s_barrier(); asm volatile("" ::: "memory"); \
            if (kt + 2 < (NK)) TL_STAGE(kt + 2, A_PTR, B_PTR); \
            const int sb_ = (kt % 3) * 32768; \
            _Pragma("unroll") for (int h_ = 0; h_ < 2; ++h_) { \
                const bf16x8 a0 = *(const PG8_LAS bf16x8*)(lds + sb_ + h_ * 8192 + aoff), a1 = *(const PG8_LAS bf16x8*)(lds + sb_ + h_ * 8192 + aoff + 1024); \
                const bf16x8 b00 = *(const PG8_LAS bf16x8*)(lds + sb_ + 16384 + h_ * 8192 + boff), b01 = *(const PG8_LAS bf16x8*)(lds + sb_ + 16384 + h_ * 8192 + boff + 1024); \
                const bf16x8 b10 = *(const PG8_LAS bf16x8*)(lds + sb_ + 16384 + h_ * 8192 + boff + 2048), b11 = *(const PG8_LAS bf16x8*)(lds + sb_ + 16384 + h_ * 8192 + boff + 3072); \
                asm volatile("s_waitcnt lgkmcnt(0)" ::: "memory"); __builtin_amdgcn_sched_barrier(0); \
                acc[0] = __builtin_amdgcn_mfma_f32_16x16x32_bf16(b00, a0, acc[0], 0, 0, 0); acc[1] = __builtin_amdgcn_mfma_f32_16x16x32_bf16(b10, a0, acc[1], 0, 0, 0); \
                acc[0] = __builtin_amdgcn_mfma_f32_16x16x32_bf16(b01, a1, acc[0], 0, 0, 0); acc[1] = __builtin_amdgcn_mfma_f32_16x16x32_bf16(b11, a1, acc[1], 0, 0, 0); } \
            AFTER_STEP(kt); } \
        asm volatile("s_waitcnt lgkmcnt(0)" ::: "memory"); __builtin_amdgcn_s_barrier(); asm volatile("" ::: "memory"); } while (0)
#define TL_SETUP(LDA, LDB) using namespace pg8; int tid_ = threadIdx.x; asm volatile("" : "+v"(tid_)); \
    const int tid = tid_, wid = __builtin_amdgcn_readfirstlane(tid >> 6), lane = tid & 63, fr = lane & 15, fq = lane >> 4, mt = wid >> 1, nh = wid & 1; \
    int R_, C_; stage_rc(tid * 16, R_, C_); \
    const unsigned voffA = (unsigned)(R_ * (LDA) + C_) * 2u, voffB = (unsigned)(R_ * (LDB) + C_) * 2u, ldsw = (unsigned)wid * 1024u; \
    const int aoff = lds_byte(mt * 16 + fr, fq * 8), boff = lds_byte(nh * 32 + fr, fq * 8); (void)lane
#define TL_NOP(kt_) do {} while (0)

struct CappedOrder : pg8::StaticOrder {
    int cap;
    __device__ bool next(int i, pg8::Unit& u) const { if ((long)i * G + c >= cap) return false; return pg8::StaticOrder::next(i, u); }
};
__device__ __forceinline__ void proj_tail_phase(LAS unsigned char* lds, const bf16* A, const bf16* Bt, int cap, const float* ssq, const float* bgate, bf16* PMp, bf16* GTp, int G, int bid) {
    TL_SETUP(D, D);
    StaticOrder S1; S1.init(M, INC, 1, 0);
    const int nsub = (S1.nwg - cap) * 16;
    for (int t = bid; t < nsub; t += G) {
        Unit u; S1.next(cap + (t >> 4), u);
        const int rb = (t >> 2) & 3, cb = t & 3, r0 = u.pm * 256 + 64 * rb, c0 = u.pn * 256 + 64 * cb;
        const char* Ab = (const char*)A + (size_t)r0 * D * 2; const char* Bb = (const char*)Bt + (size_t)c0 * D * 2;
        f32x4 acc[2] = {(f32x4){0.f, 0.f, 0.f, 0.f}, (f32x4){0.f, 0.f, 0.f, 0.f}};
#define PT_A(kt_) (Ab + (size_t)(kt_) * 256)
#define PT_B(kt_) (Bb + (size_t)(kt_) * 256)
        TL_LOOP(D / 128, PT_A, PT_B, TL_NOP);
#undef PT_A
#undef PT_B
        const int row = r0 + 16 * mt + fr;
        const float rs = pg8::row_rstd(ssq, row);
        const bool isg = u.pn >= 7;
#pragma unroll
        for (int n = 0; n < 2; ++n) { const int col = c0 + 32 * nh + 16 * n + 4 * fq; f32x4 v = acc[n] * rs;
            if (isg) { const f32x4 bv = *(const f32x4*)(bgate + (col - PMC)); v = (f32x4){::sigm(v[0] + bv[0]), ::sigm(v[1] + bv[1]), ::sigm(v[2] + bv[2]), ::sigm(v[3] + bv[3])}; }
            v2u w; w.x = pk2(v[0], v[1]); w.y = pk2(v[2], v[3]);
            if (isg) *(v2u*)(GTp + (size_t)row * GTC + (col - PMC)) = w; else *(v2u*)(PMp + (size_t)row * PMC + col) = w; }
    }
}

__device__ __forceinline__ void gemm2_tail_phase(LAS unsigned char* lds, const bf16* BRp, const bf16* WBT, const bf16* GT, bf16* MG, int G, int bid) {
    TL_SETUP(D, MIXW);
    for (int ui = bid; ui < 256; ui += G) {
        const int rb = ui >> 4, cb = ui & 15;
        const char* Ab = (const char*)BRp + (size_t)(MP + 64 * rb) * D * 2; const char* Bb = (const char*)WBT + (size_t)(64 * cb) * MIXW * 2;
        f32x4 acc[2] = {(f32x4){0.f, 0.f, 0.f, 0.f}, (f32x4){0.f, 0.f, 0.f, 0.f}}, mg[2] = {(f32x4){0.f, 0.f, 0.f, 0.f}, (f32x4){0.f, 0.f, 0.f, 0.f}};
        const int row = MP + 64 * rb + 16 * mt + fr;
#define G2T_A(kt_) (Ab + (size_t)(((kt_) >> 1) * 256 + ((kt_) & 1) * 128) * 2)
#define G2T_B(kt_) (Bb + (size_t)((kt_) >> 1) * (D * MIXW * 2) + (size_t)((kt_) & 1) * 256)
#define G2T_AFTER(kt_) do { if ((kt_) & 1) { const int kb_ = (kt_) >> 1; \
            _Pragma("unroll") for (int n = 0; n < 2; ++n) { const v2u gw = *(const v2u*)(GT + (size_t)row * GTC + kb_ * D + 64 * cb + 32 * nh + 16 * n + 4 * fq); \
                mg[n][0] += bflo(gw.x) * acc[n][0]; mg[n][1] += bfhi(gw.x) * acc[n][1]; mg[n][2] += bflo(gw.y) * acc[n][2]; mg[n][3] += bfhi(gw.y) * acc[n][3]; \
                acc[n] = (f32x4){0.f, 0.f, 0.f, 0.f}; } } } while (0)
        TL_LOOP(8, G2T_A, G2T_B, G2T_AFTER);
#undef G2T_A
#undef G2T_B
#undef G2T_AFTER
#pragma unroll
        for (int n = 0; n < 2; ++n) { v2u w; w.x = pk2(mg[n][0], mg[n][1]); w.y = pk2(mg[n][2], mg[n][3]); *(v2u*)(MG + (size_t)row * D + 64 * cb + 32 * nh + 16 * n + 4 * fq) = w; }
    }
}

__device__ __forceinline__ void resid_tail_phase(LAS unsigned char* lds, const bf16* A, const bf16* Bt, int K, const float* xs_old, float* xo, bf16* XBp, float* ssq, int G, int bid) {
    TL_SETUP(K, K);
    const int nk = K / 128;
    for (int ui = bid; ui < 256; ui += G) {
        const int rb = ui >> 4, cb = ui & 15;
        const char* Ab = (const char*)A + (size_t)(MP + 64 * rb) * K * 2; const char* Bb = (const char*)Bt + (size_t)(64 * cb) * K * 2;
        f32x4 acc[2] = {(f32x4){0.f, 0.f, 0.f, 0.f}, (f32x4){0.f, 0.f, 0.f, 0.f}};
#define RT_A(kt_) (Ab + (size_t)(kt_) * 256)
#define RT_B(kt_) (Bb + (size_t)(kt_) * 256)
        TL_LOOP(nk, RT_A, RT_B, TL_NOP);
#undef RT_A
#undef RT_B
        const int rowl = 16 * mt + fr, row = MP + 64 * rb + rowl; float ss = 0.f;
#pragma unroll
        for (int n = 0; n < 2; ++n) { const int col = 64 * cb + 32 * nh + 16 * n + 4 * fq;
            const f32x4 o = *(const f32x4*)(xs_old + (size_t)(row - MP) * D + col) + acc[n];
            *(f32x4*)(xo + (size_t)row * D + col) = o;
            v2u w; w.x = pk2(o[0], o[1]); w.y = pk2(o[2], o[3]); *(v2u*)(XBp + (size_t)row * D + col) = w;
            ss += (o[0] * o[0] + o[1] * o[1]) + (o[2] * o[2] + o[3] * o[3]); }
        ss += __shfl_xor(ss, 16); ss += __shfl_xor(ss, 32);
        LAS float* red = (LAS float*)lds;
        if (fq == 0) red[rowl * 2 + nh] = ss;
        __syncthreads();
        if (tid < 64) ssq[((size_t)(cb >> 2) * M + MP + 64 * rb + tid) * 4 + (cb & 3)] = red[tid * 2] + red[tid * 2 + 1];
        __syncthreads();
    }
}

#ifndef PROBE_REP_B
#define PROBE_REP_B 1
#endif
#ifndef PROBE_REP_C
#define PROBE_REP_C 1
#endif
#ifndef PROBE_REP_D
#define PROBE_REP_D 1
#endif
#ifndef PROBE_REP_P0
#define PROBE_REP_P0 1
#endif
__global__ void __launch_bounds__(NWAVES * 64, 2) hybrid_fwd(Args args) {
    extern __shared__ __attribute__((aligned(16))) unsigned char lds_raw[];
    LAS unsigned char* lds = (LAS unsigned char*)lds_raw;
    volatile LAS unsigned* MISC = (volatile LAS unsigned*)(lds + MISC_OFF);
    const int tid0 = threadIdx.x;
    const int G = gridDim.x, bid = blockIdx.x;
    unsigned char* ws = args.ws;
    for (int u = tid0; u < (LDS_BYTES - LDSCTL_OFF) / 4; u += NWAVES * 64) ((LAS unsigned*)(lds + LDSCTL_OFF))[u] = 0u;
    __syncthreads();
    const int lo = args.ph_lo, hi = args.ph_hi;
    XcdBarrier bar; bar.bar = (unsigned*)(ws + WS_CTL) + CW_BAR; bar.x = 0; bar.st = nullptr;
    if (hi - lo > 1) bar = xcd_barrier_post((unsigned*)(ws + WS_CTL) + CW_BAR, MISC + 8);
    bf16* XB = (bf16*)(ws + WS_ACT1); bf16* PMb = (bf16*)(ws + WS_PM); bf16* GTb = (bf16*)(ws + WS_GT);
    bf16* MGb = (bf16*)(ws + WS_PM); bf16* ACTb = (bf16*)(ws + WS_GT);
    float* ssq = (float*)(ws + WS_SSQ);
    for (int ph_i = lo; ph_i < hi; ++ph_i) {
        int ph = ph_i; asm volatile("" : "+s"(ph));
        int tid = tid0; asm volatile("" : "+v"(tid)); const int lane = tid & 63, wave = __builtin_amdgcn_readfirstlane(tid >> 6);
        const int layer = (ph - 1) / 7, k = ph == 0 ? -1 : (ph == NPHASE - 1 ? 7 : (ph - 1) % 7);
        if (k == -1) for (int rep_ = 0; rep_ < PROBE_REP_P0; ++rep_) p0_prologue(args, lds, tid, lane, wave, G, bid);
        else if (k == 7) final_norm(args, lane, wave, G, bid);
        else if (k == 0) {
            pg8::Gemm g{XB, (const bf16*)(ws + WS_WIN) + (size_t)layer * INC * D, M, INC, D}; CappedOrder S; S.init(M, INC, G, bid); S.cap = (S.nwg / G) * G;
            pg8::EpiProj E{PMb, GTb, ssq, args.in[I_BGATE] + (size_t)layer * GTC};
            pg8::gemm_phase<pg8::EpiProj, CappedOrder, true, true>(lds + RING_OFF, g, S, E);
            proj_tail_phase(lds + RING_OFF, XB, (const bf16*)(ws + WS_WIN) + (size_t)layer * INC * D, S.cap, ssq, args.in[I_BGATE] + (size_t)layer * GTC, PMb, GTb, G, bid);
#ifdef PROBE_A_SAME
            { SameTileOrder S2; S2.init(M, INC, G, bid); pg8::EpiNull EN_; pg8::gemm_phase<pg8::EpiNull, SameTileOrder, true, true>(lds + RING_OFF, g, S2, EN_); }
#endif
#ifdef PROBE_A_NULL
            { pg8::EpiNull EN_; pg8::gemm_phase<pg8::EpiNull, CappedOrder, true, true>(lds + RING_OFF, g, S, EN_); }
#endif
#ifdef PROBE_A_FULL
            pg8::gemm_phase<pg8::EpiProj, CappedOrder, true, true>(lds + RING_OFF, g, S, E);
#endif
        } else if (k == 1) for (int rep_ = 0; rep_ < PROBE_REP_B; ++rep_) {
            for (int u = bid; u < 256 + 16 + 256 + 64; u += G) {
                if (u < 256) { if ((u & 31) != NCH - 1) ssm_unit<0>(args, layer, u, lds, tid, lane, wave); }
                else if (u < 272) ssm_unit<2>(args, layer, u - 256, lds, tid, lane, wave);
                else if (u < 528) mix_unit<false>(args, layer, u - 272, lds, tid, lane, wave);
                else mix_unit<true>(args, layer, u - 528, lds, tid, lane, wave);
            }
        } else if (k == 2) for (int rep_ = 0; rep_ < PROBE_REP_C; ++rep_) {
            for (int u = bid; u < 256; u += G) ssm_unit<1>(args, layer, u, lds, tid, lane, wave);
        } else if (k == 3) for (int rep_ = 0; rep_ < PROBE_REP_D; ++rep_) {
            gemm2_phase(lds + RING_OFF, XB, (const bf16*)(ws + WS_WBR) + (size_t)layer * 4 * D * MIXW, GTb, MGb, G, bid);
            gemm2_tail_phase(lds + RING_OFF, XB, (const bf16*)(ws + WS_WBR) + (size_t)layer * 4 * D * MIXW, GTb, MGb, G, bid);
        } else if (k == 5) {
            pg8::Gemm g{XB, (const bf16*)(ws + WS_WFI) + (size_t)layer * 2 * FF * D, M, 2 * FF, D}; pg8::StaticOrder S; S.init(M, 2 * FF, G, bid);
            pg8::EpiSwiGLU E{ACTb, ssq};
            pg8::gemm_phase<pg8::EpiSwiGLU, pg8::StaticOrder, true, true>(lds + RING_OFF, g, S, E);
        } else {
            const bool isE = k == 4; const int K = isE ? D : FF;
            const bf16* Ap = isE ? MGb : ACTb; const bf16* Bp = isE ? (const bf16*)(ws + WS_WOUT) + (size_t)layer * D * D : (const bf16*)(ws + WS_WFO) + (size_t)layer * D * FF;
            const bool first = isE && layer == 0;
            const float* xp = first ? args.in[I_XP] : args.out; const float* xs = first ? args.in[I_XS] : args.out + (size_t)MP * D;
            pg8::Gemm g{Ap, Bp, MP, D, K}; pg8::StaticOrder S; S.init(MP, D, G, bid);
            pg8::EpiResid E{xp, xs, args.out, XB, ssq};
            pg8::gemm_phase<pg8::EpiResid, pg8::StaticOrder, true, true>(lds + RING_OFF, g, S, E);
            resid_tail_phase(lds + RING_OFF, Ap, Bp, K, xs, args.out, XB, ssq, G, bid);
        }
        if (ph_i + 1 < hi) xcd_barrier(bar);
    }
}

extern "C" void kernel_launch(void* const* d_in, const int* in_sizes, int n_in, void* d_out, int out_size, void* d_ws, size_t ws_size, hipStream_t stream) {
    static int grid = 0;
    if (grid == 0) {
        if (n_in != 32 || out_size != (int)O_END || ws_size < WS_END) { fprintf(stderr, "kernel_launch: expected 32 inputs, %zu outputs, >= %zu bytes of workspace; got %d, %d, %zu; nothing launched\n", (size_t)O_END, (size_t)WS_END, n_in, out_size, ws_size); grid = -1; return; }
        int dev = 0, cus = 0, per_cu = 0;
        if (hipGetDevice(&dev) != hipSuccess || hipDeviceGetAttribute(&cus, hipDeviceAttributeMultiprocessorCount, dev) != hipSuccess) { grid = -1; return; }
        if (hipFuncSetAttribute((const void*)hybrid_fwd, hipFuncAttributeMaxDynamicSharedMemorySize, LDS_BYTES) != hipSuccess) { fprintf(stderr, "kernel_launch: hipFuncSetAttribute failed\n"); grid = -1; return; }
        if (hipOccupancyMaxActiveBlocksPerMultiprocessor(&per_cu, (const void*)hybrid_fwd, NWAVES * 64, LDS_BYTES) != hipSuccess || per_cu < 1) { fprintf(stderr, "kernel_launch: occupancy query says %d blocks per CU; nothing launched\n", per_cu); (void)hipGetLastError(); grid = -1; return; }
        grid = cus;
    }
    if (grid < 0) return;
    (void)hipMemsetAsync((char*)d_ws + WS_CTL, 0, CTL_ZERO_BYTES, stream);
    Args a{};
    for (int i = 0; i < 32; ++i) a.in[i] = (const float*)d_in[i];
    a.out = (float*)d_out; a.ws = (unsigned char*)d_ws;
#if MK_PER_PHASE
    for (int k = 0; k < NPHASE; ++k) { a.ph_lo = k; a.ph_hi = k + 1; hipLaunchKernelGGL(hybrid_fwd, dim3(grid), dim3(NWAVES * 64), LDS_BYTES, stream, a); }
#else
    a.ph_lo = 0; a.ph_hi = NPHASE;
    hipLaunchKernelGGL(hybrid_fwd, dim3(grid), dim3(NWAVES * 64), LDS_BYTES, stream, a);
#endif
}
```

```cpp
#include <hip/hip_runtime.h>
#include <cstdio>
#include <cstdint>
#ifndef XPF_LEAD
#define XPF_LEAD 2
#endif
namespace pg8 {
#define PG8_LAS __attribute__((address_space(3)))
typedef unsigned short bf16_t;
typedef short bf16x8 __attribute__((ext_vector_type(8)));
typedef float f32x4 __attribute__((ext_vector_type(4)));
typedef unsigned u32x4 __attribute__((ext_vector_type(4)));
constexpr int BM = 256, BK = 64, HALF = 128, HTB = HALF * BK * 2  , STAGE_BYTES = 8 * HTB, NXCD = 8, WGM = 8, RSTD_LDS_OFF = 147456 + 320 + 1024  , RSTD_RAW_OFF = RSTD_LDS_OFF + 1024  , BIAS_LDS_OFF = RSTD_RAW_OFF + 8192  ;

__host__ __device__ __forceinline__ int lds_byte(int r, int c) { const int st = (r >> 4) * 2 + (c >> 5), rr = r & 15, cc = c & 31, ob = rr * 64 + cc * 2; return st * 1024 + (ob ^ (((ob >> 9) & 1) << 5)); }
__host__ __device__ __forceinline__ void stage_rc(int b, int& R, int& C) { const int st = b / 1024, sb = b % 1024, swz = sb ^ (((sb >> 9) & 1) << 5); R = (st >> 1) * 16 + swz / 64; C = (st & 1) * 32 + (swz % 64) / 2; }
__host__ __device__ __forceinline__ int perm32(int rho) { const int n = rho >> 4, i = rho & 15; return 8 * (i >> 2) + 4 * n + (i & 3); }

struct Unit { int pm, pn; };
struct Gemm { const bf16_t* A; const bf16_t* Bt; int M, N, K; };

struct StaticOrder {
    int nM, nN, nwg, G, c;
    __host__ __device__ void init(int M, int N, int G_, int c_) { nM = M / BM; nN = N / BM; nwg = nM * nN; G = G_; c = c_; }
    __host__ __device__ bool next(int i, Unit& u) const {
        const long L = (long)i * G + c; if (L >= nwg) return false;
        int wgid = (int)L; { const int q = nwg / NXCD, r = nwg % NXCD, xcd = wgid % NXCD, off = wgid / NXCD; wgid = (xcd < r ? xcd * (q + 1) : r * (q + 1) + (xcd - r) * q) + off; }
        const int nig = WGM * nN, gid = wgid / nig, fm = gid * WGM, gsz = (nM - fm) < WGM ? (nM - fm) : WGM;
        u.pm = fm + ((wgid % nig) % gsz); u.pn = (wgid % nig) / gsz; return true;
    }
    __device__ __forceinline__ void a_ready(const Unit&) const {}
    __device__ __forceinline__ void done(const Unit&) const {}
};
typedef float f32x2 __attribute__((ext_vector_type(2)));
typedef __bf16 bf16x2_t __attribute__((ext_vector_type(2)));
__device__ __forceinline__ unsigned cvt_pk_bf16(float lo, float hi) { f32x2 v = {lo, hi}; bf16x2_t b = __builtin_convertvector(v, bf16x2_t); return __builtin_bit_cast(unsigned, b); }
__device__ __forceinline__ float sigm(float x) { return __builtin_amdgcn_rcpf(1.0f + __builtin_amdgcn_exp2f(-1.4426950408889634f * x)); }
__device__ __forceinline__ float row_rstd(const float* ssq, int row) {
    const f32x4 a = *(const f32x4*)(ssq + ((size_t)0 * 17408 + row) * 4), b = *(const f32x4*)(ssq + ((size_t)1 * 17408 + row) * 4),
                c = *(const f32x4*)(ssq + ((size_t)2 * 17408 + row) * 4), d = *(const f32x4*)(ssq + ((size_t)3 * 17408 + row) * 4);
    const float s = (((a[0] + a[1]) + (a[2] + a[3])) + ((b[0] + b[1]) + (b[2] + b[3]))) + (((c[0] + c[1]) + (c[2] + c[3])) + ((d[0] + d[1]) + (d[2] + d[3])));
    return __builtin_amdgcn_rsqf(s * (1.0f / 1024.0f) + 1e-6f);
}
__device__ __forceinline__ void rows_rstd(const float* ssq, int row0, int fq, float (&rs)[2][4]) {
#pragma unroll
    for (int ai = 0; ai < 2; ++ai)
#pragma unroll
        for (int m = 0; m < 4; ++m) { const f32x4 p = *(const f32x4*)(ssq + ((size_t)fq * 17408 + row0 + ai * HALF + m * 16) * 4); rs[ai][m] = (p[0] + p[1]) + (p[2] + p[3]); }
#pragma unroll
    for (int ai = 0; ai < 2; ++ai)
#pragma unroll
        for (int m = 0; m < 4; ++m) { float s = rs[ai][m]; s += __shfl_xor(s, 16); s += __shfl_xor(s, 32); rs[ai][m] = __builtin_amdgcn_rsqf(s * (1.0f / 1024.0f) + 1e-6f); }
}
__device__ __forceinline__ void rows_rstd_lds(const PG8_LAS float* rl, int r0, float (&rs)[2][4]) {
#pragma unroll
    for (int ai = 0; ai < 2; ++ai)
#pragma unroll
        for (int m = 0; m < 4; ++m) rs[ai][m] = rl[r0 + ai * HALF + m * 16];
}
struct EpiNull {
    static constexpr bool PERM = true, AFTER_DRAIN = false, RSTD_LDS = false, XPREFETCH = false;
    __device__ __forceinline__ void operator()(const f32x4 (&acc)[2][2][4][2], const Unit& u, int wr, int wc, int fr, int fq) const {
#pragma unroll
        for (int ai = 0; ai < 2; ++ai)
#pragma unroll
            for (int bj = 0; bj < 2; ++bj)
#pragma unroll
                for (int m = 0; m < 4; ++m) { asm volatile("" :: "v"(acc[ai][bj][m][0]), "v"(acc[ai][bj][m][1])); }
    }
};
struct EpiProj {
    static constexpr bool PERM = true, AFTER_DRAIN = false, RSTD_LDS = true, XPREFETCH = false;
    bf16_t* PM; bf16_t* GT; const float* ssq; const float* bgate; const PG8_LAS float* rl;
    __device__ __forceinline__ void operator()(const f32x4 (&acc)[2][2][4][2], const Unit& u, int wr, int wc, int fr, int fq) const {
        const int row0 = u.pm * BM + wr * 64 + fr;
        const bool isg = u.pn >= 7;
        const int lc0 = (isg ? (u.pn - 7) * BM : u.pn * BM) + wc * 32 + 8 * fq;
        bf16_t* base = isg ? GT : PM; const int ldc = isg ? 4096 : 1792;
        constexpr float NL2E = -1.4426950408889634f;
        f32x4 bv[2][2];
#pragma unroll
        for (int bj = 0; bj < 2; ++bj)
#pragma unroll
            for (int n = 0; n < 2; ++n) bv[bj][n] = isg ? *(const f32x4*)(bgate + lc0 + bj * HALF + 4 * n) * NL2E : (f32x4){0.f, 0.f, 0.f, 0.f};
        float rsv[2][4]; rows_rstd_lds(rl, wr * 64 + fr, rsv);
#pragma unroll
        for (int ai = 0; ai < 2; ++ai)
#pragma unroll
            for (int m = 0; m < 4; ++m) { const int row = row0 + ai * HALF + m * 16;
                const float rs = isg ? rsv[ai][m] * NL2E : rsv[ai][m];
                bf16_t* rowp = base + (size_t)row * ldc + lc0;
#pragma unroll
                for (int bj = 0; bj < 2; ++bj) { f32x4 v0 = acc[ai][bj][m][0] * rs + bv[bj][0], v1 = acc[ai][bj][m][1] * rs + bv[bj][1];
                    if (isg) {
#pragma unroll
                        for (int j = 0; j < 4; ++j) { v0[j] = __builtin_amdgcn_rcpf(1.0f + __builtin_amdgcn_exp2f(v0[j])); v1[j] = __builtin_amdgcn_rcpf(1.0f + __builtin_amdgcn_exp2f(v1[j])); } }
                    u32x4 w; w.x = cvt_pk_bf16(v0[0], v0[1]); w.y = cvt_pk_bf16(v0[2], v0[3]); w.z = cvt_pk_bf16(v1[0], v1[1]); w.w = cvt_pk_bf16(v1[2], v1[3]);
                    *(u32x4*)(rowp + bj * HALF) = w; } }
    }
};
struct EpiResid {
    static constexpr bool PERM = true, AFTER_DRAIN = false, RSTD_LDS = false, XPREFETCH = true;
    const float* xp; const float* xs; bool first; bf16_t* XB; float* ssq;
    __device__ __forceinline__ void prefetch(const Unit& u, PG8_LAS unsigned char* dump, int tid) const {
        if (first) return;
        const unsigned vo = (unsigned)(tid >> 2) * 2048u + (unsigned)(tid & 3) * 128u;
        const char* base = (const char*)(XB + (size_t)u.pm * BM * 1024 + u.pn * BM);
        __builtin_amdgcn_global_load_lds((const unsigned*)(base + vo), (PG8_LAS unsigned*)dump, 4, 0, 0);
        __builtin_amdgcn_global_load_lds((const unsigned*)(base + (size_t)128 * 2048 + vo), (PG8_LAS unsigned*)dump, 4, 0, 0);
    }
    __device__ __forceinline__ void operator()(const f32x4 (&acc)[2][2][4][2], const Unit& u, int wr, int wc, int fr, int fq) const {
        const int row0 = u.pm * BM + wr * 64 + fr, col0 = u.pn * BM + wc * 32 + 8 * fq;
#pragma unroll
        for (int ai = 0; ai < 2; ++ai)
#pragma unroll
            for (int m = 0; m < 4; ++m) { const int row = row0 + ai * HALF + m * 16;
                bf16_t* dstb = XB + (size_t)row * 1024 + col0; float ss = 0.f;
                f32x4 x0[2], x1[2];
                if (first) { const float* src = (row < 16384 ? xp + (size_t)row * 1024 : xs + (size_t)(row - 16384) * 1024) + col0;
#pragma unroll
                    for (int bj = 0; bj < 2; ++bj) { x0[bj] = *(const f32x4*)(src + bj * HALF); x1[bj] = *(const f32x4*)(src + bj * HALF + 4); } }
                else {
#pragma unroll
                    for (int bj = 0; bj < 2; ++bj) { const u32x4 q = *(const u32x4*)(dstb + bj * HALF);
                        x0[bj] = (f32x4){__builtin_bit_cast(float, q.x << 16), __builtin_bit_cast(float, q.x & 0xffff0000u), __builtin_bit_cast(float, q.y << 16), __builtin_bit_cast(float, q.y & 0xffff0000u)};
                        x1[bj] = (f32x4){__builtin_bit_cast(float, q.z << 16), __builtin_bit_cast(float, q.z & 0xffff0000u), __builtin_bit_cast(float, q.w << 16), __builtin_bit_cast(float, q.w & 0xffff0000u)}; } }
#pragma unroll
                for (int bj = 0; bj < 2; ++bj) { const f32x4 o0 = x0[bj] + acc[ai][bj][m][0], o1 = x1[bj] + acc[ai][bj][m][1];
                    u32x4 w; w.x = cvt_pk_bf16(o0[0], o0[1]); w.y = cvt_pk_bf16(o0[2], o0[3]); w.z = cvt_pk_bf16(o1[0], o1[1]); w.w = cvt_pk_bf16(o1[2], o1[3]);
                    *(u32x4*)(dstb + bj * HALF) = w;
                    ss += ((o0[0] * o0[0] + o0[1] * o0[1]) + (o0[2] * o0[2] + o0[3] * o0[3])) + ((o1[0] * o1[0] + o1[1] * o1[1]) + (o1[2] * o1[2] + o1[3] * o1[3])); }
                ss += __shfl_xor(ss, 16); ss += __shfl_xor(ss, 32);
                if (fq == 0) ssq[((size_t)u.pn * 17408 + row) * 4 + wc] = ss; }
    }
};
struct EpiSwiGLU {
    static constexpr bool PERM = true, AFTER_DRAIN = false, RSTD_LDS = true, XPREFETCH = false;
    bf16_t* ACT; const float* ssq; const PG8_LAS float* rl;
    __device__ __forceinline__ void operator()(const f32x4 (&acc)[2][2][4][2], const Unit& u, int wr, int wc, int fr, int fq) const {
        const int row0 = u.pm * BM + wr * 64 + fr, col0 = u.pn * HALF + wc * 32 + 8 * fq;
        float rsv[2][4]; rows_rstd_lds(rl, wr * 64 + fr, rsv);
#pragma unroll
        for (int ai = 0; ai < 2; ++ai)
#pragma unroll
            for (int m = 0; m < 4; ++m) { const int row = row0 + ai * HALF + m * 16;
                const float rs = rsv[ai][m], rsn = rs * -1.4426950408889634f, rs2 = rs * rs;
                float o[8];
#pragma unroll
                for (int j = 0; j < 4; ++j) { const float a0 = acc[ai][0][m][0][j], a1 = acc[ai][0][m][1][j];
                    o[j] = (a0 * acc[ai][1][m][0][j]) * (__builtin_amdgcn_rcpf(1.0f + __builtin_amdgcn_exp2f(a0 * rsn)) * rs2); o[4 + j] = (a1 * acc[ai][1][m][1][j]) * (__builtin_amdgcn_rcpf(1.0f + __builtin_amdgcn_exp2f(a1 * rsn)) * rs2); }
                u32x4 w; w.x = cvt_pk_bf16(o[0], o[1]); w.y = cvt_pk_bf16(o[2], o[3]); w.z = cvt_pk_bf16(o[4], o[5]); w.w = cvt_pk_bf16(o[6], o[7]);
                *(u32x4*)(ACT + (size_t)row * 2816 + col0) = w; }
    }
};

template <class Epi, class Sched, bool ALIGN_EPI = false, bool SP2 = false>
__device__ __forceinline__ void gemm_phase(PG8_LAS unsigned char* lds, const Gemm g, const Sched& S, const Epi& E, int tidp) {
    int tid_ = tidp; asm volatile("" : "+v"(tid_));
    const int tid = tid_, wid = __builtin_amdgcn_readfirstlane(tid >> 6), lane = tid & 63, wr = wid >> 2, wc = wid & 3, fr = lane & 15, fq = lane >> 4;
    const int K = g.K, nt = K / BK;
    unsigned voffA[2], voffB[2];
#pragma unroll
    for (int i = 0; i < 2; ++i) { int R, C; stage_rc(tid * 16 + i * 8192, R, C); const int Rb = Epi::PERM ? ((R & ~31) + perm32(R & 31)) : R;
        voffA[i] = (unsigned)(R * K + C) * 2u; voffB[i] = (unsigned)(Rb * K + C) * 2u; }
    const size_t kstep = (size_t)(BK * 2);
    const size_t hstep = (size_t)HALF * K * 2;
    const size_t tstep = 2 * hstep;
    const unsigned ldsw = (unsigned)wid * 1024u;
    const int aoff = lds_byte(wr * 64 + fr, fq * 8), boff = lds_byte(wc * 32 + fr, fq * 8);
#define PG8_SA(b, h) (((b) * 2 + (h)) * HTB)
#define PG8_SB(b, h) ((4 + (b) * 2 + (h)) * HTB)
#define PG8_STAGE(bufoff, gbase, voff) do { _Pragma("unroll") for (int _i = 0; _i < 2; ++_i) \
        __builtin_amdgcn_global_load_lds((const unsigned*)((const char*)(gbase) + (voff)[_i]), (PG8_LAS unsigned*)(lds + (bufoff) + ldsw + _i * 8192), 16, 0, 0); } while (0)
#define PG8_LDA(dst, b, h) do { _Pragma("unroll") for (int m = 0; m < 4; ++m) _Pragma("unroll") for (int k = 0; k < 2; ++k) dst[m][k] = *(const PG8_LAS bf16x8*)(lds + PG8_SA(b, h) + aoff + m * 2048 + k * 1024); } while (0)
#define PG8_LDB(dst, b, h) do { _Pragma("unroll") for (int n = 0; n < 2; ++n) _Pragma("unroll") for (int k = 0; k < 2; ++k) dst[n][k] = *(const PG8_LAS bf16x8*)(lds + PG8_SB(b, h) + boff + n * 2048 + k * 1024); } while (0)
#define PG8_MMA(ai, bj, At, Bt) do { __builtin_amdgcn_s_setprio(1); _Pragma("unroll") for (int m = 0; m < 4; ++m) _Pragma("unroll") for (int n = 0; n < 2; ++n) _Pragma("unroll") for (int k = 0; k < 2; ++k) \
        acc[ai][bj][m][n] = __builtin_amdgcn_mfma_f32_16x16x32_bf16(Bt[n][k], At[m][k], acc[ai][bj][m][n], 0, 0, 0); __builtin_amdgcn_s_setprio(0); } while (0)
#define PG8_WAIT_V(n) asm volatile("s_waitcnt vmcnt(" #n ")" ::: "memory")
#define PG8_WAIT_L(n) asm volatile("s_waitcnt lgkmcnt(" #n ")" ::: "memory")
#define PG8_BAR __builtin_amdgcn_s_barrier()
#define PG8_SCHED __builtin_amdgcn_sched_barrier(0)
    Unit cur, nxt; int ui = 0;
    if (!S.next(0, cur)) return;
    f32x4 acc[2][2][4][2];
#pragma unroll
    for (int a = 0; a < 2; ++a)
#pragma unroll
        for (int b = 0; b < 2; ++b)
#pragma unroll
            for (int m = 0; m < 4; ++m)
#pragma unroll
                for (int n = 0; n < 2; ++n) acc[a][b][m][n] = (f32x4){0.f, 0.f, 0.f, 0.f};
    bf16x8 At[4][2], B0[2][2], B1[2][2];
    const char* cA = (const char*)g.A + (size_t)cur.pm * tstep; const char* cB = (const char*)g.Bt + (size_t)cur.pn * tstep;
    S.a_ready(cur);
    if constexpr (SP2) {
        PG8_STAGE(PG8_SB(0, 0), cB, voffB); PG8_STAGE(PG8_SB(0, 1), cB + hstep, voffB); PG8_STAGE(PG8_SA(0, 0), cA, voffA); PG8_STAGE(PG8_SA(0, 1), cA + hstep, voffA);
        if (wr == 1) PG8_BAR;
        PG8_WAIT_V(2); PG8_BAR;
        PG8_STAGE(PG8_SB(1, 0), cB + kstep, voffB); PG8_STAGE(PG8_SA(1, 0), cA + kstep, voffA); PG8_STAGE(PG8_SB(1, 1), cB + hstep + kstep, voffB);
        PG8_WAIT_V(6); PG8_BAR;
    } else {
        PG8_STAGE(PG8_SB(0, 0), cB, voffB); PG8_STAGE(PG8_SA(0, 0), cA, voffA); PG8_STAGE(PG8_SB(0, 1), cB + hstep, voffB); PG8_STAGE(PG8_SA(0, 1), cA + hstep, voffA);
        if (wr == 1) PG8_BAR;
        PG8_WAIT_V(4); PG8_BAR;
        PG8_STAGE(PG8_SB(1, 0), cB + kstep, voffB); PG8_STAGE(PG8_SA(1, 0), cA + kstep, voffA); PG8_STAGE(PG8_SB(1, 1), cB + hstep + kstep, voffB);
        PG8_WAIT_V(6); PG8_BAR;
    }
    for (;;) {
        const bool has_next = S.next(ui + 1, nxt);
        const char* nA = has_next ? (const char*)g.A + (size_t)nxt.pm * tstep : cA; const char* nB = has_next ? (const char*)g.Bt + (size_t)nxt.pn * tstep : cB;
        for (int t = 0; t < nt; t += 2) {
            const bool last = (t == nt - 2);
            if constexpr (Epi::RSTD_LDS) {
                if (t == 2 || t == 4) { PG8_WAIT_V(8);
                    const f32x4 v = *(const PG8_LAS f32x4*)(lds + RSTD_RAW_OFF + ldsw + lane * 16);
                    float s = (v[0] + v[1]) + (v[2] + v[3]); s += __shfl_xor(s, 1); s += __shfl_xor(s, 2);
                    if (!(tid & 3)) *(PG8_LAS float*)(lds + RSTD_LDS_OFF + ((t - 2) * 64 + (tid >> 2)) * 4) = __builtin_amdgcn_rsqf(s * (1.0f / 1024.0f) + 1e-6f);
                    PG8_WAIT_L(0); }
                if (t == 0 || t == 2) __builtin_amdgcn_global_load_lds((const unsigned*)(E.ssq + ((size_t)(tid & 3) * 17408 + (size_t)cur.pm * BM + t * 64 + (tid >> 2)) * 4), (PG8_LAS unsigned*)(lds + RSTD_RAW_OFF + ldsw), 16, 0, 0);
            }
            if constexpr (Epi::XPREFETCH) { if (t == nt - XPF_LEAD) E.prefetch(cur, lds + RSTD_RAW_OFF + ldsw, tid); }
            const char* a1 = cA + (size_t)(t + 1) * kstep;
            const char* a2 = last ? nA : cA + (size_t)(t + 2) * kstep; const char* b2 = last ? nB : cB + (size_t)(t + 2) * kstep;
            const char* a3 = a2 + kstep; const char* b3 = b2 + kstep;
            if (last && has_next) S.a_ready(nxt);
            if constexpr (SP2) {
            PG8_LDB(B0, 0, 0); PG8_LDB(B1, 0, 1); PG8_SCHED; PG8_LDA(At, 0, 0); PG8_STAGE(PG8_SA(1, 1), a1 + hstep, voffA);
            PG8_WAIT_V(8); PG8_WAIT_L(0); PG8_BAR; PG8_MMA(0, 0, At, B0); PG8_MMA(0, 1, At, B1); PG8_BAR; PG8_SCHED;
            PG8_LDA(At, 0, 1); PG8_STAGE(PG8_SB(0, 0), b2, voffB); PG8_STAGE(PG8_SB(0, 1), b2 + hstep, voffB); PG8_STAGE(PG8_SA(0, 0), a2, voffA);
            PG8_WAIT_V(8); PG8_WAIT_L(0); PG8_BAR; PG8_MMA(1, 0, At, B0); PG8_MMA(1, 1, At, B1); PG8_BAR; PG8_SCHED;
            PG8_LDB(B0, 1, 0); PG8_LDB(B1, 1, 1); PG8_SCHED; PG8_LDA(At, 1, 0); PG8_STAGE(PG8_SA(0, 1), a2 + hstep, voffA);
            PG8_WAIT_V(8); PG8_WAIT_L(0); PG8_BAR; PG8_MMA(0, 0, At, B0); PG8_MMA(0, 1, At, B1); PG8_BAR; PG8_SCHED;
            PG8_LDA(At, 1, 1); PG8_STAGE(PG8_SB(1, 0), b3, voffB); PG8_STAGE(PG8_SB(1, 1), b3 + hstep, voffB); PG8_STAGE(PG8_SA(1, 0), a3, voffA);
            PG8_WAIT_V(8); PG8_WAIT_L(0); PG8_BAR; PG8_MMA(1, 0, At, B0); PG8_MMA(1, 1, At, B1); PG8_BAR; PG8_SCHED;
            } else {
            PG8_LDB(B0, 0, 0); PG8_SCHED; PG8_LDA(At, 0, 0); PG8_STAGE(PG8_SA(1, 1), a1 + hstep, voffA);
            PG8_WAIT_L(8); PG8_BAR; PG8_WAIT_L(0); PG8_MMA(0, 0, At, B0); PG8_BAR; PG8_SCHED;
            PG8_LDB(B1, 0, 1); PG8_STAGE(PG8_SB(0, 0), b2, voffB);
            PG8_BAR; PG8_WAIT_L(0); PG8_MMA(0, 1, At, B1); PG8_BAR;
            PG8_LDA(At, 0, 1); PG8_STAGE(PG8_SA(0, 0), a2, voffA);
            PG8_BAR; PG8_WAIT_L(0); PG8_MMA(1, 0, At, B0); PG8_BAR; PG8_SCHED;
            PG8_STAGE(PG8_SB(0, 1), b2 + hstep, voffB);
            PG8_WAIT_V(6); PG8_BAR; PG8_MMA(1, 1, At, B1); PG8_BAR;
            PG8_LDB(B0, 1, 0); PG8_SCHED; PG8_LDA(At, 1, 0); PG8_STAGE(PG8_SA(0, 1), a2 + hstep, voffA);
            PG8_WAIT_L(8); PG8_BAR; PG8_WAIT_L(0); PG8_MMA(0, 0, At, B0); PG8_BAR; PG8_SCHED;
            PG8_LDB(B1, 1, 1); PG8_STAGE(PG8_SB(1, 0), b3, voffB);
            PG8_BAR; PG8_WAIT_L(0); PG8_MMA(0, 1, At, B1); PG8_BAR;
            PG8_LDA(At, 1, 1); PG8_STAGE(PG8_SA(1, 0), a3, voffA);
            PG8_BAR; PG8_WAIT_L(0); PG8_MMA(1, 0, At, B0); PG8_BAR; PG8_SCHED;
            PG8_STAGE(PG8_SB(1, 1), b3 + hstep, voffB);
            PG8_WAIT_V(6); PG8_BAR; PG8_MMA(1, 1, At, B1); PG8_BAR;
            }
        }
        if constexpr (ALIGN_EPI) { if (wr == 0) PG8_BAR; }
        if constexpr (!Epi::AFTER_DRAIN) { E(acc, cur, wr, wc, fr, fq); S.done(cur); }
        if (!has_next) break;
#pragma unroll
        for (int a = 0; a < 2; ++a)
#pragma unroll
            for (int b = 0; b < 2; ++b)
#pragma unroll
                for (int m = 0; m < 4; ++m)
#pragma unroll
                    for (int n = 0; n < 2; ++n) acc[a][b][m][n] = (f32x4){0.f, 0.f, 0.f, 0.f};
        cur = nxt; cA = nA; cB = nB; ++ui;
        if constexpr (ALIGN_EPI) { if (wr == 1) PG8_BAR; }
    }
    PG8_WAIT_V(0);
    if constexpr (!ALIGN_EPI) { if (wr == 0) PG8_BAR; }
    PG8_BAR;
    if constexpr (Epi::AFTER_DRAIN) { E.fused(acc, cur, wr, wc, fr, fq, lds, wid, lane); S.done(cur); }
#undef PG8_SA
#undef PG8_SB
#undef PG8_STAGE
#undef PG8_LDA
#undef PG8_LDB
#undef PG8_MMA
#undef PG8_WAIT_V
#undef PG8_WAIT_L
#undef PG8_BAR
#undef PG8_SCHED
}
}
constexpr int D = 1024, MP = 16384, MS = 1024, M = MP + MS, NLAYER = 4, MIXW = 256, INC = 5888, PMC = 1792, GTC = 4096, FF = 2816;
constexpr int SEQ = 2048, NB = 8, DB = 128, DSEQ = 8, NCH = SEQ / 64;
constexpr int NPHASE = 2 + 7 * NLAYER;
#ifndef MK_PER_PHASE
#define MK_PER_PHASE 0
#endif
constexpr size_t O_Y = 0, O_POOLP = 17825792, O_POOLS = 17948672, O_SREP = 19914752, O_SRES = 19947520, O_SIMP = 20471808, O_SIMS = 20504576,
                 O_SCP = 21028864, O_SCS = 21045248, O_CFP = 21307392, O_CFS = 21553152, O_END = 25485312;
constexpr size_t MiB = 1u << 20;
constexpr size_t WS_CTL = 0, CTL_ZERO_BYTES = 64 * 1024;
constexpr size_t WS_SSQ = 1 * MiB;
constexpr size_t WS_E = 3 * MiB;
constexpr size_t WS_TAB = 5 * MiB;
constexpr size_t TAB_LB = 0, TAB_LP = 8192, TAB_BBT = 16384, TAB_CM = TAB_BBT + 65536, TAB_PW = TAB_CM + 65536, TAB_STRIDE = TAB_PW + 32768;
constexpr size_t WS_WIN = 6 * MiB;
constexpr size_t WS_WFI = WS_WIN + (size_t)NLAYER * INC * D * 2;
constexpr size_t WS_WOUT = WS_WFI + (size_t)NLAYER * 2 * FF * D * 2;
constexpr size_t WS_WFO = WS_WOUT + (size_t)NLAYER * D * D * 2;
constexpr size_t WS_WBR = WS_WFO + (size_t)NLAYER * D * FF * 2;
constexpr size_t WS_WGLU = WS_WBR + (size_t)NLAYER * 4 * D * MIXW * 2;
constexpr size_t WS_ACT1 = WS_WGLU + (size_t)NLAYER * MIXW * MIXW * 2;
constexpr size_t WS_PM = WS_ACT1 + (size_t)M * D * 2;
constexpr size_t WS_GT = WS_PM + (size_t)M * PMC * 2;
constexpr size_t WS_END = WS_GT + (size_t)M * GTC * 2;
static_assert(WS_TAB + NLAYER * TAB_STRIDE <= WS_WIN && WS_E + (size_t)NB * NCH * 1024 * 8 <= WS_TAB && WS_SSQ + (size_t)M * 64 <= WS_E, "d_ws map");
constexpr int CW_BAR = 1024;
constexpr int RING_OFF = 0, RING_BYTES = 147456;
constexpr int LDSCTL_OFF = RING_BYTES, MISC_OFF = LDSCTL_OFF + 320;
constexpr int LDS_BYTES = 163840;
constexpr int NWAVES = 8;

#define GAS __attribute__((address_space(1)))
#define LAS __attribute__((address_space(3)))
typedef unsigned short bf16;
typedef unsigned short bf16_t;
typedef unsigned v4u __attribute__((ext_vector_type(4)));
typedef unsigned v2u __attribute__((ext_vector_type(2)));
typedef float f32x4 __attribute__((ext_vector_type(4)));
typedef float f32x2 __attribute__((ext_vector_type(2)));
typedef short bf16x8 __attribute__((ext_vector_type(8)));
#define LDS_WAIT() asm volatile("s_waitcnt lgkmcnt(0)" ::: "memory")
#define VM_WAIT() asm volatile("s_waitcnt vmcnt(0)" ::: "memory")
__device__ __forceinline__ unsigned pk2(float lo, float hi) { return pg8::cvt_pk_bf16(lo, hi); }
__device__ __forceinline__ float bflo(unsigned u) { return __builtin_bit_cast(float, u << 16); }
__device__ __forceinline__ float bfhi(unsigned u) { return __builtin_bit_cast(float, u & 0xffff0000u); }
__device__ __forceinline__ float bf1(bf16_t b) { return __builtin_bit_cast(float, (unsigned)b << 16); }
__device__ __forceinline__ void unpack8(const v4u v, float (&f)[8]) { f[0] = bflo(v.x); f[1] = bfhi(v.x); f[2] = bflo(v.y); f[3] = bfhi(v.y); f[4] = bflo(v.z); f[5] = bfhi(v.z); f[6] = bflo(v.w); f[7] = bfhi(v.w); }
__device__ __forceinline__ v4u pack8(const float (&f)[8]) { v4u w; w.x = pk2(f[0], f[1]); w.y = pk2(f[2], f[3]); w.z = pk2(f[4], f[5]); w.w = pk2(f[6], f[7]); return w; }
__device__ __forceinline__ float sigm(float x) { return pg8::sigm(x); }
__device__ __forceinline__ float gelu_tanh(float y) { const float in2 = 1.5957691216057308f * (y + 0.044715f * y * y * y); const float e = __builtin_amdgcn_exp2f(1.4426950408889634f * in2); return 0.5f * y * (2.0f - 2.0f * __builtin_amdgcn_rcpf(e + 1.0f)); }
__device__ __forceinline__ float wave_sum(float v) {
#pragma unroll
    for (int o = 1; o < 64; o <<= 1) v += __shfl_xor(v, o);
    return v;
}

#define XB_TMO      128
#define XB_XCNT(j)  (256  + 64 * (j))
#define XB_XSUB(j)  (1280 + 64 * (j))
#define XB_XGEN(j)  (2304 + 64 * (j))
#define XB_TOP      3328
#define XB_TOPGEN   3392
#define XCD_BAR_WORDS 3456
#define XB_SPIN_CAP (1u << 18)

__device__ __forceinline__ unsigned xb_ld(unsigned* p)              { return __hip_atomic_load(p, __ATOMIC_RELAXED, __HIP_MEMORY_SCOPE_AGENT); }
__device__ __forceinline__ unsigned xb_add(unsigned* p, unsigned v) { return __hip_atomic_fetch_add(p, v, __ATOMIC_RELAXED, __HIP_MEMORY_SCOPE_AGENT); }
__device__ __forceinline__ unsigned xb_xcc_id() { return (unsigned)__builtin_amdgcn_s_getreg((3 << 11) | 20) & 0xFu; }
#define XB_SPIN(cond, bar) do { unsigned _sp = 0; while (cond) { __builtin_amdgcn_s_sleep(1); \
    if ((++_sp & 255u) == 0u) { if (xb_ld(&(bar)[XB_TMO])) break; if (_sp > XB_SPIN_CAP) { atomicAdd(&(bar)[XB_TMO], 1u); break; } } } } while (0)

struct XcdBarrier {
    unsigned* bar; unsigned x;
    volatile LAS unsigned* st;
};

__device__ __forceinline__ XcdBarrier xcd_barrier_post(unsigned* bar, volatile LAS unsigned* st) {
    XcdBarrier b; b.bar = bar; b.x = xb_xcc_id(); b.st = st;
    if (threadIdx.x == 0) (void)xb_add(&bar[XB_XCNT(b.x)], 1u);
    return b;
}
__device__ __forceinline__ void xcd_barrier_complete(unsigned* bar, unsigned x, unsigned& nloc, unsigned& nx) {
    const unsigned G = gridDim.x * gridDim.y * gridDim.z;
    unsigned sum, cnt, mine, sp = 0u;
    for (;;) {
        sum = 0u; cnt = 0u; mine = 0u;
#pragma unroll
        for (unsigned j = 0; j < 16; ++j) { const unsigned c = xb_ld(&bar[XB_XCNT(j)]); sum += c; cnt += (c > 0u) ? 1u : 0u; mine = (j == x) ? c : mine; }
        if (sum == G) break;
        __builtin_amdgcn_s_sleep(1);
        if ((++sp & 255u) == 0u) { if (xb_ld(&bar[XB_TMO])) break; if (sp > XB_SPIN_CAP) { atomicAdd(&bar[XB_TMO], 1u); break; } }
    }
    nloc = mine > 0u ? mine : 1u; nx = cnt > 0u ? cnt : 1u;
}

__device__ __forceinline__ void xcd_barrier_leader(const XcdBarrier& b) {
    {
        unsigned* bar = b.bar;
        __builtin_amdgcn_s_waitcnt(0);
        unsigned nloc = b.st[0], nx = b.st[1];
        if (nloc == 0u) { xcd_barrier_complete(bar, b.x, nloc, nx); b.st[0] = nloc; b.st[1] = nx; }
        const unsigned old = xb_add(&bar[XB_XSUB(b.x)], 1u);
        const unsigned gen = old / nloc;
        if (old + 1u == (gen + 1u) * nloc) {
            __builtin_amdgcn_fence(__ATOMIC_RELEASE, "agent");
            asm volatile("s_waitcnt vmcnt(0)" ::: "memory");
            const unsigned og = xb_add(&bar[XB_TOP], 1u);
            const unsigned tg = og / nx;
            if (og + 1u == (tg + 1u) * nx) xb_add(&bar[XB_TOPGEN], 1u);
            else XB_SPIN(xb_ld(&bar[XB_TOPGEN]) == tg, bar);
            __builtin_amdgcn_fence(__ATOMIC_ACQUIRE, "agent");
            xb_add(&bar[XB_XGEN(b.x)], 1u);
            asm volatile("s_waitcnt vmcnt(0)" ::: "memory");
        } else {
            XB_SPIN(xb_ld(&bar[XB_XGEN(b.x)]) == gen, bar);
            __builtin_amdgcn_fence(__ATOMIC_ACQUIRE, "agent");
            asm volatile("s_waitcnt vmcnt(0)" ::: "memory");
        }
    }
}
__device__ __forceinline__ void xcd_barrier(const XcdBarrier& b, bool leader) {
    asm volatile("s_waitcnt vmcnt(0)" ::: "memory");
    __syncthreads();
    if (leader) xcd_barrier_leader(b);
    __syncthreads();
}
struct Args { const float* in[32]; float* out; unsigned char* ws; int ph_lo, ph_hi; };
enum { I_XP = 0, I_XS, I_STPOOL, I_STRE, I_STIM, I_STSC, I_STCF, I_N1G, I_N2G, I_FING, I_WIN, I_BGATE, I_POOLW, I_POOLSC, I_LAMRE, I_LAMIM, I_LOGDT,
       I_BRE, I_BIM, I_CRE, I_CIM, I_DSKIP, I_WGLU, I_BGLU, I_SCW, I_CFW, I_CFLNG, I_CFLNB, I_WBR, I_WOUT, I_WFI, I_WFO };

__device__ __forceinline__ void p0_item(const float* W, int ldw, int src_col0, const float* kscale, int k0, bf16* WTrow0, int K, LAS float* scr, int lane) {
    float wv[32];
#pragma unroll
    for (int i = 0; i < 32; ++i) { const int kk = 2 * i + (lane >> 5); wv[i] = W[(size_t)(k0 + kk) * ldw + src_col0 + (lane & 31)]; }
#pragma unroll
    for (int i = 0; i < 32; ++i) { const int kk = 2 * i + (lane >> 5); scr[kk * 33 + (lane & 31)] = wv[i]; }
    LDS_WAIT(); asm volatile("" ::: "memory");
    const int c = lane & 7;
    f32x4 ks0 = (f32x4){1.f, 1.f, 1.f, 1.f}, ks1 = ks0;
    if (kscale) { ks0 = *(const f32x4*)(kscale + k0 + 8 * c); ks1 = *(const f32x4*)(kscale + k0 + 8 * c + 4); }
#pragma unroll
    for (int j = 0; j < 4; ++j) { const int n = (lane >> 3) + 8 * j; const LAS float* s = scr + (8 * c) * 33 + n;
        v4u o; o.x = pk2(s[0 * 33] * ks0[0], s[1 * 33] * ks0[1]); o.y = pk2(s[2 * 33] * ks0[2], s[3 * 33] * ks0[3]); o.z = pk2(s[4 * 33] * ks1[0], s[5 * 33] * ks1[1]); o.w = pk2(s[6 * 33] * ks1[2], s[7 * 33] * ks1[3]);
        *(GAS v4u*)(WTrow0 + (size_t)n * K + k0 + 8 * c) = o; }
    LDS_WAIT(); asm volatile("" ::: "memory");
}
constexpr int P0_IT_IN = 16 * (INC / 32), P0_IT_FI = 16 * (2 * FF / 32), P0_IT_OUT = 16 * 32, P0_IT_FO = (FF / 64) * 32, P0_IT_BR = 4 * 4 * 32, P0_IT_GLU = 4 * 8;
constexpr int P0_IT_LAYER = P0_IT_IN + P0_IT_FI + P0_IT_OUT + P0_IT_FO + P0_IT_BR + P0_IT_GLU;
__device__ __forceinline__ void p0_weight_item(const Args& a, int L, int r, LAS float* scr, int lane) {
    unsigned char* ws = a.ws;
    if (r < P0_IT_IN) { const int nblk = INC / 32, kb = r / nblk, nb = r % nblk;
        p0_item(a.in[I_WIN] + (size_t)L * D * INC, INC, 32 * nb, a.in[I_N1G] + L * D, 64 * kb, (bf16*)(ws + WS_WIN) + ((size_t)L * INC + 32 * nb) * D, D, scr, lane); return; } r -= P0_IT_IN;
    if (r < P0_IT_FI) { const int nblk = 2 * FF / 32, kb = r / nblk, nb = r % nblk; const int nd = 32 * nb, pn = nd >> 8, rr = nd & 255;
        const int src = rr < 128 ? 128 * pn + rr : FF + 128 * pn + (rr - 128);
        p0_item(a.in[I_WFI] + (size_t)L * D * 2 * FF, 2 * FF, src, a.in[I_N2G] + L * D, 64 * kb, (bf16*)(ws + WS_WFI) + ((size_t)L * 2 * FF + nd) * D, D, scr, lane); return; } r -= P0_IT_FI;
    if (r < P0_IT_OUT) { const int kb = r / 32, nb = r % 32;
        p0_item(a.in[I_WOUT] + (size_t)L * D * D, D, 32 * nb, nullptr, 64 * kb, (bf16*)(ws + WS_WOUT) + ((size_t)L * D + 32 * nb) * D, D, scr, lane); return; } r -= P0_IT_OUT;
    if (r < P0_IT_FO) { const int kb = r / 32, nb = r % 32;
        p0_item(a.in[I_WFO] + (size_t)L * FF * D, D, 32 * nb, nullptr, 64 * kb, (bf16*)(ws + WS_WFO) + ((size_t)L * D + 32 * nb) * FF, FF, scr, lane); return; } r -= P0_IT_FO;
    if (r < P0_IT_BR) { const int br = r / 128, q = r % 128, kb = q / 32, nb = q % 32;
        p0_item(a.in[I_WBR] + (size_t)(L * 4 + br) * MIXW * D, D, 32 * nb, nullptr, 64 * kb, (bf16*)(ws + WS_WBR) + ((size_t)(L * 4 + br) * D + 32 * nb) * MIXW, MIXW, scr, lane); return; } r -= P0_IT_BR;
    { const int kb = r / 8, nb = r % 8;
        p0_item(a.in[I_WGLU] + (size_t)L * MIXW * MIXW, MIXW, 32 * nb, nullptr, 64 * kb, (bf16*)(ws + WS_WGLU) + ((size_t)L * MIXW + 32 * nb) * MIXW, MIXW, scr, lane); }
}
constexpr int P0_SLICES = 6, P0_SLICE_ITEMS = (P0_IT_LAYER + P0_SLICES - 1) / P0_SLICES;
__device__ __forceinline__ void p0_slice(const Args& a, LAS unsigned char* lds, int lane, int wave, int G, int bid, int L, int slice) {
    LAS float* scr = (LAS float*)(lds + RING_OFF + wave * 16384);
    const int lo = slice * P0_SLICE_ITEMS, hi = (lo + P0_SLICE_ITEMS < P0_IT_LAYER) ? lo + P0_SLICE_ITEMS : P0_IT_LAYER;
    for (int r = lo + bid * (NWAVES - 1) + (wave - 1); r < hi; r += G * (NWAVES - 1)) p0_weight_item(a, L, r, scr, lane);
}
__device__ __forceinline__ void p0_prologue(const Args& a, LAS unsigned char* lds, int tid, int lane, int wave, int G, int bid) {
    LAS float* scr = (LAS float*)(lds + RING_OFF + wave * 16384);
    const int gw = bid * NWAVES + wave, NGW = G * NWAVES;
    unsigned char* ws = a.ws;
    for (int it = gw; it < (MK_PER_PHASE ? NLAYER : 1) * P0_IT_LAYER; it += NGW) p0_weight_item(a, it / P0_IT_LAYER, it % P0_IT_LAYER, scr, lane);
    for (int m = gw; m < M; m += NGW) {
        const float* xrow = m < MP ? a.in[I_XP] + (size_t)m * D : a.in[I_XS] + (size_t)(m - MP) * D;
        const GAS f32x4* xr = (const GAS f32x4*)xrow + lane; f32x4 v[4]; float s = 0.f;
#pragma unroll
        for (int j = 0; j < 4; ++j) { v[j] = xr[64 * j]; s += (v[j][0] * v[j][0] + v[j][1] * v[j][1]) + (v[j][2] * v[j][2] + v[j][3] * v[j][3]); }
        s = wave_sum(s);
        GAS v2u* o8 = (GAS v2u*)((bf16*)(ws + WS_ACT1) + (size_t)m * D) + lane;
#pragma unroll
        for (int j = 0; j < 4; ++j) { v2u w; w.x = pk2(v[j][0], v[j][1]); w.y = pk2(v[j][2], v[j][3]); o8[64 * j] = w; }
        if (lane < 16) ((float*)(ws + WS_SSQ))[((size_t)(lane >> 2) * M + m) * 4 + (lane & 3)] = lane == 0 ? s : 0.f;
    }
    for (int idx = bid * 512 + tid; idx < NLAYER * 1024; idx += G * 512) {
        const int L = idx >> 10, gp = idx & 1023, g = gp >> 6, p = gp & 63;
        unsigned char* tab = ws + WS_TAB + (size_t)L * TAB_STRIDE;
        const float lre = a.in[I_LAMRE][idx], lim = a.in[I_LAMIM][idx], dt = expf(a.in[I_LOGDT][L * 16 + g]);
        const float ar = lre * dt, br_ = lim * dt, ea = expf(ar), cb = cosf(br_), sb = sinf(br_), sh = sinf(0.5f * br_);
        const float lbr = ea * cb, lbi = ea * sb;
        const float m1r = expm1f(ar) * cb - 2.0f * sh * sh, m1i = lbi;
        const float den = 1.0f / (lre * lre + lim * lim);
        const float qr = (m1r * lre + m1i * lim) * den, qi = (m1i * lre - m1r * lim) * den;
        ((f32x2*)(tab + TAB_LB))[gp] = (f32x2){lbr, lbi};
        float pr = lbr, pi = lbi;
#pragma unroll
        for (int s = 0; s < 6; ++s) { const float nr = pr * pr - pi * pi, ni = 2.0f * pr * pi; pr = nr; pi = ni; }
        ((f32x2*)(tab + TAB_LP))[gp] = (f32x2){pr, pi};
        bf16* bbt = (bf16*)(tab + TAB_BBT); bf16* cm = (bf16*)(tab + TAB_CM);
        const float* bre = a.in[I_BRE] + (size_t)idx * 16; const float* bim = a.in[I_BIM] + (size_t)idx * 16;
#pragma unroll
        for (int c = 0; c < 16; ++c) { const float Br = bre[c], Bi = bim[c];
            bbt[(g * 128 + p) * 16 + c] = (bf16)(pk2(qr * Br - qi * Bi, 0.f) & 0xffffu);
            bbt[(g * 128 + 64 + p) * 16 + c] = (bf16)(pk2(qr * Bi + qi * Br, 0.f) & 0xffffu);
            cm[(g * 16 + c) * 128 + p] = (bf16)(pk2(a.in[I_CRE][((size_t)(L * 16 + g) * 16 + c) * 64 + p], 0.f) & 0xffffu);
            cm[(g * 16 + c) * 128 + 64 + p] = (bf16)(pk2(-a.in[I_CIM][((size_t)(L * 16 + g) * 16 + c) * 64 + p], 0.f) & 0xffffu); }
    }
    for (int idx = bid * 512 + tid; idx < NLAYER * 4 * 64 * 64; idx += G * 512) {
        const int L = idx >> 14, r = idx & 16383, k = r >> 12, o = (r >> 6) & 63, c = r & 63;
        ((bf16*)(ws + WS_TAB + (size_t)L * TAB_STRIDE + TAB_PW))[r] = (bf16)(pk2(a.in[I_POOLW][((size_t)(L * 4 + k) * 64 + c) * 64 + o], 0.f) & 0xffffu);
    }
}
__device__ __forceinline__ void final_norm(const Args& a, int lane, int wave, int G, int bid) {
    const int gw = bid * NWAVES + wave, NGW = G * NWAVES;
    const float* ssq = (const float*)(a.ws + WS_SSQ);
    f32x4 gv[4];
#pragma unroll
    for (int j = 0; j < 4; ++j) gv[j] = ((const f32x4*)a.in[I_FING])[lane + 64 * j];
    for (int m = gw; m < M; m += NGW) {
        float s = lane < 16 ? ssq[((size_t)(lane >> 2) * M + m) * 4 + (lane & 3)] : 0.f; s = wave_sum(s);
        const float rs = __builtin_amdgcn_rsqf(s * (1.0f / 1024.0f) + 1e-6f);
        const GAS v2u* xb = (const GAS v2u*)((const bf16*)(a.ws + WS_ACT1) + (size_t)m * D) + lane;
        GAS f32x4* yr = (GAS f32x4*)(a.out + (size_t)m * D) + lane;
#pragma unroll
        for (int j = 0; j < 4; ++j) { const v2u q = xb[64 * j]; const f32x4 v = (f32x4){bflo(q.x), bfhi(q.x), bflo(q.y), bfhi(q.y)}; yr[64 * j] = v * rs * gv[j]; }
    }
}

typedef float f32x4_t __attribute__((ext_vector_type(4)));
__device__ __forceinline__ float fma_s(float a, float b, float c) { float r; asm("v_fma_f32 %0, %1, %2, %3" : "=v"(r) : "v"(a), "v"(b), "v"(c)); return r; }
template <bool SAMPLE>
__device__ __forceinline__ void mix_unit(const Args& a, int layer, int uidx, LAS unsigned char* lds, int tid_in, int lane_in, int wave_in) {
    int tid = tid_in; asm volatile("" : "+v"(tid));
    const int lane = tid & 63, wave = __builtin_amdgcn_readfirstlane(tid >> 6);
    constexpr int L = SAMPLE ? 8 : 64, NSEG = SAMPLE ? 2 : 1, R = NSEG * L;
    const bf16* PMb = (const bf16*)(a.ws + WS_PM); bf16* BR = (bf16*)a.out;
    const int s = uidx >> 5, c = uidx & 31, q0 = 2 * uidx;
    const int row0 = SAMPLE ? MP + q0 * 8 : s * SEQ + 64 * c;
    const bool last = SAMPLE || c == NCH - 1;
    LAS float* V = (LAS float*)lds;
    {
        constexpr int TR = NSEG * (30 + L);
        LAS float* WCF = (LAS float*)(lds + 96256);
        {
            constexpr int NIT = (TR * 32 + 511) / 512;
            v4u qa[NIT], qb[NIT]; int kind[NIT];
#pragma unroll
            for (int it = 0; it < NIT; ++it) {
                const int idx = tid + it * 512; kind[it] = 0; qa[it] = (v4u){0u, 0u, 0u, 0u}; qb[it] = (v4u){0u, 0u, 0u, 0u};
                if (idx < TR * 32) {
                    const int rr = idx >> 5, c8 = (idx & 31) * 8, seg = rr / (30 + L), e = rr % (30 + L);
                    int srow = -1;
                    if (SAMPLE) { if (e >= 30) srow = MP + (q0 + seg) * 8 + (e - 30); }
                    else { const int tabs = c * 64 + e - 30; if (tabs >= 0) srow = s * SEQ + tabs; }
                    if (srow >= 0) { kind[it] = 1; qa[it] = *(const v4u*)(PMb + (size_t)srow * PMC + 1280 + c8); qb[it] = *(const v4u*)(PMb + (size_t)srow * PMC + 1536 + c8); }
                    else if (SAMPLE) { kind[it] = 2; const float* st = a.in[I_STCF] + ((size_t)(layer * DB + q0 + seg) * 30 + e) * MIXW + c8; qa[it] = *(const v4u*)st; qb[it] = *(const v4u*)(st + 4); }
                }
            }
#pragma unroll
            for (int it = 0; it < NIT; ++it) {
                const int idx = tid + it * 512;
                if (idx < TR * 32) {
                    const int rr = idx >> 5, c8 = (idx & 31) * 8;
                    float v[8];
                    if (kind[it] == 1) { float av[8], bv[8]; unpack8(qa[it], av); unpack8(qb[it], bv);
#pragma unroll
                        for (int j = 0; j < 8; ++j) v[j] = av[j] * sigm(bv[j]); }
                    else { v[0] = __uint_as_float(qa[it].x); v[1] = __uint_as_float(qa[it].y); v[2] = __uint_as_float(qa[it].z); v[3] = __uint_as_float(qa[it].w);
                           v[4] = __uint_as_float(qb[it].x); v[5] = __uint_as_float(qb[it].y); v[6] = __uint_as_float(qb[it].z); v[7] = __uint_as_float(qb[it].w); }
                    *(LAS f32x4*)(V + rr * 256 + c8) = (f32x4){v[0], v[1], v[2], v[3]}; *(LAS f32x4*)(V + rr * 256 + c8 + 4) = (f32x4){v[4], v[5], v[6], v[7]};
                }
            }
        }
        { f32x4 wq[4];
#pragma unroll
            for (int it = 0; it < 4; ++it) { const int idx = tid + it * 512; wq[it] = idx < 31 * 64 ? *(const f32x4*)(a.in[I_CFW] + (size_t)layer * 31 * MIXW + idx * 4) : (f32x4){0.f, 0.f, 0.f, 0.f}; }
#pragma unroll
            for (int it = 0; it < 4; ++it) { const int idx = tid + it * 512; if (idx < 31 * 64) *(LAS f32x4*)(WCF + idx * 4) = wq[it]; } }
        __syncthreads();
        if (last) {
            for (int idx = tid; idx < NSEG * 30 * 64; idx += 512) { const int seg = idx / (30 * 64), r = idx % (30 * 64), j = r >> 6, c4 = (r & 63) * 4;
                float* dst = a.out + (SAMPLE ? O_CFS + ((size_t)(layer * DB + q0 + seg) * 30 + j) * MIXW : O_CFP + ((size_t)(layer * NB + s) * 30 + j) * MIXW) + c4;
                *(f32x4*)dst = *(LAS f32x4*)(V + (seg * (30 + L) + L + j) * 256 + c4); }
        }
        const f32x4 lg = *(const f32x4*)(a.in[I_CFLNG] + layer * MIXW + 4 * lane), lb = *(const f32x4*)(a.in[I_CFLNB] + layer * MIXW + 4 * lane);
        {
            constexpr int NT = R / NWAVES, TG = NT >= 4 ? 4 : NT;
#pragma unroll 1
            for (int g0 = 0; g0 < NT; g0 += TG) {
                f32x4 acc[TG]; int base[TG];
#pragma unroll
                for (int i = 0; i < TG; ++i) { const int tt = wave + NWAVES * (g0 + i), seg = tt / L, t = tt % L; base[i] = (seg * (30 + L) + t) * 256 + 4 * lane; acc[i] = (f32x4){0.f, 0.f, 0.f, 0.f}; }
#pragma unroll 4
                for (int j = 0; j < 31; ++j) { const f32x4 w = *(LAS f32x4*)(WCF + j * 256 + 4 * lane);
#pragma unroll
                    for (int i = 0; i < TG; ++i) acc[i] += w * *(LAS f32x4*)(V + base[i] + j * 256); }
                float s1[TG];
#pragma unroll
                for (int i = 0; i < TG; ++i) s1[i] = (acc[i][0] + acc[i][1]) + (acc[i][2] + acc[i][3]);
#pragma unroll
                for (int o = 1; o < 64; o <<= 1) {
#pragma unroll
                    for (int i = 0; i < TG; ++i) s1[i] += __shfl_xor(s1[i], o); }
                f32x4 d[TG]; float s2[TG];
#pragma unroll
                for (int i = 0; i < TG; ++i) { d[i] = acc[i] - s1[i] * (1.0f / 256.0f); s2[i] = (d[i][0] * d[i][0] + d[i][1] * d[i][1]) + (d[i][2] * d[i][2] + d[i][3] * d[i][3]); }
#pragma unroll
                for (int o = 1; o < 64; o <<= 1) {
#pragma unroll
                    for (int i = 0; i < TG; ++i) s2[i] += __shfl_xor(s2[i], o); }
#pragma unroll
                for (int i = 0; i < TG; ++i) { const int tt = wave + NWAVES * (g0 + i);
                    const float rstd = __builtin_amdgcn_rsqf(s2[i] * (1.0f / 256.0f) + 1e-5f);
                    const f32x4 yn = d[i] * rstd * lg + lb;
                    v2u w; w.x = pk2(yn[0] * sigm(yn[0]), yn[1] * sigm(yn[1])); w.y = pk2(yn[2] * sigm(yn[2]), yn[3] * sigm(yn[3]));
                    *(v2u*)(BR + (size_t)(row0 + tt) * D + 768 + 4 * lane) = w; }
            }
        }
        __syncthreads();
    }
    {
        constexpr int TR = NSEG * (15 + L);
        LAS bf16* Dt = (LAS bf16*)(lds + 81920);
        {
            constexpr int NIT = (TR * 32 + 511) / 512;
            v4u qa[NIT], qb[NIT]; int kind[NIT];
#pragma unroll
            for (int it = 0; it < NIT; ++it) {
                const int idx = tid + it * 512; kind[it] = 0; qa[it] = (v4u){0u, 0u, 0u, 0u}; qb[it] = (v4u){0u, 0u, 0u, 0u};
                if (idx < TR * 32) {
                    const int rr = idx >> 5, c8 = (idx & 31) * 8, seg = rr / (15 + L), e = rr % (15 + L);
                    int srow = -1;
                    if (SAMPLE) { if (e >= 15) srow = MP + (q0 + seg) * 8 + (e - 15); }
                    else { const int tabs = c * 64 + e - 15; if (tabs >= 0) srow = s * SEQ + tabs; }
                    if (srow >= 0) { kind[it] = 1; qa[it] = *(const v4u*)(PMb + (size_t)srow * PMC + c8); }
                    else if (SAMPLE) { kind[it] = 2; const float* st = a.in[I_STPOOL] + ((size_t)(layer * DB + q0 + seg) * 15 + e) * MIXW + c8; qa[it] = *(const v4u*)st; qb[it] = *(const v4u*)(st + 4); }
                }
            }
#pragma unroll
            for (int it = 0; it < NIT; ++it) {
                const int idx = tid + it * 512;
                if (idx < TR * 32) {
                    const int rr = idx >> 5, c8 = (idx & 31) * 8;
                    float v[8];
                    if (kind[it] == 1) unpack8(qa[it], v);
                    else { v[0] = __uint_as_float(qa[it].x); v[1] = __uint_as_float(qa[it].y); v[2] = __uint_as_float(qa[it].z); v[3] = __uint_as_float(qa[it].w);
                           v[4] = __uint_as_float(qb[it].x); v[5] = __uint_as_float(qb[it].y); v[6] = __uint_as_float(qb[it].z); v[7] = __uint_as_float(qb[it].w); }
                    *(LAS f32x4*)(V + rr * 256 + c8) = (f32x4){v[0], v[1], v[2], v[3]}; *(LAS f32x4*)(V + rr * 256 + c8 + 4) = (f32x4){v[4], v[5], v[6], v[7]};
                }
            }
        }
        __syncthreads();
        if (last) {
            for (int idx = tid; idx < NSEG * 15 * 64; idx += 512) { const int seg = idx / (15 * 64), r = idx % (15 * 64), j = r >> 6, c4 = (r & 63) * 4;
                float* dst = a.out + (SAMPLE ? O_POOLS + ((size_t)(layer * DB + q0 + seg) * 15 + j) * MIXW : O_POOLP + ((size_t)(layer * NB + s) * 15 + j) * MIXW) + c4;
                *(f32x4*)dst = *(LAS f32x4*)(V + (seg * (15 + L) + L + j) * 256 + c4); }
        }
        for (int idx = tid; idx < R * 32; idx += 512) {
            const int tt = idx >> 5, c8 = (idx & 31) * 8, seg = tt / L, t = tt % L, base = seg * (15 + L) + t + 15, win = 2 << (c8 >> 6);
            float sm[8];
#pragma unroll
            for (int j = 0; j < 8; ++j) sm[j] = 0.f;
            for (int w = 0; w < win; ++w) { const f32x4 x0 = *(LAS f32x4*)(V + (base - w) * 256 + c8), x1 = *(LAS f32x4*)(V + (base - w) * 256 + c8 + 4);
                sm[0] += x0[0]; sm[1] += x0[1]; sm[2] += x0[2]; sm[3] += x0[3]; sm[4] += x1[0]; sm[5] += x1[1]; sm[6] += x1[2]; sm[7] += x1[3]; }
            const int cnt = SAMPLE ? win : min(c * 64 + t + 1, win);
            const float inv = 1.0f / (float)cnt;
            const f32x4 c0 = *(LAS f32x4*)(V + base * 256 + c8), c1 = *(LAS f32x4*)(V + base * 256 + c8 + 4);
            float dd[8];
#pragma unroll
            for (int j = 0; j < 4; ++j) { dd[j] = sm[j] * inv - c0[j]; dd[4 + j] = sm[4 + j] * inv - c1[j]; }
            *(LAS v4u*)(Dt + tt * 264 + c8) = pack8(dd);
        }
        __syncthreads();
        {
            const bf16* PW = (const bf16*)(a.ws + WS_TAB + (size_t)layer * TAB_STRIDE + TAB_PW);
            const int k = wave >> 1, fr = lane & 15, fq = lane >> 4;
            constexpr int NMT = R / 16;
            for (int mt = (NMT >= 4 ? (wave & 1) * 2 : (wave & 1)); mt < (NMT >= 4 ? (wave & 1) * 2 + 2 : ((wave & 1) == 0 ? NMT : 0)); ++mt) {
                const bf16x8 b0 = *(LAS bf16x8*)(Dt + (16 * mt + fr) * 264 + 64 * k + 8 * fq), b1 = *(LAS bf16x8*)(Dt + (16 * mt + fr) * 264 + 64 * k + 32 + 8 * fq);
#pragma unroll
                for (int ot = 0; ot < 4; ++ot) {
                    f32x4 acc = (f32x4){0.f, 0.f, 0.f, 0.f};
                    const bf16x8 a0 = *(const bf16x8*)(PW + ((size_t)(k * 64 + 16 * ot + fr)) * 64 + 8 * fq), a1 = *(const bf16x8*)(PW + ((size_t)(k * 64 + 16 * ot + fr)) * 64 + 32 + 8 * fq);
                    acc = __builtin_amdgcn_mfma_f32_16x16x32_bf16(a0, b0, acc, 0, 0, 0);
                    acc = __builtin_amdgcn_mfma_f32_16x16x32_bf16(a1, b1, acc, 0, 0, 0);
                    const int o = 64 * k + 16 * ot + 4 * fq, tt = 16 * mt + fr;
                    const f32x4 sc = *(const f32x4*)(a.in[I_POOLSC] + layer * MIXW + o);
                    v2u w; w.x = pk2(acc[0] * sc[0], acc[1] * sc[1]); w.y = pk2(acc[2] * sc[2], acc[3] * sc[3]);
                    *(v2u*)(BR + (size_t)(row0 + tt) * D + o) = w;
                }
            }
        }
        __syncthreads();
    }
    {
        const float* scw = a.in[I_SCW] + (size_t)layer * 3 * MIXW;
#pragma unroll
        for (int it_ = 0; it_ < R * 32 / 512; ++it_) { const int idx = tid + it_ * 512;
            const int tt = idx >> 5, c8 = (idx & 31) * 8, seg = tt / L, t = tt % L;
            float z[3][8];
#pragma unroll
            for (int dj = 0; dj < 3; ++dj) { const int tp = t - 2 + dj;
                int srow = -1;
                if (SAMPLE) { if (tp >= 0) srow = MP + (q0 + seg) * 8 + tp; } else { const int tabs = c * 64 + tp; if (tabs >= 0) srow = s * SEQ + tabs; }
                if (srow >= 0) { float cg[8], hx[8]; unpack8(*(const v4u*)(PMb + (size_t)srow * PMC + 768 + c8), cg); unpack8(*(const v4u*)(PMb + (size_t)srow * PMC + 1024 + c8), hx);
#pragma unroll
                    for (int j = 0; j < 8; ++j) z[dj][j] = cg[j] * hx[j]; }
                else if (SAMPLE) { const float* st = a.in[I_STSC] + ((size_t)(layer * DB + q0 + seg) * 2 + (2 + tp)) * MIXW + c8; const f32x4 x0 = *(const f32x4*)st, x1 = *(const f32x4*)(st + 4);
                    z[dj][0] = x0[0]; z[dj][1] = x0[1]; z[dj][2] = x0[2]; z[dj][3] = x0[3]; z[dj][4] = x1[0]; z[dj][5] = x1[1]; z[dj][6] = x1[2]; z[dj][7] = x1[3]; }
                else {
#pragma unroll
                    for (int j = 0; j < 8; ++j) z[dj][j] = 0.f; } }
            float bg[8], o[8]; unpack8(*(const v4u*)(PMb + (size_t)(row0 + tt) * PMC + 512 + c8), bg);
#pragma unroll
            for (int j = 0; j < 8; ++j) o[j] = bg[j] * (scw[c8 + j] * z[0][j] + scw[MIXW + c8 + j] * z[1][j] + scw[2 * MIXW + c8 + j] * z[2][j]);
            *(v4u*)(BR + (size_t)(row0 + tt) * D + 512 + c8) = pack8(o);
            if (last && t >= L - 2) { float* dst = a.out + (SAMPLE ? O_SCS + ((size_t)(layer * DB + q0 + seg) * 2 + (t - (L - 2))) * MIXW : O_SCP + ((size_t)(layer * NB + s) * 2 + (t - (L - 2))) * MIXW) + c8;
                *(f32x4*)dst = (f32x4){z[2][0], z[2][1], z[2][2], z[2][3]}; *(f32x4*)(dst + 4) = (f32x4){z[2][4], z[2][5], z[2][6], z[2][7]}; }
        }
    }
}

template <int MODE>
__device__ __forceinline__ void ssm_unit(const Args& a, int layer, int uidx, LAS unsigned char* lds, int tid_in, int lane_in, int wave_in) {
    int tid = tid_in; asm volatile("" : "+v"(tid));
    const int lane = tid & 63, wave = __builtin_amdgcn_readfirstlane(tid >> 6);
    const bf16* PMb = (const bf16*)(a.ws + WS_PM); bf16* BR = (bf16*)a.out;
    const unsigned char* tab = a.ws + WS_TAB + (size_t)layer * TAB_STRIDE;
    const f32x2* LB = (const f32x2*)(tab + TAB_LB); const f32x2* LP = (const f32x2*)(tab + TAB_LP);
    const bf16* BBT = (const bf16*)(tab + TAB_BBT); const bf16* CM = (const bf16*)(tab + TAB_CM);
    f32x2* E = (f32x2*)(a.ws + WS_E);
    const int s = uidx >> 5, c = uidx & 31;
    const int row0 = MODE == 2 ? MP + 64 * uidx : s * SEQ + 64 * c;
    const int fr = lane & 15, fq = lane >> 4;
    LAS float* BU = (LAS float*)(lds + wave * 8448);
    LAS bf16* Zt = (LAS bf16*)(lds + 67584);
    const bf16x8 zf = (bf16x8){0, 0, 0, 0, 0, 0, 0, 0};
    for (int gi = 0; gi < 2; ++gi) {
        const int g = 2 * wave + gi;
        const f32x2 lam = LB[g * 64 + lane]; const float nlam1 = -lam[1];
        float hr = 0.f, hi = 0.f;
        if (MODE == 1) { const f32x2 lp = LP[g * 64 + lane];
            const float nlp1 = -lp[1]; int j = 0;
            for (; j + 4 <= c; j += 4) { f32x2 e4[4];
#pragma unroll
                for (int q = 0; q < 4; ++q) e4[q] = E[((size_t)(s * NCH + j + q) * 16 + g) * 64 + lane];
#pragma unroll
                for (int q = 0; q < 4; ++q) { const float nr = fma_s(lp[0], hr, fma_s(nlp1, hi, e4[q][0])), ni = fma_s(lp[0], hi, fma_s(lp[1], hr, e4[q][1])); hr = nr; hi = ni; } }
            for (; j < c; ++j) { const f32x2 e = E[((size_t)(s * NCH + j) * 16 + g) * 64 + lane]; const float nr = fma_s(lp[0], hr, fma_s(nlp1, hi, e[0])), ni = fma_s(lp[0], hi, fma_s(lp[1], hr, e[1])); hr = nr; hi = ni; } }
        bf16x8 bb[8];
#pragma unroll
        for (int nt = 0; nt < 8; ++nt) bb[nt] = fq < 2 ? *(const bf16x8*)(BBT + ((size_t)(g * 128 + 16 * nt + fr)) * 16 + 8 * fq) : zf;
        bf16x8 cmf[4]; float dsk = 0.f;
        if (MODE >= 1) {
#pragma unroll
            for (int ks = 0; ks < 4; ++ks) cmf[ks] = *(const bf16x8*)(CM + ((size_t)(g * 16 + fr)) * 128 + 32 * ks + 8 * fq);
            dsk = a.in[I_DSKIP][layer * MIXW + 16 * g + fr]; }
        bf16x8 ufa[4];
#pragma unroll
        for (int sub = 0; sub < 4; ++sub) ufa[sub] = fq < 2 ? *(const bf16x8*)(PMb + (size_t)(row0 + 16 * sub + fr) * PMC + 256 + 16 * g + 8 * fq) : zf;
        bf16 uva[4][4];
        if (MODE >= 1) {
#pragma unroll
            for (int sub = 0; sub < 4; ++sub)
#pragma unroll
                for (int r = 0; r < 4; ++r) uva[sub][r] = PMb[(size_t)(row0 + 16 * sub + 4 * fq + r) * PMC + 256 + 16 * g + fr]; }
#pragma unroll
        for (int sub = 0; sub < 4; ++sub) {
            const int rowb = row0 + 16 * sub;
            const bf16x8 uf = ufa[sub];
#pragma unroll
            for (int nt = 0; nt < 8; ++nt) { const f32x4 d = __builtin_amdgcn_mfma_f32_16x16x32_bf16(uf, bb[nt], (f32x4){0.f, 0.f, 0.f, 0.f}, 0, 0, 0);
#pragma unroll
                for (int r = 0; r < 4; ++r) BU[(4 * fq + r) * 132 + 16 * nt + fr] = d[r]; }
            asm volatile("s_waitcnt lgkmcnt(0)" ::: "memory");
            {
                float bre_[16], bim_[16];
#pragma unroll
                for (int t = 0; t < 16; ++t) { bre_[t] = BU[t * 132 + lane]; bim_[t] = BU[t * 132 + 64 + lane]; }
                float sre_[2] = {0.f, 0.f}, sim_[2] = {0.f, 0.f};
                if (MODE == 2) {
#pragma unroll
                    for (int hq = 0; hq < 2; ++hq) { const int q = 8 * uidx + 2 * sub + hq; const size_t si = ((size_t)(layer * DB + q) * 16 + g) * 64 + lane; sre_[hq] = a.in[I_STRE][si]; sim_[hq] = a.in[I_STIM][si]; } }
                asm volatile("s_waitcnt lgkmcnt(0)" ::: "memory");
#pragma unroll
                for (int t = 0; t < 16; ++t) {
                    if (MODE == 2 && (t & 7) == 0) { hr = sre_[t >> 3]; hi = sim_[t >> 3]; }
                    const float nr = fma_s(lam[0], hr, fma_s(nlam1, hi, bre_[t])), ni = fma_s(lam[0], hi, fma_s(lam[1], hr, bim_[t])); hr = nr; hi = ni;
                    bre_[t] = hr; bim_[t] = hi;
                    if (MODE == 2 && (t & 7) == 7) { const int q = 8 * uidx + 2 * sub + (t >> 3); const size_t si = ((size_t)(layer * DB + q) * 16 + g) * 64 + lane; a.out[O_SRES + si] = hr; a.out[O_SIMS + si] = hi; }
                }
#pragma unroll
                for (int t = 0; t < 16; ++t) { BU[t * 132 + lane] = bre_[t]; BU[t * 132 + 64 + lane] = bim_[t]; }
            }
            if (MODE >= 1) {
                asm volatile("s_waitcnt lgkmcnt(0)" ::: "memory");
                f32x4 y = (f32x4){0.f, 0.f, 0.f, 0.f};
#pragma unroll
                for (int ks = 0; ks < 4; ++ks) { const f32x4 h0 = *(LAS f32x4*)(BU + fr * 132 + 32 * ks + 8 * fq), h1 = *(LAS f32x4*)(BU + fr * 132 + 32 * ks + 8 * fq + 4);
                    v4u hw; hw.x = pk2(h0[0], h0[1]); hw.y = pk2(h0[2], h0[3]); hw.z = pk2(h1[0], h1[1]); hw.w = pk2(h1[2], h1[3]);
                    y = __builtin_amdgcn_mfma_f32_16x16x32_bf16(__builtin_bit_cast(bf16x8, hw), cmf[ks], y, 0, 0, 0); }
#pragma unroll
                for (int r = 0; r < 4; ++r) { const int t = 4 * fq + r; const float uv = bf1(uva[sub][r]);
                    const float z = gelu_tanh(y[r] + dsk * uv);
                    Zt[(16 * sub + t) * 264 + 16 * g + fr] = (bf16)(pk2(z, 0.f) & 0xffffu); }
                asm volatile("s_waitcnt lgkmcnt(0)" ::: "memory");
            }
            if (MODE == 0) { asm volatile("s_waitcnt lgkmcnt(0)" ::: "memory"); }
        }
        if (MODE == 0) E[((size_t)(s * NCH + c) * 16 + g) * 64 + lane] = (f32x2){hr, hi};
        if (MODE == 1 && c == NCH - 1) { const size_t si = ((size_t)(layer * NB + s) * 16 + g) * 64 + lane; a.out[O_SREP + si] = hr; a.out[O_SIMP + si] = hi; }
    }
    if (MODE == 0) __syncthreads();
    if (MODE >= 1) {
        __syncthreads();
        const bf16* WG = (const bf16*)(a.ws + WS_WGLU) + (size_t)layer * MIXW * MIXW;
        f32x4 acc[4][2];
#pragma unroll
        for (int mt = 0; mt < 4; ++mt) { acc[mt][0] = (f32x4){0.f, 0.f, 0.f, 0.f}; acc[mt][1] = (f32x4){0.f, 0.f, 0.f, 0.f}; }
#pragma unroll
        for (int ks = 0; ks < 8; ++ks) {
            const bf16x8 w0 = *(const bf16x8*)(WG + (size_t)(32 * wave + fr) * MIXW + 32 * ks + 8 * fq), w1 = *(const bf16x8*)(WG + (size_t)(32 * wave + 16 + fr) * MIXW + 32 * ks + 8 * fq);
#pragma unroll
            for (int mt = 0; mt < 4; ++mt) { const bf16x8 zb = *(LAS bf16x8*)(Zt + (16 * mt + fr) * 264 + 32 * ks + 8 * fq);
                acc[mt][0] = __builtin_amdgcn_mfma_f32_16x16x32_bf16(w0, zb, acc[mt][0], 0, 0, 0);
                acc[mt][1] = __builtin_amdgcn_mfma_f32_16x16x32_bf16(w1, zb, acc[mt][1], 0, 0, 0); }
        }
#pragma unroll
        for (int nl = 0; nl < 2; ++nl) { const int n0 = 32 * wave + 16 * nl + 4 * fq; const f32x4 bgl = *(const f32x4*)(a.in[I_BGLU] + layer * MIXW + n0);
#pragma unroll
            for (int mt = 0; mt < 4; ++mt) { const int tt = 16 * mt + fr; const v2u zz = *(LAS v2u*)(Zt + tt * 264 + n0);
                const float z0 = bflo(zz.x), z1 = bfhi(zz.x), z2 = bflo(zz.y), z3 = bfhi(zz.y);
                v2u w; w.x = pk2(z0 * sigm(acc[mt][nl][0] + bgl[0]), z1 * sigm(acc[mt][nl][1] + bgl[1])); w.y = pk2(z2 * sigm(acc[mt][nl][2] + bgl[2]), z3 * sigm(acc[mt][nl][3] + bgl[3]));
                *(v2u*)(BR + (size_t)(row0 + tt) * D + 256 + n0) = w; } }
        __syncthreads();
    }
}

__device__ __forceinline__ void gemm2_phase(LAS unsigned char* lds, const bf16* BRp, const bf16* WBT, const bf16* GT, bf16* MG, int G, int bid, int tidp) {
    using namespace pg8;
    int tid_ = tidp; asm volatile("" : "+v"(tid_));
    const int tid = tid_, wid = __builtin_amdgcn_readfirstlane(tid >> 6), lane = tid & 63, wr = wid >> 2, wc = wid & 3, fr = lane & 15, fq = lane >> 4;
    unsigned voffA0, voffB0;
    { int R, C; stage_rc(tid * 16, R, C); const int Rb = (R & ~31) + perm32(R & 31); voffA0 = (unsigned)(R * D + C) * 2u; voffB0 = (unsigned)(Rb * MIXW + C) * 2u; }
    const unsigned ldsw = (unsigned)wid * 1024u;
    const int aoff = lds_byte(wr * 64 + fr, fq * 8), boff = lds_byte(wc * 32 + fr, fq * 8);
    const unsigned gvoff = (unsigned)(fr * GTC + 8 * fq) * 2u;
    constexpr int STG = 49152;
#define G2_STAGE(it_, so_) do { const int kb_ = (it_) >> 2, kt_ = (it_) & 3; \
        const char* as_ = Abase + (size_t)(kb_ * 256 + kt_ * 64) * 2; const char* bs_ = Bbase + (size_t)kb_ * (D * MIXW * 2) + (size_t)kt_ * 128; \
        _Pragma("unroll") for (int _i = 0; _i < 2; ++_i) __builtin_amdgcn_global_load_lds((const unsigned*)(as_ + (size_t)_i * (64 * D * 2) + voffA0), (PG8_LAS unsigned*)(lds + (so_) + ldsw + _i * 8192), 16, 0, 0); \
        _Pragma("unroll") for (int _i = 0; _i < 2; ++_i) __builtin_amdgcn_global_load_lds((const unsigned*)(bs_ + (size_t)_i * (64 * MIXW * 2) + voffB0), (PG8_LAS unsigned*)(lds + (so_) + 16384 + ldsw + _i * 8192), 16, 0, 0); \
        _Pragma("unroll") for (int _i = 0; _i < 2; ++_i) __builtin_amdgcn_global_load_lds((const unsigned*)(bs_ + (size_t)(128 + 64 * _i) * MIXW * 2 + voffB0), (PG8_LAS unsigned*)(lds + (so_) + 32768 + ldsw + _i * 8192), 16, 0, 0); } while (0)
    const int vb = (G % 8 == 0) ? (bid % 8) * (G / 8) + bid / 8 : bid;
    constexpr int NUN = (MP / 128) * 4;
    for (int ui = vb; ui < NUN; ui += G) {
        const int pm = ui >> 2, pn = ui & 3;
        const char* Abase = (const char*)BRp + (size_t)pm * 128 * D * 2;
        const char* Bbase = (const char*)WBT + (size_t)pn * 256 * MIXW * 2;
        G2_STAGE(0, 0); G2_STAGE(1, STG);
        f32x4 mg[2][4][2], acc[2][4][2];
#pragma unroll
        for (int b = 0; b < 2; ++b)
#pragma unroll
            for (int m = 0; m < 4; ++m)
#pragma unroll
                for (int n = 0; n < 2; ++n) { mg[b][m][n] = (f32x4){0.f, 0.f, 0.f, 0.f}; acc[b][m][n] = (f32x4){0.f, 0.f, 0.f, 0.f}; }
        v4u gq[2][4];
        int so = 0, so2 = 2 * STG;
#pragma unroll 1
        for (int kb = 0; kb < 4; ++kb) {
#pragma unroll
            for (int kt = 0; kt < 4; ++kt) {
                if (kt < 2) asm volatile("s_waitcnt vmcnt(6)" ::: "memory");
                else if (kt == 3 && kb == 3) asm volatile("s_waitcnt vmcnt(8)" ::: "memory");
                else asm volatile("s_waitcnt vmcnt(14)" ::: "memory");
                __builtin_amdgcn_s_barrier(); asm volatile("" ::: "memory");
                if (kt < 2 || kb < 3) G2_STAGE(4 * kb + kt + 2, so2);
#pragma unroll
                for (int kk = 0; kk < 2; ++kk) {
                    bf16x8 At[4], B0[2], B1[2];
#pragma unroll
                    for (int m = 0; m < 4; ++m) At[m] = *(const PG8_LAS bf16x8*)(lds + so + aoff + m * 2048 + kk * 1024);
#pragma unroll
                    for (int n = 0; n < 2; ++n) { B0[n] = *(const PG8_LAS bf16x8*)(lds + so + 16384 + boff + n * 2048 + kk * 1024); B1[n] = *(const PG8_LAS bf16x8*)(lds + so + 32768 + boff + n * 2048 + kk * 1024); }
                    asm volatile("s_waitcnt lgkmcnt(0)" ::: "memory"); __builtin_amdgcn_sched_barrier(0);
#pragma unroll
                    for (int m = 0; m < 4; ++m)
#pragma unroll
                        for (int n = 0; n < 2; ++n) { acc[0][m][n] = __builtin_amdgcn_mfma_f32_16x16x32_bf16(B0[n], At[m], acc[0][m][n], 0, 0, 0);
                                                      acc[1][m][n] = __builtin_amdgcn_mfma_f32_16x16x32_bf16(B1[n], At[m], acc[1][m][n], 0, 0, 0); }
                }
                if (kt == 1) {
#pragma unroll
                    for (int m = 0; m < 4; ++m) { const bf16* gs = GT + (size_t)(pm * 128 + wr * 64 + m * 16) * GTC + kb * D + pn * 256 + wc * 32;
                        asm volatile("global_load_dwordx4 %0, %1, %2" : "=v"(gq[0][m]) : "v"(gvoff), "s"(gs) : "memory");
                        asm volatile("global_load_dwordx4 %0, %1, %2 offset:256" : "=v"(gq[1][m]) : "v"(gvoff), "s"(gs) : "memory"); }
                }
                so = so == 2 * STG ? 0 : so + STG; so2 = so2 == 2 * STG ? 0 : so2 + STG;
            }
            if (kb == 3) asm volatile("s_waitcnt vmcnt(0)" ::: "memory"); else asm volatile("s_waitcnt vmcnt(12)" ::: "memory");
            asm volatile("" : "+v"(gq[0][0]), "+v"(gq[0][1]), "+v"(gq[0][2]), "+v"(gq[0][3]), "+v"(gq[1][0]), "+v"(gq[1][1]), "+v"(gq[1][2]), "+v"(gq[1][3]));
#pragma unroll
            for (int b = 0; b < 2; ++b)
#pragma unroll
                for (int m = 0; m < 4; ++m) { float gv[8]; unpack8(gq[b][m], gv);
#pragma unroll
                    for (int j = 0; j < 4; ++j) { mg[b][m][0][j] += gv[j] * acc[b][m][0][j]; mg[b][m][1][j] += gv[4 + j] * acc[b][m][1][j]; }
                    acc[b][m][0] = (f32x4){0.f, 0.f, 0.f, 0.f}; acc[b][m][1] = (f32x4){0.f, 0.f, 0.f, 0.f}; }
        }
        asm volatile("" ::: "memory"); __builtin_amdgcn_s_barrier(); asm volatile("" ::: "memory");
#pragma unroll
        for (int b = 0; b < 2; ++b)
#pragma unroll
            for (int m = 0; m < 4; ++m) { const int row = pm * 128 + wr * 64 + m * 16 + fr, col = pn * 256 + b * 128 + wc * 32 + 8 * fq;
                v4u w; w.x = pk2(mg[b][m][0][0], mg[b][m][0][1]); w.y = pk2(mg[b][m][0][2], mg[b][m][0][3]); w.z = pk2(mg[b][m][1][0], mg[b][m][1][1]); w.w = pk2(mg[b][m][1][2], mg[b][m][1][3]);
                *(v4u*)(MG + (size_t)row * D + col) = w; }
    }
#undef G2_STAGE
}


#define TL_GLDS(src_, dst_) __builtin_amdgcn_global_load_lds((const unsigned*)(src_), (PG8_LAS unsigned*)(dst_), 16, 0, 0)
#define TL_STAGE(kt_, A_PTR, B_PTR) do { const int s_ = (kt_) & 3; const char* ap_ = A_PTR(kt_); const char* bp_ = B_PTR(kt_); \
        TL_GLDS(ap_ + voffA, lds + s_ * 32768 + ldsw); TL_GLDS(ap_ + voffA + 128, lds + s_ * 32768 + 8192 + ldsw); \
        TL_GLDS(bp_ + voffB, lds + s_ * 32768 + 16384 + ldsw); TL_GLDS(bp_ + voffB + 128, lds + s_ * 32768 + 24576 + ldsw); } while (0)
#define TL_LOOP(NK, A_PTR, B_PTR, AFTER_STEP) do { \
        TL_STAGE(0, A_PTR, B_PTR); if ((NK) > 1) TL_STAGE(1, A_PTR, B_PTR); if ((NK) > 2) TL_STAGE(2, A_PTR, B_PTR); \
        _Pragma("unroll 1") for (int kt = 0; kt < (NK); ++kt) { \
            if (kt + 2 < (NK)) asm volatile("s_waitcnt vmcnt(8)" ::: "memory"); else if (kt + 1 < (NK)) asm volatile("s_waitcnt vmcnt(4)" ::: "memory"); else asm volatile("s_waitcnt vmcnt(0)" ::: "memory"); \
            __builtin_amdgcn_s_barrier(); asm volatile("" ::: "memory"); \
            if (kt + 3 < (NK)) TL_STAGE(kt + 3, A_PTR, B_PTR); \
            const int sb_ = (kt & 3) * 32768; \
            _Pragma("unroll") for (int h_ = 0; h_ < 2; ++h_) { \
                const bf16x8 a0 = *(const PG8_LAS bf16x8*)(lds + sb_ + h_ * 8192 + aoff), a1 = *(const PG8_LAS bf16x8*)(lds + sb_ + h_ * 8192 + aoff + 1024); \
                const bf16x8 b00 = *(const PG8_LAS bf16x8*)(lds + sb_ + 16384 + h_ * 8192 + boff), b01 = *(const PG8_LAS bf16x8*)(lds + sb_ + 16384 + h_ * 8192 + boff + 1024); \
                const bf16x8 b10 = *(const PG8_LAS bf16x8*)(lds + sb_ + 16384 + h_ * 8192 + boff + 2048), b11 = *(const PG8_LAS bf16x8*)(lds + sb_ + 16384 + h_ * 8192 + boff + 3072); \
                asm volatile("s_waitcnt lgkmcnt(0)" ::: "memory"); __builtin_amdgcn_sched_barrier(0); \
                acc[0] = __builtin_amdgcn_mfma_f32_16x16x32_bf16(b00, a0, acc[0], 0, 0, 0); acc[1] = __builtin_amdgcn_mfma_f32_16x16x32_bf16(b10, a0, acc[1], 0, 0, 0); \
                acc[0] = __builtin_amdgcn_mfma_f32_16x16x32_bf16(b01, a1, acc[0], 0, 0, 0); acc[1] = __builtin_amdgcn_mfma_f32_16x16x32_bf16(b11, a1, acc[1], 0, 0, 0); } \
            AFTER_STEP(kt); } \
        asm volatile("s_waitcnt lgkmcnt(0)" ::: "memory"); __builtin_amdgcn_s_barrier(); asm volatile("" ::: "memory"); } while (0)
#define TL_SETUP(LDA, LDB) using namespace pg8; int tid_ = tidp; asm volatile("" : "+v"(tid_)); \
    const int tid = tid_, wid = __builtin_amdgcn_readfirstlane(tid >> 6), lane = tid & 63, fr = lane & 15, fq = lane >> 4, mt = wid >> 1, nh = wid & 1; \
    int R_, C_; stage_rc(tid * 16, R_, C_); \
    const unsigned voffA = (unsigned)(R_ * (LDA) + C_) * 2u, voffB = (unsigned)(R_ * (LDB) + C_) * 2u, ldsw = (unsigned)wid * 1024u; \
    const int aoff = lds_byte(mt * 16 + fr, fq * 8), boff = lds_byte(nh * 32 + fr, fq * 8); (void)lane
#define TL_NOP(kt_) do {} while (0)

struct CappedOrder : pg8::StaticOrder {
    int cap;
    __device__ bool next(int i, pg8::Unit& u) const { if ((long)i * G + c >= cap) return false; return pg8::StaticOrder::next(i, u); }
};
__device__ __forceinline__ void proj_tail_phase(LAS unsigned char* lds, const bf16* A, const bf16* Bt, int cap, const float* ssq, const float* bgate, bf16* PMp, bf16* GTp, int G, int bid, int tidp) {
    TL_SETUP(D, D);
    StaticOrder S1; S1.init(M, INC, 1, 0);
    const int nsub = (S1.nwg - cap) * 16;
    for (int t = bid; t < nsub; t += G) {
        Unit u; S1.next(cap + (t >> 4), u);
        const int rb = (t >> 2) & 3, cb = t & 3, r0 = u.pm * 256 + 64 * rb, c0 = u.pn * 256 + 64 * cb;
        const char* Ab = (const char*)A + (size_t)r0 * D * 2; const char* Bb = (const char*)Bt + (size_t)c0 * D * 2;
        f32x4 acc[2] = {(f32x4){0.f, 0.f, 0.f, 0.f}, (f32x4){0.f, 0.f, 0.f, 0.f}};
        const int row = r0 + 16 * mt + fr;
        const float rs = pg8::row_rstd(ssq, row);
        const bool isg = u.pn >= 7;
        f32x4 bvv[2];
#pragma unroll
        for (int n = 0; n < 2; ++n) bvv[n] = isg ? *(const f32x4*)(bgate + (c0 + 32 * nh + 16 * n + 4 * fq - PMC)) : (f32x4){0.f, 0.f, 0.f, 0.f};
#define PT_A(kt_) (Ab + (size_t)(kt_) * 256)
#define PT_B(kt_) (Bb + (size_t)(kt_) * 256)
        TL_LOOP(D / 128, PT_A, PT_B, TL_NOP);
#undef PT_A
#undef PT_B
#pragma unroll
        for (int n = 0; n < 2; ++n) { const int col = c0 + 32 * nh + 16 * n + 4 * fq; f32x4 v = acc[n] * rs;
            if (isg) { const f32x4 bv = bvv[n]; v = (f32x4){::sigm(v[0] + bv[0]), ::sigm(v[1] + bv[1]), ::sigm(v[2] + bv[2]), ::sigm(v[3] + bv[3])}; }
            v2u w; w.x = pk2(v[0], v[1]); w.y = pk2(v[2], v[3]);
            if (isg) *(v2u*)(GTp + (size_t)row * GTC + (col - PMC)) = w; else *(v2u*)(PMp + (size_t)row * PMC + col) = w; }
    }
}

__device__ __forceinline__ void gemm2_tail_phase(LAS unsigned char* lds, const bf16* BRp, const bf16* WBT, const bf16* GT, bf16* MG, int G, int bid, int tidp) {
    TL_SETUP(D, MIXW);
    for (int ui = bid; ui < 256; ui += G) {
        const int rb = ((ui & 7) >> 1) * 4 + (ui >> 6), cb = (ui & 1) * 8 + ((ui >> 3) & 7);
        const char* Ab = (const char*)BRp + (size_t)(MP + 64 * rb) * D * 2; const char* Bb = (const char*)WBT + (size_t)(64 * cb) * MIXW * 2;
        f32x4 acc[2] = {(f32x4){0.f, 0.f, 0.f, 0.f}, (f32x4){0.f, 0.f, 0.f, 0.f}}, mg[2] = {(f32x4){0.f, 0.f, 0.f, 0.f}, (f32x4){0.f, 0.f, 0.f, 0.f}};
        const int row = MP + 64 * rb + 16 * mt + fr;
#define G2T_A(kt_) (Ab + (size_t)(((kt_) >> 1) * 256 + ((kt_) & 1) * 128) * 2)
#define G2T_B(kt_) (Bb + (size_t)((kt_) >> 1) * (D * MIXW * 2) + (size_t)((kt_) & 1) * 256)
        v2u gwp[4][2];
#pragma unroll
        for (int kb = 0; kb < 4; ++kb)
#pragma unroll
            for (int n = 0; n < 2; ++n) gwp[kb][n] = *(const v2u*)(GT + (size_t)row * GTC + kb * D + 64 * cb + 32 * nh + 16 * n + 4 * fq);
#define G2T_AFTER(kt_) do { if ((kt_) & 1) { const int kb_ = (kt_) >> 1; \
            _Pragma("unroll") for (int n = 0; n < 2; ++n) { const v2u gw = kb_ == 0 ? gwp[0][n] : (kb_ == 1 ? gwp[1][n] : (kb_ == 2 ? gwp[2][n] : gwp[3][n])); \
                mg[n][0] += bflo(gw.x) * acc[n][0]; mg[n][1] += bfhi(gw.x) * acc[n][1]; mg[n][2] += bflo(gw.y) * acc[n][2]; mg[n][3] += bfhi(gw.y) * acc[n][3]; \
                acc[n] = (f32x4){0.f, 0.f, 0.f, 0.f}; } } } while (0)
        TL_LOOP(8, G2T_A, G2T_B, G2T_AFTER);
#undef G2T_A
#undef G2T_B
#undef G2T_AFTER
#pragma unroll
        for (int n = 0; n < 2; ++n) { v2u w; w.x = pk2(mg[n][0], mg[n][1]); w.y = pk2(mg[n][2], mg[n][3]); *(v2u*)(MG + (size_t)row * D + 64 * cb + 32 * nh + 16 * n + 4 * fq) = w; }
    }
}

__device__ __forceinline__ void resid_tail_phase(LAS unsigned char* lds, const bf16* A, const bf16* Bt, int K, const float* xs_old, bool first, bf16* XBp, float* ssq, int G, int bid, int tidp) {
    TL_SETUP(K, K);
    const int nk = K / 128;
    for (int ui = bid; ui < 256; ui += G) {
        const int rb = ((ui & 7) >> 1) * 4 + (ui >> 6), cb = (ui & 1) * 8 + ((ui >> 3) & 7);
        const char* Ab = (const char*)A + (size_t)(MP + 64 * rb) * K * 2; const char* Bb = (const char*)Bt + (size_t)(64 * cb) * K * 2;
        f32x4 acc[2] = {(f32x4){0.f, 0.f, 0.f, 0.f}, (f32x4){0.f, 0.f, 0.f, 0.f}};
        const int rowl = 16 * mt + fr, row = MP + 64 * rb + rowl; float ss = 0.f;
        f32x4 xold[2];
#pragma unroll
        for (int n = 0; n < 2; ++n) { const int col = 64 * cb + 32 * nh + 16 * n + 4 * fq;
            if (first) xold[n] = *(const f32x4*)(xs_old + (size_t)(row - MP) * D + col);
            else { const v2u q = *(const v2u*)(XBp + (size_t)row * D + col); xold[n] = (f32x4){bflo(q.x), bfhi(q.x), bflo(q.y), bfhi(q.y)}; } }
#define RT_A(kt_) (Ab + (size_t)(kt_) * 256)
#define RT_B(kt_) (Bb + (size_t)(kt_) * 256)
        TL_LOOP(nk, RT_A, RT_B, TL_NOP);
#undef RT_A
#undef RT_B
#pragma unroll
        for (int n = 0; n < 2; ++n) { const int col = 64 * cb + 32 * nh + 16 * n + 4 * fq;
            const f32x4 o = xold[n] + acc[n];
            v2u w; w.x = pk2(o[0], o[1]); w.y = pk2(o[2], o[3]); *(v2u*)(XBp + (size_t)row * D + col) = w;
            ss += (o[0] * o[0] + o[1] * o[1]) + (o[2] * o[2] + o[3] * o[3]); }
        ss += __shfl_xor(ss, 16); ss += __shfl_xor(ss, 32);
        LAS float* red = (LAS float*)lds;
        if (fq == 0) red[rowl * 2 + nh] = ss;
        __syncthreads();
        if (tid < 64) ssq[((size_t)(cb >> 2) * M + MP + 64 * rb + tid) * 4 + (cb & 3)] = red[tid * 2] + red[tid * 2 + 1];
        __syncthreads();
    }
}

__global__ void __launch_bounds__(NWAVES * 64, 2) hybrid_fwd(Args args) {
    extern __shared__ __attribute__((aligned(16))) unsigned char lds_raw[];
    LAS unsigned char* lds = (LAS unsigned char*)lds_raw;
    volatile LAS unsigned* MISC = (volatile LAS unsigned*)(lds + MISC_OFF);
    const int tid0 = threadIdx.x, wave0 = __builtin_amdgcn_readfirstlane(tid0 >> 6);
    const int G0 = gridDim.x, bid = blockIdx.x;
    unsigned char* ws = args.ws;
    for (int u = tid0; u < (LDS_BYTES - LDSCTL_OFF) / 4; u += NWAVES * 64) ((LAS unsigned*)(lds + LDSCTL_OFF))[u] = 0u;
    __syncthreads();
    const int lo = args.ph_lo, hi = args.ph_hi;
    XcdBarrier bar; bar.bar = (unsigned*)(ws + WS_CTL) + CW_BAR; bar.x = 0; bar.st = nullptr;
    if (hi - lo > 1) bar = xcd_barrier_post((unsigned*)(ws + WS_CTL) + CW_BAR, MISC + 8);
    bf16* XB = (bf16*)(ws + WS_ACT1); bf16* PMb = (bf16*)(ws + WS_PM); bf16* GTb = (bf16*)(ws + WS_GT);
    bf16* MGb = (bf16*)(ws + WS_PM); bf16* ACTb = (bf16*)(ws + WS_GT);
    float* ssq = (float*)(ws + WS_SSQ);
    for (int ph_i = lo; ph_i < hi; ++ph_i) {
        int ph = ph_i, G = G0; asm volatile("" : "+s"(ph), "+s"(G));
        int tid = wave0 * 64 + (int)__builtin_amdgcn_mbcnt_hi(~0u, __builtin_amdgcn_mbcnt_lo(~0u, 0u)); asm volatile("" : "+v"(tid)); const int lane = tid & 63, wave = __builtin_amdgcn_readfirstlane(tid >> 6);
        const int layer = (ph - 1) / 7, k = ph == 0 ? -1 : (ph == NPHASE - 1 ? 7 : (ph - 1) % 7);
        if (k == -1) p0_prologue(args, lds, tid, lane, wave, G, bid);
        else if (k == 7) final_norm(args, lane, wave, G, bid);
        else if (k == 0) {
            pg8::Gemm g{XB, (const bf16*)(ws + WS_WIN) + (size_t)layer * INC * D, M, INC, D}; CappedOrder S; S.init(M, INC, G, bid); S.cap = (S.nwg / G) * G;
            pg8::EpiProj E{PMb, GTb, ssq, args.in[I_BGATE] + (size_t)layer * GTC, (const LAS float*)(lds + RING_OFF + pg8::RSTD_LDS_OFF)};
            pg8::gemm_phase<pg8::EpiProj, CappedOrder, true, true>(lds + RING_OFF, g, S, E, tid);
            proj_tail_phase(lds + RING_OFF, XB, (const bf16*)(ws + WS_WIN) + (size_t)layer * INC * D, S.cap, ssq, args.in[I_BGATE] + (size_t)layer * GTC, PMb, GTb, G, bid, tid);
        } else if (k == 1) {
            for (int s_ = 0; ; ++s_) { int u;
                if (G == 256) { if (s_ > 2) break;
                    if (s_ == 0) u = 272 + ((bid + 240) & 255);
                    else if (bid < 16) { if (s_ == 2) break; u = 256 + bid; }
                    else if (bid < 80) { if (s_ == 2) break; u = 528 + (bid - 16); }
                    else { if (s_ == 2 && bid >= 152) break; const int v = (s_ == 1 ? 0 : 176) + (bid - 80); u = (v / 31) * 32 + v % 31; } }
                else { u = bid + s_ * G; if (u >= 256 + 16 + 256 + 64) break; }
                if (u < 256) { if ((u & 31) != NCH - 1) ssm_unit<0>(args, layer, u, lds, tid, lane, wave); }
                else if (u < 272) ssm_unit<2>(args, layer, u - 256, lds, tid, lane, wave);
                else if (u < 528) mix_unit<false>(args, layer, u - 272, lds, tid, lane, wave);
                else mix_unit<true>(args, layer, u - 528, lds, tid, lane, wave);
            }
        } else if (k == 2) {
            for (int u = bid; u < 256; u += G) ssm_unit<1>(args, layer, u, lds, tid, lane, wave);
        } else if (k == 3) {
            gemm2_phase(lds + RING_OFF, (const bf16*)args.out, (const bf16*)(ws + WS_WBR) + (size_t)layer * 4 * D * MIXW, GTb, MGb, G, bid, tid);
            gemm2_tail_phase(lds + RING_OFF, (const bf16*)args.out, (const bf16*)(ws + WS_WBR) + (size_t)layer * 4 * D * MIXW, GTb, MGb, G, bid, tid);
        } else if (k == 5) {
            pg8::Gemm g{XB, (const bf16*)(ws + WS_WFI) + (size_t)layer * 2 * FF * D, M, 2 * FF, D}; pg8::StaticOrder S; S.init(M, 2 * FF, G, bid);
            pg8::EpiSwiGLU E{ACTb, ssq, (const LAS float*)(lds + RING_OFF + pg8::RSTD_LDS_OFF)};
            pg8::gemm_phase<pg8::EpiSwiGLU, pg8::StaticOrder, true, true>(lds + RING_OFF, g, S, E, tid);
        } else {
            const bool isE = k == 4; const int K = isE ? D : FF;
            const bf16* Ap = isE ? MGb : ACTb; const bf16* Bp = isE ? (const bf16*)(ws + WS_WOUT) + (size_t)layer * D * D : (const bf16*)(ws + WS_WFO) + (size_t)layer * D * FF;
            const bool first = isE && layer == 0;
            { pg8::Gemm g{Ap, Bp, MP, D, K}; pg8::StaticOrder S; S.init(MP, D, G, bid);
              pg8::EpiResid E{args.in[I_XP], args.in[I_XS], first, XB, ssq};
              pg8::gemm_phase<pg8::EpiResid, pg8::StaticOrder, true, true>(lds + RING_OFF, g, S, E, tid); }
            resid_tail_phase(lds + RING_OFF, Ap, Bp, K, args.in[I_XS], first, XB, ssq, G, bid, tid);
        }
        if (ph_i + 1 < hi) {
            asm volatile("s_waitcnt vmcnt(0)" ::: "memory"); __syncthreads();
            if (tid == 0) xcd_barrier_leader(bar);
            else if (!MK_PER_PHASE && wave != 0 && k >= 0 && k < P0_SLICES && layer + 1 < NLAYER) p0_slice(args, lds, lane, wave, G, bid, layer + 1, k);
            __syncthreads();
        }
    }
}

extern "C" void kernel_launch(void* const* d_in, const int* in_sizes, int n_in, void* d_out, int out_size, void* d_ws, size_t ws_size, hipStream_t stream) {
    static int grid = 0;
    if (grid == 0) {
        if (n_in != 32 || out_size != (int)O_END || ws_size < WS_END) { fprintf(stderr, "kernel_launch: expected 32 inputs, %zu outputs, >= %zu bytes of workspace; got %d, %d, %zu; nothing launched\n", (size_t)O_END, (size_t)WS_END, n_in, out_size, ws_size); grid = -1; return; }
        int dev = 0, cus = 0, per_cu = 0;
        if (hipGetDevice(&dev) != hipSuccess || hipDeviceGetAttribute(&cus, hipDeviceAttributeMultiprocessorCount, dev) != hipSuccess) { grid = -1; return; }
        if (hipFuncSetAttribute((const void*)hybrid_fwd, hipFuncAttributeMaxDynamicSharedMemorySize, LDS_BYTES) != hipSuccess) { fprintf(stderr, "kernel_launch: hipFuncSetAttribute failed\n"); grid = -1; return; }
        if (hipOccupancyMaxActiveBlocksPerMultiprocessor(&per_cu, (const void*)hybrid_fwd, NWAVES * 64, LDS_BYTES) != hipSuccess || per_cu < 1) { fprintf(stderr, "kernel_launch: occupancy query says %d blocks per CU; nothing launched\n", per_cu); (void)hipGetLastError(); grid = -1; return; }
        grid = cus;
    }
    if (grid < 0) return;
    (void)hipMemsetAsync((char*)d_ws + WS_CTL, 0, CTL_ZERO_BYTES, stream);
    Args a{};
    for (int i = 0; i < 32; ++i) a.in[i] = (const float*)d_in[i];
    a.out = (float*)d_out; a.ws = (unsigned char*)d_ws;
#if MK_PER_PHASE
    for (int k = 0; k < NPHASE; ++k) { a.ph_lo = k; a.ph_hi = k + 1; hipLaunchKernelGGL(hybrid_fwd, dim3(grid), dim3(NWAVES * 64), LDS_BYTES, stream, a); }
#else
    a.ph_lo = 0; a.ph_hi = NPHASE;
    hipLaunchKernelGGL(hybrid_fwd, dim3(grid), dim3(NWAVES * 64), LDS_BYTES, stream, a);
#endif
}
```

```cpp
#include <hip/hip_runtime.h>
#include <cstdio>
#include <cstdint>
#ifndef XPF_LEAD
#define XPF_LEAD 2
#endif
namespace pg8 {
#define PG8_LAS __attribute__((address_space(3)))
typedef unsigned short bf16_t;
typedef short bf16x8 __attribute__((ext_vector_type(8)));
typedef float f32x4 __attribute__((ext_vector_type(4)));
typedef unsigned u32x4 __attribute__((ext_vector_type(4)));
constexpr int BM = 256, BK = 64, HALF = 128, HTB = HALF * BK * 2  , STAGE_BYTES = 8 * HTB, NXCD = 8, WGM = 8, RSTD_LDS_OFF = 147456 + 320 + 1024  , RSTD_RAW_OFF = RSTD_LDS_OFF + 1024  , BIAS_LDS_OFF = RSTD_RAW_OFF + 8192  ;

__host__ __device__ __forceinline__ int lds_byte(int r, int c) { const int st = (r >> 4) * 2 + (c >> 5), rr = r & 15, cc = c & 31, ob = rr * 64 + cc * 2; return st * 1024 + (ob ^ (((ob >> 9) & 1) << 5)); }
__host__ __device__ __forceinline__ void stage_rc(int b, int& R, int& C) { const int st = b / 1024, sb = b % 1024, swz = sb ^ (((sb >> 9) & 1) << 5); R = (st >> 1) * 16 + swz / 64; C = (st & 1) * 32 + (swz % 64) / 2; }
__host__ __device__ __forceinline__ int perm32(int rho) { const int n = rho >> 4, i = rho & 15; return 8 * (i >> 2) + 4 * n + (i & 3); }

struct Unit { int pm, pn; };
struct Gemm { const bf16_t* A; const bf16_t* Bt; int M, N, K; };

struct StaticOrder {
    int nM, nN, nwg, G, c;
    __host__ __device__ void init(int M, int N, int G_, int c_) { nM = M / BM; nN = N / BM; nwg = nM * nN; G = G_; c = c_; }
    __host__ __device__ bool next(int i, Unit& u) const {
        const long L = (long)i * G + c; if (L >= nwg) return false;
        int wgid = (int)L; { const int q = nwg / NXCD, r = nwg % NXCD, xcd = wgid % NXCD, off = wgid / NXCD; wgid = (xcd < r ? xcd * (q + 1) : r * (q + 1) + (xcd - r) * q) + off; }
        const int nig = WGM * nN, gid = wgid / nig, fm = gid * WGM, gsz = (nM - fm) < WGM ? (nM - fm) : WGM;
        u.pm = fm + ((wgid % nig) % gsz); u.pn = (wgid % nig) / gsz; return true;
    }
    __device__ __forceinline__ void a_ready(const Unit&) const {}
    __device__ __forceinline__ void done(const Unit&) const {}
};
typedef float f32x2 __attribute__((ext_vector_type(2)));
typedef __bf16 bf16x2_t __attribute__((ext_vector_type(2)));
__device__ __forceinline__ unsigned cvt_pk_bf16(float lo, float hi) { f32x2 v = {lo, hi}; bf16x2_t b = __builtin_convertvector(v, bf16x2_t); return __builtin_bit_cast(unsigned, b); }
__device__ __forceinline__ float sigm(float x) { return __builtin_amdgcn_rcpf(1.0f + __builtin_amdgcn_exp2f(-1.4426950408889634f * x)); }
__device__ __forceinline__ float row_rstd(const float* ssq, int row) {
    const f32x4 a = *(const f32x4*)(ssq + ((size_t)0 * 17408 + row) * 4), b = *(const f32x4*)(ssq + ((size_t)1 * 17408 + row) * 4),
                c = *(const f32x4*)(ssq + ((size_t)2 * 17408 + row) * 4), d = *(const f32x4*)(ssq + ((size_t)3 * 17408 + row) * 4);
    const float s = (((a[0] + a[1]) + (a[2] + a[3])) + ((b[0] + b[1]) + (b[2] + b[3]))) + (((c[0] + c[1]) + (c[2] + c[3])) + ((d[0] + d[1]) + (d[2] + d[3])));
    return __builtin_amdgcn_rsqf(s * (1.0f / 1024.0f) + 1e-6f);
}
__device__ __forceinline__ void rows_rstd(const float* ssq, int row0, int fq, float (&rs)[2][4]) {
#pragma unroll
    for (int ai = 0; ai < 2; ++ai)
#pragma unroll
        for (int m = 0; m < 4; ++m) { const f32x4 p = *(const f32x4*)(ssq + ((size_t)fq * 17408 + row0 + ai * HALF + m * 16) * 4); rs[ai][m] = (p[0] + p[1]) + (p[2] + p[3]); }
#pragma unroll
    for (int ai = 0; ai < 2; ++ai)
#pragma unroll
        for (int m = 0; m < 4; ++m) { float s = rs[ai][m]; s += __shfl_xor(s, 16); s += __shfl_xor(s, 32); rs[ai][m] = __builtin_amdgcn_rsqf(s * (1.0f / 1024.0f) + 1e-6f); }
}
__device__ __forceinline__ void rows_rstd_lds(const PG8_LAS float* rl, int r0, float (&rs)[2][4]) {
#pragma unroll
    for (int ai = 0; ai < 2; ++ai)
#pragma unroll
        for (int m = 0; m < 4; ++m) rs[ai][m] = rl[r0 + ai * HALF + m * 16];
}
struct EpiNull {
    static constexpr bool PERM = true, AFTER_DRAIN = false, RSTD_LDS = false, XPREFETCH = false;
    __device__ __forceinline__ void operator()(const f32x4 (&acc)[2][2][4][2], const Unit& u, int wr, int wc, int fr, int fq) const {
#pragma unroll
        for (int ai = 0; ai < 2; ++ai)
#pragma unroll
            for (int bj = 0; bj < 2; ++bj)
#pragma unroll
                for (int m = 0; m < 4; ++m) { asm volatile("" :: "v"(acc[ai][bj][m][0]), "v"(acc[ai][bj][m][1])); }
    }
};
struct EpiProj {
    static constexpr bool PERM = true, AFTER_DRAIN = false, RSTD_LDS = true, XPREFETCH = false;
    bf16_t* PM; bf16_t* GT; const float* ssq; const float* bgate; const PG8_LAS float* rl;
    __device__ __forceinline__ void operator()(const f32x4 (&acc)[2][2][4][2], const Unit& u, int wr, int wc, int fr, int fq) const {
        const int row0 = u.pm * BM + wr * 64 + fr;
        const bool isg = u.pn >= 7;
        const int lc0 = (isg ? (u.pn - 7) * BM : u.pn * BM) + wc * 32 + 8 * fq;
        bf16_t* base = isg ? GT : PM; const int ldc = isg ? 4096 : 1792;
        constexpr float NL2E = -1.4426950408889634f;
        f32x4 bv[2][2];
#pragma unroll
        for (int bj = 0; bj < 2; ++bj)
#pragma unroll
            for (int n = 0; n < 2; ++n) bv[bj][n] = isg ? *(const f32x4*)(bgate + lc0 + bj * HALF + 4 * n) * NL2E : (f32x4){0.f, 0.f, 0.f, 0.f};
        float rsv[2][4]; rows_rstd_lds(rl, wr * 64 + fr, rsv);
#pragma unroll
        for (int ai = 0; ai < 2; ++ai)
#pragma unroll
            for (int m = 0; m < 4; ++m) { const int row = row0 + ai * HALF + m * 16;
                const float rs = isg ? rsv[ai][m] * NL2E : rsv[ai][m];
                bf16_t* rowp = base + (size_t)row * ldc + lc0;
#pragma unroll
                for (int bj = 0; bj < 2; ++bj) { f32x4 v0 = acc[ai][bj][m][0] * rs + bv[bj][0], v1 = acc[ai][bj][m][1] * rs + bv[bj][1];
                    if (isg) {
#pragma unroll
                        for (int j = 0; j < 4; ++j) { v0[j] = __builtin_amdgcn_rcpf(1.0f + __builtin_amdgcn_exp2f(v0[j])); v1[j] = __builtin_amdgcn_rcpf(1.0f + __builtin_amdgcn_exp2f(v1[j])); } }
                    u32x4 w; w.x = cvt_pk_bf16(v0[0], v0[1]); w.y = cvt_pk_bf16(v0[2], v0[3]); w.z = cvt_pk_bf16(v1[0], v1[1]); w.w = cvt_pk_bf16(v1[2], v1[3]);
                    *(u32x4*)(rowp + bj * HALF) = w; } }
    }
};
struct EpiResid {
    static constexpr bool PERM = true, AFTER_DRAIN = false, RSTD_LDS = false, XPREFETCH = true;
    const float* xp; const float* xs; bool first; bf16_t* XB; float* ssq;
    __device__ __forceinline__ void prefetch(const Unit& u, PG8_LAS unsigned char* dump, int tid) const {
        if (first) return;
        const unsigned vo = (unsigned)(tid >> 2) * 2048u + (unsigned)(tid & 3) * 128u;
        const char* base = (const char*)(XB + (size_t)u.pm * BM * 1024 + u.pn * BM);
        __builtin_amdgcn_global_load_lds((const unsigned*)(base + vo), (PG8_LAS unsigned*)dump, 4, 0, 0);
        __builtin_amdgcn_global_load_lds((const unsigned*)(base + (size_t)128 * 2048 + vo), (PG8_LAS unsigned*)dump, 4, 0, 0);
    }
    __device__ __forceinline__ void operator()(const f32x4 (&acc)[2][2][4][2], const Unit& u, int wr, int wc, int fr, int fq) const {
        const int row0 = u.pm * BM + wr * 64 + fr, col0 = u.pn * BM + wc * 32 + 8 * fq;
#pragma unroll
        for (int ai = 0; ai < 2; ++ai)
#pragma unroll
            for (int m = 0; m < 4; ++m) { const int row = row0 + ai * HALF + m * 16;
                bf16_t* dstb = XB + (size_t)row * 1024 + col0; float ss = 0.f;
                f32x4 x0[2], x1[2];
                if (first) { const float* src = (row < 16384 ? xp + (size_t)row * 1024 : xs + (size_t)(row - 16384) * 1024) + col0;
#pragma unroll
                    for (int bj = 0; bj < 2; ++bj) { x0[bj] = *(const f32x4*)(src + bj * HALF); x1[bj] = *(const f32x4*)(src + bj * HALF + 4); } }
                else {
#pragma unroll
                    for (int bj = 0; bj < 2; ++bj) { const u32x4 q = *(const u32x4*)(dstb + bj * HALF);
                        x0[bj] = (f32x4){__builtin_bit_cast(float, q.x << 16), __builtin_bit_cast(float, q.x & 0xffff0000u), __builtin_bit_cast(float, q.y << 16), __builtin_bit_cast(float, q.y & 0xffff0000u)};
                        x1[bj] = (f32x4){__builtin_bit_cast(float, q.z << 16), __builtin_bit_cast(float, q.z & 0xffff0000u), __builtin_bit_cast(float, q.w << 16), __builtin_bit_cast(float, q.w & 0xffff0000u)}; } }
#pragma unroll
                for (int bj = 0; bj < 2; ++bj) { const f32x4 o0 = x0[bj] + acc[ai][bj][m][0], o1 = x1[bj] + acc[ai][bj][m][1];
                    u32x4 w; w.x = cvt_pk_bf16(o0[0], o0[1]); w.y = cvt_pk_bf16(o0[2], o0[3]); w.z = cvt_pk_bf16(o1[0], o1[1]); w.w = cvt_pk_bf16(o1[2], o1[3]);
                    *(u32x4*)(dstb + bj * HALF) = w;
                    ss += ((o0[0] * o0[0] + o0[1] * o0[1]) + (o0[2] * o0[2] + o0[3] * o0[3])) + ((o1[0] * o1[0] + o1[1] * o1[1]) + (o1[2] * o1[2] + o1[3] * o1[3])); }
                ss += __shfl_xor(ss, 16); ss += __shfl_xor(ss, 32);
                if (fq == 0) ssq[((size_t)u.pn * 17408 + row) * 4 + wc] = ss; }
    }
};
struct EpiSwiGLU {
    static constexpr bool PERM = true, AFTER_DRAIN = false, RSTD_LDS = true, XPREFETCH = false;
    bf16_t* ACT; const float* ssq; const PG8_LAS float* rl;
    __device__ __forceinline__ void operator()(const f32x4 (&acc)[2][2][4][2], const Unit& u, int wr, int wc, int fr, int fq) const {
        const int row0 = u.pm * BM + wr * 64 + fr, col0 = u.pn * HALF + wc * 32 + 8 * fq;
        float rsv[2][4]; rows_rstd_lds(rl, wr * 64 + fr, rsv);
#pragma unroll
        for (int ai = 0; ai < 2; ++ai)
#pragma unroll
            for (int m = 0; m < 4; ++m) { const int row = row0 + ai * HALF + m * 16;
                const float rs = rsv[ai][m], rsn = rs * -1.4426950408889634f, rs2 = rs * rs;
                float o[8];
#pragma unroll
                for (int j = 0; j < 4; ++j) { const float a0 = acc[ai][0][m][0][j], a1 = acc[ai][0][m][1][j];
                    o[j] = (a0 * acc[ai][1][m][0][j]) * (__builtin_amdgcn_rcpf(1.0f + __builtin_amdgcn_exp2f(a0 * rsn)) * rs2); o[4 + j] = (a1 * acc[ai][1][m][1][j]) * (__builtin_amdgcn_rcpf(1.0f + __builtin_amdgcn_exp2f(a1 * rsn)) * rs2); }
                u32x4 w; w.x = cvt_pk_bf16(o[0], o[1]); w.y = cvt_pk_bf16(o[2], o[3]); w.z = cvt_pk_bf16(o[4], o[5]); w.w = cvt_pk_bf16(o[6], o[7]);
                *(u32x4*)(ACT + (size_t)row * 2816 + col0) = w; }
    }
};

template <class Epi, class Sched, bool ALIGN_EPI = false, bool SP2 = false>
__device__ __forceinline__ void gemm_phase(PG8_LAS unsigned char* lds, const Gemm g, const Sched& S, const Epi& E, int tidp) {
    int tid_ = tidp; asm volatile("" : "+v"(tid_));
    const int tid = tid_, wid = __builtin_amdgcn_readfirstlane(tid >> 6), lane = tid & 63, wr = wid >> 2, wc = wid & 3, fr = lane & 15, fq = lane >> 4;
    const int K = g.K, nt = K / BK;
    unsigned voffA[2], voffB[2];
#pragma unroll
    for (int i = 0; i < 2; ++i) { int R, C; stage_rc(tid * 16 + i * 8192, R, C); const int Rb = Epi::PERM ? ((R & ~31) + perm32(R & 31)) : R;
        voffA[i] = (unsigned)(R * K + C) * 2u; voffB[i] = (unsigned)(Rb * K + C) * 2u; }
    const size_t kstep = (size_t)(BK * 2);
    const size_t hstep = (size_t)HALF * K * 2;
    const size_t tstep = 2 * hstep;
    const unsigned ldsw = (unsigned)wid * 1024u;
    const int aoff = lds_byte(wr * 64 + fr, fq * 8), boff = lds_byte(wc * 32 + fr, fq * 8);
#define PG8_SA(b, h) (((b) * 2 + (h)) * HTB)
#define PG8_SB(b, h) ((4 + (b) * 2 + (h)) * HTB)
#define PG8_STAGE(bufoff, gbase, voff) do { _Pragma("unroll") for (int _i = 0; _i < 2; ++_i) \
        __builtin_amdgcn_global_load_lds((const unsigned*)((const char*)(gbase) + (voff)[_i]), (PG8_LAS unsigned*)(lds + (bufoff) + ldsw + _i * 8192), 16, 0, 0); } while (0)
#define PG8_LDA(dst, b, h) do { _Pragma("unroll") for (int m = 0; m < 4; ++m) _Pragma("unroll") for (int k = 0; k < 2; ++k) dst[m][k] = *(const PG8_LAS bf16x8*)(lds + PG8_SA(b, h) + aoff + m * 2048 + k * 1024); } while (0)
#define PG8_LDB(dst, b, h) do { _Pragma("unroll") for (int n = 0; n < 2; ++n) _Pragma("unroll") for (int k = 0; k < 2; ++k) dst[n][k] = *(const PG8_LAS bf16x8*)(lds + PG8_SB(b, h) + boff + n * 2048 + k * 1024); } while (0)
#define PG8_MMA(ai, bj, At, Bt) do { __builtin_amdgcn_s_setprio(1); _Pragma("unroll") for (int m = 0; m < 4; ++m) _Pragma("unroll") for (int n = 0; n < 2; ++n) _Pragma("unroll") for (int k = 0; k < 2; ++k) \
        acc[ai][bj][m][n] = __builtin_amdgcn_mfma_f32_16x16x32_bf16(Bt[n][k], At[m][k], acc[ai][bj][m][n], 0, 0, 0); __builtin_amdgcn_s_setprio(0); } while (0)
#define PG8_WAIT_V(n) asm volatile("s_waitcnt vmcnt(" #n ")" ::: "memory")
#define PG8_WAIT_L(n) asm volatile("s_waitcnt lgkmcnt(" #n ")" ::: "memory")
#define PG8_BAR __builtin_amdgcn_s_barrier()
#define PG8_SCHED __builtin_amdgcn_sched_barrier(0)
    Unit cur, nxt; int ui = 0;
    if (!S.next(0, cur)) return;
    f32x4 acc[2][2][4][2];
#pragma unroll
    for (int a = 0; a < 2; ++a)
#pragma unroll
        for (int b = 0; b < 2; ++b)
#pragma unroll
            for (int m = 0; m < 4; ++m)
#pragma unroll
                for (int n = 0; n < 2; ++n) acc[a][b][m][n] = (f32x4){0.f, 0.f, 0.f, 0.f};
    bf16x8 At[4][2], B0[2][2], B1[2][2];
    const char* cA = (const char*)g.A + (size_t)cur.pm * tstep; const char* cB = (const char*)g.Bt + (size_t)cur.pn * tstep;
    S.a_ready(cur);
    if constexpr (SP2) {
        PG8_STAGE(PG8_SB(0, 0), cB, voffB); PG8_STAGE(PG8_SB(0, 1), cB + hstep, voffB); PG8_STAGE(PG8_SA(0, 0), cA, voffA); PG8_STAGE(PG8_SA(0, 1), cA + hstep, voffA);
        if (wr == 1) PG8_BAR;
        PG8_WAIT_V(2); PG8_BAR;
        PG8_STAGE(PG8_SB(1, 0), cB + kstep, voffB); PG8_STAGE(PG8_SA(1, 0), cA + kstep, voffA); PG8_STAGE(PG8_SB(1, 1), cB + hstep + kstep, voffB);
        PG8_WAIT_V(6); PG8_BAR;
    } else {
        PG8_STAGE(PG8_SB(0, 0), cB, voffB); PG8_STAGE(PG8_SA(0, 0), cA, voffA); PG8_STAGE(PG8_SB(0, 1), cB + hstep, voffB); PG8_STAGE(PG8_SA(0, 1), cA + hstep, voffA);
        if (wr == 1) PG8_BAR;
        PG8_WAIT_V(4); PG8_BAR;
        PG8_STAGE(PG8_SB(1, 0), cB + kstep, voffB); PG8_STAGE(PG8_SA(1, 0), cA + kstep, voffA); PG8_STAGE(PG8_SB(1, 1), cB + hstep + kstep, voffB);
        PG8_WAIT_V(6); PG8_BAR;
    }
    for (;;) {
        const bool has_next = S.next(ui + 1, nxt);
        const char* nA = has_next ? (const char*)g.A + (size_t)nxt.pm * tstep : cA; const char* nB = has_next ? (const char*)g.Bt + (size_t)nxt.pn * tstep : cB;
#ifdef DBG_KLOOP_T
        if (ui == DBG_KLOOP_UNIT + 1 && blockIdx.x == DBG_T_BLK && tid == 0) { ((volatile PG8_LAS unsigned long long*)(lds + 147456 + 320 + 256))[8] = __builtin_amdgcn_s_memtime(); }
        if (ui == DBG_KLOOP_UNIT && blockIdx.x == DBG_T_BLK && tid == 0) { ((volatile PG8_LAS unsigned long long*)(lds + 147456 + 320 + 256))[4] = __builtin_amdgcn_s_memtime(); ((volatile PG8_LAS unsigned long long*)(lds + 147456 + 320 + 256))[5] = __builtin_amdgcn_s_memrealtime(); }
#endif
        for (int t = 0; t < nt; t += 2) {
            const bool last = (t == nt - 2);
            if constexpr (Epi::RSTD_LDS) {
                if (t == 2 || t == 4) { PG8_WAIT_V(8);
                    const f32x4 v = *(const PG8_LAS f32x4*)(lds + RSTD_RAW_OFF + ldsw + lane * 16);
                    float s = (v[0] + v[1]) + (v[2] + v[3]); s += __shfl_xor(s, 1); s += __shfl_xor(s, 2);
                    if (!(tid & 3)) *(PG8_LAS float*)(lds + RSTD_LDS_OFF + ((t - 2) * 64 + (tid >> 2)) * 4) = __builtin_amdgcn_rsqf(s * (1.0f / 1024.0f) + 1e-6f);
                    PG8_WAIT_L(0); }
                if (t == 0 || t == 2) __builtin_amdgcn_global_load_lds((const unsigned*)(E.ssq + ((size_t)(tid & 3) * 17408 + (size_t)cur.pm * BM + t * 64 + (tid >> 2)) * 4), (PG8_LAS unsigned*)(lds + RSTD_RAW_OFF + ldsw), 16, 0, 0);
            }
            if constexpr (Epi::XPREFETCH) { if (t == nt - XPF_LEAD) E.prefetch(cur, lds + RSTD_RAW_OFF + ldsw, tid); }
            const char* a1 = cA + (size_t)(t + 1) * kstep;
            const char* a2 = last ? nA : cA + (size_t)(t + 2) * kstep; const char* b2 = last ? nB : cB + (size_t)(t + 2) * kstep;
            const char* a3 = a2 + kstep; const char* b3 = b2 + kstep;
            if (last && has_next) S.a_ready(nxt);
            if constexpr (SP2) {
            PG8_LDB(B0, 0, 0); PG8_LDB(B1, 0, 1); PG8_SCHED; PG8_LDA(At, 0, 0); PG8_STAGE(PG8_SA(1, 1), a1 + hstep, voffA);
            PG8_WAIT_V(8); PG8_WAIT_L(0); PG8_BAR; PG8_MMA(0, 0, At, B0); PG8_MMA(0, 1, At, B1); PG8_BAR; PG8_SCHED;
            PG8_LDA(At, 0, 1); PG8_STAGE(PG8_SB(0, 0), b2, voffB); PG8_STAGE(PG8_SB(0, 1), b2 + hstep, voffB); PG8_STAGE(PG8_SA(0, 0), a2, voffA);
            PG8_WAIT_V(8); PG8_WAIT_L(0); PG8_BAR; PG8_MMA(1, 0, At, B0); PG8_MMA(1, 1, At, B1); PG8_BAR; PG8_SCHED;
            PG8_LDB(B0, 1, 0); PG8_LDB(B1, 1, 1); PG8_SCHED; PG8_LDA(At, 1, 0); PG8_STAGE(PG8_SA(0, 1), a2 + hstep, voffA);
            PG8_WAIT_V(8); PG8_WAIT_L(0); PG8_BAR; PG8_MMA(0, 0, At, B0); PG8_MMA(0, 1, At, B1); PG8_BAR; PG8_SCHED;
            PG8_LDA(At, 1, 1); PG8_STAGE(PG8_SB(1, 0), b3, voffB); PG8_STAGE(PG8_SB(1, 1), b3 + hstep, voffB); PG8_STAGE(PG8_SA(1, 0), a3, voffA);
            PG8_WAIT_V(8); PG8_WAIT_L(0); PG8_BAR; PG8_MMA(1, 0, At, B0); PG8_MMA(1, 1, At, B1); PG8_BAR; PG8_SCHED;
            } else {
            PG8_LDB(B0, 0, 0); PG8_SCHED; PG8_LDA(At, 0, 0); PG8_STAGE(PG8_SA(1, 1), a1 + hstep, voffA);
            PG8_WAIT_L(8); PG8_BAR; PG8_WAIT_L(0); PG8_MMA(0, 0, At, B0); PG8_BAR; PG8_SCHED;
            PG8_LDB(B1, 0, 1); PG8_STAGE(PG8_SB(0, 0), b2, voffB);
            PG8_BAR; PG8_WAIT_L(0); PG8_MMA(0, 1, At, B1); PG8_BAR;
            PG8_LDA(At, 0, 1); PG8_STAGE(PG8_SA(0, 0), a2, voffA);
            PG8_BAR; PG8_WAIT_L(0); PG8_MMA(1, 0, At, B0); PG8_BAR; PG8_SCHED;
            PG8_STAGE(PG8_SB(0, 1), b2 + hstep, voffB);
            PG8_WAIT_V(6); PG8_BAR; PG8_MMA(1, 1, At, B1); PG8_BAR;
            PG8_LDB(B0, 1, 0); PG8_SCHED; PG8_LDA(At, 1, 0); PG8_STAGE(PG8_SA(0, 1), a2 + hstep, voffA);
            PG8_WAIT_L(8); PG8_BAR; PG8_WAIT_L(0); PG8_MMA(0, 0, At, B0); PG8_BAR; PG8_SCHED;
            PG8_LDB(B1, 1, 1); PG8_STAGE(PG8_SB(1, 0), b3, voffB);
            PG8_BAR; PG8_WAIT_L(0); PG8_MMA(0, 1, At, B1); PG8_BAR;
            PG8_LDA(At, 1, 1); PG8_STAGE(PG8_SA(1, 0), a3, voffA);
            PG8_BAR; PG8_WAIT_L(0); PG8_MMA(1, 0, At, B0); PG8_BAR; PG8_SCHED;
            PG8_STAGE(PG8_SB(1, 1), b3 + hstep, voffB);
            PG8_WAIT_V(6); PG8_BAR; PG8_MMA(1, 1, At, B1); PG8_BAR;
            }
        }
#ifdef DBG_KLOOP_T
        if (ui == DBG_KLOOP_UNIT && blockIdx.x == DBG_T_BLK && tid == 0) { ((volatile PG8_LAS unsigned long long*)(lds + 147456 + 320 + 256))[6] = __builtin_amdgcn_s_memtime(); ((volatile PG8_LAS unsigned long long*)(lds + 147456 + 320 + 256))[7] = __builtin_amdgcn_s_memrealtime(); }
#endif
        if constexpr (ALIGN_EPI) { if (wr == 0) PG8_BAR; }
        if constexpr (!Epi::AFTER_DRAIN) { E(acc, cur, wr, wc, fr, fq); S.done(cur); }
        if (!has_next) break;
#pragma unroll
        for (int a = 0; a < 2; ++a)
#pragma unroll
            for (int b = 0; b < 2; ++b)
#pragma unroll
                for (int m = 0; m < 4; ++m)
#pragma unroll
                    for (int n = 0; n < 2; ++n) acc[a][b][m][n] = (f32x4){0.f, 0.f, 0.f, 0.f};
        cur = nxt; cA = nA; cB = nB; ++ui;
        if constexpr (ALIGN_EPI) { if (wr == 1) PG8_BAR; }
    }
    PG8_WAIT_V(0);
    if constexpr (!ALIGN_EPI) { if (wr == 0) PG8_BAR; }
    PG8_BAR;
    if constexpr (Epi::AFTER_DRAIN) { E.fused(acc, cur, wr, wc, fr, fq, lds, wid, lane); S.done(cur); }
#undef PG8_SA
#undef PG8_SB
#undef PG8_STAGE
#undef PG8_LDA
#undef PG8_LDB
#undef PG8_MMA
#undef PG8_WAIT_V
#undef PG8_WAIT_L
#undef PG8_BAR
#undef PG8_SCHED
}
}
constexpr int D = 1024, MP = 16384, MS = 1024, M = MP + MS, NLAYER = 4, MIXW = 256, INC = 5888, PMC = 1792, GTC = 4096, FF = 2816;
constexpr int SEQ = 2048, NB = 8, DB = 128, DSEQ = 8, NCH = SEQ / 64;
constexpr int NPHASE = 2 + 7 * NLAYER;
#ifndef MK_PER_PHASE
#define MK_PER_PHASE 0
#endif
constexpr size_t O_Y = 0, O_POOLP = 17825792, O_POOLS = 17948672, O_SREP = 19914752, O_SRES = 19947520, O_SIMP = 20471808, O_SIMS = 20504576,
                 O_SCP = 21028864, O_SCS = 21045248, O_CFP = 21307392, O_CFS = 21553152, O_END = 25485312;
constexpr size_t MiB = 1u << 20;
constexpr size_t WS_CTL = 0, CTL_ZERO_BYTES = 64 * 1024;
constexpr size_t WS_SSQ = 1 * MiB;
constexpr size_t WS_E = 3 * MiB;
constexpr size_t WS_TAB = 5 * MiB;
constexpr size_t TAB_LB = 0, TAB_LP = 8192, TAB_BBT = 16384, TAB_CM = TAB_BBT + 65536, TAB_PW = TAB_CM + 65536, TAB_STRIDE = TAB_PW + 32768;
constexpr size_t WS_WIN = 6 * MiB;
constexpr size_t WS_WFI = WS_WIN + (size_t)NLAYER * INC * D * 2;
constexpr size_t WS_WOUT = WS_WFI + (size_t)NLAYER * 2 * FF * D * 2;
constexpr size_t WS_WFO = WS_WOUT + (size_t)NLAYER * D * D * 2;
constexpr size_t WS_WBR = WS_WFO + (size_t)NLAYER * D * FF * 2;
constexpr size_t WS_WGLU = WS_WBR + (size_t)NLAYER * 4 * D * MIXW * 2;
constexpr size_t WS_ACT1 = WS_WGLU + (size_t)NLAYER * MIXW * MIXW * 2;
constexpr size_t WS_PM = WS_ACT1 + (size_t)M * D * 2;
constexpr size_t WS_GT = WS_PM + (size_t)M * PMC * 2;
constexpr size_t WS_END = WS_GT + (size_t)M * GTC * 2;
static_assert(WS_TAB + NLAYER * TAB_STRIDE <= WS_WIN && WS_E + (size_t)NB * NCH * 1024 * 8 <= WS_TAB && WS_SSQ + (size_t)M * 64 <= WS_E, "d_ws map");
constexpr int CW_BAR = 1024;
constexpr int RING_OFF = 0, RING_BYTES = 147456;
constexpr int LDSCTL_OFF = RING_BYTES, MISC_OFF = LDSCTL_OFF + 320;
constexpr int LDS_BYTES = 163840;
constexpr int NWAVES = 8;

#define GAS __attribute__((address_space(1)))
#define LAS __attribute__((address_space(3)))
typedef unsigned short bf16;
typedef unsigned short bf16_t;
typedef unsigned v4u __attribute__((ext_vector_type(4)));
typedef unsigned v2u __attribute__((ext_vector_type(2)));
typedef float f32x4 __attribute__((ext_vector_type(4)));
typedef float f32x2 __attribute__((ext_vector_type(2)));
typedef short bf16x8 __attribute__((ext_vector_type(8)));
#define LDS_WAIT() asm volatile("s_waitcnt lgkmcnt(0)" ::: "memory")
#define VM_WAIT() asm volatile("s_waitcnt vmcnt(0)" ::: "memory")
__device__ __forceinline__ unsigned pk2(float lo, float hi) { return pg8::cvt_pk_bf16(lo, hi); }
__device__ __forceinline__ float bflo(unsigned u) { return __builtin_bit_cast(float, u << 16); }
__device__ __forceinline__ float bfhi(unsigned u) { return __builtin_bit_cast(float, u & 0xffff0000u); }
__device__ __forceinline__ float bf1(bf16_t b) { return __builtin_bit_cast(float, (unsigned)b << 16); }
__device__ __forceinline__ void unpack8(const v4u v, float (&f)[8]) { f[0] = bflo(v.x); f[1] = bfhi(v.x); f[2] = bflo(v.y); f[3] = bfhi(v.y); f[4] = bflo(v.z); f[5] = bfhi(v.z); f[6] = bflo(v.w); f[7] = bfhi(v.w); }
__device__ __forceinline__ v4u pack8(const float (&f)[8]) { v4u w; w.x = pk2(f[0], f[1]); w.y = pk2(f[2], f[3]); w.z = pk2(f[4], f[5]); w.w = pk2(f[6], f[7]); return w; }
__device__ __forceinline__ float sigm(float x) { return pg8::sigm(x); }
__device__ __forceinline__ float gelu_tanh(float y) { const float in2 = 1.5957691216057308f * (y + 0.044715f * y * y * y); const float e = __builtin_amdgcn_exp2f(1.4426950408889634f * in2); return 0.5f * y * (2.0f - 2.0f * __builtin_amdgcn_rcpf(e + 1.0f)); }
__device__ __forceinline__ float wave_sum(float v) {
#pragma unroll
    for (int o = 1; o < 64; o <<= 1) v += __shfl_xor(v, o);
    return v;
}

#define XB_TMO      128
#define XB_XCNT(j)  (256  + 64 * (j))
#define XB_XSUB(j)  (1280 + 64 * (j))
#define XB_XGEN(j)  (2304 + 64 * (j))
#define XB_TOP      3328
#define XB_TOPGEN   3392
#define XCD_BAR_WORDS 3456
#define XB_SPIN_CAP (1u << 18)

__device__ __forceinline__ unsigned xb_ld(unsigned* p)              { return __hip_atomic_load(p, __ATOMIC_RELAXED, __HIP_MEMORY_SCOPE_AGENT); }
__device__ __forceinline__ unsigned xb_add(unsigned* p, unsigned v) { return __hip_atomic_fetch_add(p, v, __ATOMIC_RELAXED, __HIP_MEMORY_SCOPE_AGENT); }
__device__ __forceinline__ unsigned xb_xcc_id() { return (unsigned)__builtin_amdgcn_s_getreg((3 << 11) | 20) & 0xFu; }
#define XB_SPIN(cond, bar) do { unsigned _sp = 0; while (cond) { __builtin_amdgcn_s_sleep(1); \
    if ((++_sp & 255u) == 0u) { if (xb_ld(&(bar)[XB_TMO])) break; if (_sp > XB_SPIN_CAP) { atomicAdd(&(bar)[XB_TMO], 1u); break; } } } } while (0)

struct XcdBarrier {
    unsigned* bar; unsigned x;
    volatile LAS unsigned* st;
};

__device__ __forceinline__ XcdBarrier xcd_barrier_post(unsigned* bar, volatile LAS unsigned* st) {
    XcdBarrier b; b.bar = bar; b.x = xb_xcc_id(); b.st = st;
    if (threadIdx.x == 0) (void)xb_add(&bar[XB_XCNT(b.x)], 1u);
    return b;
}
__device__ __forceinline__ void xcd_barrier_complete(unsigned* bar, unsigned x, unsigned& nloc, unsigned& nx) {
    const unsigned G = gridDim.x * gridDim.y * gridDim.z;
    unsigned sum, cnt, mine, sp = 0u;
    for (;;) {
        sum = 0u; cnt = 0u; mine = 0u;
#pragma unroll
        for (unsigned j = 0; j < 16; ++j) { const unsigned c = xb_ld(&bar[XB_XCNT(j)]); sum += c; cnt += (c > 0u) ? 1u : 0u; mine = (j == x) ? c : mine; }
        if (sum == G) break;
        __builtin_amdgcn_s_sleep(1);
        if ((++sp & 255u) == 0u) { if (xb_ld(&bar[XB_TMO])) break; if (sp > XB_SPIN_CAP) { atomicAdd(&bar[XB_TMO], 1u); break; } }
    }
    nloc = mine > 0u ? mine : 1u; nx = cnt > 0u ? cnt : 1u;
}

__device__ __forceinline__ void xcd_barrier_leader(const XcdBarrier& b) {
    {
        unsigned* bar = b.bar;
        __builtin_amdgcn_s_waitcnt(0);
        unsigned nloc = b.st[0], nx = b.st[1];
        if (nloc == 0u) { xcd_barrier_complete(bar, b.x, nloc, nx); b.st[0] = nloc; b.st[1] = nx; }
        const unsigned old = xb_add(&bar[XB_XSUB(b.x)], 1u);
        const unsigned gen = old / nloc;
        if (old + 1u == (gen + 1u) * nloc) {
            __builtin_amdgcn_fence(__ATOMIC_RELEASE, "agent");
            asm volatile("s_waitcnt vmcnt(0)" ::: "memory");
            const unsigned og = xb_add(&bar[XB_TOP], 1u);
            const unsigned tg = og / nx;
            if (og + 1u == (tg + 1u) * nx) xb_add(&bar[XB_TOPGEN], 1u);
            else XB_SPIN(xb_ld(&bar[XB_TOPGEN]) == tg, bar);
            __builtin_amdgcn_fence(__ATOMIC_ACQUIRE, "agent");
            xb_add(&bar[XB_XGEN(b.x)], 1u);
            asm volatile("s_waitcnt vmcnt(0)" ::: "memory");
        } else {
            XB_SPIN(xb_ld(&bar[XB_XGEN(b.x)]) == gen, bar);
            __builtin_amdgcn_fence(__ATOMIC_ACQUIRE, "agent");
            asm volatile("s_waitcnt vmcnt(0)" ::: "memory");
        }
    }
}
__device__ __forceinline__ void xcd_barrier(const XcdBarrier& b, bool leader) {
    asm volatile("s_waitcnt vmcnt(0)" ::: "memory");
    __syncthreads();
    if (leader) xcd_barrier_leader(b);
    __syncthreads();
}
struct Args { const float* in[32]; float* out; unsigned char* ws; int ph_lo, ph_hi; };
enum { I_XP = 0, I_XS, I_STPOOL, I_STRE, I_STIM, I_STSC, I_STCF, I_N1G, I_N2G, I_FING, I_WIN, I_BGATE, I_POOLW, I_POOLSC, I_LAMRE, I_LAMIM, I_LOGDT,
       I_BRE, I_BIM, I_CRE, I_CIM, I_DSKIP, I_WGLU, I_BGLU, I_SCW, I_CFW, I_CFLNG, I_CFLNB, I_WBR, I_WOUT, I_WFI, I_WFO };

__device__ __forceinline__ void p0_item(const float* W, int ldw, int src_col0, const float* kscale, int k0, bf16* WTrow0, int K, LAS float* scr, int lane) {
    float wv[32];
#pragma unroll
    for (int i = 0; i < 32; ++i) { const int kk = 2 * i + (lane >> 5); wv[i] = W[(size_t)(k0 + kk) * ldw + src_col0 + (lane & 31)]; }
#pragma unroll
    for (int i = 0; i < 32; ++i) { const int kk = 2 * i + (lane >> 5); scr[kk * 33 + (lane & 31)] = wv[i]; }
    LDS_WAIT(); asm volatile("" ::: "memory");
    const int c = lane & 7;
    f32x4 ks0 = (f32x4){1.f, 1.f, 1.f, 1.f}, ks1 = ks0;
    if (kscale) { ks0 = *(const f32x4*)(kscale + k0 + 8 * c); ks1 = *(const f32x4*)(kscale + k0 + 8 * c + 4); }
#pragma unroll
    for (int j = 0; j < 4; ++j) { const int n = (lane >> 3) + 8 * j; const LAS float* s = scr + (8 * c) * 33 + n;
        v4u o; o.x = pk2(s[0 * 33] * ks0[0], s[1 * 33] * ks0[1]); o.y = pk2(s[2 * 33] * ks0[2], s[3 * 33] * ks0[3]); o.z = pk2(s[4 * 33] * ks1[0], s[5 * 33] * ks1[1]); o.w = pk2(s[6 * 33] * ks1[2], s[7 * 33] * ks1[3]);
        *(GAS v4u*)(WTrow0 + (size_t)n * K + k0 + 8 * c) = o; }
    LDS_WAIT(); asm volatile("" ::: "memory");
}
constexpr int P0_IT_IN = 16 * (INC / 32), P0_IT_FI = 16 * (2 * FF / 32), P0_IT_OUT = 16 * 32, P0_IT_FO = (FF / 64) * 32, P0_IT_BR = 4 * 4 * 32, P0_IT_GLU = 4 * 8;
constexpr int P0_IT_LAYER = P0_IT_IN + P0_IT_FI + P0_IT_OUT + P0_IT_FO + P0_IT_BR + P0_IT_GLU;
__device__ __forceinline__ void p0_weight_item(const Args& a, int L, int r, LAS float* scr, int lane) {
    unsigned char* ws = a.ws;
    if (r < P0_IT_IN) { const int nblk = INC / 32, kb = r / nblk, nb = r % nblk;
        p0_item(a.in[I_WIN] + (size_t)L * D * INC, INC, 32 * nb, a.in[I_N1G] + L * D, 64 * kb, (bf16*)(ws + WS_WIN) + ((size_t)L * INC + 32 * nb) * D, D, scr, lane); return; } r -= P0_IT_IN;
    if (r < P0_IT_FI) { const int nblk = 2 * FF / 32, kb = r / nblk, nb = r % nblk; const int nd = 32 * nb, pn = nd >> 8, rr = nd & 255;
        const int src = rr < 128 ? 128 * pn + rr : FF + 128 * pn + (rr - 128);
        p0_item(a.in[I_WFI] + (size_t)L * D * 2 * FF, 2 * FF, src, a.in[I_N2G] + L * D, 64 * kb, (bf16*)(ws + WS_WFI) + ((size_t)L * 2 * FF + nd) * D, D, scr, lane); return; } r -= P0_IT_FI;
    if (r < P0_IT_OUT) { const int kb = r / 32, nb = r % 32;
        p0_item(a.in[I_WOUT] + (size_t)L * D * D, D, 32 * nb, nullptr, 64 * kb, (bf16*)(ws + WS_WOUT) + ((size_t)L * D + 32 * nb) * D, D, scr, lane); return; } r -= P0_IT_OUT;
    if (r < P0_IT_FO) { const int kb = r / 32, nb = r % 32;
        p0_item(a.in[I_WFO] + (size_t)L * FF * D, D, 32 * nb, nullptr, 64 * kb, (bf16*)(ws + WS_WFO) + ((size_t)L * D + 32 * nb) * FF, FF, scr, lane); return; } r -= P0_IT_FO;
    if (r < P0_IT_BR) { const int br = r / 128, q = r % 128, kb = q / 32, nb = q % 32;
        p0_item(a.in[I_WBR] + (size_t)(L * 4 + br) * MIXW * D, D, 32 * nb, nullptr, 64 * kb, (bf16*)(ws + WS_WBR) + ((size_t)(L * 4 + br) * D + 32 * nb) * MIXW, MIXW, scr, lane); return; } r -= P0_IT_BR;
    { const int kb = r / 8, nb = r % 8;
        p0_item(a.in[I_WGLU] + (size_t)L * MIXW * MIXW, MIXW, 32 * nb, nullptr, 64 * kb, (bf16*)(ws + WS_WGLU) + ((size_t)L * MIXW + 32 * nb) * MIXW, MIXW, scr, lane); }
}
constexpr int P0_SLICES = 6, P0_F_PER = 7, P0_A_PER = 2, P0_F_BID0 = 216, P0_A_BID0 = 192;
__device__ __forceinline__ int p0_items_A(int G) { return G == 256 ? (256 - P0_A_BID0) * NWAVES * P0_A_PER : 0; }
__device__ __forceinline__ int p0_items_F(int G) { return G == 256 ? (256 - P0_F_BID0) * NWAVES * P0_F_PER : 0; }
__device__ __forceinline__ void p0_idle_items(const Args& a, LAS unsigned char* lds, int lane, int wave, int bid, int L, int base, int bid0, int per) {
    LAS float* scr = (LAS float*)(lds + RING_OFF + wave * 16384);
    const int nw = (256 - bid0) * NWAVES, w = (bid - bid0) * NWAVES + wave;
    for (int q = 0; q < per; ++q) p0_weight_item(a, L, base + w + q * nw, scr, lane);
}
__device__ __forceinline__ void p0_slice(const Args& a, LAS unsigned char* lds, int lane, int wave, int G, int bid, int L, int slice) {
    LAS float* scr = (LAS float*)(lds + RING_OFF + wave * 16384);
    const int first = p0_items_A(G) + p0_items_F(G), per = (P0_IT_LAYER - first + P0_SLICES - 1) / P0_SLICES;
    const int lo = first + slice * per, hi = (lo + per < P0_IT_LAYER) ? lo + per : P0_IT_LAYER;
    for (int r = lo + bid * (NWAVES - 1) + (wave - 1); r < hi; r += G * (NWAVES - 1)) p0_weight_item(a, L, r, scr, lane);
}
__device__ __forceinline__ void p0_prologue(const Args& a, LAS unsigned char* lds, int tid, int lane, int wave, int G, int bid) {
    LAS float* scr = (LAS float*)(lds + RING_OFF + wave * 16384);
    const int gw = bid * NWAVES + wave, NGW = G * NWAVES;
    unsigned char* ws = a.ws;
    for (int it = gw; it < (MK_PER_PHASE ? NLAYER : 1) * P0_IT_LAYER; it += NGW) p0_weight_item(a, it / P0_IT_LAYER, it % P0_IT_LAYER, scr, lane);
    for (int m = gw; m < M; m += NGW) {
        const float* xrow = m < MP ? a.in[I_XP] + (size_t)m * D : a.in[I_XS] + (size_t)(m - MP) * D;
        const GAS f32x4* xr = (const GAS f32x4*)xrow + lane; f32x4 v[4]; float s = 0.f;
#pragma unroll
        for (int j = 0; j < 4; ++j) { v[j] = xr[64 * j]; s += (v[j][0] * v[j][0] + v[j][1] * v[j][1]) + (v[j][2] * v[j][2] + v[j][3] * v[j][3]); }
        s = wave_sum(s);
        GAS v2u* o8 = (GAS v2u*)((bf16*)(ws + WS_ACT1) + (size_t)m * D) + lane;
#pragma unroll
        for (int j = 0; j < 4; ++j) { v2u w; w.x = pk2(v[j][0], v[j][1]); w.y = pk2(v[j][2], v[j][3]); o8[64 * j] = w; }
        if (lane < 16) ((float*)(ws + WS_SSQ))[((size_t)(lane >> 2) * M + m) * 4 + (lane & 3)] = lane == 0 ? s : 0.f;
    }
    for (int idx = bid * 512 + tid; idx < NLAYER * 1024; idx += G * 512) {
        const int L = idx >> 10, gp = idx & 1023, g = gp >> 6, p = gp & 63;
        unsigned char* tab = ws + WS_TAB + (size_t)L * TAB_STRIDE;
        const float lre = a.in[I_LAMRE][idx], lim = a.in[I_LAMIM][idx], dt = expf(a.in[I_LOGDT][L * 16 + g]);
        const float ar = lre * dt, br_ = lim * dt, ea = expf(ar), cb = cosf(br_), sb = sinf(br_), sh = sinf(0.5f * br_);
        const float lbr = ea * cb, lbi = ea * sb;
        const float m1r = expm1f(ar) * cb - 2.0f * sh * sh, m1i = lbi;
        const float den = 1.0f / (lre * lre + lim * lim);
        const float qr = (m1r * lre + m1i * lim) * den, qi = (m1i * lre - m1r * lim) * den;
        ((f32x2*)(tab + TAB_LB))[gp] = (f32x2){lbr, lbi};
        float pr = lbr, pi = lbi;
#pragma unroll
        for (int s = 0; s < 6; ++s) { const float nr = pr * pr - pi * pi, ni = 2.0f * pr * pi; pr = nr; pi = ni; }
        ((f32x2*)(tab + TAB_LP))[gp] = (f32x2){pr, pi};
        bf16* bbt = (bf16*)(tab + TAB_BBT); bf16* cm = (bf16*)(tab + TAB_CM);
        const float* bre = a.in[I_BRE] + (size_t)idx * 16; const float* bim = a.in[I_BIM] + (size_t)idx * 16;
#pragma unroll
        for (int c = 0; c < 16; ++c) { const float Br = bre[c], Bi = bim[c];
            bbt[(g * 128 + p) * 16 + c] = (bf16)(pk2(qr * Br - qi * Bi, 0.f) & 0xffffu);
            bbt[(g * 128 + 64 + p) * 16 + c] = (bf16)(pk2(qr * Bi + qi * Br, 0.f) & 0xffffu);
            cm[(g * 16 + c) * 128 + p] = (bf16)(pk2(a.in[I_CRE][((size_t)(L * 16 + g) * 16 + c) * 64 + p], 0.f) & 0xffffu);
            cm[(g * 16 + c) * 128 + 64 + p] = (bf16)(pk2(-a.in[I_CIM][((size_t)(L * 16 + g) * 16 + c) * 64 + p], 0.f) & 0xffffu); }
    }
    for (int idx = bid * 512 + tid; idx < NLAYER * 4 * 64 * 64; idx += G * 512) {
        const int L = idx >> 14, r = idx & 16383, k = r >> 12, o = (r >> 6) & 63, c = r & 63;
        ((bf16*)(ws + WS_TAB + (size_t)L * TAB_STRIDE + TAB_PW))[r] = (bf16)(pk2(a.in[I_POOLW][((size_t)(L * 4 + k) * 64 + c) * 64 + o], 0.f) & 0xffffu);
    }
}
__device__ __forceinline__ void final_norm(const Args& a, int lane, int wave, int G, int bid) {
    const int gw = bid * NWAVES + wave, NGW = G * NWAVES;
    const float* ssq = (const float*)(a.ws + WS_SSQ);
    f32x4 gv[4];
#pragma unroll
    for (int j = 0; j < 4; ++j) gv[j] = ((const f32x4*)a.in[I_FING])[lane + 64 * j];
    for (int m = gw; m < M; m += NGW) {
        float s = lane < 16 ? ssq[((size_t)(lane >> 2) * M + m) * 4 + (lane & 3)] : 0.f; s = wave_sum(s);
        const float rs = __builtin_amdgcn_rsqf(s * (1.0f / 1024.0f) + 1e-6f);
        const GAS v2u* xb = (const GAS v2u*)((const bf16*)(a.ws + WS_ACT1) + (size_t)m * D) + lane;
        GAS f32x4* yr = (GAS f32x4*)(a.out + (size_t)m * D) + lane;
#pragma unroll
#ifdef DBG_HASH_Y
        for (int j = 0; j < 4; ++j) { const v2u q = xb[64 * j]; f32x4 v = (f32x4){bflo(q.x), bfhi(q.x), bflo(q.y), bfhi(q.y)}; v = v * rs * gv[j]; f32x4 h;
            for (int qq = 0; qq < 4; ++qq) { const unsigned b = __float_as_uint(v[qq]); const unsigned hh = (b * 2654435761u) ^ (b >> 15); h[qq] = (float)(hh >> 8) * (1.0f / 16777216.0f); }
            yr[64 * j] = h; }
#else
        for (int j = 0; j < 4; ++j) { const v2u q = xb[64 * j]; const f32x4 v = (f32x4){bflo(q.x), bfhi(q.x), bflo(q.y), bfhi(q.y)}; yr[64 * j] = v * rs * gv[j]; }
#endif
    }
}

typedef float f32x4_t __attribute__((ext_vector_type(4)));
#ifdef DBG_MIX_T
#define MIX_STAMP(i) do { if (((i) == DBG_TA || (i) == DBG_TB) && !SAMPLE && layer == 1 && blockIdx.x == DBG_T_BLK && wave == 0) { const unsigned long long t__ = __builtin_amdgcn_s_memrealtime(); if (lane == 0) ((volatile LAS unsigned long long*)(lds + 131072 + 320 + 256))[16 + (i)] = t__; } } while (0)
#else
#define MIX_STAMP(i) do {} while (0)
#endif
__device__ __forceinline__ float fma_s(float a, float b, float c) { float r; asm("v_fma_f32 %0, %1, %2, %3" : "=v"(r) : "v"(a), "v"(b), "v"(c)); return r; }
template <bool SAMPLE>
__device__ __forceinline__ void mix_unit(const Args& a, int layer, int uidx, LAS unsigned char* lds, int tid_in, int lane_in, int wave_in, int stages) {
    int tid = tid_in; asm volatile("" : "+v"(tid));
    const int lane = tid & 63, wave = __builtin_amdgcn_readfirstlane(tid >> 6);
#ifdef DBG_EXTRA_SYNC
    asm volatile("s_waitcnt vmcnt(0) lgkmcnt(0)" ::: "memory"); __syncthreads();
#endif
    constexpr int L = SAMPLE ? 8 : 64, NSEG = SAMPLE ? 2 : 1, R = NSEG * L;
    const bf16* PMb = (const bf16*)(a.ws + WS_PM); bf16* BR = (bf16*)a.out;
    const int s = uidx >> 5, c = uidx & 31, q0 = 2 * uidx;
    const int row0 = SAMPLE ? MP + q0 * 8 : s * SEQ + 64 * c;
    const bool last = SAMPLE || c == NCH - 1;
    LAS float* V = (LAS float*)lds;
    MIX_STAMP(0);
    if (stages & 1) {
        constexpr int TR = NSEG * (30 + L);
        LAS float* WCF = (LAS float*)(lds + 96256);
        {
            constexpr int NIT = (TR * 32 + 511) / 512;
            v4u qa[NIT], qb[NIT]; int kind[NIT];
#pragma unroll
            for (int it = 0; it < NIT; ++it) {
                const int idx = tid + it * 512; kind[it] = 0; qa[it] = (v4u){0u, 0u, 0u, 0u}; qb[it] = (v4u){0u, 0u, 0u, 0u};
                if (idx < TR * 32) {
                    const int rr = idx >> 5, c8 = (idx & 31) * 8, seg = rr / (30 + L), e = rr % (30 + L);
                    int srow = -1;
                    if (SAMPLE) { if (e >= 30) srow = MP + (q0 + seg) * 8 + (e - 30); }
                    else { const int tabs = c * 64 + e - 30; if (tabs >= 0) srow = s * SEQ + tabs; }
                    if (srow >= 0) { kind[it] = 1; qa[it] = *(const v4u*)(PMb + (size_t)srow * PMC + 1280 + c8); qb[it] = *(const v4u*)(PMb + (size_t)srow * PMC + 1536 + c8); }
                    else if (SAMPLE) { kind[it] = 2; const float* st = a.in[I_STCF] + ((size_t)(layer * DB + q0 + seg) * 30 + e) * MIXW + c8; qa[it] = *(const v4u*)st; qb[it] = *(const v4u*)(st + 4); }
                }
            }
#pragma unroll
            for (int it = 0; it < NIT; ++it) {
                const int idx = tid + it * 512;
                if (idx < TR * 32) {
                    const int rr = idx >> 5, c8 = (idx & 31) * 8;
                    float v[8];
                    if (kind[it] == 1) { float av[8], bv[8]; unpack8(qa[it], av); unpack8(qb[it], bv);
#pragma unroll
                        for (int j = 0; j < 8; ++j) v[j] = av[j] * sigm(bv[j]); }
                    else { v[0] = __uint_as_float(qa[it].x); v[1] = __uint_as_float(qa[it].y); v[2] = __uint_as_float(qa[it].z); v[3] = __uint_as_float(qa[it].w);
                           v[4] = __uint_as_float(qb[it].x); v[5] = __uint_as_float(qb[it].y); v[6] = __uint_as_float(qb[it].z); v[7] = __uint_as_float(qb[it].w); }
                    *(LAS f32x4*)(V + rr * 256 + c8) = (f32x4){v[0], v[1], v[2], v[3]}; *(LAS f32x4*)(V + rr * 256 + c8 + 4) = (f32x4){v[4], v[5], v[6], v[7]};
                }
            }
        }
        { f32x4 wq[4];
#pragma unroll
            for (int it = 0; it < 4; ++it) { const int idx = tid + it * 512; wq[it] = idx < 31 * 64 ? *(const f32x4*)(a.in[I_CFW] + (size_t)layer * 31 * MIXW + idx * 4) : (f32x4){0.f, 0.f, 0.f, 0.f}; }
#pragma unroll
            for (int it = 0; it < 4; ++it) { const int idx = tid + it * 512; if (idx < 31 * 64) *(LAS f32x4*)(WCF + idx * 4) = wq[it]; } }
        __syncthreads();
        MIX_STAMP(1);
        if (last) {
            for (int idx = tid; idx < NSEG * 30 * 64; idx += 512) { const int seg = idx / (30 * 64), r = idx % (30 * 64), j = r >> 6, c4 = (r & 63) * 4;
                float* dst = a.out + (SAMPLE ? O_CFS + ((size_t)(layer * DB + q0 + seg) * 30 + j) * MIXW : O_CFP + ((size_t)(layer * NB + s) * 30 + j) * MIXW) + c4;
                *(f32x4*)dst = *(LAS f32x4*)(V + (seg * (30 + L) + L + j) * 256 + c4); }
        }
        const f32x4 lg = *(const f32x4*)(a.in[I_CFLNG] + layer * MIXW + 4 * lane), lb = *(const f32x4*)(a.in[I_CFLNB] + layer * MIXW + 4 * lane);
        {
            constexpr int NT = R / NWAVES, TG = NT >= 4 ? 4 : NT;
#pragma unroll 1
            for (int g0 = 0; g0 < NT; g0 += TG) {
                f32x4 acc[TG]; int base[TG];
#pragma unroll
                for (int i = 0; i < TG; ++i) { const int tt = wave + NWAVES * (g0 + i), seg = tt / L, t = tt % L; base[i] = (seg * (30 + L) + t) * 256 + 4 * lane; acc[i] = (f32x4){0.f, 0.f, 0.f, 0.f}; }
#pragma unroll 4
                for (int j = 0; j < 31; ++j) { const f32x4 w = *(LAS f32x4*)(WCF + j * 256 + 4 * lane);
#pragma unroll
                    for (int i = 0; i < TG; ++i) acc[i] += w * *(LAS f32x4*)(V + base[i] + j * 256); }
                float s1[TG];
#pragma unroll
                for (int i = 0; i < TG; ++i) s1[i] = (acc[i][0] + acc[i][1]) + (acc[i][2] + acc[i][3]);
#pragma unroll
                for (int o = 1; o < 64; o <<= 1) {
#pragma unroll
                    for (int i = 0; i < TG; ++i) s1[i] += __shfl_xor(s1[i], o); }
                f32x4 d[TG]; float s2[TG];
#pragma unroll
                for (int i = 0; i < TG; ++i) { d[i] = acc[i] - s1[i] * (1.0f / 256.0f); s2[i] = (d[i][0] * d[i][0] + d[i][1] * d[i][1]) + (d[i][2] * d[i][2] + d[i][3] * d[i][3]); }
#pragma unroll
                for (int o = 1; o < 64; o <<= 1) {
#pragma unroll
                    for (int i = 0; i < TG; ++i) s2[i] += __shfl_xor(s2[i], o); }
#pragma unroll
                for (int i = 0; i < TG; ++i) { const int tt = wave + NWAVES * (g0 + i);
                    const float rstd = __builtin_amdgcn_rsqf(s2[i] * (1.0f / 256.0f) + 1e-5f);
                    const f32x4 yn = d[i] * rstd * lg + lb;
                    v2u w; w.x = pk2(yn[0] * sigm(yn[0]), yn[1] * sigm(yn[1])); w.y = pk2(yn[2] * sigm(yn[2]), yn[3] * sigm(yn[3]));
                    *(v2u*)(BR + (size_t)(row0 + tt) * D + 768 + 4 * lane) = w; }
            }
        }
        __syncthreads();
    }
    MIX_STAMP(2);
    if (stages & 2) {
        constexpr int TR = NSEG * (15 + L);
        LAS bf16* Dt = (LAS bf16*)(lds + 81920);
        {
            constexpr int NIT = (TR * 32 + 511) / 512;
            v4u qa[NIT], qb[NIT]; int kind[NIT];
#pragma unroll
            for (int it = 0; it < NIT; ++it) {
                const int idx = tid + it * 512; kind[it] = 0; qa[it] = (v4u){0u, 0u, 0u, 0u}; qb[it] = (v4u){0u, 0u, 0u, 0u};
                if (idx < TR * 32) {
                    const int rr = idx >> 5, c8 = (idx & 31) * 8, seg = rr / (15 + L), e = rr % (15 + L);
                    int srow = -1;
                    if (SAMPLE) { if (e >= 15) srow = MP + (q0 + seg) * 8 + (e - 15); }
                    else { const int tabs = c * 64 + e - 15; if (tabs >= 0) srow = s * SEQ + tabs; }
                    if (srow >= 0) { kind[it] = 1; qa[it] = *(const v4u*)(PMb + (size_t)srow * PMC + c8); }
                    else if (SAMPLE) { kind[it] = 2; const float* st = a.in[I_STPOOL] + ((size_t)(layer * DB + q0 + seg) * 15 + e) * MIXW + c8; qa[it] = *(const v4u*)st; qb[it] = *(const v4u*)(st + 4); }
                }
            }
#pragma unroll
            for (int it = 0; it < NIT; ++it) {
                const int idx = tid + it * 512;
                if (idx < TR * 32) {
                    const int rr = idx >> 5, c8 = (idx & 31) * 8;
                    float v[8];
                    if (kind[it] == 1) unpack8(qa[it], v);
                    else { v[0] = __uint_as_float(qa[it].x); v[1] = __uint_as_float(qa[it].y); v[2] = __uint_as_float(qa[it].z); v[3] = __uint_as_float(qa[it].w);
                           v[4] = __uint_as_float(qb[it].x); v[5] = __uint_as_float(qb[it].y); v[6] = __uint_as_float(qb[it].z); v[7] = __uint_as_float(qb[it].w); }
                    *(LAS f32x4*)(V + rr * 256 + c8) = (f32x4){v[0], v[1], v[2], v[3]}; *(LAS f32x4*)(V + rr * 256 + c8 + 4) = (f32x4){v[4], v[5], v[6], v[7]};
                }
            }
        }
        __syncthreads();
        MIX_STAMP(3);
        if (last) {
            for (int idx = tid; idx < NSEG * 15 * 64; idx += 512) { const int seg = idx / (15 * 64), r = idx % (15 * 64), j = r >> 6, c4 = (r & 63) * 4;
                float* dst = a.out + (SAMPLE ? O_POOLS + ((size_t)(layer * DB + q0 + seg) * 15 + j) * MIXW : O_POOLP + ((size_t)(layer * NB + s) * 15 + j) * MIXW) + c4;
                *(f32x4*)dst = *(LAS f32x4*)(V + (seg * (15 + L) + L + j) * 256 + c4); }
        }
        for (int idx = tid; idx < R * 32; idx += 512) {
            const int tt = idx >> 5, c8 = (idx & 31) * 8, seg = tt / L, t = tt % L, base = seg * (15 + L) + t + 15, win = 2 << (c8 >> 6);
            float sm[8];
#pragma unroll
            for (int j = 0; j < 8; ++j) sm[j] = 0.f;
            for (int w = 0; w < win; ++w) { const f32x4 x0 = *(LAS f32x4*)(V + (base - w) * 256 + c8), x1 = *(LAS f32x4*)(V + (base - w) * 256 + c8 + 4);
                sm[0] += x0[0]; sm[1] += x0[1]; sm[2] += x0[2]; sm[3] += x0[3]; sm[4] += x1[0]; sm[5] += x1[1]; sm[6] += x1[2]; sm[7] += x1[3]; }
            const int cnt = SAMPLE ? win : min(c * 64 + t + 1, win);
            const float inv = 1.0f / (float)cnt;
            const f32x4 c0 = *(LAS f32x4*)(V + base * 256 + c8), c1 = *(LAS f32x4*)(V + base * 256 + c8 + 4);
            float dd[8];
#pragma unroll
            for (int j = 0; j < 4; ++j) { dd[j] = sm[j] * inv - c0[j]; dd[4 + j] = sm[4 + j] * inv - c1[j]; }
            *(LAS v4u*)(Dt + tt * 264 + c8) = pack8(dd);
        }
        __syncthreads();
        MIX_STAMP(4);
        {
            const bf16* PW = (const bf16*)(a.ws + WS_TAB + (size_t)layer * TAB_STRIDE + TAB_PW);
            const int k = wave >> 1, fr = lane & 15, fq = lane >> 4;
            constexpr int NMT = R / 16;
            for (int mt = (NMT >= 4 ? (wave & 1) * 2 : (wave & 1)); mt < (NMT >= 4 ? (wave & 1) * 2 + 2 : ((wave & 1) == 0 ? NMT : 0)); ++mt) {
                const bf16x8 b0 = *(LAS bf16x8*)(Dt + (16 * mt + fr) * 264 + 64 * k + 8 * fq), b1 = *(LAS bf16x8*)(Dt + (16 * mt + fr) * 264 + 64 * k + 32 + 8 * fq);
#pragma unroll
                for (int ot = 0; ot < 4; ++ot) {
                    f32x4 acc = (f32x4){0.f, 0.f, 0.f, 0.f};
                    const bf16x8 a0 = *(const bf16x8*)(PW + ((size_t)(k * 64 + 16 * ot + fr)) * 64 + 8 * fq), a1 = *(const bf16x8*)(PW + ((size_t)(k * 64 + 16 * ot + fr)) * 64 + 32 + 8 * fq);
                    acc = __builtin_amdgcn_mfma_f32_16x16x32_bf16(a0, b0, acc, 0, 0, 0);
                    acc = __builtin_amdgcn_mfma_f32_16x16x32_bf16(a1, b1, acc, 0, 0, 0);
                    const int o = 64 * k + 16 * ot + 4 * fq, tt = 16 * mt + fr;
                    const f32x4 sc = *(const f32x4*)(a.in[I_POOLSC] + layer * MIXW + o);
                    v2u w; w.x = pk2(acc[0] * sc[0], acc[1] * sc[1]); w.y = pk2(acc[2] * sc[2], acc[3] * sc[3]);
                    *(v2u*)(BR + (size_t)(row0 + tt) * D + o) = w;
                }
            }
        }
        __syncthreads();
    }
    MIX_STAMP(5);
    if (stages & 4) {
        const float* scw = a.in[I_SCW] + (size_t)layer * 3 * MIXW;
#pragma unroll
        for (int it_ = 0; it_ < R * 32 / 512; ++it_) { const int idx = tid + it_ * 512;
            const int tt = idx >> 5, c8 = (idx & 31) * 8, seg = tt / L, t = tt % L;
            float z[3][8];
#pragma unroll
            for (int dj = 0; dj < 3; ++dj) { const int tp = t - 2 + dj;
                int srow = -1;
                if (SAMPLE) { if (tp >= 0) srow = MP + (q0 + seg) * 8 + tp; } else { const int tabs = c * 64 + tp; if (tabs >= 0) srow = s * SEQ + tabs; }
                if (srow >= 0) { float cg[8], hx[8]; unpack8(*(const v4u*)(PMb + (size_t)srow * PMC + 768 + c8), cg); unpack8(*(const v4u*)(PMb + (size_t)srow * PMC + 1024 + c8), hx);
#pragma unroll
                    for (int j = 0; j < 8; ++j) z[dj][j] = cg[j] * hx[j]; }
                else if (SAMPLE) { const float* st = a.in[I_STSC] + ((size_t)(layer * DB + q0 + seg) * 2 + (2 + tp)) * MIXW + c8; const f32x4 x0 = *(const f32x4*)st, x1 = *(const f32x4*)(st + 4);
                    z[dj][0] = x0[0]; z[dj][1] = x0[1]; z[dj][2] = x0[2]; z[dj][3] = x0[3]; z[dj][4] = x1[0]; z[dj][5] = x1[1]; z[dj][6] = x1[2]; z[dj][7] = x1[3]; }
                else {
#pragma unroll
                    for (int j = 0; j < 8; ++j) z[dj][j] = 0.f; } }
            float bg[8], o[8]; unpack8(*(const v4u*)(PMb + (size_t)(row0 + tt) * PMC + 512 + c8), bg);
#pragma unroll
            for (int j = 0; j < 8; ++j) o[j] = bg[j] * (scw[c8 + j] * z[0][j] + scw[MIXW + c8 + j] * z[1][j] + scw[2 * MIXW + c8 + j] * z[2][j]);
            *(v4u*)(BR + (size_t)(row0 + tt) * D + 512 + c8) = pack8(o);
            if (last && t >= L - 2) { float* dst = a.out + (SAMPLE ? O_SCS + ((size_t)(layer * DB + q0 + seg) * 2 + (t - (L - 2))) * MIXW : O_SCP + ((size_t)(layer * NB + s) * 2 + (t - (L - 2))) * MIXW) + c8;
                *(f32x4*)dst = (f32x4){z[2][0], z[2][1], z[2][2], z[2][3]}; *(f32x4*)(dst + 4) = (f32x4){z[2][4], z[2][5], z[2][6], z[2][7]}; }
        }
    }
    MIX_STAMP(6);
}

template <int MODE>
__device__ __forceinline__ void ssm_unit(const Args& a, int layer, int uidx, LAS unsigned char* lds, int tid_in, int lane_in, int wave_in) {
    int tid = tid_in; asm volatile("" : "+v"(tid));
    const int lane = tid & 63, wave = __builtin_amdgcn_readfirstlane(tid >> 6);
    const bf16* PMb = (const bf16*)(a.ws + WS_PM); bf16* BR = (bf16*)a.out;
    const unsigned char* tab = a.ws + WS_TAB + (size_t)layer * TAB_STRIDE;
    const f32x2* LB = (const f32x2*)(tab + TAB_LB); const f32x2* LP = (const f32x2*)(tab + TAB_LP);
    const bf16* BBT = (const bf16*)(tab + TAB_BBT); const bf16* CM = (const bf16*)(tab + TAB_CM);
    f32x2* E = (f32x2*)(a.ws + WS_E);
    const int s = uidx >> 5, c = uidx & 31;
    const int row0 = MODE == 2 ? MP + 64 * uidx : s * SEQ + 64 * c;
    const int fr = lane & 15, fq = lane >> 4;
    LAS float* BU = (LAS float*)(lds + wave * 8448);
    LAS bf16* Zt = (LAS bf16*)(lds + 67584);
    const bf16x8 zf = (bf16x8){0, 0, 0, 0, 0, 0, 0, 0};
    for (int gi = 0; gi < 2; ++gi) {
        const int g = 2 * wave + gi;
        const f32x2 lam = LB[g * 64 + lane]; const float nlam1 = -lam[1];
        float hr = 0.f, hi = 0.f;
        bf16x8 bb[8];
#pragma unroll
        for (int nt = 0; nt < 8; ++nt) bb[nt] = fq < 2 ? *(const bf16x8*)(BBT + ((size_t)(g * 128 + 16 * nt + fr)) * 16 + 8 * fq) : zf;
        bf16x8 cmf[4]; float dsk = 0.f;
        if (MODE >= 1) {
#pragma unroll
            for (int ks = 0; ks < 4; ++ks) cmf[ks] = *(const bf16x8*)(CM + ((size_t)(g * 16 + fr)) * 128 + 32 * ks + 8 * fq);
            dsk = a.in[I_DSKIP][layer * MIXW + 16 * g + fr]; }
        bf16x8 ufa[4];
#pragma unroll
        for (int sub = 0; sub < 4; ++sub) ufa[sub] = fq < 2 ? *(const bf16x8*)(PMb + (size_t)(row0 + 16 * sub + fr) * PMC + 256 + 16 * g + 8 * fq) : zf;
        bf16 uva[4][4];
        if (MODE >= 1) {
#pragma unroll
            for (int sub = 0; sub < 4; ++sub)
#pragma unroll
                for (int r = 0; r < 4; ++r) uva[sub][r] = PMb[(size_t)(row0 + 16 * sub + 4 * fq + r) * PMC + 256 + 16 * g + fr]; }
        if (MODE == 1) { const f32x2 lp = LP[g * 64 + lane];
            const float nlp1 = -lp[1];
#pragma unroll 1
            for (int j = 0; j < c; j += 16) { f32x2 e16[16]; const int nq = c - j;
#pragma unroll
                for (int q = 0; q < 16; ++q) if (q < nq) e16[q] = E[((size_t)(s * NCH + j + q) * 16 + g) * 64 + lane];
#pragma unroll
                for (int q = 0; q < 16; ++q) if (q < nq) { const float nr = fma_s(lp[0], hr, fma_s(nlp1, hi, e16[q][0])), ni = fma_s(lp[0], hi, fma_s(lp[1], hr, e16[q][1])); hr = nr; hi = ni; } } }
#pragma unroll
        for (int sub = 0; sub < 4; ++sub) {
            const int rowb = row0 + 16 * sub;
            const bf16x8 uf = ufa[sub];
#pragma unroll
            for (int nt = 0; nt < 8; ++nt) { const f32x4 d = __builtin_amdgcn_mfma_f32_16x16x32_bf16(uf, bb[nt], (f32x4){0.f, 0.f, 0.f, 0.f}, 0, 0, 0);
#pragma unroll
                for (int r = 0; r < 4; ++r) BU[(4 * fq + r) * 132 + 16 * nt + fr] = d[r]; }
            asm volatile("s_waitcnt lgkmcnt(0)" ::: "memory");
            {
                float bre_[16], bim_[16];
#pragma unroll
                for (int t = 0; t < 16; ++t) { bre_[t] = BU[t * 132 + lane]; bim_[t] = BU[t * 132 + 64 + lane]; }
                float sre_[2] = {0.f, 0.f}, sim_[2] = {0.f, 0.f};
                if (MODE == 2) {
#pragma unroll
                    for (int hq = 0; hq < 2; ++hq) { const int q = 8 * uidx + 2 * sub + hq; const size_t si = ((size_t)(layer * DB + q) * 16 + g) * 64 + lane; sre_[hq] = a.in[I_STRE][si]; sim_[hq] = a.in[I_STIM][si]; } }
                asm volatile("s_waitcnt lgkmcnt(0)" ::: "memory");
#pragma unroll
                for (int t = 0; t < 16; ++t) {
                    if (MODE == 2 && (t & 7) == 0) { hr = sre_[t >> 3]; hi = sim_[t >> 3]; }
                    const float nr = fma_s(lam[0], hr, fma_s(nlam1, hi, bre_[t])), ni = fma_s(lam[0], hi, fma_s(lam[1], hr, bim_[t])); hr = nr; hi = ni;
                    bre_[t] = hr; bim_[t] = hi;
                    if (MODE == 2 && (t & 7) == 7) { const int q = 8 * uidx + 2 * sub + (t >> 3); const size_t si = ((size_t)(layer * DB + q) * 16 + g) * 64 + lane; a.out[O_SRES + si] = hr; a.out[O_SIMS + si] = hi; }
                }
#pragma unroll
                for (int t = 0; t < 16; ++t) { BU[t * 132 + lane] = bre_[t]; BU[t * 132 + 64 + lane] = bim_[t]; }
            }
            if (MODE >= 1) {
                asm volatile("s_waitcnt lgkmcnt(0)" ::: "memory");
                f32x4 y = (f32x4){0.f, 0.f, 0.f, 0.f};
#pragma unroll
                for (int ks = 0; ks < 4; ++ks) { const f32x4 h0 = *(LAS f32x4*)(BU + fr * 132 + 32 * ks + 8 * fq), h1 = *(LAS f32x4*)(BU + fr * 132 + 32 * ks + 8 * fq + 4);
                    v4u hw; hw.x = pk2(h0[0], h0[1]); hw.y = pk2(h0[2], h0[3]); hw.z = pk2(h1[0], h1[1]); hw.w = pk2(h1[2], h1[3]);
                    y = __builtin_amdgcn_mfma_f32_16x16x32_bf16(__builtin_bit_cast(bf16x8, hw), cmf[ks], y, 0, 0, 0); }
#pragma unroll
                for (int r = 0; r < 4; ++r) { const int t = 4 * fq + r; const float uv = bf1(uva[sub][r]);
                    const float z = gelu_tanh(y[r] + dsk * uv);
                    Zt[(16 * sub + t) * 264 + 16 * g + fr] = (bf16)(pk2(z, 0.f) & 0xffffu); }
                asm volatile("s_waitcnt lgkmcnt(0)" ::: "memory");
            }
            if (MODE == 0) { asm volatile("s_waitcnt lgkmcnt(0)" ::: "memory"); }
        }
        if (MODE == 0) E[((size_t)(s * NCH + c) * 16 + g) * 64 + lane] = (f32x2){hr, hi};
        if (MODE == 1 && c == NCH - 1) { const size_t si = ((size_t)(layer * NB + s) * 16 + g) * 64 + lane; a.out[O_SREP + si] = hr; a.out[O_SIMP + si] = hi; }
    }
    if (MODE == 0) __syncthreads();
    if (MODE >= 1) {
        __syncthreads();
        const bf16* WG = (const bf16*)(a.ws + WS_WGLU) + (size_t)layer * MIXW * MIXW;
        f32x4 acc[4][2];
#pragma unroll
        for (int mt = 0; mt < 4; ++mt) { acc[mt][0] = (f32x4){0.f, 0.f, 0.f, 0.f}; acc[mt][1] = (f32x4){0.f, 0.f, 0.f, 0.f}; }
#pragma unroll
        for (int ks = 0; ks < 8; ++ks) {
            const bf16x8 w0 = *(const bf16x8*)(WG + (size_t)(32 * wave + fr) * MIXW + 32 * ks + 8 * fq), w1 = *(const bf16x8*)(WG + (size_t)(32 * wave + 16 + fr) * MIXW + 32 * ks + 8 * fq);
#pragma unroll
            for (int mt = 0; mt < 4; ++mt) { const bf16x8 zb = *(LAS bf16x8*)(Zt + (16 * mt + fr) * 264 + 32 * ks + 8 * fq);
                acc[mt][0] = __builtin_amdgcn_mfma_f32_16x16x32_bf16(w0, zb, acc[mt][0], 0, 0, 0);
                acc[mt][1] = __builtin_amdgcn_mfma_f32_16x16x32_bf16(w1, zb, acc[mt][1], 0, 0, 0); }
        }
#pragma unroll
        for (int nl = 0; nl < 2; ++nl) { const int n0 = 32 * wave + 16 * nl + 4 * fq; const f32x4 bgl = *(const f32x4*)(a.in[I_BGLU] + layer * MIXW + n0);
#pragma unroll
            for (int mt = 0; mt < 4; ++mt) { const int tt = 16 * mt + fr; const v2u zz = *(LAS v2u*)(Zt + tt * 264 + n0);
                const float z0 = bflo(zz.x), z1 = bfhi(zz.x), z2 = bflo(zz.y), z3 = bfhi(zz.y);
                v2u w; w.x = pk2(z0 * sigm(acc[mt][nl][0] + bgl[0]), z1 * sigm(acc[mt][nl][1] + bgl[1])); w.y = pk2(z2 * sigm(acc[mt][nl][2] + bgl[2]), z3 * sigm(acc[mt][nl][3] + bgl[3]));
                *(v2u*)(BR + (size_t)(row0 + tt) * D + 256 + n0) = w; } }
        __syncthreads();
    }
}

__device__ __forceinline__ void gemm2_phase(LAS unsigned char* lds, const bf16* BRp, const bf16* WBT, const bf16* GT, bf16* MG, int G, int bid, int tidp) {
    using namespace pg8;
    int tid_ = tidp; asm volatile("" : "+v"(tid_));
    const int tid = tid_, wid = __builtin_amdgcn_readfirstlane(tid >> 6), lane = tid & 63, wr = wid >> 2, wc = wid & 3, fr = lane & 15, fq = lane >> 4;
    unsigned voffA0, voffB0;
    { int R, C; stage_rc(tid * 16, R, C); const int Rb = (R & ~31) + perm32(R & 31); voffA0 = (unsigned)(R * D + C) * 2u; voffB0 = (unsigned)(Rb * MIXW + C) * 2u; }
    const unsigned ldsw = (unsigned)wid * 1024u;
    const int aoff = lds_byte(wr * 64 + fr, fq * 8), boff = lds_byte(wc * 32 + fr, fq * 8);
    const unsigned gvoff = (unsigned)(fr * GTC + 8 * fq) * 2u;
    constexpr int STG = 49152;
#define G2_STAGE(it_, so_) do { const int kb_ = (it_) >> 2, kt_ = (it_) & 3; \
        const char* as_ = Abase + (size_t)(kb_ * 256 + kt_ * 64) * 2; const char* bs_ = Bbase + (size_t)kb_ * (D * MIXW * 2) + (size_t)kt_ * 128; \
        _Pragma("unroll") for (int _i = 0; _i < 2; ++_i) __builtin_amdgcn_global_load_lds((const unsigned*)(as_ + (size_t)_i * (64 * D * 2) + voffA0), (PG8_LAS unsigned*)(lds + (so_) + ldsw + _i * 8192), 16, 0, 0); \
        _Pragma("unroll") for (int _i = 0; _i < 2; ++_i) __builtin_amdgcn_global_load_lds((const unsigned*)(bs_ + (size_t)_i * (64 * MIXW * 2) + voffB0), (PG8_LAS unsigned*)(lds + (so_) + 16384 + ldsw + _i * 8192), 16, 0, 0); \
        _Pragma("unroll") for (int _i = 0; _i < 2; ++_i) __builtin_amdgcn_global_load_lds((const unsigned*)(bs_ + (size_t)(128 + 64 * _i) * MIXW * 2 + voffB0), (PG8_LAS unsigned*)(lds + (so_) + 32768 + ldsw + _i * 8192), 16, 0, 0); } while (0)
    const int vb = (G % 8 == 0) ? (bid % 8) * (G / 8) + bid / 8 : bid;
    constexpr int NUN = (MP / 128) * 4;
    for (int ui = vb; ui < NUN; ui += G) {
        const int pm = ui >> 2, pn = ui & 3;
        const char* Abase = (const char*)BRp + (size_t)pm * 128 * D * 2;
        const char* Bbase = (const char*)WBT + (size_t)pn * 256 * MIXW * 2;
        G2_STAGE(0, 0); G2_STAGE(1, STG);
        f32x4 mg[2][4][2], acc[2][4][2];
#pragma unroll
        for (int b = 0; b < 2; ++b)
#pragma unroll
            for (int m = 0; m < 4; ++m)
#pragma unroll
                for (int n = 0; n < 2; ++n) { mg[b][m][n] = (f32x4){0.f, 0.f, 0.f, 0.f}; acc[b][m][n] = (f32x4){0.f, 0.f, 0.f, 0.f}; }
        v4u gq[2][4];
        int so = 0, so2 = 2 * STG;
#pragma unroll 1
        for (int kb = 0; kb < 4; ++kb) {
#pragma unroll
            for (int kt = 0; kt < 4; ++kt) {
                if (kt < 2) asm volatile("s_waitcnt vmcnt(6)" ::: "memory");
                else if (kt == 3 && kb == 3) asm volatile("s_waitcnt vmcnt(8)" ::: "memory");
                else asm volatile("s_waitcnt vmcnt(14)" ::: "memory");
                __builtin_amdgcn_s_barrier(); asm volatile("" ::: "memory");
                if (kt < 2 || kb < 3) G2_STAGE(4 * kb + kt + 2, so2);
#pragma unroll
                for (int kk = 0; kk < 2; ++kk) {
                    bf16x8 At[4], B0[2], B1[2];
#pragma unroll
                    for (int m = 0; m < 4; ++m) At[m] = *(const PG8_LAS bf16x8*)(lds + so + aoff + m * 2048 + kk * 1024);
#pragma unroll
                    for (int n = 0; n < 2; ++n) { B0[n] = *(const PG8_LAS bf16x8*)(lds + so + 16384 + boff + n * 2048 + kk * 1024); B1[n] = *(const PG8_LAS bf16x8*)(lds + so + 32768 + boff + n * 2048 + kk * 1024); }
                    asm volatile("s_waitcnt lgkmcnt(0)" ::: "memory"); __builtin_amdgcn_sched_barrier(0);
#pragma unroll
                    for (int m = 0; m < 4; ++m)
#pragma unroll
                        for (int n = 0; n < 2; ++n) { acc[0][m][n] = __builtin_amdgcn_mfma_f32_16x16x32_bf16(B0[n], At[m], acc[0][m][n], 0, 0, 0);
                                                      acc[1][m][n] = __builtin_amdgcn_mfma_f32_16x16x32_bf16(B1[n], At[m], acc[1][m][n], 0, 0, 0); }
                }
                if (kt == 1) {
#pragma unroll
                    for (int m = 0; m < 4; ++m) { const bf16* gs = GT + (size_t)(pm * 128 + wr * 64 + m * 16) * GTC + kb * D + pn * 256 + wc * 32;
                        asm volatile("global_load_dwordx4 %0, %1, %2" : "=v"(gq[0][m]) : "v"(gvoff), "s"(gs) : "memory");
                        asm volatile("global_load_dwordx4 %0, %1, %2 offset:256" : "=v"(gq[1][m]) : "v"(gvoff), "s"(gs) : "memory"); }
                }
                so = so == 2 * STG ? 0 : so + STG; so2 = so2 == 2 * STG ? 0 : so2 + STG;
            }
            if (kb == 3) asm volatile("s_waitcnt vmcnt(0)" ::: "memory"); else asm volatile("s_waitcnt vmcnt(12)" ::: "memory");
            asm volatile("" : "+v"(gq[0][0]), "+v"(gq[0][1]), "+v"(gq[0][2]), "+v"(gq[0][3]), "+v"(gq[1][0]), "+v"(gq[1][1]), "+v"(gq[1][2]), "+v"(gq[1][3]));
#pragma unroll
            for (int b = 0; b < 2; ++b)
#pragma unroll
                for (int m = 0; m < 4; ++m) { float gv[8]; unpack8(gq[b][m], gv);
#pragma unroll
                    for (int j = 0; j < 4; ++j) { mg[b][m][0][j] += gv[j] * acc[b][m][0][j]; mg[b][m][1][j] += gv[4 + j] * acc[b][m][1][j]; }
                    acc[b][m][0] = (f32x4){0.f, 0.f, 0.f, 0.f}; acc[b][m][1] = (f32x4){0.f, 0.f, 0.f, 0.f}; }
        }
        asm volatile("" ::: "memory"); __builtin_amdgcn_s_barrier(); asm volatile("" ::: "memory");
#pragma unroll
        for (int b = 0; b < 2; ++b)
#pragma unroll
            for (int m = 0; m < 4; ++m) { const int row = pm * 128 + wr * 64 + m * 16 + fr, col = pn * 256 + b * 128 + wc * 32 + 8 * fq;
                v4u w; w.x = pk2(mg[b][m][0][0], mg[b][m][0][1]); w.y = pk2(mg[b][m][0][2], mg[b][m][0][3]); w.z = pk2(mg[b][m][1][0], mg[b][m][1][1]); w.w = pk2(mg[b][m][1][2], mg[b][m][1][3]);
                *(v4u*)(MG + (size_t)row * D + col) = w; }
    }
#undef G2_STAGE
}


#define TL_GLDS(src_, dst_) __builtin_amdgcn_global_load_lds((const unsigned*)(src_), (PG8_LAS unsigned*)(dst_), 16, 0, 0)
#define TL_STAGE(kt_, A_PTR, B_PTR) do { const int s_ = (kt_) & 3; const char* ap_ = A_PTR(kt_); const char* bp_ = B_PTR(kt_); \
        TL_GLDS(ap_ + voffA, lds + s_ * 32768 + ldsw); TL_GLDS(ap_ + voffA + 128, lds + s_ * 32768 + 8192 + ldsw); \
        TL_GLDS(bp_ + voffB, lds + s_ * 32768 + 16384 + ldsw); TL_GLDS(bp_ + voffB + 128, lds + s_ * 32768 + 24576 + ldsw); } while (0)
#define TL_LOOP(NK, A_PTR, B_PTR, AFTER_STEP) do { \
        TL_STAGE(0, A_PTR, B_PTR); if ((NK) > 1) TL_STAGE(1, A_PTR, B_PTR); if ((NK) > 2) TL_STAGE(2, A_PTR, B_PTR); \
        _Pragma("unroll 1") for (int kt = 0; kt < (NK); ++kt) { \
            if (kt + 2 < (NK)) asm volatile("s_waitcnt vmcnt(8)" ::: "memory"); else if (kt + 1 < (NK)) asm volatile("s_waitcnt vmcnt(4)" ::: "memory"); else asm volatile("s_waitcnt vmcnt(0)" ::: "memory"); \
            __builtin_amdgcn_s_barrier(); asm volatile("" ::: "memory"); \
            if (kt + 3 < (NK)) TL_STAGE(kt + 3, A_PTR, B_PTR); \
            const int sb_ = (kt & 3) * 32768; \
            _Pragma("unroll") for (int h_ = 0; h_ < 2; ++h_) { \
                const bf16x8 a0 = *(const PG8_LAS bf16x8*)(lds + sb_ + h_ * 8192 + aoff), a1 = *(const PG8_LAS bf16x8*)(lds + sb_ + h_ * 8192 + aoff + 1024); \
                const bf16x8 b00 = *(const PG8_LAS bf16x8*)(lds + sb_ + 16384 + h_ * 8192 + boff), b01 = *(const PG8_LAS bf16x8*)(lds + sb_ + 16384 + h_ * 8192 + boff + 1024); \
                const bf16x8 b10 = *(const PG8_LAS bf16x8*)(lds + sb_ + 16384 + h_ * 8192 + boff + 2048), b11 = *(const PG8_LAS bf16x8*)(lds + sb_ + 16384 + h_ * 8192 + boff + 3072); \
                asm volatile("s_waitcnt lgkmcnt(0)" ::: "memory"); __builtin_amdgcn_sched_barrier(0); \
                acc[0] = __builtin_amdgcn_mfma_f32_16x16x32_bf16(b00, a0, acc[0], 0, 0, 0); acc[1] = __builtin_amdgcn_mfma_f32_16x16x32_bf16(b10, a0, acc[1], 0, 0, 0); \
                acc[0] = __builtin_amdgcn_mfma_f32_16x16x32_bf16(b01, a1, acc[0], 0, 0, 0); acc[1] = __builtin_amdgcn_mfma_f32_16x16x32_bf16(b11, a1, acc[1], 0, 0, 0); } \
            AFTER_STEP(kt); } \
        asm volatile("s_waitcnt lgkmcnt(0)" ::: "memory"); __builtin_amdgcn_s_barrier(); asm volatile("" ::: "memory"); } while (0)
#define TL_SETUP(LDA, LDB) using namespace pg8; int tid_ = tidp; asm volatile("" : "+v"(tid_)); \
    const int tid = tid_, wid = __builtin_amdgcn_readfirstlane(tid >> 6), lane = tid & 63, fr = lane & 15, fq = lane >> 4, mt = wid >> 1, nh = wid & 1; \
    int R_, C_; stage_rc(tid * 16, R_, C_); \
    const unsigned voffA = (unsigned)(R_ * (LDA) + C_) * 2u, voffB = (unsigned)(R_ * (LDB) + C_) * 2u, ldsw = (unsigned)wid * 1024u; \
    const int aoff = lds_byte(mt * 16 + fr, fq * 8), boff = lds_byte(nh * 32 + fr, fq * 8); (void)lane
#define TL_NOP(kt_) do {} while (0)

struct CappedOrder : pg8::StaticOrder {
    int cap;
    __device__ bool next(int i, pg8::Unit& u) const { if ((long)i * G + c >= cap) return false; return pg8::StaticOrder::next(i, u); }
};
__device__ __forceinline__ void proj_tail_phase(LAS unsigned char* lds, const bf16* A, const bf16* Bt, int cap, const float* ssq, const float* bgate, bf16* PMp, bf16* GTp, int G, int bid, int tidp) {
    TL_SETUP(D, D);
    StaticOrder S1; S1.init(M, INC, 1, 0);
    const int nsub = (S1.nwg - cap) * 16;
    for (int t = bid; t < nsub; t += G) {
        Unit u; S1.next(cap + (t >> 4), u);
        const int rb = (t >> 2) & 3, cb = t & 3, r0 = u.pm * 256 + 64 * rb, c0 = u.pn * 256 + 64 * cb;
        const char* Ab = (const char*)A + (size_t)r0 * D * 2; const char* Bb = (const char*)Bt + (size_t)c0 * D * 2;
        f32x4 acc[2] = {(f32x4){0.f, 0.f, 0.f, 0.f}, (f32x4){0.f, 0.f, 0.f, 0.f}};
        const int row = r0 + 16 * mt + fr;
        const float rs = pg8::row_rstd(ssq, row);
        const bool isg = u.pn >= 7;
        f32x4 bvv[2];
#pragma unroll
        for (int n = 0; n < 2; ++n) bvv[n] = isg ? *(const f32x4*)(bgate + (c0 + 32 * nh + 16 * n + 4 * fq - PMC)) : (f32x4){0.f, 0.f, 0.f, 0.f};
#define PT_A(kt_) (Ab + (size_t)(kt_) * 256)
#define PT_B(kt_) (Bb + (size_t)(kt_) * 256)
        TL_LOOP(D / 128, PT_A, PT_B, TL_NOP);
#undef PT_A
#undef PT_B
#pragma unroll
        for (int n = 0; n < 2; ++n) { const int col = c0 + 32 * nh + 16 * n + 4 * fq; f32x4 v = acc[n] * rs;
            if (isg) { const f32x4 bv = bvv[n]; v = (f32x4){::sigm(v[0] + bv[0]), ::sigm(v[1] + bv[1]), ::sigm(v[2] + bv[2]), ::sigm(v[3] + bv[3])}; }
            v2u w; w.x = pk2(v[0], v[1]); w.y = pk2(v[2], v[3]);
            if (isg) *(v2u*)(GTp + (size_t)row * GTC + (col - PMC)) = w; else *(v2u*)(PMp + (size_t)row * PMC + col) = w; }
    }
}

__device__ __forceinline__ void gemm2_tail_phase(LAS unsigned char* lds, const bf16* BRp, const bf16* WBT, const bf16* GT, bf16* MG, int G, int bid, int tidp) {
    TL_SETUP(D, MIXW);
    for (int ui = bid; ui < 256; ui += G) {
        const int rb = ((ui & 7) >> 1) * 4 + (ui >> 6), cb = (ui & 1) * 8 + ((ui >> 3) & 7);
        const char* Ab = (const char*)BRp + (size_t)(MP + 64 * rb) * D * 2; const char* Bb = (const char*)WBT + (size_t)(64 * cb) * MIXW * 2;
        f32x4 acc[2] = {(f32x4){0.f, 0.f, 0.f, 0.f}, (f32x4){0.f, 0.f, 0.f, 0.f}}, mg[2] = {(f32x4){0.f, 0.f, 0.f, 0.f}, (f32x4){0.f, 0.f, 0.f, 0.f}};
        const int row = MP + 64 * rb + 16 * mt + fr;
#define G2T_A(kt_) (Ab + (size_t)(((kt_) >> 1) * 256 + ((kt_) & 1) * 128) * 2)
#define G2T_B(kt_) (Bb + (size_t)((kt_) >> 1) * (D * MIXW * 2) + (size_t)((kt_) & 1) * 256)
        v2u gwp[4][2];
#pragma unroll
        for (int kb = 0; kb < 4; ++kb)
#pragma unroll
            for (int n = 0; n < 2; ++n) gwp[kb][n] = *(const v2u*)(GT + (size_t)row * GTC + kb * D + 64 * cb + 32 * nh + 16 * n + 4 * fq);
#define G2T_AFTER(kt_) do { if ((kt_) & 1) { const int kb_ = (kt_) >> 1; \
            _Pragma("unroll") for (int n = 0; n < 2; ++n) { const v2u gw = kb_ == 0 ? gwp[0][n] : (kb_ == 1 ? gwp[1][n] : (kb_ == 2 ? gwp[2][n] : gwp[3][n])); \
                mg[n][0] += bflo(gw.x) * acc[n][0]; mg[n][1] += bfhi(gw.x) * acc[n][1]; mg[n][2] += bflo(gw.y) * acc[n][2]; mg[n][3] += bfhi(gw.y) * acc[n][3]; \
                acc[n] = (f32x4){0.f, 0.f, 0.f, 0.f}; } } } while (0)
        TL_LOOP(8, G2T_A, G2T_B, G2T_AFTER);
#undef G2T_A
#undef G2T_B
#undef G2T_AFTER
#pragma unroll
        for (int n = 0; n < 2; ++n) { v2u w; w.x = pk2(mg[n][0], mg[n][1]); w.y = pk2(mg[n][2], mg[n][3]); *(v2u*)(MG + (size_t)row * D + 64 * cb + 32 * nh + 16 * n + 4 * fq) = w; }
    }
}

__device__ __forceinline__ void resid_tail_phase(LAS unsigned char* lds, const bf16* A, const bf16* Bt, int K, const float* xs_old, bool first, bf16* XBp, float* ssq, int G, int bid, int tidp) {
    TL_SETUP(K, K);
    const int nk = K / 128;
    for (int ui = bid; ui < 256; ui += G) {
        const int rb = ((ui & 7) >> 1) * 4 + (ui >> 6), cb = (ui & 1) * 8 + ((ui >> 3) & 7);
        const char* Ab = (const char*)A + (size_t)(MP + 64 * rb) * K * 2; const char* Bb = (const char*)Bt + (size_t)(64 * cb) * K * 2;
        f32x4 acc[2] = {(f32x4){0.f, 0.f, 0.f, 0.f}, (f32x4){0.f, 0.f, 0.f, 0.f}};
        const int rowl = 16 * mt + fr, row = MP + 64 * rb + rowl; float ss = 0.f;
        f32x4 xold[2];
#pragma unroll
        for (int n = 0; n < 2; ++n) { const int col = 64 * cb + 32 * nh + 16 * n + 4 * fq;
            if (first) xold[n] = *(const f32x4*)(xs_old + (size_t)(row - MP) * D + col);
            else { const v2u q = *(const v2u*)(XBp + (size_t)row * D + col); xold[n] = (f32x4){bflo(q.x), bfhi(q.x), bflo(q.y), bfhi(q.y)}; } }
#define RT_A(kt_) (Ab + (size_t)(kt_) * 256)
#define RT_B(kt_) (Bb + (size_t)(kt_) * 256)
        TL_LOOP(nk, RT_A, RT_B, TL_NOP);
#undef RT_A
#undef RT_B
#pragma unroll
        for (int n = 0; n < 2; ++n) { const int col = 64 * cb + 32 * nh + 16 * n + 4 * fq;
            const f32x4 o = xold[n] + acc[n];
            v2u w; w.x = pk2(o[0], o[1]); w.y = pk2(o[2], o[3]); *(v2u*)(XBp + (size_t)row * D + col) = w;
            ss += (o[0] * o[0] + o[1] * o[1]) + (o[2] * o[2] + o[3] * o[3]); }
        ss += __shfl_xor(ss, 16); ss += __shfl_xor(ss, 32);
        LAS float* red = (LAS float*)lds;
        if (fq == 0) red[rowl * 2 + nh] = ss;
        __syncthreads();
        if (tid < 64) ssq[((size_t)(cb >> 2) * M + MP + 64 * rb + tid) * 4 + (cb & 3)] = red[tid * 2] + red[tid * 2 + 1];
        __syncthreads();
    }
}

#ifndef PROBE_REP_B
#define PROBE_REP_B 1
#endif
#ifndef PROBE_REP_C
#define PROBE_REP_C 1
#endif
#ifndef PROBE_REP_D
#define PROBE_REP_D 1
#endif
#ifndef PROBE_REP_P0
#define PROBE_REP_P0 1
#endif
__global__ void __launch_bounds__(NWAVES * 64, 2) hybrid_fwd(Args args) {
    extern __shared__ __attribute__((aligned(16))) unsigned char lds_raw[];
    LAS unsigned char* lds = (LAS unsigned char*)lds_raw;
    volatile LAS unsigned* MISC = (volatile LAS unsigned*)(lds + MISC_OFF);
    const int tid0 = threadIdx.x, wave0 = __builtin_amdgcn_readfirstlane(tid0 >> 6);
    const int G0 = gridDim.x, bid = blockIdx.x;
    unsigned char* ws = args.ws;
    for (int u = tid0; u < (LDS_BYTES - LDSCTL_OFF) / 4; u += NWAVES * 64) ((LAS unsigned*)(lds + LDSCTL_OFF))[u] = 0u;
    __syncthreads();
    const int lo = args.ph_lo, hi = args.ph_hi;
    XcdBarrier bar; bar.bar = (unsigned*)(ws + WS_CTL) + CW_BAR; bar.x = 0; bar.st = nullptr;
    if (hi - lo > 1) bar = xcd_barrier_post((unsigned*)(ws + WS_CTL) + CW_BAR, MISC + 8);
    bf16* XB = (bf16*)(ws + WS_ACT1); bf16* PMb = (bf16*)(ws + WS_PM); bf16* GTb = (bf16*)(ws + WS_GT);
    bf16* MGb = (bf16*)(ws + WS_PM); bf16* ACTb = (bf16*)(ws + WS_GT);
    float* ssq = (float*)(ws + WS_SSQ);
    for (int ph_i = lo; ph_i < hi; ++ph_i) {
#ifdef DBG_T_PH
        if (ph_i == DBG_T_PH && bid == DBG_T_BLK && wave0 == 0 && __builtin_amdgcn_mbcnt_lo(~0u, 0u) == 0u) { ((volatile LAS unsigned long long*)(lds + MISC_OFF + 256))[0] = __builtin_amdgcn_s_memtime(); ((volatile LAS unsigned long long*)(lds + MISC_OFF + 256))[1] = __builtin_amdgcn_s_memrealtime(); }
#endif
        int ph = ph_i, G = G0; asm volatile("" : "+s"(ph), "+s"(G));
        int tid = wave0 * 64 + (int)__builtin_amdgcn_mbcnt_hi(~0u, __builtin_amdgcn_mbcnt_lo(~0u, 0u)); asm volatile("" : "+v"(tid)); const int lane = tid & 63, wave = __builtin_amdgcn_readfirstlane(tid >> 6);
        const int layer = (ph - 1) / 7, k = ph == 0 ? -1 : (ph == NPHASE - 1 ? 7 : (ph - 1) % 7);
        if (k == -1) for (int rep_ = 0; rep_ < PROBE_REP_P0; ++rep_) p0_prologue(args, lds, tid, lane, wave, G, bid);
        else if (k == 7) final_norm(args, lane, wave, G, bid);
        else if (k == 0) {
            pg8::Gemm g{XB, (const bf16*)(ws + WS_WIN) + (size_t)layer * INC * D, M, INC, D}; CappedOrder S; S.init(M, INC, G, bid); S.cap = (S.nwg / G) * G;
            pg8::EpiProj E{PMb, GTb, ssq, args.in[I_BGATE] + (size_t)layer * GTC, (const LAS float*)(lds + RING_OFF + pg8::RSTD_LDS_OFF)};
            pg8::gemm_phase<pg8::EpiProj, CappedOrder, true, true>(lds + RING_OFF, g, S, E, tid);
            proj_tail_phase(lds + RING_OFF, XB, (const bf16*)(ws + WS_WIN) + (size_t)layer * INC * D, S.cap, ssq, args.in[I_BGATE] + (size_t)layer * GTC, PMb, GTb, G, bid, tid);
            if (!MK_PER_PHASE && G == 256 && bid >= P0_A_BID0 && layer + 1 < NLAYER) p0_idle_items(args, lds, lane, wave, bid, layer + 1, 0, P0_A_BID0, P0_A_PER);
#ifdef PROBE_A_SAME
            { SameTileOrder S2; S2.init(M, INC, G, bid); pg8::EpiNull EN_; pg8::gemm_phase<pg8::EpiNull, SameTileOrder, true, true>(lds + RING_OFF, g, S2, EN_, tid); }
#endif
#ifdef PROBE_A_NULL
            { pg8::EpiNull EN_; pg8::gemm_phase<pg8::EpiNull, CappedOrder, true, true>(lds + RING_OFF, g, S, EN_, tid); }
#endif
#ifdef PROBE_A_FULL
            pg8::gemm_phase<pg8::EpiProj, CappedOrder, true, true>(lds + RING_OFF, g, S, E, tid);
#endif
        } else if (k == 1) for (int rep_ = 0; rep_ < PROBE_REP_B; ++rep_) {
            for (int s_ = 0; ; ++s_) { int u; bool donor = false;
                if (G == 256) { if (s_ > 2) break;
                    donor = bid < 16 || (bid >= 80 && bid < 152);
                    if (s_ == 0) u = 272 + ((bid + 240) & 255);
                    else if (bid < 16) { if (s_ == 2) break; u = 256 + bid; }
                    else if (bid < 80) { if (s_ == 2) break; u = 528 + (bid - 16); }
                    else if (s_ == 1 || bid < 152) { const int v = (s_ == 1 ? 0 : 176) + (bid - 80); u = (v / 31) * 32 + v % 31; }
                    else if (bid < 240) { const int t_ = bid - 152, db = t_ < 16 ? t_ : 80 + (t_ - 16); u = 592 + ((db + 240) & 255); }
                    else break; }
                else { u = bid + s_ * G; if (u >= 256 + 16 + 256 + 64) break; }
                if (u < 256) { if ((u & 31) != NCH - 1) ssm_unit<0>(args, layer, u, lds, tid, lane, wave); }
                else if (u < 272) ssm_unit<2>(args, layer, u - 256, lds, tid, lane, wave);
                else if (u < 528 || u >= 592) mix_unit<false>(args, layer, u < 528 ? u - 272 : u - 592, lds, tid, lane, wave, u >= 592 ? 4 : (donor ? 3 : 7));
                else mix_unit<true>(args, layer, u - 528, lds, tid, lane, wave, 7);
            }
        } else if (k == 2) for (int rep_ = 0; rep_ < PROBE_REP_C; ++rep_) {
            for (int u = bid; u < 256; u += G) ssm_unit<1>(args, layer, u, lds, tid, lane, wave);
        } else if (k == 3) for (int rep_ = 0; rep_ < PROBE_REP_D; ++rep_) {
            gemm2_phase(lds + RING_OFF, (const bf16*)args.out, (const bf16*)(ws + WS_WBR) + (size_t)layer * 4 * D * MIXW, GTb, MGb, G, bid, tid);
            gemm2_tail_phase(lds + RING_OFF, (const bf16*)args.out, (const bf16*)(ws + WS_WBR) + (size_t)layer * 4 * D * MIXW, GTb, MGb, G, bid, tid);
        } else if (k == 5) {
            pg8::Gemm g{XB, (const bf16*)(ws + WS_WFI) + (size_t)layer * 2 * FF * D, M, 2 * FF, D}; pg8::StaticOrder S; S.init(M, 2 * FF, G, bid);
            pg8::EpiSwiGLU E{ACTb, ssq, (const LAS float*)(lds + RING_OFF + pg8::RSTD_LDS_OFF)};
            pg8::gemm_phase<pg8::EpiSwiGLU, pg8::StaticOrder, true, true>(lds + RING_OFF, g, S, E, tid);
            if (!MK_PER_PHASE && G == 256 && bid >= P0_F_BID0 && layer + 1 < NLAYER) p0_idle_items(args, lds, lane, wave, bid, layer + 1, p0_items_A(G), P0_F_BID0, P0_F_PER);
        } else {
            const bool isE = k == 4; const int K = isE ? D : FF;
            const bf16* Ap = isE ? MGb : ACTb; const bf16* Bp = isE ? (const bf16*)(ws + WS_WOUT) + (size_t)layer * D * D : (const bf16*)(ws + WS_WFO) + (size_t)layer * D * FF;
            const bool first = isE && layer == 0;
            { pg8::Gemm g{Ap, Bp, MP, D, K}; pg8::StaticOrder S; S.init(MP, D, G, bid);
              pg8::EpiResid E{args.in[I_XP], args.in[I_XS], first, XB, ssq};
              pg8::gemm_phase<pg8::EpiResid, pg8::StaticOrder, true, true>(lds + RING_OFF, g, S, E, tid); }
#ifdef DBG_T_TAIL
            if (ph == DBG_T_PH && bid == DBG_T_BLK && tid == 0) ((volatile LAS unsigned long long*)(lds + MISC_OFF + 256))[9] = __builtin_amdgcn_s_memrealtime();
#endif
            resid_tail_phase(lds + RING_OFF, Ap, Bp, K, args.in[I_XS], first, XB, ssq, G, bid, tid);
#ifdef DBG_T_TAIL
            if (ph == DBG_T_PH && bid == DBG_T_BLK && tid == 0) ((volatile LAS unsigned long long*)(lds + MISC_OFF + 256))[10] = __builtin_amdgcn_s_memrealtime();
#endif
        }
#ifdef DBG_T_PH
        if (ph == DBG_T_PH && bid == DBG_T_BLK && tid == 0) { ((volatile LAS unsigned long long*)(lds + MISC_OFF + 256))[2] = __builtin_amdgcn_s_memtime(); ((volatile LAS unsigned long long*)(lds + MISC_OFF + 256))[3] = __builtin_amdgcn_s_memrealtime(); }
#endif
        if (ph_i + 1 < hi) {
            asm volatile("s_waitcnt vmcnt(0)" ::: "memory"); __syncthreads();
            if (tid == 0) xcd_barrier_leader(bar);
            else if (!MK_PER_PHASE && wave != 0 && k >= 0 && k < P0_SLICES && layer + 1 < NLAYER) p0_slice(args, lds, lane, wave, G, bid, layer + 1, k);
            __syncthreads();
        }
#ifdef PROBE_XBAR
        if (ph_i == 8) for (int i_ = 0; i_ < PROBE_XBAR; ++i_) xcd_barrier(bar, tid == 0);
#endif
#if defined(DBG_T_PH) && defined(DBG_T_AFTERBAR)
        if (ph == DBG_T_PH && bid == DBG_T_BLK && tid == 0) { ((volatile LAS unsigned long long*)(lds + MISC_OFF + 256))[2] = __builtin_amdgcn_s_memtime(); ((volatile LAS unsigned long long*)(lds + MISC_OFF + 256))[3] = __builtin_amdgcn_s_memrealtime(); }
#endif
    }
#ifdef DBG_T_PH
    if (bid == DBG_T_BLK && wave0 == 0 && __builtin_amdgcn_mbcnt_lo(~0u, 0u) == 0u) {
        volatile LAS unsigned long long* ts_ = (volatile LAS unsigned long long*)(lds + MISC_OFF + 256);
        const unsigned long long dc = ts_[2] - ts_[0], dr = ts_[3] - ts_[1];
        unsigned long long val = DBG_T_MODE == 11 ? (ts_[16 + DBG_TB] - ts_[16 + DBG_TA]) : DBG_T_MODE == 8 ? (ts_[5] - ts_[1])   : DBG_T_MODE == 9 ? (ts_[3] - ts_[7])   : DBG_T_MODE == 10 ? (ts_[7] - ts_[5])   : DBG_T_MODE == 7 ? (ts_[10] - ts_[9])   : DBG_T_MODE == 5 ? (ts_[8] - ts_[4]) / 16ull   : DBG_T_MODE == 3 ? (ts_[6] - ts_[4]) / 16ull   : DBG_T_MODE == 4 ? (ts_[7] - ts_[5]) * 10ull   : DBG_T_MODE == 0 ? (dc * 100ull) / (dr ? dr : 1ull)      : DBG_T_MODE == 1 ? dr   : dc / 1000ull;
        const unsigned long long t0 = __builtin_amdgcn_s_memrealtime();
        while (__builtin_amdgcn_s_memrealtime() - t0 < val * 100ull) __builtin_amdgcn_s_sleep(16);
    }
#endif
}

extern "C" void kernel_launch(void* const* d_in, const int* in_sizes, int n_in, void* d_out, int out_size, void* d_ws, size_t ws_size, hipStream_t stream) {
    static int grid = 0;
    if (grid == 0) {
        if (n_in != 32 || out_size != (int)O_END || ws_size < WS_END) { fprintf(stderr, "kernel_launch: expected 32 inputs, %zu outputs, >= %zu bytes of workspace; got %d, %d, %zu; nothing launched\n", (size_t)O_END, (size_t)WS_END, n_in, out_size, ws_size); grid = -1; return; }
        int dev = 0, cus = 0, per_cu = 0;
        if (hipGetDevice(&dev) != hipSuccess || hipDeviceGetAttribute(&cus, hipDeviceAttributeMultiprocessorCount, dev) != hipSuccess) { grid = -1; return; }
        if (hipFuncSetAttribute((const void*)hybrid_fwd, hipFuncAttributeMaxDynamicSharedMemorySize, LDS_BYTES) != hipSuccess) { fprintf(stderr, "kernel_launch: hipFuncSetAttribute failed\n"); grid = -1; return; }
        if (hipOccupancyMaxActiveBlocksPerMultiprocessor(&per_cu, (const void*)hybrid_fwd, NWAVES * 64, LDS_BYTES) != hipSuccess || per_cu < 1) { fprintf(stderr, "kernel_launch: occupancy query says %d blocks per CU; nothing launched\n", per_cu); (void)hipGetLastError(); grid = -1; return; }
        grid = cus;
    }
    if (grid < 0) return;
    (void)hipMemsetAsync((char*)d_ws + WS_CTL, 0, CTL_ZERO_BYTES, stream);
    Args a{};
    for (int i = 0; i < 32; ++i) a.in[i] = (const float*)d_in[i];
    a.out = (float*)d_out; a.ws = (unsigned char*)d_ws;
#if MK_PER_PHASE
    for (int k = 0; k < NPHASE; ++k) { a.ph_lo = k; a.ph_hi = k + 1; hipLaunchKernelGGL(hybrid_fwd, dim3(grid), dim3(NWAVES * 64), LDS_BYTES, stream, a); }
#else
    a.ph_lo = 0; a.ph_hi = NPHASE;
    hipLaunchKernelGGL(hybrid_fwd, dim3(grid), dim3(NWAVES * 64), LDS_BYTES, stream, a);
#endif
}
```

```cpp
#include <hip/hip_runtime.h>
#include <cstdio>
#include <cstdint>
#ifndef XPF_LEAD
#define XPF_LEAD 2
#endif
namespace pg8 {
#define PG8_LAS __attribute__((address_space(3)))
typedef unsigned short bf16_t;
typedef short bf16x8 __attribute__((ext_vector_type(8)));
typedef float f32x4 __attribute__((ext_vector_type(4)));
typedef unsigned u32x4 __attribute__((ext_vector_type(4)));
constexpr int BM = 256, BK = 64, HALF = 128, HTB = HALF * BK * 2  , STAGE_BYTES = 8 * HTB, NXCD = 8, WGM = 8, RSTD_LDS_OFF = 147456 + 320 + 1024  , RSTD_RAW_OFF = RSTD_LDS_OFF + 1024  , BIAS_LDS_OFF = RSTD_RAW_OFF + 8192  ;

__host__ __device__ __forceinline__ int lds_byte(int r, int c) { const int st = (r >> 4) * 2 + (c >> 5), rr = r & 15, cc = c & 31, ob = rr * 64 + cc * 2; return st * 1024 + (ob ^ (((ob >> 9) & 1) << 5)); }
__host__ __device__ __forceinline__ void stage_rc(int b, int& R, int& C) { const int st = b / 1024, sb = b % 1024, swz = sb ^ (((sb >> 9) & 1) << 5); R = (st >> 1) * 16 + swz / 64; C = (st & 1) * 32 + (swz % 64) / 2; }
__host__ __device__ __forceinline__ int perm32(int rho) { const int n = rho >> 4, i = rho & 15; return 8 * (i >> 2) + 4 * n + (i & 3); }

struct Unit { int pm, pn; };
struct Gemm { const bf16_t* A; const bf16_t* Bt; int M, N, K; };

struct StaticOrder {
    int nM, nN, nwg, G, c;
    __host__ __device__ void init(int M, int N, int G_, int c_) { nM = M / BM; nN = N / BM; nwg = nM * nN; G = G_; c = c_; }
    __host__ __device__ bool next(int i, Unit& u) const {
        const long L = (long)i * G + c; if (L >= nwg) return false;
        int wgid = (int)L; { const int q = nwg / NXCD, r = nwg % NXCD, xcd = wgid % NXCD, off = wgid / NXCD; wgid = (xcd < r ? xcd * (q + 1) : r * (q + 1) + (xcd - r) * q) + off; }
        const int nig = WGM * nN, gid = wgid / nig, fm = gid * WGM, gsz = (nM - fm) < WGM ? (nM - fm) : WGM;
        u.pm = fm + ((wgid % nig) % gsz); u.pn = (wgid % nig) / gsz; return true;
    }
    __device__ __forceinline__ void a_ready(const Unit&) const {}
    __device__ __forceinline__ void done(const Unit&) const {}
};
typedef float f32x2 __attribute__((ext_vector_type(2)));
typedef __bf16 bf16x2_t __attribute__((ext_vector_type(2)));
__device__ __forceinline__ unsigned cvt_pk_bf16(float lo, float hi) { f32x2 v = {lo, hi}; bf16x2_t b = __builtin_convertvector(v, bf16x2_t); return __builtin_bit_cast(unsigned, b); }
__device__ __forceinline__ float sigm(float x) { return __builtin_amdgcn_rcpf(1.0f + __builtin_amdgcn_exp2f(-1.4426950408889634f * x)); }
__device__ __forceinline__ float row_rstd(const float* ssq, int row) {
    const f32x4 a = *(const f32x4*)(ssq + ((size_t)0 * 17408 + row) * 4), b = *(const f32x4*)(ssq + ((size_t)1 * 17408 + row) * 4),
                c = *(const f32x4*)(ssq + ((size_t)2 * 17408 + row) * 4), d = *(const f32x4*)(ssq + ((size_t)3 * 17408 + row) * 4);
    const float s = (((a[0] + a[1]) + (a[2] + a[3])) + ((b[0] + b[1]) + (b[2] + b[3]))) + (((c[0] + c[1]) + (c[2] + c[3])) + ((d[0] + d[1]) + (d[2] + d[3])));
    return __builtin_amdgcn_rsqf(s * (1.0f / 1024.0f) + 1e-6f);
}
__device__ __forceinline__ void rows_rstd(const float* ssq, int row0, int fq, float (&rs)[2][4]) {
#pragma unroll
    for (int ai = 0; ai < 2; ++ai)
#pragma unroll
        for (int m = 0; m < 4; ++m) { const f32x4 p = *(const f32x4*)(ssq + ((size_t)fq * 17408 + row0 + ai * HALF + m * 16) * 4); rs[ai][m] = (p[0] + p[1]) + (p[2] + p[3]); }
#pragma unroll
    for (int ai = 0; ai < 2; ++ai)
#pragma unroll
        for (int m = 0; m < 4; ++m) { float s = rs[ai][m]; s += __shfl_xor(s, 16); s += __shfl_xor(s, 32); rs[ai][m] = __builtin_amdgcn_rsqf(s * (1.0f / 1024.0f) + 1e-6f); }
}
__device__ __forceinline__ void rows_rstd_lds(const PG8_LAS float* rl, int r0, float (&rs)[2][4]) {
#pragma unroll
    for (int ai = 0; ai < 2; ++ai)
#pragma unroll
        for (int m = 0; m < 4; ++m) rs[ai][m] = rl[r0 + ai * HALF + m * 16];
}
struct EpiNull {
    static constexpr bool PERM = true, AFTER_DRAIN = false, RSTD_LDS = false, XPREFETCH = false;
    __device__ __forceinline__ void operator()(const f32x4 (&acc)[2][2][4][2], const Unit& u, int wr, int wc, int fr, int fq) const {
#pragma unroll
        for (int ai = 0; ai < 2; ++ai)
#pragma unroll
            for (int bj = 0; bj < 2; ++bj)
#pragma unroll
                for (int m = 0; m < 4; ++m) { asm volatile("" :: "v"(acc[ai][bj][m][0]), "v"(acc[ai][bj][m][1])); }
    }
};
__device__ __forceinline__ unsigned pack_u8x4(float a, float b, float c, float d) {
    unsigned w = 0u; w = __builtin_amdgcn_cvt_pk_u8_f32(a, 0u, w); w = __builtin_amdgcn_cvt_pk_u8_f32(b, 1u, w); w = __builtin_amdgcn_cvt_pk_u8_f32(c, 2u, w); w = __builtin_amdgcn_cvt_pk_u8_f32(d, 3u, w); return w; }
__device__ __forceinline__ float sig255(float t) { return __builtin_amdgcn_rcpf(__builtin_fmaf(__builtin_amdgcn_exp2f(t), 1.0f / 255.0f, 1.0f / 255.0f)); }
struct EpiProj {
    static constexpr bool PERM = true, AFTER_DRAIN = false, RSTD_LDS = true, XPREFETCH = false;
    bf16_t* PM; unsigned char* GT; const float* ssq; const float* bgate; const PG8_LAS float* rl;
    __device__ __forceinline__ void operator()(const f32x4 (&acc)[2][2][4][2], const Unit& u, int wr, int wc, int fr, int fq) const {
        const int row0 = u.pm * BM + wr * 64 + fr;
        float rsv[2][4]; rows_rstd_lds(rl, wr * 64 + fr, rsv);
        if (u.pn >= 7) {
            constexpr float NL2E = -1.4426950408889634f;
            const int lc0 = (u.pn - 7) * BM + wc * 32 + 8 * fq;
            f32x4 bv[2][2];
#pragma unroll
            for (int bj = 0; bj < 2; ++bj)
#pragma unroll
                for (int n = 0; n < 2; ++n) bv[bj][n] = *(const f32x4*)(bgate + lc0 + bj * HALF + 4 * n) * NL2E;
#pragma unroll
            for (int ai = 0; ai < 2; ++ai)
#pragma unroll
                for (int m = 0; m < 4; ++m) { const int row = row0 + ai * HALF + m * 16;
                    const float rs = rsv[ai][m] * NL2E;
                    unsigned char* rowp = GT + (size_t)row * 4096 + lc0;
#pragma unroll
                    for (int bj = 0; bj < 2; ++bj) { const f32x4 v0 = acc[ai][bj][m][0] * rs + bv[bj][0], v1 = acc[ai][bj][m][1] * rs + bv[bj][1];
                        typedef unsigned u32x2_t __attribute__((ext_vector_type(2)));
                        u32x2_t w; w.x = pack_u8x4(sig255(v0[0]), sig255(v0[1]), sig255(v0[2]), sig255(v0[3])); w.y = pack_u8x4(sig255(v1[0]), sig255(v1[1]), sig255(v1[2]), sig255(v1[3]));
                        *(u32x2_t*)(rowp + bj * HALF) = w; } }
        } else {
            const int lc0 = u.pn * BM + wc * 32 + 8 * fq;
#pragma unroll
            for (int ai = 0; ai < 2; ++ai)
#pragma unroll
                for (int m = 0; m < 4; ++m) { const int row = row0 + ai * HALF + m * 16;
                    const float rs = rsv[ai][m];
                    bf16_t* rowp = PM + (size_t)row * 1792 + lc0;
#pragma unroll
                    for (int bj = 0; bj < 2; ++bj) { const f32x4 v0 = acc[ai][bj][m][0] * rs, v1 = acc[ai][bj][m][1] * rs;
                        u32x4 w; w.x = cvt_pk_bf16(v0[0], v0[1]); w.y = cvt_pk_bf16(v0[2], v0[3]); w.z = cvt_pk_bf16(v1[0], v1[1]); w.w = cvt_pk_bf16(v1[2], v1[3]);
                        *(u32x4*)(rowp + bj * HALF) = w; } }
        }
    }
};
struct EpiResid {
    static constexpr bool PERM = true, AFTER_DRAIN = false, RSTD_LDS = false, XPREFETCH = true;
    const float* xp; const float* xs; bool first; bf16_t* XB; float* ssq;
    __device__ __forceinline__ void prefetch(const Unit& u, PG8_LAS unsigned char* dump, int tid) const {
        if (first) return;
        const unsigned vo = (unsigned)(tid >> 2) * 2048u + (unsigned)(tid & 3) * 128u;
        const char* base = (const char*)(XB + (size_t)u.pm * BM * 1024 + u.pn * BM);
        __builtin_amdgcn_global_load_lds((const unsigned*)(base + vo), (PG8_LAS unsigned*)dump, 4, 0, 0);
        __builtin_amdgcn_global_load_lds((const unsigned*)(base + (size_t)128 * 2048 + vo), (PG8_LAS unsigned*)dump, 4, 0, 0);
    }
    __device__ __forceinline__ void operator()(const f32x4 (&acc)[2][2][4][2], const Unit& u, int wr, int wc, int fr, int fq) const {
        const int row0 = u.pm * BM + wr * 64 + fr, col0 = u.pn * BM + wc * 32 + 8 * fq;
#pragma unroll
        for (int ai = 0; ai < 2; ++ai)
#pragma unroll
            for (int m = 0; m < 4; ++m) { const int row = row0 + ai * HALF + m * 16;
                bf16_t* dstb = XB + (size_t)row * 1024 + col0; float ss = 0.f;
                f32x4 x0[2], x1[2];
                if (first) { const float* src = (row < 16384 ? xp + (size_t)row * 1024 : xs + (size_t)(row - 16384) * 1024) + col0;
#pragma unroll
                    for (int bj = 0; bj < 2; ++bj) { x0[bj] = *(const f32x4*)(src + bj * HALF); x1[bj] = *(const f32x4*)(src + bj * HALF + 4); } }
                else {
#pragma unroll
                    for (int bj = 0; bj < 2; ++bj) { const u32x4 q = *(const u32x4*)(dstb + bj * HALF);
                        x0[bj] = (f32x4){__builtin_bit_cast(float, q.x << 16), __builtin_bit_cast(float, q.x & 0xffff0000u), __builtin_bit_cast(float, q.y << 16), __builtin_bit_cast(float, q.y & 0xffff0000u)};
                        x1[bj] = (f32x4){__builtin_bit_cast(float, q.z << 16), __builtin_bit_cast(float, q.z & 0xffff0000u), __builtin_bit_cast(float, q.w << 16), __builtin_bit_cast(float, q.w & 0xffff0000u)}; } }
#pragma unroll
                for (int bj = 0; bj < 2; ++bj) { const f32x4 o0 = x0[bj] + acc[ai][bj][m][0], o1 = x1[bj] + acc[ai][bj][m][1];
                    u32x4 w; w.x = cvt_pk_bf16(o0[0], o0[1]); w.y = cvt_pk_bf16(o0[2], o0[3]); w.z = cvt_pk_bf16(o1[0], o1[1]); w.w = cvt_pk_bf16(o1[2], o1[3]);
                    *(u32x4*)(dstb + bj * HALF) = w;
                    ss += ((o0[0] * o0[0] + o0[1] * o0[1]) + (o0[2] * o0[2] + o0[3] * o0[3])) + ((o1[0] * o1[0] + o1[1] * o1[1]) + (o1[2] * o1[2] + o1[3] * o1[3])); }
                ss += __shfl_xor(ss, 16); ss += __shfl_xor(ss, 32);
                if (fq == 0) ssq[((size_t)u.pn * 17408 + row) * 4 + wc] = ss; }
    }
};
struct EpiSwiGLU {
    static constexpr bool PERM = true, AFTER_DRAIN = false, RSTD_LDS = true, XPREFETCH = false;
    bf16_t* ACT; const float* ssq; const PG8_LAS float* rl;
    __device__ __forceinline__ void operator()(const f32x4 (&acc)[2][2][4][2], const Unit& u, int wr, int wc, int fr, int fq) const {
        const int row0 = u.pm * BM + wr * 64 + fr, col0 = u.pn * HALF + wc * 32 + 8 * fq;
        float rsv[2][4]; rows_rstd_lds(rl, wr * 64 + fr, rsv);
#pragma unroll
        for (int ai = 0; ai < 2; ++ai)
#pragma unroll
            for (int m = 0; m < 4; ++m) { const int row = row0 + ai * HALF + m * 16;
                const float rs = rsv[ai][m], rsn = rs * -1.4426950408889634f, rs2 = rs * rs;
                float o[8];
#pragma unroll
                for (int j = 0; j < 4; ++j) { const float a0 = acc[ai][0][m][0][j], a1 = acc[ai][0][m][1][j];
                    o[j] = (a0 * acc[ai][1][m][0][j]) * (__builtin_amdgcn_rcpf(1.0f + __builtin_amdgcn_exp2f(a0 * rsn)) * rs2); o[4 + j] = (a1 * acc[ai][1][m][1][j]) * (__builtin_amdgcn_rcpf(1.0f + __builtin_amdgcn_exp2f(a1 * rsn)) * rs2); }
                u32x4 w; w.x = cvt_pk_bf16(o[0], o[1]); w.y = cvt_pk_bf16(o[2], o[3]); w.z = cvt_pk_bf16(o[4], o[5]); w.w = cvt_pk_bf16(o[6], o[7]);
                *(u32x4*)(ACT + (size_t)row * 2816 + col0) = w; }
    }
};

template <class Epi, class Sched, bool ALIGN_EPI = false, bool SP2 = false>
__device__ __forceinline__ void gemm_phase(PG8_LAS unsigned char* lds, const Gemm g, const Sched& S, const Epi& E, int tidp) {
    int tid_ = tidp; asm volatile("" : "+v"(tid_));
    const int tid = tid_, wid = __builtin_amdgcn_readfirstlane(tid >> 6), lane = tid & 63, wr = wid >> 2, wc = wid & 3, fr = lane & 15, fq = lane >> 4;
    const int K = g.K, nt = K / BK;
    unsigned voffA[2], voffB[2];
#pragma unroll
    for (int i = 0; i < 2; ++i) { int R, C; stage_rc(tid * 16 + i * 8192, R, C); const int Rb = Epi::PERM ? ((R & ~31) + perm32(R & 31)) : R;
        voffA[i] = (unsigned)(R * K + C) * 2u; voffB[i] = (unsigned)(Rb * K + C) * 2u; }
    const size_t kstep = (size_t)(BK * 2);
    const size_t hstep = (size_t)HALF * K * 2;
    const size_t tstep = 2 * hstep;
    const unsigned ldsw = (unsigned)wid * 1024u;
    const int aoff = lds_byte(wr * 64 + fr, fq * 8), boff = lds_byte(wc * 32 + fr, fq * 8);
#define PG8_SA(b, h) (((b) * 2 + (h)) * HTB)
#define PG8_SB(b, h) ((4 + (b) * 2 + (h)) * HTB)
#define PG8_STAGE(bufoff, gbase, voff) do { _Pragma("unroll") for (int _i = 0; _i < 2; ++_i) \
        __builtin_amdgcn_global_load_lds((const unsigned*)((const char*)(gbase) + (voff)[_i]), (PG8_LAS unsigned*)(lds + (bufoff) + ldsw + _i * 8192), 16, 0, 0); } while (0)
#define PG8_LDA(dst, b, h) do { _Pragma("unroll") for (int m = 0; m < 4; ++m) _Pragma("unroll") for (int k = 0; k < 2; ++k) dst[m][k] = *(const PG8_LAS bf16x8*)(lds + PG8_SA(b, h) + aoff + m * 2048 + k * 1024); } while (0)
#define PG8_LDB(dst, b, h) do { _Pragma("unroll") for (int n = 0; n < 2; ++n) _Pragma("unroll") for (int k = 0; k < 2; ++k) dst[n][k] = *(const PG8_LAS bf16x8*)(lds + PG8_SB(b, h) + boff + n * 2048 + k * 1024); } while (0)
#define PG8_MMA(ai, bj, At, Bt) do { __builtin_amdgcn_s_setprio(1); _Pragma("unroll") for (int m = 0; m < 4; ++m) _Pragma("unroll") for (int n = 0; n < 2; ++n) _Pragma("unroll") for (int k = 0; k < 2; ++k) \
        acc[ai][bj][m][n] = __builtin_amdgcn_mfma_f32_16x16x32_bf16(Bt[n][k], At[m][k], acc[ai][bj][m][n], 0, 0, 0); __builtin_amdgcn_s_setprio(0); } while (0)
#define PG8_WAIT_V(n) asm volatile("s_waitcnt vmcnt(" #n ")" ::: "memory")
#define PG8_WAIT_L(n) asm volatile("s_waitcnt lgkmcnt(" #n ")" ::: "memory")
#define PG8_BAR __builtin_amdgcn_s_barrier()
#define PG8_SCHED __builtin_amdgcn_sched_barrier(0)
    Unit cur, nxt; int ui = 0;
    if (!S.next(0, cur)) return;
    f32x4 acc[2][2][4][2];
#pragma unroll
    for (int a = 0; a < 2; ++a)
#pragma unroll
        for (int b = 0; b < 2; ++b)
#pragma unroll
            for (int m = 0; m < 4; ++m)
#pragma unroll
                for (int n = 0; n < 2; ++n) acc[a][b][m][n] = (f32x4){0.f, 0.f, 0.f, 0.f};
    bf16x8 At[4][2], B0[2][2], B1[2][2];
    const char* cA = (const char*)g.A + (size_t)cur.pm * tstep; const char* cB = (const char*)g.Bt + (size_t)cur.pn * tstep;
    S.a_ready(cur);
    if constexpr (SP2) {
        PG8_STAGE(PG8_SB(0, 0), cB, voffB); PG8_STAGE(PG8_SB(0, 1), cB + hstep, voffB); PG8_STAGE(PG8_SA(0, 0), cA, voffA); PG8_STAGE(PG8_SA(0, 1), cA + hstep, voffA);
        if (wr == 1) PG8_BAR;
        PG8_WAIT_V(2); PG8_BAR;
        PG8_STAGE(PG8_SB(1, 0), cB + kstep, voffB); PG8_STAGE(PG8_SA(1, 0), cA + kstep, voffA); PG8_STAGE(PG8_SB(1, 1), cB + hstep + kstep, voffB);
        PG8_WAIT_V(6); PG8_BAR;
    } else {
        PG8_STAGE(PG8_SB(0, 0), cB, voffB); PG8_STAGE(PG8_SA(0, 0), cA, voffA); PG8_STAGE(PG8_SB(0, 1), cB + hstep, voffB); PG8_STAGE(PG8_SA(0, 1), cA + hstep, voffA);
        if (wr == 1) PG8_BAR;
        PG8_WAIT_V(4); PG8_BAR;
        PG8_STAGE(PG8_SB(1, 0), cB + kstep, voffB); PG8_STAGE(PG8_SA(1, 0), cA + kstep, voffA); PG8_STAGE(PG8_SB(1, 1), cB + hstep + kstep, voffB);
        PG8_WAIT_V(6); PG8_BAR;
    }
    for (;;) {
        const bool has_next = S.next(ui + 1, nxt);
        const char* nA = has_next ? (const char*)g.A + (size_t)nxt.pm * tstep : cA; const char* nB = has_next ? (const char*)g.Bt + (size_t)nxt.pn * tstep : cB;
#ifdef DBG_KLOOP_T
        if (ui == DBG_KLOOP_UNIT + 1 && blockIdx.x == DBG_T_BLK && tid == 0) { ((volatile PG8_LAS unsigned long long*)(lds + 147456 + 320 + 256))[8] = __builtin_amdgcn_s_memtime(); }
        if (ui == DBG_KLOOP_UNIT && blockIdx.x == DBG_T_BLK && tid == 0) { ((volatile PG8_LAS unsigned long long*)(lds + 147456 + 320 + 256))[4] = __builtin_amdgcn_s_memtime(); ((volatile PG8_LAS unsigned long long*)(lds + 147456 + 320 + 256))[5] = __builtin_amdgcn_s_memrealtime(); }
#endif
        for (int t = 0; t < nt; t += 2) {
            const bool last = (t == nt - 2);
            if constexpr (Epi::RSTD_LDS) {
                if (t == 2 || t == 4) { PG8_WAIT_V(8);
                    const f32x4 v = *(const PG8_LAS f32x4*)(lds + RSTD_RAW_OFF + ldsw + lane * 16);
                    float s = (v[0] + v[1]) + (v[2] + v[3]); s += __shfl_xor(s, 1); s += __shfl_xor(s, 2);
                    if (!(tid & 3)) *(PG8_LAS float*)(lds + RSTD_LDS_OFF + ((t - 2) * 64 + (tid >> 2)) * 4) = __builtin_amdgcn_rsqf(s * (1.0f / 1024.0f) + 1e-6f);
                    PG8_WAIT_L(0); }
                if (t == 0 || t == 2) __builtin_amdgcn_global_load_lds((const unsigned*)(E.ssq + ((size_t)(tid & 3) * 17408 + (size_t)cur.pm * BM + t * 64 + (tid >> 2)) * 4), (PG8_LAS unsigned*)(lds + RSTD_RAW_OFF + ldsw), 16, 0, 0);
            }
            if constexpr (Epi::XPREFETCH) { if (t == nt - XPF_LEAD) E.prefetch(cur, lds + RSTD_RAW_OFF + ldsw, tid); }
            const char* a1 = cA + (size_t)(t + 1) * kstep;
            const char* a2 = last ? nA : cA + (size_t)(t + 2) * kstep; const char* b2 = last ? nB : cB + (size_t)(t + 2) * kstep;
            const char* a3 = a2 + kstep; const char* b3 = b2 + kstep;
            if (last && has_next) S.a_ready(nxt);
            if constexpr (SP2) {
            PG8_LDB(B0, 0, 0); PG8_LDB(B1, 0, 1); PG8_SCHED; PG8_LDA(At, 0, 0); PG8_STAGE(PG8_SA(1, 1), a1 + hstep, voffA);
            PG8_WAIT_V(8); PG8_WAIT_L(0); PG8_BAR; PG8_MMA(0, 0, At, B0); PG8_MMA(0, 1, At, B1); PG8_BAR; PG8_SCHED;
            PG8_LDA(At, 0, 1); PG8_STAGE(PG8_SB(0, 0), b2, voffB); PG8_STAGE(PG8_SB(0, 1), b2 + hstep, voffB); PG8_STAGE(PG8_SA(0, 0), a2, voffA);
            PG8_WAIT_V(8); PG8_WAIT_L(0); PG8_BAR; PG8_MMA(1, 0, At, B0); PG8_MMA(1, 1, At, B1); PG8_BAR; PG8_SCHED;
            PG8_LDB(B0, 1, 0); PG8_LDB(B1, 1, 1); PG8_SCHED; PG8_LDA(At, 1, 0); PG8_STAGE(PG8_SA(0, 1), a2 + hstep, voffA);
            PG8_WAIT_V(8); PG8_WAIT_L(0); PG8_BAR; PG8_MMA(0, 0, At, B0); PG8_MMA(0, 1, At, B1); PG8_BAR; PG8_SCHED;
            PG8_LDA(At, 1, 1); PG8_STAGE(PG8_SB(1, 0), b3, voffB); PG8_STAGE(PG8_SB(1, 1), b3 + hstep, voffB); PG8_STAGE(PG8_SA(1, 0), a3, voffA);
            PG8_WAIT_V(8); PG8_WAIT_L(0); PG8_BAR; PG8_MMA(1, 0, At, B0); PG8_MMA(1, 1, At, B1); PG8_BAR; PG8_SCHED;
            } else {
            PG8_LDB(B0, 0, 0); PG8_SCHED; PG8_LDA(At, 0, 0); PG8_STAGE(PG8_SA(1, 1), a1 + hstep, voffA);
            PG8_WAIT_L(8); PG8_BAR; PG8_WAIT_L(0); PG8_MMA(0, 0, At, B0); PG8_BAR; PG8_SCHED;
            PG8_LDB(B1, 0, 1); PG8_STAGE(PG8_SB(0, 0), b2, voffB);
            PG8_BAR; PG8_WAIT_L(0); PG8_MMA(0, 1, At, B1); PG8_BAR;
            PG8_LDA(At, 0, 1); PG8_STAGE(PG8_SA(0, 0), a2, voffA);
            PG8_BAR; PG8_WAIT_L(0); PG8_MMA(1, 0, At, B0); PG8_BAR; PG8_SCHED;
            PG8_STAGE(PG8_SB(0, 1), b2 + hstep, voffB);
            PG8_WAIT_V(6); PG8_BAR; PG8_MMA(1, 1, At, B1); PG8_BAR;
            PG8_LDB(B0, 1, 0); PG8_SCHED; PG8_LDA(At, 1, 0); PG8_STAGE(PG8_SA(0, 1), a2 + hstep, voffA);
            PG8_WAIT_L(8); PG8_BAR; PG8_WAIT_L(0); PG8_MMA(0, 0, At, B0); PG8_BAR; PG8_SCHED;
            PG8_LDB(B1, 1, 1); PG8_STAGE(PG8_SB(1, 0), b3, voffB);
            PG8_BAR; PG8_WAIT_L(0); PG8_MMA(0, 1, At, B1); PG8_BAR;
            PG8_LDA(At, 1, 1); PG8_STAGE(PG8_SA(1, 0), a3, voffA);
            PG8_BAR; PG8_WAIT_L(0); PG8_MMA(1, 0, At, B0); PG8_BAR; PG8_SCHED;
            PG8_STAGE(PG8_SB(1, 1), b3 + hstep, voffB);
            PG8_WAIT_V(6); PG8_BAR; PG8_MMA(1, 1, At, B1); PG8_BAR;
            }
        }
#ifdef DBG_KLOOP_T
        if (ui == DBG_KLOOP_UNIT && blockIdx.x == DBG_T_BLK && tid == 0) { ((volatile PG8_LAS unsigned long long*)(lds + 147456 + 320 + 256))[6] = __builtin_amdgcn_s_memtime(); ((volatile PG8_LAS unsigned long long*)(lds + 147456 + 320 + 256))[7] = __builtin_amdgcn_s_memrealtime(); }
#endif
        if constexpr (ALIGN_EPI) { if (wr == 0) PG8_BAR; }
        if constexpr (!Epi::AFTER_DRAIN) { E(acc, cur, wr, wc, fr, fq); S.done(cur); }
        if (!has_next) break;
#pragma unroll
        for (int a = 0; a < 2; ++a)
#pragma unroll
            for (int b = 0; b < 2; ++b)
#pragma unroll
                for (int m = 0; m < 4; ++m)
#pragma unroll
                    for (int n = 0; n < 2; ++n) acc[a][b][m][n] = (f32x4){0.f, 0.f, 0.f, 0.f};
        cur = nxt; cA = nA; cB = nB; ++ui;
        if constexpr (ALIGN_EPI) { if (wr == 1) PG8_BAR; }
    }
    PG8_WAIT_V(0);
    if constexpr (!ALIGN_EPI) { if (wr == 0) PG8_BAR; }
    PG8_BAR;
    if constexpr (Epi::AFTER_DRAIN) { E.fused(acc, cur, wr, wc, fr, fq, lds, wid, lane); S.done(cur); }
#undef PG8_SA
#undef PG8_SB
#undef PG8_STAGE
#undef PG8_LDA
#undef PG8_LDB
#undef PG8_MMA
#undef PG8_WAIT_V
#undef PG8_WAIT_L
#undef PG8_BAR
#undef PG8_SCHED
}
}
constexpr int D = 1024, MP = 16384, MS = 1024, M = MP + MS, NLAYER = 4, MIXW = 256, INC = 5888, PMC = 1792, GTC = 4096, FF = 2816;
constexpr int SEQ = 2048, NB = 8, DB = 128, DSEQ = 8, NCH = SEQ / 64;
constexpr int NPHASE = 2 + 7 * NLAYER;
#ifndef MK_PER_PHASE
#define MK_PER_PHASE 0
#endif
constexpr size_t O_Y = 0, O_POOLP = 17825792, O_POOLS = 17948672, O_SREP = 19914752, O_SRES = 19947520, O_SIMP = 20471808, O_SIMS = 20504576,
                 O_SCP = 21028864, O_SCS = 21045248, O_CFP = 21307392, O_CFS = 21553152, O_END = 25485312;
constexpr size_t MiB = 1u << 20;
constexpr size_t WS_CTL = 0, CTL_ZERO_BYTES = 64 * 1024;
constexpr size_t WS_SSQ = 1 * MiB;
constexpr size_t WS_E = 3 * MiB;
constexpr size_t WS_TAB = 5 * MiB;
constexpr size_t TAB_LB = 0, TAB_LP = 8192, TAB_BBT = 16384, TAB_CM = TAB_BBT + 65536, TAB_PW = TAB_CM + 65536, TAB_STRIDE = TAB_PW + 32768;
constexpr size_t WS_WIN = 6 * MiB;
constexpr size_t WS_WFI = WS_WIN + (size_t)NLAYER * INC * D * 2;
constexpr size_t WS_WOUT = WS_WFI + (size_t)NLAYER * 2 * FF * D * 2;
constexpr size_t WS_WFO = WS_WOUT + (size_t)NLAYER * D * D * 2;
constexpr size_t WS_WBR = WS_WFO + (size_t)NLAYER * D * FF * 2;
constexpr size_t WS_WGLU = WS_WBR + (size_t)NLAYER * 4 * D * MIXW * 2;
constexpr size_t WS_ACT1 = WS_WGLU + (size_t)NLAYER * MIXW * MIXW * 2;
constexpr size_t WS_PM = WS_ACT1 + (size_t)M * D * 2;
constexpr size_t WS_GT = WS_PM + (size_t)M * PMC * 2;
constexpr size_t WS_END = WS_GT + (size_t)M * GTC * 2;
static_assert(WS_TAB + NLAYER * TAB_STRIDE <= WS_WIN && WS_E + (size_t)NB * NCH * 1024 * 8 <= WS_TAB && WS_SSQ + (size_t)M * 64 <= WS_E, "d_ws map");
constexpr int CW_BAR = 1024;
constexpr int RING_OFF = 0, RING_BYTES = 147456;
constexpr int LDSCTL_OFF = RING_BYTES, MISC_OFF = LDSCTL_OFF + 320;
constexpr int LDS_BYTES = 163840;
constexpr int NWAVES = 8;

#define GAS __attribute__((address_space(1)))
#define LAS __attribute__((address_space(3)))
typedef unsigned short bf16;
typedef unsigned short bf16_t;
typedef unsigned v4u __attribute__((ext_vector_type(4)));
typedef unsigned v2u __attribute__((ext_vector_type(2)));
typedef float f32x4 __attribute__((ext_vector_type(4)));
typedef float f32x2 __attribute__((ext_vector_type(2)));
typedef short bf16x8 __attribute__((ext_vector_type(8)));
#define LDS_WAIT() asm volatile("s_waitcnt lgkmcnt(0)" ::: "memory")
#define VM_WAIT() asm volatile("s_waitcnt vmcnt(0)" ::: "memory")
__device__ __forceinline__ unsigned pk2(float lo, float hi) { return pg8::cvt_pk_bf16(lo, hi); }
__device__ __forceinline__ float bflo(unsigned u) { return __builtin_bit_cast(float, u << 16); }
__device__ __forceinline__ float bfhi(unsigned u) { return __builtin_bit_cast(float, u & 0xffff0000u); }
__device__ __forceinline__ float bf1(bf16_t b) { return __builtin_bit_cast(float, (unsigned)b << 16); }
__device__ __forceinline__ void unpack8(const v4u v, float (&f)[8]) { f[0] = bflo(v.x); f[1] = bfhi(v.x); f[2] = bflo(v.y); f[3] = bfhi(v.y); f[4] = bflo(v.z); f[5] = bfhi(v.z); f[6] = bflo(v.w); f[7] = bfhi(v.w); }
__device__ __forceinline__ v4u pack8(const float (&f)[8]) { v4u w; w.x = pk2(f[0], f[1]); w.y = pk2(f[2], f[3]); w.z = pk2(f[4], f[5]); w.w = pk2(f[6], f[7]); return w; }
__device__ __forceinline__ float sigm(float x) { return pg8::sigm(x); }
__device__ __forceinline__ float gelu_tanh(float y) { const float in2 = 1.5957691216057308f * (y + 0.044715f * y * y * y); const float e = __builtin_amdgcn_exp2f(1.4426950408889634f * in2); return 0.5f * y * (2.0f - 2.0f * __builtin_amdgcn_rcpf(e + 1.0f)); }
__device__ __forceinline__ float wave_sum(float v) {
#pragma unroll
    for (int o = 1; o < 64; o <<= 1) v += __shfl_xor(v, o);
    return v;
}

#define XB_TMO      128
#define XB_XCNT(j)  (256  + 64 * (j))
#define XB_XSUB(j)  (1280 + 64 * (j))
#define XB_XGEN(j)  (2304 + 64 * (j))
#define XB_TOP      3328
#define XB_TOPGEN   3392
#define XCD_BAR_WORDS 3456
#define XB_SPIN_CAP (1u << 18)

__device__ __forceinline__ unsigned xb_ld(unsigned* p)              { return __hip_atomic_load(p, __ATOMIC_RELAXED, __HIP_MEMORY_SCOPE_AGENT); }
__device__ __forceinline__ unsigned xb_add(unsigned* p, unsigned v) { return __hip_atomic_fetch_add(p, v, __ATOMIC_RELAXED, __HIP_MEMORY_SCOPE_AGENT); }
__device__ __forceinline__ unsigned xb_xcc_id() { return (unsigned)__builtin_amdgcn_s_getreg((3 << 11) | 20) & 0xFu; }
#define XB_SPIN(cond, bar) do { unsigned _sp = 0; while (cond) { __builtin_amdgcn_s_sleep(1); \
    if ((++_sp & 255u) == 0u) { if (xb_ld(&(bar)[XB_TMO])) break; if (_sp > XB_SPIN_CAP) { atomicAdd(&(bar)[XB_TMO], 1u); break; } } } } while (0)

struct XcdBarrier {
    unsigned* bar; unsigned x;
    volatile LAS unsigned* st;
};

__device__ __forceinline__ XcdBarrier xcd_barrier_post(unsigned* bar, volatile LAS unsigned* st) {
    XcdBarrier b; b.bar = bar; b.x = xb_xcc_id(); b.st = st;
    if (threadIdx.x == 0) (void)xb_add(&bar[XB_XCNT(b.x)], 1u);
    return b;
}
__device__ __forceinline__ void xcd_barrier_complete(unsigned* bar, unsigned x, unsigned& nloc, unsigned& nx) {
    const unsigned G = gridDim.x * gridDim.y * gridDim.z;
    unsigned sum, cnt, mine, sp = 0u;
    for (;;) {
        sum = 0u; cnt = 0u; mine = 0u;
#pragma unroll
        for (unsigned j = 0; j < 16; ++j) { const unsigned c = xb_ld(&bar[XB_XCNT(j)]); sum += c; cnt += (c > 0u) ? 1u : 0u; mine = (j == x) ? c : mine; }
        if (sum == G) break;
        __builtin_amdgcn_s_sleep(1);
        if ((++sp & 255u) == 0u) { if (xb_ld(&bar[XB_TMO])) break; if (sp > XB_SPIN_CAP) { atomicAdd(&bar[XB_TMO], 1u); break; } }
    }
    nloc = mine > 0u ? mine : 1u; nx = cnt > 0u ? cnt : 1u;
}

__device__ __forceinline__ void xcd_barrier_leader(const XcdBarrier& b) {
    {
        unsigned* bar = b.bar;
        __builtin_amdgcn_s_waitcnt(0);
        unsigned nloc = b.st[0], nx = b.st[1];
        if (nloc == 0u) { xcd_barrier_complete(bar, b.x, nloc, nx); b.st[0] = nloc; b.st[1] = nx; }
        const unsigned old = xb_add(&bar[XB_XSUB(b.x)], 1u);
        const unsigned gen = old / nloc;
        if (old + 1u == (gen + 1u) * nloc) {
            __builtin_amdgcn_fence(__ATOMIC_RELEASE, "agent");
            asm volatile("s_waitcnt vmcnt(0)" ::: "memory");
            const unsigned og = xb_add(&bar[XB_TOP], 1u);
            const unsigned tg = og / nx;
            if (og + 1u == (tg + 1u) * nx) xb_add(&bar[XB_TOPGEN], 1u);
            else XB_SPIN(xb_ld(&bar[XB_TOPGEN]) == tg, bar);
            __builtin_amdgcn_fence(__ATOMIC_ACQUIRE, "agent");
            xb_add(&bar[XB_XGEN(b.x)], 1u);
            asm volatile("s_waitcnt vmcnt(0)" ::: "memory");
        } else {
            XB_SPIN(xb_ld(&bar[XB_XGEN(b.x)]) == gen, bar);
            __builtin_amdgcn_fence(__ATOMIC_ACQUIRE, "agent");
            asm volatile("s_waitcnt vmcnt(0)" ::: "memory");
        }
    }
}
__device__ __forceinline__ void xcd_barrier(const XcdBarrier& b, bool leader) {
    asm volatile("s_waitcnt vmcnt(0)" ::: "memory");
    __syncthreads();
    if (leader) xcd_barrier_leader(b);
    __syncthreads();
}
struct Args { const float* in[32]; float* out; unsigned char* ws; int ph_lo, ph_hi; };
enum { I_XP = 0, I_XS, I_STPOOL, I_STRE, I_STIM, I_STSC, I_STCF, I_N1G, I_N2G, I_FING, I_WIN, I_BGATE, I_POOLW, I_POOLSC, I_LAMRE, I_LAMIM, I_LOGDT,
       I_BRE, I_BIM, I_CRE, I_CIM, I_DSKIP, I_WGLU, I_BGLU, I_SCW, I_CFW, I_CFLNG, I_CFLNB, I_WBR, I_WOUT, I_WFI, I_WFO };

__device__ __forceinline__ void p0_item(const float* W, int ldw, int src_col0, const float* kscale, int k0, bf16* WTrow0, int K, LAS float* scr, int lane) {
    float wv[32];
#pragma unroll
    for (int i = 0; i < 32; ++i) { const int kk = 2 * i + (lane >> 5); wv[i] = W[(size_t)(k0 + kk) * ldw + src_col0 + (lane & 31)]; }
#pragma unroll
    for (int i = 0; i < 32; ++i) { const int kk = 2 * i + (lane >> 5); scr[kk * 33 + (lane & 31)] = wv[i]; }
    LDS_WAIT(); asm volatile("" ::: "memory");
    const int c = lane & 7;
    f32x4 ks0 = (f32x4){1.f, 1.f, 1.f, 1.f}, ks1 = ks0;
    if (kscale) { ks0 = *(const f32x4*)(kscale + k0 + 8 * c); ks1 = *(const f32x4*)(kscale + k0 + 8 * c + 4); }
#pragma unroll
    for (int j = 0; j < 4; ++j) { const int n = (lane >> 3) + 8 * j; const LAS float* s = scr + (8 * c) * 33 + n;
        v4u o; o.x = pk2(s[0 * 33] * ks0[0], s[1 * 33] * ks0[1]); o.y = pk2(s[2 * 33] * ks0[2], s[3 * 33] * ks0[3]); o.z = pk2(s[4 * 33] * ks1[0], s[5 * 33] * ks1[1]); o.w = pk2(s[6 * 33] * ks1[2], s[7 * 33] * ks1[3]);
        *(GAS v4u*)(WTrow0 + (size_t)n * K + k0 + 8 * c) = o; }
    LDS_WAIT(); asm volatile("" ::: "memory");
}
constexpr int P0_IT_IN = 16 * (INC / 32), P0_IT_FI = 16 * (2 * FF / 32), P0_IT_OUT = 16 * 32, P0_IT_FO = (FF / 64) * 32, P0_IT_BR = 4 * 4 * 32, P0_IT_GLU = 4 * 8;
constexpr int P0_IT_LAYER = P0_IT_IN + P0_IT_FI + P0_IT_OUT + P0_IT_FO + P0_IT_BR + P0_IT_GLU;
__device__ __forceinline__ void p0_weight_item(const Args& a, int L, int r, LAS float* scr, int lane) {
    unsigned char* ws = a.ws;
    if (r < P0_IT_IN) { const int nblk = INC / 32, kb = r / nblk, nb = r % nblk;
        p0_item(a.in[I_WIN] + (size_t)L * D * INC, INC, 32 * nb, a.in[I_N1G] + L * D, 64 * kb, (bf16*)(ws + WS_WIN) + ((size_t)L * INC + 32 * nb) * D, D, scr, lane); return; } r -= P0_IT_IN;
    if (r < P0_IT_FI) { const int nblk = 2 * FF / 32, kb = r / nblk, nb = r % nblk; const int nd = 32 * nb, pn = nd >> 8, rr = nd & 255;
        const int src = rr < 128 ? 128 * pn + rr : FF + 128 * pn + (rr - 128);
        p0_item(a.in[I_WFI] + (size_t)L * D * 2 * FF, 2 * FF, src, a.in[I_N2G] + L * D, 64 * kb, (bf16*)(ws + WS_WFI) + ((size_t)L * 2 * FF + nd) * D, D, scr, lane); return; } r -= P0_IT_FI;
    if (r < P0_IT_OUT) { const int kb = r / 32, nb = r % 32;
        p0_item(a.in[I_WOUT] + (size_t)L * D * D, D, 32 * nb, nullptr, 64 * kb, (bf16*)(ws + WS_WOUT) + ((size_t)L * D + 32 * nb) * D, D, scr, lane); return; } r -= P0_IT_OUT;
    if (r < P0_IT_FO) { const int kb = r / 32, nb = r % 32;
        p0_item(a.in[I_WFO] + (size_t)L * FF * D, D, 32 * nb, nullptr, 64 * kb, (bf16*)(ws + WS_WFO) + ((size_t)L * D + 32 * nb) * FF, FF, scr, lane); return; } r -= P0_IT_FO;
    if (r < P0_IT_BR) { const int br = r / 128, q = r % 128, kb = q / 32, nb = q % 32;
        p0_item(a.in[I_WBR] + (size_t)(L * 4 + br) * MIXW * D, D, 32 * nb, nullptr, 64 * kb, (bf16*)(ws + WS_WBR) + ((size_t)(L * 4 + br) * D + 32 * nb) * MIXW, MIXW, scr, lane); return; } r -= P0_IT_BR;
    { const int kb = r / 8, nb = r % 8;
        p0_item(a.in[I_WGLU] + (size_t)L * MIXW * MIXW, MIXW, 32 * nb, nullptr, 64 * kb, (bf16*)(ws + WS_WGLU) + ((size_t)L * MIXW + 32 * nb) * MIXW, MIXW, scr, lane); }
}
constexpr int P0_SLICES = 6, P0_F_PER = 7, P0_A_PER = 2, P0_F_BID0 = 216, P0_A_BID0 = 192;
__device__ __forceinline__ int p0_items_A(int G) { return G == 256 ? (256 - P0_A_BID0) * NWAVES * P0_A_PER : 0; }
__device__ __forceinline__ int p0_items_F(int G) { return G == 256 ? (256 - P0_F_BID0) * NWAVES * P0_F_PER : 0; }
__device__ __forceinline__ void p0_idle_items(const Args& a, LAS unsigned char* lds, int lane, int wave, int bid, int L, int base, int bid0, int per) {
    LAS float* scr = (LAS float*)(lds + RING_OFF + wave * 16384);
    const int nw = (256 - bid0) * NWAVES, w = (bid - bid0) * NWAVES + wave;
    for (int q = 0; q < per; ++q) p0_weight_item(a, L, base + w + q * nw, scr, lane);
}
__device__ __forceinline__ void p0_slice(const Args& a, LAS unsigned char* lds, int lane, int wave, int G, int bid, int L, int slice) {
    LAS float* scr = (LAS float*)(lds + RING_OFF + wave * 16384);
    const int first = p0_items_A(G) + p0_items_F(G), per = (P0_IT_LAYER - first + P0_SLICES - 1) / P0_SLICES;
    const int lo = first + slice * per, hi = (lo + per < P0_IT_LAYER) ? lo + per : P0_IT_LAYER;
    for (int r = lo + bid * (NWAVES - 1) + (wave - 1); r < hi; r += G * (NWAVES - 1)) p0_weight_item(a, L, r, scr, lane);
}
__device__ __forceinline__ void p0_prologue(const Args& a, LAS unsigned char* lds, int tid, int lane, int wave, int G, int bid) {
    LAS float* scr = (LAS float*)(lds + RING_OFF + wave * 16384);
    const int gw = bid * NWAVES + wave, NGW = G * NWAVES;
    unsigned char* ws = a.ws;
    for (int it = gw; it < (MK_PER_PHASE ? NLAYER : 1) * P0_IT_LAYER; it += NGW) p0_weight_item(a, it / P0_IT_LAYER, it % P0_IT_LAYER, scr, lane);
    for (int m = gw; m < M; m += NGW) {
        const float* xrow = m < MP ? a.in[I_XP] + (size_t)m * D : a.in[I_XS] + (size_t)(m - MP) * D;
        const GAS f32x4* xr = (const GAS f32x4*)xrow + lane; f32x4 v[4]; float s = 0.f;
#pragma unroll
        for (int j = 0; j < 4; ++j) { v[j] = xr[64 * j]; s += (v[j][0] * v[j][0] + v[j][1] * v[j][1]) + (v[j][2] * v[j][2] + v[j][3] * v[j][3]); }
        s = wave_sum(s);
        GAS v2u* o8 = (GAS v2u*)((bf16*)(ws + WS_ACT1) + (size_t)m * D) + lane;
#pragma unroll
        for (int j = 0; j < 4; ++j) { v2u w; w.x = pk2(v[j][0], v[j][1]); w.y = pk2(v[j][2], v[j][3]); o8[64 * j] = w; }
        if (lane < 16) ((float*)(ws + WS_SSQ))[((size_t)(lane >> 2) * M + m) * 4 + (lane & 3)] = lane == 0 ? s : 0.f;
    }
    for (int idx = bid * 512 + tid; idx < NLAYER * 1024; idx += G * 512) {
        const int L = idx >> 10, gp = idx & 1023, g = gp >> 6, p = gp & 63;
        unsigned char* tab = ws + WS_TAB + (size_t)L * TAB_STRIDE;
        const float lre = a.in[I_LAMRE][idx], lim = a.in[I_LAMIM][idx], dt = expf(a.in[I_LOGDT][L * 16 + g]);
        const float ar = lre * dt, br_ = lim * dt, ea = expf(ar), cb = cosf(br_), sb = sinf(br_), sh = sinf(0.5f * br_);
        const float lbr = ea * cb, lbi = ea * sb;
        const float m1r = expm1f(ar) * cb - 2.0f * sh * sh, m1i = lbi;
        const float den = 1.0f / (lre * lre + lim * lim);
        const float qr = (m1r * lre + m1i * lim) * den, qi = (m1i * lre - m1r * lim) * den;
        ((f32x2*)(tab + TAB_LB))[gp] = (f32x2){lbr, lbi};
        float pr = lbr, pi = lbi;
#pragma unroll
        for (int s = 0; s < 6; ++s) { const float nr = pr * pr - pi * pi, ni = 2.0f * pr * pi; pr = nr; pi = ni; }
        ((f32x2*)(tab + TAB_LP))[gp] = (f32x2){pr, pi};
        bf16* bbt = (bf16*)(tab + TAB_BBT); bf16* cm = (bf16*)(tab + TAB_CM);
        const float* bre = a.in[I_BRE] + (size_t)idx * 16; const float* bim = a.in[I_BIM] + (size_t)idx * 16;
#pragma unroll
        for (int c = 0; c < 16; ++c) { const float Br = bre[c], Bi = bim[c];
            bbt[(g * 128 + p) * 16 + c] = (bf16)(pk2(qr * Br - qi * Bi, 0.f) & 0xffffu);
            bbt[(g * 128 + 64 + p) * 16 + c] = (bf16)(pk2(qr * Bi + qi * Br, 0.f) & 0xffffu);
            cm[(g * 16 + c) * 128 + p] = (bf16)(pk2(a.in[I_CRE][((size_t)(L * 16 + g) * 16 + c) * 64 + p], 0.f) & 0xffffu);
            cm[(g * 16 + c) * 128 + 64 + p] = (bf16)(pk2(-a.in[I_CIM][((size_t)(L * 16 + g) * 16 + c) * 64 + p], 0.f) & 0xffffu); }
    }
    for (int idx = bid * 512 + tid; idx < NLAYER * 4 * 64 * 64; idx += G * 512) {
        const int L = idx >> 14, r = idx & 16383, k = r >> 12, o = (r >> 6) & 63, c = r & 63;
        ((bf16*)(ws + WS_TAB + (size_t)L * TAB_STRIDE + TAB_PW))[r] = (bf16)(pk2(a.in[I_POOLW][((size_t)(L * 4 + k) * 64 + c) * 64 + o], 0.f) & 0xffffu);
    }
}
__device__ __forceinline__ void final_norm(const Args& a, int lane, int wave, int G, int bid) {
    const int gw = bid * NWAVES + wave, NGW = G * NWAVES;
    const float* ssq = (const float*)(a.ws + WS_SSQ);
    f32x4 gv[4];
#pragma unroll
    for (int j = 0; j < 4; ++j) gv[j] = ((const f32x4*)a.in[I_FING])[lane + 64 * j];
    for (int m = gw; m < M; m += NGW) {
        float s = lane < 16 ? ssq[((size_t)(lane >> 2) * M + m) * 4 + (lane & 3)] : 0.f; s = wave_sum(s);
        const float rs = __builtin_amdgcn_rsqf(s * (1.0f / 1024.0f) + 1e-6f);
        const GAS v2u* xb = (const GAS v2u*)((const bf16*)(a.ws + WS_ACT1) + (size_t)m * D) + lane;
        GAS f32x4* yr = (GAS f32x4*)(a.out + (size_t)m * D) + lane;
#pragma unroll
#ifdef DBG_HASH_Y
        for (int j = 0; j < 4; ++j) { const v2u q = xb[64 * j]; f32x4 v = (f32x4){bflo(q.x), bfhi(q.x), bflo(q.y), bfhi(q.y)}; v = v * rs * gv[j]; f32x4 h;
            for (int qq = 0; qq < 4; ++qq) { const unsigned b = __float_as_uint(v[qq]); const unsigned hh = (b * 2654435761u) ^ (b >> 15); h[qq] = (float)(hh >> 8) * (1.0f / 16777216.0f); }
            yr[64 * j] = h; }
#else
        for (int j = 0; j < 4; ++j) { const v2u q = xb[64 * j]; const f32x4 v = (f32x4){bflo(q.x), bfhi(q.x), bflo(q.y), bfhi(q.y)}; yr[64 * j] = v * rs * gv[j]; }
#endif
    }
}

typedef float f32x4_t __attribute__((ext_vector_type(4)));
#ifdef DBG_MIX_T
#define MIX_STAMP(i) do { if (((i) == DBG_TA || (i) == DBG_TB) && !SAMPLE && layer == 1 && blockIdx.x == DBG_T_BLK && wave == 0) { const unsigned long long t__ = __builtin_amdgcn_s_memrealtime(); if (lane == 0) ((volatile LAS unsigned long long*)(lds + 131072 + 320 + 256))[16 + (i)] = t__; } } while (0)
#else
#define MIX_STAMP(i) do {} while (0)
#endif
__device__ __forceinline__ float fma_s(float a, float b, float c) { float r; asm("v_fma_f32 %0, %1, %2, %3" : "=v"(r) : "v"(a), "v"(b), "v"(c)); return r; }
template <bool SAMPLE>
__device__ __forceinline__ void mix_unit(const Args& a, int layer, int uidx, LAS unsigned char* lds, int tid_in, int lane_in, int wave_in, int stages) {
    int tid = tid_in; asm volatile("" : "+v"(tid));
    const int lane = tid & 63, wave = __builtin_amdgcn_readfirstlane(tid >> 6);
#ifdef DBG_EXTRA_SYNC
    asm volatile("s_waitcnt vmcnt(0) lgkmcnt(0)" ::: "memory"); __syncthreads();
#endif
    constexpr int L = SAMPLE ? 8 : 64, NSEG = SAMPLE ? 2 : 1, R = NSEG * L;
    const bf16* PMb = (const bf16*)(a.ws + WS_PM); bf16* BR = (bf16*)a.out;
    const int s = uidx >> 5, c = uidx & 31, q0 = 2 * uidx;
    const int row0 = SAMPLE ? MP + q0 * 8 : s * SEQ + 64 * c;
    const bool last = SAMPLE || c == NCH - 1;
    LAS float* V = (LAS float*)lds;
    MIX_STAMP(0);
    if (stages & 1) {
        constexpr int TR = NSEG * (30 + L);
        LAS float* WCF = (LAS float*)(lds + 96256);
        {
            constexpr int NIT = (TR * 32 + 511) / 512;
            v4u qa[NIT], qb[NIT]; int kind[NIT];
#pragma unroll
            for (int it = 0; it < NIT; ++it) {
                const int idx = tid + it * 512; kind[it] = 0; qa[it] = (v4u){0u, 0u, 0u, 0u}; qb[it] = (v4u){0u, 0u, 0u, 0u};
                if (idx < TR * 32) {
                    const int rr = idx >> 5, c8 = (idx & 31) * 8, seg = rr / (30 + L), e = rr % (30 + L);
                    int srow = -1;
                    if (SAMPLE) { if (e >= 30) srow = MP + (q0 + seg) * 8 + (e - 30); }
                    else { const int tabs = c * 64 + e - 30; if (tabs >= 0) srow = s * SEQ + tabs; }
                    if (srow >= 0) { kind[it] = 1; qa[it] = *(const v4u*)(PMb + (size_t)srow * PMC + 1280 + c8); qb[it] = *(const v4u*)(PMb + (size_t)srow * PMC + 1536 + c8); }
                    else if (SAMPLE) { kind[it] = 2; const float* st = a.in[I_STCF] + ((size_t)(layer * DB + q0 + seg) * 30 + e) * MIXW + c8; qa[it] = *(const v4u*)st; qb[it] = *(const v4u*)(st + 4); }
                }
            }
#pragma unroll
            for (int it = 0; it < NIT; ++it) {
                const int idx = tid + it * 512;
                if (idx < TR * 32) {
                    const int rr = idx >> 5, c8 = (idx & 31) * 8;
                    float v[8];
                    if (kind[it] == 1) { float av[8], bv[8]; unpack8(qa[it], av); unpack8(qb[it], bv);
#pragma unroll
                        for (int j = 0; j < 8; ++j) v[j] = av[j] * sigm(bv[j]); }
                    else { v[0] = __uint_as_float(qa[it].x); v[1] = __uint_as_float(qa[it].y); v[2] = __uint_as_float(qa[it].z); v[3] = __uint_as_float(qa[it].w);
                           v[4] = __uint_as_float(qb[it].x); v[5] = __uint_as_float(qb[it].y); v[6] = __uint_as_float(qb[it].z); v[7] = __uint_as_float(qb[it].w); }
                    *(LAS f32x4*)(V + rr * 256 + c8) = (f32x4){v[0], v[1], v[2], v[3]}; *(LAS f32x4*)(V + rr * 256 + c8 + 4) = (f32x4){v[4], v[5], v[6], v[7]};
                }
            }
        }
        { f32x4 wq[4];
#pragma unroll
            for (int it = 0; it < 4; ++it) { const int idx = tid + it * 512; wq[it] = idx < 31 * 64 ? *(const f32x4*)(a.in[I_CFW] + (size_t)layer * 31 * MIXW + idx * 4) : (f32x4){0.f, 0.f, 0.f, 0.f}; }
#pragma unroll
            for (int it = 0; it < 4; ++it) { const int idx = tid + it * 512; if (idx < 31 * 64) *(LAS f32x4*)(WCF + idx * 4) = wq[it]; } }
        __syncthreads();
        MIX_STAMP(1);
        if (last) {
            for (int idx = tid; idx < NSEG * 30 * 64; idx += 512) { const int seg = idx / (30 * 64), r = idx % (30 * 64), j = r >> 6, c4 = (r & 63) * 4;
                float* dst = a.out + (SAMPLE ? O_CFS + ((size_t)(layer * DB + q0 + seg) * 30 + j) * MIXW : O_CFP + ((size_t)(layer * NB + s) * 30 + j) * MIXW) + c4;
                *(f32x4*)dst = *(LAS f32x4*)(V + (seg * (30 + L) + L + j) * 256 + c4); }
        }
        const f32x4 lg = *(const f32x4*)(a.in[I_CFLNG] + layer * MIXW + 4 * lane), lb = *(const f32x4*)(a.in[I_CFLNB] + layer * MIXW + 4 * lane);
        {
            constexpr int NT = R / NWAVES, TG = NT >= 4 ? 4 : NT;
#pragma unroll 1
            for (int g0 = 0; g0 < NT; g0 += TG) {
                f32x4 acc[TG]; int base[TG];
#pragma unroll
                for (int i = 0; i < TG; ++i) { const int tt = wave + NWAVES * (g0 + i), seg = tt / L, t = tt % L; base[i] = (seg * (30 + L) + t) * 256 + 4 * lane; acc[i] = (f32x4){0.f, 0.f, 0.f, 0.f}; }
#pragma unroll 4
                for (int j = 0; j < 31; ++j) { const f32x4 w = *(LAS f32x4*)(WCF + j * 256 + 4 * lane);
#pragma unroll
                    for (int i = 0; i < TG; ++i) acc[i] += w * *(LAS f32x4*)(V + base[i] + j * 256); }
                float s1[TG];
#pragma unroll
                for (int i = 0; i < TG; ++i) s1[i] = (acc[i][0] + acc[i][1]) + (acc[i][2] + acc[i][3]);
#pragma unroll
                for (int o = 1; o < 64; o <<= 1) {
#pragma unroll
                    for (int i = 0; i < TG; ++i) s1[i] += __shfl_xor(s1[i], o); }
                f32x4 d[TG]; float s2[TG];
#pragma unroll
                for (int i = 0; i < TG; ++i) { d[i] = acc[i] - s1[i] * (1.0f / 256.0f); s2[i] = (d[i][0] * d[i][0] + d[i][1] * d[i][1]) + (d[i][2] * d[i][2] + d[i][3] * d[i][3]); }
#pragma unroll
                for (int o = 1; o < 64; o <<= 1) {
#pragma unroll
                    for (int i = 0; i < TG; ++i) s2[i] += __shfl_xor(s2[i], o); }
#pragma unroll
                for (int i = 0; i < TG; ++i) { const int tt = wave + NWAVES * (g0 + i);
                    const float rstd = __builtin_amdgcn_rsqf(s2[i] * (1.0f / 256.0f) + 1e-5f);
                    const f32x4 yn = d[i] * rstd * lg + lb;
                    v2u w; w.x = pk2(yn[0] * sigm(yn[0]), yn[1] * sigm(yn[1])); w.y = pk2(yn[2] * sigm(yn[2]), yn[3] * sigm(yn[3]));
                    *(v2u*)(BR + (size_t)(row0 + tt) * D + 768 + 4 * lane) = w; }
            }
        }
        __syncthreads();
    }
    MIX_STAMP(2);
    if (stages & 2) {
        constexpr int TR = NSEG * (15 + L);
        LAS bf16* Dt = (LAS bf16*)(lds + 81920);
        {
            constexpr int NIT = (TR * 32 + 511) / 512;
            v4u qa[NIT], qb[NIT]; int kind[NIT];
#pragma unroll
            for (int it = 0; it < NIT; ++it) {
                const int idx = tid + it * 512; kind[it] = 0; qa[it] = (v4u){0u, 0u, 0u, 0u}; qb[it] = (v4u){0u, 0u, 0u, 0u};
                if (idx < TR * 32) {
                    const int rr = idx >> 5, c8 = (idx & 31) * 8, seg = rr / (15 + L), e = rr % (15 + L);
                    int srow = -1;
                    if (SAMPLE) { if (e >= 15) srow = MP + (q0 + seg) * 8 + (e - 15); }
                    else { const int tabs = c * 64 + e - 15; if (tabs >= 0) srow = s * SEQ + tabs; }
                    if (srow >= 0) { kind[it] = 1; qa[it] = *(const v4u*)(PMb + (size_t)srow * PMC + c8); }
                    else if (SAMPLE) { kind[it] = 2; const float* st = a.in[I_STPOOL] + ((size_t)(layer * DB + q0 + seg) * 15 + e) * MIXW + c8; qa[it] = *(const v4u*)st; qb[it] = *(const v4u*)(st + 4); }
                }
            }
#pragma unroll
            for (int it = 0; it < NIT; ++it) {
                const int idx = tid + it * 512;
                if (idx < TR * 32) {
                    const int rr = idx >> 5, c8 = (idx & 31) * 8;
                    float v[8];
                    if (kind[it] == 1) unpack8(qa[it], v);
                    else { v[0] = __uint_as_float(qa[it].x); v[1] = __uint_as_float(qa[it].y); v[2] = __uint_as_float(qa[it].z); v[3] = __uint_as_float(qa[it].w);
                           v[4] = __uint_as_float(qb[it].x); v[5] = __uint_as_float(qb[it].y); v[6] = __uint_as_float(qb[it].z); v[7] = __uint_as_float(qb[it].w); }
                    *(LAS f32x4*)(V + rr * 256 + c8) = (f32x4){v[0], v[1], v[2], v[3]}; *(LAS f32x4*)(V + rr * 256 + c8 + 4) = (f32x4){v[4], v[5], v[6], v[7]};
                }
            }
        }
        __syncthreads();
        MIX_STAMP(3);
        if (last) {
            for (int idx = tid; idx < NSEG * 15 * 64; idx += 512) { const int seg = idx / (15 * 64), r = idx % (15 * 64), j = r >> 6, c4 = (r & 63) * 4;
                float* dst = a.out + (SAMPLE ? O_POOLS + ((size_t)(layer * DB + q0 + seg) * 15 + j) * MIXW : O_POOLP + ((size_t)(layer * NB + s) * 15 + j) * MIXW) + c4;
                *(f32x4*)dst = *(LAS f32x4*)(V + (seg * (15 + L) + L + j) * 256 + c4); }
        }
        for (int idx = tid; idx < R * 32; idx += 512) {
            const int tt = idx >> 5, c8 = (idx & 31) * 8, seg = tt / L, t = tt % L, base = seg * (15 + L) + t + 15, win = 2 << (c8 >> 6);
            float sm[8];
#pragma unroll
            for (int j = 0; j < 8; ++j) sm[j] = 0.f;
            for (int w = 0; w < win; ++w) { const f32x4 x0 = *(LAS f32x4*)(V + (base - w) * 256 + c8), x1 = *(LAS f32x4*)(V + (base - w) * 256 + c8 + 4);
                sm[0] += x0[0]; sm[1] += x0[1]; sm[2] += x0[2]; sm[3] += x0[3]; sm[4] += x1[0]; sm[5] += x1[1]; sm[6] += x1[2]; sm[7] += x1[3]; }
            const int cnt = SAMPLE ? win : min(c * 64 + t + 1, win);
            const float inv = 1.0f / (float)cnt;
            const f32x4 c0 = *(LAS f32x4*)(V + base * 256 + c8), c1 = *(LAS f32x4*)(V + base * 256 + c8 + 4);
            float dd[8];
#pragma unroll
            for (int j = 0; j < 4; ++j) { dd[j] = sm[j] * inv - c0[j]; dd[4 + j] = sm[4 + j] * inv - c1[j]; }
            *(LAS v4u*)(Dt + tt * 264 + c8) = pack8(dd);
        }
        __syncthreads();
        MIX_STAMP(4);
        {
            const bf16* PW = (const bf16*)(a.ws + WS_TAB + (size_t)layer * TAB_STRIDE + TAB_PW);
            const int k = wave >> 1, fr = lane & 15, fq = lane >> 4;
            constexpr int NMT = R / 16;
            for (int mt = (NMT >= 4 ? (wave & 1) * 2 : (wave & 1)); mt < (NMT >= 4 ? (wave & 1) * 2 + 2 : ((wave & 1) == 0 ? NMT : 0)); ++mt) {
                const bf16x8 b0 = *(LAS bf16x8*)(Dt + (16 * mt + fr) * 264 + 64 * k + 8 * fq), b1 = *(LAS bf16x8*)(Dt + (16 * mt + fr) * 264 + 64 * k + 32 + 8 * fq);
#pragma unroll
                for (int ot = 0; ot < 4; ++ot) {
                    f32x4 acc = (f32x4){0.f, 0.f, 0.f, 0.f};
                    const bf16x8 a0 = *(const bf16x8*)(PW + ((size_t)(k * 64 + 16 * ot + fr)) * 64 + 8 * fq), a1 = *(const bf16x8*)(PW + ((size_t)(k * 64 + 16 * ot + fr)) * 64 + 32 + 8 * fq);
                    acc = __builtin_amdgcn_mfma_f32_16x16x32_bf16(a0, b0, acc, 0, 0, 0);
                    acc = __builtin_amdgcn_mfma_f32_16x16x32_bf16(a1, b1, acc, 0, 0, 0);
                    const int o = 64 * k + 16 * ot + 4 * fq, tt = 16 * mt + fr;
                    const f32x4 sc = *(const f32x4*)(a.in[I_POOLSC] + layer * MIXW + o);
                    v2u w; w.x = pk2(acc[0] * sc[0], acc[1] * sc[1]); w.y = pk2(acc[2] * sc[2], acc[3] * sc[3]);
                    *(v2u*)(BR + (size_t)(row0 + tt) * D + o) = w;
                }
            }
        }
        __syncthreads();
    }
    MIX_STAMP(5);
    if (stages & 4) {
        const float* scw = a.in[I_SCW] + (size_t)layer * 3 * MIXW;
#pragma unroll
        for (int it_ = 0; it_ < R * 32 / 512; ++it_) { const int idx = tid + it_ * 512;
            const int tt = idx >> 5, c8 = (idx & 31) * 8, seg = tt / L, t = tt % L;
            float z[3][8];
#pragma unroll
            for (int dj = 0; dj < 3; ++dj) { const int tp = t - 2 + dj;
                int srow = -1;
                if (SAMPLE) { if (tp >= 0) srow = MP + (q0 + seg) * 8 + tp; } else { const int tabs = c * 64 + tp; if (tabs >= 0) srow = s * SEQ + tabs; }
                if (srow >= 0) { float cg[8], hx[8]; unpack8(*(const v4u*)(PMb + (size_t)srow * PMC + 768 + c8), cg); unpack8(*(const v4u*)(PMb + (size_t)srow * PMC + 1024 + c8), hx);
#pragma unroll
                    for (int j = 0; j < 8; ++j) z[dj][j] = cg[j] * hx[j]; }
                else if (SAMPLE) { const float* st = a.in[I_STSC] + ((size_t)(layer * DB + q0 + seg) * 2 + (2 + tp)) * MIXW + c8; const f32x4 x0 = *(const f32x4*)st, x1 = *(const f32x4*)(st + 4);
                    z[dj][0] = x0[0]; z[dj][1] = x0[1]; z[dj][2] = x0[2]; z[dj][3] = x0[3]; z[dj][4] = x1[0]; z[dj][5] = x1[1]; z[dj][6] = x1[2]; z[dj][7] = x1[3]; }
                else {
#pragma unroll
                    for (int j = 0; j < 8; ++j) z[dj][j] = 0.f; } }
            float bg[8], o[8]; unpack8(*(const v4u*)(PMb + (size_t)(row0 + tt) * PMC + 512 + c8), bg);
#pragma unroll
            for (int j = 0; j < 8; ++j) o[j] = bg[j] * (scw[c8 + j] * z[0][j] + scw[MIXW + c8 + j] * z[1][j] + scw[2 * MIXW + c8 + j] * z[2][j]);
            *(v4u*)(BR + (size_t)(row0 + tt) * D + 512 + c8) = pack8(o);
            if (last && t >= L - 2) { float* dst = a.out + (SAMPLE ? O_SCS + ((size_t)(layer * DB + q0 + seg) * 2 + (t - (L - 2))) * MIXW : O_SCP + ((size_t)(layer * NB + s) * 2 + (t - (L - 2))) * MIXW) + c8;
                *(f32x4*)dst = (f32x4){z[2][0], z[2][1], z[2][2], z[2][3]}; *(f32x4*)(dst + 4) = (f32x4){z[2][4], z[2][5], z[2][6], z[2][7]}; }
        }
    }
    MIX_STAMP(6);
}

template <int MODE>
__device__ __forceinline__ void ssm_unit(const Args& a, int layer, int uidx, LAS unsigned char* lds, int tid_in, int lane_in, int wave_in) {
    int tid = tid_in; asm volatile("" : "+v"(tid));
    const int lane = tid & 63, wave = __builtin_amdgcn_readfirstlane(tid >> 6);
    const bf16* PMb = (const bf16*)(a.ws + WS_PM); bf16* BR = (bf16*)a.out;
    const unsigned char* tab = a.ws + WS_TAB + (size_t)layer * TAB_STRIDE;
    const f32x2* LB = (const f32x2*)(tab + TAB_LB); const f32x2* LP = (const f32x2*)(tab + TAB_LP);
    const bf16* BBT = (const bf16*)(tab + TAB_BBT); const bf16* CM = (const bf16*)(tab + TAB_CM);
    f32x2* E = (f32x2*)(a.ws + WS_E);
    const int s = uidx >> 5, c = uidx & 31;
    const int row0 = MODE == 2 ? MP + 64 * uidx : s * SEQ + 64 * c;
    const int fr = lane & 15, fq = lane >> 4;
    LAS float* BU = (LAS float*)(lds + wave * 8448);
    LAS bf16* Zt = (LAS bf16*)(lds + 67584);
    const bf16x8 zf = (bf16x8){0, 0, 0, 0, 0, 0, 0, 0};
    for (int gi = 0; gi < 2; ++gi) {
        const int g = 2 * wave + gi;
        const f32x2 lam = LB[g * 64 + lane]; const float nlam1 = -lam[1];
        float hr = 0.f, hi = 0.f;
        bf16x8 bb[8];
#pragma unroll
        for (int nt = 0; nt < 8; ++nt) bb[nt] = fq < 2 ? *(const bf16x8*)(BBT + ((size_t)(g * 128 + 16 * nt + fr)) * 16 + 8 * fq) : zf;
        bf16x8 cmf[4]; float dsk = 0.f;
        if (MODE >= 1) {
#pragma unroll
            for (int ks = 0; ks < 4; ++ks) cmf[ks] = *(const bf16x8*)(CM + ((size_t)(g * 16 + fr)) * 128 + 32 * ks + 8 * fq);
            dsk = a.in[I_DSKIP][layer * MIXW + 16 * g + fr]; }
        bf16x8 ufa[4];
#pragma unroll
        for (int sub = 0; sub < 4; ++sub) ufa[sub] = fq < 2 ? *(const bf16x8*)(PMb + (size_t)(row0 + 16 * sub + fr) * PMC + 256 + 16 * g + 8 * fq) : zf;
        bf16 uva[4][4];
        if (MODE >= 1) {
#pragma unroll
            for (int sub = 0; sub < 4; ++sub)
#pragma unroll
                for (int r = 0; r < 4; ++r) uva[sub][r] = PMb[(size_t)(row0 + 16 * sub + 4 * fq + r) * PMC + 256 + 16 * g + fr]; }
        if (MODE == 1) { const f32x2 lp = LP[g * 64 + lane];
            const float nlp1 = -lp[1];
#pragma unroll 1
            for (int j = 0; j < c; j += 16) { f32x2 e16[16]; const int nq = c - j;
#pragma unroll
                for (int q = 0; q < 16; ++q) if (q < nq) e16[q] = E[((size_t)(s * NCH + j + q) * 16 + g) * 64 + lane];
#pragma unroll
                for (int q = 0; q < 16; ++q) if (q < nq) { const float nr = fma_s(lp[0], hr, fma_s(nlp1, hi, e16[q][0])), ni = fma_s(lp[0], hi, fma_s(lp[1], hr, e16[q][1])); hr = nr; hi = ni; } } }
#pragma unroll
        for (int sub = 0; sub < 4; ++sub) {
            const int rowb = row0 + 16 * sub;
            const bf16x8 uf = ufa[sub];
#pragma unroll
            for (int nt = 0; nt < 8; ++nt) { const f32x4 d = __builtin_amdgcn_mfma_f32_16x16x32_bf16(uf, bb[nt], (f32x4){0.f, 0.f, 0.f, 0.f}, 0, 0, 0);
#pragma unroll
                for (int r = 0; r < 4; ++r) BU[(4 * fq + r) * 132 + 16 * nt + fr] = d[r]; }
            asm volatile("s_waitcnt lgkmcnt(0)" ::: "memory");
            {
                float bre_[16], bim_[16];
#pragma unroll
                for (int t = 0; t < 16; ++t) { bre_[t] = BU[t * 132 + lane]; bim_[t] = BU[t * 132 + 64 + lane]; }
                float sre_[2] = {0.f, 0.f}, sim_[2] = {0.f, 0.f};
                if (MODE == 2) {
#pragma unroll
                    for (int hq = 0; hq < 2; ++hq) { const int q = 8 * uidx + 2 * sub + hq; const size_t si = ((size_t)(layer * DB + q) * 16 + g) * 64 + lane; sre_[hq] = a.in[I_STRE][si]; sim_[hq] = a.in[I_STIM][si]; } }
                asm volatile("s_waitcnt lgkmcnt(0)" ::: "memory");
#pragma unroll
                for (int t = 0; t < 16; ++t) {
                    if (MODE == 2 && (t & 7) == 0) { hr = sre_[t >> 3]; hi = sim_[t >> 3]; }
                    const float nr = fma_s(lam[0], hr, fma_s(nlam1, hi, bre_[t])), ni = fma_s(lam[0], hi, fma_s(lam[1], hr, bim_[t])); hr = nr; hi = ni;
                    bre_[t] = hr; bim_[t] = hi;
                    if (MODE == 2 && (t & 7) == 7) { const int q = 8 * uidx + 2 * sub + (t >> 3); const size_t si = ((size_t)(layer * DB + q) * 16 + g) * 64 + lane; a.out[O_SRES + si] = hr; a.out[O_SIMS + si] = hi; }
                }
#pragma unroll
                for (int t = 0; t < 16; ++t) { BU[t * 132 + lane] = bre_[t]; BU[t * 132 + 64 + lane] = bim_[t]; }
            }
            if (MODE >= 1) {
                asm volatile("s_waitcnt lgkmcnt(0)" ::: "memory");
                f32x4 y = (f32x4){0.f, 0.f, 0.f, 0.f};
#pragma unroll
                for (int ks = 0; ks < 4; ++ks) { const f32x4 h0 = *(LAS f32x4*)(BU + fr * 132 + 32 * ks + 8 * fq), h1 = *(LAS f32x4*)(BU + fr * 132 + 32 * ks + 8 * fq + 4);
                    v4u hw; hw.x = pk2(h0[0], h0[1]); hw.y = pk2(h0[2], h0[3]); hw.z = pk2(h1[0], h1[1]); hw.w = pk2(h1[2], h1[3]);
                    y = __builtin_amdgcn_mfma_f32_16x16x32_bf16(__builtin_bit_cast(bf16x8, hw), cmf[ks], y, 0, 0, 0); }
#pragma unroll
                for (int r = 0; r < 4; ++r) { const int t = 4 * fq + r; const float uv = bf1(uva[sub][r]);
                    const float z = gelu_tanh(y[r] + dsk * uv);
                    Zt[(16 * sub + t) * 264 + 16 * g + fr] = (bf16)(pk2(z, 0.f) & 0xffffu); }
                asm volatile("s_waitcnt lgkmcnt(0)" ::: "memory");
            }
            if (MODE == 0) { asm volatile("s_waitcnt lgkmcnt(0)" ::: "memory"); }
        }
        if (MODE == 0) E[((size_t)(s * NCH + c) * 16 + g) * 64 + lane] = (f32x2){hr, hi};
        if (MODE == 1 && c == NCH - 1) { const size_t si = ((size_t)(layer * NB + s) * 16 + g) * 64 + lane; a.out[O_SREP + si] = hr; a.out[O_SIMP + si] = hi; }
    }
    if (MODE == 0) __syncthreads();
    if (MODE >= 1) {
        __syncthreads();
        const bf16* WG = (const bf16*)(a.ws + WS_WGLU) + (size_t)layer * MIXW * MIXW;
        f32x4 acc[4][2];
#pragma unroll
        for (int mt = 0; mt < 4; ++mt) { acc[mt][0] = (f32x4){0.f, 0.f, 0.f, 0.f}; acc[mt][1] = (f32x4){0.f, 0.f, 0.f, 0.f}; }
#pragma unroll
        for (int ks = 0; ks < 8; ++ks) {
            const bf16x8 w0 = *(const bf16x8*)(WG + (size_t)(32 * wave + fr) * MIXW + 32 * ks + 8 * fq), w1 = *(const bf16x8*)(WG + (size_t)(32 * wave + 16 + fr) * MIXW + 32 * ks + 8 * fq);
#pragma unroll
            for (int mt = 0; mt < 4; ++mt) { const bf16x8 zb = *(LAS bf16x8*)(Zt + (16 * mt + fr) * 264 + 32 * ks + 8 * fq);
                acc[mt][0] = __builtin_amdgcn_mfma_f32_16x16x32_bf16(w0, zb, acc[mt][0], 0, 0, 0);
                acc[mt][1] = __builtin_amdgcn_mfma_f32_16x16x32_bf16(w1, zb, acc[mt][1], 0, 0, 0); }
        }
#pragma unroll
        for (int nl = 0; nl < 2; ++nl) { const int n0 = 32 * wave + 16 * nl + 4 * fq; const f32x4 bgl = *(const f32x4*)(a.in[I_BGLU] + layer * MIXW + n0);
#pragma unroll
            for (int mt = 0; mt < 4; ++mt) { const int tt = 16 * mt + fr; const v2u zz = *(LAS v2u*)(Zt + tt * 264 + n0);
                const float z0 = bflo(zz.x), z1 = bfhi(zz.x), z2 = bflo(zz.y), z3 = bfhi(zz.y);
                v2u w; w.x = pk2(z0 * sigm(acc[mt][nl][0] + bgl[0]), z1 * sigm(acc[mt][nl][1] + bgl[1])); w.y = pk2(z2 * sigm(acc[mt][nl][2] + bgl[2]), z3 * sigm(acc[mt][nl][3] + bgl[3]));
                *(v2u*)(BR + (size_t)(row0 + tt) * D + 256 + n0) = w; } }
        __syncthreads();
    }
}

__device__ __forceinline__ void gemm2_phase(LAS unsigned char* lds, const bf16* BRp, const bf16* WBT, const unsigned char* GT, bf16* MG, int G, int bid, int tidp) {
    using namespace pg8;
    int tid_ = tidp; asm volatile("" : "+v"(tid_));
    const int tid = tid_, wid = __builtin_amdgcn_readfirstlane(tid >> 6), lane = tid & 63, wr = wid >> 2, wc = wid & 3, fr = lane & 15, fq = lane >> 4;
    unsigned voffA0, voffB0;
    { int R, C; stage_rc(tid * 16, R, C); const int Rb = (R & ~31) + perm32(R & 31); voffA0 = (unsigned)(R * D + C) * 2u; voffB0 = (unsigned)(Rb * MIXW + C) * 2u; }
    const unsigned ldsw = (unsigned)wid * 1024u;
    const int aoff = lds_byte(wr * 64 + fr, fq * 8), boff = lds_byte(wc * 32 + fr, fq * 8);
    const unsigned gvoff = (unsigned)(fr * GTC + 8 * fq);
    constexpr int STG = 49152;
#define G2_STAGE(it_, so_) do { const int kb_ = (it_) >> 2, kt_ = (it_) & 3; \
        const char* as_ = Abase + (size_t)(kb_ * 256 + kt_ * 64) * 2; const char* bs_ = Bbase + (size_t)kb_ * (D * MIXW * 2) + (size_t)kt_ * 128; \
        _Pragma("unroll") for (int _i = 0; _i < 2; ++_i) __builtin_amdgcn_global_load_lds((const unsigned*)(as_ + (size_t)_i * (64 * D * 2) + voffA0), (PG8_LAS unsigned*)(lds + (so_) + ldsw + _i * 8192), 16, 0, 0); \
        _Pragma("unroll") for (int _i = 0; _i < 2; ++_i) __builtin_amdgcn_global_load_lds((const unsigned*)(bs_ + (size_t)_i * (64 * MIXW * 2) + voffB0), (PG8_LAS unsigned*)(lds + (so_) + 16384 + ldsw + _i * 8192), 16, 0, 0); \
        _Pragma("unroll") for (int _i = 0; _i < 2; ++_i) __builtin_amdgcn_global_load_lds((const unsigned*)(bs_ + (size_t)(128 + 64 * _i) * MIXW * 2 + voffB0), (PG8_LAS unsigned*)(lds + (so_) + 32768 + ldsw + _i * 8192), 16, 0, 0); } while (0)
    const int vb = (G % 8 == 0) ? (bid % 8) * (G / 8) + bid / 8 : bid;
    constexpr int NUN = (MP / 128) * 4;
    for (int ui = vb; ui < NUN; ui += G) {
        const int pm = ui >> 2, pn = ui & 3;
        const char* Abase = (const char*)BRp + (size_t)pm * 128 * D * 2;
        const char* Bbase = (const char*)WBT + (size_t)pn * 256 * MIXW * 2;
        G2_STAGE(0, 0); G2_STAGE(1, STG);
        f32x4 mg[2][4][2], acc[2][4][2];
#pragma unroll
        for (int b = 0; b < 2; ++b)
#pragma unroll
            for (int m = 0; m < 4; ++m)
#pragma unroll
                for (int n = 0; n < 2; ++n) { mg[b][m][n] = (f32x4){0.f, 0.f, 0.f, 0.f}; acc[b][m][n] = (f32x4){0.f, 0.f, 0.f, 0.f}; }
        v2u gq[2][4];
        int so = 0, so2 = 2 * STG;
#pragma unroll 1
        for (int kb = 0; kb < 4; ++kb) {
#pragma unroll
            for (int kt = 0; kt < 4; ++kt) {
                if (kt < 2) asm volatile("s_waitcnt vmcnt(6)" ::: "memory");
                else if (kt == 3 && kb == 3) asm volatile("s_waitcnt vmcnt(8)" ::: "memory");
                else asm volatile("s_waitcnt vmcnt(14)" ::: "memory");
                __builtin_amdgcn_s_barrier(); asm volatile("" ::: "memory");
                if (kt < 2 || kb < 3) G2_STAGE(4 * kb + kt + 2, so2);
#pragma unroll
                for (int kk = 0; kk < 2; ++kk) {
                    bf16x8 At[4], B0[2], B1[2];
#pragma unroll
                    for (int m = 0; m < 4; ++m) At[m] = *(const PG8_LAS bf16x8*)(lds + so + aoff + m * 2048 + kk * 1024);
#pragma unroll
                    for (int n = 0; n < 2; ++n) { B0[n] = *(const PG8_LAS bf16x8*)(lds + so + 16384 + boff + n * 2048 + kk * 1024); B1[n] = *(const PG8_LAS bf16x8*)(lds + so + 32768 + boff + n * 2048 + kk * 1024); }
                    asm volatile("s_waitcnt lgkmcnt(0)" ::: "memory"); __builtin_amdgcn_sched_barrier(0);
#pragma unroll
                    for (int m = 0; m < 4; ++m)
#pragma unroll
                        for (int n = 0; n < 2; ++n) { acc[0][m][n] = __builtin_amdgcn_mfma_f32_16x16x32_bf16(B0[n], At[m], acc[0][m][n], 0, 0, 0);
                                                      acc[1][m][n] = __builtin_amdgcn_mfma_f32_16x16x32_bf16(B1[n], At[m], acc[1][m][n], 0, 0, 0); }
                }
                if (kt == 1) {
#pragma unroll
                    for (int m = 0; m < 4; ++m) { const unsigned char* gs = GT + (size_t)(pm * 128 + wr * 64 + m * 16) * GTC + kb * D + pn * 256 + wc * 32;
                        asm volatile("global_load_dwordx2 %0, %1, %2" : "=v"(gq[0][m]) : "v"(gvoff), "s"(gs) : "memory");
                        asm volatile("global_load_dwordx2 %0, %1, %2 offset:128" : "=v"(gq[1][m]) : "v"(gvoff), "s"(gs) : "memory"); }
                }
                so = so == 2 * STG ? 0 : so + STG; so2 = so2 == 2 * STG ? 0 : so2 + STG;
            }
            if (kb == 3) asm volatile("s_waitcnt vmcnt(0)" ::: "memory"); else asm volatile("s_waitcnt vmcnt(12)" ::: "memory");
            asm volatile("" : "+v"(gq[0][0]), "+v"(gq[0][1]), "+v"(gq[0][2]), "+v"(gq[0][3]), "+v"(gq[1][0]), "+v"(gq[1][1]), "+v"(gq[1][2]), "+v"(gq[1][3]));
#pragma unroll
            for (int b = 0; b < 2; ++b)
#pragma unroll
                for (int m = 0; m < 4; ++m) { const v2u q_ = gq[b][m];
#pragma unroll
                    for (int j = 0; j < 4; ++j) { mg[b][m][0][j] += (float)((q_.x >> (8 * j)) & 0xffu) * acc[b][m][0][j]; mg[b][m][1][j] += (float)((q_.y >> (8 * j)) & 0xffu) * acc[b][m][1][j]; }
                    acc[b][m][0] = (f32x4){0.f, 0.f, 0.f, 0.f}; acc[b][m][1] = (f32x4){0.f, 0.f, 0.f, 0.f}; }
        }
        asm volatile("" ::: "memory"); __builtin_amdgcn_s_barrier(); asm volatile("" ::: "memory");
#pragma unroll
        for (int b = 0; b < 2; ++b)
#pragma unroll
            for (int m = 0; m < 4; ++m) { const int row = pm * 128 + wr * 64 + m * 16 + fr, col = pn * 256 + b * 128 + wc * 32 + 8 * fq;
                const f32x4 m0 = mg[b][m][0] * (1.0f / 255.0f), m1 = mg[b][m][1] * (1.0f / 255.0f);
                v4u w; w.x = pk2(m0[0], m0[1]); w.y = pk2(m0[2], m0[3]); w.z = pk2(m1[0], m1[1]); w.w = pk2(m1[2], m1[3]);
                *(v4u*)(MG + (size_t)row * D + col) = w; }
    }
#undef G2_STAGE
}


#define TL_GLDS(src_, dst_) __builtin_amdgcn_global_load_lds((const unsigned*)(src_), (PG8_LAS unsigned*)(dst_), 16, 0, 0)
#define TL_STAGE(kt_, A_PTR, B_PTR) do { const int s_ = (kt_) & 3; const char* ap_ = A_PTR(kt_); const char* bp_ = B_PTR(kt_); \
        TL_GLDS(ap_ + voffA, lds + s_ * 32768 + ldsw); TL_GLDS(ap_ + voffA + 128, lds + s_ * 32768 + 8192 + ldsw); \
        TL_GLDS(bp_ + voffB, lds + s_ * 32768 + 16384 + ldsw); TL_GLDS(bp_ + voffB + 128, lds + s_ * 32768 + 24576 + ldsw); } while (0)
#define TL_LOOP(NK, A_PTR, B_PTR, AFTER_STEP) do { \
        TL_STAGE(0, A_PTR, B_PTR); if ((NK) > 1) TL_STAGE(1, A_PTR, B_PTR); if ((NK) > 2) TL_STAGE(2, A_PTR, B_PTR); \
        _Pragma("unroll 1") for (int kt = 0; kt < (NK); ++kt) { \
            if (kt + 2 < (NK)) asm volatile("s_waitcnt vmcnt(8)" ::: "memory"); else if (kt + 1 < (NK)) asm volatile("s_waitcnt vmcnt(4)" ::: "memory"); else asm volatile("s_waitcnt vmcnt(0)" ::: "memory"); \
            __builtin_amdgcn_s_barrier(); asm volatile("" ::: "memory"); \
            if (kt + 3 < (NK)) TL_STAGE(kt + 3, A_PTR, B_PTR); \
            const int sb_ = (kt & 3) * 32768; \
            _Pragma("unroll") for (int h_ = 0; h_ < 2; ++h_) { \
                const bf16x8 a0 = *(const PG8_LAS bf16x8*)(lds + sb_ + h_ * 8192 + aoff), a1 = *(const PG8_LAS bf16x8*)(lds + sb_ + h_ * 8192 + aoff + 1024); \
                const bf16x8 b00 = *(const PG8_LAS bf16x8*)(lds + sb_ + 16384 + h_ * 8192 + boff), b01 = *(const PG8_LAS bf16x8*)(lds + sb_ + 16384 + h_ * 8192 + boff + 1024); \
                const bf16x8 b10 = *(const PG8_LAS bf16x8*)(lds + sb_ + 16384 + h_ * 8192 + boff + 2048), b11 = *(const PG8_LAS bf16x8*)(lds + sb_ + 16384 + h_ * 8192 + boff + 3072); \
                asm volatile("s_waitcnt lgkmcnt(0)" ::: "memory"); __builtin_amdgcn_sched_barrier(0); \
                acc[0] = __builtin_amdgcn_mfma_f32_16x16x32_bf16(b00, a0, acc[0], 0, 0, 0); acc[1] = __builtin_amdgcn_mfma_f32_16x16x32_bf16(b10, a0, acc[1], 0, 0, 0); \
                acc[0] = __builtin_amdgcn_mfma_f32_16x16x32_bf16(b01, a1, acc[0], 0, 0, 0); acc[1] = __builtin_amdgcn_mfma_f32_16x16x32_bf16(b11, a1, acc[1], 0, 0, 0); } \
            AFTER_STEP(kt); } \
        asm volatile("s_waitcnt lgkmcnt(0)" ::: "memory"); __builtin_amdgcn_s_barrier(); asm volatile("" ::: "memory"); } while (0)
#define TL_SETUP(LDA, LDB) using namespace pg8; int tid_ = tidp; asm volatile("" : "+v"(tid_)); \
    const int tid = tid_, wid = __builtin_amdgcn_readfirstlane(tid >> 6), lane = tid & 63, fr = lane & 15, fq = lane >> 4, mt = wid >> 1, nh = wid & 1; \
    int R_, C_; stage_rc(tid * 16, R_, C_); \
    const unsigned voffA = (unsigned)(R_ * (LDA) + C_) * 2u, voffB = (unsigned)(R_ * (LDB) + C_) * 2u, ldsw = (unsigned)wid * 1024u; \
    const int aoff = lds_byte(mt * 16 + fr, fq * 8), boff = lds_byte(nh * 32 + fr, fq * 8); (void)lane
#define TL_NOP(kt_) do {} while (0)

struct CappedOrder : pg8::StaticOrder {
    int cap;
    __device__ bool next(int i, pg8::Unit& u) const { if ((long)i * G + c >= cap) return false; return pg8::StaticOrder::next(i, u); }
};
__device__ __forceinline__ void proj_tail_phase(LAS unsigned char* lds, const bf16* A, const bf16* Bt, int cap, const float* ssq, const float* bgate, bf16* PMp, unsigned char* GTp, int G, int bid, int tidp) {
    TL_SETUP(D, D);
    StaticOrder S1; S1.init(M, INC, 1, 0);
    const int nsub = (S1.nwg - cap) * 16;
    for (int t = bid; t < nsub; t += G) {
        Unit u; S1.next(cap + (t >> 4), u);
        const int rb = (t >> 2) & 3, cb = t & 3, r0 = u.pm * 256 + 64 * rb, c0 = u.pn * 256 + 64 * cb;
        const char* Ab = (const char*)A + (size_t)r0 * D * 2; const char* Bb = (const char*)Bt + (size_t)c0 * D * 2;
        f32x4 acc[2] = {(f32x4){0.f, 0.f, 0.f, 0.f}, (f32x4){0.f, 0.f, 0.f, 0.f}};
        const int row = r0 + 16 * mt + fr;
        const float rs = pg8::row_rstd(ssq, row);
        const bool isg = u.pn >= 7;
        f32x4 bvv[2];
#pragma unroll
        for (int n = 0; n < 2; ++n) bvv[n] = isg ? *(const f32x4*)(bgate + (c0 + 32 * nh + 16 * n + 4 * fq - PMC)) : (f32x4){0.f, 0.f, 0.f, 0.f};
#define PT_A(kt_) (Ab + (size_t)(kt_) * 256)
#define PT_B(kt_) (Bb + (size_t)(kt_) * 256)
        TL_LOOP(D / 128, PT_A, PT_B, TL_NOP);
#undef PT_A
#undef PT_B
#pragma unroll
        for (int n = 0; n < 2; ++n) { const int col = c0 + 32 * nh + 16 * n + 4 * fq; f32x4 v = acc[n] * rs;
            if (isg) { const f32x4 t = (v + bvv[n]) * -1.4426950408889634f;
                *(unsigned*)(GTp + (size_t)row * GTC + (col - PMC)) = pg8::pack_u8x4(pg8::sig255(t[0]), pg8::sig255(t[1]), pg8::sig255(t[2]), pg8::sig255(t[3])); }
            else { v2u w; w.x = pk2(v[0], v[1]); w.y = pk2(v[2], v[3]); *(v2u*)(PMp + (size_t)row * PMC + col) = w; } }
    }
}

__device__ __forceinline__ void gemm2_tail_phase(LAS unsigned char* lds, const bf16* BRp, const bf16* WBT, const unsigned char* GT, bf16* MG, int G, int bid, int tidp) {
    TL_SETUP(D, MIXW);
    for (int ui = bid; ui < 256; ui += G) {
        const int rb = ((ui & 7) >> 1) * 4 + (ui >> 6), cb = (ui & 1) * 8 + ((ui >> 3) & 7);
        const char* Ab = (const char*)BRp + (size_t)(MP + 64 * rb) * D * 2; const char* Bb = (const char*)WBT + (size_t)(64 * cb) * MIXW * 2;
        f32x4 acc[2] = {(f32x4){0.f, 0.f, 0.f, 0.f}, (f32x4){0.f, 0.f, 0.f, 0.f}}, mg[2] = {(f32x4){0.f, 0.f, 0.f, 0.f}, (f32x4){0.f, 0.f, 0.f, 0.f}};
        const int row = MP + 64 * rb + 16 * mt + fr;
#define G2T_A(kt_) (Ab + (size_t)(((kt_) >> 1) * 256 + ((kt_) & 1) * 128) * 2)
#define G2T_B(kt_) (Bb + (size_t)((kt_) >> 1) * (D * MIXW * 2) + (size_t)((kt_) & 1) * 256)
        unsigned gwp[4][2];
#pragma unroll
        for (int kb = 0; kb < 4; ++kb)
#pragma unroll
            for (int n = 0; n < 2; ++n) gwp[kb][n] = *(const unsigned*)(GT + (size_t)row * GTC + kb * D + 64 * cb + 32 * nh + 16 * n + 4 * fq);
#define G2T_AFTER(kt_) do { if ((kt_) & 1) { const int kb_ = (kt_) >> 1; \
            _Pragma("unroll") for (int n = 0; n < 2; ++n) { const unsigned gw = kb_ == 0 ? gwp[0][n] : (kb_ == 1 ? gwp[1][n] : (kb_ == 2 ? gwp[2][n] : gwp[3][n])); \
                mg[n][0] += (float)(gw & 0xffu) * acc[n][0]; mg[n][1] += (float)((gw >> 8) & 0xffu) * acc[n][1]; mg[n][2] += (float)((gw >> 16) & 0xffu) * acc[n][2]; mg[n][3] += (float)(gw >> 24) * acc[n][3]; \
                acc[n] = (f32x4){0.f, 0.f, 0.f, 0.f}; } } } while (0)
        TL_LOOP(8, G2T_A, G2T_B, G2T_AFTER);
#undef G2T_A
#undef G2T_B
#undef G2T_AFTER
#pragma unroll
        for (int n = 0; n < 2; ++n) { const f32x4 mm = mg[n] * (1.0f / 255.0f); v2u w; w.x = pk2(mm[0], mm[1]); w.y = pk2(mm[2], mm[3]); *(v2u*)(MG + (size_t)row * D + 64 * cb + 32 * nh + 16 * n + 4 * fq) = w; }
    }
}

__device__ __forceinline__ void resid_tail_phase(LAS unsigned char* lds, const bf16* A, const bf16* Bt, int K, const float* xs_old, bool first, bf16* XBp, float* ssq, int G, int bid, int tidp) {
    TL_SETUP(K, K);
    const int nk = K / 128;
    for (int ui = bid; ui < 256; ui += G) {
        const int rb = ((ui & 7) >> 1) * 4 + (ui >> 6), cb = (ui & 1) * 8 + ((ui >> 3) & 7);
        const char* Ab = (const char*)A + (size_t)(MP + 64 * rb) * K * 2; const char* Bb = (const char*)Bt + (size_t)(64 * cb) * K * 2;
        f32x4 acc[2] = {(f32x4){0.f, 0.f, 0.f, 0.f}, (f32x4){0.f, 0.f, 0.f, 0.f}};
        const int rowl = 16 * mt + fr, row = MP + 64 * rb + rowl; float ss = 0.f;
        f32x4 xold[2];
#pragma unroll
        for (int n = 0; n < 2; ++n) { const int col = 64 * cb + 32 * nh + 16 * n + 4 * fq;
            if (first) xold[n] = *(const f32x4*)(xs_old + (size_t)(row - MP) * D + col);
            else { const v2u q = *(const v2u*)(XBp + (size_t)row * D + col); xold[n] = (f32x4){bflo(q.x), bfhi(q.x), bflo(q.y), bfhi(q.y)}; } }
#define RT_A(kt_) (Ab + (size_t)(kt_) * 256)
#define RT_B(kt_) (Bb + (size_t)(kt_) * 256)
        TL_LOOP(nk, RT_A, RT_B, TL_NOP);
#undef RT_A
#undef RT_B
#pragma unroll
        for (int n = 0; n < 2; ++n) { const int col = 64 * cb + 32 * nh + 16 * n + 4 * fq;
            const f32x4 o = xold[n] + acc[n];
            v2u w; w.x = pk2(o[0], o[1]); w.y = pk2(o[2], o[3]); *(v2u*)(XBp + (size_t)row * D + col) = w;
            ss += (o[0] * o[0] + o[1] * o[1]) + (o[2] * o[2] + o[3] * o[3]); }
        ss += __shfl_xor(ss, 16); ss += __shfl_xor(ss, 32);
        LAS float* red = (LAS float*)lds;
        if (fq == 0) red[rowl * 2 + nh] = ss;
        __syncthreads();
        if (tid < 64) ssq[((size_t)(cb >> 2) * M + MP + 64 * rb + tid) * 4 + (cb & 3)] = red[tid * 2] + red[tid * 2 + 1];
        __syncthreads();
    }
}

#ifndef PROBE_REP_B
#define PROBE_REP_B 1
#endif
#ifndef PROBE_REP_C
#define PROBE_REP_C 1
#endif
#ifndef PROBE_REP_D
#define PROBE_REP_D 1
#endif
#ifndef PROBE_REP_P0
#define PROBE_REP_P0 1
#endif
__global__ void __launch_bounds__(NWAVES * 64, 2) hybrid_fwd(Args args) {
    extern __shared__ __attribute__((aligned(16))) unsigned char lds_raw[];
    LAS unsigned char* lds = (LAS unsigned char*)lds_raw;
    volatile LAS unsigned* MISC = (volatile LAS unsigned*)(lds + MISC_OFF);
    const int tid0 = threadIdx.x, wave0 = __builtin_amdgcn_readfirstlane(tid0 >> 6);
    const int G0 = gridDim.x, bid = blockIdx.x;
    unsigned char* ws = args.ws;
    for (int u = tid0; u < (LDS_BYTES - LDSCTL_OFF) / 4; u += NWAVES * 64) ((LAS unsigned*)(lds + LDSCTL_OFF))[u] = 0u;
    __syncthreads();
    const int lo = args.ph_lo, hi = args.ph_hi;
    XcdBarrier bar; bar.bar = (unsigned*)(ws + WS_CTL) + CW_BAR; bar.x = 0; bar.st = nullptr;
    if (hi - lo > 1) bar = xcd_barrier_post((unsigned*)(ws + WS_CTL) + CW_BAR, MISC + 8);
    bf16* XB = (bf16*)(ws + WS_ACT1); bf16* PMb = (bf16*)(ws + WS_PM); unsigned char* GTb = ws + WS_GT;
    bf16* MGb = (bf16*)(ws + WS_PM); bf16* ACTb = (bf16*)(ws + WS_GT);
    float* ssq = (float*)(ws + WS_SSQ);
    for (int ph_i = lo; ph_i < hi; ++ph_i) {
#ifdef DBG_T_PH
        if (ph_i == DBG_T_PH && bid == DBG_T_BLK && wave0 == 0 && __builtin_amdgcn_mbcnt_lo(~0u, 0u) == 0u) { ((volatile LAS unsigned long long*)(lds + MISC_OFF + 256))[0] = __builtin_amdgcn_s_memtime(); ((volatile LAS unsigned long long*)(lds + MISC_OFF + 256))[1] = __builtin_amdgcn_s_memrealtime(); }
#endif
        int ph = ph_i, G = G0; asm volatile("" : "+s"(ph), "+s"(G));
        unsigned z_ = 0u; asm volatile("" : "+v"(z_));
        int tid = wave0 * 64 + (int)__builtin_amdgcn_mbcnt_hi(~0u, __builtin_amdgcn_mbcnt_lo(~0u, z_)); asm volatile("" : "+v"(tid)); const int lane = tid & 63, wave = __builtin_amdgcn_readfirstlane(tid >> 6);
        const int layer = (ph - 1) / 7, k = ph == 0 ? -1 : (ph == NPHASE - 1 ? 7 : (ph - 1) % 7);
        if (k == -1) for (int rep_ = 0; rep_ < PROBE_REP_P0; ++rep_) p0_prologue(args, lds, tid, lane, wave, G, bid);
        else if (k == 7) final_norm(args, lane, wave, G, bid);
        else if (k == 0) {
            pg8::Gemm g{XB, (const bf16*)(ws + WS_WIN) + (size_t)layer * INC * D, M, INC, D}; CappedOrder S; S.init(M, INC, G, bid); S.cap = (S.nwg / G) * G;
            pg8::EpiProj E{PMb, GTb, ssq, args.in[I_BGATE] + (size_t)layer * GTC, (const LAS float*)(lds + RING_OFF + pg8::RSTD_LDS_OFF)};
            pg8::gemm_phase<pg8::EpiProj, CappedOrder, true, true>(lds + RING_OFF, g, S, E, tid);
            proj_tail_phase(lds + RING_OFF, XB, (const bf16*)(ws + WS_WIN) + (size_t)layer * INC * D, S.cap, ssq, args.in[I_BGATE] + (size_t)layer * GTC, PMb, GTb, G, bid, tid);
            if (!MK_PER_PHASE && G == 256 && bid >= P0_A_BID0 && layer + 1 < NLAYER) p0_idle_items(args, lds, lane, wave, bid, layer + 1, 0, P0_A_BID0, P0_A_PER);
#ifdef PROBE_A_SAME
            { SameTileOrder S2; S2.init(M, INC, G, bid); pg8::EpiNull EN_; pg8::gemm_phase<pg8::EpiNull, SameTileOrder, true, true>(lds + RING_OFF, g, S2, EN_, tid); }
#endif
#ifdef PROBE_A_NULL
            { pg8::EpiNull EN_; pg8::gemm_phase<pg8::EpiNull, CappedOrder, true, true>(lds + RING_OFF, g, S, EN_, tid); }
#endif
#ifdef PROBE_A_FULL
            pg8::gemm_phase<pg8::EpiProj, CappedOrder, true, true>(lds + RING_OFF, g, S, E, tid);
#endif
        } else if (k == 1) for (int rep_ = 0; rep_ < PROBE_REP_B; ++rep_) {
            for (int s_ = 0; ; ++s_) { int u; bool donor = false;
                if (G == 256) { if (s_ > 2) break;
                    donor = bid < 16 || (bid >= 80 && bid < 152);
                    if (s_ == 0) u = 272 + ((bid + 240) & 255);
                    else if (bid < 16) { if (s_ == 2) break; u = 256 + bid; }
                    else if (bid < 80) { if (s_ == 2) break; u = 528 + (bid - 16); }
                    else if (s_ == 1 || bid < 152) { const int v = (s_ == 1 ? 0 : 176) + (bid - 80); u = (v / 31) * 32 + v % 31; }
                    else if (bid < 240) { const int t_ = bid - 152, db = t_ < 16 ? t_ : 80 + (t_ - 16); u = 592 + ((db + 240) & 255); }
                    else break; }
                else { u = bid + s_ * G; if (u >= 256 + 16 + 256 + 64) break; }
                if (u < 256) { if ((u & 31) != NCH - 1) ssm_unit<0>(args, layer, u, lds, tid, lane, wave); }
                else if (u < 272) ssm_unit<2>(args, layer, u - 256, lds, tid, lane, wave);
                else if (u < 528 || u >= 592) mix_unit<false>(args, layer, u < 528 ? u - 272 : u - 592, lds, tid, lane, wave, u >= 592 ? 4 : (donor ? 3 : 7));
                else mix_unit<true>(args, layer, u - 528, lds, tid, lane, wave, 7);
            }
        } else if (k == 2) for (int rep_ = 0; rep_ < PROBE_REP_C; ++rep_) {
            for (int u = bid; u < 256; u += G) ssm_unit<1>(args, layer, u, lds, tid, lane, wave);
        } else if (k == 3) for (int rep_ = 0; rep_ < PROBE_REP_D; ++rep_) {
            gemm2_phase(lds + RING_OFF, (const bf16*)args.out, (const bf16*)(ws + WS_WBR) + (size_t)layer * 4 * D * MIXW, GTb, MGb, G, bid, tid);
            gemm2_tail_phase(lds + RING_OFF, (const bf16*)args.out, (const bf16*)(ws + WS_WBR) + (size_t)layer * 4 * D * MIXW, GTb, MGb, G, bid, tid);
        } else if (k == 5) {
            pg8::Gemm g{XB, (const bf16*)(ws + WS_WFI) + (size_t)layer * 2 * FF * D, M, 2 * FF, D}; pg8::StaticOrder S; S.init(M, 2 * FF, G, bid);
            pg8::EpiSwiGLU E{ACTb, ssq, (const LAS float*)(lds + RING_OFF + pg8::RSTD_LDS_OFF)};
            pg8::gemm_phase<pg8::EpiSwiGLU, pg8::StaticOrder, true, true>(lds + RING_OFF, g, S, E, tid);
            if (!MK_PER_PHASE && G == 256 && bid >= P0_F_BID0 && layer + 1 < NLAYER) p0_idle_items(args, lds, lane, wave, bid, layer + 1, p0_items_A(G), P0_F_BID0, P0_F_PER);
        } else {
            const bool isE = k == 4; const int K = isE ? D : FF;
            const bf16* Ap = isE ? MGb : ACTb; const bf16* Bp = isE ? (const bf16*)(ws + WS_WOUT) + (size_t)layer * D * D : (const bf16*)(ws + WS_WFO) + (size_t)layer * D * FF;
            const bool first = isE && layer == 0;
            { pg8::Gemm g{Ap, Bp, MP, D, K}; pg8::StaticOrder S; S.init(MP, D, G, bid);
              pg8::EpiResid E{args.in[I_XP], args.in[I_XS], first, XB, ssq};
              pg8::gemm_phase<pg8::EpiResid, pg8::StaticOrder, true, true>(lds + RING_OFF, g, S, E, tid); }
#ifdef DBG_T_TAIL
            if (ph == DBG_T_PH && bid == DBG_T_BLK && tid == 0) ((volatile LAS unsigned long long*)(lds + MISC_OFF + 256))[9] = __builtin_amdgcn_s_memrealtime();
#endif
            resid_tail_phase(lds + RING_OFF, Ap, Bp, K, args.in[I_XS], first, XB, ssq, G, bid, tid);
#ifdef DBG_T_TAIL
            if (ph == DBG_T_PH && bid == DBG_T_BLK && tid == 0) ((volatile LAS unsigned long long*)(lds + MISC_OFF + 256))[10] = __builtin_amdgcn_s_memrealtime();
#endif
        }
#ifdef DBG_T_PH
        if (ph == DBG_T_PH && bid == DBG_T_BLK && tid == 0) { ((volatile LAS unsigned long long*)(lds + MISC_OFF + 256))[2] = __builtin_amdgcn_s_memtime(); ((volatile LAS unsigned long long*)(lds + MISC_OFF + 256))[3] = __builtin_amdgcn_s_memrealtime(); }
#endif
        if (ph_i + 1 < hi) {
            asm volatile("s_waitcnt vmcnt(0)" ::: "memory"); __syncthreads();
            if (tid == 0) xcd_barrier_leader(bar);
            else if (!MK_PER_PHASE && wave != 0 && k >= 0 && k < P0_SLICES && layer + 1 < NLAYER) p0_slice(args, lds, lane, wave, G, bid, layer + 1, k);
            __syncthreads();
        }
#ifdef PROBE_XBAR
        if (ph_i == 8) for (int i_ = 0; i_ < PROBE_XBAR; ++i_) xcd_barrier(bar, tid == 0);
#endif
#if defined(DBG_T_PH) && defined(DBG_T_AFTERBAR)
        if (ph == DBG_T_PH && bid == DBG_T_BLK && tid == 0) { ((volatile LAS unsigned long long*)(lds + MISC_OFF + 256))[2] = __builtin_amdgcn_s_memtime(); ((volatile LAS unsigned long long*)(lds + MISC_OFF + 256))[3] = __builtin_amdgcn_s_memrealtime(); }
#endif
    }
#ifdef DBG_T_PH
    if (bid == DBG_T_BLK && wave0 == 0 && __builtin_amdgcn_mbcnt_lo(~0u, 0u) == 0u) {
        volatile LAS unsigned long long* ts_ = (volatile LAS unsigned long long*)(lds + MISC_OFF + 256);
        const unsigned long long dc = ts_[2] - ts_[0], dr = ts_[3] - ts_[1];
        unsigned long long val = DBG_T_MODE == 11 ? (ts_[16 + DBG_TB] - ts_[16 + DBG_TA]) : DBG_T_MODE == 8 ? (ts_[5] - ts_[1])   : DBG_T_MODE == 9 ? (ts_[3] - ts_[7])   : DBG_T_MODE == 10 ? (ts_[7] - ts_[5])   : DBG_T_MODE == 7 ? (ts_[10] - ts_[9])   : DBG_T_MODE == 5 ? (ts_[8] - ts_[4]) / 16ull   : DBG_T_MODE == 3 ? (ts_[6] - ts_[4]) / 16ull   : DBG_T_MODE == 4 ? (ts_[7] - ts_[5]) * 10ull   : DBG_T_MODE == 0 ? (dc * 100ull) / (dr ? dr : 1ull)      : DBG_T_MODE == 1 ? dr   : dc / 1000ull;
        const unsigned long long t0 = __builtin_amdgcn_s_memrealtime();
        while (__builtin_amdgcn_s_memrealtime() - t0 < val * 100ull) __builtin_amdgcn_s_sleep(16);
    }
#endif
}

extern "C" void kernel_launch(void* const* d_in, const int* in_sizes, int n_in, void* d_out, int out_size, void* d_ws, size_t ws_size, hipStream_t stream) {
    static int grid = 0;
    if (grid == 0) {
        if (n_in != 32 || out_size != (int)O_END || ws_size < WS_END) { fprintf(stderr, "kernel_launch: expected 32 inputs, %zu outputs, >= %zu bytes of workspace; got %d, %d, %zu; nothing launched\n", (size_t)O_END, (size_t)WS_END, n_in, out_size, ws_size); grid = -1; return; }
        int dev = 0, cus = 0, per_cu = 0;
        if (hipGetDevice(&dev) != hipSuccess || hipDeviceGetAttribute(&cus, hipDeviceAttributeMultiprocessorCount, dev) != hipSuccess) { grid = -1; return; }
        if (hipFuncSetAttribute((const void*)hybrid_fwd, hipFuncAttributeMaxDynamicSharedMemorySize, LDS_BYTES) != hipSuccess) { fprintf(stderr, "kernel_launch: hipFuncSetAttribute failed\n"); grid = -1; return; }
        if (hipOccupancyMaxActiveBlocksPerMultiprocessor(&per_cu, (const void*)hybrid_fwd, NWAVES * 64, LDS_BYTES) != hipSuccess || per_cu < 1) { fprintf(stderr, "kernel_launch: occupancy query says %d blocks per CU; nothing launched\n", per_cu); (void)hipGetLastError(); grid = -1; return; }
        grid = cus;
    }
    if (grid < 0) return;
    (void)hipMemsetAsync((char*)d_ws + WS_CTL, 0, CTL_ZERO_BYTES, stream);
    Args a{};
    for (int i = 0; i < 32; ++i) a.in[i] = (const float*)d_in[i];
    a.out = (float*)d_out; a.ws = (unsigned char*)d_ws;
#if MK_PER_PHASE
    for (int k = 0; k < NPHASE; ++k) { a.ph_lo = k; a.ph_hi = k + 1; hipLaunchKernelGGL(hybrid_fwd, dim3(grid), dim3(NWAVES * 64), LDS_BYTES, stream, a); }
#else
    a.ph_lo = 0; a.ph_hi = NPHASE;
    hipLaunchKernelGGL(hybrid_fwd, dim3(grid), dim3(NWAVES * 64), LDS_BYTES, stream, a);
#endif
}
```

```cpp
#include <hip/hip_runtime.h>
#include <cstdio>
#include <cstdint>
#ifndef XPF_LEAD
#define XPF_LEAD 2
#endif
namespace pg8 {
#define PG8_LAS __attribute__((address_space(3)))
typedef unsigned short bf16_t;
typedef short bf16x8 __attribute__((ext_vector_type(8)));
typedef float f32x4 __attribute__((ext_vector_type(4)));
typedef unsigned u32x4 __attribute__((ext_vector_type(4)));
constexpr int BM = 256, BK = 64, HALF = 128, HTB = HALF * BK * 2  , STAGE_BYTES = 8 * HTB, NXCD = 8, WGM = 8, RSTD_LDS_OFF = 147456 + 320 + 1024  , RSTD_RAW_OFF = RSTD_LDS_OFF + 1024  , BIAS_LDS_OFF = RSTD_RAW_OFF + 8192  ;

__host__ __device__ __forceinline__ int lds_byte(int r, int c) { const int st = (r >> 4) * 2 + (c >> 5), rr = r & 15, cc = c & 31, ob = rr * 64 + cc * 2; return st * 1024 + (ob ^ (((ob >> 9) & 1) << 5)); }
__host__ __device__ __forceinline__ void stage_rc(int b, int& R, int& C) { const int st = b / 1024, sb = b % 1024, swz = sb ^ (((sb >> 9) & 1) << 5); R = (st >> 1) * 16 + swz / 64; C = (st & 1) * 32 + (swz % 64) / 2; }
__host__ __device__ __forceinline__ int perm32(int rho) { const int n = rho >> 4, i = rho & 15; return 8 * (i >> 2) + 4 * n + (i & 3); }

struct Unit { int pm, pn; };
struct Gemm { const bf16_t* A; const bf16_t* Bt; int M, N, K; };

struct StaticOrder {
    int nM, nN, nwg, G, c;
    __host__ __device__ void init(int M, int N, int G_, int c_) { nM = M / BM; nN = N / BM; nwg = nM * nN; G = G_; c = c_; }
    __host__ __device__ bool next(int i, Unit& u) const {
        const long L = (long)i * G + c; if (L >= nwg) return false;
        int wgid = (int)L; { const int q = nwg / NXCD, r = nwg % NXCD, xcd = wgid % NXCD, off = wgid / NXCD; wgid = (xcd < r ? xcd * (q + 1) : r * (q + 1) + (xcd - r) * q) + off; }
        const int nig = WGM * nN, gid = wgid / nig, fm = gid * WGM, gsz = (nM - fm) < WGM ? (nM - fm) : WGM;
        u.pm = fm + ((wgid % nig) % gsz); u.pn = (wgid % nig) / gsz; return true;
    }
    __device__ __forceinline__ void a_ready(const Unit&) const {}
    __device__ __forceinline__ void done(const Unit&) const {}
};
typedef float f32x2 __attribute__((ext_vector_type(2)));
typedef __bf16 bf16x2_t __attribute__((ext_vector_type(2)));
__device__ __forceinline__ unsigned cvt_pk_bf16(float lo, float hi) { f32x2 v = {lo, hi}; bf16x2_t b = __builtin_convertvector(v, bf16x2_t); return __builtin_bit_cast(unsigned, b); }
__device__ __forceinline__ float sigm(float x) { return __builtin_amdgcn_rcpf(1.0f + __builtin_amdgcn_exp2f(-1.4426950408889634f * x)); }
__device__ __forceinline__ float row_rstd(const float* ssq, int row) {
    const f32x4 a = *(const f32x4*)(ssq + ((size_t)0 * 17408 + row) * 4), b = *(const f32x4*)(ssq + ((size_t)1 * 17408 + row) * 4),
                c = *(const f32x4*)(ssq + ((size_t)2 * 17408 + row) * 4), d = *(const f32x4*)(ssq + ((size_t)3 * 17408 + row) * 4);
    const float s = (((a[0] + a[1]) + (a[2] + a[3])) + ((b[0] + b[1]) + (b[2] + b[3]))) + (((c[0] + c[1]) + (c[2] + c[3])) + ((d[0] + d[1]) + (d[2] + d[3])));
    return __builtin_amdgcn_rsqf(s * (1.0f / 1024.0f) + 1e-6f);
}
__device__ __forceinline__ void rows_rstd(const float* ssq, int row0, int fq, float (&rs)[2][4]) {
#pragma unroll
    for (int ai = 0; ai < 2; ++ai)
#pragma unroll
        for (int m = 0; m < 4; ++m) { const f32x4 p = *(const f32x4*)(ssq + ((size_t)fq * 17408 + row0 + ai * HALF + m * 16) * 4); rs[ai][m] = (p[0] + p[1]) + (p[2] + p[3]); }
#pragma unroll
    for (int ai = 0; ai < 2; ++ai)
#pragma unroll
        for (int m = 0; m < 4; ++m) { float s = rs[ai][m]; s += __shfl_xor(s, 16); s += __shfl_xor(s, 32); rs[ai][m] = __builtin_amdgcn_rsqf(s * (1.0f / 1024.0f) + 1e-6f); }
}
__device__ __forceinline__ void rows_rstd_lds(const PG8_LAS float* rl, int r0, float (&rs)[2][4]) {
#pragma unroll
    for (int ai = 0; ai < 2; ++ai)
#pragma unroll
        for (int m = 0; m < 4; ++m) rs[ai][m] = rl[r0 + ai * HALF + m * 16];
}
struct EpiNull {
    static constexpr bool PERM = true, AFTER_DRAIN = false, RSTD_LDS = false, XPREFETCH = false;
    __device__ __forceinline__ void operator()(const f32x4 (&acc)[2][2][4][2], const Unit& u, int wr, int wc, int fr, int fq) const {
#pragma unroll
        for (int ai = 0; ai < 2; ++ai)
#pragma unroll
            for (int bj = 0; bj < 2; ++bj)
#pragma unroll
                for (int m = 0; m < 4; ++m) { asm volatile("" :: "v"(acc[ai][bj][m][0]), "v"(acc[ai][bj][m][1])); }
    }
};
__device__ __forceinline__ unsigned pack_u8x4(float a, float b, float c, float d) {
    unsigned w = 0u; w = __builtin_amdgcn_cvt_pk_u8_f32(a, 0u, w); w = __builtin_amdgcn_cvt_pk_u8_f32(b, 1u, w); w = __builtin_amdgcn_cvt_pk_u8_f32(c, 2u, w); w = __builtin_amdgcn_cvt_pk_u8_f32(d, 3u, w); return w; }
__device__ __forceinline__ float sig255(float t) { return __builtin_amdgcn_rcpf(__builtin_fmaf(__builtin_amdgcn_exp2f(t), 1.0f / 255.0f, 1.0f / 255.0f)); }
struct EpiProj {
    static constexpr bool PERM = true, AFTER_DRAIN = false, RSTD_LDS = true, XPREFETCH = false;
    bf16_t* PM; unsigned char* GT; const float* ssq; const float* bgate; const PG8_LAS float* rl;
    __device__ __forceinline__ void operator()(const f32x4 (&acc)[2][2][4][2], const Unit& u, int wr, int wc, int fr, int fq) const {
        const int row0 = u.pm * BM + wr * 64 + fr;
        float rsv[2][4]; rows_rstd_lds(rl, wr * 64 + fr, rsv);
        if (u.pn >= 7) {
            constexpr float NL2E = -1.4426950408889634f;
            const int lc0 = (u.pn - 7) * BM + wc * 32 + 8 * fq;
            f32x4 bv[2][2];
#pragma unroll
            for (int bj = 0; bj < 2; ++bj)
#pragma unroll
                for (int n = 0; n < 2; ++n) bv[bj][n] = *(const f32x4*)(bgate + lc0 + bj * HALF + 4 * n) * NL2E;
#pragma unroll
            for (int ai = 0; ai < 2; ++ai)
#pragma unroll
                for (int m = 0; m < 4; ++m) { const int row = row0 + ai * HALF + m * 16;
                    const float rs = rsv[ai][m] * NL2E;
                    unsigned char* rowp = GT + (size_t)row * 4096 + lc0;
#pragma unroll
                    for (int bj = 0; bj < 2; ++bj) { const f32x4 v0 = acc[ai][bj][m][0] * rs + bv[bj][0], v1 = acc[ai][bj][m][1] * rs + bv[bj][1];
                        typedef unsigned u32x2_t __attribute__((ext_vector_type(2)));
                        u32x2_t w; w.x = pack_u8x4(sig255(v0[0]), sig255(v0[1]), sig255(v0[2]), sig255(v0[3])); w.y = pack_u8x4(sig255(v1[0]), sig255(v1[1]), sig255(v1[2]), sig255(v1[3]));
                        *(u32x2_t*)(rowp + bj * HALF) = w; } }
        } else {
            const int lc0 = u.pn * BM + wc * 32 + 8 * fq;
#pragma unroll
            for (int ai = 0; ai < 2; ++ai)
#pragma unroll
                for (int m = 0; m < 4; ++m) { const int row = row0 + ai * HALF + m * 16;
                    const float rs = rsv[ai][m];
                    bf16_t* rowp = PM + (size_t)row * 1792 + lc0;
#pragma unroll
                    for (int bj = 0; bj < 2; ++bj) { const f32x4 v0 = acc[ai][bj][m][0] * rs, v1 = acc[ai][bj][m][1] * rs;
                        u32x4 w; w.x = cvt_pk_bf16(v0[0], v0[1]); w.y = cvt_pk_bf16(v0[2], v0[3]); w.z = cvt_pk_bf16(v1[0], v1[1]); w.w = cvt_pk_bf16(v1[2], v1[3]);
                        *(u32x4*)(rowp + bj * HALF) = w; } }
        }
    }
};
struct EpiResid {
    static constexpr bool PERM = true, AFTER_DRAIN = false, RSTD_LDS = false, XPREFETCH = true;
    const float* xp; const float* xs; bool first; bf16_t* XB; float* ssq;
    __device__ __forceinline__ void prefetch(const Unit& u, PG8_LAS unsigned char* dump, int tid) const {
        if (first) return;
        const unsigned vo = (unsigned)(tid >> 2) * 2048u + (unsigned)(tid & 3) * 128u;
        const char* base = (const char*)(XB + (size_t)u.pm * BM * 1024 + u.pn * BM);
        __builtin_amdgcn_global_load_lds((const unsigned*)(base + vo), (PG8_LAS unsigned*)dump, 4, 0, 0);
        __builtin_amdgcn_global_load_lds((const unsigned*)(base + (size_t)128 * 2048 + vo), (PG8_LAS unsigned*)dump, 4, 0, 0);
    }
    __device__ __forceinline__ void operator()(const f32x4 (&acc)[2][2][4][2], const Unit& u, int wr, int wc, int fr, int fq) const {
        const int row0 = u.pm * BM + wr * 64 + fr, col0 = u.pn * BM + wc * 32 + 8 * fq;
#pragma unroll
        for (int ai = 0; ai < 2; ++ai)
#pragma unroll
            for (int m = 0; m < 4; ++m) { const int row = row0 + ai * HALF + m * 16;
                bf16_t* dstb = XB + (size_t)row * 1024 + col0; float ss = 0.f;
                f32x4 x0[2], x1[2];
                if (first) { const float* src = (row < 16384 ? xp + (size_t)row * 1024 : xs + (size_t)(row - 16384) * 1024) + col0;
#pragma unroll
                    for (int bj = 0; bj < 2; ++bj) { x0[bj] = *(const f32x4*)(src + bj * HALF); x1[bj] = *(const f32x4*)(src + bj * HALF + 4); } }
                else {
#pragma unroll
                    for (int bj = 0; bj < 2; ++bj) { const u32x4 q = *(const u32x4*)(dstb + bj * HALF);
                        x0[bj] = (f32x4){__builtin_bit_cast(float, q.x << 16), __builtin_bit_cast(float, q.x & 0xffff0000u), __builtin_bit_cast(float, q.y << 16), __builtin_bit_cast(float, q.y & 0xffff0000u)};
                        x1[bj] = (f32x4){__builtin_bit_cast(float, q.z << 16), __builtin_bit_cast(float, q.z & 0xffff0000u), __builtin_bit_cast(float, q.w << 16), __builtin_bit_cast(float, q.w & 0xffff0000u)}; } }
#pragma unroll
                for (int bj = 0; bj < 2; ++bj) { const f32x4 o0 = x0[bj] + acc[ai][bj][m][0], o1 = x1[bj] + acc[ai][bj][m][1];
                    u32x4 w; w.x = cvt_pk_bf16(o0[0], o0[1]); w.y = cvt_pk_bf16(o0[2], o0[3]); w.z = cvt_pk_bf16(o1[0], o1[1]); w.w = cvt_pk_bf16(o1[2], o1[3]);
                    *(u32x4*)(dstb + bj * HALF) = w;
                    ss += ((o0[0] * o0[0] + o0[1] * o0[1]) + (o0[2] * o0[2] + o0[3] * o0[3])) + ((o1[0] * o1[0] + o1[1] * o1[1]) + (o1[2] * o1[2] + o1[3] * o1[3])); }
                ss += __shfl_xor(ss, 16); ss += __shfl_xor(ss, 32);
                if (fq == 0) ssq[((size_t)u.pn * 17408 + row) * 4 + wc] = ss; }
    }
};
struct EpiSwiGLU {
    static constexpr bool PERM = true, AFTER_DRAIN = false, RSTD_LDS = true, XPREFETCH = false;
    bf16_t* ACT; const float* ssq; const PG8_LAS float* rl;
    __device__ __forceinline__ void operator()(const f32x4 (&acc)[2][2][4][2], const Unit& u, int wr, int wc, int fr, int fq) const {
        const int row0 = u.pm * BM + wr * 64 + fr, col0 = u.pn * HALF + wc * 32 + 8 * fq;
        float rsv[2][4]; rows_rstd_lds(rl, wr * 64 + fr, rsv);
#pragma unroll
        for (int ai = 0; ai < 2; ++ai)
#pragma unroll
            for (int m = 0; m < 4; ++m) { const int row = row0 + ai * HALF + m * 16;
                const float rs = rsv[ai][m], rsn = rs * -1.4426950408889634f, rs2 = rs * rs;
                float o[8];
#pragma unroll
                for (int j = 0; j < 4; ++j) { const float a0 = acc[ai][0][m][0][j], a1 = acc[ai][0][m][1][j];
                    o[j] = (a0 * acc[ai][1][m][0][j]) * (__builtin_amdgcn_rcpf(1.0f + __builtin_amdgcn_exp2f(a0 * rsn)) * rs2); o[4 + j] = (a1 * acc[ai][1][m][1][j]) * (__builtin_amdgcn_rcpf(1.0f + __builtin_amdgcn_exp2f(a1 * rsn)) * rs2); }
                u32x4 w; w.x = cvt_pk_bf16(o[0], o[1]); w.y = cvt_pk_bf16(o[2], o[3]); w.z = cvt_pk_bf16(o[4], o[5]); w.w = cvt_pk_bf16(o[6], o[7]);
                *(u32x4*)(ACT + (size_t)row * 2816 + col0) = w; }
    }
};

template <class Epi, class Sched, bool ALIGN_EPI = false, bool SP2 = false>
__device__ __forceinline__ void gemm_phase(PG8_LAS unsigned char* lds, const Gemm g, const Sched& S, const Epi& E, int tidp) {
    int tid_ = tidp; asm volatile("" : "+v"(tid_));
    const int tid = tid_, wid = __builtin_amdgcn_readfirstlane(tid >> 6), lane = tid & 63, wr = wid >> 2, wc = wid & 3, fr = lane & 15, fq = lane >> 4;
    const int K = g.K, nt = K / BK;
    unsigned voffA[2], voffB[2];
#pragma unroll
    for (int i = 0; i < 2; ++i) { int R, C; stage_rc(tid * 16 + i * 8192, R, C); const int Rb = Epi::PERM ? ((R & ~31) + perm32(R & 31)) : R;
        voffA[i] = (unsigned)(R * K + C) * 2u; voffB[i] = (unsigned)(Rb * K + C) * 2u; }
    const size_t kstep = (size_t)(BK * 2);
    const size_t hstep = (size_t)HALF * K * 2;
    const size_t tstep = 2 * hstep;
    const unsigned ldsw = (unsigned)wid * 1024u;
    const int aoff = lds_byte(wr * 64 + fr, fq * 8), boff = lds_byte(wc * 32 + fr, fq * 8);
#define PG8_SA(b, h) (((b) * 2 + (h)) * HTB)
#define PG8_SB(b, h) ((4 + (b) * 2 + (h)) * HTB)
#define PG8_STAGE(bufoff, gbase, voff) do { _Pragma("unroll") for (int _i = 0; _i < 2; ++_i) \
        __builtin_amdgcn_global_load_lds((const unsigned*)((const char*)(gbase) + (voff)[_i]), (PG8_LAS unsigned*)(lds + (bufoff) + ldsw + _i * 8192), 16, 0, 0); } while (0)
#define PG8_LDA(dst, b, h) do { _Pragma("unroll") for (int m = 0; m < 4; ++m) _Pragma("unroll") for (int k = 0; k < 2; ++k) dst[m][k] = *(const PG8_LAS bf16x8*)(lds + PG8_SA(b, h) + aoff + m * 2048 + k * 1024); } while (0)
#define PG8_LDB(dst, b, h) do { _Pragma("unroll") for (int n = 0; n < 2; ++n) _Pragma("unroll") for (int k = 0; k < 2; ++k) dst[n][k] = *(const PG8_LAS bf16x8*)(lds + PG8_SB(b, h) + boff + n * 2048 + k * 1024); } while (0)
#define PG8_MMA(ai, bj, At, Bt) do { __builtin_amdgcn_s_setprio(1); _Pragma("unroll") for (int m = 0; m < 4; ++m) _Pragma("unroll") for (int n = 0; n < 2; ++n) _Pragma("unroll") for (int k = 0; k < 2; ++k) \
        acc[ai][bj][m][n] = __builtin_amdgcn_mfma_f32_16x16x32_bf16(Bt[n][k], At[m][k], acc[ai][bj][m][n], 0, 0, 0); __builtin_amdgcn_s_setprio(0); } while (0)
#define PG8_WAIT_V(n) asm volatile("s_waitcnt vmcnt(" #n ")" ::: "memory")
#define PG8_WAIT_L(n) asm volatile("s_waitcnt lgkmcnt(" #n ")" ::: "memory")
#define PG8_BAR __builtin_amdgcn_s_barrier()
#define PG8_SCHED __builtin_amdgcn_sched_barrier(0)
    Unit cur, nxt; int ui = 0;
    if (!S.next(0, cur)) return;
    f32x4 acc[2][2][4][2];
#pragma unroll
    for (int a = 0; a < 2; ++a)
#pragma unroll
        for (int b = 0; b < 2; ++b)
#pragma unroll
            for (int m = 0; m < 4; ++m)
#pragma unroll
                for (int n = 0; n < 2; ++n) acc[a][b][m][n] = (f32x4){0.f, 0.f, 0.f, 0.f};
    bf16x8 At[4][2], B0[2][2], B1[2][2];
    const char* cA = (const char*)g.A + (size_t)cur.pm * tstep; const char* cB = (const char*)g.Bt + (size_t)cur.pn * tstep;
    S.a_ready(cur);
    if constexpr (SP2) {
        PG8_STAGE(PG8_SB(0, 0), cB, voffB); PG8_STAGE(PG8_SB(0, 1), cB + hstep, voffB); PG8_STAGE(PG8_SA(0, 0), cA, voffA); PG8_STAGE(PG8_SA(0, 1), cA + hstep, voffA);
        if (wr == 1) PG8_BAR;
        PG8_WAIT_V(2); PG8_BAR;
        PG8_STAGE(PG8_SB(1, 0), cB + kstep, voffB); PG8_STAGE(PG8_SA(1, 0), cA + kstep, voffA); PG8_STAGE(PG8_SB(1, 1), cB + hstep + kstep, voffB);
        PG8_WAIT_V(6); PG8_BAR;
    } else {
        PG8_STAGE(PG8_SB(0, 0), cB, voffB); PG8_STAGE(PG8_SA(0, 0), cA, voffA); PG8_STAGE(PG8_SB(0, 1), cB + hstep, voffB); PG8_STAGE(PG8_SA(0, 1), cA + hstep, voffA);
        if (wr == 1) PG8_BAR;
        PG8_WAIT_V(4); PG8_BAR;
        PG8_STAGE(PG8_SB(1, 0), cB + kstep, voffB); PG8_STAGE(PG8_SA(1, 0), cA + kstep, voffA); PG8_STAGE(PG8_SB(1, 1), cB + hstep + kstep, voffB);
        PG8_WAIT_V(6); PG8_BAR;
    }
    for (;;) {
        const bool has_next = S.next(ui + 1, nxt);
        const char* nA = has_next ? (const char*)g.A + (size_t)nxt.pm * tstep : cA; const char* nB = has_next ? (const char*)g.Bt + (size_t)nxt.pn * tstep : cB;
#ifdef DBG_KLOOP_T
        if (ui == DBG_KLOOP_UNIT + 1 && blockIdx.x == DBG_T_BLK && tid == 0) { ((volatile PG8_LAS unsigned long long*)(lds + 147456 + 320 + 256))[8] = __builtin_amdgcn_s_memtime(); }
        if (ui == DBG_KLOOP_UNIT && blockIdx.x == DBG_T_BLK && tid == 0) { ((volatile PG8_LAS unsigned long long*)(lds + 147456 + 320 + 256))[4] = __builtin_amdgcn_s_memtime(); ((volatile PG8_LAS unsigned long long*)(lds + 147456 + 320 + 256))[5] = __builtin_amdgcn_s_memrealtime(); }
#endif
        for (int t = 0; t < nt; t += 2) {
            const bool last = (t == nt - 2);
            if constexpr (Epi::RSTD_LDS) {
                if (t == 2 || t == 4) { PG8_WAIT_V(8);
                    const f32x4 v = *(const PG8_LAS f32x4*)(lds + RSTD_RAW_OFF + ldsw + lane * 16);
                    float s = (v[0] + v[1]) + (v[2] + v[3]); s += __shfl_xor(s, 1); s += __shfl_xor(s, 2);
                    if (!(tid & 3)) *(PG8_LAS float*)(lds + RSTD_LDS_OFF + ((t - 2) * 64 + (tid >> 2)) * 4) = __builtin_amdgcn_rsqf(s * (1.0f / 1024.0f) + 1e-6f);
                    PG8_WAIT_L(0); }
                if (t == 0 || t == 2) __builtin_amdgcn_global_load_lds((const unsigned*)(E.ssq + ((size_t)(tid & 3) * 17408 + (size_t)cur.pm * BM + t * 64 + (tid >> 2)) * 4), (PG8_LAS unsigned*)(lds + RSTD_RAW_OFF + ldsw), 16, 0, 0);
            }
            if constexpr (Epi::XPREFETCH) { if (t == nt - XPF_LEAD) E.prefetch(cur, lds + RSTD_RAW_OFF + ldsw, tid); }
            const char* a1 = cA + (size_t)(t + 1) * kstep;
            const char* a2 = last ? nA : cA + (size_t)(t + 2) * kstep; const char* b2 = last ? nB : cB + (size_t)(t + 2) * kstep;
            const char* a3 = a2 + kstep; const char* b3 = b2 + kstep;
            if (last && has_next) S.a_ready(nxt);
            if constexpr (SP2) {
            PG8_LDB(B0, 0, 0); PG8_LDB(B1, 0, 1); PG8_SCHED; PG8_LDA(At, 0, 0); PG8_STAGE(PG8_SA(1, 1), a1 + hstep, voffA);
            PG8_WAIT_V(8); PG8_WAIT_L(0); PG8_BAR; PG8_MMA(0, 0, At, B0); PG8_MMA(0, 1, At, B1); PG8_BAR; PG8_SCHED;
            PG8_LDA(At, 0, 1); PG8_STAGE(PG8_SB(0, 0), b2, voffB); PG8_STAGE(PG8_SB(0, 1), b2 + hstep, voffB); PG8_STAGE(PG8_SA(0, 0), a2, voffA);
            PG8_WAIT_V(8); PG8_WAIT_L(0); PG8_BAR; PG8_MMA(1, 0, At, B0); PG8_MMA(1, 1, At, B1); PG8_BAR; PG8_SCHED;
            PG8_LDB(B0, 1, 0); PG8_LDB(B1, 1, 1); PG8_SCHED; PG8_LDA(At, 1, 0); PG8_STAGE(PG8_SA(0, 1), a2 + hstep, voffA);
            PG8_WAIT_V(8); PG8_WAIT_L(0); PG8_BAR; PG8_MMA(0, 0, At, B0); PG8_MMA(0, 1, At, B1); PG8_BAR; PG8_SCHED;
            PG8_LDA(At, 1, 1); PG8_STAGE(PG8_SB(1, 0), b3, voffB); PG8_STAGE(PG8_SB(1, 1), b3 + hstep, voffB); PG8_STAGE(PG8_SA(1, 0), a3, voffA);
            PG8_WAIT_V(8); PG8_WAIT_L(0); PG8_BAR; PG8_MMA(1, 0, At, B0); PG8_MMA(1, 1, At, B1); PG8_BAR; PG8_SCHED;
            } else {
            PG8_LDB(B0, 0, 0); PG8_SCHED; PG8_LDA(At, 0, 0); PG8_STAGE(PG8_SA(1, 1), a1 + hstep, voffA);
            PG8_WAIT_L(8); PG8_BAR; PG8_WAIT_L(0); PG8_MMA(0, 0, At, B0); PG8_BAR; PG8_SCHED;
            PG8_LDB(B1, 0, 1); PG8_STAGE(PG8_SB(0, 0), b2, voffB);
            PG8_BAR; PG8_WAIT_L(0); PG8_MMA(0, 1, At, B1); PG8_BAR;
            PG8_LDA(At, 0, 1); PG8_STAGE(PG8_SA(0, 0), a2, voffA);
            PG8_BAR; PG8_WAIT_L(0); PG8_MMA(1, 0, At, B0); PG8_BAR; PG8_SCHED;
            PG8_STAGE(PG8_SB(0, 1), b2 + hstep, voffB);
            PG8_WAIT_V(6); PG8_BAR; PG8_MMA(1, 1, At, B1); PG8_BAR;
            PG8_LDB(B0, 1, 0); PG8_SCHED; PG8_LDA(At, 1, 0); PG8_STAGE(PG8_SA(0, 1), a2 + hstep, voffA);
            PG8_WAIT_L(8); PG8_BAR; PG8_WAIT_L(0); PG8_MMA(0, 0, At, B0); PG8_BAR; PG8_SCHED;
            PG8_LDB(B1, 1, 1); PG8_STAGE(PG8_SB(1, 0), b3, voffB);
            PG8_BAR; PG8_WAIT_L(0); PG8_MMA(0, 1, At, B1); PG8_BAR;
            PG8_LDA(At, 1, 1); PG8_STAGE(PG8_SA(1, 0), a3, voffA);
            PG8_BAR; PG8_WAIT_L(0); PG8_MMA(1, 0, At, B0); PG8_BAR; PG8_SCHED;
            PG8_STAGE(PG8_SB(1, 1), b3 + hstep, voffB);
            PG8_WAIT_V(6); PG8_BAR; PG8_MMA(1, 1, At, B1); PG8_BAR;
            }
        }
#ifdef DBG_KLOOP_T
        if (ui == DBG_KLOOP_UNIT && blockIdx.x == DBG_T_BLK && tid == 0) { ((volatile PG8_LAS unsigned long long*)(lds + 147456 + 320 + 256))[6] = __builtin_amdgcn_s_memtime(); ((volatile PG8_LAS unsigned long long*)(lds + 147456 + 320 + 256))[7] = __builtin_amdgcn_s_memrealtime(); }
#endif
        if constexpr (ALIGN_EPI) { if (wr == 0) PG8_BAR; }
        if constexpr (!Epi::AFTER_DRAIN) { E(acc, cur, wr, wc, fr, fq); S.done(cur); }
        if (!has_next) break;
#pragma unroll
        for (int a = 0; a < 2; ++a)
#pragma unroll
            for (int b = 0; b < 2; ++b)
#pragma unroll
                for (int m = 0; m < 4; ++m)
#pragma unroll
                    for (int n = 0; n < 2; ++n) acc[a][b][m][n] = (f32x4){0.f, 0.f, 0.f, 0.f};
        cur = nxt; cA = nA; cB = nB; ++ui;
        if constexpr (ALIGN_EPI) { if (wr == 1) PG8_BAR; }
    }
    PG8_WAIT_V(0);
    if constexpr (!ALIGN_EPI) { if (wr == 0) PG8_BAR; }
    PG8_BAR;
    if constexpr (Epi::AFTER_DRAIN) { E.fused(acc, cur, wr, wc, fr, fq, lds, wid, lane); S.done(cur); }
#undef PG8_SA
#undef PG8_SB
#undef PG8_STAGE
#undef PG8_LDA
#undef PG8_LDB
#undef PG8_MMA
#undef PG8_WAIT_V
#undef PG8_WAIT_L
#undef PG8_BAR
#undef PG8_SCHED
}
}
constexpr int D = 1024, MP = 16384, MS = 1024, M = MP + MS, NLAYER = 4, MIXW = 256, INC = 5888, PMC = 1792, GTC = 4096, FF = 2816;
constexpr int SEQ = 2048, NB = 8, DB = 128, DSEQ = 8, NCH = SEQ / 64;
constexpr int NPHASE = 2 + 7 * NLAYER;
#ifndef MK_PER_PHASE
#define MK_PER_PHASE 0
#endif
constexpr size_t O_Y = 0, O_POOLP = 17825792, O_POOLS = 17948672, O_SREP = 19914752, O_SRES = 19947520, O_SIMP = 20471808, O_SIMS = 20504576,
                 O_SCP = 21028864, O_SCS = 21045248, O_CFP = 21307392, O_CFS = 21553152, O_END = 25485312;
constexpr size_t MiB = 1u << 20;
constexpr size_t WS_CTL = 0, CTL_ZERO_BYTES = 64 * 1024;
constexpr size_t WS_SSQ = 1 * MiB;
constexpr size_t WS_E = 3 * MiB;
constexpr size_t WS_TAB = 5 * MiB;
constexpr size_t TAB_LB = 0, TAB_LP = 8192, TAB_BBT = 16384, TAB_CM = TAB_BBT + 65536, TAB_PW = TAB_CM + 65536, TAB_STRIDE = TAB_PW + 32768;
constexpr size_t WS_WIN = 6 * MiB;
constexpr size_t WS_WFI = WS_WIN + (size_t)NLAYER * INC * D * 2;
constexpr size_t WS_WOUT = WS_WFI + (size_t)NLAYER * 2 * FF * D * 2;
constexpr size_t WS_WFO = WS_WOUT + (size_t)NLAYER * D * D * 2;
constexpr size_t WS_WBR = WS_WFO + (size_t)NLAYER * D * FF * 2;
constexpr size_t WS_WGLU = WS_WBR + (size_t)NLAYER * 4 * D * MIXW * 2;
constexpr size_t WS_ACT1 = WS_WGLU + (size_t)NLAYER * MIXW * MIXW * 2;
constexpr size_t WS_PM = WS_ACT1 + (size_t)M * D * 2;
constexpr size_t WS_GT = WS_PM + (size_t)M * PMC * 2;
constexpr size_t WS_END = WS_GT + (size_t)M * GTC * 2;
static_assert(WS_TAB + NLAYER * TAB_STRIDE <= WS_WIN && WS_E + (size_t)NB * NCH * 1024 * 8 <= WS_TAB && WS_SSQ + (size_t)M * 64 <= WS_E, "d_ws map");
constexpr int CW_BAR = 1024;
constexpr int RING_OFF = 0, RING_BYTES = 147456;
constexpr int LDSCTL_OFF = RING_BYTES, MISC_OFF = LDSCTL_OFF + 320;
constexpr int LDS_BYTES = 163840;
constexpr int NWAVES = 8;

#define GAS __attribute__((address_space(1)))
#define LAS __attribute__((address_space(3)))
typedef unsigned short bf16;
typedef unsigned short bf16_t;
typedef unsigned v4u __attribute__((ext_vector_type(4)));
typedef unsigned v2u __attribute__((ext_vector_type(2)));
typedef float f32x4 __attribute__((ext_vector_type(4)));
typedef float f32x2 __attribute__((ext_vector_type(2)));
typedef short bf16x8 __attribute__((ext_vector_type(8)));
#define LDS_WAIT() asm volatile("s_waitcnt lgkmcnt(0)" ::: "memory")
#define VM_WAIT() asm volatile("s_waitcnt vmcnt(0)" ::: "memory")
__device__ __forceinline__ unsigned pk2(float lo, float hi) { return pg8::cvt_pk_bf16(lo, hi); }
__device__ __forceinline__ float bflo(unsigned u) { return __builtin_bit_cast(float, u << 16); }
__device__ __forceinline__ float bfhi(unsigned u) { return __builtin_bit_cast(float, u & 0xffff0000u); }
__device__ __forceinline__ float bf1(bf16_t b) { return __builtin_bit_cast(float, (unsigned)b << 16); }
__device__ __forceinline__ void unpack8(const v4u v, float (&f)[8]) { f[0] = bflo(v.x); f[1] = bfhi(v.x); f[2] = bflo(v.y); f[3] = bfhi(v.y); f[4] = bflo(v.z); f[5] = bfhi(v.z); f[6] = bflo(v.w); f[7] = bfhi(v.w); }
__device__ __forceinline__ v4u pack8(const float (&f)[8]) { v4u w; w.x = pk2(f[0], f[1]); w.y = pk2(f[2], f[3]); w.z = pk2(f[4], f[5]); w.w = pk2(f[6], f[7]); return w; }
__device__ __forceinline__ float sigm(float x) { return pg8::sigm(x); }
__device__ __forceinline__ float gelu_tanh(float y) { const float in2 = 1.5957691216057308f * (y + 0.044715f * y * y * y); const float e = __builtin_amdgcn_exp2f(1.4426950408889634f * in2); return 0.5f * y * (2.0f - 2.0f * __builtin_amdgcn_rcpf(e + 1.0f)); }
__device__ __forceinline__ float wave_sum(float v) {
#pragma unroll
    for (int o = 1; o < 64; o <<= 1) v += __shfl_xor(v, o);
    return v;
}

#define XB_TMO      128
#define XB_XCNT(j)  (256  + 64 * (j))
#define XB_XSUB(j)  (1280 + 64 * (j))
#define XB_XGEN(j)  (2304 + 64 * (j))
#define XB_TOP      3328
#define XB_TOPGEN   3392
#define XCD_BAR_WORDS 3456
#define XB_SPIN_CAP (1u << 18)

__device__ __forceinline__ unsigned xb_ld(unsigned* p)              { return __hip_atomic_load(p, __ATOMIC_RELAXED, __HIP_MEMORY_SCOPE_AGENT); }
__device__ __forceinline__ unsigned xb_add(unsigned* p, unsigned v) { return __hip_atomic_fetch_add(p, v, __ATOMIC_RELAXED, __HIP_MEMORY_SCOPE_AGENT); }
__device__ __forceinline__ unsigned xb_xcc_id() { return (unsigned)__builtin_amdgcn_s_getreg((3 << 11) | 20) & 0xFu; }
#define XB_SPIN(cond, bar) do { unsigned _sp = 0; while (cond) { __builtin_amdgcn_s_sleep(1); \
    if ((++_sp & 255u) == 0u) { if (xb_ld(&(bar)[XB_TMO])) break; if (_sp > XB_SPIN_CAP) { atomicAdd(&(bar)[XB_TMO], 1u); break; } } } } while (0)

struct XcdBarrier {
    unsigned* bar; unsigned x;
    volatile LAS unsigned* st;
};

__device__ __forceinline__ XcdBarrier xcd_barrier_post(unsigned* bar, volatile LAS unsigned* st) {
    XcdBarrier b; b.bar = bar; b.x = xb_xcc_id(); b.st = st;
    if (threadIdx.x == 0) (void)xb_add(&bar[XB_XCNT(b.x)], 1u);
    return b;
}
__device__ __forceinline__ void xcd_barrier_complete(unsigned* bar, unsigned x, unsigned& nloc, unsigned& nx) {
    const unsigned G = gridDim.x * gridDim.y * gridDim.z;
    unsigned sum, cnt, mine, sp = 0u;
    for (;;) {
        sum = 0u; cnt = 0u; mine = 0u;
#pragma unroll
        for (unsigned j = 0; j < 16; ++j) { const unsigned c = xb_ld(&bar[XB_XCNT(j)]); sum += c; cnt += (c > 0u) ? 1u : 0u; mine = (j == x) ? c : mine; }
        if (sum == G) break;
        __builtin_amdgcn_s_sleep(1);
        if ((++sp & 255u) == 0u) { if (xb_ld(&bar[XB_TMO])) break; if (sp > XB_SPIN_CAP) { atomicAdd(&bar[XB_TMO], 1u); break; } }
    }
    nloc = mine > 0u ? mine : 1u; nx = cnt > 0u ? cnt : 1u;
}

__device__ __forceinline__ void xcd_barrier_leader(const XcdBarrier& b) {
    {
        unsigned* bar = b.bar;
        __builtin_amdgcn_s_waitcnt(0);
        unsigned nloc = b.st[0], nx = b.st[1];
        if (nloc == 0u) { xcd_barrier_complete(bar, b.x, nloc, nx); b.st[0] = nloc; b.st[1] = nx; }
        const unsigned old = xb_add(&bar[XB_XSUB(b.x)], 1u);
        const unsigned gen = old / nloc;
        if (old + 1u == (gen + 1u) * nloc) {
            __builtin_amdgcn_fence(__ATOMIC_RELEASE, "agent");
            asm volatile("s_waitcnt vmcnt(0)" ::: "memory");
            const unsigned og = xb_add(&bar[XB_TOP], 1u);
            const unsigned tg = og / nx;
            if (og + 1u == (tg + 1u) * nx) xb_add(&bar[XB_TOPGEN], 1u);
            else XB_SPIN(xb_ld(&bar[XB_TOPGEN]) == tg, bar);
            __builtin_amdgcn_fence(__ATOMIC_ACQUIRE, "agent");
            xb_add(&bar[XB_XGEN(b.x)], 1u);
            asm volatile("s_waitcnt vmcnt(0)" ::: "memory");
        } else {
            XB_SPIN(xb_ld(&bar[XB_XGEN(b.x)]) == gen, bar);
            __builtin_amdgcn_fence(__ATOMIC_ACQUIRE, "agent");
            asm volatile("s_waitcnt vmcnt(0)" ::: "memory");
        }
    }
}
__device__ __forceinline__ void xcd_barrier(const XcdBarrier& b, bool leader) {
    asm volatile("s_waitcnt vmcnt(0)" ::: "memory");
    __syncthreads();
    if (leader) xcd_barrier_leader(b);
    __syncthreads();
}
struct Args { const float* in[32]; float* out; unsigned char* ws; int ph_lo, ph_hi; };
enum { I_XP = 0, I_XS, I_STPOOL, I_STRE, I_STIM, I_STSC, I_STCF, I_N1G, I_N2G, I_FING, I_WIN, I_BGATE, I_POOLW, I_POOLSC, I_LAMRE, I_LAMIM, I_LOGDT,
       I_BRE, I_BIM, I_CRE, I_CIM, I_DSKIP, I_WGLU, I_BGLU, I_SCW, I_CFW, I_CFLNG, I_CFLNB, I_WBR, I_WOUT, I_WFI, I_WFO };

__device__ __forceinline__ void p0_item(const float* W, int ldw, int src_col0, const float* kscale, int k0, bf16* WTrow0, int K, LAS float* scr, int lane) {
    float wv[32];
#pragma unroll
    for (int i = 0; i < 32; ++i) { const int kk = 2 * i + (lane >> 5); wv[i] = W[(size_t)(k0 + kk) * ldw + src_col0 + (lane & 31)]; }
#pragma unroll
    for (int i = 0; i < 32; ++i) { const int kk = 2 * i + (lane >> 5); scr[kk * 33 + (lane & 31)] = wv[i]; }
    LDS_WAIT(); asm volatile("" ::: "memory");
    const int c = lane & 7;
    f32x4 ks0 = (f32x4){1.f, 1.f, 1.f, 1.f}, ks1 = ks0;
    if (kscale) { ks0 = *(const f32x4*)(kscale + k0 + 8 * c); ks1 = *(const f32x4*)(kscale + k0 + 8 * c + 4); }
#pragma unroll
    for (int j = 0; j < 4; ++j) { const int n = (lane >> 3) + 8 * j; const LAS float* s = scr + (8 * c) * 33 + n;
        v4u o; o.x = pk2(s[0 * 33] * ks0[0], s[1 * 33] * ks0[1]); o.y = pk2(s[2 * 33] * ks0[2], s[3 * 33] * ks0[3]); o.z = pk2(s[4 * 33] * ks1[0], s[5 * 33] * ks1[1]); o.w = pk2(s[6 * 33] * ks1[2], s[7 * 33] * ks1[3]);
        *(GAS v4u*)(WTrow0 + (size_t)n * K + k0 + 8 * c) = o; }
    LDS_WAIT(); asm volatile("" ::: "memory");
}
constexpr int P0_IT_IN = 16 * (INC / 32), P0_IT_FI = 16 * (2 * FF / 32), P0_IT_OUT = 16 * 32, P0_IT_FO = (FF / 64) * 32, P0_IT_BR = 4 * 4 * 32, P0_IT_GLU = 4 * 8;
constexpr int P0_IT_LAYER = P0_IT_IN + P0_IT_FI + P0_IT_OUT + P0_IT_FO + P0_IT_BR + P0_IT_GLU;
__device__ __forceinline__ void p0_weight_item(const Args& a, int L, int r, LAS float* scr, int lane) {
    unsigned char* ws = a.ws;
    if (r < P0_IT_IN) { const int nblk = INC / 32, kb = r / nblk, nb = r % nblk;
        p0_item(a.in[I_WIN] + (size_t)L * D * INC, INC, 32 * nb, a.in[I_N1G] + L * D, 64 * kb, (bf16*)(ws + WS_WIN) + ((size_t)L * INC + 32 * nb) * D, D, scr, lane); return; } r -= P0_IT_IN;
    if (r < P0_IT_FI) { const int nblk = 2 * FF / 32, kb = r / nblk, nb = r % nblk; const int nd = 32 * nb, pn = nd >> 8, rr = nd & 255;
        const int src = rr < 128 ? 128 * pn + rr : FF + 128 * pn + (rr - 128);
        p0_item(a.in[I_WFI] + (size_t)L * D * 2 * FF, 2 * FF, src, a.in[I_N2G] + L * D, 64 * kb, (bf16*)(ws + WS_WFI) + ((size_t)L * 2 * FF + nd) * D, D, scr, lane); return; } r -= P0_IT_FI;
    if (r < P0_IT_OUT) { const int kb = r / 32, nb = r % 32;
        p0_item(a.in[I_WOUT] + (size_t)L * D * D, D, 32 * nb, nullptr, 64 * kb, (bf16*)(ws + WS_WOUT) + ((size_t)L * D + 32 * nb) * D, D, scr, lane); return; } r -= P0_IT_OUT;
    if (r < P0_IT_FO) { const int kb = r / 32, nb = r % 32;
        p0_item(a.in[I_WFO] + (size_t)L * FF * D, D, 32 * nb, nullptr, 64 * kb, (bf16*)(ws + WS_WFO) + ((size_t)L * D + 32 * nb) * FF, FF, scr, lane); return; } r -= P0_IT_FO;
    if (r < P0_IT_BR) { const int br = r / 128, q = r % 128, kb = q / 32, nb = q % 32;
        p0_item(a.in[I_WBR] + (size_t)(L * 4 + br) * MIXW * D, D, 32 * nb, nullptr, 64 * kb, (bf16*)(ws + WS_WBR) + ((size_t)(L * 4 + br) * D + 32 * nb) * MIXW, MIXW, scr, lane); return; } r -= P0_IT_BR;
    { const int kb = r / 8, nb = r % 8;
        p0_item(a.in[I_WGLU] + (size_t)L * MIXW * MIXW, MIXW, 32 * nb, nullptr, 64 * kb, (bf16*)(ws + WS_WGLU) + ((size_t)L * MIXW + 32 * nb) * MIXW, MIXW, scr, lane); }
}
constexpr int P0_SLICES = 6, P0_F_PER = 7, P0_A_PER = 2, P0_F_BID0 = 216, P0_A_BID0 = 192;
__device__ __forceinline__ int p0_items_A(int G) { return G == 256 ? (256 - P0_A_BID0) * NWAVES * P0_A_PER : 0; }
__device__ __forceinline__ int p0_items_F(int G) { return G == 256 ? (256 - P0_F_BID0) * NWAVES * P0_F_PER : 0; }
__device__ __forceinline__ void p0_idle_items(const Args& a, LAS unsigned char* lds, int lane, int wave, int bid, int L, int base, int bid0, int per) {
    LAS float* scr = (LAS float*)(lds + RING_OFF + wave * 16384);
    const int nw = (256 - bid0) * NWAVES, w = (bid - bid0) * NWAVES + wave;
    for (int q = 0; q < per; ++q) p0_weight_item(a, L, base + w + q * nw, scr, lane);
}
__device__ __forceinline__ void p0_slice(const Args& a, LAS unsigned char* lds, int lane, int wave, int G, int bid, int L, int slice) {
    LAS float* scr = (LAS float*)(lds + RING_OFF + wave * 16384);
    const int first = p0_items_A(G) + p0_items_F(G), per = (P0_IT_LAYER - first + P0_SLICES - 1) / P0_SLICES;
    const int lo = first + slice * per, hi = (lo + per < P0_IT_LAYER) ? lo + per : P0_IT_LAYER;
    for (int r = lo + bid * (NWAVES - 1) + (wave - 1); r < hi; r += G * (NWAVES - 1)) p0_weight_item(a, L, r, scr, lane);
}
__device__ __forceinline__ void p0_prologue(const Args& a, LAS unsigned char* lds, int tid, int lane, int wave, int G, int bid) {
    LAS float* scr = (LAS float*)(lds + RING_OFF + wave * 16384);
    const int gw = bid * NWAVES + wave, NGW = G * NWAVES;
    unsigned char* ws = a.ws;
    for (int it = gw; it < (MK_PER_PHASE ? NLAYER : 1) * P0_IT_LAYER; it += NGW) p0_weight_item(a, it / P0_IT_LAYER, it % P0_IT_LAYER, scr, lane);
    for (int m = gw; m < M; m += NGW) {
        const float* xrow = m < MP ? a.in[I_XP] + (size_t)m * D : a.in[I_XS] + (size_t)(m - MP) * D;
        const GAS f32x4* xr = (const GAS f32x4*)xrow + lane; f32x4 v[4]; float s = 0.f;
#pragma unroll
        for (int j = 0; j < 4; ++j) { v[j] = xr[64 * j]; s += (v[j][0] * v[j][0] + v[j][1] * v[j][1]) + (v[j][2] * v[j][2] + v[j][3] * v[j][3]); }
        s = wave_sum(s);
        GAS v2u* o8 = (GAS v2u*)((bf16*)(ws + WS_ACT1) + (size_t)m * D) + lane;
#pragma unroll
        for (int j = 0; j < 4; ++j) { v2u w; w.x = pk2(v[j][0], v[j][1]); w.y = pk2(v[j][2], v[j][3]); o8[64 * j] = w; }
        if (lane < 16) ((float*)(ws + WS_SSQ))[((size_t)(lane >> 2) * M + m) * 4 + (lane & 3)] = lane == 0 ? s : 0.f;
    }
    for (int idx = bid * 512 + tid; idx < NLAYER * 1024; idx += G * 512) {
        const int L = idx >> 10, gp = idx & 1023, g = gp >> 6, p = gp & 63;
        unsigned char* tab = ws + WS_TAB + (size_t)L * TAB_STRIDE;
        const float lre = a.in[I_LAMRE][idx], lim = a.in[I_LAMIM][idx], dt = expf(a.in[I_LOGDT][L * 16 + g]);
        const float ar = lre * dt, br_ = lim * dt, ea = expf(ar), cb = cosf(br_), sb = sinf(br_), sh = sinf(0.5f * br_);
        const float lbr = ea * cb, lbi = ea * sb;
        const float m1r = expm1f(ar) * cb - 2.0f * sh * sh, m1i = lbi;
        const float den = 1.0f / (lre * lre + lim * lim);
        const float qr = (m1r * lre + m1i * lim) * den, qi = (m1i * lre - m1r * lim) * den;
        ((f32x2*)(tab + TAB_LB))[gp] = (f32x2){lbr, lbi};
        float pr = lbr, pi = lbi;
#pragma unroll
        for (int s = 0; s < 6; ++s) { const float nr = pr * pr - pi * pi, ni = 2.0f * pr * pi; pr = nr; pi = ni; }
        ((f32x2*)(tab + TAB_LP))[gp] = (f32x2){pr, pi};
        bf16* bbt = (bf16*)(tab + TAB_BBT); bf16* cm = (bf16*)(tab + TAB_CM);
        const float* bre = a.in[I_BRE] + (size_t)idx * 16; const float* bim = a.in[I_BIM] + (size_t)idx * 16;
#pragma unroll
        for (int c = 0; c < 16; ++c) { const float Br = bre[c], Bi = bim[c];
            bbt[(g * 128 + p) * 16 + c] = (bf16)(pk2(qr * Br - qi * Bi, 0.f) & 0xffffu);
            bbt[(g * 128 + 64 + p) * 16 + c] = (bf16)(pk2(qr * Bi + qi * Br, 0.f) & 0xffffu);
            cm[(g * 16 + c) * 128 + p] = (bf16)(pk2(a.in[I_CRE][((size_t)(L * 16 + g) * 16 + c) * 64 + p], 0.f) & 0xffffu);
            cm[(g * 16 + c) * 128 + 64 + p] = (bf16)(pk2(-a.in[I_CIM][((size_t)(L * 16 + g) * 16 + c) * 64 + p], 0.f) & 0xffffu); }
    }
    for (int idx = bid * 512 + tid; idx < NLAYER * 4 * 64 * 64; idx += G * 512) {
        const int L = idx >> 14, r = idx & 16383, k = r >> 12, o = (r >> 6) & 63, c = r & 63;
        ((bf16*)(ws + WS_TAB + (size_t)L * TAB_STRIDE + TAB_PW))[r] = (bf16)(pk2(a.in[I_POOLW][((size_t)(L * 4 + k) * 64 + c) * 64 + o], 0.f) & 0xffffu);
    }
}
__device__ __forceinline__ void final_norm(const Args& a, int lane, int wave, int G, int bid) {
    const int gw = bid * NWAVES + wave, NGW = G * NWAVES;
    const float* ssq = (const float*)(a.ws + WS_SSQ);
    f32x4 gv[4];
#pragma unroll
    for (int j = 0; j < 4; ++j) gv[j] = ((const f32x4*)a.in[I_FING])[lane + 64 * j];
    for (int m = gw; m < M; m += NGW) {
        float s = lane < 16 ? ssq[((size_t)(lane >> 2) * M + m) * 4 + (lane & 3)] : 0.f; s = wave_sum(s);
        const float rs = __builtin_amdgcn_rsqf(s * (1.0f / 1024.0f) + 1e-6f);
        const GAS v2u* xb = (const GAS v2u*)((const bf16*)(a.ws + WS_ACT1) + (size_t)m * D) + lane;
        GAS f32x4* yr = (GAS f32x4*)(a.out + (size_t)m * D) + lane;
#pragma unroll
#ifdef DBG_HASH_Y
        for (int j = 0; j < 4; ++j) { const v2u q = xb[64 * j]; f32x4 v = (f32x4){bflo(q.x), bfhi(q.x), bflo(q.y), bfhi(q.y)}; v = v * rs * gv[j]; f32x4 h;
            for (int qq = 0; qq < 4; ++qq) { const unsigned b = __float_as_uint(v[qq]); const unsigned hh = (b * 2654435761u) ^ (b >> 15); h[qq] = (float)(hh >> 8) * (1.0f / 16777216.0f); }
            yr[64 * j] = h; }
#else
        for (int j = 0; j < 4; ++j) { const v2u q = xb[64 * j]; const f32x4 v = (f32x4){bflo(q.x), bfhi(q.x), bflo(q.y), bfhi(q.y)}; yr[64 * j] = v * rs * gv[j]; }
#endif
    }
}

typedef float f32x4_t __attribute__((ext_vector_type(4)));
#ifdef DBG_MIX_T
#define MIX_STAMP(i) do { if (((i) == DBG_TA || (i) == DBG_TB) && !SAMPLE && layer == 1 && blockIdx.x == DBG_T_BLK && wave == 0) { const unsigned long long t__ = __builtin_amdgcn_s_memrealtime(); if (lane == 0) ((volatile LAS unsigned long long*)(lds + 131072 + 320 + 256))[16 + (i)] = t__; } } while (0)
#else
#define MIX_STAMP(i) do {} while (0)
#endif
__device__ __forceinline__ float fma_s(float a, float b, float c) { float r; asm("v_fma_f32 %0, %1, %2, %3" : "=v"(r) : "v"(a), "v"(b), "v"(c)); return r; }
template <bool SAMPLE>
__device__ __forceinline__ void mix_unit(const Args& a, int layer, int uidx, LAS unsigned char* lds, int tid_in, int lane_in, int wave_in, int stages) {
    int tid = tid_in; asm volatile("" : "+v"(tid));
    const int lane = tid & 63, wave = __builtin_amdgcn_readfirstlane(tid >> 6);
#ifdef DBG_EXTRA_SYNC
    asm volatile("s_waitcnt vmcnt(0) lgkmcnt(0)" ::: "memory"); __syncthreads();
#endif
    constexpr int L = SAMPLE ? 8 : 64, NSEG = SAMPLE ? 2 : 1, R = NSEG * L;
    const bf16* PMb = (const bf16*)(a.ws + WS_PM); bf16* BR = (bf16*)a.out;
    const int s = uidx >> 5, c = uidx & 31, q0 = 2 * uidx;
    const int row0 = SAMPLE ? MP + q0 * 8 : s * SEQ + 64 * c;
    const bool last = SAMPLE || c == NCH - 1;
    LAS float* V = (LAS float*)lds;
    MIX_STAMP(0);
    if (stages & 1) {
        constexpr int TR = NSEG * (30 + L);
        LAS float* WCF = (LAS float*)(lds + 96256);
        {
            constexpr int NIT = (TR * 32 + 511) / 512;
            v4u qa[NIT], qb[NIT]; int kind[NIT];
#pragma unroll
            for (int it = 0; it < NIT; ++it) {
                const int idx = tid + it * 512; kind[it] = 0; qa[it] = (v4u){0u, 0u, 0u, 0u}; qb[it] = (v4u){0u, 0u, 0u, 0u};
                if (idx < TR * 32) {
                    const int rr = idx >> 5, c8 = (idx & 31) * 8, seg = rr / (30 + L), e = rr % (30 + L);
                    int srow = -1;
                    if (SAMPLE) { if (e >= 30) srow = MP + (q0 + seg) * 8 + (e - 30); }
                    else { const int tabs = c * 64 + e - 30; if (tabs >= 0) srow = s * SEQ + tabs; }
                    if (srow >= 0) { kind[it] = 1; qa[it] = *(const v4u*)(PMb + (size_t)srow * PMC + 1280 + c8); qb[it] = *(const v4u*)(PMb + (size_t)srow * PMC + 1536 + c8); }
                    else if (SAMPLE) { kind[it] = 2; const float* st = a.in[I_STCF] + ((size_t)(layer * DB + q0 + seg) * 30 + e) * MIXW + c8; qa[it] = *(const v4u*)st; qb[it] = *(const v4u*)(st + 4); }
                }
            }
#pragma unroll
            for (int it = 0; it < NIT; ++it) {
                const int idx = tid + it * 512;
                if (idx < TR * 32) {
                    const int rr = idx >> 5, c8 = (idx & 31) * 8;
                    float v[8];
                    if (kind[it] == 1) { float av[8], bv[8]; unpack8(qa[it], av); unpack8(qb[it], bv);
#pragma unroll
                        for (int j = 0; j < 8; ++j) v[j] = av[j] * sigm(bv[j]); }
                    else { v[0] = __uint_as_float(qa[it].x); v[1] = __uint_as_float(qa[it].y); v[2] = __uint_as_float(qa[it].z); v[3] = __uint_as_float(qa[it].w);
                           v[4] = __uint_as_float(qb[it].x); v[5] = __uint_as_float(qb[it].y); v[6] = __uint_as_float(qb[it].z); v[7] = __uint_as_float(qb[it].w); }
                    *(LAS f32x4*)(V + rr * 256 + c8) = (f32x4){v[0], v[1], v[2], v[3]}; *(LAS f32x4*)(V + rr * 256 + c8 + 4) = (f32x4){v[4], v[5], v[6], v[7]};
                }
            }
        }
        { f32x4 wq[4];
#pragma unroll
            for (int it = 0; it < 4; ++it) { const int idx = tid + it * 512; wq[it] = idx < 31 * 64 ? *(const f32x4*)(a.in[I_CFW] + (size_t)layer * 31 * MIXW + idx * 4) : (f32x4){0.f, 0.f, 0.f, 0.f}; }
#pragma unroll
            for (int it = 0; it < 4; ++it) { const int idx = tid + it * 512; if (idx < 31 * 64) *(LAS f32x4*)(WCF + idx * 4) = wq[it]; } }
        __syncthreads();
        MIX_STAMP(1);
        if (last) {
            for (int idx = tid; idx < NSEG * 30 * 64; idx += 512) { const int seg = idx / (30 * 64), r = idx % (30 * 64), j = r >> 6, c4 = (r & 63) * 4;
                float* dst = a.out + (SAMPLE ? O_CFS + ((size_t)(layer * DB + q0 + seg) * 30 + j) * MIXW : O_CFP + ((size_t)(layer * NB + s) * 30 + j) * MIXW) + c4;
                *(f32x4*)dst = *(LAS f32x4*)(V + (seg * (30 + L) + L + j) * 256 + c4); }
        }
        const f32x4 lg = *(const f32x4*)(a.in[I_CFLNG] + layer * MIXW + 4 * lane), lb = *(const f32x4*)(a.in[I_CFLNB] + layer * MIXW + 4 * lane);
        {
            constexpr int NT = R / NWAVES, TG = NT >= 4 ? 4 : NT;
#pragma unroll 1
            for (int g0 = 0; g0 < NT; g0 += TG) {
                f32x4 acc[TG]; int base[TG];
#pragma unroll
                for (int i = 0; i < TG; ++i) { const int tt = wave + NWAVES * (g0 + i), seg = tt / L, t = tt % L; base[i] = (seg * (30 + L) + t) * 256 + 4 * lane; acc[i] = (f32x4){0.f, 0.f, 0.f, 0.f}; }
#pragma unroll 4
                for (int j = 0; j < 31; ++j) { const f32x4 w = *(LAS f32x4*)(WCF + j * 256 + 4 * lane);
#pragma unroll
                    for (int i = 0; i < TG; ++i) acc[i] += w * *(LAS f32x4*)(V + base[i] + j * 256); }
                float s1[TG];
#pragma unroll
                for (int i = 0; i < TG; ++i) s1[i] = (acc[i][0] + acc[i][1]) + (acc[i][2] + acc[i][3]);
#pragma unroll
                for (int o = 1; o < 64; o <<= 1) {
#pragma unroll
                    for (int i = 0; i < TG; ++i) s1[i] += __shfl_xor(s1[i], o); }
                f32x4 d[TG]; float s2[TG];
#pragma unroll
                for (int i = 0; i < TG; ++i) { d[i] = acc[i] - s1[i] * (1.0f / 256.0f); s2[i] = (d[i][0] * d[i][0] + d[i][1] * d[i][1]) + (d[i][2] * d[i][2] + d[i][3] * d[i][3]); }
#pragma unroll
                for (int o = 1; o < 64; o <<= 1) {
#pragma unroll
                    for (int i = 0; i < TG; ++i) s2[i] += __shfl_xor(s2[i], o); }
#pragma unroll
                for (int i = 0; i < TG; ++i) { const int tt = wave + NWAVES * (g0 + i);
                    const float rstd = __builtin_amdgcn_rsqf(s2[i] * (1.0f / 256.0f) + 1e-5f);
                    const f32x4 yn = d[i] * rstd * lg + lb;
                    v2u w; w.x = pk2(yn[0] * sigm(yn[0]), yn[1] * sigm(yn[1])); w.y = pk2(yn[2] * sigm(yn[2]), yn[3] * sigm(yn[3]));
                    *(v2u*)(BR + (size_t)(row0 + tt) * D + 768 + 4 * lane) = w; }
            }
        }
        __syncthreads();
    }
    MIX_STAMP(2);
    if (stages & 2) {
        constexpr int TR = NSEG * (15 + L);
        LAS bf16* Dt = (LAS bf16*)(lds + 81920);
        {
            constexpr int NIT = (TR * 32 + 511) / 512;
            v4u qa[NIT], qb[NIT]; int kind[NIT];
#pragma unroll
            for (int it = 0; it < NIT; ++it) {
                const int idx = tid + it * 512; kind[it] = 0; qa[it] = (v4u){0u, 0u, 0u, 0u}; qb[it] = (v4u){0u, 0u, 0u, 0u};
                if (idx < TR * 32) {
                    const int rr = idx >> 5, c8 = (idx & 31) * 8, seg = rr / (15 + L), e = rr % (15 + L);
                    int srow = -1;
                    if (SAMPLE) { if (e >= 15) srow = MP + (q0 + seg) * 8 + (e - 15); }
                    else { const int tabs = c * 64 + e - 15; if (tabs >= 0) srow = s * SEQ + tabs; }
                    if (srow >= 0) { kind[it] = 1; qa[it] = *(const v4u*)(PMb + (size_t)srow * PMC + c8); }
                    else if (SAMPLE) { kind[it] = 2; const float* st = a.in[I_STPOOL] + ((size_t)(layer * DB + q0 + seg) * 15 + e) * MIXW + c8; qa[it] = *(const v4u*)st; qb[it] = *(const v4u*)(st + 4); }
                }
            }
#pragma unroll
            for (int it = 0; it < NIT; ++it) {
                const int idx = tid + it * 512;
                if (idx < TR * 32) {
                    const int rr = idx >> 5, c8 = (idx & 31) * 8;
                    float v[8];
                    if (kind[it] == 1) unpack8(qa[it], v);
                    else { v[0] = __uint_as_float(qa[it].x); v[1] = __uint_as_float(qa[it].y); v[2] = __uint_as_float(qa[it].z); v[3] = __uint_as_float(qa[it].w);
                           v[4] = __uint_as_float(qb[it].x); v[5] = __uint_as_float(qb[it].y); v[6] = __uint_as_float(qb[it].z); v[7] = __uint_as_float(qb[it].w); }
                    *(LAS f32x4*)(V + rr * 256 + c8) = (f32x4){v[0], v[1], v[2], v[3]}; *(LAS f32x4*)(V + rr * 256 + c8 + 4) = (f32x4){v[4], v[5], v[6], v[7]};
                }
            }
        }
        __syncthreads();
        MIX_STAMP(3);
        if (last) {
            for (int idx = tid; idx < NSEG * 15 * 64; idx += 512) { const int seg = idx / (15 * 64), r = idx % (15 * 64), j = r >> 6, c4 = (r & 63) * 4;
                float* dst = a.out + (SAMPLE ? O_POOLS + ((size_t)(layer * DB + q0 + seg) * 15 + j) * MIXW : O_POOLP + ((size_t)(layer * NB + s) * 15 + j) * MIXW) + c4;
                *(f32x4*)dst = *(LAS f32x4*)(V + (seg * (15 + L) + L + j) * 256 + c4); }
        }
        for (int idx = tid; idx < R * 32; idx += 512) {
            const int tt = idx >> 5, c8 = (idx & 31) * 8, seg = tt / L, t = tt % L, base = seg * (15 + L) + t + 15, win = 2 << (c8 >> 6);
            float sm[8];
#pragma unroll
            for (int j = 0; j < 8; ++j) sm[j] = 0.f;
            for (int w = 0; w < win; ++w) { const f32x4 x0 = *(LAS f32x4*)(V + (base - w) * 256 + c8), x1 = *(LAS f32x4*)(V + (base - w) * 256 + c8 + 4);
                sm[0] += x0[0]; sm[1] += x0[1]; sm[2] += x0[2]; sm[3] += x0[3]; sm[4] += x1[0]; sm[5] += x1[1]; sm[6] += x1[2]; sm[7] += x1[3]; }
            const int cnt = SAMPLE ? win : min(c * 64 + t + 1, win);
            const float inv = 1.0f / (float)cnt;
            const f32x4 c0 = *(LAS f32x4*)(V + base * 256 + c8), c1 = *(LAS f32x4*)(V + base * 256 + c8 + 4);
            float dd[8];
#pragma unroll
            for (int j = 0; j < 4; ++j) { dd[j] = sm[j] * inv - c0[j]; dd[4 + j] = sm[4 + j] * inv - c1[j]; }
            *(LAS v4u*)(Dt + tt * 264 + c8) = pack8(dd);
        }
        __syncthreads();
        MIX_STAMP(4);
        {
            const bf16* PW = (const bf16*)(a.ws + WS_TAB + (size_t)layer * TAB_STRIDE + TAB_PW);
            const int k = wave >> 1, fr = lane & 15, fq = lane >> 4;
            constexpr int NMT = R / 16;
            for (int mt = (NMT >= 4 ? (wave & 1) * 2 : (wave & 1)); mt < (NMT >= 4 ? (wave & 1) * 2 + 2 : ((wave & 1) == 0 ? NMT : 0)); ++mt) {
                const bf16x8 b0 = *(LAS bf16x8*)(Dt + (16 * mt + fr) * 264 + 64 * k + 8 * fq), b1 = *(LAS bf16x8*)(Dt + (16 * mt + fr) * 264 + 64 * k + 32 + 8 * fq);
#pragma unroll
                for (int ot = 0; ot < 4; ++ot) {
                    f32x4 acc = (f32x4){0.f, 0.f, 0.f, 0.f};
                    const bf16x8 a0 = *(const bf16x8*)(PW + ((size_t)(k * 64 + 16 * ot + fr)) * 64 + 8 * fq), a1 = *(const bf16x8*)(PW + ((size_t)(k * 64 + 16 * ot + fr)) * 64 + 32 + 8 * fq);
                    acc = __builtin_amdgcn_mfma_f32_16x16x32_bf16(a0, b0, acc, 0, 0, 0);
                    acc = __builtin_amdgcn_mfma_f32_16x16x32_bf16(a1, b1, acc, 0, 0, 0);
                    const int o = 64 * k + 16 * ot + 4 * fq, tt = 16 * mt + fr;
                    const f32x4 sc = *(const f32x4*)(a.in[I_POOLSC] + layer * MIXW + o);
                    v2u w; w.x = pk2(acc[0] * sc[0], acc[1] * sc[1]); w.y = pk2(acc[2] * sc[2], acc[3] * sc[3]);
                    *(v2u*)(BR + (size_t)(row0 + tt) * D + o) = w;
                }
            }
        }
        __syncthreads();
    }
    MIX_STAMP(5);
    if (stages & 4) {
        const float* scw = a.in[I_SCW] + (size_t)layer * 3 * MIXW;
#pragma unroll
        for (int it_ = 0; it_ < R * 32 / 512; ++it_) { const int idx = tid + it_ * 512;
            const int tt = idx >> 5, c8 = (idx & 31) * 8, seg = tt / L, t = tt % L;
            float z[3][8];
#pragma unroll
            for (int dj = 0; dj < 3; ++dj) { const int tp = t - 2 + dj;
                int srow = -1;
                if (SAMPLE) { if (tp >= 0) srow = MP + (q0 + seg) * 8 + tp; } else { const int tabs = c * 64 + tp; if (tabs >= 0) srow = s * SEQ + tabs; }
                if (srow >= 0) { float cg[8], hx[8]; unpack8(*(const v4u*)(PMb + (size_t)srow * PMC + 768 + c8), cg); unpack8(*(const v4u*)(PMb + (size_t)srow * PMC + 1024 + c8), hx);
#pragma unroll
                    for (int j = 0; j < 8; ++j) z[dj][j] = cg[j] * hx[j]; }
                else if (SAMPLE) { const float* st = a.in[I_STSC] + ((size_t)(layer * DB + q0 + seg) * 2 + (2 + tp)) * MIXW + c8; const f32x4 x0 = *(const f32x4*)st, x1 = *(const f32x4*)(st + 4);
                    z[dj][0] = x0[0]; z[dj][1] = x0[1]; z[dj][2] = x0[2]; z[dj][3] = x0[3]; z[dj][4] = x1[0]; z[dj][5] = x1[1]; z[dj][6] = x1[2]; z[dj][7] = x1[3]; }
                else {
#pragma unroll
                    for (int j = 0; j < 8; ++j) z[dj][j] = 0.f; } }
            float bg[8], o[8]; unpack8(*(const v4u*)(PMb + (size_t)(row0 + tt) * PMC + 512 + c8), bg);
#pragma unroll
            for (int j = 0; j < 8; ++j) o[j] = bg[j] * (scw[c8 + j] * z[0][j] + scw[MIXW + c8 + j] * z[1][j] + scw[2 * MIXW + c8 + j] * z[2][j]);
            *(v4u*)(BR + (size_t)(row0 + tt) * D + 512 + c8) = pack8(o);
            if (last && t >= L - 2) { float* dst = a.out + (SAMPLE ? O_SCS + ((size_t)(layer * DB + q0 + seg) * 2 + (t - (L - 2))) * MIXW : O_SCP + ((size_t)(layer * NB + s) * 2 + (t - (L - 2))) * MIXW) + c8;
                *(f32x4*)dst = (f32x4){z[2][0], z[2][1], z[2][2], z[2][3]}; *(f32x4*)(dst + 4) = (f32x4){z[2][4], z[2][5], z[2][6], z[2][7]}; }
        }
    }
    MIX_STAMP(6);
}

template <int MODE>
__device__ __forceinline__ void ssm_unit(const Args& a, int layer, int uidx, LAS unsigned char* lds, int tid_in, int lane_in, int wave_in) {
    int tid = tid_in; asm volatile("" : "+v"(tid));
    const int lane = tid & 63, wave = __builtin_amdgcn_readfirstlane(tid >> 6);
    const bf16* PMb = (const bf16*)(a.ws + WS_PM); bf16* BR = (bf16*)a.out;
    const unsigned char* tab = a.ws + WS_TAB + (size_t)layer * TAB_STRIDE;
    const f32x2* LB = (const f32x2*)(tab + TAB_LB); const f32x2* LP = (const f32x2*)(tab + TAB_LP);
    const bf16* BBT = (const bf16*)(tab + TAB_BBT); const bf16* CM = (const bf16*)(tab + TAB_CM);
    f32x2* E = (f32x2*)(a.ws + WS_E);
    const int s = uidx >> 5, c = uidx & 31;
    const int row0 = MODE == 2 ? MP + 64 * uidx : s * SEQ + 64 * c;
    const int fr = lane & 15, fq = lane >> 4;
    LAS float* BU = (LAS float*)(lds + wave * 8448);
    LAS bf16* Zt = (LAS bf16*)(lds + 67584);
    const bf16x8 zf = (bf16x8){0, 0, 0, 0, 0, 0, 0, 0};
    for (int gi = 0; gi < 2; ++gi) {
        const int g = 2 * wave + gi;
        const f32x2 lam = LB[g * 64 + lane]; const float nlam1 = -lam[1];
        float hr = 0.f, hi = 0.f;
        bf16x8 bb[8];
#pragma unroll
        for (int nt = 0; nt < 8; ++nt) bb[nt] = fq < 2 ? *(const bf16x8*)(BBT + ((size_t)(g * 128 + 16 * nt + fr)) * 16 + 8 * fq) : zf;
        bf16x8 cmf[4]; float dsk = 0.f;
        if (MODE >= 1) {
#pragma unroll
            for (int ks = 0; ks < 4; ++ks) cmf[ks] = *(const bf16x8*)(CM + ((size_t)(g * 16 + fr)) * 128 + 32 * ks + 8 * fq);
            dsk = a.in[I_DSKIP][layer * MIXW + 16 * g + fr]; }
        bf16x8 ufa[4];
#pragma unroll
        for (int sub = 0; sub < 4; ++sub) ufa[sub] = fq < 2 ? *(const bf16x8*)(PMb + (size_t)(row0 + 16 * sub + fr) * PMC + 256 + 16 * g + 8 * fq) : zf;
        bf16 uva[4][4];
        if (MODE >= 1) {
#pragma unroll
            for (int sub = 0; sub < 4; ++sub)
#pragma unroll
                for (int r = 0; r < 4; ++r) uva[sub][r] = PMb[(size_t)(row0 + 16 * sub + 4 * fq + r) * PMC + 256 + 16 * g + fr]; }
        if (MODE == 1) { const f32x2 lp = LP[g * 64 + lane];
            const float nlp1 = -lp[1];
#pragma unroll 1
            for (int j = 0; j < c; j += 16) { f32x2 e16[16]; const int nq = c - j;
#pragma unroll
                for (int q = 0; q < 16; ++q) if (q < nq) e16[q] = E[((size_t)(s * NCH + j + q) * 16 + g) * 64 + lane];
#pragma unroll
                for (int q = 0; q < 16; ++q) if (q < nq) { const float nr = fma_s(lp[0], hr, fma_s(nlp1, hi, e16[q][0])), ni = fma_s(lp[0], hi, fma_s(lp[1], hr, e16[q][1])); hr = nr; hi = ni; } } }
#pragma unroll
        for (int sub = 0; sub < 4; ++sub) {
            const int rowb = row0 + 16 * sub;
            const bf16x8 uf = ufa[sub];
#pragma unroll
            for (int nt = 0; nt < 8; ++nt) { const f32x4 d = __builtin_amdgcn_mfma_f32_16x16x32_bf16(uf, bb[nt], (f32x4){0.f, 0.f, 0.f, 0.f}, 0, 0, 0);
#pragma unroll
                for (int r = 0; r < 4; ++r) BU[(4 * fq + r) * 132 + 16 * nt + fr] = d[r]; }
            asm volatile("s_waitcnt lgkmcnt(0)" ::: "memory");
            {
                float bre_[16], bim_[16];
#pragma unroll
                for (int t = 0; t < 16; ++t) { bre_[t] = BU[t * 132 + lane]; bim_[t] = BU[t * 132 + 64 + lane]; }
                float sre_[2] = {0.f, 0.f}, sim_[2] = {0.f, 0.f};
                if (MODE == 2) {
#pragma unroll
                    for (int hq = 0; hq < 2; ++hq) { const int q = 8 * uidx + 2 * sub + hq; const size_t si = ((size_t)(layer * DB + q) * 16 + g) * 64 + lane; sre_[hq] = a.in[I_STRE][si]; sim_[hq] = a.in[I_STIM][si]; } }
                asm volatile("s_waitcnt lgkmcnt(0)" ::: "memory");
#pragma unroll
                for (int t = 0; t < 16; ++t) {
                    if (MODE == 2 && (t & 7) == 0) { hr = sre_[t >> 3]; hi = sim_[t >> 3]; }
                    const float nr = fma_s(lam[0], hr, fma_s(nlam1, hi, bre_[t])), ni = fma_s(lam[0], hi, fma_s(lam[1], hr, bim_[t])); hr = nr; hi = ni;
                    bre_[t] = hr; bim_[t] = hi;
                    if (MODE == 2 && (t & 7) == 7) { const int q = 8 * uidx + 2 * sub + (t >> 3); const size_t si = ((size_t)(layer * DB + q) * 16 + g) * 64 + lane; a.out[O_SRES + si] = hr; a.out[O_SIMS + si] = hi; }
                }
#pragma unroll
                for (int t = 0; t < 16; ++t) { BU[t * 132 + lane] = bre_[t]; BU[t * 132 + 64 + lane] = bim_[t]; }
            }
            if (MODE >= 1) {
                asm volatile("s_waitcnt lgkmcnt(0)" ::: "memory");
                f32x4 y = (f32x4){0.f, 0.f, 0.f, 0.f};
#pragma unroll
                for (int ks = 0; ks < 4; ++ks) { const f32x4 h0 = *(LAS f32x4*)(BU + fr * 132 + 32 * ks + 8 * fq), h1 = *(LAS f32x4*)(BU + fr * 132 + 32 * ks + 8 * fq + 4);
                    v4u hw; hw.x = pk2(h0[0], h0[1]); hw.y = pk2(h0[2], h0[3]); hw.z = pk2(h1[0], h1[1]); hw.w = pk2(h1[2], h1[3]);
                    y = __builtin_amdgcn_mfma_f32_16x16x32_bf16(__builtin_bit_cast(bf16x8, hw), cmf[ks], y, 0, 0, 0); }
#pragma unroll
                for (int r = 0; r < 4; ++r) { const int t = 4 * fq + r; const float uv = bf1(uva[sub][r]);
                    const float z = gelu_tanh(y[r] + dsk * uv);
                    Zt[(16 * sub + t) * 264 + 16 * g + fr] = (bf16)(pk2(z, 0.f) & 0xffffu); }
                asm volatile("s_waitcnt lgkmcnt(0)" ::: "memory");
            }
            if (MODE == 0) { asm volatile("s_waitcnt lgkmcnt(0)" ::: "memory"); }
        }
        if (MODE == 0) E[((size_t)(s * NCH + c) * 16 + g) * 64 + lane] = (f32x2){hr, hi};
        if (MODE == 1 && c == NCH - 1) { const size_t si = ((size_t)(layer * NB + s) * 16 + g) * 64 + lane; a.out[O_SREP + si] = hr; a.out[O_SIMP + si] = hi; }
    }
    if (MODE == 0) __syncthreads();
    if (MODE >= 1) {
        __syncthreads();
        const bf16* WG = (const bf16*)(a.ws + WS_WGLU) + (size_t)layer * MIXW * MIXW;
        f32x4 acc[4][2];
#pragma unroll
        for (int mt = 0; mt < 4; ++mt) { acc[mt][0] = (f32x4){0.f, 0.f, 0.f, 0.f}; acc[mt][1] = (f32x4){0.f, 0.f, 0.f, 0.f}; }
#pragma unroll
        for (int ks = 0; ks < 8; ++ks) {
            const bf16x8 w0 = *(const bf16x8*)(WG + (size_t)(32 * wave + fr) * MIXW + 32 * ks + 8 * fq), w1 = *(const bf16x8*)(WG + (size_t)(32 * wave + 16 + fr) * MIXW + 32 * ks + 8 * fq);
#pragma unroll
            for (int mt = 0; mt < 4; ++mt) { const bf16x8 zb = *(LAS bf16x8*)(Zt + (16 * mt + fr) * 264 + 32 * ks + 8 * fq);
                acc[mt][0] = __builtin_amdgcn_mfma_f32_16x16x32_bf16(w0, zb, acc[mt][0], 0, 0, 0);
                acc[mt][1] = __builtin_amdgcn_mfma_f32_16x16x32_bf16(w1, zb, acc[mt][1], 0, 0, 0); }
        }
#pragma unroll
        for (int nl = 0; nl < 2; ++nl) { const int n0 = 32 * wave + 16 * nl + 4 * fq; const f32x4 bgl = *(const f32x4*)(a.in[I_BGLU] + layer * MIXW + n0);
#pragma unroll
            for (int mt = 0; mt < 4; ++mt) { const int tt = 16 * mt + fr; const v2u zz = *(LAS v2u*)(Zt + tt * 264 + n0);
                const float z0 = bflo(zz.x), z1 = bfhi(zz.x), z2 = bflo(zz.y), z3 = bfhi(zz.y);
                v2u w; w.x = pk2(z0 * sigm(acc[mt][nl][0] + bgl[0]), z1 * sigm(acc[mt][nl][1] + bgl[1])); w.y = pk2(z2 * sigm(acc[mt][nl][2] + bgl[2]), z3 * sigm(acc[mt][nl][3] + bgl[3]));
                *(v2u*)(BR + (size_t)(row0 + tt) * D + 256 + n0) = w; } }
        __syncthreads();
    }
}

__device__ __forceinline__ void gemm2_phase(LAS unsigned char* lds, const bf16* BRp, const bf16* WBT, const unsigned char* GT, bf16* MG, int G, int bid, int tidp) {
    using namespace pg8;
    int tid_ = tidp; asm volatile("" : "+v"(tid_));
    const int tid = tid_, wid = __builtin_amdgcn_readfirstlane(tid >> 6), lane = tid & 63, wr = wid >> 2, wc = wid & 3, fr = lane & 15, fq = lane >> 4;
    unsigned voffA0, voffB0;
    { int R, C; stage_rc(tid * 16, R, C); const int Rb = (R & ~31) + perm32(R & 31); voffA0 = (unsigned)(R * D + C) * 2u; voffB0 = (unsigned)(Rb * MIXW + C) * 2u; }
    const unsigned ldsw = (unsigned)wid * 1024u;
    const int aoff = lds_byte(wr * 64 + fr, fq * 8), boff = lds_byte(wc * 32 + fr, fq * 8);
    const unsigned gvoff = (unsigned)(fr * GTC + 8 * fq);
    constexpr int STG = 49152;
#define G2_STAGE(it_, so_) do { const int kb_ = (it_) >> 2, kt_ = (it_) & 3; \
        const char* as_ = Abase + (size_t)(kb_ * 256 + kt_ * 64) * 2; const char* bs_ = Bbase + (size_t)kb_ * (D * MIXW * 2) + (size_t)kt_ * 128; \
        _Pragma("unroll") for (int _i = 0; _i < 2; ++_i) __builtin_amdgcn_global_load_lds((const unsigned*)(as_ + (size_t)_i * (64 * D * 2) + voffA0), (PG8_LAS unsigned*)(lds + (so_) + ldsw + _i * 8192), 16, 0, 0); \
        _Pragma("unroll") for (int _i = 0; _i < 2; ++_i) __builtin_amdgcn_global_load_lds((const unsigned*)(bs_ + (size_t)_i * (64 * MIXW * 2) + voffB0), (PG8_LAS unsigned*)(lds + (so_) + 16384 + ldsw + _i * 8192), 16, 0, 0); \
        _Pragma("unroll") for (int _i = 0; _i < 2; ++_i) __builtin_amdgcn_global_load_lds((const unsigned*)(bs_ + (size_t)(128 + 64 * _i) * MIXW * 2 + voffB0), (PG8_LAS unsigned*)(lds + (so_) + 32768 + ldsw + _i * 8192), 16, 0, 0); } while (0)
    const int vb = (G % 8 == 0) ? (bid % 8) * (G / 8) + bid / 8 : bid;
    constexpr int NUN = (MP / 128) * 4;
    for (int ui = vb; ui < NUN; ui += G) {
        const int pm = ui >> 2, pn = ui & 3;
        const char* Abase = (const char*)BRp + (size_t)pm * 128 * D * 2;
        const char* Bbase = (const char*)WBT + (size_t)pn * 256 * MIXW * 2;
        G2_STAGE(0, 0); G2_STAGE(1, STG);
        f32x4 mg[2][4][2], acc[2][4][2];
#pragma unroll
        for (int b = 0; b < 2; ++b)
#pragma unroll
            for (int m = 0; m < 4; ++m)
#pragma unroll
                for (int n = 0; n < 2; ++n) { mg[b][m][n] = (f32x4){0.f, 0.f, 0.f, 0.f}; acc[b][m][n] = (f32x4){0.f, 0.f, 0.f, 0.f}; }
        v2u gq[2][4];
        int so = 0, so2 = 2 * STG;
#pragma unroll 1
        for (int kb = 0; kb < 4; ++kb) {
#pragma unroll
            for (int kt = 0; kt < 4; ++kt) {
                if (kt < 2) asm volatile("s_waitcnt vmcnt(6)" ::: "memory");
                else if (kt == 3 && kb == 3) asm volatile("s_waitcnt vmcnt(8)" ::: "memory");
                else asm volatile("s_waitcnt vmcnt(14)" ::: "memory");
                __builtin_amdgcn_s_barrier(); asm volatile("" ::: "memory");
                if (kt < 2 || kb < 3) G2_STAGE(4 * kb + kt + 2, so2);
#pragma unroll
                for (int kk = 0; kk < 2; ++kk) {
                    bf16x8 At[4], B0[2], B1[2];
#pragma unroll
                    for (int m = 0; m < 4; ++m) At[m] = *(const PG8_LAS bf16x8*)(lds + so + aoff + m * 2048 + kk * 1024);
#pragma unroll
                    for (int n = 0; n < 2; ++n) { B0[n] = *(const PG8_LAS bf16x8*)(lds + so + 16384 + boff + n * 2048 + kk * 1024); B1[n] = *(const PG8_LAS bf16x8*)(lds + so + 32768 + boff + n * 2048 + kk * 1024); }
                    asm volatile("s_waitcnt lgkmcnt(0)" ::: "memory"); __builtin_amdgcn_sched_barrier(0);
#pragma unroll
                    for (int m = 0; m < 4; ++m)
#pragma unroll
                        for (int n = 0; n < 2; ++n) { acc[0][m][n] = __builtin_amdgcn_mfma_f32_16x16x32_bf16(B0[n], At[m], acc[0][m][n], 0, 0, 0);
                                                      acc[1][m][n] = __builtin_amdgcn_mfma_f32_16x16x32_bf16(B1[n], At[m], acc[1][m][n], 0, 0, 0); }
                }
                if (kt == 1) {
#pragma unroll
                    for (int m = 0; m < 4; ++m) { const unsigned char* gs = GT + (size_t)(pm * 128 + wr * 64 + m * 16) * GTC + kb * D + pn * 256 + wc * 32;
                        asm volatile("global_load_dwordx2 %0, %1, %2" : "=v"(gq[0][m]) : "v"(gvoff), "s"(gs) : "memory");
                        asm volatile("global_load_dwordx2 %0, %1, %2 offset:128" : "=v"(gq[1][m]) : "v"(gvoff), "s"(gs) : "memory"); }
                }
                so = so == 2 * STG ? 0 : so + STG; so2 = so2 == 2 * STG ? 0 : so2 + STG;
            }
            if (kb == 3) asm volatile("s_waitcnt vmcnt(0)" ::: "memory"); else asm volatile("s_waitcnt vmcnt(12)" ::: "memory");
            asm volatile("" : "+v"(gq[0][0]), "+v"(gq[0][1]), "+v"(gq[0][2]), "+v"(gq[0][3]), "+v"(gq[1][0]), "+v"(gq[1][1]), "+v"(gq[1][2]), "+v"(gq[1][3]));
#pragma unroll
            for (int b = 0; b < 2; ++b)
#pragma unroll
                for (int m = 0; m < 4; ++m) { const v2u q_ = gq[b][m];
#pragma unroll
                    for (int j = 0; j < 4; ++j) { mg[b][m][0][j] += (float)((q_.x >> (8 * j)) & 0xffu) * acc[b][m][0][j]; mg[b][m][1][j] += (float)((q_.y >> (8 * j)) & 0xffu) * acc[b][m][1][j]; }
                    acc[b][m][0] = (f32x4){0.f, 0.f, 0.f, 0.f}; acc[b][m][1] = (f32x4){0.f, 0.f, 0.f, 0.f}; }
        }
        asm volatile("" ::: "memory"); __builtin_amdgcn_s_barrier(); asm volatile("" ::: "memory");
#pragma unroll
        for (int b = 0; b < 2; ++b)
#pragma unroll
            for (int m = 0; m < 4; ++m) { const int row = pm * 128 + wr * 64 + m * 16 + fr, col = pn * 256 + b * 128 + wc * 32 + 8 * fq;
                const f32x4 m0 = mg[b][m][0] * (1.0f / 255.0f), m1 = mg[b][m][1] * (1.0f / 255.0f);
                v4u w; w.x = pk2(m0[0], m0[1]); w.y = pk2(m0[2], m0[3]); w.z = pk2(m1[0], m1[1]); w.w = pk2(m1[2], m1[3]);
                *(v4u*)(MG + (size_t)row * D + col) = w; }
    }
#undef G2_STAGE
}


#define TL_GLDS(src_, dst_) __builtin_amdgcn_global_load_lds((const unsigned*)(src_), (PG8_LAS unsigned*)(dst_), 16, 0, 0)
#define TL_STAGE(kt_, A_PTR, B_PTR) do { const int s_ = (kt_) & 3; const char* ap_ = A_PTR(kt_); const char* bp_ = B_PTR(kt_); \
        TL_GLDS(ap_ + voffA, lds + s_ * 32768 + ldsw); TL_GLDS(ap_ + voffA + 128, lds + s_ * 32768 + 8192 + ldsw); \
        TL_GLDS(bp_ + voffB, lds + s_ * 32768 + 16384 + ldsw); TL_GLDS(bp_ + voffB + 128, lds + s_ * 32768 + 24576 + ldsw); } while (0)
#define TL_LOOP(NK, A_PTR, B_PTR, AFTER_STEP) do { \
        TL_STAGE(0, A_PTR, B_PTR); if ((NK) > 1) TL_STAGE(1, A_PTR, B_PTR); if ((NK) > 2) TL_STAGE(2, A_PTR, B_PTR); \
        _Pragma("unroll 1") for (int kt = 0; kt < (NK); ++kt) { \
            if (kt + 2 < (NK)) asm volatile("s_waitcnt vmcnt(8)" ::: "memory"); else if (kt + 1 < (NK)) asm volatile("s_waitcnt vmcnt(4)" ::: "memory"); else asm volatile("s_waitcnt vmcnt(0)" ::: "memory"); \
            __builtin_amdgcn_s_barrier(); asm volatile("" ::: "memory"); \
            if (kt + 3 < (NK)) TL_STAGE(kt + 3, A_PTR, B_PTR); \
            const int sb_ = (kt & 3) * 32768; \
            _Pragma("unroll") for (int h_ = 0; h_ < 2; ++h_) { \
                const bf16x8 a0 = *(const PG8_LAS bf16x8*)(lds + sb_ + h_ * 8192 + aoff), a1 = *(const PG8_LAS bf16x8*)(lds + sb_ + h_ * 8192 + aoff + 1024); \
                const bf16x8 b00 = *(const PG8_LAS bf16x8*)(lds + sb_ + 16384 + h_ * 8192 + boff), b01 = *(const PG8_LAS bf16x8*)(lds + sb_ + 16384 + h_ * 8192 + boff + 1024); \
                const bf16x8 b10 = *(const PG8_LAS bf16x8*)(lds + sb_ + 16384 + h_ * 8192 + boff + 2048), b11 = *(const PG8_LAS bf16x8*)(lds + sb_ + 16384 + h_ * 8192 + boff + 3072); \
                asm volatile("s_waitcnt lgkmcnt(0)" ::: "memory"); __builtin_amdgcn_sched_barrier(0); \
                acc[0] = __builtin_amdgcn_mfma_f32_16x16x32_bf16(b00, a0, acc[0], 0, 0, 0); acc[1] = __builtin_amdgcn_mfma_f32_16x16x32_bf16(b10, a0, acc[1], 0, 0, 0); \
                acc[0] = __builtin_amdgcn_mfma_f32_16x16x32_bf16(b01, a1, acc[0], 0, 0, 0); acc[1] = __builtin_amdgcn_mfma_f32_16x16x32_bf16(b11, a1, acc[1], 0, 0, 0); } \
            AFTER_STEP(kt); } \
        asm volatile("s_waitcnt lgkmcnt(0)" ::: "memory"); __builtin_amdgcn_s_barrier(); asm volatile("" ::: "memory"); } while (0)
#define TL_SETUP(LDA, LDB) using namespace pg8; int tid_ = tidp; asm volatile("" : "+v"(tid_)); \
    const int tid = tid_, wid = __builtin_amdgcn_readfirstlane(tid >> 6), lane = tid & 63, fr = lane & 15, fq = lane >> 4, mt = wid >> 1, nh = wid & 1; \
    int R_, C_; stage_rc(tid * 16, R_, C_); \
    const unsigned voffA = (unsigned)(R_ * (LDA) + C_) * 2u, voffB = (unsigned)(R_ * (LDB) + C_) * 2u, ldsw = (unsigned)wid * 1024u; \
    const int aoff = lds_byte(mt * 16 + fr, fq * 8), boff = lds_byte(nh * 32 + fr, fq * 8); (void)lane
#define TL_NOP(kt_) do {} while (0)

struct CappedOrder : pg8::StaticOrder {
    int cap;
    __device__ bool next(int i, pg8::Unit& u) const { if ((long)i * G + c >= cap) return false; return pg8::StaticOrder::next(i, u); }
};
__device__ __forceinline__ void proj_tail_phase(LAS unsigned char* lds, const bf16* A, const bf16* Bt, int cap, const float* ssq, const float* bgate, bf16* PMp, unsigned char* GTp, int G, int bid, int tidp) {
    TL_SETUP(D, D);
    StaticOrder S1; S1.init(M, INC, 1, 0);
    const int nsub = (S1.nwg - cap) * 16;
    for (int t = bid; t < nsub; t += G) {
        Unit u; S1.next(cap + (t >> 4), u);
        const int rb = (t >> 2) & 3, cb = t & 3, r0 = u.pm * 256 + 64 * rb, c0 = u.pn * 256 + 64 * cb;
        const char* Ab = (const char*)A + (size_t)r0 * D * 2; const char* Bb = (const char*)Bt + (size_t)c0 * D * 2;
        f32x4 acc[2] = {(f32x4){0.f, 0.f, 0.f, 0.f}, (f32x4){0.f, 0.f, 0.f, 0.f}};
        const int row = r0 + 16 * mt + fr;
        const float rs = pg8::row_rstd(ssq, row);
        const bool isg = u.pn >= 7;
        f32x4 bvv[2];
#pragma unroll
        for (int n = 0; n < 2; ++n) bvv[n] = isg ? *(const f32x4*)(bgate + (c0 + 32 * nh + 16 * n + 4 * fq - PMC)) : (f32x4){0.f, 0.f, 0.f, 0.f};
#define PT_A(kt_) (Ab + (size_t)(kt_) * 256)
#define PT_B(kt_) (Bb + (size_t)(kt_) * 256)
        TL_LOOP(D / 128, PT_A, PT_B, TL_NOP);
#undef PT_A
#undef PT_B
#pragma unroll
        for (int n = 0; n < 2; ++n) { const int col = c0 + 32 * nh + 16 * n + 4 * fq; f32x4 v = acc[n] * rs;
            if (isg) { const f32x4 t = (v + bvv[n]) * -1.4426950408889634f;
                *(unsigned*)(GTp + (size_t)row * GTC + (col - PMC)) = pg8::pack_u8x4(pg8::sig255(t[0]), pg8::sig255(t[1]), pg8::sig255(t[2]), pg8::sig255(t[3])); }
            else { v2u w; w.x = pk2(v[0], v[1]); w.y = pk2(v[2], v[3]); *(v2u*)(PMp + (size_t)row * PMC + col) = w; } }
    }
}

__device__ __forceinline__ void gemm2_tail_phase(LAS unsigned char* lds, const bf16* BRp, const bf16* WBT, const unsigned char* GT, bf16* MG, int G, int bid, int tidp) {
    TL_SETUP(D, MIXW);
    for (int ui = bid; ui < 256; ui += G) {
        const int rb = ((ui & 7) >> 1) * 4 + (ui >> 6), cb = (ui & 1) * 8 + ((ui >> 3) & 7);
        const char* Ab = (const char*)BRp + (size_t)(MP + 64 * rb) * D * 2; const char* Bb = (const char*)WBT + (size_t)(64 * cb) * MIXW * 2;
        f32x4 acc[2] = {(f32x4){0.f, 0.f, 0.f, 0.f}, (f32x4){0.f, 0.f, 0.f, 0.f}}, mg[2] = {(f32x4){0.f, 0.f, 0.f, 0.f}, (f32x4){0.f, 0.f, 0.f, 0.f}};
        const int row = MP + 64 * rb + 16 * mt + fr;
#define G2T_A(kt_) (Ab + (size_t)(((kt_) >> 1) * 256 + ((kt_) & 1) * 128) * 2)
#define G2T_B(kt_) (Bb + (size_t)((kt_) >> 1) * (D * MIXW * 2) + (size_t)((kt_) & 1) * 256)
        unsigned gwp[4][2];
#pragma unroll
        for (int kb = 0; kb < 4; ++kb)
#pragma unroll
            for (int n = 0; n < 2; ++n) gwp[kb][n] = *(const unsigned*)(GT + (size_t)row * GTC + kb * D + 64 * cb + 32 * nh + 16 * n + 4 * fq);
#define G2T_AFTER(kt_) do { if ((kt_) & 1) { const int kb_ = (kt_) >> 1; \
            _Pragma("unroll") for (int n = 0; n < 2; ++n) { const unsigned gw = kb_ == 0 ? gwp[0][n] : (kb_ == 1 ? gwp[1][n] : (kb_ == 2 ? gwp[2][n] : gwp[3][n])); \
                mg[n][0] += (float)(gw & 0xffu) * acc[n][0]; mg[n][1] += (float)((gw >> 8) & 0xffu) * acc[n][1]; mg[n][2] += (float)((gw >> 16) & 0xffu) * acc[n][2]; mg[n][3] += (float)(gw >> 24) * acc[n][3]; \
                acc[n] = (f32x4){0.f, 0.f, 0.f, 0.f}; } } } while (0)
        TL_LOOP(8, G2T_A, G2T_B, G2T_AFTER);
#undef G2T_A
#undef G2T_B
#undef G2T_AFTER
#pragma unroll
        for (int n = 0; n < 2; ++n) { const f32x4 mm = mg[n] * (1.0f / 255.0f); v2u w; w.x = pk2(mm[0], mm[1]); w.y = pk2(mm[2], mm[3]); *(v2u*)(MG + (size_t)row * D + 64 * cb + 32 * nh + 16 * n + 4 * fq) = w; }
    }
}

__device__ __forceinline__ void resid_tail_phase(LAS unsigned char* lds, const bf16* A, const bf16* Bt, int K, const float* xs_old, bool first, bf16* XBp, float* ssq, int G, int bid, int tidp) {
    TL_SETUP(K, K);
    const int nk = K / 128;
    for (int ui = bid; ui < 256; ui += G) {
        const int rb = ((ui & 7) >> 1) * 4 + (ui >> 6), cb = (ui & 1) * 8 + ((ui >> 3) & 7);
        const char* Ab = (const char*)A + (size_t)(MP + 64 * rb) * K * 2; const char* Bb = (const char*)Bt + (size_t)(64 * cb) * K * 2;
        f32x4 acc[2] = {(f32x4){0.f, 0.f, 0.f, 0.f}, (f32x4){0.f, 0.f, 0.f, 0.f}};
        const int rowl = 16 * mt + fr, row = MP + 64 * rb + rowl; float ss = 0.f;
        f32x4 xold[2];
#pragma unroll
        for (int n = 0; n < 2; ++n) { const int col = 64 * cb + 32 * nh + 16 * n + 4 * fq;
            if (first) xold[n] = *(const f32x4*)(xs_old + (size_t)(row - MP) * D + col);
            else { const v2u q = *(const v2u*)(XBp + (size_t)row * D + col); xold[n] = (f32x4){bflo(q.x), bfhi(q.x), bflo(q.y), bfhi(q.y)}; } }
#define RT_A(kt_) (Ab + (size_t)(kt_) * 256)
#define RT_B(kt_) (Bb + (size_t)(kt_) * 256)
        TL_LOOP(nk, RT_A, RT_B, TL_NOP);
#undef RT_A
#undef RT_B
#pragma unroll
        for (int n = 0; n < 2; ++n) { const int col = 64 * cb + 32 * nh + 16 * n + 4 * fq;
            const f32x4 o = xold[n] + acc[n];
            v2u w; w.x = pk2(o[0], o[1]); w.y = pk2(o[2], o[3]); *(v2u*)(XBp + (size_t)row * D + col) = w;
            ss += (o[0] * o[0] + o[1] * o[1]) + (o[2] * o[2] + o[3] * o[3]); }
        ss += __shfl_xor(ss, 16); ss += __shfl_xor(ss, 32);
        LAS float* red = (LAS float*)lds;
        if (fq == 0) red[rowl * 2 + nh] = ss;
        __syncthreads();
        if (tid < 64) ssq[((size_t)(cb >> 2) * M + MP + 64 * rb + tid) * 4 + (cb & 3)] = red[tid * 2] + red[tid * 2 + 1];
        __syncthreads();
    }
}

#ifndef PROBE_REP_B
#define PROBE_REP_B 1
#endif
#ifndef PROBE_REP_C
#define PROBE_REP_C 1
#endif
#ifndef PROBE_REP_D
#define PROBE_REP_D 1
#endif
#ifndef PROBE_REP_P0
#define PROBE_REP_P0 1
#endif
__global__ void __launch_bounds__(NWAVES * 64, 2) hybrid_fwd(Args args) {
    extern __shared__ __attribute__((aligned(16))) unsigned char lds_raw[];
    LAS unsigned char* lds = (LAS unsigned char*)lds_raw;
    volatile LAS unsigned* MISC = (volatile LAS unsigned*)(lds + MISC_OFF);
    const int tid0 = threadIdx.x, wave0 = __builtin_amdgcn_readfirstlane(tid0 >> 6);
    const int G0 = gridDim.x, bid = blockIdx.x;
    unsigned char* ws = args.ws;
    for (int u = tid0; u < (LDS_BYTES - LDSCTL_OFF) / 4; u += NWAVES * 64) ((LAS unsigned*)(lds + LDSCTL_OFF))[u] = 0u;
    __syncthreads();
    const int lo = args.ph_lo, hi = args.ph_hi;
    XcdBarrier bar; bar.bar = (unsigned*)(ws + WS_CTL) + CW_BAR; bar.x = 0; bar.st = nullptr;
    if (hi - lo > 1) bar = xcd_barrier_post((unsigned*)(ws + WS_CTL) + CW_BAR, MISC + 8);
    bf16* XB = (bf16*)(ws + WS_ACT1); bf16* PMb = (bf16*)(ws + WS_PM); unsigned char* GTb = ws + WS_GT;
    bf16* MGb = (bf16*)(ws + WS_PM); bf16* ACTb = (bf16*)(ws + WS_GT);
    float* ssq = (float*)(ws + WS_SSQ);
    for (int ph_i = lo; ph_i < hi; ++ph_i) {
#ifdef DBG_T_PH
        if (ph_i == DBG_T_PH && bid == DBG_T_BLK && wave0 == 0 && __builtin_amdgcn_mbcnt_lo(~0u, 0u) == 0u) { ((volatile LAS unsigned long long*)(lds + MISC_OFF + 256))[0] = __builtin_amdgcn_s_memtime(); ((volatile LAS unsigned long long*)(lds + MISC_OFF + 256))[1] = __builtin_amdgcn_s_memrealtime(); }
#endif
        int ph = ph_i, G = G0; asm volatile("" : "+s"(ph), "+s"(G));
        unsigned z_ = 0u; asm volatile("" : "+v"(z_));
        int tid = wave0 * 64 + (int)__builtin_amdgcn_mbcnt_hi(~0u, __builtin_amdgcn_mbcnt_lo(~0u, z_)); asm volatile("" : "+v"(tid)); const int lane = tid & 63, wave = __builtin_amdgcn_readfirstlane(tid >> 6);
        const int layer = (ph - 1) / 7, k = ph == 0 ? -1 : (ph == NPHASE - 1 ? 7 : (ph - 1) % 7);
        if (k == -1) for (int rep_ = 0; rep_ < PROBE_REP_P0; ++rep_) p0_prologue(args, lds, tid, lane, wave, G, bid);
        else if (k == 7) final_norm(args, lane, wave, G, bid);
        else if (k == 0) {
            pg8::Gemm g{XB, (const bf16*)(ws + WS_WIN) + (size_t)layer * INC * D, M, INC, D}; CappedOrder S; S.init(M, INC, G, bid); S.cap = (S.nwg / G) * G;
            pg8::EpiProj E{PMb, GTb, ssq, args.in[I_BGATE] + (size_t)layer * GTC, (const LAS float*)(lds + RING_OFF + pg8::RSTD_LDS_OFF)};
            pg8::gemm_phase<pg8::EpiProj, CappedOrder, true, true>(lds + RING_OFF, g, S, E, tid);
            proj_tail_phase(lds + RING_OFF, XB, (const bf16*)(ws + WS_WIN) + (size_t)layer * INC * D, S.cap, ssq, args.in[I_BGATE] + (size_t)layer * GTC, PMb, GTb, G, bid, tid);
            if (!MK_PER_PHASE && G == 256 && bid >= P0_A_BID0 && layer + 1 < NLAYER) p0_idle_items(args, lds, lane, wave, bid, layer + 1, 0, P0_A_BID0, P0_A_PER);
#ifdef PROBE_A_SAME
            { SameTileOrder S2; S2.init(M, INC, G, bid); pg8::EpiNull EN_; pg8::gemm_phase<pg8::EpiNull, SameTileOrder, true, true>(lds + RING_OFF, g, S2, EN_, tid); }
#endif
#ifdef PROBE_A_NULL
            { pg8::EpiNull EN_; pg8::gemm_phase<pg8::EpiNull, CappedOrder, true, true>(lds + RING_OFF, g, S, EN_, tid); }
#endif
#ifdef PROBE_A_FULL
            pg8::gemm_phase<pg8::EpiProj, CappedOrder, true, true>(lds + RING_OFF, g, S, E, tid);
#endif
        } else if (k == 1) for (int rep_ = 0; rep_ < PROBE_REP_B; ++rep_) {
            for (int s_ = 0; ; ++s_) { int u; bool donor = false;
                if (G == 256) { if (s_ > 2) break;
                    donor = bid < 16 || (bid >= 80 && bid < 152);
                    if (s_ == 0) u = 272 + ((bid + 240) & 255);
                    else if (bid < 16) { if (s_ == 2) break; u = 256 + bid; }
                    else if (bid < 80) { if (s_ == 2) break; u = 528 + (bid - 16); }
                    else if (s_ == 1 || bid < 152) { const int v = (s_ == 1 ? 0 : 176) + (bid - 80); u = (v / 31) * 32 + v % 31; }
                    else if (bid < 240) { const int t_ = bid - 152, db = t_ < 16 ? t_ : 80 + (t_ - 16); u = 592 + ((db + 240) & 255); }
                    else break; }
                else { u = bid + s_ * G; if (u >= 256 + 16 + 256 + 64) break; }
                if (u < 256) { if ((u & 31) != NCH - 1) ssm_unit<0>(args, layer, u, lds, tid, lane, wave); }
                else if (u < 272) ssm_unit<2>(args, layer, u - 256, lds, tid, lane, wave);
                else if (u < 528 || u >= 592) mix_unit<false>(args, layer, u < 528 ? u - 272 : u - 592, lds, tid, lane, wave, u >= 592 ? 4 : (donor ? 3 : 7));
                else mix_unit<true>(args, layer, u - 528, lds, tid, lane, wave, 7);
            }
        } else if (k == 2) for (int rep_ = 0; rep_ < PROBE_REP_C; ++rep_) {
            for (int u = bid; u < 256; u += G) ssm_unit<1>(args, layer, u, lds, tid, lane, wave);
        } else if (k == 3) for (int rep_ = 0; rep_ < PROBE_REP_D; ++rep_) {
            gemm2_phase(lds + RING_OFF, (const bf16*)args.out, (const bf16*)(ws + WS_WBR) + (size_t)layer * 4 * D * MIXW, GTb, MGb, G, bid, tid);
            gemm2_tail_phase(lds + RING_OFF, (const bf16*)args.out, (const bf16*)(ws + WS_WBR) + (size_t)layer * 4 * D * MIXW, GTb, MGb, G, bid, tid);
        } else if (k == 5) {
            pg8::Gemm g{XB, (const bf16*)(ws + WS_WFI) + (size_t)layer * 2 * FF * D, M, 2 * FF, D}; pg8::StaticOrder S; S.init(M, 2 * FF, G, bid);
            pg8::EpiSwiGLU E{ACTb, ssq, (const LAS float*)(lds + RING_OFF + pg8::RSTD_LDS_OFF)};
            pg8::gemm_phase<pg8::EpiSwiGLU, pg8::StaticOrder, true, true>(lds + RING_OFF, g, S, E, tid);
            if (!MK_PER_PHASE && G == 256 && bid >= P0_F_BID0 && layer + 1 < NLAYER) p0_idle_items(args, lds, lane, wave, bid, layer + 1, p0_items_A(G), P0_F_BID0, P0_F_PER);
        } else {
            const bool isE = k == 4; const int K = isE ? D : FF;
            const bf16* Ap = isE ? MGb : ACTb; const bf16* Bp = isE ? (const bf16*)(ws + WS_WOUT) + (size_t)layer * D * D : (const bf16*)(ws + WS_WFO) + (size_t)layer * D * FF;
            const bool first = isE && layer == 0;
#pragma unroll 1
            for (int step = 0; step < 2; ++step) {
                if ((step == 0) == (((bid >> 3) & 1) != 0)) resid_tail_phase(lds + RING_OFF, Ap, Bp, K, args.in[I_XS], first, XB, ssq, G, bid, tid);
                else { pg8::Gemm g{Ap, Bp, MP, D, K}; pg8::StaticOrder S; S.init(MP, D, G, bid);
                    pg8::EpiResid E{args.in[I_XP], args.in[I_XS], first, XB, ssq};
                    pg8::gemm_phase<pg8::EpiResid, pg8::StaticOrder, true, true>(lds + RING_OFF, g, S, E, tid); }
            }
        }
#ifdef DBG_T_PH
        if (ph == DBG_T_PH && bid == DBG_T_BLK && tid == 0) { ((volatile LAS unsigned long long*)(lds + MISC_OFF + 256))[2] = __builtin_amdgcn_s_memtime(); ((volatile LAS unsigned long long*)(lds + MISC_OFF + 256))[3] = __builtin_amdgcn_s_memrealtime(); }
#endif
        if (ph_i + 1 < hi) {
            asm volatile("s_waitcnt vmcnt(0)" ::: "memory"); __syncthreads();
            if (tid == 0) xcd_barrier_leader(bar);
            else if (!MK_PER_PHASE && wave != 0 && k >= 0 && k < P0_SLICES && layer + 1 < NLAYER) p0_slice(args, lds, lane, wave, G, bid, layer + 1, k);
            __syncthreads();
        }
#ifdef PROBE_XBAR
        if (ph_i == 8) for (int i_ = 0; i_ < PROBE_XBAR; ++i_) xcd_barrier(bar, tid == 0);
#endif
#if defined(DBG_T_PH) && defined(DBG_T_AFTERBAR)
        if (ph == DBG_T_PH && bid == DBG_T_BLK && tid == 0) { ((volatile LAS unsigned long long*)(lds + MISC_OFF + 256))[2] = __builtin_amdgcn_s_memtime(); ((volatile LAS unsigned long long*)(lds + MISC_OFF + 256))[3] = __builtin_amdgcn_s_memrealtime(); }
#endif
    }
#ifdef DBG_T_PH
    if (bid == DBG_T_BLK && wave0 == 0 && __builtin_amdgcn_mbcnt_lo(~0u, 0u) == 0u) {
        volatile LAS unsigned long long* ts_ = (volatile LAS unsigned long long*)(lds + MISC_OFF + 256);
        const unsigned long long dc = ts_[2] - ts_[0], dr = ts_[3] - ts_[1];
        unsigned long long val = DBG_T_MODE == 11 ? (ts_[16 + DBG_TB] - ts_[16 + DBG_TA]) : DBG_T_MODE == 8 ? (ts_[5] - ts_[1])   : DBG_T_MODE == 9 ? (ts_[3] - ts_[7])   : DBG_T_MODE == 10 ? (ts_[7] - ts_[5])   : DBG_T_MODE == 7 ? (ts_[10] - ts_[9])   : DBG_T_MODE == 5 ? (ts_[8] - ts_[4]) / 16ull   : DBG_T_MODE == 3 ? (ts_[6] - ts_[4]) / 16ull   : DBG_T_MODE == 4 ? (ts_[7] - ts_[5]) * 10ull   : DBG_T_MODE == 0 ? (dc * 100ull) / (dr ? dr : 1ull)      : DBG_T_MODE == 1 ? dr   : dc / 1000ull;
        const unsigned long long t0 = __builtin_amdgcn_s_memrealtime();
        while (__builtin_amdgcn_s_memrealtime() - t0 < val * 100ull) __builtin_amdgcn_s_sleep(16);
    }
#endif
}

extern "C" void kernel_launch(void* const* d_in, const int* in_sizes, int n_in, void* d_out, int out_size, void* d_ws, size_t ws_size, hipStream_t stream) {
    static int grid = 0;
    if (grid == 0) {
        if (n_in != 32 || out_size != (int)O_END || ws_size < WS_END) { fprintf(stderr, "kernel_launch: expected 32 inputs, %zu outputs, >= %zu bytes of workspace; got %d, %d, %zu; nothing launched\n", (size_t)O_END, (size_t)WS_END, n_in, out_size, ws_size); grid = -1; return; }
        int dev = 0, cus = 0, per_cu = 0;
        if (hipGetDevice(&dev) != hipSuccess || hipDeviceGetAttribute(&cus, hipDeviceAttributeMultiprocessorCount, dev) != hipSuccess) { grid = -1; return; }
        if (hipFuncSetAttribute((const void*)hybrid_fwd, hipFuncAttributeMaxDynamicSharedMemorySize, LDS_BYTES) != hipSuccess) { fprintf(stderr, "kernel_launch: hipFuncSetAttribute failed\n"); grid = -1; return; }
        if (hipOccupancyMaxActiveBlocksPerMultiprocessor(&per_cu, (const void*)hybrid_fwd, NWAVES * 64, LDS_BYTES) != hipSuccess || per_cu < 1) { fprintf(stderr, "kernel_launch: occupancy query says %d blocks per CU; nothing launched\n", per_cu); (void)hipGetLastError(); grid = -1; return; }
        grid = cus;
    }
    if (grid < 0) return;
    (void)hipMemsetAsync((char*)d_ws + WS_CTL, 0, CTL_ZERO_BYTES, stream);
    Args a{};
    for (int i = 0; i < 32; ++i) a.in[i] = (const float*)d_in[i];
    a.out = (float*)d_out; a.ws = (unsigned char*)d_ws;
#if MK_PER_PHASE
    for (int k = 0; k < NPHASE; ++k) { a.ph_lo = k; a.ph_hi = k + 1; hipLaunchKernelGGL(hybrid_fwd, dim3(grid), dim3(NWAVES * 64), LDS_BYTES, stream, a); }
#else
    a.ph_lo = 0; a.ph_hi = NPHASE;
    hipLaunchKernelGGL(hybrid_fwd, dim3(grid), dim3(NWAVES * 64), LDS_BYTES, stream, a);
#endif
}
```

```cpp
#include <hip/hip_runtime.h>
#include <cstdio>
#include <cstdint>
#ifndef XPF_LEAD
#define XPF_LEAD 2
#endif
namespace pg8 {
#define PG8_LAS __attribute__((address_space(3)))
typedef unsigned short bf16_t;
typedef short bf16x8 __attribute__((ext_vector_type(8)));
typedef float f32x4 __attribute__((ext_vector_type(4)));
typedef unsigned u32x4 __attribute__((ext_vector_type(4)));
constexpr int BM = 256, BK = 64, HALF = 128, HTB = HALF * BK * 2  , STAGE_BYTES = 8 * HTB, NXCD = 8, WGM = 8, RSTD_LDS_OFF = 147456 + 320 + 1024  , RSTD_RAW_OFF = RSTD_LDS_OFF + 1024  , BIAS_LDS_OFF = RSTD_RAW_OFF + 8192  ;

__host__ __device__ __forceinline__ int lds_byte(int r, int c) { const int st = (r >> 4) * 2 + (c >> 5), rr = r & 15, cc = c & 31, ob = rr * 64 + cc * 2; return st * 1024 + (ob ^ (((ob >> 9) & 1) << 5)); }
__host__ __device__ __forceinline__ void stage_rc(int b, int& R, int& C) { const int st = b / 1024, sb = b % 1024, swz = sb ^ (((sb >> 9) & 1) << 5); R = (st >> 1) * 16 + swz / 64; C = (st & 1) * 32 + (swz % 64) / 2; }
__host__ __device__ __forceinline__ int perm32(int rho) { const int n = rho >> 4, i = rho & 15; return 8 * (i >> 2) + 4 * n + (i & 3); }

struct Unit { int pm, pn; };
struct Gemm { const bf16_t* A; const bf16_t* Bt; int M, N, K; };

struct StaticOrder {
    int nM, nN, nwg, G, c;
    __host__ __device__ void init(int M, int N, int G_, int c_) { nM = M / BM; nN = N / BM; nwg = nM * nN; G = G_; c = c_; }
    __host__ __device__ bool next(int i, Unit& u) const {
        const long L = (long)i * G + c; if (L >= nwg) return false;
        int wgid = (int)L; { const int q = nwg / NXCD, r = nwg % NXCD, xcd = wgid % NXCD, off = wgid / NXCD; wgid = (xcd < r ? xcd * (q + 1) : r * (q + 1) + (xcd - r) * q) + off; }
        const int nig = WGM * nN, gid = wgid / nig, fm = gid * WGM, gsz = (nM - fm) < WGM ? (nM - fm) : WGM;
        u.pm = fm + ((wgid % nig) % gsz); u.pn = (wgid % nig) / gsz; return true;
    }
    __device__ __forceinline__ void a_ready(const Unit&) const {}
    __device__ __forceinline__ void done(const Unit&) const {}
};
typedef float f32x2 __attribute__((ext_vector_type(2)));
typedef __bf16 bf16x2_t __attribute__((ext_vector_type(2)));
__device__ __forceinline__ unsigned cvt_pk_bf16(float lo, float hi) { f32x2 v = {lo, hi}; bf16x2_t b = __builtin_convertvector(v, bf16x2_t); return __builtin_bit_cast(unsigned, b); }
__device__ __forceinline__ float sigm(float x) { return __builtin_amdgcn_rcpf(1.0f + __builtin_amdgcn_exp2f(-1.4426950408889634f * x)); }
__device__ __forceinline__ float row_rstd(const float* ssq, int row) {
    const f32x4 a = *(const f32x4*)(ssq + ((size_t)0 * 17408 + row) * 4), b = *(const f32x4*)(ssq + ((size_t)1 * 17408 + row) * 4),
                c = *(const f32x4*)(ssq + ((size_t)2 * 17408 + row) * 4), d = *(const f32x4*)(ssq + ((size_t)3 * 17408 + row) * 4);
    const float s = (((a[0] + a[1]) + (a[2] + a[3])) + ((b[0] + b[1]) + (b[2] + b[3]))) + (((c[0] + c[1]) + (c[2] + c[3])) + ((d[0] + d[1]) + (d[2] + d[3])));
    return __builtin_amdgcn_rsqf(s * (1.0f / 1024.0f) + 1e-6f);
}
__device__ __forceinline__ void rows_rstd(const float* ssq, int row0, int fq, float (&rs)[2][4]) {
#pragma unroll
    for (int ai = 0; ai < 2; ++ai)
#pragma unroll
        for (int m = 0; m < 4; ++m) { const f32x4 p = *(const f32x4*)(ssq + ((size_t)fq * 17408 + row0 + ai * HALF + m * 16) * 4); rs[ai][m] = (p[0] + p[1]) + (p[2] + p[3]); }
#pragma unroll
    for (int ai = 0; ai < 2; ++ai)
#pragma unroll
        for (int m = 0; m < 4; ++m) { float s = rs[ai][m]; s += __shfl_xor(s, 16); s += __shfl_xor(s, 32); rs[ai][m] = __builtin_amdgcn_rsqf(s * (1.0f / 1024.0f) + 1e-6f); }
}
__device__ __forceinline__ void rows_rstd_lds(const PG8_LAS float* rl, int r0, float (&rs)[2][4]) {
#pragma unroll
    for (int ai = 0; ai < 2; ++ai)
#pragma unroll
        for (int m = 0; m < 4; ++m) rs[ai][m] = rl[r0 + ai * HALF + m * 16];
}
struct EpiNull {
    static constexpr bool PERM = true, AFTER_DRAIN = false, RSTD_LDS = false, XPREFETCH = false;
    __device__ __forceinline__ void operator()(const f32x4 (&acc)[2][2][4][2], const Unit& u, int wr, int wc, int fr, int fq) const {
#pragma unroll
        for (int ai = 0; ai < 2; ++ai)
#pragma unroll
            for (int bj = 0; bj < 2; ++bj)
#pragma unroll
                for (int m = 0; m < 4; ++m) { asm volatile("" :: "v"(acc[ai][bj][m][0]), "v"(acc[ai][bj][m][1])); }
    }
};
__device__ __forceinline__ unsigned pack_u8x4(float a, float b, float c, float d) {
    unsigned w = 0u; w = __builtin_amdgcn_cvt_pk_u8_f32(a, 0u, w); w = __builtin_amdgcn_cvt_pk_u8_f32(b, 1u, w); w = __builtin_amdgcn_cvt_pk_u8_f32(c, 2u, w); w = __builtin_amdgcn_cvt_pk_u8_f32(d, 3u, w); return w; }
__device__ __forceinline__ float sig255(float t) { return __builtin_amdgcn_rcpf(__builtin_fmaf(__builtin_amdgcn_exp2f(t), 1.0f / 255.0f, 1.0f / 255.0f)); }
struct EpiProj {
    static constexpr bool PERM = true, AFTER_DRAIN = false, RSTD_LDS = true, XPREFETCH = false;
    bf16_t* PM; unsigned char* GT; const float* ssq; const float* bgate; const PG8_LAS float* rl;
    __device__ __forceinline__ void operator()(const f32x4 (&acc)[2][2][4][2], const Unit& u, int wr, int wc, int fr, int fq) const {
        const int row0 = u.pm * BM + wr * 64 + fr;
        float rsv[2][4]; rows_rstd_lds(rl, wr * 64 + fr, rsv);
        if (u.pn >= 7) {
            constexpr float NL2E = -1.4426950408889634f;
            const int lc0 = (u.pn - 7) * BM + wc * 32 + 8 * fq;
            f32x4 bv[2][2];
#pragma unroll
            for (int bj = 0; bj < 2; ++bj)
#pragma unroll
                for (int n = 0; n < 2; ++n) bv[bj][n] = *(const f32x4*)(bgate + lc0 + bj * HALF + 4 * n) * NL2E;
#pragma unroll
            for (int ai = 0; ai < 2; ++ai)
#pragma unroll
                for (int m = 0; m < 4; ++m) { const int row = row0 + ai * HALF + m * 16;
                    const float rs = rsv[ai][m] * NL2E;
                    unsigned char* rowp = GT + (size_t)row * 4096 + lc0;
#pragma unroll
                    for (int bj = 0; bj < 2; ++bj) { const f32x4 v0 = acc[ai][bj][m][0] * rs + bv[bj][0], v1 = acc[ai][bj][m][1] * rs + bv[bj][1];
                        typedef unsigned u32x2_t __attribute__((ext_vector_type(2)));
                        u32x2_t w; w.x = pack_u8x4(sig255(v0[0]), sig255(v0[1]), sig255(v0[2]), sig255(v0[3])); w.y = pack_u8x4(sig255(v1[0]), sig255(v1[1]), sig255(v1[2]), sig255(v1[3]));
                        *(u32x2_t*)(rowp + bj * HALF) = w; } }
        } else {
            const int lc0 = u.pn * BM + wc * 32 + 8 * fq;
#pragma unroll
            for (int ai = 0; ai < 2; ++ai)
#pragma unroll
                for (int m = 0; m < 4; ++m) { const int row = row0 + ai * HALF + m * 16;
                    const float rs = rsv[ai][m];
                    bf16_t* rowp = PM + (size_t)row * 1792 + lc0;
#pragma unroll
                    for (int bj = 0; bj < 2; ++bj) { const f32x4 v0 = acc[ai][bj][m][0] * rs, v1 = acc[ai][bj][m][1] * rs;
                        u32x4 w; w.x = cvt_pk_bf16(v0[0], v0[1]); w.y = cvt_pk_bf16(v0[2], v0[3]); w.z = cvt_pk_bf16(v1[0], v1[1]); w.w = cvt_pk_bf16(v1[2], v1[3]);
                        *(u32x4*)(rowp + bj * HALF) = w; } }
        }
    }
};
struct EpiResid {
    static constexpr bool PERM = true, AFTER_DRAIN = false, RSTD_LDS = false, XPREFETCH = true;
    const float* xp; const float* xs; bool first; bf16_t* XB; float* ssq;
    __device__ __forceinline__ void prefetch(const Unit& u, PG8_LAS unsigned char* dump, int tid) const {
        if (first) return;
        const unsigned vo = (unsigned)(tid >> 2) * 2048u + (unsigned)(tid & 3) * 128u;
        const char* base = (const char*)(XB + (size_t)u.pm * BM * 1024 + u.pn * BM);
        __builtin_amdgcn_global_load_lds((const unsigned*)(base + vo), (PG8_LAS unsigned*)dump, 4, 0, 0);
        __builtin_amdgcn_global_load_lds((const unsigned*)(base + (size_t)128 * 2048 + vo), (PG8_LAS unsigned*)dump, 4, 0, 0);
    }
    __device__ __forceinline__ void operator()(const f32x4 (&acc)[2][2][4][2], const Unit& u, int wr, int wc, int fr, int fq) const {
        const int row0 = u.pm * BM + wr * 64 + fr, col0 = u.pn * BM + wc * 32 + 8 * fq;
#pragma unroll
        for (int ai = 0; ai < 2; ++ai)
#pragma unroll
            for (int m = 0; m < 4; ++m) { const int row = row0 + ai * HALF + m * 16;
                bf16_t* dstb = XB + (size_t)row * 1024 + col0; float ss = 0.f;
                f32x4 x0[2], x1[2];
                if (first) { const float* src = (row < 16384 ? xp + (size_t)row * 1024 : xs + (size_t)(row - 16384) * 1024) + col0;
#pragma unroll
                    for (int bj = 0; bj < 2; ++bj) { x0[bj] = *(const f32x4*)(src + bj * HALF); x1[bj] = *(const f32x4*)(src + bj * HALF + 4); } }
                else {
#pragma unroll
                    for (int bj = 0; bj < 2; ++bj) { const u32x4 q = *(const u32x4*)(dstb + bj * HALF);
                        x0[bj] = (f32x4){__builtin_bit_cast(float, q.x << 16), __builtin_bit_cast(float, q.x & 0xffff0000u), __builtin_bit_cast(float, q.y << 16), __builtin_bit_cast(float, q.y & 0xffff0000u)};
                        x1[bj] = (f32x4){__builtin_bit_cast(float, q.z << 16), __builtin_bit_cast(float, q.z & 0xffff0000u), __builtin_bit_cast(float, q.w << 16), __builtin_bit_cast(float, q.w & 0xffff0000u)}; } }
#pragma unroll
                for (int bj = 0; bj < 2; ++bj) { const f32x4 o0 = x0[bj] + acc[ai][bj][m][0], o1 = x1[bj] + acc[ai][bj][m][1];
                    u32x4 w; w.x = cvt_pk_bf16(o0[0], o0[1]); w.y = cvt_pk_bf16(o0[2], o0[3]); w.z = cvt_pk_bf16(o1[0], o1[1]); w.w = cvt_pk_bf16(o1[2], o1[3]);
                    *(u32x4*)(dstb + bj * HALF) = w;
                    ss += ((o0[0] * o0[0] + o0[1] * o0[1]) + (o0[2] * o0[2] + o0[3] * o0[3])) + ((o1[0] * o1[0] + o1[1] * o1[1]) + (o1[2] * o1[2] + o1[3] * o1[3])); }
                ss += __shfl_xor(ss, 16); ss += __shfl_xor(ss, 32);
                if (fq == 0) ssq[((size_t)u.pn * 17408 + row) * 4 + wc] = ss; }
    }
};
struct EpiSwiGLU {
    static constexpr bool PERM = true, AFTER_DRAIN = false, RSTD_LDS = true, XPREFETCH = false;
    bf16_t* ACT; const float* ssq; const PG8_LAS float* rl;
    __device__ __forceinline__ void operator()(const f32x4 (&acc)[2][2][4][2], const Unit& u, int wr, int wc, int fr, int fq) const {
        const int row0 = u.pm * BM + wr * 64 + fr, col0 = u.pn * HALF + wc * 32 + 8 * fq;
        float rsv[2][4]; rows_rstd_lds(rl, wr * 64 + fr, rsv);
#pragma unroll
        for (int ai = 0; ai < 2; ++ai)
#pragma unroll
            for (int m = 0; m < 4; ++m) { const int row = row0 + ai * HALF + m * 16;
                const float rs = rsv[ai][m], rsn = rs * -1.4426950408889634f, rs2 = rs * rs;
                float o[8];
#pragma unroll
                for (int j = 0; j < 4; ++j) { const float a0 = acc[ai][0][m][0][j], a1 = acc[ai][0][m][1][j];
                    o[j] = (a0 * acc[ai][1][m][0][j]) * (__builtin_amdgcn_rcpf(1.0f + __builtin_amdgcn_exp2f(a0 * rsn)) * rs2); o[4 + j] = (a1 * acc[ai][1][m][1][j]) * (__builtin_amdgcn_rcpf(1.0f + __builtin_amdgcn_exp2f(a1 * rsn)) * rs2); }
                u32x4 w; w.x = cvt_pk_bf16(o[0], o[1]); w.y = cvt_pk_bf16(o[2], o[3]); w.z = cvt_pk_bf16(o[4], o[5]); w.w = cvt_pk_bf16(o[6], o[7]);
                *(u32x4*)(ACT + (size_t)row * 2816 + col0) = w; }
    }
};

template <class Epi, class Sched, bool ALIGN_EPI = false, bool SP2 = false>
__device__ __forceinline__ void gemm_phase(PG8_LAS unsigned char* lds, const Gemm g, const Sched& S, const Epi& E, int tidp) {
    int tid_ = tidp; asm volatile("" : "+v"(tid_));
    const int tid = tid_, wid = __builtin_amdgcn_readfirstlane(tid >> 6), lane = tid & 63, wr = wid >> 2, wc = wid & 3, fr = lane & 15, fq = lane >> 4;
    const int K = g.K, nt = K / BK;
    unsigned voffA[2], voffB[2];
#pragma unroll
    for (int i = 0; i < 2; ++i) { int R, C; stage_rc(tid * 16 + i * 8192, R, C); const int Rb = Epi::PERM ? ((R & ~31) + perm32(R & 31)) : R;
        voffA[i] = (unsigned)(R * K + C) * 2u; voffB[i] = (unsigned)(Rb * K + C) * 2u; }
    const size_t kstep = (size_t)(BK * 2);
    const size_t hstep = (size_t)HALF * K * 2;
    const size_t tstep = 2 * hstep;
    const unsigned ldsw = (unsigned)wid * 1024u;
    const int aoff = lds_byte(wr * 64 + fr, fq * 8), boff = lds_byte(wc * 32 + fr, fq * 8);
#define PG8_SA(b, h) (((b) * 2 + (h)) * HTB)
#define PG8_SB(b, h) ((4 + (b) * 2 + (h)) * HTB)
#define PG8_STAGE(bufoff, gbase, voff) do { _Pragma("unroll") for (int _i = 0; _i < 2; ++_i) \
        __builtin_amdgcn_global_load_lds((const unsigned*)((const char*)(gbase) + (voff)[_i]), (PG8_LAS unsigned*)(lds + (bufoff) + ldsw + _i * 8192), 16, 0, 0); } while (0)
#define PG8_LDA(dst, b, h) do { _Pragma("unroll") for (int m = 0; m < 4; ++m) _Pragma("unroll") for (int k = 0; k < 2; ++k) dst[m][k] = *(const PG8_LAS bf16x8*)(lds + PG8_SA(b, h) + aoff + m * 2048 + k * 1024); } while (0)
#define PG8_LDB(dst, b, h) do { _Pragma("unroll") for (int n = 0; n < 2; ++n) _Pragma("unroll") for (int k = 0; k < 2; ++k) dst[n][k] = *(const PG8_LAS bf16x8*)(lds + PG8_SB(b, h) + boff + n * 2048 + k * 1024); } while (0)
#define PG8_MMA(ai, bj, At, Bt) do { __builtin_amdgcn_s_setprio(1); _Pragma("unroll") for (int m = 0; m < 4; ++m) _Pragma("unroll") for (int n = 0; n < 2; ++n) _Pragma("unroll") for (int k = 0; k < 2; ++k) \
        acc[ai][bj][m][n] = __builtin_amdgcn_mfma_f32_16x16x32_bf16(Bt[n][k], At[m][k], acc[ai][bj][m][n], 0, 0, 0); __builtin_amdgcn_s_setprio(0); } while (0)
#define PG8_WAIT_V(n) asm volatile("s_waitcnt vmcnt(" #n ")" ::: "memory")
#define PG8_WAIT_L(n) asm volatile("s_waitcnt lgkmcnt(" #n ")" ::: "memory")
#define PG8_BAR __builtin_amdgcn_s_barrier()
#define PG8_SCHED __builtin_amdgcn_sched_barrier(0)
    Unit cur, nxt; int ui = 0;
    if (!S.next(0, cur)) return;
    f32x4 acc[2][2][4][2];
#pragma unroll
    for (int a = 0; a < 2; ++a)
#pragma unroll
        for (int b = 0; b < 2; ++b)
#pragma unroll
            for (int m = 0; m < 4; ++m)
#pragma unroll
                for (int n = 0; n < 2; ++n) acc[a][b][m][n] = (f32x4){0.f, 0.f, 0.f, 0.f};
    bf16x8 At[4][2], B0[2][2], B1[2][2];
    const char* cA = (const char*)g.A + (size_t)cur.pm * tstep; const char* cB = (const char*)g.Bt + (size_t)cur.pn * tstep;
    S.a_ready(cur);
    if constexpr (SP2) {
        PG8_STAGE(PG8_SB(0, 0), cB, voffB); PG8_STAGE(PG8_SB(0, 1), cB + hstep, voffB); PG8_STAGE(PG8_SA(0, 0), cA, voffA); PG8_STAGE(PG8_SA(0, 1), cA + hstep, voffA);
        if (wr == 1) PG8_BAR;
        PG8_WAIT_V(2); PG8_BAR;
        PG8_STAGE(PG8_SB(1, 0), cB + kstep, voffB); PG8_STAGE(PG8_SA(1, 0), cA + kstep, voffA); PG8_STAGE(PG8_SB(1, 1), cB + hstep + kstep, voffB);
        PG8_WAIT_V(6); PG8_BAR;
    } else {
        PG8_STAGE(PG8_SB(0, 0), cB, voffB); PG8_STAGE(PG8_SA(0, 0), cA, voffA); PG8_STAGE(PG8_SB(0, 1), cB + hstep, voffB); PG8_STAGE(PG8_SA(0, 1), cA + hstep, voffA);
        if (wr == 1) PG8_BAR;
        PG8_WAIT_V(4); PG8_BAR;
        PG8_STAGE(PG8_SB(1, 0), cB + kstep, voffB); PG8_STAGE(PG8_SA(1, 0), cA + kstep, voffA); PG8_STAGE(PG8_SB(1, 1), cB + hstep + kstep, voffB);
        PG8_WAIT_V(6); PG8_BAR;
    }
    for (;;) {
        const bool has_next = S.next(ui + 1, nxt);
        const char* nA = has_next ? (const char*)g.A + (size_t)nxt.pm * tstep : cA; const char* nB = has_next ? (const char*)g.Bt + (size_t)nxt.pn * tstep : cB;
#ifdef DBG_KLOOP_T
        if (ui == DBG_KLOOP_UNIT + 1 && blockIdx.x == DBG_T_BLK && tid == 0) { ((volatile PG8_LAS unsigned long long*)(lds + 147456 + 320 + 256))[8] = __builtin_amdgcn_s_memtime(); }
        if (ui == DBG_KLOOP_UNIT && blockIdx.x == DBG_T_BLK && tid == 0) { ((volatile PG8_LAS unsigned long long*)(lds + 147456 + 320 + 256))[4] = __builtin_amdgcn_s_memtime(); ((volatile PG8_LAS unsigned long long*)(lds + 147456 + 320 + 256))[5] = __builtin_amdgcn_s_memrealtime(); }
#endif
        for (int t = 0; t < nt; t += 2) {
            const bool last = (t == nt - 2);
            if constexpr (Epi::RSTD_LDS) {
                if (t == 2 || t == 4) { PG8_WAIT_V(8);
                    const f32x4 v = *(const PG8_LAS f32x4*)(lds + RSTD_RAW_OFF + ldsw + lane * 16);
                    float s = (v[0] + v[1]) + (v[2] + v[3]); s += __shfl_xor(s, 1); s += __shfl_xor(s, 2);
                    if (!(tid & 3)) *(PG8_LAS float*)(lds + RSTD_LDS_OFF + ((t - 2) * 64 + (tid >> 2)) * 4) = __builtin_amdgcn_rsqf(s * (1.0f / 1024.0f) + 1e-6f);
                    PG8_WAIT_L(0); }
                if (t == 0 || t == 2) __builtin_amdgcn_global_load_lds((const unsigned*)(E.ssq + ((size_t)(tid & 3) * 17408 + (size_t)cur.pm * BM + t * 64 + (tid >> 2)) * 4), (PG8_LAS unsigned*)(lds + RSTD_RAW_OFF + ldsw), 16, 0, 0);
            }
            if constexpr (Epi::XPREFETCH) { if (t == nt - XPF_LEAD) E.prefetch(cur, lds + RSTD_RAW_OFF + ldsw, tid); }
            const char* a1 = cA + (size_t)(t + 1) * kstep;
            const char* a2 = last ? nA : cA + (size_t)(t + 2) * kstep; const char* b2 = last ? nB : cB + (size_t)(t + 2) * kstep;
            const char* a3 = a2 + kstep; const char* b3 = b2 + kstep;
            if (last && has_next) S.a_ready(nxt);
            if constexpr (SP2) {
            PG8_LDB(B0, 0, 0); PG8_LDB(B1, 0, 1); PG8_SCHED; PG8_LDA(At, 0, 0); PG8_STAGE(PG8_SA(1, 1), a1 + hstep, voffA);
            PG8_WAIT_V(8); PG8_WAIT_L(0); PG8_BAR; PG8_MMA(0, 0, At, B0); PG8_MMA(0, 1, At, B1); PG8_BAR; PG8_SCHED;
            PG8_LDA(At, 0, 1); PG8_STAGE(PG8_SB(0, 0), b2, voffB); PG8_STAGE(PG8_SB(0, 1), b2 + hstep, voffB); PG8_STAGE(PG8_SA(0, 0), a2, voffA);
            PG8_WAIT_V(8); PG8_WAIT_L(0); PG8_BAR; PG8_MMA(1, 0, At, B0); PG8_MMA(1, 1, At, B1); PG8_BAR; PG8_SCHED;
            PG8_LDB(B0, 1, 0); PG8_LDB(B1, 1, 1); PG8_SCHED; PG8_LDA(At, 1, 0); PG8_STAGE(PG8_SA(0, 1), a2 + hstep, voffA);
            PG8_WAIT_V(8); PG8_WAIT_L(0); PG8_BAR; PG8_MMA(0, 0, At, B0); PG8_MMA(0, 1, At, B1); PG8_BAR; PG8_SCHED;
            PG8_LDA(At, 1, 1); PG8_STAGE(PG8_SB(1, 0), b3, voffB); PG8_STAGE(PG8_SB(1, 1), b3 + hstep, voffB); PG8_STAGE(PG8_SA(1, 0), a3, voffA);
            PG8_WAIT_V(8); PG8_WAIT_L(0); PG8_BAR; PG8_MMA(1, 0, At, B0); PG8_MMA(1, 1, At, B1); PG8_BAR; PG8_SCHED;
            } else {
            PG8_LDB(B0, 0, 0); PG8_SCHED; PG8_LDA(At, 0, 0); PG8_STAGE(PG8_SA(1, 1), a1 + hstep, voffA);
            PG8_WAIT_L(8); PG8_BAR; PG8_WAIT_L(0); PG8_MMA(0, 0, At, B0); PG8_BAR; PG8_SCHED;
            PG8_LDB(B1, 0, 1); PG8_STAGE(PG8_SB(0, 0), b2, voffB);
            PG8_BAR; PG8_WAIT_L(0); PG8_MMA(0, 1, At, B1); PG8_BAR;
            PG8_LDA(At, 0, 1); PG8_STAGE(PG8_SA(0, 0), a2, voffA);
            PG8_BAR; PG8_WAIT_L(0); PG8_MMA(1, 0, At, B0); PG8_BAR; PG8_SCHED;
            PG8_STAGE(PG8_SB(0, 1), b2 + hstep, voffB);
            PG8_WAIT_V(6); PG8_BAR; PG8_MMA(1, 1, At, B1); PG8_BAR;
            PG8_LDB(B0, 1, 0); PG8_SCHED; PG8_LDA(At, 1, 0); PG8_STAGE(PG8_SA(0, 1), a2 + hstep, voffA);
            PG8_WAIT_L(8); PG8_BAR; PG8_WAIT_L(0); PG8_MMA(0, 0, At, B0); PG8_BAR; PG8_SCHED;
            PG8_LDB(B1, 1, 1); PG8_STAGE(PG8_SB(1, 0), b3, voffB);
            PG8_BAR; PG8_WAIT_L(0); PG8_MMA(0, 1, At, B1); PG8_BAR;
            PG8_LDA(At, 1, 1); PG8_STAGE(PG8_SA(1, 0), a3, voffA);
            PG8_BAR; PG8_WAIT_L(0); PG8_MMA(1, 0, At, B0); PG8_BAR; PG8_SCHED;
            PG8_STAGE(PG8_SB(1, 1), b3 + hstep, voffB);
            PG8_WAIT_V(6); PG8_BAR; PG8_MMA(1, 1, At, B1); PG8_BAR;
            }
        }
#ifdef DBG_KLOOP_T
        if (ui == DBG_KLOOP_UNIT && blockIdx.x == DBG_T_BLK && tid == 0) { ((volatile PG8_LAS unsigned long long*)(lds + 147456 + 320 + 256))[6] = __builtin_amdgcn_s_memtime(); ((volatile PG8_LAS unsigned long long*)(lds + 147456 + 320 + 256))[7] = __builtin_amdgcn_s_memrealtime(); }
#endif
        if constexpr (ALIGN_EPI) { if (wr == 0) PG8_BAR; }
        if constexpr (!Epi::AFTER_DRAIN) { E(acc, cur, wr, wc, fr, fq); S.done(cur); }
        if (!has_next) break;
#pragma unroll
        for (int a = 0; a < 2; ++a)
#pragma unroll
            for (int b = 0; b < 2; ++b)
#pragma unroll
                for (int m = 0; m < 4; ++m)
#pragma unroll
                    for (int n = 0; n < 2; ++n) acc[a][b][m][n] = (f32x4){0.f, 0.f, 0.f, 0.f};
        cur = nxt; cA = nA; cB = nB; ++ui;
        if constexpr (ALIGN_EPI) { if (wr == 1) PG8_BAR; }
    }
    PG8_WAIT_V(0);
    if constexpr (!ALIGN_EPI) { if (wr == 0) PG8_BAR; }
    PG8_BAR;
    if constexpr (Epi::AFTER_DRAIN) { E.fused(acc, cur, wr, wc, fr, fq, lds, wid, lane); S.done(cur); }
#undef PG8_SA
#undef PG8_SB
#undef PG8_STAGE
#undef PG8_LDA
#undef PG8_LDB
#undef PG8_MMA
#undef PG8_WAIT_V
#undef PG8_WAIT_L
#undef PG8_BAR
#undef PG8_SCHED
}
}
constexpr int D = 1024, MP = 16384, MS = 1024, M = MP + MS, NLAYER = 4, MIXW = 256, INC = 5888, PMC = 1792, GTC = 4096, FF = 2816;
constexpr int SEQ = 2048, NB = 8, DB = 128, DSEQ = 8, NCH = SEQ / 64;
constexpr int NPHASE = 2 + 7 * NLAYER;
#ifndef MK_PER_PHASE
#define MK_PER_PHASE 0
#endif
constexpr size_t O_Y = 0, O_POOLP = 17825792, O_POOLS = 17948672, O_SREP = 19914752, O_SRES = 19947520, O_SIMP = 20471808, O_SIMS = 20504576,
                 O_SCP = 21028864, O_SCS = 21045248, O_CFP = 21307392, O_CFS = 21553152, O_END = 25485312;
constexpr size_t MiB = 1u << 20;
constexpr size_t WS_CTL = 0, CTL_ZERO_BYTES = 64 * 1024;
constexpr size_t WS_SSQ = 1 * MiB;
constexpr size_t WS_E = 3 * MiB;
constexpr size_t WS_TAB = 5 * MiB;
constexpr size_t TAB_LB = 0, TAB_LP = 8192, TAB_BBT = 16384, TAB_CM = TAB_BBT + 65536, TAB_PW = TAB_CM + 65536, TAB_STRIDE = TAB_PW + 32768;
constexpr size_t WS_WIN = 6 * MiB;
constexpr size_t WS_WFI = WS_WIN + (size_t)NLAYER * INC * D * 2;
constexpr size_t WS_WOUT = WS_WFI + (size_t)NLAYER * 2 * FF * D * 2;
constexpr size_t WS_WFO = WS_WOUT + (size_t)NLAYER * D * D * 2;
constexpr size_t WS_WBR = WS_WFO + (size_t)NLAYER * D * FF * 2;
constexpr size_t WS_WGLU = WS_WBR + (size_t)NLAYER * 4 * D * MIXW * 2;
constexpr size_t WS_ACT1 = WS_WGLU + (size_t)NLAYER * MIXW * MIXW * 2;
constexpr size_t WS_PM = WS_ACT1 + (size_t)M * D * 2;
constexpr size_t WS_GT = WS_PM + (size_t)M * PMC * 2;
constexpr size_t WS_END = WS_GT + (size_t)M * GTC * 2;
static_assert(WS_TAB + NLAYER * TAB_STRIDE <= WS_WIN && WS_E + (size_t)NB * NCH * 1024 * 8 <= WS_TAB && WS_SSQ + (size_t)M * 64 <= WS_E, "d_ws map");
constexpr int CW_Q = 8192;
constexpr int CW_BAR = 1024;
constexpr int RING_OFF = 0, RING_BYTES = 147456;
constexpr int LDSCTL_OFF = RING_BYTES, MISC_OFF = LDSCTL_OFF + 320;
constexpr int LDS_BYTES = 163840;
constexpr int NWAVES = 8;

#define GAS __attribute__((address_space(1)))
#define LAS __attribute__((address_space(3)))
typedef unsigned short bf16;
typedef unsigned short bf16_t;
typedef unsigned v4u __attribute__((ext_vector_type(4)));
typedef unsigned v2u __attribute__((ext_vector_type(2)));
typedef float f32x4 __attribute__((ext_vector_type(4)));
typedef float f32x2 __attribute__((ext_vector_type(2)));
typedef short bf16x8 __attribute__((ext_vector_type(8)));
#define LDS_WAIT() asm volatile("s_waitcnt lgkmcnt(0)" ::: "memory")
#define VM_WAIT() asm volatile("s_waitcnt vmcnt(0)" ::: "memory")
__device__ __forceinline__ unsigned pk2(float lo, float hi) { return pg8::cvt_pk_bf16(lo, hi); }
__device__ __forceinline__ float bflo(unsigned u) { return __builtin_bit_cast(float, u << 16); }
__device__ __forceinline__ float bfhi(unsigned u) { return __builtin_bit_cast(float, u & 0xffff0000u); }
__device__ __forceinline__ float bf1(bf16_t b) { return __builtin_bit_cast(float, (unsigned)b << 16); }
__device__ __forceinline__ void unpack8(const v4u v, float (&f)[8]) { f[0] = bflo(v.x); f[1] = bfhi(v.x); f[2] = bflo(v.y); f[3] = bfhi(v.y); f[4] = bflo(v.z); f[5] = bfhi(v.z); f[6] = bflo(v.w); f[7] = bfhi(v.w); }
__device__ __forceinline__ v4u pack8(const float (&f)[8]) { v4u w; w.x = pk2(f[0], f[1]); w.y = pk2(f[2], f[3]); w.z = pk2(f[4], f[5]); w.w = pk2(f[6], f[7]); return w; }
__device__ __forceinline__ float sigm(float x) { return pg8::sigm(x); }
__device__ __forceinline__ float gelu_tanh(float y) { const float in2 = 1.5957691216057308f * (y + 0.044715f * y * y * y); const float e = __builtin_amdgcn_exp2f(1.4426950408889634f * in2); return 0.5f * y * (2.0f - 2.0f * __builtin_amdgcn_rcpf(e + 1.0f)); }
__device__ __forceinline__ float wave_sum(float v) {
#pragma unroll
    for (int o = 1; o < 64; o <<= 1) v += __shfl_xor(v, o);
    return v;
}

#define XB_TMO      128
#define XB_XCNT(j)  (256  + 64 * (j))
#define XB_XSUB(j)  (1280 + 64 * (j))
#define XB_XGEN(j)  (2304 + 64 * (j))
#define XB_TOP      3328
#define XB_TOPGEN   3392
#define XCD_BAR_WORDS 3456
#define XB_SPIN_CAP (1u << 18)

__device__ __forceinline__ unsigned xb_ld(unsigned* p)              { return __hip_atomic_load(p, __ATOMIC_RELAXED, __HIP_MEMORY_SCOPE_AGENT); }
__device__ __forceinline__ unsigned xb_add(unsigned* p, unsigned v) { return __hip_atomic_fetch_add(p, v, __ATOMIC_RELAXED, __HIP_MEMORY_SCOPE_AGENT); }
__device__ __forceinline__ unsigned xb_xcc_id() { return (unsigned)__builtin_amdgcn_s_getreg((3 << 11) | 20) & 0xFu; }
#define XB_SPIN(cond, bar) do { unsigned _sp = 0; while (cond) { __builtin_amdgcn_s_sleep(1); \
    if ((++_sp & 255u) == 0u) { if (xb_ld(&(bar)[XB_TMO])) break; if (_sp > XB_SPIN_CAP) { atomicAdd(&(bar)[XB_TMO], 1u); break; } } } } while (0)

struct XcdBarrier {
    unsigned* bar; unsigned x;
    volatile LAS unsigned* st;
};

__device__ __forceinline__ XcdBarrier xcd_barrier_post(unsigned* bar, volatile LAS unsigned* st) {
    XcdBarrier b; b.bar = bar; b.x = xb_xcc_id(); b.st = st;
    if (threadIdx.x == 0) (void)xb_add(&bar[XB_XCNT(b.x)], 1u);
    return b;
}
__device__ __forceinline__ void xcd_barrier_complete(unsigned* bar, unsigned x, unsigned& nloc, unsigned& nx) {
    const unsigned G = gridDim.x * gridDim.y * gridDim.z;
    unsigned sum, cnt, mine, sp = 0u;
    for (;;) {
        sum = 0u; cnt = 0u; mine = 0u;
#pragma unroll
        for (unsigned j = 0; j < 16; ++j) { const unsigned c = xb_ld(&bar[XB_XCNT(j)]); sum += c; cnt += (c > 0u) ? 1u : 0u; mine = (j == x) ? c : mine; }
        if (sum == G) break;
        __builtin_amdgcn_s_sleep(1);
        if ((++sp & 255u) == 0u) { if (xb_ld(&bar[XB_TMO])) break; if (sp > XB_SPIN_CAP) { atomicAdd(&bar[XB_TMO], 1u); break; } }
    }
    nloc = mine > 0u ? mine : 1u; nx = cnt > 0u ? cnt : 1u;
}

__device__ __forceinline__ void xcd_barrier_leader(const XcdBarrier& b) {
    {
        unsigned* bar = b.bar;
        __builtin_amdgcn_s_waitcnt(0);
        unsigned nloc = b.st[0], nx = b.st[1];
        if (nloc == 0u) { xcd_barrier_complete(bar, b.x, nloc, nx); b.st[0] = nloc; b.st[1] = nx; }
        const unsigned old = xb_add(&bar[XB_XSUB(b.x)], 1u);
        const unsigned gen = old / nloc;
        if (old + 1u == (gen + 1u) * nloc) {
            __builtin_amdgcn_fence(__ATOMIC_RELEASE, "agent");
            asm volatile("s_waitcnt vmcnt(0)" ::: "memory");
            const unsigned og = xb_add(&bar[XB_TOP], 1u);
            const unsigned tg = og / nx;
            if (og + 1u == (tg + 1u) * nx) xb_add(&bar[XB_TOPGEN], 1u);
            else XB_SPIN(xb_ld(&bar[XB_TOPGEN]) == tg, bar);
            __builtin_amdgcn_fence(__ATOMIC_ACQUIRE, "agent");
            xb_add(&bar[XB_XGEN(b.x)], 1u);
            asm volatile("s_waitcnt vmcnt(0)" ::: "memory");
        } else {
            XB_SPIN(xb_ld(&bar[XB_XGEN(b.x)]) == gen, bar);
            __builtin_amdgcn_fence(__ATOMIC_ACQUIRE, "agent");
            asm volatile("s_waitcnt vmcnt(0)" ::: "memory");
        }
    }
}
__device__ __forceinline__ void xcd_barrier(const XcdBarrier& b, bool leader) {
    asm volatile("s_waitcnt vmcnt(0)" ::: "memory");
    __syncthreads();
    if (leader) xcd_barrier_leader(b);
    __syncthreads();
}
struct Args { const float* in[32]; float* out; unsigned char* ws; int ph_lo, ph_hi; };
enum { I_XP = 0, I_XS, I_STPOOL, I_STRE, I_STIM, I_STSC, I_STCF, I_N1G, I_N2G, I_FING, I_WIN, I_BGATE, I_POOLW, I_POOLSC, I_LAMRE, I_LAMIM, I_LOGDT,
       I_BRE, I_BIM, I_CRE, I_CIM, I_DSKIP, I_WGLU, I_BGLU, I_SCW, I_CFW, I_CFLNG, I_CFLNB, I_WBR, I_WOUT, I_WFI, I_WFO };

__device__ __forceinline__ void p0_item(const float* W, int ldw, int src_col0, const float* kscale, int k0, bf16* WTrow0, int K, LAS float* scr, int lane) {
    float wv[32];
#pragma unroll
    for (int i = 0; i < 32; ++i) { const int kk = 2 * i + (lane >> 5); wv[i] = W[(size_t)(k0 + kk) * ldw + src_col0 + (lane & 31)]; }
#pragma unroll
    for (int i = 0; i < 32; ++i) { const int kk = 2 * i + (lane >> 5); scr[kk * 33 + (lane & 31)] = wv[i]; }
    LDS_WAIT(); asm volatile("" ::: "memory");
    const int c = lane & 7;
    f32x4 ks0 = (f32x4){1.f, 1.f, 1.f, 1.f}, ks1 = ks0;
    if (kscale) { ks0 = *(const f32x4*)(kscale + k0 + 8 * c); ks1 = *(const f32x4*)(kscale + k0 + 8 * c + 4); }
#pragma unroll
    for (int j = 0; j < 4; ++j) { const int n = (lane >> 3) + 8 * j; const LAS float* s = scr + (8 * c) * 33 + n;
        v4u o; o.x = pk2(s[0 * 33] * ks0[0], s[1 * 33] * ks0[1]); o.y = pk2(s[2 * 33] * ks0[2], s[3 * 33] * ks0[3]); o.z = pk2(s[4 * 33] * ks1[0], s[5 * 33] * ks1[1]); o.w = pk2(s[6 * 33] * ks1[2], s[7 * 33] * ks1[3]);
        *(GAS v4u*)(WTrow0 + (size_t)n * K + k0 + 8 * c) = o; }
    LDS_WAIT(); asm volatile("" ::: "memory");
}
constexpr int P0_IT_IN = 16 * (INC / 32), P0_IT_FI = 16 * (2 * FF / 32), P0_IT_OUT = 16 * 32, P0_IT_FO = (FF / 64) * 32, P0_IT_BR = 4 * 4 * 32, P0_IT_GLU = 4 * 8;
constexpr int P0_IT_LAYER = P0_IT_IN + P0_IT_FI + P0_IT_OUT + P0_IT_FO + P0_IT_BR + P0_IT_GLU;
__device__ __forceinline__ void p0_weight_item(const Args& a, int L, int r, LAS float* scr, int lane) {
    unsigned char* ws = a.ws;
    if (r < P0_IT_IN) { const int nblk = INC / 32, kb = r / nblk, nb = r % nblk;
        p0_item(a.in[I_WIN] + (size_t)L * D * INC, INC, 32 * nb, a.in[I_N1G] + L * D, 64 * kb, (bf16*)(ws + WS_WIN) + ((size_t)L * INC + 32 * nb) * D, D, scr, lane); return; } r -= P0_IT_IN;
    if (r < P0_IT_FI) { const int nblk = 2 * FF / 32, kb = r / nblk, nb = r % nblk; const int nd = 32 * nb, pn = nd >> 8, rr = nd & 255;
        const int src = rr < 128 ? 128 * pn + rr : FF + 128 * pn + (rr - 128);
        p0_item(a.in[I_WFI] + (size_t)L * D * 2 * FF, 2 * FF, src, a.in[I_N2G] + L * D, 64 * kb, (bf16*)(ws + WS_WFI) + ((size_t)L * 2 * FF + nd) * D, D, scr, lane); return; } r -= P0_IT_FI;
    if (r < P0_IT_OUT) { const int kb = r / 32, nb = r % 32;
        p0_item(a.in[I_WOUT] + (size_t)L * D * D, D, 32 * nb, nullptr, 64 * kb, (bf16*)(ws + WS_WOUT) + ((size_t)L * D + 32 * nb) * D, D, scr, lane); return; } r -= P0_IT_OUT;
    if (r < P0_IT_FO) { const int kb = r / 32, nb = r % 32;
        p0_item(a.in[I_WFO] + (size_t)L * FF * D, D, 32 * nb, nullptr, 64 * kb, (bf16*)(ws + WS_WFO) + ((size_t)L * D + 32 * nb) * FF, FF, scr, lane); return; } r -= P0_IT_FO;
    if (r < P0_IT_BR) { const int br = r / 128, q = r % 128, kb = q / 32, nb = q % 32;
        p0_item(a.in[I_WBR] + (size_t)(L * 4 + br) * MIXW * D, D, 32 * nb, nullptr, 64 * kb, (bf16*)(ws + WS_WBR) + ((size_t)(L * 4 + br) * D + 32 * nb) * MIXW, MIXW, scr, lane); return; } r -= P0_IT_BR;
    { const int kb = r / 8, nb = r % 8;
        p0_item(a.in[I_WGLU] + (size_t)L * MIXW * MIXW, MIXW, 32 * nb, nullptr, 64 * kb, (bf16*)(ws + WS_WGLU) + ((size_t)L * MIXW + 32 * nb) * MIXW, MIXW, scr, lane); }
}
constexpr int P0_SLICES = 6, P0_F_PER = 7, P0_A_PER = 2, P0_F_BID0 = 216, P0_A_BID0 = 192;
__device__ __forceinline__ int p0_items_A(int G) { return 0; }
__device__ __forceinline__ int p0_items_F(int G) { return G == 256 ? (256 - P0_F_BID0) * NWAVES * P0_F_PER : 0; }
__device__ __forceinline__ void p0_idle_items(const Args& a, LAS unsigned char* lds, int lane, int wave, int bid, int L, int base, int bid0, int per) {
    LAS float* scr = (LAS float*)(lds + RING_OFF + wave * 16384);
    const int nw = (256 - bid0) * NWAVES, w = (bid - bid0) * NWAVES + wave;
    for (int q = 0; q < per; ++q) p0_weight_item(a, L, base + w + q * nw, scr, lane);
}
__device__ __forceinline__ void p0_slice(const Args& a, LAS unsigned char* lds, int lane, int wave, int G, int bid, int L, int slice) {
    LAS float* scr = (LAS float*)(lds + RING_OFF + wave * 16384);
    const int first = p0_items_A(G) + p0_items_F(G), per = (P0_IT_LAYER - first + P0_SLICES - 1) / P0_SLICES;
    const int lo = first + slice * per, hi = (lo + per < P0_IT_LAYER) ? lo + per : P0_IT_LAYER;
    for (int r = lo + bid * (NWAVES - 1) + (wave - 1); r < hi; r += G * (NWAVES - 1)) p0_weight_item(a, L, r, scr, lane);
}
__device__ __forceinline__ void p0_prologue(const Args& a, LAS unsigned char* lds, int tid, int lane, int wave, int G, int bid) {
    LAS float* scr = (LAS float*)(lds + RING_OFF + wave * 16384);
    const int gw = bid * NWAVES + wave, NGW = G * NWAVES;
    unsigned char* ws = a.ws;
    for (int it = gw; it < (MK_PER_PHASE ? NLAYER : 1) * P0_IT_LAYER; it += NGW) p0_weight_item(a, it / P0_IT_LAYER, it % P0_IT_LAYER, scr, lane);
    for (int m = gw; m < M; m += NGW) {
        const float* xrow = m < MP ? a.in[I_XP] + (size_t)m * D : a.in[I_XS] + (size_t)(m - MP) * D;
        const GAS f32x4* xr = (const GAS f32x4*)xrow + lane; f32x4 v[4]; float s = 0.f;
#pragma unroll
        for (int j = 0; j < 4; ++j) { v[j] = xr[64 * j]; s += (v[j][0] * v[j][0] + v[j][1] * v[j][1]) + (v[j][2] * v[j][2] + v[j][3] * v[j][3]); }
        s = wave_sum(s);
        GAS v2u* o8 = (GAS v2u*)((bf16*)(ws + WS_ACT1) + (size_t)m * D) + lane;
#pragma unroll
        for (int j = 0; j < 4; ++j) { v2u w; w.x = pk2(v[j][0], v[j][1]); w.y = pk2(v[j][2], v[j][3]); o8[64 * j] = w; }
        if (lane < 16) ((float*)(ws + WS_SSQ))[((size_t)(lane >> 2) * M + m) * 4 + (lane & 3)] = lane == 0 ? s : 0.f;
    }
    for (int idx = bid * 512 + tid; idx < NLAYER * 1024; idx += G * 512) {
        const int L = idx >> 10, gp = idx & 1023, g = gp >> 6, p = gp & 63;
        unsigned char* tab = ws + WS_TAB + (size_t)L * TAB_STRIDE;
        const float lre = a.in[I_LAMRE][idx], lim = a.in[I_LAMIM][idx], dt = expf(a.in[I_LOGDT][L * 16 + g]);
        const float ar = lre * dt, br_ = lim * dt, ea = expf(ar), cb = cosf(br_), sb = sinf(br_), sh = sinf(0.5f * br_);
        const float lbr = ea * cb, lbi = ea * sb;
        const float m1r = expm1f(ar) * cb - 2.0f * sh * sh, m1i = lbi;
        const float den = 1.0f / (lre * lre + lim * lim);
        const float qr = (m1r * lre + m1i * lim) * den, qi = (m1i * lre - m1r * lim) * den;
        ((f32x2*)(tab + TAB_LB))[gp] = (f32x2){lbr, lbi};
        float pr = lbr, pi = lbi;
#pragma unroll
        for (int s = 0; s < 6; ++s) { const float nr = pr * pr - pi * pi, ni = 2.0f * pr * pi; pr = nr; pi = ni; }
        ((f32x2*)(tab + TAB_LP))[gp] = (f32x2){pr, pi};
        bf16* bbt = (bf16*)(tab + TAB_BBT); bf16* cm = (bf16*)(tab + TAB_CM);
        const float* bre = a.in[I_BRE] + (size_t)idx * 16; const float* bim = a.in[I_BIM] + (size_t)idx * 16;
#pragma unroll
        for (int c = 0; c < 16; ++c) { const float Br = bre[c], Bi = bim[c];
            bbt[(g * 128 + p) * 16 + c] = (bf16)(pk2(qr * Br - qi * Bi, 0.f) & 0xffffu);
            bbt[(g * 128 + 64 + p) * 16 + c] = (bf16)(pk2(qr * Bi + qi * Br, 0.f) & 0xffffu);
            cm[(g * 16 + c) * 128 + p] = (bf16)(pk2(a.in[I_CRE][((size_t)(L * 16 + g) * 16 + c) * 64 + p], 0.f) & 0xffffu);
            cm[(g * 16 + c) * 128 + 64 + p] = (bf16)(pk2(-a.in[I_CIM][((size_t)(L * 16 + g) * 16 + c) * 64 + p], 0.f) & 0xffffu); }
    }
    for (int idx = bid * 512 + tid; idx < NLAYER * 4 * 64 * 64; idx += G * 512) {
        const int L = idx >> 14, r = idx & 16383, k = r >> 12, o = (r >> 6) & 63, c = r & 63;
        ((bf16*)(ws + WS_TAB + (size_t)L * TAB_STRIDE + TAB_PW))[r] = (bf16)(pk2(a.in[I_POOLW][((size_t)(L * 4 + k) * 64 + c) * 64 + o], 0.f) & 0xffffu);
    }
}
__device__ __forceinline__ void final_norm(const Args& a, int lane, int wave, int G, int bid) {
    const int gw = bid * NWAVES + wave, NGW = G * NWAVES;
    const float* ssq = (const float*)(a.ws + WS_SSQ);
    f32x4 gv[4];
#pragma unroll
    for (int j = 0; j < 4; ++j) gv[j] = ((const f32x4*)a.in[I_FING])[lane + 64 * j];
    for (int m = gw; m < M; m += NGW) {
        float s = lane < 16 ? ssq[((size_t)(lane >> 2) * M + m) * 4 + (lane & 3)] : 0.f; s = wave_sum(s);
        const float rs = __builtin_amdgcn_rsqf(s * (1.0f / 1024.0f) + 1e-6f);
        const GAS v2u* xb = (const GAS v2u*)((const bf16*)(a.ws + WS_ACT1) + (size_t)m * D) + lane;
        GAS f32x4* yr = (GAS f32x4*)(a.out + (size_t)m * D) + lane;
#pragma unroll
#ifdef DBG_HASH_Y
        for (int j = 0; j < 4; ++j) { const v2u q = xb[64 * j]; f32x4 v = (f32x4){bflo(q.x), bfhi(q.x), bflo(q.y), bfhi(q.y)}; v = v * rs * gv[j]; f32x4 h;
            for (int qq = 0; qq < 4; ++qq) { const unsigned b = __float_as_uint(v[qq]); const unsigned hh = (b * 2654435761u) ^ (b >> 15); h[qq] = (float)(hh >> 8) * (1.0f / 16777216.0f); }
            yr[64 * j] = h; }
#else
        for (int j = 0; j < 4; ++j) { const v2u q = xb[64 * j]; const f32x4 v = (f32x4){bflo(q.x), bfhi(q.x), bflo(q.y), bfhi(q.y)}; yr[64 * j] = v * rs * gv[j]; }
#endif
    }
}

typedef float f32x4_t __attribute__((ext_vector_type(4)));
#ifdef DBG_MIX_T
#define MIX_STAMP(i) do { if (((i) == DBG_TA || (i) == DBG_TB) && !SAMPLE && layer == 1 && blockIdx.x == DBG_T_BLK && wave == 0) { const unsigned long long t__ = __builtin_amdgcn_s_memrealtime(); if (lane == 0) ((volatile LAS unsigned long long*)(lds + 131072 + 320 + 256))[16 + (i)] = t__; } } while (0)
#else
#define MIX_STAMP(i) do {} while (0)
#endif
__device__ __forceinline__ float fma_s(float a, float b, float c) { float r; asm("v_fma_f32 %0, %1, %2, %3" : "=v"(r) : "v"(a), "v"(b), "v"(c)); return r; }
template <bool SAMPLE>
__device__ __forceinline__ void mix_unit(const Args& a, int layer, int uidx, LAS unsigned char* lds, int tid_in, int lane_in, int wave_in, int stages) {
    int tid = tid_in; asm volatile("" : "+v"(tid));
    const int lane = tid & 63, wave = __builtin_amdgcn_readfirstlane(tid >> 6);
#ifdef DBG_EXTRA_SYNC
    asm volatile("s_waitcnt vmcnt(0) lgkmcnt(0)" ::: "memory"); __syncthreads();
#endif
    constexpr int L = SAMPLE ? 8 : 64, NSEG = SAMPLE ? 2 : 1, R = NSEG * L;
    const bf16* PMb = (const bf16*)(a.ws + WS_PM); bf16* BR = (bf16*)a.out;
    const int s = uidx >> 5, c = uidx & 31, q0 = 2 * uidx;
    const int row0 = SAMPLE ? MP + q0 * 8 : s * SEQ + 64 * c;
    const bool last = SAMPLE || c == NCH - 1;
    LAS float* V = (LAS float*)lds;
    MIX_STAMP(0);
    if (stages & 1) {
        constexpr int TR = NSEG * (30 + L);
        LAS float* WCF = (LAS float*)(lds + 96256);
        {
            constexpr int NIT = (TR * 32 + 511) / 512;
            v4u qa[NIT], qb[NIT]; int kind[NIT];
#pragma unroll
            for (int it = 0; it < NIT; ++it) {
                const int idx = tid + it * 512; kind[it] = 0; qa[it] = (v4u){0u, 0u, 0u, 0u}; qb[it] = (v4u){0u, 0u, 0u, 0u};
                if (idx < TR * 32) {
                    const int rr = idx >> 5, c8 = (idx & 31) * 8, seg = rr / (30 + L), e = rr % (30 + L);
                    int srow = -1;
                    if (SAMPLE) { if (e >= 30) srow = MP + (q0 + seg) * 8 + (e - 30); }
                    else { const int tabs = c * 64 + e - 30; if (tabs >= 0) srow = s * SEQ + tabs; }
                    if (srow >= 0) { kind[it] = 1; qa[it] = *(const v4u*)(PMb + (size_t)srow * PMC + 1280 + c8); qb[it] = *(const v4u*)(PMb + (size_t)srow * PMC + 1536 + c8); }
                    else if (SAMPLE) { kind[it] = 2; const float* st = a.in[I_STCF] + ((size_t)(layer * DB + q0 + seg) * 30 + e) * MIXW + c8; qa[it] = *(const v4u*)st; qb[it] = *(const v4u*)(st + 4); }
                }
            }
#pragma unroll
            for (int it = 0; it < NIT; ++it) {
                const int idx = tid + it * 512;
                if (idx < TR * 32) {
                    const int rr = idx >> 5, c8 = (idx & 31) * 8;
                    float v[8];
                    if (kind[it] == 1) { float av[8], bv[8]; unpack8(qa[it], av); unpack8(qb[it], bv);
#pragma unroll
                        for (int j = 0; j < 8; ++j) v[j] = av[j] * sigm(bv[j]); }
                    else { v[0] = __uint_as_float(qa[it].x); v[1] = __uint_as_float(qa[it].y); v[2] = __uint_as_float(qa[it].z); v[3] = __uint_as_float(qa[it].w);
                           v[4] = __uint_as_float(qb[it].x); v[5] = __uint_as_float(qb[it].y); v[6] = __uint_as_float(qb[it].z); v[7] = __uint_as_float(qb[it].w); }
                    *(LAS f32x4*)(V + rr * 256 + c8) = (f32x4){v[0], v[1], v[2], v[3]}; *(LAS f32x4*)(V + rr * 256 + c8 + 4) = (f32x4){v[4], v[5], v[6], v[7]};
                }
            }
        }
        { f32x4 wq[4];
#pragma unroll
            for (int it = 0; it < 4; ++it) { const int idx = tid + it * 512; wq[it] = idx < 31 * 64 ? *(const f32x4*)(a.in[I_CFW] + (size_t)layer * 31 * MIXW + idx * 4) : (f32x4){0.f, 0.f, 0.f, 0.f}; }
#pragma unroll
            for (int it = 0; it < 4; ++it) { const int idx = tid + it * 512; if (idx < 31 * 64) *(LAS f32x4*)(WCF + idx * 4) = wq[it]; } }
        __syncthreads();
        MIX_STAMP(1);
        if (last) {
            for (int idx = tid; idx < NSEG * 30 * 64; idx += 512) { const int seg = idx / (30 * 64), r = idx % (30 * 64), j = r >> 6, c4 = (r & 63) * 4;
                float* dst = a.out + (SAMPLE ? O_CFS + ((size_t)(layer * DB + q0 + seg) * 30 + j) * MIXW : O_CFP + ((size_t)(layer * NB + s) * 30 + j) * MIXW) + c4;
                *(f32x4*)dst = *(LAS f32x4*)(V + (seg * (30 + L) + L + j) * 256 + c4); }
        }
        const f32x4 lg = *(const f32x4*)(a.in[I_CFLNG] + layer * MIXW + 4 * lane), lb = *(const f32x4*)(a.in[I_CFLNB] + layer * MIXW + 4 * lane);
        {
            constexpr int NT = R / NWAVES, TG = NT >= 4 ? 4 : NT;
#pragma unroll 1
            for (int g0 = 0; g0 < NT; g0 += TG) {
                f32x4 acc[TG]; int base[TG];
#pragma unroll
                for (int i = 0; i < TG; ++i) { const int tt = wave + NWAVES * (g0 + i), seg = tt / L, t = tt % L; base[i] = (seg * (30 + L) + t) * 256 + 4 * lane; acc[i] = (f32x4){0.f, 0.f, 0.f, 0.f}; }
#pragma unroll 4
                for (int j = 0; j < 31; ++j) { const f32x4 w = *(LAS f32x4*)(WCF + j * 256 + 4 * lane);
#pragma unroll
                    for (int i = 0; i < TG; ++i) acc[i] += w * *(LAS f32x4*)(V + base[i] + j * 256); }
                float s1[TG];
#pragma unroll
                for (int i = 0; i < TG; ++i) s1[i] = (acc[i][0] + acc[i][1]) + (acc[i][2] + acc[i][3]);
#pragma unroll
                for (int o = 1; o < 64; o <<= 1) {
#pragma unroll
                    for (int i = 0; i < TG; ++i) s1[i] += __shfl_xor(s1[i], o); }
                f32x4 d[TG]; float s2[TG];
#pragma unroll
                for (int i = 0; i < TG; ++i) { d[i] = acc[i] - s1[i] * (1.0f / 256.0f); s2[i] = (d[i][0] * d[i][0] + d[i][1] * d[i][1]) + (d[i][2] * d[i][2] + d[i][3] * d[i][3]); }
#pragma unroll
                for (int o = 1; o < 64; o <<= 1) {
#pragma unroll
                    for (int i = 0; i < TG; ++i) s2[i] += __shfl_xor(s2[i], o); }
#pragma unroll
                for (int i = 0; i < TG; ++i) { const int tt = wave + NWAVES * (g0 + i);
                    const float rstd = __builtin_amdgcn_rsqf(s2[i] * (1.0f / 256.0f) + 1e-5f);
                    const f32x4 yn = d[i] * rstd * lg + lb;
                    v2u w; w.x = pk2(yn[0] * sigm(yn[0]), yn[1] * sigm(yn[1])); w.y = pk2(yn[2] * sigm(yn[2]), yn[3] * sigm(yn[3]));
                    *(v2u*)(BR + (size_t)(row0 + tt) * D + 768 + 4 * lane) = w; }
            }
        }
        __syncthreads();
    }
    MIX_STAMP(2);
    if (stages & 2) {
        constexpr int TR = NSEG * (15 + L);
        LAS bf16* Dt = (LAS bf16*)(lds + 81920);
        {
            constexpr int NIT = (TR * 32 + 511) / 512;
            v4u qa[NIT], qb[NIT]; int kind[NIT];
#pragma unroll
            for (int it = 0; it < NIT; ++it) {
                const int idx = tid + it * 512; kind[it] = 0; qa[it] = (v4u){0u, 0u, 0u, 0u}; qb[it] = (v4u){0u, 0u, 0u, 0u};
                if (idx < TR * 32) {
                    const int rr = idx >> 5, c8 = (idx & 31) * 8, seg = rr / (15 + L), e = rr % (15 + L);
                    int srow = -1;
                    if (SAMPLE) { if (e >= 15) srow = MP + (q0 + seg) * 8 + (e - 15); }
                    else { const int tabs = c * 64 + e - 15; if (tabs >= 0) srow = s * SEQ + tabs; }
                    if (srow >= 0) { kind[it] = 1; qa[it] = *(const v4u*)(PMb + (size_t)srow * PMC + c8); }
                    else if (SAMPLE) { kind[it] = 2; const float* st = a.in[I_STPOOL] + ((size_t)(layer * DB + q0 + seg) * 15 + e) * MIXW + c8; qa[it] = *(const v4u*)st; qb[it] = *(const v4u*)(st + 4); }
                }
            }
#pragma unroll
            for (int it = 0; it < NIT; ++it) {
                const int idx = tid + it * 512;
                if (idx < TR * 32) {
                    const int rr = idx >> 5, c8 = (idx & 31) * 8;
                    float v[8];
                    if (kind[it] == 1) unpack8(qa[it], v);
                    else { v[0] = __uint_as_float(qa[it].x); v[1] = __uint_as_float(qa[it].y); v[2] = __uint_as_float(qa[it].z); v[3] = __uint_as_float(qa[it].w);
                           v[4] = __uint_as_float(qb[it].x); v[5] = __uint_as_float(qb[it].y); v[6] = __uint_as_float(qb[it].z); v[7] = __uint_as_float(qb[it].w); }
                    *(LAS f32x4*)(V + rr * 256 + c8) = (f32x4){v[0], v[1], v[2], v[3]}; *(LAS f32x4*)(V + rr * 256 + c8 + 4) = (f32x4){v[4], v[5], v[6], v[7]};
                }
            }
        }
        __syncthreads();
        MIX_STAMP(3);
        if (last) {
            for (int idx = tid; idx < NSEG * 15 * 64; idx += 512) { const int seg = idx / (15 * 64), r = idx % (15 * 64), j = r >> 6, c4 = (r & 63) * 4;
                float* dst = a.out + (SAMPLE ? O_POOLS + ((size_t)(layer * DB + q0 + seg) * 15 + j) * MIXW : O_POOLP + ((size_t)(layer * NB + s) * 15 + j) * MIXW) + c4;
                *(f32x4*)dst = *(LAS f32x4*)(V + (seg * (15 + L) + L + j) * 256 + c4); }
        }
        for (int idx = tid; idx < R * 32; idx += 512) {
            const int tt = idx >> 5, c8 = (idx & 31) * 8, seg = tt / L, t = tt % L, base = seg * (15 + L) + t + 15, win = 2 << (c8 >> 6);
            float sm[8];
#pragma unroll
            for (int j = 0; j < 8; ++j) sm[j] = 0.f;
            for (int w = 0; w < win; ++w) { const f32x4 x0 = *(LAS f32x4*)(V + (base - w) * 256 + c8), x1 = *(LAS f32x4*)(V + (base - w) * 256 + c8 + 4);
                sm[0] += x0[0]; sm[1] += x0[1]; sm[2] += x0[2]; sm[3] += x0[3]; sm[4] += x1[0]; sm[5] += x1[1]; sm[6] += x1[2]; sm[7] += x1[3]; }
            const int cnt = SAMPLE ? win : min(c * 64 + t + 1, win);
            const float inv = 1.0f / (float)cnt;
            const f32x4 c0 = *(LAS f32x4*)(V + base * 256 + c8), c1 = *(LAS f32x4*)(V + base * 256 + c8 + 4);
            float dd[8];
#pragma unroll
            for (int j = 0; j < 4; ++j) { dd[j] = sm[j] * inv - c0[j]; dd[4 + j] = sm[4 + j] * inv - c1[j]; }
            *(LAS v4u*)(Dt + tt * 264 + c8) = pack8(dd);
        }
        __syncthreads();
        MIX_STAMP(4);
        {
            const bf16* PW = (const bf16*)(a.ws + WS_TAB + (size_t)layer * TAB_STRIDE + TAB_PW);
            const int k = wave >> 1, fr = lane & 15, fq = lane >> 4;
            constexpr int NMT = R / 16;
            for (int mt = (NMT >= 4 ? (wave & 1) * 2 : (wave & 1)); mt < (NMT >= 4 ? (wave & 1) * 2 + 2 : ((wave & 1) == 0 ? NMT : 0)); ++mt) {
                const bf16x8 b0 = *(LAS bf16x8*)(Dt + (16 * mt + fr) * 264 + 64 * k + 8 * fq), b1 = *(LAS bf16x8*)(Dt + (16 * mt + fr) * 264 + 64 * k + 32 + 8 * fq);
#pragma unroll
                for (int ot = 0; ot < 4; ++ot) {
                    f32x4 acc = (f32x4){0.f, 0.f, 0.f, 0.f};
                    const bf16x8 a0 = *(const bf16x8*)(PW + ((size_t)(k * 64 + 16 * ot + fr)) * 64 + 8 * fq), a1 = *(const bf16x8*)(PW + ((size_t)(k * 64 + 16 * ot + fr)) * 64 + 32 + 8 * fq);
                    acc = __builtin_amdgcn_mfma_f32_16x16x32_bf16(a0, b0, acc, 0, 0, 0);
                    acc = __builtin_amdgcn_mfma_f32_16x16x32_bf16(a1, b1, acc, 0, 0, 0);
                    const int o = 64 * k + 16 * ot + 4 * fq, tt = 16 * mt + fr;
                    const f32x4 sc = *(const f32x4*)(a.in[I_POOLSC] + layer * MIXW + o);
                    v2u w; w.x = pk2(acc[0] * sc[0], acc[1] * sc[1]); w.y = pk2(acc[2] * sc[2], acc[3] * sc[3]);
                    *(v2u*)(BR + (size_t)(row0 + tt) * D + o) = w;
                }
            }
        }
        __syncthreads();
    }
    MIX_STAMP(5);
    if (stages & 4) {
        const float* scw = a.in[I_SCW] + (size_t)layer * 3 * MIXW;
#pragma unroll
        for (int it_ = 0; it_ < R * 32 / 512; ++it_) { const int idx = tid + it_ * 512;
            const int tt = idx >> 5, c8 = (idx & 31) * 8, seg = tt / L, t = tt % L;
            float z[3][8];
#pragma unroll
            for (int dj = 0; dj < 3; ++dj) { const int tp = t - 2 + dj;
                int srow = -1;
                if (SAMPLE) { if (tp >= 0) srow = MP + (q0 + seg) * 8 + tp; } else { const int tabs = c * 64 + tp; if (tabs >= 0) srow = s * SEQ + tabs; }
                if (srow >= 0) { float cg[8], hx[8]; unpack8(*(const v4u*)(PMb + (size_t)srow * PMC + 768 + c8), cg); unpack8(*(const v4u*)(PMb + (size_t)srow * PMC + 1024 + c8), hx);
#pragma unroll
                    for (int j = 0; j < 8; ++j) z[dj][j] = cg[j] * hx[j]; }
                else if (SAMPLE) { const float* st = a.in[I_STSC] + ((size_t)(layer * DB + q0 + seg) * 2 + (2 + tp)) * MIXW + c8; const f32x4 x0 = *(const f32x4*)st, x1 = *(const f32x4*)(st + 4);
                    z[dj][0] = x0[0]; z[dj][1] = x0[1]; z[dj][2] = x0[2]; z[dj][3] = x0[3]; z[dj][4] = x1[0]; z[dj][5] = x1[1]; z[dj][6] = x1[2]; z[dj][7] = x1[3]; }
                else {
#pragma unroll
                    for (int j = 0; j < 8; ++j) z[dj][j] = 0.f; } }
            float bg[8], o[8]; unpack8(*(const v4u*)(PMb + (size_t)(row0 + tt) * PMC + 512 + c8), bg);
#pragma unroll
            for (int j = 0; j < 8; ++j) o[j] = bg[j] * (scw[c8 + j] * z[0][j] + scw[MIXW + c8 + j] * z[1][j] + scw[2 * MIXW + c8 + j] * z[2][j]);
            *(v4u*)(BR + (size_t)(row0 + tt) * D + 512 + c8) = pack8(o);
            if (last && t >= L - 2) { float* dst = a.out + (SAMPLE ? O_SCS + ((size_t)(layer * DB + q0 + seg) * 2 + (t - (L - 2))) * MIXW : O_SCP + ((size_t)(layer * NB + s) * 2 + (t - (L - 2))) * MIXW) + c8;
                *(f32x4*)dst = (f32x4){z[2][0], z[2][1], z[2][2], z[2][3]}; *(f32x4*)(dst + 4) = (f32x4){z[2][4], z[2][5], z[2][6], z[2][7]}; }
        }
    }
    MIX_STAMP(6);
}

template <int MODE>
__device__ __forceinline__ void ssm_unit(const Args& a, int layer, int uidx, LAS unsigned char* lds, int tid_in, int lane_in, int wave_in) {
    int tid = tid_in; asm volatile("" : "+v"(tid));
    const int lane = tid & 63, wave = __builtin_amdgcn_readfirstlane(tid >> 6);
    const bf16* PMb = (const bf16*)(a.ws + WS_PM); bf16* BR = (bf16*)a.out;
    const unsigned char* tab = a.ws + WS_TAB + (size_t)layer * TAB_STRIDE;
    const f32x2* LB = (const f32x2*)(tab + TAB_LB); const f32x2* LP = (const f32x2*)(tab + TAB_LP);
    const bf16* BBT = (const bf16*)(tab + TAB_BBT); const bf16* CM = (const bf16*)(tab + TAB_CM);
    f32x2* E = (f32x2*)(a.ws + WS_E);
    const int s = uidx >> 5, c = uidx & 31;
    const int row0 = MODE == 2 ? MP + 64 * uidx : s * SEQ + 64 * c;
    const int fr = lane & 15, fq = lane >> 4;
    LAS float* BU = (LAS float*)(lds + wave * 8448);
    LAS bf16* Zt = (LAS bf16*)(lds + 67584);
    const bf16x8 zf = (bf16x8){0, 0, 0, 0, 0, 0, 0, 0};
    for (int gi = 0; gi < 2; ++gi) {
        const int g = 2 * wave + gi;
        const f32x2 lam = LB[g * 64 + lane]; const float nlam1 = -lam[1];
        float hr = 0.f, hi = 0.f;
        bf16x8 bb[8];
#pragma unroll
        for (int nt = 0; nt < 8; ++nt) bb[nt] = fq < 2 ? *(const bf16x8*)(BBT + ((size_t)(g * 128 + 16 * nt + fr)) * 16 + 8 * fq) : zf;
        bf16x8 cmf[4]; float dsk = 0.f;
        if (MODE >= 1) {
#pragma unroll
            for (int ks = 0; ks < 4; ++ks) cmf[ks] = *(const bf16x8*)(CM + ((size_t)(g * 16 + fr)) * 128 + 32 * ks + 8 * fq);
            dsk = a.in[I_DSKIP][layer * MIXW + 16 * g + fr]; }
        bf16x8 ufa[4];
#pragma unroll
        for (int sub = 0; sub < 4; ++sub) ufa[sub] = fq < 2 ? *(const bf16x8*)(PMb + (size_t)(row0 + 16 * sub + fr) * PMC + 256 + 16 * g + 8 * fq) : zf;
        bf16 uva[4][4];
        if (MODE >= 1) {
#pragma unroll
            for (int sub = 0; sub < 4; ++sub)
#pragma unroll
                for (int r = 0; r < 4; ++r) uva[sub][r] = PMb[(size_t)(row0 + 16 * sub + 4 * fq + r) * PMC + 256 + 16 * g + fr]; }
        if (MODE == 1) { const f32x2 lp = LP[g * 64 + lane];
            const float nlp1 = -lp[1];
#pragma unroll 1
            for (int j = 0; j < c; j += 16) { f32x2 e16[16]; const int nq = c - j;
#pragma unroll
                for (int q = 0; q < 16; ++q) if (q < nq) e16[q] = E[((size_t)(s * NCH + j + q) * 16 + g) * 64 + lane];
#pragma unroll
                for (int q = 0; q < 16; ++q) if (q < nq) { const float nr = fma_s(lp[0], hr, fma_s(nlp1, hi, e16[q][0])), ni = fma_s(lp[0], hi, fma_s(lp[1], hr, e16[q][1])); hr = nr; hi = ni; } } }
#pragma unroll
        for (int sub = 0; sub < 4; ++sub) {
            const int rowb = row0 + 16 * sub;
            const bf16x8 uf = ufa[sub];
#pragma unroll
            for (int nt = 0; nt < 8; ++nt) { const f32x4 d = __builtin_amdgcn_mfma_f32_16x16x32_bf16(uf, bb[nt], (f32x4){0.f, 0.f, 0.f, 0.f}, 0, 0, 0);
#pragma unroll
                for (int r = 0; r < 4; ++r) BU[(4 * fq + r) * 132 + 16 * nt + fr] = d[r]; }
            asm volatile("s_waitcnt lgkmcnt(0)" ::: "memory");
            {
                float bre_[16], bim_[16];
#pragma unroll
                for (int t = 0; t < 16; ++t) { bre_[t] = BU[t * 132 + lane]; bim_[t] = BU[t * 132 + 64 + lane]; }
                float sre_[2] = {0.f, 0.f}, sim_[2] = {0.f, 0.f};
                if (MODE == 2) {
#pragma unroll
                    for (int hq = 0; hq < 2; ++hq) { const int q = 8 * uidx + 2 * sub + hq; const size_t si = ((size_t)(layer * DB + q) * 16 + g) * 64 + lane; sre_[hq] = a.in[I_STRE][si]; sim_[hq] = a.in[I_STIM][si]; } }
                asm volatile("s_waitcnt lgkmcnt(0)" ::: "memory");
#pragma unroll
                for (int t = 0; t < 16; ++t) {
                    if (MODE == 2 && (t & 7) == 0) { hr = sre_[t >> 3]; hi = sim_[t >> 3]; }
                    const float nr = fma_s(lam[0], hr, fma_s(nlam1, hi, bre_[t])), ni = fma_s(lam[0], hi, fma_s(lam[1], hr, bim_[t])); hr = nr; hi = ni;
                    bre_[t] = hr; bim_[t] = hi;
                    if (MODE == 2 && (t & 7) == 7) { const int q = 8 * uidx + 2 * sub + (t >> 3); const size_t si = ((size_t)(layer * DB + q) * 16 + g) * 64 + lane; a.out[O_SRES + si] = hr; a.out[O_SIMS + si] = hi; }
                }
#pragma unroll
                for (int t = 0; t < 16; ++t) { BU[t * 132 + lane] = bre_[t]; BU[t * 132 + 64 + lane] = bim_[t]; }
            }
            if (MODE >= 1) {
                asm volatile("s_waitcnt lgkmcnt(0)" ::: "memory");
                f32x4 y = (f32x4){0.f, 0.f, 0.f, 0.f};
#pragma unroll
                for (int ks = 0; ks < 4; ++ks) { const f32x4 h0 = *(LAS f32x4*)(BU + fr * 132 + 32 * ks + 8 * fq), h1 = *(LAS f32x4*)(BU + fr * 132 + 32 * ks + 8 * fq + 4);
                    v4u hw; hw.x = pk2(h0[0], h0[1]); hw.y = pk2(h0[2], h0[3]); hw.z = pk2(h1[0], h1[1]); hw.w = pk2(h1[2], h1[3]);
                    y = __builtin_amdgcn_mfma_f32_16x16x32_bf16(__builtin_bit_cast(bf16x8, hw), cmf[ks], y, 0, 0, 0); }
#pragma unroll
                for (int r = 0; r < 4; ++r) { const int t = 4 * fq + r; const float uv = bf1(uva[sub][r]);
                    const float z = gelu_tanh(y[r] + dsk * uv);
                    Zt[(16 * sub + t) * 264 + 16 * g + fr] = (bf16)(pk2(z, 0.f) & 0xffffu); }
                asm volatile("s_waitcnt lgkmcnt(0)" ::: "memory");
            }
            if (MODE == 0) { asm volatile("s_waitcnt lgkmcnt(0)" ::: "memory"); }
        }
        if (MODE == 0) E[((size_t)(s * NCH + c) * 16 + g) * 64 + lane] = (f32x2){hr, hi};
        if (MODE == 1 && c == NCH - 1) { const size_t si = ((size_t)(layer * NB + s) * 16 + g) * 64 + lane; a.out[O_SREP + si] = hr; a.out[O_SIMP + si] = hi; }
    }
    if (MODE == 0) __syncthreads();
    if (MODE >= 1) {
        __syncthreads();
        const bf16* WG = (const bf16*)(a.ws + WS_WGLU) + (size_t)layer * MIXW * MIXW;
        f32x4 acc[4][2];
#pragma unroll
        for (int mt = 0; mt < 4; ++mt) { acc[mt][0] = (f32x4){0.f, 0.f, 0.f, 0.f}; acc[mt][1] = (f32x4){0.f, 0.f, 0.f, 0.f}; }
#pragma unroll
        for (int ks = 0; ks < 8; ++ks) {
            const bf16x8 w0 = *(const bf16x8*)(WG + (size_t)(32 * wave + fr) * MIXW + 32 * ks + 8 * fq), w1 = *(const bf16x8*)(WG + (size_t)(32 * wave + 16 + fr) * MIXW + 32 * ks + 8 * fq);
#pragma unroll
            for (int mt = 0; mt < 4; ++mt) { const bf16x8 zb = *(LAS bf16x8*)(Zt + (16 * mt + fr) * 264 + 32 * ks + 8 * fq);
                acc[mt][0] = __builtin_amdgcn_mfma_f32_16x16x32_bf16(w0, zb, acc[mt][0], 0, 0, 0);
                acc[mt][1] = __builtin_amdgcn_mfma_f32_16x16x32_bf16(w1, zb, acc[mt][1], 0, 0, 0); }
        }
#pragma unroll
        for (int nl = 0; nl < 2; ++nl) { const int n0 = 32 * wave + 16 * nl + 4 * fq; const f32x4 bgl = *(const f32x4*)(a.in[I_BGLU] + layer * MIXW + n0);
#pragma unroll
            for (int mt = 0; mt < 4; ++mt) { const int tt = 16 * mt + fr; const v2u zz = *(LAS v2u*)(Zt + tt * 264 + n0);
                const float z0 = bflo(zz.x), z1 = bfhi(zz.x), z2 = bflo(zz.y), z3 = bfhi(zz.y);
                v2u w; w.x = pk2(z0 * sigm(acc[mt][nl][0] + bgl[0]), z1 * sigm(acc[mt][nl][1] + bgl[1])); w.y = pk2(z2 * sigm(acc[mt][nl][2] + bgl[2]), z3 * sigm(acc[mt][nl][3] + bgl[3]));
                *(v2u*)(BR + (size_t)(row0 + tt) * D + 256 + n0) = w; } }
        __syncthreads();
    }
}

__device__ __forceinline__ void gemm2_phase(LAS unsigned char* lds, const bf16* BRp, const bf16* WBT, const unsigned char* GT, bf16* MG, int G, int bid, int tidp) {
    using namespace pg8;
    int tid_ = tidp; asm volatile("" : "+v"(tid_));
    const int tid = tid_, wid = __builtin_amdgcn_readfirstlane(tid >> 6), lane = tid & 63, wr = wid >> 2, wc = wid & 3, fr = lane & 15, fq = lane >> 4;
    unsigned voffA0, voffB0;
    { int R, C; stage_rc(tid * 16, R, C); const int Rb = (R & ~31) + perm32(R & 31); voffA0 = (unsigned)(R * D + C) * 2u; voffB0 = (unsigned)(Rb * MIXW + C) * 2u; }
    const unsigned ldsw = (unsigned)wid * 1024u;
    const int aoff = lds_byte(wr * 64 + fr, fq * 8), boff = lds_byte(wc * 32 + fr, fq * 8);
    const unsigned gvoff = (unsigned)(fr * GTC + 8 * fq);
    constexpr int STG = 49152;
#define G2_STAGE(it_, so_) do { const int kb_ = (it_) >> 2, kt_ = (it_) & 3; \
        const char* as_ = Abase + (size_t)(kb_ * 256 + kt_ * 64) * 2; const char* bs_ = Bbase + (size_t)kb_ * (D * MIXW * 2) + (size_t)kt_ * 128; \
        _Pragma("unroll") for (int _i = 0; _i < 2; ++_i) __builtin_amdgcn_global_load_lds((const unsigned*)(as_ + (size_t)_i * (64 * D * 2) + voffA0), (PG8_LAS unsigned*)(lds + (so_) + ldsw + _i * 8192), 16, 0, 0); \
        _Pragma("unroll") for (int _i = 0; _i < 2; ++_i) __builtin_amdgcn_global_load_lds((const unsigned*)(bs_ + (size_t)_i * (64 * MIXW * 2) + voffB0), (PG8_LAS unsigned*)(lds + (so_) + 16384 + ldsw + _i * 8192), 16, 0, 0); \
        _Pragma("unroll") for (int _i = 0; _i < 2; ++_i) __builtin_amdgcn_global_load_lds((const unsigned*)(bs_ + (size_t)(128 + 64 * _i) * MIXW * 2 + voffB0), (PG8_LAS unsigned*)(lds + (so_) + 32768 + ldsw + _i * 8192), 16, 0, 0); } while (0)
    const int vb = (G % 8 == 0) ? (bid % 8) * (G / 8) + bid / 8 : bid;
    constexpr int NUN = (MP / 128) * 4;
    for (int ui = vb; ui < NUN; ui += G) {
        const int pm = ui >> 2, pn = ui & 3;
        const char* Abase = (const char*)BRp + (size_t)pm * 128 * D * 2;
        const char* Bbase = (const char*)WBT + (size_t)pn * 256 * MIXW * 2;
        G2_STAGE(0, 0); G2_STAGE(1, STG);
        f32x4 mg[2][4][2], acc[2][4][2];
#pragma unroll
        for (int b = 0; b < 2; ++b)
#pragma unroll
            for (int m = 0; m < 4; ++m)
#pragma unroll
                for (int n = 0; n < 2; ++n) { mg[b][m][n] = (f32x4){0.f, 0.f, 0.f, 0.f}; acc[b][m][n] = (f32x4){0.f, 0.f, 0.f, 0.f}; }
        v2u gq[2][4];
        int so = 0, so2 = 2 * STG;
#pragma unroll 1
        for (int kb = 0; kb < 4; ++kb) {
#pragma unroll
            for (int kt = 0; kt < 4; ++kt) {
                if (kt < 2) asm volatile("s_waitcnt vmcnt(6)" ::: "memory");
                else if (kt == 3 && kb == 3) asm volatile("s_waitcnt vmcnt(8)" ::: "memory");
                else asm volatile("s_waitcnt vmcnt(14)" ::: "memory");
                __builtin_amdgcn_s_barrier(); asm volatile("" ::: "memory");
                if (kt < 2 || kb < 3) G2_STAGE(4 * kb + kt + 2, so2);
#pragma unroll
                for (int kk = 0; kk < 2; ++kk) {
                    bf16x8 At[4], B0[2], B1[2];
#pragma unroll
                    for (int m = 0; m < 4; ++m) At[m] = *(const PG8_LAS bf16x8*)(lds + so + aoff + m * 2048 + kk * 1024);
#pragma unroll
                    for (int n = 0; n < 2; ++n) { B0[n] = *(const PG8_LAS bf16x8*)(lds + so + 16384 + boff + n * 2048 + kk * 1024); B1[n] = *(const PG8_LAS bf16x8*)(lds + so + 32768 + boff + n * 2048 + kk * 1024); }
                    asm volatile("s_waitcnt lgkmcnt(0)" ::: "memory"); __builtin_amdgcn_sched_barrier(0);
#pragma unroll
                    for (int m = 0; m < 4; ++m)
#pragma unroll
                        for (int n = 0; n < 2; ++n) { acc[0][m][n] = __builtin_amdgcn_mfma_f32_16x16x32_bf16(B0[n], At[m], acc[0][m][n], 0, 0, 0);
                                                      acc[1][m][n] = __builtin_amdgcn_mfma_f32_16x16x32_bf16(B1[n], At[m], acc[1][m][n], 0, 0, 0); }
                }
                if (kt == 1) {
#pragma unroll
                    for (int m = 0; m < 4; ++m) { const unsigned char* gs = GT + (size_t)(pm * 128 + wr * 64 + m * 16) * GTC + kb * D + pn * 256 + wc * 32;
                        asm volatile("global_load_dwordx2 %0, %1, %2" : "=v"(gq[0][m]) : "v"(gvoff), "s"(gs) : "memory");
                        asm volatile("global_load_dwordx2 %0, %1, %2 offset:128" : "=v"(gq[1][m]) : "v"(gvoff), "s"(gs) : "memory"); }
                }
                so = so == 2 * STG ? 0 : so + STG; so2 = so2 == 2 * STG ? 0 : so2 + STG;
            }
            if (kb == 3) asm volatile("s_waitcnt vmcnt(0)" ::: "memory"); else asm volatile("s_waitcnt vmcnt(12)" ::: "memory");
            asm volatile("" : "+v"(gq[0][0]), "+v"(gq[0][1]), "+v"(gq[0][2]), "+v"(gq[0][3]), "+v"(gq[1][0]), "+v"(gq[1][1]), "+v"(gq[1][2]), "+v"(gq[1][3]));
#pragma unroll
            for (int b = 0; b < 2; ++b)
#pragma unroll
                for (int m = 0; m < 4; ++m) { const v2u q_ = gq[b][m];
#pragma unroll
                    for (int j = 0; j < 4; ++j) { mg[b][m][0][j] += (float)((q_.x >> (8 * j)) & 0xffu) * acc[b][m][0][j]; mg[b][m][1][j] += (float)((q_.y >> (8 * j)) & 0xffu) * acc[b][m][1][j]; }
                    acc[b][m][0] = (f32x4){0.f, 0.f, 0.f, 0.f}; acc[b][m][1] = (f32x4){0.f, 0.f, 0.f, 0.f}; }
        }
        asm volatile("" ::: "memory"); __builtin_amdgcn_s_barrier(); asm volatile("" ::: "memory");
#pragma unroll
        for (int b = 0; b < 2; ++b)
#pragma unroll
            for (int m = 0; m < 4; ++m) { const int row = pm * 128 + wr * 64 + m * 16 + fr, col = pn * 256 + b * 128 + wc * 32 + 8 * fq;
                const f32x4 m0 = mg[b][m][0] * (1.0f / 255.0f), m1 = mg[b][m][1] * (1.0f / 255.0f);
                v4u w; w.x = pk2(m0[0], m0[1]); w.y = pk2(m0[2], m0[3]); w.z = pk2(m1[0], m1[1]); w.w = pk2(m1[2], m1[3]);
                *(v4u*)(MG + (size_t)row * D + col) = w; }
    }
#undef G2_STAGE
}


#define TL_GLDS(src_, dst_) __builtin_amdgcn_global_load_lds((const unsigned*)(src_), (PG8_LAS unsigned*)(dst_), 16, 0, 0)
#define TL_STAGE(kt_, A_PTR, B_PTR) do { const int s_ = (kt_) & 3; const char* ap_ = A_PTR(kt_); const char* bp_ = B_PTR(kt_); \
        TL_GLDS(ap_ + voffA, lds + s_ * 32768 + ldsw); TL_GLDS(ap_ + voffA + 128, lds + s_ * 32768 + 8192 + ldsw); \
        TL_GLDS(bp_ + voffB, lds + s_ * 32768 + 16384 + ldsw); TL_GLDS(bp_ + voffB + 128, lds + s_ * 32768 + 24576 + ldsw); } while (0)
#define TL_LOOP(NK, A_PTR, B_PTR, AFTER_STEP) do { \
        TL_STAGE(0, A_PTR, B_PTR); if ((NK) > 1) TL_STAGE(1, A_PTR, B_PTR); if ((NK) > 2) TL_STAGE(2, A_PTR, B_PTR); \
        _Pragma("unroll 1") for (int kt = 0; kt < (NK); ++kt) { \
            if (kt + 2 < (NK)) asm volatile("s_waitcnt vmcnt(8)" ::: "memory"); else if (kt + 1 < (NK)) asm volatile("s_waitcnt vmcnt(4)" ::: "memory"); else asm volatile("s_waitcnt vmcnt(0)" ::: "memory"); \
            __builtin_amdgcn_s_barrier(); asm volatile("" ::: "memory"); \
            if (kt + 3 < (NK)) TL_STAGE(kt + 3, A_PTR, B_PTR); \
            const int sb_ = (kt & 3) * 32768; \
            _Pragma("unroll") for (int h_ = 0; h_ < 2; ++h_) { \
                const bf16x8 a0 = *(const PG8_LAS bf16x8*)(lds + sb_ + h_ * 8192 + aoff), a1 = *(const PG8_LAS bf16x8*)(lds + sb_ + h_ * 8192 + aoff + 1024); \
                const bf16x8 b00 = *(const PG8_LAS bf16x8*)(lds + sb_ + 16384 + h_ * 8192 + boff), b01 = *(const PG8_LAS bf16x8*)(lds + sb_ + 16384 + h_ * 8192 + boff + 1024); \
                const bf16x8 b10 = *(const PG8_LAS bf16x8*)(lds + sb_ + 16384 + h_ * 8192 + boff + 2048), b11 = *(const PG8_LAS bf16x8*)(lds + sb_ + 16384 + h_ * 8192 + boff + 3072); \
                asm volatile("s_waitcnt lgkmcnt(0)" ::: "memory"); __builtin_amdgcn_sched_barrier(0); \
                acc[0] = __builtin_amdgcn_mfma_f32_16x16x32_bf16(b00, a0, acc[0], 0, 0, 0); acc[1] = __builtin_amdgcn_mfma_f32_16x16x32_bf16(b10, a0, acc[1], 0, 0, 0); \
                acc[0] = __builtin_amdgcn_mfma_f32_16x16x32_bf16(b01, a1, acc[0], 0, 0, 0); acc[1] = __builtin_amdgcn_mfma_f32_16x16x32_bf16(b11, a1, acc[1], 0, 0, 0); } \
            AFTER_STEP(kt); } \
        asm volatile("s_waitcnt lgkmcnt(0)" ::: "memory"); __builtin_amdgcn_s_barrier(); asm volatile("" ::: "memory"); } while (0)
#define TL_SETUP(LDA, LDB) using namespace pg8; int tid_ = tidp; asm volatile("" : "+v"(tid_)); \
    const int tid = tid_, wid = __builtin_amdgcn_readfirstlane(tid >> 6), lane = tid & 63, fr = lane & 15, fq = lane >> 4, mt = wid >> 1, nh = wid & 1; \
    int R_, C_; stage_rc(tid * 16, R_, C_); \
    const unsigned voffA = (unsigned)(R_ * (LDA) + C_) * 2u, voffB = (unsigned)(R_ * (LDB) + C_) * 2u, ldsw = (unsigned)wid * 1024u; \
    const int aoff = lds_byte(mt * 16 + fr, fq * 8), boff = lds_byte(nh * 32 + fr, fq * 8); (void)lane
#define TL_NOP(kt_) do {} while (0)

struct CappedOrder : pg8::StaticOrder {
    int cap;
    __device__ bool next(int i, pg8::Unit& u) const { if ((long)i * G + c >= cap) return false; return pg8::StaticOrder::next(i, u); }
};
__device__ __forceinline__ void proj_tail_phase(LAS unsigned char* lds, const bf16* A, const bf16* Bt, int cap, const float* ssq, const float* bgate, bf16* PMp, unsigned char* GTp, int G, int bid, int tidp, unsigned* qctr) {
    TL_SETUP(D, D);
    StaticOrder S1; S1.init(M, INC, 1, 0);
    const int nsub = (S1.nwg - cap) * 16;
    volatile LAS int* qslot = (volatile LAS int*)(lds + MISC_OFF + 192);
    for (int t = bid; t < nsub; ) {
        Unit u; S1.next(cap + (t >> 4), u);
        const int rb = (t >> 2) & 3, cb = t & 3, r0 = u.pm * 256 + 64 * rb, c0 = u.pn * 256 + 64 * cb;
        const char* Ab = (const char*)A + (size_t)r0 * D * 2; const char* Bb = (const char*)Bt + (size_t)c0 * D * 2;
        f32x4 acc[2] = {(f32x4){0.f, 0.f, 0.f, 0.f}, (f32x4){0.f, 0.f, 0.f, 0.f}};
        const int row = r0 + 16 * mt + fr;
        const float rs = pg8::row_rstd(ssq, row);
        const bool isg = u.pn >= 7;
        f32x4 bvv[2];
#pragma unroll
        for (int n = 0; n < 2; ++n) bvv[n] = isg ? *(const f32x4*)(bgate + (c0 + 32 * nh + 16 * n + 4 * fq - PMC)) : (f32x4){0.f, 0.f, 0.f, 0.f};
#define PT_A(kt_) (Ab + (size_t)(kt_) * 256)
#define PT_B(kt_) (Bb + (size_t)(kt_) * 256)
        TL_LOOP(D / 128, PT_A, PT_B, TL_NOP);
#undef PT_A
#undef PT_B
        unsigned got = 0u;
        if (tid == 0) got = __hip_atomic_fetch_add(qctr, 1u, __ATOMIC_RELAXED, __HIP_MEMORY_SCOPE_AGENT);
#pragma unroll
        for (int n = 0; n < 2; ++n) { const int col = c0 + 32 * nh + 16 * n + 4 * fq; f32x4 v = acc[n] * rs;
            if (isg) { const f32x4 tt = (v + bvv[n]) * -1.4426950408889634f;
                *(unsigned*)(GTp + (size_t)row * GTC + (col - PMC)) = pg8::pack_u8x4(pg8::sig255(tt[0]), pg8::sig255(tt[1]), pg8::sig255(tt[2]), pg8::sig255(tt[3])); }
            else { v2u w; w.x = pk2(v[0], v[1]); w.y = pk2(v[2], v[3]); *(v2u*)(PMp + (size_t)row * PMC + col) = w; } }
        if (tid == 0) *qslot = G + (int)got;
        __syncthreads();
        t = *qslot;
        __syncthreads();
    }
}

__device__ __forceinline__ void gemm2_tail_phase(LAS unsigned char* lds, const bf16* BRp, const bf16* WBT, const unsigned char* GT, bf16* MG, int G, int bid, int tidp) {
    TL_SETUP(D, MIXW);
    for (int ui = bid; ui < 256; ui += G) {
        const int rb = ((ui & 7) >> 1) * 4 + (ui >> 6), cb = (ui & 1) * 8 + ((ui >> 3) & 7);
        const char* Ab = (const char*)BRp + (size_t)(MP + 64 * rb) * D * 2; const char* Bb = (const char*)WBT + (size_t)(64 * cb) * MIXW * 2;
        f32x4 acc[2] = {(f32x4){0.f, 0.f, 0.f, 0.f}, (f32x4){0.f, 0.f, 0.f, 0.f}}, mg[2] = {(f32x4){0.f, 0.f, 0.f, 0.f}, (f32x4){0.f, 0.f, 0.f, 0.f}};
        const int row = MP + 64 * rb + 16 * mt + fr;
#define G2T_A(kt_) (Ab + (size_t)(((kt_) >> 1) * 256 + ((kt_) & 1) * 128) * 2)
#define G2T_B(kt_) (Bb + (size_t)((kt_) >> 1) * (D * MIXW * 2) + (size_t)((kt_) & 1) * 256)
        unsigned gwp[4][2];
#pragma unroll
        for (int kb = 0; kb < 4; ++kb)
#pragma unroll
            for (int n = 0; n < 2; ++n) gwp[kb][n] = *(const unsigned*)(GT + (size_t)row * GTC + kb * D + 64 * cb + 32 * nh + 16 * n + 4 * fq);
#define G2T_AFTER(kt_) do { if ((kt_) & 1) { const int kb_ = (kt_) >> 1; \
            _Pragma("unroll") for (int n = 0; n < 2; ++n) { const unsigned gw = kb_ == 0 ? gwp[0][n] : (kb_ == 1 ? gwp[1][n] : (kb_ == 2 ? gwp[2][n] : gwp[3][n])); \
                mg[n][0] += (float)(gw & 0xffu) * acc[n][0]; mg[n][1] += (float)((gw >> 8) & 0xffu) * acc[n][1]; mg[n][2] += (float)((gw >> 16) & 0xffu) * acc[n][2]; mg[n][3] += (float)(gw >> 24) * acc[n][3]; \
                acc[n] = (f32x4){0.f, 0.f, 0.f, 0.f}; } } } while (0)
        TL_LOOP(8, G2T_A, G2T_B, G2T_AFTER);
#undef G2T_A
#undef G2T_B
#undef G2T_AFTER
#pragma unroll
        for (int n = 0; n < 2; ++n) { const f32x4 mm = mg[n] * (1.0f / 255.0f); v2u w; w.x = pk2(mm[0], mm[1]); w.y = pk2(mm[2], mm[3]); *(v2u*)(MG + (size_t)row * D + 64 * cb + 32 * nh + 16 * n + 4 * fq) = w; }
    }
}

__device__ __forceinline__ void resid_tail_phase(LAS unsigned char* lds, const bf16* A, const bf16* Bt, int K, const float* xs_old, bool first, bf16* XBp, float* ssq, int G, int bid, int tidp) {
    TL_SETUP(K, K);
    const int nk = K / 128;
    for (int ui = bid; ui < 256; ui += G) {
        const int rb = ((ui & 7) >> 1) * 4 + (ui >> 6), cb = (ui & 1) * 8 + ((ui >> 3) & 7);
        const char* Ab = (const char*)A + (size_t)(MP + 64 * rb) * K * 2; const char* Bb = (const char*)Bt + (size_t)(64 * cb) * K * 2;
        f32x4 acc[2] = {(f32x4){0.f, 0.f, 0.f, 0.f}, (f32x4){0.f, 0.f, 0.f, 0.f}};
        const int rowl = 16 * mt + fr, row = MP + 64 * rb + rowl; float ss = 0.f;
        f32x4 xold[2];
#pragma unroll
        for (int n = 0; n < 2; ++n) { const int col = 64 * cb + 32 * nh + 16 * n + 4 * fq;
            if (first) xold[n] = *(const f32x4*)(xs_old + (size_t)(row - MP) * D + col);
            else { const v2u q = *(const v2u*)(XBp + (size_t)row * D + col); xold[n] = (f32x4){bflo(q.x), bfhi(q.x), bflo(q.y), bfhi(q.y)}; } }
#define RT_A(kt_) (Ab + (size_t)(kt_) * 256)
#define RT_B(kt_) (Bb + (size_t)(kt_) * 256)
        TL_LOOP(nk, RT_A, RT_B, TL_NOP);
#undef RT_A
#undef RT_B
#pragma unroll
        for (int n = 0; n < 2; ++n) { const int col = 64 * cb + 32 * nh + 16 * n + 4 * fq;
            const f32x4 o = xold[n] + acc[n];
            v2u w; w.x = pk2(o[0], o[1]); w.y = pk2(o[2], o[3]); *(v2u*)(XBp + (size_t)row * D + col) = w;
            ss += (o[0] * o[0] + o[1] * o[1]) + (o[2] * o[2] + o[3] * o[3]); }
        ss += __shfl_xor(ss, 16); ss += __shfl_xor(ss, 32);
        LAS float* red = (LAS float*)lds;
        if (fq == 0) red[rowl * 2 + nh] = ss;
        __syncthreads();
        if (tid < 64) ssq[((size_t)(cb >> 2) * M + MP + 64 * rb + tid) * 4 + (cb & 3)] = red[tid * 2] + red[tid * 2 + 1];
        __syncthreads();
    }
}

#ifndef PROBE_REP_B
#define PROBE_REP_B 1
#endif
#ifndef PROBE_REP_C
#define PROBE_REP_C 1
#endif
#ifndef PROBE_REP_D
#define PROBE_REP_D 1
#endif
#ifndef PROBE_REP_P0
#define PROBE_REP_P0 1
#endif
__global__ void __launch_bounds__(NWAVES * 64, 2) hybrid_fwd(Args args) {
    extern __shared__ __attribute__((aligned(16))) unsigned char lds_raw[];
    LAS unsigned char* lds = (LAS unsigned char*)lds_raw;
    volatile LAS unsigned* MISC = (volatile LAS unsigned*)(lds + MISC_OFF);
    const int tid0 = threadIdx.x, wave0 = __builtin_amdgcn_readfirstlane(tid0 >> 6);
    const int G0 = gridDim.x, bid = blockIdx.x;
    unsigned char* ws = args.ws;
    for (int u = tid0; u < (LDS_BYTES - LDSCTL_OFF) / 4; u += NWAVES * 64) ((LAS unsigned*)(lds + LDSCTL_OFF))[u] = 0u;
    __syncthreads();
    const int lo = args.ph_lo, hi = args.ph_hi;
    XcdBarrier bar; bar.bar = (unsigned*)(ws + WS_CTL) + CW_BAR; bar.x = 0; bar.st = nullptr;
    if (hi - lo > 1) bar = xcd_barrier_post((unsigned*)(ws + WS_CTL) + CW_BAR, MISC + 8);
    bf16* XB = (bf16*)(ws + WS_ACT1); bf16* PMb = (bf16*)(ws + WS_PM); unsigned char* GTb = ws + WS_GT;
    bf16* MGb = (bf16*)(ws + WS_PM); bf16* ACTb = (bf16*)(ws + WS_GT);
    float* ssq = (float*)(ws + WS_SSQ);
    for (int ph_i = lo; ph_i < hi; ++ph_i) {
#ifdef DBG_T_PH
        if (ph_i == DBG_T_PH && bid == DBG_T_BLK && wave0 == 0 && __builtin_amdgcn_mbcnt_lo(~0u, 0u) == 0u) { ((volatile LAS unsigned long long*)(lds + MISC_OFF + 256))[0] = __builtin_amdgcn_s_memtime(); ((volatile LAS unsigned long long*)(lds + MISC_OFF + 256))[1] = __builtin_amdgcn_s_memrealtime(); }
#endif
        int ph = ph_i, G = G0; asm volatile("" : "+s"(ph), "+s"(G));
        unsigned z_ = 0u; asm volatile("" : "+v"(z_));
        int tid = wave0 * 64 + (int)__builtin_amdgcn_mbcnt_hi(~0u, __builtin_amdgcn_mbcnt_lo(~0u, z_)); asm volatile("" : "+v"(tid)); const int lane = tid & 63, wave = __builtin_amdgcn_readfirstlane(tid >> 6);
        const int layer = (ph - 1) / 7, k = ph == 0 ? -1 : (ph == NPHASE - 1 ? 7 : (ph - 1) % 7);
        if (k == -1) for (int rep_ = 0; rep_ < PROBE_REP_P0; ++rep_) p0_prologue(args, lds, tid, lane, wave, G, bid);
        else if (k == 7) final_norm(args, lane, wave, G, bid);
        else if (k == 0) {
            pg8::Gemm g{XB, (const bf16*)(ws + WS_WIN) + (size_t)layer * INC * D, M, INC, D}; CappedOrder S; S.init(M, INC, G, bid); S.cap = (S.nwg / G) * G;
            pg8::EpiProj E{PMb, GTb, ssq, args.in[I_BGATE] + (size_t)layer * GTC, (const LAS float*)(lds + RING_OFF + pg8::RSTD_LDS_OFF)};
            pg8::gemm_phase<pg8::EpiProj, CappedOrder, true, true>(lds + RING_OFF, g, S, E, tid);
            proj_tail_phase(lds + RING_OFF, XB, (const bf16*)(ws + WS_WIN) + (size_t)layer * INC * D, S.cap, ssq, args.in[I_BGATE] + (size_t)layer * GTC, PMb, GTb, G, bid, tid, (unsigned*)(ws + WS_CTL) + CW_Q + 64 * layer);
#ifdef PROBE_A_SAME
            { SameTileOrder S2; S2.init(M, INC, G, bid); pg8::EpiNull EN_; pg8::gemm_phase<pg8::EpiNull, SameTileOrder, true, true>(lds + RING_OFF, g, S2, EN_, tid); }
#endif
#ifdef PROBE_A_NULL
            { pg8::EpiNull EN_; pg8::gemm_phase<pg8::EpiNull, CappedOrder, true, true>(lds + RING_OFF, g, S, EN_, tid); }
#endif
#ifdef PROBE_A_FULL
            pg8::gemm_phase<pg8::EpiProj, CappedOrder, true, true>(lds + RING_OFF, g, S, E, tid);
#endif
        } else if (k == 1) for (int rep_ = 0; rep_ < PROBE_REP_B; ++rep_) {
            for (int s_ = 0; ; ++s_) { int u; bool donor = false;
                if (G == 256) { if (s_ > 2) break;
                    donor = bid < 16 || (bid >= 80 && bid < 152);
                    if (s_ == 0) u = 272 + ((bid + 240) & 255);
                    else if (bid < 16) { if (s_ == 2) break; u = 256 + bid; }
                    else if (bid < 80) { if (s_ == 2) break; u = 528 + (bid - 16); }
                    else if (s_ == 1 || bid < 152) { const int v = (s_ == 1 ? 0 : 176) + (bid - 80); u = (v / 31) * 32 + v % 31; }
                    else if (bid < 240) { const int t_ = bid - 152, db = t_ < 16 ? t_ : 80 + (t_ - 16); u = 592 + ((db + 240) & 255); }
                    else break; }
                else { u = bid + s_ * G; if (u >= 256 + 16 + 256 + 64) break; }
                if (u < 256) { if ((u & 31) != NCH - 1) ssm_unit<0>(args, layer, u, lds, tid, lane, wave); }
                else if (u < 272) ssm_unit<2>(args, layer, u - 256, lds, tid, lane, wave);
                else if (u < 528 || u >= 592) mix_unit<false>(args, layer, u < 528 ? u - 272 : u - 592, lds, tid, lane, wave, u >= 592 ? 4 : (donor ? 3 : 7));
                else mix_unit<true>(args, layer, u - 528, lds, tid, lane, wave, 7);
            }
        } else if (k == 2) for (int rep_ = 0; rep_ < PROBE_REP_C; ++rep_) {
            for (int u = bid; u < 256; u += G) ssm_unit<1>(args, layer, u, lds, tid, lane, wave);
        } else if (k == 3) for (int rep_ = 0; rep_ < PROBE_REP_D; ++rep_) {
            gemm2_phase(lds + RING_OFF, (const bf16*)args.out, (const bf16*)(ws + WS_WBR) + (size_t)layer * 4 * D * MIXW, GTb, MGb, G, bid, tid);
            gemm2_tail_phase(lds + RING_OFF, (const bf16*)args.out, (const bf16*)(ws + WS_WBR) + (size_t)layer * 4 * D * MIXW, GTb, MGb, G, bid, tid);
        } else if (k == 5) {
            pg8::Gemm g{XB, (const bf16*)(ws + WS_WFI) + (size_t)layer * 2 * FF * D, M, 2 * FF, D}; pg8::StaticOrder S; S.init(M, 2 * FF, G, bid);
            pg8::EpiSwiGLU E{ACTb, ssq, (const LAS float*)(lds + RING_OFF + pg8::RSTD_LDS_OFF)};
            pg8::gemm_phase<pg8::EpiSwiGLU, pg8::StaticOrder, true, true>(lds + RING_OFF, g, S, E, tid);
            if (!MK_PER_PHASE && G == 256 && bid >= P0_F_BID0 && layer + 1 < NLAYER) p0_idle_items(args, lds, lane, wave, bid, layer + 1, p0_items_A(G), P0_F_BID0, P0_F_PER);
        } else {
            const bool isE = k == 4; const int K = isE ? D : FF;
            const bf16* Ap = isE ? MGb : ACTb; const bf16* Bp = isE ? (const bf16*)(ws + WS_WOUT) + (size_t)layer * D * D : (const bf16*)(ws + WS_WFO) + (size_t)layer * D * FF;
            const bool first = false;
            { pg8::Gemm g{Ap, Bp, MP, D, K}; pg8::StaticOrder S; S.init(MP, D, G, bid);
              pg8::EpiResid E{args.in[I_XP], args.in[I_XS], first, XB, ssq};
              pg8::gemm_phase<pg8::EpiResid, pg8::StaticOrder, true, true>(lds + RING_OFF, g, S, E, tid); }
#ifdef DBG_T_TAIL
            if (ph == DBG_T_PH && bid == DBG_T_BLK && tid == 0) ((volatile LAS unsigned long long*)(lds + MISC_OFF + 256))[9] = __builtin_amdgcn_s_memrealtime();
#endif
            resid_tail_phase(lds + RING_OFF, Ap, Bp, K, args.in[I_XS], first, XB, ssq, G, bid, tid);
#ifdef DBG_T_TAIL
            if (ph == DBG_T_PH && bid == DBG_T_BLK && tid == 0) ((volatile LAS unsigned long long*)(lds + MISC_OFF + 256))[10] = __builtin_amdgcn_s_memrealtime();
#endif
        }
#ifdef DBG_T_PH
        if (ph == DBG_T_PH && bid == DBG_T_BLK && tid == 0) { ((volatile LAS unsigned long long*)(lds + MISC_OFF + 256))[2] = __builtin_amdgcn_s_memtime(); ((volatile LAS unsigned long long*)(lds + MISC_OFF + 256))[3] = __builtin_amdgcn_s_memrealtime(); }
#endif
        if (ph_i + 1 < hi) {
            asm volatile("s_waitcnt vmcnt(0)" ::: "memory"); __syncthreads();
            if (tid == 0) xcd_barrier_leader(bar);
            else if (!MK_PER_PHASE && wave != 0 && k >= 0 && k < P0_SLICES && layer + 1 < NLAYER) p0_slice(args, lds, lane, wave, G, bid, layer + 1, k);
            __syncthreads();
        }
#ifdef PROBE_XBAR
        if (ph_i == 8) for (int i_ = 0; i_ < PROBE_XBAR; ++i_) xcd_barrier(bar, tid == 0);
#endif
#if defined(DBG_T_PH) && defined(DBG_T_AFTERBAR)
        if (ph == DBG_T_PH && bid == DBG_T_BLK && tid == 0) { ((volatile LAS unsigned long long*)(lds + MISC_OFF + 256))[2] = __builtin_amdgcn_s_memtime(); ((volatile LAS unsigned long long*)(lds + MISC_OFF + 256))[3] = __builtin_amdgcn_s_memrealtime(); }
#endif
    }
#ifdef DBG_T_PH
    if (bid == DBG_T_BLK && wave0 == 0 && __builtin_amdgcn_mbcnt_lo(~0u, 0u) == 0u) {
        volatile LAS unsigned long long* ts_ = (volatile LAS unsigned long long*)(lds + MISC_OFF + 256);
        const unsigned long long dc = ts_[2] - ts_[0], dr = ts_[3] - ts_[1];
        unsigned long long val = DBG_T_MODE == 11 ? (ts_[16 + DBG_TB] - ts_[16 + DBG_TA]) : DBG_T_MODE == 8 ? (ts_[5] - ts_[1])   : DBG_T_MODE == 9 ? (ts_[3] - ts_[7])   : DBG_T_MODE == 10 ? (ts_[7] - ts_[5])   : DBG_T_MODE == 7 ? (ts_[10] - ts_[9])   : DBG_T_MODE == 5 ? (ts_[8] - ts_[4]) / 16ull   : DBG_T_MODE == 3 ? (ts_[6] - ts_[4]) / 16ull   : DBG_T_MODE == 4 ? (ts_[7] - ts_[5]) * 10ull   : DBG_T_MODE == 0 ? (dc * 100ull) / (dr ? dr : 1ull)      : DBG_T_MODE == 1 ? dr   : dc / 1000ull;
        const unsigned long long t0 = __builtin_amdgcn_s_memrealtime();
        while (__builtin_amdgcn_s_memrealtime() - t0 < val * 100ull) __builtin_amdgcn_s_sleep(16);
    }
#endif
}

extern "C" void kernel_launch(void* const* d_in, const int* in_sizes, int n_in, void* d_out, int out_size, void* d_ws, size_t ws_size, hipStream_t stream) {
    static int grid = 0;
    if (grid == 0) {
        if (n_in != 32 || out_size != (int)O_END || ws_size < WS_END) { fprintf(stderr, "kernel_launch: expected 32 inputs, %zu outputs, >= %zu bytes of workspace; got %d, %d, %zu; nothing launched\n", (size_t)O_END, (size_t)WS_END, n_in, out_size, ws_size); grid = -1; return; }
        int dev = 0, cus = 0, per_cu = 0;
        if (hipGetDevice(&dev) != hipSuccess || hipDeviceGetAttribute(&cus, hipDeviceAttributeMultiprocessorCount, dev) != hipSuccess) { grid = -1; return; }
        if (hipFuncSetAttribute((const void*)hybrid_fwd, hipFuncAttributeMaxDynamicSharedMemorySize, LDS_BYTES) != hipSuccess) { fprintf(stderr, "kernel_launch: hipFuncSetAttribute failed\n"); grid = -1; return; }
        if (hipOccupancyMaxActiveBlocksPerMultiprocessor(&per_cu, (const void*)hybrid_fwd, NWAVES * 64, LDS_BYTES) != hipSuccess || per_cu < 1) { fprintf(stderr, "kernel_launch: occupancy query says %d blocks per CU; nothing launched\n", per_cu); (void)hipGetLastError(); grid = -1; return; }
        grid = cus;
    }
    if (grid < 0) return;
    (void)hipMemsetAsync((char*)d_ws + WS_CTL, 0, CTL_ZERO_BYTES, stream);
    Args a{};
    for (int i = 0; i < 32; ++i) a.in[i] = (const float*)d_in[i];
    a.out = (float*)d_out; a.ws = (unsigned char*)d_ws;
#if MK_PER_PHASE
    for (int k = 0; k < NPHASE; ++k) { a.ph_lo = k; a.ph_hi = k + 1; hipLaunchKernelGGL(hybrid_fwd, dim3(grid), dim3(NWAVES * 64), LDS_BYTES, stream, a); }
#else
    a.ph_lo = 0; a.ph_hi = NPHASE;
    hipLaunchKernelGGL(hybrid_fwd, dim3(grid), dim3(NWAVES * 64), LDS_BYTES, stream, a);
#endif
}
```

```cpp
#include <hip/hip_runtime.h>
#include <cstdio>
#include <cstdint>
#ifndef XPF_LEAD
#define XPF_LEAD 2
#endif
namespace pg8 {
#define PG8_LAS __attribute__((address_space(3)))
typedef unsigned short bf16_t;
typedef short bf16x8 __attribute__((ext_vector_type(8)));
typedef float f32x4 __attribute__((ext_vector_type(4)));
typedef unsigned u32x4 __attribute__((ext_vector_type(4)));
constexpr int BM = 256, BK = 64, HALF = 128, HTB = HALF * BK * 2  , STAGE_BYTES = 8 * HTB, NXCD = 8, WGM = 8, RSTD_LDS_OFF = 147456 + 320 + 1024  , RSTD_RAW_OFF = RSTD_LDS_OFF + 1024  , BIAS_LDS_OFF = RSTD_RAW_OFF + 8192  ;

__host__ __device__ __forceinline__ int lds_byte(int r, int c) { const int st = (r >> 4) * 2 + (c >> 5), rr = r & 15, cc = c & 31, ob = rr * 64 + cc * 2; return st * 1024 + (ob ^ (((ob >> 9) & 1) << 5)); }
__host__ __device__ __forceinline__ void stage_rc(int b, int& R, int& C) { const int st = b / 1024, sb = b % 1024, swz = sb ^ (((sb >> 9) & 1) << 5); R = (st >> 1) * 16 + swz / 64; C = (st & 1) * 32 + (swz % 64) / 2; }
__host__ __device__ __forceinline__ int perm32(int rho) { const int n = rho >> 4, i = rho & 15; return 8 * (i >> 2) + 4 * n + (i & 3); }

struct Unit { int pm, pn; };
struct Gemm { const bf16_t* A; const bf16_t* Bt; int M, N, K; };

struct StaticOrder {
    int nM, nN, nwg, G, c;
    __host__ __device__ void init(int M, int N, int G_, int c_) { nM = M / BM; nN = N / BM; nwg = nM * nN; G = G_; c = c_; }
    __host__ __device__ bool next(int i, Unit& u) const {
        const long L = (long)i * G + c; if (L >= nwg) return false;
        int wgid = (int)L; { const int q = nwg / NXCD, r = nwg % NXCD, xcd = wgid % NXCD, off = wgid / NXCD; wgid = (xcd < r ? xcd * (q + 1) : r * (q + 1) + (xcd - r) * q) + off; }
        const int nig = WGM * nN, gid = wgid / nig, fm = gid * WGM, gsz = (nM - fm) < WGM ? (nM - fm) : WGM;
        u.pm = fm + ((wgid % nig) % gsz); u.pn = (wgid % nig) / gsz; return true;
    }
    __device__ __forceinline__ void a_ready(const Unit&) const {}
    __device__ __forceinline__ void done(const Unit&) const {}
};
typedef float f32x2 __attribute__((ext_vector_type(2)));
typedef __bf16 bf16x2_t __attribute__((ext_vector_type(2)));
__device__ __forceinline__ unsigned cvt_pk_bf16(float lo, float hi) { f32x2 v = {lo, hi}; bf16x2_t b = __builtin_convertvector(v, bf16x2_t); return __builtin_bit_cast(unsigned, b); }
__device__ __forceinline__ float sigm(float x) { return __builtin_amdgcn_rcpf(1.0f + __builtin_amdgcn_exp2f(-1.4426950408889634f * x)); }
__device__ __forceinline__ float row_rstd(const float* ssq, int row) {
    const f32x4 a = *(const f32x4*)(ssq + ((size_t)0 * 17408 + row) * 4), b = *(const f32x4*)(ssq + ((size_t)1 * 17408 + row) * 4),
                c = *(const f32x4*)(ssq + ((size_t)2 * 17408 + row) * 4), d = *(const f32x4*)(ssq + ((size_t)3 * 17408 + row) * 4);
    const float s = (((a[0] + a[1]) + (a[2] + a[3])) + ((b[0] + b[1]) + (b[2] + b[3]))) + (((c[0] + c[1]) + (c[2] + c[3])) + ((d[0] + d[1]) + (d[2] + d[3])));
    return __builtin_amdgcn_rsqf(s * (1.0f / 1024.0f) + 1e-6f);
}
__device__ __forceinline__ void rows_rstd(const float* ssq, int row0, int fq, float (&rs)[2][4]) {
#pragma unroll
    for (int ai = 0; ai < 2; ++ai)
#pragma unroll
        for (int m = 0; m < 4; ++m) { const f32x4 p = *(const f32x4*)(ssq + ((size_t)fq * 17408 + row0 + ai * HALF + m * 16) * 4); rs[ai][m] = (p[0] + p[1]) + (p[2] + p[3]); }
#pragma unroll
    for (int ai = 0; ai < 2; ++ai)
#pragma unroll
        for (int m = 0; m < 4; ++m) { float s = rs[ai][m]; s += __shfl_xor(s, 16); s += __shfl_xor(s, 32); rs[ai][m] = __builtin_amdgcn_rsqf(s * (1.0f / 1024.0f) + 1e-6f); }
}
__device__ __forceinline__ void rows_rstd_lds(const PG8_LAS float* rl, int r0, float (&rs)[2][4]) {
#pragma unroll
    for (int ai = 0; ai < 2; ++ai)
#pragma unroll
        for (int m = 0; m < 4; ++m) rs[ai][m] = rl[r0 + ai * HALF + m * 16];
}
struct EpiNull {
    static constexpr bool PERM = true, AFTER_DRAIN = false, RSTD_LDS = false, XPREFETCH = false;
    __device__ __forceinline__ void operator()(const f32x4 (&acc)[2][2][4][2], const Unit& u, int wr, int wc, int fr, int fq) const {
#pragma unroll
        for (int ai = 0; ai < 2; ++ai)
#pragma unroll
            for (int bj = 0; bj < 2; ++bj)
#pragma unroll
                for (int m = 0; m < 4; ++m) { asm volatile("" :: "v"(acc[ai][bj][m][0]), "v"(acc[ai][bj][m][1])); }
    }
};
__device__ __forceinline__ unsigned pack_u8x4(float a, float b, float c, float d) {
    unsigned w = 0u; w = __builtin_amdgcn_cvt_pk_u8_f32(a, 0u, w); w = __builtin_amdgcn_cvt_pk_u8_f32(b, 1u, w); w = __builtin_amdgcn_cvt_pk_u8_f32(c, 2u, w); w = __builtin_amdgcn_cvt_pk_u8_f32(d, 3u, w); return w; }
__device__ __forceinline__ float sig255(float t) { return __builtin_amdgcn_rcpf(__builtin_fmaf(__builtin_amdgcn_exp2f(t), 1.0f / 255.0f, 1.0f / 255.0f)); }
struct EpiProj {
    static constexpr bool PERM = true, AFTER_DRAIN = false, RSTD_LDS = true, XPREFETCH = false;
    bf16_t* PM; unsigned char* GT; const float* ssq; const float* bgate; const PG8_LAS float* rl;
    __device__ __forceinline__ void operator()(const f32x4 (&acc)[2][2][4][2], const Unit& u, int wr, int wc, int fr, int fq) const {
        const int row0 = u.pm * BM + wr * 64 + fr;
        float rsv[2][4]; rows_rstd_lds(rl, wr * 64 + fr, rsv);
        if (u.pn >= 7) {
            constexpr float NL2E = -1.4426950408889634f;
            const int lc0 = (u.pn - 7) * BM + wc * 32 + 8 * fq;
            f32x4 bv[2][2];
#pragma unroll
            for (int bj = 0; bj < 2; ++bj)
#pragma unroll
                for (int n = 0; n < 2; ++n) bv[bj][n] = *(const f32x4*)(bgate + lc0 + bj * HALF + 4 * n) * NL2E;
#pragma unroll
            for (int ai = 0; ai < 2; ++ai)
#pragma unroll
                for (int m = 0; m < 4; ++m) { const int row = row0 + ai * HALF + m * 16;
                    const float rs = rsv[ai][m] * NL2E;
                    unsigned char* rowp = GT + (size_t)row * 4096 + lc0;
#pragma unroll
                    for (int bj = 0; bj < 2; ++bj) { const f32x4 v0 = acc[ai][bj][m][0] * rs + bv[bj][0], v1 = acc[ai][bj][m][1] * rs + bv[bj][1];
                        typedef unsigned u32x2_t __attribute__((ext_vector_type(2)));
                        u32x2_t w; w.x = pack_u8x4(sig255(v0[0]), sig255(v0[1]), sig255(v0[2]), sig255(v0[3])); w.y = pack_u8x4(sig255(v1[0]), sig255(v1[1]), sig255(v1[2]), sig255(v1[3]));
                        *(u32x2_t*)(rowp + bj * HALF) = w; } }
        } else {
            const int lc0 = u.pn * BM + wc * 32 + 8 * fq;
#pragma unroll
            for (int ai = 0; ai < 2; ++ai)
#pragma unroll
                for (int m = 0; m < 4; ++m) { const int row = row0 + ai * HALF + m * 16;
                    const float rs = rsv[ai][m];
                    bf16_t* rowp = PM + (size_t)row * 1792 + lc0;
#pragma unroll
                    for (int bj = 0; bj < 2; ++bj) { const f32x4 v0 = acc[ai][bj][m][0] * rs, v1 = acc[ai][bj][m][1] * rs;
                        u32x4 w; w.x = cvt_pk_bf16(v0[0], v0[1]); w.y = cvt_pk_bf16(v0[2], v0[3]); w.z = cvt_pk_bf16(v1[0], v1[1]); w.w = cvt_pk_bf16(v1[2], v1[3]);
                        *(u32x4*)(rowp + bj * HALF) = w; } }
        }
    }
};
struct EpiResid {
    static constexpr bool PERM = true, AFTER_DRAIN = false, RSTD_LDS = false, XPREFETCH = true;
    bf16_t* XB; float* ssq;
    __device__ __forceinline__ void prefetch(const Unit& u, PG8_LAS unsigned char* dump, int tid) const {
        const unsigned vo = (unsigned)(tid >> 2) * 2048u + (unsigned)(tid & 3) * 128u;
        const char* base = (const char*)(XB + (size_t)u.pm * BM * 1024 + u.pn * BM);
        __builtin_amdgcn_global_load_lds((const unsigned*)(base + vo), (PG8_LAS unsigned*)dump, 4, 0, 0);
        __builtin_amdgcn_global_load_lds((const unsigned*)(base + (size_t)128 * 2048 + vo), (PG8_LAS unsigned*)dump, 4, 0, 0);
    }
    __device__ __forceinline__ void operator()(const f32x4 (&acc)[2][2][4][2], const Unit& u, int wr, int wc, int fr, int fq) const {
        const int row0 = u.pm * BM + wr * 64 + fr, col0 = u.pn * BM + wc * 32 + 8 * fq;
#pragma unroll
        for (int ai = 0; ai < 2; ++ai)
#pragma unroll
            for (int m = 0; m < 4; ++m) { const int row = row0 + ai * HALF + m * 16;
                bf16_t* dstb = XB + (size_t)row * 1024 + col0; float ss = 0.f;
                f32x4 x0[2], x1[2];
                {
#pragma unroll
                    for (int bj = 0; bj < 2; ++bj) { const u32x4 q = *(const u32x4*)(dstb + bj * HALF);
                        x0[bj] = (f32x4){__builtin_bit_cast(float, q.x << 16), __builtin_bit_cast(float, q.x & 0xffff0000u), __builtin_bit_cast(float, q.y << 16), __builtin_bit_cast(float, q.y & 0xffff0000u)};
                        x1[bj] = (f32x4){__builtin_bit_cast(float, q.z << 16), __builtin_bit_cast(float, q.z & 0xffff0000u), __builtin_bit_cast(float, q.w << 16), __builtin_bit_cast(float, q.w & 0xffff0000u)}; } }
#pragma unroll
                for (int bj = 0; bj < 2; ++bj) { const f32x4 o0 = x0[bj] + acc[ai][bj][m][0], o1 = x1[bj] + acc[ai][bj][m][1];
                    u32x4 w; w.x = cvt_pk_bf16(o0[0], o0[1]); w.y = cvt_pk_bf16(o0[2], o0[3]); w.z = cvt_pk_bf16(o1[0], o1[1]); w.w = cvt_pk_bf16(o1[2], o1[3]);
                    *(u32x4*)(dstb + bj * HALF) = w;
                    ss += ((o0[0] * o0[0] + o0[1] * o0[1]) + (o0[2] * o0[2] + o0[3] * o0[3])) + ((o1[0] * o1[0] + o1[1] * o1[1]) + (o1[2] * o1[2] + o1[3] * o1[3])); }
                ss += __shfl_xor(ss, 16); ss += __shfl_xor(ss, 32);
                if (fq == 0) ssq[((size_t)u.pn * 17408 + row) * 4 + wc] = ss; }
    }
};
struct EpiSwiGLU {
    static constexpr bool PERM = true, AFTER_DRAIN = false, RSTD_LDS = true, XPREFETCH = false;
    bf16_t* ACT; const float* ssq; const PG8_LAS float* rl;
    __device__ __forceinline__ void operator()(const f32x4 (&acc)[2][2][4][2], const Unit& u, int wr, int wc, int fr, int fq) const {
        const int row0 = u.pm * BM + wr * 64 + fr, col0 = u.pn * HALF + wc * 32 + 8 * fq;
        float rsv[2][4]; rows_rstd_lds(rl, wr * 64 + fr, rsv);
#pragma unroll
        for (int ai = 0; ai < 2; ++ai)
#pragma unroll
            for (int m = 0; m < 4; ++m) { const int row = row0 + ai * HALF + m * 16;
                const float rs = rsv[ai][m], rsn = rs * -1.4426950408889634f, rs2 = rs * rs;
                float o[8];
#pragma unroll
                for (int j = 0; j < 4; ++j) { const float a0 = acc[ai][0][m][0][j], a1 = acc[ai][0][m][1][j];
                    o[j] = (a0 * acc[ai][1][m][0][j]) * (__builtin_amdgcn_rcpf(1.0f + __builtin_amdgcn_exp2f(a0 * rsn)) * rs2); o[4 + j] = (a1 * acc[ai][1][m][1][j]) * (__builtin_amdgcn_rcpf(1.0f + __builtin_amdgcn_exp2f(a1 * rsn)) * rs2); }
                u32x4 w; w.x = cvt_pk_bf16(o[0], o[1]); w.y = cvt_pk_bf16(o[2], o[3]); w.z = cvt_pk_bf16(o[4], o[5]); w.w = cvt_pk_bf16(o[6], o[7]);
                *(u32x4*)(ACT + (size_t)row * 2816 + col0) = w; }
    }
};

template <class Epi, class Sched, bool ALIGN_EPI = false, bool SP2 = false>
__device__ __forceinline__ void gemm_phase(PG8_LAS unsigned char* lds, const Gemm g, const Sched& S, const Epi& E, int tidp) {
    int tid_ = tidp; asm volatile("" : "+v"(tid_));
    const int tid = tid_, wid = __builtin_amdgcn_readfirstlane(tid >> 6), lane = tid & 63, wr = wid >> 2, wc = wid & 3, fr = lane & 15, fq = lane >> 4;
    const int K = g.K, nt = K / BK;
    unsigned voffA[2], voffB[2];
#pragma unroll
    for (int i = 0; i < 2; ++i) { int R, C; stage_rc(tid * 16 + i * 8192, R, C); const int Rb = Epi::PERM ? ((R & ~31) + perm32(R & 31)) : R;
        voffA[i] = (unsigned)(R * K + C) * 2u; voffB[i] = (unsigned)(Rb * K + C) * 2u; }
    const size_t kstep = (size_t)(BK * 2);
    const size_t hstep = (size_t)HALF * K * 2;
    const size_t tstep = 2 * hstep;
    const unsigned ldsw = (unsigned)wid * 1024u;
    const int aoff = lds_byte(wr * 64 + fr, fq * 8), boff = lds_byte(wc * 32 + fr, fq * 8);
#define PG8_SA(b, h) (((b) * 2 + (h)) * HTB)
#define PG8_SB(b, h) ((4 + (b) * 2 + (h)) * HTB)
#define PG8_STAGE(bufoff, gbase, voff) do { _Pragma("unroll") for (int _i = 0; _i < 2; ++_i) \
        __builtin_amdgcn_global_load_lds((const unsigned*)((const char*)(gbase) + (voff)[_i]), (PG8_LAS unsigned*)(lds + (bufoff) + ldsw + _i * 8192), 16, 0, 0); } while (0)
#define PG8_LDA(dst, b, h) do { _Pragma("unroll") for (int m = 0; m < 4; ++m) _Pragma("unroll") for (int k = 0; k < 2; ++k) dst[m][k] = *(const PG8_LAS bf16x8*)(lds + PG8_SA(b, h) + aoff + m * 2048 + k * 1024); } while (0)
#define PG8_LDB(dst, b, h) do { _Pragma("unroll") for (int n = 0; n < 2; ++n) _Pragma("unroll") for (int k = 0; k < 2; ++k) dst[n][k] = *(const PG8_LAS bf16x8*)(lds + PG8_SB(b, h) + boff + n * 2048 + k * 1024); } while (0)
#define PG8_MMA(ai, bj, At, Bt) do { __builtin_amdgcn_s_setprio(1); _Pragma("unroll") for (int m = 0; m < 4; ++m) _Pragma("unroll") for (int n = 0; n < 2; ++n) _Pragma("unroll") for (int k = 0; k < 2; ++k) \
        acc[ai][bj][m][n] = __builtin_amdgcn_mfma_f32_16x16x32_bf16(Bt[n][k], At[m][k], acc[ai][bj][m][n], 0, 0, 0); __builtin_amdgcn_s_setprio(0); } while (0)
#define PG8_WAIT_V(n) asm volatile("s_waitcnt vmcnt(" #n ")" ::: "memory")
#define PG8_WAIT_L(n) asm volatile("s_waitcnt lgkmcnt(" #n ")" ::: "memory")
#define PG8_BAR __builtin_amdgcn_s_barrier()
#define PG8_SCHED __builtin_amdgcn_sched_barrier(0)
    Unit cur, nxt; int ui = 0;
    if (!S.next(0, cur)) return;
    f32x4 acc[2][2][4][2];
#pragma unroll
    for (int a = 0; a < 2; ++a)
#pragma unroll
        for (int b = 0; b < 2; ++b)
#pragma unroll
            for (int m = 0; m < 4; ++m)
#pragma unroll
                for (int n = 0; n < 2; ++n) acc[a][b][m][n] = (f32x4){0.f, 0.f, 0.f, 0.f};
    bf16x8 At[4][2], B0[2][2], B1[2][2];
    const char* cA = (const char*)g.A + (size_t)cur.pm * tstep; const char* cB = (const char*)g.Bt + (size_t)cur.pn * tstep;
    S.a_ready(cur);
    if constexpr (SP2) {
        PG8_STAGE(PG8_SB(0, 0), cB, voffB); PG8_STAGE(PG8_SB(0, 1), cB + hstep, voffB); PG8_STAGE(PG8_SA(0, 0), cA, voffA); PG8_STAGE(PG8_SA(0, 1), cA + hstep, voffA);
        if (wr == 1) PG8_BAR;
        PG8_WAIT_V(2); PG8_BAR;
        PG8_STAGE(PG8_SB(1, 0), cB + kstep, voffB); PG8_STAGE(PG8_SA(1, 0), cA + kstep, voffA); PG8_STAGE(PG8_SB(1, 1), cB + hstep + kstep, voffB);
        PG8_WAIT_V(6); PG8_BAR;
    } else {
        PG8_STAGE(PG8_SB(0, 0), cB, voffB); PG8_STAGE(PG8_SA(0, 0), cA, voffA); PG8_STAGE(PG8_SB(0, 1), cB + hstep, voffB); PG8_STAGE(PG8_SA(0, 1), cA + hstep, voffA);
        if (wr == 1) PG8_BAR;
        PG8_WAIT_V(4); PG8_BAR;
        PG8_STAGE(PG8_SB(1, 0), cB + kstep, voffB); PG8_STAGE(PG8_SA(1, 0), cA + kstep, voffA); PG8_STAGE(PG8_SB(1, 1), cB + hstep + kstep, voffB);
        PG8_WAIT_V(6); PG8_BAR;
    }
    for (;;) {
        const bool has_next = S.next(ui + 1, nxt);
        const char* nA = has_next ? (const char*)g.A + (size_t)nxt.pm * tstep : cA; const char* nB = has_next ? (const char*)g.Bt + (size_t)nxt.pn * tstep : cB;
        for (int t = 0; t < nt; t += 2) {
            const bool last = (t == nt - 2);
            if constexpr (Epi::RSTD_LDS) {
                if (t == 2 || t == 4) { PG8_WAIT_V(8);
                    const f32x4 v = *(const PG8_LAS f32x4*)(lds + RSTD_RAW_OFF + ldsw + lane * 16);
                    float s = (v[0] + v[1]) + (v[2] + v[3]); s += __shfl_xor(s, 1); s += __shfl_xor(s, 2);
                    if (!(tid & 3)) *(PG8_LAS float*)(lds + RSTD_LDS_OFF + ((t - 2) * 64 + (tid >> 2)) * 4) = __builtin_amdgcn_rsqf(s * (1.0f / 1024.0f) + 1e-6f);
                    PG8_WAIT_L(0); }
                if (t == 0 || t == 2) __builtin_amdgcn_global_load_lds((const unsigned*)(E.ssq + ((size_t)(tid & 3) * 17408 + (size_t)cur.pm * BM + t * 64 + (tid >> 2)) * 4), (PG8_LAS unsigned*)(lds + RSTD_RAW_OFF + ldsw), 16, 0, 0);
            }
            if constexpr (Epi::XPREFETCH) { if (t == nt - XPF_LEAD) E.prefetch(cur, lds + RSTD_RAW_OFF + ldsw, tid); }
            const char* a1 = cA + (size_t)(t + 1) * kstep;
            const char* a2 = last ? nA : cA + (size_t)(t + 2) * kstep; const char* b2 = last ? nB : cB + (size_t)(t + 2) * kstep;
            const char* a3 = a2 + kstep; const char* b3 = b2 + kstep;
            if (last && has_next) S.a_ready(nxt);
            if constexpr (SP2) {
            PG8_LDB(B0, 0, 0); PG8_LDB(B1, 0, 1); PG8_SCHED; PG8_LDA(At, 0, 0); PG8_STAGE(PG8_SA(1, 1), a1 + hstep, voffA);
            PG8_WAIT_V(8); PG8_WAIT_L(0); PG8_BAR; PG8_MMA(0, 0, At, B0); PG8_MMA(0, 1, At, B1); PG8_BAR; PG8_SCHED;
            PG8_LDA(At, 0, 1); PG8_STAGE(PG8_SB(0, 0), b2, voffB); PG8_STAGE(PG8_SB(0, 1), b2 + hstep, voffB); PG8_STAGE(PG8_SA(0, 0), a2, voffA);
            PG8_WAIT_V(8); PG8_WAIT_L(0); PG8_BAR; PG8_MMA(1, 0, At, B0); PG8_MMA(1, 1, At, B1); PG8_BAR; PG8_SCHED;
            PG8_LDB(B0, 1, 0); PG8_LDB(B1, 1, 1); PG8_SCHED; PG8_LDA(At, 1, 0); PG8_STAGE(PG8_SA(0, 1), a2 + hstep, voffA);
            PG8_WAIT_V(8); PG8_WAIT_L(0); PG8_BAR; PG8_MMA(0, 0, At, B0); PG8_MMA(0, 1, At, B1); PG8_BAR; PG8_SCHED;
            PG8_LDA(At, 1, 1); PG8_STAGE(PG8_SB(1, 0), b3, voffB); PG8_STAGE(PG8_SB(1, 1), b3 + hstep, voffB); PG8_STAGE(PG8_SA(1, 0), a3, voffA);
            PG8_WAIT_V(8); PG8_WAIT_L(0); PG8_BAR; PG8_MMA(1, 0, At, B0); PG8_MMA(1, 1, At, B1); PG8_BAR; PG8_SCHED;
            } else {
            PG8_LDB(B0, 0, 0); PG8_SCHED; PG8_LDA(At, 0, 0); PG8_STAGE(PG8_SA(1, 1), a1 + hstep, voffA);
            PG8_WAIT_L(8); PG8_BAR; PG8_WAIT_L(0); PG8_MMA(0, 0, At, B0); PG8_BAR; PG8_SCHED;
            PG8_LDB(B1, 0, 1); PG8_STAGE(PG8_SB(0, 0), b2, voffB);
            PG8_BAR; PG8_WAIT_L(0); PG8_MMA(0, 1, At, B1); PG8_BAR;
            PG8_LDA(At, 0, 1); PG8_STAGE(PG8_SA(0, 0), a2, voffA);
            PG8_BAR; PG8_WAIT_L(0); PG8_MMA(1, 0, At, B0); PG8_BAR; PG8_SCHED;
            PG8_STAGE(PG8_SB(0, 1), b2 + hstep, voffB);
            PG8_WAIT_V(6); PG8_BAR; PG8_MMA(1, 1, At, B1); PG8_BAR;
            PG8_LDB(B0, 1, 0); PG8_SCHED; PG8_LDA(At, 1, 0); PG8_STAGE(PG8_SA(0, 1), a2 + hstep, voffA);
            PG8_WAIT_L(8); PG8_BAR; PG8_WAIT_L(0); PG8_MMA(0, 0, At, B0); PG8_BAR; PG8_SCHED;
            PG8_LDB(B1, 1, 1); PG8_STAGE(PG8_SB(1, 0), b3, voffB);
            PG8_BAR; PG8_WAIT_L(0); PG8_MMA(0, 1, At, B1); PG8_BAR;
            PG8_LDA(At, 1, 1); PG8_STAGE(PG8_SA(1, 0), a3, voffA);
            PG8_BAR; PG8_WAIT_L(0); PG8_MMA(1, 0, At, B0); PG8_BAR; PG8_SCHED;
            PG8_STAGE(PG8_SB(1, 1), b3 + hstep, voffB);
            PG8_WAIT_V(6); PG8_BAR; PG8_MMA(1, 1, At, B1); PG8_BAR;
            }
        }
        if constexpr (ALIGN_EPI) { if (wr == 0) PG8_BAR; }
        if constexpr (!Epi::AFTER_DRAIN) { E(acc, cur, wr, wc, fr, fq); S.done(cur); }
        if (!has_next) break;
#pragma unroll
        for (int a = 0; a < 2; ++a)
#pragma unroll
            for (int b = 0; b < 2; ++b)
#pragma unroll
                for (int m = 0; m < 4; ++m)
#pragma unroll
                    for (int n = 0; n < 2; ++n) acc[a][b][m][n] = (f32x4){0.f, 0.f, 0.f, 0.f};
        cur = nxt; cA = nA; cB = nB; ++ui;
        if constexpr (ALIGN_EPI) { if (wr == 1) PG8_BAR; }
    }
    PG8_WAIT_V(0);
    if constexpr (!ALIGN_EPI) { if (wr == 0) PG8_BAR; }
    PG8_BAR;
    if constexpr (Epi::AFTER_DRAIN) { E.fused(acc, cur, wr, wc, fr, fq, lds, wid, lane); S.done(cur); }
#undef PG8_SA
#undef PG8_SB
#undef PG8_STAGE
#undef PG8_LDA
#undef PG8_LDB
#undef PG8_MMA
#undef PG8_WAIT_V
#undef PG8_WAIT_L
#undef PG8_BAR
#undef PG8_SCHED
}
}
constexpr int D = 1024, MP = 16384, MS = 1024, M = MP + MS, NLAYER = 4, MIXW = 256, INC = 5888, PMC = 1792, GTC = 4096, FF = 2816;
constexpr int SEQ = 2048, NB = 8, DB = 128, DSEQ = 8, NCH = SEQ / 64;
constexpr int NPHASE = 2 + 7 * NLAYER;
#ifndef MK_PER_PHASE
#define MK_PER_PHASE 0
#endif
constexpr size_t O_Y = 0, O_POOLP = 17825792, O_POOLS = 17948672, O_SREP = 19914752, O_SRES = 19947520, O_SIMP = 20471808, O_SIMS = 20504576,
                 O_SCP = 21028864, O_SCS = 21045248, O_CFP = 21307392, O_CFS = 21553152, O_END = 25485312;
constexpr size_t MiB = 1u << 20;
constexpr size_t WS_CTL = 0, CTL_ZERO_BYTES = 64 * 1024;
constexpr size_t WS_SSQ = 1 * MiB;
constexpr size_t WS_E = 3 * MiB;
constexpr size_t WS_TAB = 5 * MiB;
constexpr size_t TAB_LB = 0, TAB_LP = 8192, TAB_BBT = 16384, TAB_CM = TAB_BBT + 65536, TAB_PW = TAB_CM + 65536, TAB_STRIDE = TAB_PW + 32768;
constexpr size_t WS_WIN = 6 * MiB;
constexpr size_t WS_WFI = WS_WIN + (size_t)NLAYER * INC * D * 2;
constexpr size_t WS_WOUT = WS_WFI + (size_t)NLAYER * 2 * FF * D * 2;
constexpr size_t WS_WFO = WS_WOUT + (size_t)NLAYER * D * D * 2;
constexpr size_t WS_WBR = WS_WFO + (size_t)NLAYER * D * FF * 2;
constexpr size_t WS_WGLU = WS_WBR + (size_t)NLAYER * 4 * D * MIXW * 2;
constexpr size_t WS_ACT1 = WS_WGLU + (size_t)NLAYER * MIXW * MIXW * 2;
constexpr size_t WS_PM = WS_ACT1 + (size_t)M * D * 2;
constexpr size_t WS_GT = WS_PM + (size_t)M * PMC * 2;
constexpr size_t WS_END = WS_GT + (size_t)M * GTC * 2;
static_assert(WS_TAB + NLAYER * TAB_STRIDE <= WS_WIN && WS_E + (size_t)NB * NCH * 1024 * 8 <= WS_TAB && WS_SSQ + (size_t)M * 64 <= WS_E, "d_ws map");
constexpr int CW_Q = 8192;
constexpr int CW_BAR = 1024;
constexpr int RING_OFF = 0, RING_BYTES = 147456;
constexpr int LDSCTL_OFF = RING_BYTES, MISC_OFF = LDSCTL_OFF + 320;
constexpr int LDS_BYTES = 163840;
constexpr int NWAVES = 8;

#define GAS __attribute__((address_space(1)))
#define LAS __attribute__((address_space(3)))
typedef unsigned short bf16;
typedef unsigned short bf16_t;
typedef unsigned v4u __attribute__((ext_vector_type(4)));
typedef unsigned v2u __attribute__((ext_vector_type(2)));
typedef float f32x4 __attribute__((ext_vector_type(4)));
typedef float f32x2 __attribute__((ext_vector_type(2)));
typedef short bf16x8 __attribute__((ext_vector_type(8)));
#define LDS_WAIT() asm volatile("s_waitcnt lgkmcnt(0)" ::: "memory")
#define VM_WAIT() asm volatile("s_waitcnt vmcnt(0)" ::: "memory")
__device__ __forceinline__ unsigned pk2(float lo, float hi) { return pg8::cvt_pk_bf16(lo, hi); }
__device__ __forceinline__ float bflo(unsigned u) { return __builtin_bit_cast(float, u << 16); }
__device__ __forceinline__ float bfhi(unsigned u) { return __builtin_bit_cast(float, u & 0xffff0000u); }
__device__ __forceinline__ float bf1(bf16_t b) { return __builtin_bit_cast(float, (unsigned)b << 16); }
__device__ __forceinline__ void unpack8(const v4u v, float (&f)[8]) { f[0] = bflo(v.x); f[1] = bfhi(v.x); f[2] = bflo(v.y); f[3] = bfhi(v.y); f[4] = bflo(v.z); f[5] = bfhi(v.z); f[6] = bflo(v.w); f[7] = bfhi(v.w); }
__device__ __forceinline__ v4u pack8(const float (&f)[8]) { v4u w; w.x = pk2(f[0], f[1]); w.y = pk2(f[2], f[3]); w.z = pk2(f[4], f[5]); w.w = pk2(f[6], f[7]); return w; }
__device__ __forceinline__ float sigm(float x) { return pg8::sigm(x); }
__device__ __forceinline__ float gelu_tanh(float y) { const float in2 = 1.5957691216057308f * (y + 0.044715f * y * y * y); const float e = __builtin_amdgcn_exp2f(1.4426950408889634f * in2); return 0.5f * y * (2.0f - 2.0f * __builtin_amdgcn_rcpf(e + 1.0f)); }
__device__ __forceinline__ float wave_sum(float v) {
#pragma unroll
    for (int o = 1; o < 64; o <<= 1) v += __shfl_xor(v, o);
    return v;
}

#define XB_TMO      128
#define XB_XCNT(j)  (256  + 64 * (j))
#define XB_XSUB(j)  (1280 + 64 * (j))
#define XB_XGEN(j)  (2304 + 64 * (j))
#define XB_TOP      3328
#define XB_TOPGEN   3392
#define XCD_BAR_WORDS 3456
#define XB_SPIN_CAP (1u << 18)

__device__ __forceinline__ unsigned xb_ld(unsigned* p)              { return __hip_atomic_load(p, __ATOMIC_RELAXED, __HIP_MEMORY_SCOPE_AGENT); }
__device__ __forceinline__ unsigned xb_add(unsigned* p, unsigned v) { return __hip_atomic_fetch_add(p, v, __ATOMIC_RELAXED, __HIP_MEMORY_SCOPE_AGENT); }
__device__ __forceinline__ unsigned xb_xcc_id() { return (unsigned)__builtin_amdgcn_s_getreg((3 << 11) | 20) & 0xFu; }
#define XB_SPIN(cond, bar) do { unsigned _sp = 0; while (cond) { __builtin_amdgcn_s_sleep(1); \
    if ((++_sp & 255u) == 0u) { if (xb_ld(&(bar)[XB_TMO])) break; if (_sp > XB_SPIN_CAP) { atomicAdd(&(bar)[XB_TMO], 1u); break; } } } } while (0)

struct XcdBarrier {
    unsigned* bar; unsigned x;
    volatile LAS unsigned* st;
};

__device__ __forceinline__ XcdBarrier xcd_barrier_post(unsigned* bar, volatile LAS unsigned* st) {
    XcdBarrier b; b.bar = bar; b.x = xb_xcc_id(); b.st = st;
    if (threadIdx.x == 0) (void)xb_add(&bar[XB_XCNT(b.x)], 1u);
    return b;
}
__device__ __forceinline__ void xcd_barrier_complete(unsigned* bar, unsigned x, unsigned& nloc, unsigned& nx) {
    const unsigned G = gridDim.x * gridDim.y * gridDim.z;
    unsigned sum, cnt, mine, sp = 0u;
    for (;;) {
        sum = 0u; cnt = 0u; mine = 0u;
#pragma unroll
        for (unsigned j = 0; j < 16; ++j) { const unsigned c = xb_ld(&bar[XB_XCNT(j)]); sum += c; cnt += (c > 0u) ? 1u : 0u; mine = (j == x) ? c : mine; }
        if (sum == G) break;
        __builtin_amdgcn_s_sleep(1);
        if ((++sp & 255u) == 0u) { if (xb_ld(&bar[XB_TMO])) break; if (sp > XB_SPIN_CAP) { atomicAdd(&bar[XB_TMO], 1u); break; } }
    }
    nloc = mine > 0u ? mine : 1u; nx = cnt > 0u ? cnt : 1u;
}

__device__ __forceinline__ void xcd_barrier_leader(const XcdBarrier& b) {
    {
        unsigned* bar = b.bar;
        __builtin_amdgcn_s_waitcnt(0);
        unsigned nloc = b.st[0], nx = b.st[1];
        if (nloc == 0u) { xcd_barrier_complete(bar, b.x, nloc, nx); b.st[0] = nloc; b.st[1] = nx; }
        const unsigned old = xb_add(&bar[XB_XSUB(b.x)], 1u);
        const unsigned gen = old / nloc;
        if (old + 1u == (gen + 1u) * nloc) {
            __builtin_amdgcn_fence(__ATOMIC_RELEASE, "agent");
            asm volatile("s_waitcnt vmcnt(0)" ::: "memory");
            const unsigned og = xb_add(&bar[XB_TOP], 1u);
            const unsigned tg = og / nx;
            if (og + 1u == (tg + 1u) * nx) xb_add(&bar[XB_TOPGEN], 1u);
            else XB_SPIN(xb_ld(&bar[XB_TOPGEN]) == tg, bar);
            __builtin_amdgcn_fence(__ATOMIC_ACQUIRE, "agent");
            xb_add(&bar[XB_XGEN(b.x)], 1u);
            asm volatile("s_waitcnt vmcnt(0)" ::: "memory");
        } else {
            XB_SPIN(xb_ld(&bar[XB_XGEN(b.x)]) == gen, bar);
            __builtin_amdgcn_fence(__ATOMIC_ACQUIRE, "agent");
            asm volatile("s_waitcnt vmcnt(0)" ::: "memory");
        }
    }
}
__device__ __forceinline__ void xcd_barrier(const XcdBarrier& b, bool leader) {
    asm volatile("s_waitcnt vmcnt(0)" ::: "memory");
    __syncthreads();
    if (leader) xcd_barrier_leader(b);
    __syncthreads();
}
struct Args { const float* in[32]; float* out; unsigned char* ws; int ph_lo, ph_hi; };
enum { I_XP = 0, I_XS, I_STPOOL, I_STRE, I_STIM, I_STSC, I_STCF, I_N1G, I_N2G, I_FING, I_WIN, I_BGATE, I_POOLW, I_POOLSC, I_LAMRE, I_LAMIM, I_LOGDT,
       I_BRE, I_BIM, I_CRE, I_CIM, I_DSKIP, I_WGLU, I_BGLU, I_SCW, I_CFW, I_CFLNG, I_CFLNB, I_WBR, I_WOUT, I_WFI, I_WFO };

__device__ __forceinline__ void p0_item(const float* W, int ldw, int src_col0, const float* kscale, int k0, bf16* WTrow0, int K, LAS float* scr, int lane) {
    float wv[32];
#pragma unroll
    for (int i = 0; i < 32; ++i) { const int kk = 2 * i + (lane >> 5); wv[i] = W[(size_t)(k0 + kk) * ldw + src_col0 + (lane & 31)]; }
#pragma unroll
    for (int i = 0; i < 32; ++i) { const int kk = 2 * i + (lane >> 5); scr[kk * 33 + (lane & 31)] = wv[i]; }
    LDS_WAIT(); asm volatile("" ::: "memory");
    const int c = lane & 7;
    f32x4 ks0 = (f32x4){1.f, 1.f, 1.f, 1.f}, ks1 = ks0;
    if (kscale) { ks0 = *(const f32x4*)(kscale + k0 + 8 * c); ks1 = *(const f32x4*)(kscale + k0 + 8 * c + 4); }
#pragma unroll
    for (int j = 0; j < 4; ++j) { const int n = (lane >> 3) + 8 * j; const LAS float* s = scr + (8 * c) * 33 + n;
        v4u o; o.x = pk2(s[0 * 33] * ks0[0], s[1 * 33] * ks0[1]); o.y = pk2(s[2 * 33] * ks0[2], s[3 * 33] * ks0[3]); o.z = pk2(s[4 * 33] * ks1[0], s[5 * 33] * ks1[1]); o.w = pk2(s[6 * 33] * ks1[2], s[7 * 33] * ks1[3]);
        *(GAS v4u*)(WTrow0 + (size_t)n * K + k0 + 8 * c) = o; }
    LDS_WAIT(); asm volatile("" ::: "memory");
}
constexpr int P0_IT_IN = 16 * (INC / 32), P0_IT_FI = 16 * (2 * FF / 32), P0_IT_OUT = 16 * 32, P0_IT_FO = (FF / 64) * 32, P0_IT_BR = 4 * 4 * 32, P0_IT_GLU = 4 * 8;
constexpr int P0_IT_LAYER = P0_IT_IN + P0_IT_FI + P0_IT_OUT + P0_IT_FO + P0_IT_BR + P0_IT_GLU;
__device__ __forceinline__ void p0_weight_item(const Args& a, int L, int r, LAS float* scr, int lane) {
    unsigned char* ws = a.ws;
    if (r < P0_IT_IN) { const int nblk = INC / 32, kb = r / nblk, nb = r % nblk;
        p0_item(a.in[I_WIN] + (size_t)L * D * INC, INC, 32 * nb, a.in[I_N1G] + L * D, 64 * kb, (bf16*)(ws + WS_WIN) + ((size_t)L * INC + 32 * nb) * D, D, scr, lane); return; } r -= P0_IT_IN;
    if (r < P0_IT_FI) { const int nblk = 2 * FF / 32, kb = r / nblk, nb = r % nblk; const int nd = 32 * nb, pn = nd >> 8, rr = nd & 255;
        const int src = rr < 128 ? 128 * pn + rr : FF + 128 * pn + (rr - 128);
        p0_item(a.in[I_WFI] + (size_t)L * D * 2 * FF, 2 * FF, src, a.in[I_N2G] + L * D, 64 * kb, (bf16*)(ws + WS_WFI) + ((size_t)L * 2 * FF + nd) * D, D, scr, lane); return; } r -= P0_IT_FI;
    if (r < P0_IT_OUT) { const int kb = r / 32, nb = r % 32;
        p0_item(a.in[I_WOUT] + (size_t)L * D * D, D, 32 * nb, nullptr, 64 * kb, (bf16*)(ws + WS_WOUT) + ((size_t)L * D + 32 * nb) * D, D, scr, lane); return; } r -= P0_IT_OUT;
    if (r < P0_IT_FO) { const int kb = r / 32, nb = r % 32;
        p0_item(a.in[I_WFO] + (size_t)L * FF * D, D, 32 * nb, nullptr, 64 * kb, (bf16*)(ws + WS_WFO) + ((size_t)L * D + 32 * nb) * FF, FF, scr, lane); return; } r -= P0_IT_FO;
    if (r < P0_IT_BR) { const int br = r / 128, q = r % 128, kb = q / 32, nb = q % 32;
        p0_item(a.in[I_WBR] + (size_t)(L * 4 + br) * MIXW * D, D, 32 * nb, nullptr, 64 * kb, (bf16*)(ws + WS_WBR) + ((size_t)(L * 4 + br) * D + 32 * nb) * MIXW, MIXW, scr, lane); return; } r -= P0_IT_BR;
    { const int kb = r / 8, nb = r % 8;
        p0_item(a.in[I_WGLU] + (size_t)L * MIXW * MIXW, MIXW, 32 * nb, nullptr, 64 * kb, (bf16*)(ws + WS_WGLU) + ((size_t)L * MIXW + 32 * nb) * MIXW, MIXW, scr, lane); }
}
constexpr int P0_SLICES = 6, P0_F_PER = 7, P0_A_PER = 2, P0_F_BID0 = 216, P0_A_BID0 = 192;
__device__ __forceinline__ int p0_items_A(int G) { return 0; }
__device__ __forceinline__ int p0_items_F(int G) { return G == 256 ? (256 - P0_F_BID0) * NWAVES * P0_F_PER : 0; }
__device__ __forceinline__ void p0_idle_items(const Args& a, LAS unsigned char* lds, int lane, int wave, int bid, int L, int base, int bid0, int per) {
    LAS float* scr = (LAS float*)(lds + RING_OFF + wave * 16384);
    const int nw = (256 - bid0) * NWAVES, w = (bid - bid0) * NWAVES + wave;
    for (int q = 0; q < per; ++q) p0_weight_item(a, L, base + w + q * nw, scr, lane);
}
__device__ __forceinline__ void p0_slice(const Args& a, LAS unsigned char* lds, int lane, int wave, int G, int bid, int L, int slice) {
    LAS float* scr = (LAS float*)(lds + RING_OFF + wave * 16384);
    const int first = p0_items_A(G) + p0_items_F(G), per = (P0_IT_LAYER - first + P0_SLICES - 1) / P0_SLICES;
    const int lo = first + slice * per, hi = (lo + per < P0_IT_LAYER) ? lo + per : P0_IT_LAYER;
    for (int r = lo + bid * (NWAVES - 1) + (wave - 1); r < hi; r += G * (NWAVES - 1)) p0_weight_item(a, L, r, scr, lane);
}
__device__ __forceinline__ void p0_prologue(const Args& a, LAS unsigned char* lds, int tid, int lane, int wave, int G, int bid) {
    LAS float* scr = (LAS float*)(lds + RING_OFF + wave * 16384);
    const int gw = bid * NWAVES + wave, NGW = G * NWAVES;
    unsigned char* ws = a.ws;
    for (int it = gw; it < (MK_PER_PHASE ? NLAYER : 1) * P0_IT_LAYER; it += NGW) p0_weight_item(a, it / P0_IT_LAYER, it % P0_IT_LAYER, scr, lane);
    for (int m = gw; m < M; m += NGW) {
        const float* xrow = m < MP ? a.in[I_XP] + (size_t)m * D : a.in[I_XS] + (size_t)(m - MP) * D;
        const GAS f32x4* xr = (const GAS f32x4*)xrow + lane; f32x4 v[4]; float s = 0.f;
#pragma unroll
        for (int j = 0; j < 4; ++j) { v[j] = xr[64 * j]; s += (v[j][0] * v[j][0] + v[j][1] * v[j][1]) + (v[j][2] * v[j][2] + v[j][3] * v[j][3]); }
        s = wave_sum(s);
        GAS v2u* o8 = (GAS v2u*)((bf16*)(ws + WS_ACT1) + (size_t)m * D) + lane;
#pragma unroll
        for (int j = 0; j < 4; ++j) { v2u w; w.x = pk2(v[j][0], v[j][1]); w.y = pk2(v[j][2], v[j][3]); o8[64 * j] = w; }
        if (lane < 16) ((float*)(ws + WS_SSQ))[((size_t)(lane >> 2) * M + m) * 4 + (lane & 3)] = lane == 0 ? s : 0.f;
    }
    for (int idx = bid * 512 + tid; idx < NLAYER * 1024; idx += G * 512) {
        const int L = idx >> 10, gp = idx & 1023, g = gp >> 6, p = gp & 63;
        unsigned char* tab = ws + WS_TAB + (size_t)L * TAB_STRIDE;
        const float lre = a.in[I_LAMRE][idx], lim = a.in[I_LAMIM][idx], dt = expf(a.in[I_LOGDT][L * 16 + g]);
        const float ar = lre * dt, br_ = lim * dt, ea = expf(ar), cb = cosf(br_), sb = sinf(br_), sh = sinf(0.5f * br_);
        const float lbr = ea * cb, lbi = ea * sb;
        const float m1r = expm1f(ar) * cb - 2.0f * sh * sh, m1i = lbi;
        const float den = 1.0f / (lre * lre + lim * lim);
        const float qr = (m1r * lre + m1i * lim) * den, qi = (m1i * lre - m1r * lim) * den;
        ((f32x2*)(tab + TAB_LB))[gp] = (f32x2){lbr, lbi};
        float pr = lbr, pi = lbi;
#pragma unroll
        for (int s = 0; s < 6; ++s) { const float nr = pr * pr - pi * pi, ni = 2.0f * pr * pi; pr = nr; pi = ni; }
        ((f32x2*)(tab + TAB_LP))[gp] = (f32x2){pr, pi};
        bf16* bbt = (bf16*)(tab + TAB_BBT); bf16* cm = (bf16*)(tab + TAB_CM);
        const float* bre = a.in[I_BRE] + (size_t)idx * 16; const float* bim = a.in[I_BIM] + (size_t)idx * 16;
#pragma unroll
        for (int c = 0; c < 16; ++c) { const float Br = bre[c], Bi = bim[c];
            bbt[(g * 128 + p) * 16 + c] = (bf16)(pk2(qr * Br - qi * Bi, 0.f) & 0xffffu);
            bbt[(g * 128 + 64 + p) * 16 + c] = (bf16)(pk2(qr * Bi + qi * Br, 0.f) & 0xffffu);
            cm[(g * 16 + c) * 128 + p] = (bf16)(pk2(a.in[I_CRE][((size_t)(L * 16 + g) * 16 + c) * 64 + p], 0.f) & 0xffffu);
            cm[(g * 16 + c) * 128 + 64 + p] = (bf16)(pk2(-a.in[I_CIM][((size_t)(L * 16 + g) * 16 + c) * 64 + p], 0.f) & 0xffffu); }
    }
    for (int idx = bid * 512 + tid; idx < NLAYER * 4 * 64 * 64; idx += G * 512) {
        const int L = idx >> 14, r = idx & 16383, k = r >> 12, o = (r >> 6) & 63, c = r & 63;
        ((bf16*)(ws + WS_TAB + (size_t)L * TAB_STRIDE + TAB_PW))[r] = (bf16)(pk2(a.in[I_POOLW][((size_t)(L * 4 + k) * 64 + c) * 64 + o], 0.f) & 0xffffu);
    }
}
__device__ __forceinline__ void final_norm(const Args& a, int lane, int wave, int G, int bid) {
    const int gw = bid * NWAVES + wave, NGW = G * NWAVES;
    const float* ssq = (const float*)(a.ws + WS_SSQ);
    f32x4 gv[4];
#pragma unroll
    for (int j = 0; j < 4; ++j) gv[j] = ((const f32x4*)a.in[I_FING])[lane + 64 * j];
    for (int m = gw; m < M; m += NGW) {
        float s = lane < 16 ? ssq[((size_t)(lane >> 2) * M + m) * 4 + (lane & 3)] : 0.f; s = wave_sum(s);
        const float rs = __builtin_amdgcn_rsqf(s * (1.0f / 1024.0f) + 1e-6f);
        const GAS v2u* xb = (const GAS v2u*)((const bf16*)(a.ws + WS_ACT1) + (size_t)m * D) + lane;
        GAS f32x4* yr = (GAS f32x4*)(a.out + (size_t)m * D) + lane;
#pragma unroll
        for (int j = 0; j < 4; ++j) { const v2u q = xb[64 * j]; const f32x4 v = (f32x4){bflo(q.x), bfhi(q.x), bflo(q.y), bfhi(q.y)}; yr[64 * j] = v * rs * gv[j]; }
    }
}

typedef float f32x4_t __attribute__((ext_vector_type(4)));
__device__ __forceinline__ float fma_s(float a, float b, float c) { float r; asm("v_fma_f32 %0, %1, %2, %3" : "=v"(r) : "v"(a), "v"(b), "v"(c)); return r; }
template <bool SAMPLE>
__device__ __forceinline__ void mix_unit(const Args& a, int layer, int uidx, LAS unsigned char* lds, int tid_in, int lane_in, int wave_in, int stages) {
    int tid = tid_in; asm volatile("" : "+v"(tid));
    const int lane = tid & 63, wave = __builtin_amdgcn_readfirstlane(tid >> 6);
    constexpr int L = SAMPLE ? 8 : 64, NSEG = SAMPLE ? 2 : 1, R = NSEG * L;
    const bf16* PMb = (const bf16*)(a.ws + WS_PM); bf16* BR = (bf16*)a.out;
    const int s = uidx >> 5, c = uidx & 31, q0 = 2 * uidx;
    const int row0 = SAMPLE ? MP + q0 * 8 : s * SEQ + 64 * c;
    const bool last = SAMPLE || c == NCH - 1;
    LAS float* V = (LAS float*)lds;
    if (stages & 1) {
        constexpr int TR = NSEG * (30 + L);
        LAS float* WCF = (LAS float*)(lds + 96256);
        {
            constexpr int NIT = (TR * 32 + 511) / 512;
            v4u qa[NIT], qb[NIT]; int kind[NIT];
#pragma unroll
            for (int it = 0; it < NIT; ++it) {
                const int idx = tid + it * 512; kind[it] = 0; qa[it] = (v4u){0u, 0u, 0u, 0u}; qb[it] = (v4u){0u, 0u, 0u, 0u};
                if (idx < TR * 32) {
                    const int rr = idx >> 5, c8 = (idx & 31) * 8, seg = rr / (30 + L), e = rr % (30 + L);
                    int srow = -1;
                    if (SAMPLE) { if (e >= 30) srow = MP + (q0 + seg) * 8 + (e - 30); }
                    else { const int tabs = c * 64 + e - 30; if (tabs >= 0) srow = s * SEQ + tabs; }
                    if (srow >= 0) { kind[it] = 1; qa[it] = *(const v4u*)(PMb + (size_t)srow * PMC + 1280 + c8); qb[it] = *(const v4u*)(PMb + (size_t)srow * PMC + 1536 + c8); }
                    else if (SAMPLE) { kind[it] = 2; const float* st = a.in[I_STCF] + ((size_t)(layer * DB + q0 + seg) * 30 + e) * MIXW + c8; qa[it] = *(const v4u*)st; qb[it] = *(const v4u*)(st + 4); }
                }
            }
#pragma unroll
            for (int it = 0; it < NIT; ++it) {
                const int idx = tid + it * 512;
                if (idx < TR * 32) {
                    const int rr = idx >> 5, c8 = (idx & 31) * 8;
                    float v[8];
                    if (kind[it] == 1) { float av[8], bv[8]; unpack8(qa[it], av); unpack8(qb[it], bv);
#pragma unroll
                        for (int j = 0; j < 8; ++j) v[j] = av[j] * sigm(bv[j]); }
                    else { v[0] = __uint_as_float(qa[it].x); v[1] = __uint_as_float(qa[it].y); v[2] = __uint_as_float(qa[it].z); v[3] = __uint_as_float(qa[it].w);
                           v[4] = __uint_as_float(qb[it].x); v[5] = __uint_as_float(qb[it].y); v[6] = __uint_as_float(qb[it].z); v[7] = __uint_as_float(qb[it].w); }
                    *(LAS f32x4*)(V + rr * 256 + c8) = (f32x4){v[0], v[1], v[2], v[3]}; *(LAS f32x4*)(V + rr * 256 + c8 + 4) = (f32x4){v[4], v[5], v[6], v[7]};
                }
            }
        }
        { f32x4 wq[4];
#pragma unroll
            for (int it = 0; it < 4; ++it) { const int idx = tid + it * 512; wq[it] = idx < 31 * 64 ? *(const f32x4*)(a.in[I_CFW] + (size_t)layer * 31 * MIXW + idx * 4) : (f32x4){0.f, 0.f, 0.f, 0.f}; }
#pragma unroll
            for (int it = 0; it < 4; ++it) { const int idx = tid + it * 512; if (idx < 31 * 64) *(LAS f32x4*)(WCF + idx * 4) = wq[it]; } }
        __syncthreads();
        if (last) {
            for (int idx = tid; idx < NSEG * 30 * 64; idx += 512) { const int seg = idx / (30 * 64), r = idx % (30 * 64), j = r >> 6, c4 = (r & 63) * 4;
                float* dst = a.out + (SAMPLE ? O_CFS + ((size_t)(layer * DB + q0 + seg) * 30 + j) * MIXW : O_CFP + ((size_t)(layer * NB + s) * 30 + j) * MIXW) + c4;
                *(f32x4*)dst = *(LAS f32x4*)(V + (seg * (30 + L) + L + j) * 256 + c4); }
        }
        const f32x4 lg = *(const f32x4*)(a.in[I_CFLNG] + layer * MIXW + 4 * lane), lb = *(const f32x4*)(a.in[I_CFLNB] + layer * MIXW + 4 * lane);
        {
            constexpr int NT = R / NWAVES, TG = NT >= 4 ? 4 : NT;
#pragma unroll 1
            for (int g0 = 0; g0 < NT; g0 += TG) {
                f32x4 acc[TG]; int base[TG];
#pragma unroll
                for (int i = 0; i < TG; ++i) { const int tt = wave + NWAVES * (g0 + i), seg = tt / L, t = tt % L; base[i] = (seg * (30 + L) + t) * 256 + 4 * lane; acc[i] = (f32x4){0.f, 0.f, 0.f, 0.f}; }
#pragma unroll 4
                for (int j = 0; j < 31; ++j) { const f32x4 w = *(LAS f32x4*)(WCF + j * 256 + 4 * lane);
#pragma unroll
                    for (int i = 0; i < TG; ++i) acc[i] += w * *(LAS f32x4*)(V + base[i] + j * 256); }
                float s1[TG];
#pragma unroll
                for (int i = 0; i < TG; ++i) s1[i] = (acc[i][0] + acc[i][1]) + (acc[i][2] + acc[i][3]);
#pragma unroll
                for (int o = 1; o < 64; o <<= 1) {
#pragma unroll
                    for (int i = 0; i < TG; ++i) s1[i] += __shfl_xor(s1[i], o); }
                f32x4 d[TG]; float s2[TG];
#pragma unroll
                for (int i = 0; i < TG; ++i) { d[i] = acc[i] - s1[i] * (1.0f / 256.0f); s2[i] = (d[i][0] * d[i][0] + d[i][1] * d[i][1]) + (d[i][2] * d[i][2] + d[i][3] * d[i][3]); }
#pragma unroll
                for (int o = 1; o < 64; o <<= 1) {
#pragma unroll
                    for (int i = 0; i < TG; ++i) s2[i] += __shfl_xor(s2[i], o); }
#pragma unroll
                for (int i = 0; i < TG; ++i) { const int tt = wave + NWAVES * (g0 + i);
                    const float rstd = __builtin_amdgcn_rsqf(s2[i] * (1.0f / 256.0f) + 1e-5f);
                    const f32x4 yn = d[i] * rstd * lg + lb;
                    v2u w; w.x = pk2(yn[0] * sigm(yn[0]), yn[1] * sigm(yn[1])); w.y = pk2(yn[2] * sigm(yn[2]), yn[3] * sigm(yn[3]));
                    *(v2u*)(BR + (size_t)(row0 + tt) * D + 768 + 4 * lane) = w; }
            }
        }
        __syncthreads();
    }
    if (stages & 2) {
        constexpr int TR = NSEG * (15 + L);
        LAS bf16* Dt = (LAS bf16*)(lds + 81920);
        {
            constexpr int NIT = (TR * 32 + 511) / 512;
            v4u qa[NIT], qb[NIT]; int kind[NIT];
#pragma unroll
            for (int it = 0; it < NIT; ++it) {
                const int idx = tid + it * 512; kind[it] = 0; qa[it] = (v4u){0u, 0u, 0u, 0u}; qb[it] = (v4u){0u, 0u, 0u, 0u};
                if (idx < TR * 32) {
                    const int rr = idx >> 5, c8 = (idx & 31) * 8, seg = rr / (15 + L), e = rr % (15 + L);
                    int srow = -1;
                    if (SAMPLE) { if (e >= 15) srow = MP + (q0 + seg) * 8 + (e - 15); }
                    else { const int tabs = c * 64 + e - 15; if (tabs >= 0) srow = s * SEQ + tabs; }
                    if (srow >= 0) { kind[it] = 1; qa[it] = *(const v4u*)(PMb + (size_t)srow * PMC + c8); }
                    else if (SAMPLE) { kind[it] = 2; const float* st = a.in[I_STPOOL] + ((size_t)(layer * DB + q0 + seg) * 15 + e) * MIXW + c8; qa[it] = *(const v4u*)st; qb[it] = *(const v4u*)(st + 4); }
                }
            }
#pragma unroll
            for (int it = 0; it < NIT; ++it) {
                const int idx = tid + it * 512;
                if (idx < TR * 32) {
                    const int rr = idx >> 5, c8 = (idx & 31) * 8;
                    float v[8];
                    if (kind[it] == 1) unpack8(qa[it], v);
                    else { v[0] = __uint_as_float(qa[it].x); v[1] = __uint_as_float(qa[it].y); v[2] = __uint_as_float(qa[it].z); v[3] = __uint_as_float(qa[it].w);
                           v[4] = __uint_as_float(qb[it].x); v[5] = __uint_as_float(qb[it].y); v[6] = __uint_as_float(qb[it].z); v[7] = __uint_as_float(qb[it].w); }
                    *(LAS f32x4*)(V + rr * 256 + c8) = (f32x4){v[0], v[1], v[2], v[3]}; *(LAS f32x4*)(V + rr * 256 + c8 + 4) = (f32x4){v[4], v[5], v[6], v[7]};
                }
            }
        }
        __syncthreads();
        if (last) {
            for (int idx = tid; idx < NSEG * 15 * 64; idx += 512) { const int seg = idx / (15 * 64), r = idx % (15 * 64), j = r >> 6, c4 = (r & 63) * 4;
                float* dst = a.out + (SAMPLE ? O_POOLS + ((size_t)(layer * DB + q0 + seg) * 15 + j) * MIXW : O_POOLP + ((size_t)(layer * NB + s) * 15 + j) * MIXW) + c4;
                *(f32x4*)dst = *(LAS f32x4*)(V + (seg * (15 + L) + L + j) * 256 + c4); }
        }
        for (int idx = tid; idx < R * 32; idx += 512) {
            const int tt = idx >> 5, c8 = (idx & 31) * 8, seg = tt / L, t = tt % L, base = seg * (15 + L) + t + 15, win = 2 << (c8 >> 6);
            float sm[8];
#pragma unroll
            for (int j = 0; j < 8; ++j) sm[j] = 0.f;
            for (int w = 0; w < win; ++w) { const f32x4 x0 = *(LAS f32x4*)(V + (base - w) * 256 + c8), x1 = *(LAS f32x4*)(V + (base - w) * 256 + c8 + 4);
                sm[0] += x0[0]; sm[1] += x0[1]; sm[2] += x0[2]; sm[3] += x0[3]; sm[4] += x1[0]; sm[5] += x1[1]; sm[6] += x1[2]; sm[7] += x1[3]; }
            const int cnt = SAMPLE ? win : min(c * 64 + t + 1, win);
            const float inv = 1.0f / (float)cnt;
            const f32x4 c0 = *(LAS f32x4*)(V + base * 256 + c8), c1 = *(LAS f32x4*)(V + base * 256 + c8 + 4);
            float dd[8];
#pragma unroll
            for (int j = 0; j < 4; ++j) { dd[j] = sm[j] * inv - c0[j]; dd[4 + j] = sm[4 + j] * inv - c1[j]; }
            *(LAS v4u*)(Dt + tt * 264 + c8) = pack8(dd);
        }
        __syncthreads();
        {
            const bf16* PW = (const bf16*)(a.ws + WS_TAB + (size_t)layer * TAB_STRIDE + TAB_PW);
            const int k = wave >> 1, fr = lane & 15, fq = lane >> 4;
            constexpr int NMT = R / 16;
            for (int mt = (NMT >= 4 ? (wave & 1) * 2 : (wave & 1)); mt < (NMT >= 4 ? (wave & 1) * 2 + 2 : ((wave & 1) == 0 ? NMT : 0)); ++mt) {
                const bf16x8 b0 = *(LAS bf16x8*)(Dt + (16 * mt + fr) * 264 + 64 * k + 8 * fq), b1 = *(LAS bf16x8*)(Dt + (16 * mt + fr) * 264 + 64 * k + 32 + 8 * fq);
#pragma unroll
                for (int ot = 0; ot < 4; ++ot) {
                    f32x4 acc = (f32x4){0.f, 0.f, 0.f, 0.f};
                    const bf16x8 a0 = *(const bf16x8*)(PW + ((size_t)(k * 64 + 16 * ot + fr)) * 64 + 8 * fq), a1 = *(const bf16x8*)(PW + ((size_t)(k * 64 + 16 * ot + fr)) * 64 + 32 + 8 * fq);
                    acc = __builtin_amdgcn_mfma_f32_16x16x32_bf16(a0, b0, acc, 0, 0, 0);
                    acc = __builtin_amdgcn_mfma_f32_16x16x32_bf16(a1, b1, acc, 0, 0, 0);
                    const int o = 64 * k + 16 * ot + 4 * fq, tt = 16 * mt + fr;
                    const f32x4 sc = *(const f32x4*)(a.in[I_POOLSC] + layer * MIXW + o);
                    v2u w; w.x = pk2(acc[0] * sc[0], acc[1] * sc[1]); w.y = pk2(acc[2] * sc[2], acc[3] * sc[3]);
                    *(v2u*)(BR + (size_t)(row0 + tt) * D + o) = w;
                }
            }
        }
        __syncthreads();
    }
    if (stages & 4) {
        const float* scw = a.in[I_SCW] + (size_t)layer * 3 * MIXW;
#pragma unroll
        for (int it_ = 0; it_ < R * 32 / 512; ++it_) { const int idx = tid + it_ * 512;
            const int tt = idx >> 5, c8 = (idx & 31) * 8, seg = tt / L, t = tt % L;
            float z[3][8];
#pragma unroll
            for (int dj = 0; dj < 3; ++dj) { const int tp = t - 2 + dj;
                int srow = -1;
                if (SAMPLE) { if (tp >= 0) srow = MP + (q0 + seg) * 8 + tp; } else { const int tabs = c * 64 + tp; if (tabs >= 0) srow = s * SEQ + tabs; }
                if (srow >= 0) { float cg[8], hx[8]; unpack8(*(const v4u*)(PMb + (size_t)srow * PMC + 768 + c8), cg); unpack8(*(const v4u*)(PMb + (size_t)srow * PMC + 1024 + c8), hx);
#pragma unroll
                    for (int j = 0; j < 8; ++j) z[dj][j] = cg[j] * hx[j]; }
                else if (SAMPLE) { const float* st = a.in[I_STSC] + ((size_t)(layer * DB + q0 + seg) * 2 + (2 + tp)) * MIXW + c8; const f32x4 x0 = *(const f32x4*)st, x1 = *(const f32x4*)(st + 4);
                    z[dj][0] = x0[0]; z[dj][1] = x0[1]; z[dj][2] = x0[2]; z[dj][3] = x0[3]; z[dj][4] = x1[0]; z[dj][5] = x1[1]; z[dj][6] = x1[2]; z[dj][7] = x1[3]; }
                else {
#pragma unroll
                    for (int j = 0; j < 8; ++j) z[dj][j] = 0.f; } }
            float bg[8], o[8]; unpack8(*(const v4u*)(PMb + (size_t)(row0 + tt) * PMC + 512 + c8), bg);
#pragma unroll
            for (int j = 0; j < 8; ++j) o[j] = bg[j] * (scw[c8 + j] * z[0][j] + scw[MIXW + c8 + j] * z[1][j] + scw[2 * MIXW + c8 + j] * z[2][j]);
            *(v4u*)(BR + (size_t)(row0 + tt) * D + 512 + c8) = pack8(o);
            if (last && t >= L - 2) { float* dst = a.out + (SAMPLE ? O_SCS + ((size_t)(layer * DB + q0 + seg) * 2 + (t - (L - 2))) * MIXW : O_SCP + ((size_t)(layer * NB + s) * 2 + (t - (L - 2))) * MIXW) + c8;
                *(f32x4*)dst = (f32x4){z[2][0], z[2][1], z[2][2], z[2][3]}; *(f32x4*)(dst + 4) = (f32x4){z[2][4], z[2][5], z[2][6], z[2][7]}; }
        }
    }
}

template <int MODE>
__device__ __forceinline__ void ssm_unit(const Args& a, int layer, int uidx, LAS unsigned char* lds, int tid_in, int lane_in, int wave_in) {
    int tid = tid_in; asm volatile("" : "+v"(tid));
    const int lane = tid & 63, wave = __builtin_amdgcn_readfirstlane(tid >> 6);
    const bf16* PMb = (const bf16*)(a.ws + WS_PM); bf16* BR = (bf16*)a.out;
    const unsigned char* tab = a.ws + WS_TAB + (size_t)layer * TAB_STRIDE;
    const f32x2* LB = (const f32x2*)(tab + TAB_LB); const f32x2* LP = (const f32x2*)(tab + TAB_LP);
    const bf16* BBT = (const bf16*)(tab + TAB_BBT); const bf16* CM = (const bf16*)(tab + TAB_CM);
    f32x2* E = (f32x2*)(a.ws + WS_E);
    const int s = uidx >> 5, c = uidx & 31;
    const int row0 = MODE == 2 ? MP + 64 * uidx : s * SEQ + 64 * c;
    const int fr = lane & 15, fq = lane >> 4;
    LAS float* BU = (LAS float*)(lds + wave * 8448);
    LAS bf16* Zt = (LAS bf16*)(lds + 67584);
    const bf16x8 zf = (bf16x8){0, 0, 0, 0, 0, 0, 0, 0};
    for (int gi = 0; gi < 2; ++gi) {
        const int g = 2 * wave + gi;
        const f32x2 lam = LB[g * 64 + lane]; const float nlam1 = -lam[1];
        float hr = 0.f, hi = 0.f;
        bf16x8 bb[8];
#pragma unroll
        for (int nt = 0; nt < 8; ++nt) bb[nt] = fq < 2 ? *(const bf16x8*)(BBT + ((size_t)(g * 128 + 16 * nt + fr)) * 16 + 8 * fq) : zf;
        bf16x8 cmf[4]; float dsk = 0.f;
        if (MODE >= 1) {
#pragma unroll
            for (int ks = 0; ks < 4; ++ks) cmf[ks] = *(const bf16x8*)(CM + ((size_t)(g * 16 + fr)) * 128 + 32 * ks + 8 * fq);
            dsk = a.in[I_DSKIP][layer * MIXW + 16 * g + fr]; }
        bf16x8 ufa[4];
#pragma unroll
        for (int sub = 0; sub < 4; ++sub) ufa[sub] = fq < 2 ? *(const bf16x8*)(PMb + (size_t)(row0 + 16 * sub + fr) * PMC + 256 + 16 * g + 8 * fq) : zf;
        bf16 uva[4][4];
        if (MODE >= 1) {
#pragma unroll
            for (int sub = 0; sub < 4; ++sub)
#pragma unroll
                for (int r = 0; r < 4; ++r) uva[sub][r] = PMb[(size_t)(row0 + 16 * sub + 4 * fq + r) * PMC + 256 + 16 * g + fr]; }
        if (MODE == 1) { const f32x2 lp = LP[g * 64 + lane];
            const float nlp1 = -lp[1];
#pragma unroll 1
            for (int j = 0; j < c; j += 16) { f32x2 e16[16]; const int nq = c - j;
#pragma unroll
                for (int q = 0; q < 16; ++q) if (q < nq) e16[q] = E[((size_t)(s * NCH + j + q) * 16 + g) * 64 + lane];
#pragma unroll
                for (int q = 0; q < 16; ++q) if (q < nq) { const float nr = fma_s(lp[0], hr, fma_s(nlp1, hi, e16[q][0])), ni = fma_s(lp[0], hi, fma_s(lp[1], hr, e16[q][1])); hr = nr; hi = ni; } } }
#pragma unroll
        for (int sub = 0; sub < 4; ++sub) {
            const int rowb = row0 + 16 * sub;
            const bf16x8 uf = ufa[sub];
#pragma unroll
            for (int nt = 0; nt < 8; ++nt) { const f32x4 d = __builtin_amdgcn_mfma_f32_16x16x32_bf16(uf, bb[nt], (f32x4){0.f, 0.f, 0.f, 0.f}, 0, 0, 0);
#pragma unroll
                for (int r = 0; r < 4; ++r) BU[(4 * fq + r) * 132 + 16 * nt + fr] = d[r]; }
            asm volatile("s_waitcnt lgkmcnt(0)" ::: "memory");
            {
                float bre_[16], bim_[16];
#pragma unroll
                for (int t = 0; t < 16; ++t) { bre_[t] = BU[t * 132 + lane]; bim_[t] = BU[t * 132 + 64 + lane]; }
                float sre_[2] = {0.f, 0.f}, sim_[2] = {0.f, 0.f};
                if (MODE == 2) {
#pragma unroll
                    for (int hq = 0; hq < 2; ++hq) { const int q = 8 * uidx + 2 * sub + hq; const size_t si = ((size_t)(layer * DB + q) * 16 + g) * 64 + lane; sre_[hq] = a.in[I_STRE][si]; sim_[hq] = a.in[I_STIM][si]; } }
                asm volatile("s_waitcnt lgkmcnt(0)" ::: "memory");
#pragma unroll
                for (int t = 0; t < 16; ++t) {
                    if (MODE == 2 && (t & 7) == 0) { hr = sre_[t >> 3]; hi = sim_[t >> 3]; }
                    const float nr = fma_s(lam[0], hr, fma_s(nlam1, hi, bre_[t])), ni = fma_s(lam[0], hi, fma_s(lam[1], hr, bim_[t])); hr = nr; hi = ni;
                    bre_[t] = hr; bim_[t] = hi;
                    if (MODE == 2 && (t & 7) == 7) { const int q = 8 * uidx + 2 * sub + (t >> 3); const size_t si = ((size_t)(layer * DB + q) * 16 + g) * 64 + lane; a.out[O_SRES + si] = hr; a.out[O_SIMS + si] = hi; }
                }
#pragma unroll
                for (int t = 0; t < 16; ++t) { BU[t * 132 + lane] = bre_[t]; BU[t * 132 + 64 + lane] = bim_[t]; }
            }
            if (MODE >= 1) {
                asm volatile("s_waitcnt lgkmcnt(0)" ::: "memory");
                f32x4 y = (f32x4){0.f, 0.f, 0.f, 0.f};
#pragma unroll
                for (int ks = 0; ks < 4; ++ks) { const f32x4 h0 = *(LAS f32x4*)(BU + fr * 132 + 32 * ks + 8 * fq), h1 = *(LAS f32x4*)(BU + fr * 132 + 32 * ks + 8 * fq + 4);
                    v4u hw; hw.x = pk2(h0[0], h0[1]); hw.y = pk2(h0[2], h0[3]); hw.z = pk2(h1[0], h1[1]); hw.w = pk2(h1[2], h1[3]);
                    y = __builtin_amdgcn_mfma_f32_16x16x32_bf16(__builtin_bit_cast(bf16x8, hw), cmf[ks], y, 0, 0, 0); }
#pragma unroll
                for (int r = 0; r < 4; ++r) { const int t = 4 * fq + r; const float uv = bf1(uva[sub][r]);
                    const float z = gelu_tanh(y[r] + dsk * uv);
                    Zt[(16 * sub + t) * 264 + 16 * g + fr] = (bf16)(pk2(z, 0.f) & 0xffffu); }
                asm volatile("s_waitcnt lgkmcnt(0)" ::: "memory");
            }
            if (MODE == 0) { asm volatile("s_waitcnt lgkmcnt(0)" ::: "memory"); }
        }
        if (MODE == 0) E[((size_t)(s * NCH + c) * 16 + g) * 64 + lane] = (f32x2){hr, hi};
        if (MODE == 1 && c == NCH - 1) { const size_t si = ((size_t)(layer * NB + s) * 16 + g) * 64 + lane; a.out[O_SREP + si] = hr; a.out[O_SIMP + si] = hi; }
    }
    if (MODE == 0) __syncthreads();
    if (MODE >= 1) {
        __syncthreads();
        const bf16* WG = (const bf16*)(a.ws + WS_WGLU) + (size_t)layer * MIXW * MIXW;
        f32x4 acc[4][2];
#pragma unroll
        for (int mt = 0; mt < 4; ++mt) { acc[mt][0] = (f32x4){0.f, 0.f, 0.f, 0.f}; acc[mt][1] = (f32x4){0.f, 0.f, 0.f, 0.f}; }
#pragma unroll
        for (int ks = 0; ks < 8; ++ks) {
            const bf16x8 w0 = *(const bf16x8*)(WG + (size_t)(32 * wave + fr) * MIXW + 32 * ks + 8 * fq), w1 = *(const bf16x8*)(WG + (size_t)(32 * wave + 16 + fr) * MIXW + 32 * ks + 8 * fq);
#pragma unroll
            for (int mt = 0; mt < 4; ++mt) { const bf16x8 zb = *(LAS bf16x8*)(Zt + (16 * mt + fr) * 264 + 32 * ks + 8 * fq);
                acc[mt][0] = __builtin_amdgcn_mfma_f32_16x16x32_bf16(w0, zb, acc[mt][0], 0, 0, 0);
                acc[mt][1] = __builtin_amdgcn_mfma_f32_16x16x32_bf16(w1, zb, acc[mt][1], 0, 0, 0); }
        }
#pragma unroll
        for (int nl = 0; nl < 2; ++nl) { const int n0 = 32 * wave + 16 * nl + 4 * fq; const f32x4 bgl = *(const f32x4*)(a.in[I_BGLU] + layer * MIXW + n0);
#pragma unroll
            for (int mt = 0; mt < 4; ++mt) { const int tt = 16 * mt + fr; const v2u zz = *(LAS v2u*)(Zt + tt * 264 + n0);
                const float z0 = bflo(zz.x), z1 = bfhi(zz.x), z2 = bflo(zz.y), z3 = bfhi(zz.y);
                v2u w; w.x = pk2(z0 * sigm(acc[mt][nl][0] + bgl[0]), z1 * sigm(acc[mt][nl][1] + bgl[1])); w.y = pk2(z2 * sigm(acc[mt][nl][2] + bgl[2]), z3 * sigm(acc[mt][nl][3] + bgl[3]));
                *(v2u*)(BR + (size_t)(row0 + tt) * D + 256 + n0) = w; } }
        __syncthreads();
    }
}

__device__ __forceinline__ void gemm2_phase(LAS unsigned char* lds, const bf16* BRp, const bf16* WBT, const unsigned char* GT, bf16* MG, int G, int bid, int tidp) {
    using namespace pg8;
    int tid_ = tidp; asm volatile("" : "+v"(tid_));
    const int tid = tid_, wid = __builtin_amdgcn_readfirstlane(tid >> 6), lane = tid & 63, wr = wid >> 2, wc = wid & 3, fr = lane & 15, fq = lane >> 4;
    unsigned voffA0, voffB0;
    { int R, C; stage_rc(tid * 16, R, C); const int Rb = (R & ~31) + perm32(R & 31); voffA0 = (unsigned)(R * D + C) * 2u; voffB0 = (unsigned)(Rb * MIXW + C) * 2u; }
    const unsigned ldsw = (unsigned)wid * 1024u;
    const int aoff = lds_byte(wr * 64 + fr, fq * 8), boff = lds_byte(wc * 32 + fr, fq * 8);
    const unsigned gvoff = (unsigned)(fr * GTC + 8 * fq);
    constexpr int STG = 49152;
#define G2_STAGE(it_, so_) do { const int kb_ = (it_) >> 2, kt_ = (it_) & 3; \
        const char* as_ = Abase + (size_t)(kb_ * 256 + kt_ * 64) * 2; const char* bs_ = Bbase + (size_t)kb_ * (D * MIXW * 2) + (size_t)kt_ * 128; \
        _Pragma("unroll") for (int _i = 0; _i < 2; ++_i) __builtin_amdgcn_global_load_lds((const unsigned*)(as_ + (size_t)_i * (64 * D * 2) + voffA0), (PG8_LAS unsigned*)(lds + (so_) + ldsw + _i * 8192), 16, 0, 0); \
        _Pragma("unroll") for (int _i = 0; _i < 2; ++_i) __builtin_amdgcn_global_load_lds((const unsigned*)(bs_ + (size_t)_i * (64 * MIXW * 2) + voffB0), (PG8_LAS unsigned*)(lds + (so_) + 16384 + ldsw + _i * 8192), 16, 0, 0); \
        _Pragma("unroll") for (int _i = 0; _i < 2; ++_i) __builtin_amdgcn_global_load_lds((const unsigned*)(bs_ + (size_t)(128 + 64 * _i) * MIXW * 2 + voffB0), (PG8_LAS unsigned*)(lds + (so_) + 32768 + ldsw + _i * 8192), 16, 0, 0); } while (0)
    const int vb = (G % 8 == 0) ? (bid % 8) * (G / 8) + bid / 8 : bid;
    constexpr int NUN = (MP / 128) * 4;
    for (int ui = vb; ui < NUN; ui += G) {
        const int pm = ui >> 2, pn = ui & 3;
        const char* Abase = (const char*)BRp + (size_t)pm * 128 * D * 2;
        const char* Bbase = (const char*)WBT + (size_t)pn * 256 * MIXW * 2;
        G2_STAGE(0, 0); G2_STAGE(1, STG);
        f32x4 mg[2][4][2], acc[2][4][2];
#pragma unroll
        for (int b = 0; b < 2; ++b)
#pragma unroll
            for (int m = 0; m < 4; ++m)
#pragma unroll
                for (int n = 0; n < 2; ++n) { mg[b][m][n] = (f32x4){0.f, 0.f, 0.f, 0.f}; acc[b][m][n] = (f32x4){0.f, 0.f, 0.f, 0.f}; }
        v2u gq[2][4];
        int so = 0, so2 = 2 * STG;
#pragma unroll 1
        for (int kb = 0; kb < 4; ++kb) {
#pragma unroll
            for (int kt = 0; kt < 4; ++kt) {
                if (kt < 2) asm volatile("s_waitcnt vmcnt(6)" ::: "memory");
                else if (kt == 3 && kb == 3) asm volatile("s_waitcnt vmcnt(8)" ::: "memory");
                else asm volatile("s_waitcnt vmcnt(14)" ::: "memory");
                __builtin_amdgcn_s_barrier(); asm volatile("" ::: "memory");
                if (kt < 2 || kb < 3) G2_STAGE(4 * kb + kt + 2, so2);
#pragma unroll
                for (int kk = 0; kk < 2; ++kk) {
                    bf16x8 At[4], B0[2], B1[2];
#pragma unroll
                    for (int m = 0; m < 4; ++m) At[m] = *(const PG8_LAS bf16x8*)(lds + so + aoff + m * 2048 + kk * 1024);
#pragma unroll
                    for (int n = 0; n < 2; ++n) { B0[n] = *(const PG8_LAS bf16x8*)(lds + so + 16384 + boff + n * 2048 + kk * 1024); B1[n] = *(const PG8_LAS bf16x8*)(lds + so + 32768 + boff + n * 2048 + kk * 1024); }
                    asm volatile("s_waitcnt lgkmcnt(0)" ::: "memory"); __builtin_amdgcn_sched_barrier(0);
#pragma unroll
                    for (int m = 0; m < 4; ++m)
#pragma unroll
                        for (int n = 0; n < 2; ++n) { acc[0][m][n] = __builtin_amdgcn_mfma_f32_16x16x32_bf16(B0[n], At[m], acc[0][m][n], 0, 0, 0);
                                                      acc[1][m][n] = __builtin_amdgcn_mfma_f32_16x16x32_bf16(B1[n], At[m], acc[1][m][n], 0, 0, 0); }
                }
                if (kt == 1) {
#pragma unroll
                    for (int m = 0; m < 4; ++m) { const unsigned char* gs = GT + (size_t)(pm * 128 + wr * 64 + m * 16) * GTC + kb * D + pn * 256 + wc * 32;
                        asm volatile("global_load_dwordx2 %0, %1, %2" : "=v"(gq[0][m]) : "v"(gvoff), "s"(gs) : "memory");
                        asm volatile("global_load_dwordx2 %0, %1, %2 offset:128" : "=v"(gq[1][m]) : "v"(gvoff), "s"(gs) : "memory"); }
                }
                so = so == 2 * STG ? 0 : so + STG; so2 = so2 == 2 * STG ? 0 : so2 + STG;
            }
            if (kb == 3) asm volatile("s_waitcnt vmcnt(0)" ::: "memory"); else asm volatile("s_waitcnt vmcnt(12)" ::: "memory");
            asm volatile("" : "+v"(gq[0][0]), "+v"(gq[0][1]), "+v"(gq[0][2]), "+v"(gq[0][3]), "+v"(gq[1][0]), "+v"(gq[1][1]), "+v"(gq[1][2]), "+v"(gq[1][3]));
#pragma unroll
            for (int b = 0; b < 2; ++b)
#pragma unroll
                for (int m = 0; m < 4; ++m) { const v2u q_ = gq[b][m];
#pragma unroll
                    for (int j = 0; j < 4; ++j) { mg[b][m][0][j] += (float)((q_.x >> (8 * j)) & 0xffu) * acc[b][m][0][j]; mg[b][m][1][j] += (float)((q_.y >> (8 * j)) & 0xffu) * acc[b][m][1][j]; }
                    acc[b][m][0] = (f32x4){0.f, 0.f, 0.f, 0.f}; acc[b][m][1] = (f32x4){0.f, 0.f, 0.f, 0.f}; }
        }
        asm volatile("" ::: "memory"); __builtin_amdgcn_s_barrier(); asm volatile("" ::: "memory");
#pragma unroll
        for (int b = 0; b < 2; ++b)
#pragma unroll
            for (int m = 0; m < 4; ++m) { const int row = pm * 128 + wr * 64 + m * 16 + fr, col = pn * 256 + b * 128 + wc * 32 + 8 * fq;
                const f32x4 m0 = mg[b][m][0] * (1.0f / 255.0f), m1 = mg[b][m][1] * (1.0f / 255.0f);
                v4u w; w.x = pk2(m0[0], m0[1]); w.y = pk2(m0[2], m0[3]); w.z = pk2(m1[0], m1[1]); w.w = pk2(m1[2], m1[3]);
                *(v4u*)(MG + (size_t)row * D + col) = w; }
    }
#undef G2_STAGE
}


#define TL_GLDS(src_, dst_) __builtin_amdgcn_global_load_lds((const unsigned*)(src_), (PG8_LAS unsigned*)(dst_), 16, 0, 0)
#define TL_STAGE(kt_, A_PTR, B_PTR) do { const int s_ = (kt_) & 3; const char* ap_ = A_PTR(kt_); const char* bp_ = B_PTR(kt_); \
        TL_GLDS(ap_ + voffA, lds + s_ * 32768 + ldsw); TL_GLDS(ap_ + voffA + 128, lds + s_ * 32768 + 8192 + ldsw); \
        TL_GLDS(bp_ + voffB, lds + s_ * 32768 + 16384 + ldsw); TL_GLDS(bp_ + voffB + 128, lds + s_ * 32768 + 24576 + ldsw); } while (0)
#define TL_LOOP(NK, A_PTR, B_PTR, AFTER_STEP) do { \
        TL_STAGE(0, A_PTR, B_PTR); if ((NK) > 1) TL_STAGE(1, A_PTR, B_PTR); if ((NK) > 2) TL_STAGE(2, A_PTR, B_PTR); \
        _Pragma("unroll 1") for (int kt = 0; kt < (NK); ++kt) { \
            if (kt + 2 < (NK)) asm volatile("s_waitcnt vmcnt(8)" ::: "memory"); else if (kt + 1 < (NK)) asm volatile("s_waitcnt vmcnt(4)" ::: "memory"); else asm volatile("s_waitcnt vmcnt(0)" ::: "memory"); \
            __builtin_amdgcn_s_barrier(); asm volatile("" ::: "memory"); \
            if (kt + 3 < (NK)) TL_STAGE(kt + 3, A_PTR, B_PTR); \
            const int sb_ = (kt & 3) * 32768; \
            _Pragma("unroll") for (int h_ = 0; h_ < 2; ++h_) { \
                const bf16x8 a0 = *(const PG8_LAS bf16x8*)(lds + sb_ + h_ * 8192 + aoff), a1 = *(const PG8_LAS bf16x8*)(lds + sb_ + h_ * 8192 + aoff + 1024); \
                const bf16x8 b00 = *(const PG8_LAS bf16x8*)(lds + sb_ + 16384 + h_ * 8192 + boff), b01 = *(const PG8_LAS bf16x8*)(lds + sb_ + 16384 + h_ * 8192 + boff + 1024); \
                const bf16x8 b10 = *(const PG8_LAS bf16x8*)(lds + sb_ + 16384 + h_ * 8192 + boff + 2048), b11 = *(const PG8_LAS bf16x8*)(lds + sb_ + 16384 + h_ * 8192 + boff + 3072); \
                asm volatile("s_waitcnt lgkmcnt(0)" ::: "memory"); __builtin_amdgcn_sched_barrier(0); \
                acc[0] = __builtin_amdgcn_mfma_f32_16x16x32_bf16(b00, a0, acc[0], 0, 0, 0); acc[1] = __builtin_amdgcn_mfma_f32_16x16x32_bf16(b10, a0, acc[1], 0, 0, 0); \
                acc[0] = __builtin_amdgcn_mfma_f32_16x16x32_bf16(b01, a1, acc[0], 0, 0, 0); acc[1] = __builtin_amdgcn_mfma_f32_16x16x32_bf16(b11, a1, acc[1], 0, 0, 0); } \
            AFTER_STEP(kt); } \
        asm volatile("s_waitcnt lgkmcnt(0)" ::: "memory"); __builtin_amdgcn_s_barrier(); asm volatile("" ::: "memory"); } while (0)
#define TL_SETUP(LDA, LDB) using namespace pg8; int tid_ = tidp; asm volatile("" : "+v"(tid_)); \
    const int tid = tid_, wid = __builtin_amdgcn_readfirstlane(tid >> 6), lane = tid & 63, fr = lane & 15, fq = lane >> 4, mt = wid >> 1, nh = wid & 1; \
    int R_, C_; stage_rc(tid * 16, R_, C_); \
    const unsigned voffA = (unsigned)(R_ * (LDA) + C_) * 2u, voffB = (unsigned)(R_ * (LDB) + C_) * 2u, ldsw = (unsigned)wid * 1024u; \
    const int aoff = lds_byte(mt * 16 + fr, fq * 8), boff = lds_byte(nh * 32 + fr, fq * 8); (void)lane
#define TL_NOP(kt_) do {} while (0)

struct CappedOrder : pg8::StaticOrder {
    int cap;
    __device__ bool next(int i, pg8::Unit& u) const { if ((long)i * G + c >= cap) return false; return pg8::StaticOrder::next(i, u); }
};
__device__ __forceinline__ void proj_tail_phase(LAS unsigned char* lds, const bf16* A, const bf16* Bt, int cap, const float* ssq, const float* bgate, bf16* PMp, unsigned char* GTp, int G, int bid, int tidp, unsigned* qctr) {
    TL_SETUP(D, D);
    StaticOrder S1; S1.init(M, INC, 1, 0);
    const int nsub = (S1.nwg - cap) * 16;
    volatile LAS int* qslot = (volatile LAS int*)(lds + MISC_OFF + 192);
    for (int t = bid; t < nsub; ) {
        Unit u; S1.next(cap + (t >> 4), u);
        const int rb = (t >> 2) & 3, cb = t & 3, r0 = u.pm * 256 + 64 * rb, c0 = u.pn * 256 + 64 * cb;
        const char* Ab = (const char*)A + (size_t)r0 * D * 2; const char* Bb = (const char*)Bt + (size_t)c0 * D * 2;
        f32x4 acc[2] = {(f32x4){0.f, 0.f, 0.f, 0.f}, (f32x4){0.f, 0.f, 0.f, 0.f}};
        const int row = r0 + 16 * mt + fr;
        const float rs = pg8::row_rstd(ssq, row);
        const bool isg = u.pn >= 7;
        f32x4 bvv[2];
#pragma unroll
        for (int n = 0; n < 2; ++n) bvv[n] = isg ? *(const f32x4*)(bgate + (c0 + 32 * nh + 16 * n + 4 * fq - PMC)) : (f32x4){0.f, 0.f, 0.f, 0.f};
#define PT_A(kt_) (Ab + (size_t)(kt_) * 256)
#define PT_B(kt_) (Bb + (size_t)(kt_) * 256)
        TL_LOOP(D / 128, PT_A, PT_B, TL_NOP);
#undef PT_A
#undef PT_B
        unsigned got = 0u;
        if (tid == 0) got = __hip_atomic_fetch_add(qctr, 1u, __ATOMIC_RELAXED, __HIP_MEMORY_SCOPE_AGENT);
#pragma unroll
        for (int n = 0; n < 2; ++n) { const int col = c0 + 32 * nh + 16 * n + 4 * fq; f32x4 v = acc[n] * rs;
            if (isg) { const f32x4 tt = (v + bvv[n]) * -1.4426950408889634f;
                *(unsigned*)(GTp + (size_t)row * GTC + (col - PMC)) = pg8::pack_u8x4(pg8::sig255(tt[0]), pg8::sig255(tt[1]), pg8::sig255(tt[2]), pg8::sig255(tt[3])); }
            else { v2u w; w.x = pk2(v[0], v[1]); w.y = pk2(v[2], v[3]); *(v2u*)(PMp + (size_t)row * PMC + col) = w; } }
        if (tid == 0) *qslot = G + (int)got;
        __syncthreads();
        t = *qslot;
        __syncthreads();
    }
}

__device__ __forceinline__ void gemm2_tail_phase(LAS unsigned char* lds, const bf16* BRp, const bf16* WBT, const unsigned char* GT, bf16* MG, int G, int bid, int tidp) {
    TL_SETUP(D, MIXW);
    for (int ui = bid; ui < 256; ui += G) {
        const int rb = ((ui & 7) >> 1) * 4 + (ui >> 6), cb = (ui & 1) * 8 + ((ui >> 3) & 7);
        const char* Ab = (const char*)BRp + (size_t)(MP + 64 * rb) * D * 2; const char* Bb = (const char*)WBT + (size_t)(64 * cb) * MIXW * 2;
        f32x4 acc[2] = {(f32x4){0.f, 0.f, 0.f, 0.f}, (f32x4){0.f, 0.f, 0.f, 0.f}}, mg[2] = {(f32x4){0.f, 0.f, 0.f, 0.f}, (f32x4){0.f, 0.f, 0.f, 0.f}};
        const int row = MP + 64 * rb + 16 * mt + fr;
#define G2T_A(kt_) (Ab + (size_t)(((kt_) >> 1) * 256 + ((kt_) & 1) * 128) * 2)
#define G2T_B(kt_) (Bb + (size_t)((kt_) >> 1) * (D * MIXW * 2) + (size_t)((kt_) & 1) * 256)
        unsigned gwp[4][2];
#pragma unroll
        for (int kb = 0; kb < 4; ++kb)
#pragma unroll
            for (int n = 0; n < 2; ++n) gwp[kb][n] = *(const unsigned*)(GT + (size_t)row * GTC + kb * D + 64 * cb + 32 * nh + 16 * n + 4 * fq);
#define G2T_AFTER(kt_) do { if ((kt_) & 1) { const int kb_ = (kt_) >> 1; \
            _Pragma("unroll") for (int n = 0; n < 2; ++n) { const unsigned gw = kb_ == 0 ? gwp[0][n] : (kb_ == 1 ? gwp[1][n] : (kb_ == 2 ? gwp[2][n] : gwp[3][n])); \
                mg[n][0] += (float)(gw & 0xffu) * acc[n][0]; mg[n][1] += (float)((gw >> 8) & 0xffu) * acc[n][1]; mg[n][2] += (float)((gw >> 16) & 0xffu) * acc[n][2]; mg[n][3] += (float)(gw >> 24) * acc[n][3]; \
                acc[n] = (f32x4){0.f, 0.f, 0.f, 0.f}; } } } while (0)
        TL_LOOP(8, G2T_A, G2T_B, G2T_AFTER);
#undef G2T_A
#undef G2T_B
#undef G2T_AFTER
#pragma unroll
        for (int n = 0; n < 2; ++n) { const f32x4 mm = mg[n] * (1.0f / 255.0f); v2u w; w.x = pk2(mm[0], mm[1]); w.y = pk2(mm[2], mm[3]); *(v2u*)(MG + (size_t)row * D + 64 * cb + 32 * nh + 16 * n + 4 * fq) = w; }
    }
}

__device__ __forceinline__ void resid_tail_phase(LAS unsigned char* lds, const bf16* A, const bf16* Bt, int K, bf16* XBp, float* ssq, int G, int bid, int tidp) {
    TL_SETUP(K, K);
    const int nk = K / 128;
    for (int ui = bid; ui < 256; ui += G) {
        const int rb = ((ui & 7) >> 1) * 4 + (ui >> 6), cb = (ui & 1) * 8 + ((ui >> 3) & 7);
        const char* Ab = (const char*)A + (size_t)(MP + 64 * rb) * K * 2; const char* Bb = (const char*)Bt + (size_t)(64 * cb) * K * 2;
        f32x4 acc[2] = {(f32x4){0.f, 0.f, 0.f, 0.f}, (f32x4){0.f, 0.f, 0.f, 0.f}};
        const int rowl = 16 * mt + fr, row = MP + 64 * rb + rowl; float ss = 0.f;
        f32x4 xold[2];
#pragma unroll
        for (int n = 0; n < 2; ++n) { const int col = 64 * cb + 32 * nh + 16 * n + 4 * fq;
            const v2u q = *(const v2u*)(XBp + (size_t)row * D + col); xold[n] = (f32x4){bflo(q.x), bfhi(q.x), bflo(q.y), bfhi(q.y)}; }
#define RT_A(kt_) (Ab + (size_t)(kt_) * 256)
#define RT_B(kt_) (Bb + (size_t)(kt_) * 256)
        TL_LOOP(nk, RT_A, RT_B, TL_NOP);
#undef RT_A
#undef RT_B
#pragma unroll
        for (int n = 0; n < 2; ++n) { const int col = 64 * cb + 32 * nh + 16 * n + 4 * fq;
            const f32x4 o = xold[n] + acc[n];
            v2u w; w.x = pk2(o[0], o[1]); w.y = pk2(o[2], o[3]); *(v2u*)(XBp + (size_t)row * D + col) = w;
            ss += (o[0] * o[0] + o[1] * o[1]) + (o[2] * o[2] + o[3] * o[3]); }
        ss += __shfl_xor(ss, 16); ss += __shfl_xor(ss, 32);
        LAS float* red = (LAS float*)lds;
        if (fq == 0) red[rowl * 2 + nh] = ss;
        __syncthreads();
        if (tid < 64) ssq[((size_t)(cb >> 2) * M + MP + 64 * rb + tid) * 4 + (cb & 3)] = red[tid * 2] + red[tid * 2 + 1];
        __syncthreads();
    }
}

__global__ void __launch_bounds__(NWAVES * 64, 2) hybrid_fwd(Args args) {
    extern __shared__ __attribute__((aligned(16))) unsigned char lds_raw[];
    LAS unsigned char* lds = (LAS unsigned char*)lds_raw;
    volatile LAS unsigned* MISC = (volatile LAS unsigned*)(lds + MISC_OFF);
    const int tid0 = threadIdx.x, wave0 = __builtin_amdgcn_readfirstlane(tid0 >> 6);
    const int G0 = gridDim.x, bid = blockIdx.x;
    unsigned char* ws = args.ws;
    for (int u = tid0; u < (LDS_BYTES - LDSCTL_OFF) / 4; u += NWAVES * 64) ((LAS unsigned*)(lds + LDSCTL_OFF))[u] = 0u;
    __syncthreads();
    const int lo = args.ph_lo, hi = args.ph_hi;
    XcdBarrier bar; bar.bar = (unsigned*)(ws + WS_CTL) + CW_BAR; bar.x = 0; bar.st = nullptr;
    if (hi - lo > 1) bar = xcd_barrier_post((unsigned*)(ws + WS_CTL) + CW_BAR, MISC + 8);
    bf16* XB = (bf16*)(ws + WS_ACT1); bf16* PMb = (bf16*)(ws + WS_PM); unsigned char* GTb = ws + WS_GT;
    bf16* MGb = (bf16*)(ws + WS_PM); bf16* ACTb = (bf16*)(ws + WS_GT);
    float* ssq = (float*)(ws + WS_SSQ);
    for (int ph_i = lo; ph_i < hi; ++ph_i) {
        int ph = ph_i, G = G0; asm volatile("" : "+s"(ph), "+s"(G));
        unsigned z_ = 0u; asm volatile("" : "+v"(z_));
        int tid = wave0 * 64 + (int)__builtin_amdgcn_mbcnt_hi(~0u, __builtin_amdgcn_mbcnt_lo(~0u, z_)); asm volatile("" : "+v"(tid)); const int lane = tid & 63, wave = __builtin_amdgcn_readfirstlane(tid >> 6);
        const int layer = (ph - 1) / 7, k = ph == 0 ? -1 : (ph == NPHASE - 1 ? 7 : (ph - 1) % 7);
        if (k == -1) p0_prologue(args, lds, tid, lane, wave, G, bid);
        else if (k == 7) final_norm(args, lane, wave, G, bid);
        else if (k == 0) {
            pg8::Gemm g{XB, (const bf16*)(ws + WS_WIN) + (size_t)layer * INC * D, M, INC, D}; CappedOrder S; S.init(M, INC, G, bid); S.cap = (S.nwg / G) * G;
            pg8::EpiProj E{PMb, GTb, ssq, args.in[I_BGATE] + (size_t)layer * GTC, (const LAS float*)(lds + RING_OFF + pg8::RSTD_LDS_OFF)};
            pg8::gemm_phase<pg8::EpiProj, CappedOrder, true, true>(lds + RING_OFF, g, S, E, tid);
            proj_tail_phase(lds + RING_OFF, XB, (const bf16*)(ws + WS_WIN) + (size_t)layer * INC * D, S.cap, ssq, args.in[I_BGATE] + (size_t)layer * GTC, PMb, GTb, G, bid, tid, (unsigned*)(ws + WS_CTL) + CW_Q + 64 * layer);
        } else if (k == 1) {
            for (int s_ = 0; ; ++s_) { int u; bool donor = false;
                if (G == 256) { if (s_ > 2) break;
                    donor = bid < 16 || (bid >= 80 && bid < 152);
                    if (s_ == 0) u = 272 + ((bid + 240) & 255);
                    else if (bid < 16) { if (s_ == 2) break; u = 256 + bid; }
                    else if (bid < 80) { if (s_ == 2) break; u = 528 + (bid - 16); }
                    else if (s_ == 1 || bid < 152) { const int v = (s_ == 1 ? 0 : 176) + (bid - 80); u = (v / 31) * 32 + v % 31; }
                    else if (bid < 240) { const int t_ = bid - 152, db = t_ < 16 ? t_ : 80 + (t_ - 16); u = 592 + ((db + 240) & 255); }
                    else break; }
                else { u = bid + s_ * G; if (u >= 256 + 16 + 256 + 64) break; }
                if (u < 256) { if ((u & 31) != NCH - 1) ssm_unit<0>(args, layer, u, lds, tid, lane, wave); }
                else if (u < 272) ssm_unit<2>(args, layer, u - 256, lds, tid, lane, wave);
                else if (u < 528 || u >= 592) mix_unit<false>(args, layer, u < 528 ? u - 272 : u - 592, lds, tid, lane, wave, u >= 592 ? 4 : (donor ? 3 : 7));
                else mix_unit<true>(args, layer, u - 528, lds, tid, lane, wave, 7);
            }
        } else if (k == 2) {
            for (int u = bid; u < 256; u += G) ssm_unit<1>(args, layer, u, lds, tid, lane, wave);
        } else if (k == 3) {
            gemm2_phase(lds + RING_OFF, (const bf16*)args.out, (const bf16*)(ws + WS_WBR) + (size_t)layer * 4 * D * MIXW, GTb, MGb, G, bid, tid);
            gemm2_tail_phase(lds + RING_OFF, (const bf16*)args.out, (const bf16*)(ws + WS_WBR) + (size_t)layer * 4 * D * MIXW, GTb, MGb, G, bid, tid);
        } else if (k == 5) {
            pg8::Gemm g{XB, (const bf16*)(ws + WS_WFI) + (size_t)layer * 2 * FF * D, M, 2 * FF, D}; pg8::StaticOrder S; S.init(M, 2 * FF, G, bid);
            pg8::EpiSwiGLU E{ACTb, ssq, (const LAS float*)(lds + RING_OFF + pg8::RSTD_LDS_OFF)};
            pg8::gemm_phase<pg8::EpiSwiGLU, pg8::StaticOrder, true, true>(lds + RING_OFF, g, S, E, tid);
            if (!MK_PER_PHASE && G == 256 && bid >= P0_F_BID0 && layer + 1 < NLAYER) p0_idle_items(args, lds, lane, wave, bid, layer + 1, p0_items_A(G), P0_F_BID0, P0_F_PER);
        } else {
            const bool isE = k == 4; const int K = isE ? D : FF;
            const bf16* Ap = isE ? MGb : ACTb; const bf16* Bp = isE ? (const bf16*)(ws + WS_WOUT) + (size_t)layer * D * D : (const bf16*)(ws + WS_WFO) + (size_t)layer * D * FF;
            { pg8::Gemm g{Ap, Bp, MP, D, K}; pg8::StaticOrder S; S.init(MP, D, G, bid);
              pg8::EpiResid E{XB, ssq};
              pg8::gemm_phase<pg8::EpiResid, pg8::StaticOrder, true, true>(lds + RING_OFF, g, S, E, tid); }
            resid_tail_phase(lds + RING_OFF, Ap, Bp, K, XB, ssq, G, bid, tid);
        }
        if (ph_i + 1 < hi) {
            asm volatile("s_waitcnt vmcnt(0)" ::: "memory"); __syncthreads();
            if (tid == 0) xcd_barrier_leader(bar);
            else if (!MK_PER_PHASE && wave != 0 && k >= 0 && k < P0_SLICES && layer + 1 < NLAYER) p0_slice(args, lds, lane, wave, G, bid, layer + 1, k);
            __syncthreads();
        }
    }
}

extern "C" void kernel_launch(void* const* d_in, const int* in_sizes, int n_in, void* d_out, int out_size, void* d_ws, size_t ws_size, hipStream_t stream) {
    static int grid = 0;
    if (grid == 0) {
        if (n_in != 32 || out_size != (int)O_END || ws_size < WS_END) { fprintf(stderr, "kernel_launch: expected 32 inputs, %zu outputs, >= %zu bytes of workspace; got %d, %d, %zu; nothing launched\n", (size_t)O_END, (size_t)WS_END, n_in, out_size, ws_size); grid = -1; return; }
        int dev = 0, cus = 0, per_cu = 0;
        if (hipGetDevice(&dev) != hipSuccess || hipDeviceGetAttribute(&cus, hipDeviceAttributeMultiprocessorCount, dev) != hipSuccess) { grid = -1; return; }
        if (hipFuncSetAttribute((const void*)hybrid_fwd, hipFuncAttributeMaxDynamicSharedMemorySize, LDS_BYTES) != hipSuccess) { fprintf(stderr, "kernel_launch: hipFuncSetAttribute failed\n"); grid = -1; return; }
        if (hipOccupancyMaxActiveBlocksPerMultiprocessor(&per_cu, (const void*)hybrid_fwd, NWAVES * 64, LDS_BYTES) != hipSuccess || per_cu < 1) { fprintf(stderr, "kernel_launch: occupancy query says %d blocks per CU; nothing launched\n", per_cu); (void)hipGetLastError(); grid = -1; return; }
        grid = cus;
    }
    if (grid < 0) return;
    (void)hipMemsetAsync((char*)d_ws + WS_CTL, 0, CTL_ZERO_BYTES, stream);
    Args a{};
    for (int i = 0; i < 32; ++i) a.in[i] = (const float*)d_in[i];
    a.out = (float*)d_out; a.ws = (unsigned char*)d_ws;
#if MK_PER_PHASE
    for (int k = 0; k < NPHASE; ++k) { a.ph_lo = k; a.ph_hi = k + 1; hipLaunchKernelGGL(hybrid_fwd, dim3(grid), dim3(NWAVES * 64), LDS_BYTES, stream, a); }
#else
    a.ph_lo = 0; a.ph_hi = NPHASE;
    hipLaunchKernelGGL(hybrid_fwd, dim3(grid), dim3(NWAVES * 64), LDS_BYTES, stream, a);
#endif
}
```

```cpp
#include <hip/hip_runtime.h>
#include <cstdio>
#include <cstdint>
#ifndef XPF_LEAD
#define XPF_LEAD 2
#endif
namespace pg8 {
#define PG8_LAS __attribute__((address_space(3)))
typedef unsigned short bf16_t;
typedef short bf16x8 __attribute__((ext_vector_type(8)));
typedef float f32x4 __attribute__((ext_vector_type(4)));
typedef unsigned u32x4 __attribute__((ext_vector_type(4)));
constexpr int BM = 256, BK = 64, HALF = 128, HTB = HALF * BK * 2  , STAGE_BYTES = 8 * HTB, NXCD = 8, WGM = 8, RSTD_LDS_OFF = 147456 + 320 + 1024  , RSTD_RAW_OFF = RSTD_LDS_OFF + 1024  , BIAS_LDS_OFF = RSTD_RAW_OFF + 8192  ;

__host__ __device__ __forceinline__ int lds_byte(int r, int c) { const int st = (r >> 4) * 2 + (c >> 5), rr = r & 15, cc = c & 31, ob = rr * 64 + cc * 2; return st * 1024 + (ob ^ (((ob >> 9) & 1) << 5)); }
__host__ __device__ __forceinline__ void stage_rc(int b, int& R, int& C) { const int st = b / 1024, sb = b % 1024, swz = sb ^ (((sb >> 9) & 1) << 5); R = (st >> 1) * 16 + swz / 64; C = (st & 1) * 32 + (swz % 64) / 2; }
__host__ __device__ __forceinline__ int perm32(int rho) { const int n = rho >> 4, i = rho & 15; return 8 * (i >> 2) + 4 * n + (i & 3); }

struct Unit { int pm, pn; };
struct Gemm { const bf16_t* A; const bf16_t* Bt; int M, N, K; };

struct StaticOrder {
    int nM, nN, nwg, G, c;
    __host__ __device__ void init(int M, int N, int G_, int c_) { nM = M / BM; nN = N / BM; nwg = nM * nN; G = G_; c = c_; }
    __host__ __device__ bool next(int i, Unit& u) const {
        const long L = (long)i * G + c; if (L >= nwg) return false;
        int wgid = (int)L; { const int q = nwg / NXCD, r = nwg % NXCD, xcd = wgid % NXCD, off = wgid / NXCD; wgid = (xcd < r ? xcd * (q + 1) : r * (q + 1) + (xcd - r) * q) + off; }
        const int nig = WGM * nN, gid = wgid / nig, fm = gid * WGM, gsz = (nM - fm) < WGM ? (nM - fm) : WGM;
        u.pm = fm + ((wgid % nig) % gsz); u.pn = (wgid % nig) / gsz; return true;
    }
    __device__ __forceinline__ void a_ready(const Unit&) const {}
    __device__ __forceinline__ void done(const Unit&) const {}
};
typedef float f32x2 __attribute__((ext_vector_type(2)));
typedef __bf16 bf16x2_t __attribute__((ext_vector_type(2)));
__device__ __forceinline__ unsigned cvt_pk_bf16(float lo, float hi) { f32x2 v = {lo, hi}; bf16x2_t b = __builtin_convertvector(v, bf16x2_t); return __builtin_bit_cast(unsigned, b); }
__device__ __forceinline__ float sigm(float x) { return __builtin_amdgcn_rcpf(1.0f + __builtin_amdgcn_exp2f(-1.4426950408889634f * x)); }
__device__ __forceinline__ float row_rstd(const float* ssq, int row) {
    const f32x4 a = *(const f32x4*)(ssq + ((size_t)0 * 17408 + row) * 4), b = *(const f32x4*)(ssq + ((size_t)1 * 17408 + row) * 4),
                c = *(const f32x4*)(ssq + ((size_t)2 * 17408 + row) * 4), d = *(const f32x4*)(ssq + ((size_t)3 * 17408 + row) * 4);
    const float s = (((a[0] + a[1]) + (a[2] + a[3])) + ((b[0] + b[1]) + (b[2] + b[3]))) + (((c[0] + c[1]) + (c[2] + c[3])) + ((d[0] + d[1]) + (d[2] + d[3])));
    return __builtin_amdgcn_rsqf(s * (1.0f / 1024.0f) + 1e-6f);
}
__device__ __forceinline__ void rows_rstd(const float* ssq, int row0, int fq, float (&rs)[2][4]) {
#pragma unroll
    for (int ai = 0; ai < 2; ++ai)
#pragma unroll
        for (int m = 0; m < 4; ++m) { const f32x4 p = *(const f32x4*)(ssq + ((size_t)fq * 17408 + row0 + ai * HALF + m * 16) * 4); rs[ai][m] = (p[0] + p[1]) + (p[2] + p[3]); }
#pragma unroll
    for (int ai = 0; ai < 2; ++ai)
#pragma unroll
        for (int m = 0; m < 4; ++m) { float s = rs[ai][m]; s += __shfl_xor(s, 16); s += __shfl_xor(s, 32); rs[ai][m] = __builtin_amdgcn_rsqf(s * (1.0f / 1024.0f) + 1e-6f); }
}
__device__ __forceinline__ void rows_rstd_lds(const PG8_LAS float* rl, int r0, float (&rs)[2][4]) {
#pragma unroll
    for (int ai = 0; ai < 2; ++ai)
#pragma unroll
        for (int m = 0; m < 4; ++m) rs[ai][m] = rl[r0 + ai * HALF + m * 16];
}
struct EpiNull {
    static constexpr bool PERM = true, AFTER_DRAIN = false, RSTD_LDS = false, XPREFETCH = false;
    __device__ __forceinline__ void operator()(const f32x4 (&acc)[2][2][4][2], const Unit& u, int wr, int wc, int fr, int fq) const {
#pragma unroll
        for (int ai = 0; ai < 2; ++ai)
#pragma unroll
            for (int bj = 0; bj < 2; ++bj)
#pragma unroll
                for (int m = 0; m < 4; ++m) { asm volatile("" :: "v"(acc[ai][bj][m][0]), "v"(acc[ai][bj][m][1])); }
    }
};
__device__ __forceinline__ unsigned pack_u8x4(float a, float b, float c, float d) {
    unsigned w = 0u; w = __builtin_amdgcn_cvt_pk_u8_f32(a, 0u, w); w = __builtin_amdgcn_cvt_pk_u8_f32(b, 1u, w); w = __builtin_amdgcn_cvt_pk_u8_f32(c, 2u, w); w = __builtin_amdgcn_cvt_pk_u8_f32(d, 3u, w); return w; }
__device__ __forceinline__ float sig255(float t) { return __builtin_amdgcn_rcpf(__builtin_fmaf(__builtin_amdgcn_exp2f(t), 1.0f / 255.0f, 1.0f / 255.0f)); }
struct EpiProj {
    static constexpr bool PERM = true, AFTER_DRAIN = false, RSTD_LDS = true, XPREFETCH = false;
    bf16_t* PM; unsigned char* GT; const float* ssq; const float* bgate; const PG8_LAS float* rl;
    __device__ __forceinline__ void operator()(const f32x4 (&acc)[2][2][4][2], const Unit& u, int wr, int wc, int fr, int fq) const {
        const int row0 = u.pm * BM + wr * 64 + fr;
        float rsv[2][4]; rows_rstd_lds(rl, wr * 64 + fr, rsv);
        if (u.pn >= 7) {
            constexpr float NL2E = -1.4426950408889634f;
            const int lc0 = (u.pn - 7) * BM + wc * 32 + 8 * fq;
            f32x4 bv[2][2];
#pragma unroll
            for (int bj = 0; bj < 2; ++bj)
#pragma unroll
                for (int n = 0; n < 2; ++n) bv[bj][n] = *(const f32x4*)(bgate + lc0 + bj * HALF + 4 * n) * NL2E;
#pragma unroll
            for (int ai = 0; ai < 2; ++ai)
#pragma unroll
                for (int m = 0; m < 4; ++m) { const int row = row0 + ai * HALF + m * 16;
                    const float rs = rsv[ai][m] * NL2E;
                    unsigned char* rowp = GT + (size_t)row * 4096 + lc0;
#pragma unroll
                    for (int bj = 0; bj < 2; ++bj) { const f32x4 v0 = acc[ai][bj][m][0] * rs + bv[bj][0], v1 = acc[ai][bj][m][1] * rs + bv[bj][1];
                        typedef unsigned u32x2_t __attribute__((ext_vector_type(2)));
                        u32x2_t w; w.x = pack_u8x4(sig255(v0[0]), sig255(v0[1]), sig255(v0[2]), sig255(v0[3])); w.y = pack_u8x4(sig255(v1[0]), sig255(v1[1]), sig255(v1[2]), sig255(v1[3]));
                        *(u32x2_t*)(rowp + bj * HALF) = w; } }
        } else {
            const int lc0 = u.pn * BM + wc * 32 + 8 * fq;
#pragma unroll
            for (int ai = 0; ai < 2; ++ai)
#pragma unroll
                for (int m = 0; m < 4; ++m) { const int row = row0 + ai * HALF + m * 16;
                    const float rs = rsv[ai][m];
                    bf16_t* rowp = PM + (size_t)row * 1792 + lc0;
#pragma unroll
                    for (int bj = 0; bj < 2; ++bj) { const f32x4 v0 = acc[ai][bj][m][0] * rs, v1 = acc[ai][bj][m][1] * rs;
                        u32x4 w; w.x = cvt_pk_bf16(v0[0], v0[1]); w.y = cvt_pk_bf16(v0[2], v0[3]); w.z = cvt_pk_bf16(v1[0], v1[1]); w.w = cvt_pk_bf16(v1[2], v1[3]);
                        *(u32x4*)(rowp + bj * HALF) = w; } }
        }
    }
};
struct EpiResid {
    static constexpr bool PERM = true, AFTER_DRAIN = false, RSTD_LDS = false, XPREFETCH = true;
    bf16_t* XB; float* ssq;
    __device__ __forceinline__ void prefetch(const Unit& u, PG8_LAS unsigned char* dump, int tid) const {
        const unsigned vo = (unsigned)(tid >> 2) * 2048u + (unsigned)(tid & 3) * 128u;
        const char* base = (const char*)(XB + (size_t)u.pm * BM * 1024 + u.pn * BM);
        __builtin_amdgcn_global_load_lds((const unsigned*)(base + vo), (PG8_LAS unsigned*)dump, 4, 0, 0);
        __builtin_amdgcn_global_load_lds((const unsigned*)(base + (size_t)128 * 2048 + vo), (PG8_LAS unsigned*)dump, 4, 0, 0);
    }
    __device__ __forceinline__ void operator()(const f32x4 (&acc)[2][2][4][2], const Unit& u, int wr, int wc, int fr, int fq) const {
        const int row0 = u.pm * BM + wr * 64 + fr, col0 = u.pn * BM + wc * 32 + 8 * fq;
#pragma unroll
        for (int ai = 0; ai < 2; ++ai)
#pragma unroll
            for (int m = 0; m < 4; ++m) { const int row = row0 + ai * HALF + m * 16;
                bf16_t* dstb = XB + (size_t)row * 1024 + col0; float ss = 0.f;
                f32x4 x0[2], x1[2];
                {
#pragma unroll
                    for (int bj = 0; bj < 2; ++bj) { const u32x4 q = *(const u32x4*)(dstb + bj * HALF);
                        x0[bj] = (f32x4){__builtin_bit_cast(float, q.x << 16), __builtin_bit_cast(float, q.x & 0xffff0000u), __builtin_bit_cast(float, q.y << 16), __builtin_bit_cast(float, q.y & 0xffff0000u)};
                        x1[bj] = (f32x4){__builtin_bit_cast(float, q.z << 16), __builtin_bit_cast(float, q.z & 0xffff0000u), __builtin_bit_cast(float, q.w << 16), __builtin_bit_cast(float, q.w & 0xffff0000u)}; } }
#pragma unroll
                for (int bj = 0; bj < 2; ++bj) { const f32x4 o0 = x0[bj] + acc[ai][bj][m][0], o1 = x1[bj] + acc[ai][bj][m][1];
                    u32x4 w; w.x = cvt_pk_bf16(o0[0], o0[1]); w.y = cvt_pk_bf16(o0[2], o0[3]); w.z = cvt_pk_bf16(o1[0], o1[1]); w.w = cvt_pk_bf16(o1[2], o1[3]);
                    *(u32x4*)(dstb + bj * HALF) = w;
                    ss += ((o0[0] * o0[0] + o0[1] * o0[1]) + (o0[2] * o0[2] + o0[3] * o0[3])) + ((o1[0] * o1[0] + o1[1] * o1[1]) + (o1[2] * o1[2] + o1[3] * o1[3])); }
                ss += __shfl_xor(ss, 16); ss += __shfl_xor(ss, 32);
                if (fq == 0) ssq[((size_t)u.pn * 17408 + row) * 4 + wc] = ss; }
    }
};
struct EpiSwiGLU {
    static constexpr bool PERM = true, AFTER_DRAIN = false, RSTD_LDS = true, XPREFETCH = false;
    bf16_t* ACT; const float* ssq; const PG8_LAS float* rl;
    __device__ __forceinline__ void operator()(const f32x4 (&acc)[2][2][4][2], const Unit& u, int wr, int wc, int fr, int fq) const {
        const int row0 = u.pm * BM + wr * 64 + fr, col0 = u.pn * HALF + wc * 32 + 8 * fq;
        float rsv[2][4]; rows_rstd_lds(rl, wr * 64 + fr, rsv);
#pragma unroll
        for (int ai = 0; ai < 2; ++ai)
#pragma unroll
            for (int m = 0; m < 4; ++m) { const int row = row0 + ai * HALF + m * 16;
                const float rs = rsv[ai][m], rsn = rs * -1.4426950408889634f, rs2 = rs * rs;
                float o[8];
#pragma unroll
                for (int j = 0; j < 4; ++j) { const float a0 = acc[ai][0][m][0][j], a1 = acc[ai][0][m][1][j];
                    o[j] = (a0 * acc[ai][1][m][0][j]) * (__builtin_amdgcn_rcpf(1.0f + __builtin_amdgcn_exp2f(a0 * rsn)) * rs2); o[4 + j] = (a1 * acc[ai][1][m][1][j]) * (__builtin_amdgcn_rcpf(1.0f + __builtin_amdgcn_exp2f(a1 * rsn)) * rs2); }
                u32x4 w; w.x = cvt_pk_bf16(o[0], o[1]); w.y = cvt_pk_bf16(o[2], o[3]); w.z = cvt_pk_bf16(o[4], o[5]); w.w = cvt_pk_bf16(o[6], o[7]);
                *(u32x4*)(ACT + (size_t)row * 2816 + col0) = w; }
    }
};

template <class Epi, class Sched, bool ALIGN_EPI = false, bool SP2 = false>
__device__ __forceinline__ void gemm_phase(PG8_LAS unsigned char* lds, const Gemm g, const Sched& S, const Epi& E, int tidp) {
    int tid_ = tidp; asm volatile("" : "+v"(tid_));
    const int tid = tid_, wid = __builtin_amdgcn_readfirstlane(tid >> 6), lane = tid & 63, wr = wid >> 2, wc = wid & 3, fr = lane & 15, fq = lane >> 4;
    const int K = g.K, nt = K / BK;
    unsigned voffA[2], voffB[2];
#pragma unroll
    for (int i = 0; i < 2; ++i) { int R, C; stage_rc(tid * 16 + i * 8192, R, C); const int Rb = Epi::PERM ? ((R & ~31) + perm32(R & 31)) : R;
        voffA[i] = (unsigned)(R * K + C) * 2u; voffB[i] = (unsigned)(Rb * K + C) * 2u; }
    const size_t kstep = (size_t)(BK * 2);
    const size_t hstep = (size_t)HALF * K * 2;
    const size_t tstep = 2 * hstep;
    const unsigned ldsw = (unsigned)wid * 1024u;
    const int aoff = lds_byte(wr * 64 + fr, fq * 8), boff = lds_byte(wc * 32 + fr, fq * 8);
#define PG8_SA(b, h) (((b) * 2 + (h)) * HTB)
#define PG8_SB(b, h) ((4 + (b) * 2 + (h)) * HTB)
#define PG8_STAGE(bufoff, gbase, voff) do { _Pragma("unroll") for (int _i = 0; _i < 2; ++_i) \
        __builtin_amdgcn_global_load_lds((const unsigned*)((const char*)(gbase) + (voff)[_i]), (PG8_LAS unsigned*)(lds + (bufoff) + ldsw + _i * 8192), 16, 0, 0); } while (0)
#define PG8_LDA(dst, b, h) do { _Pragma("unroll") for (int m = 0; m < 4; ++m) _Pragma("unroll") for (int k = 0; k < 2; ++k) dst[m][k] = *(const PG8_LAS bf16x8*)(lds + PG8_SA(b, h) + aoff + m * 2048 + k * 1024); } while (0)
#define PG8_LDB(dst, b, h) do { _Pragma("unroll") for (int n = 0; n < 2; ++n) _Pragma("unroll") for (int k = 0; k < 2; ++k) dst[n][k] = *(const PG8_LAS bf16x8*)(lds + PG8_SB(b, h) + boff + n * 2048 + k * 1024); } while (0)
#define PG8_MMA(ai, bj, At, Bt) do { __builtin_amdgcn_s_setprio(1); _Pragma("unroll") for (int m = 0; m < 4; ++m) _Pragma("unroll") for (int n = 0; n < 2; ++n) _Pragma("unroll") for (int k = 0; k < 2; ++k) \
        acc[ai][bj][m][n] = __builtin_amdgcn_mfma_f32_16x16x32_bf16(Bt[n][k], At[m][k], acc[ai][bj][m][n], 0, 0, 0); __builtin_amdgcn_s_setprio(0); } while (0)
#define PG8_WAIT_V(n) asm volatile("s_waitcnt vmcnt(" #n ")" ::: "memory")
#define PG8_WAIT_L(n) asm volatile("s_waitcnt lgkmcnt(" #n ")" ::: "memory")
#define PG8_BAR __builtin_amdgcn_s_barrier()
#define PG8_SCHED __builtin_amdgcn_sched_barrier(0)
    Unit cur, nxt; int ui = 0;
    if (!S.next(0, cur)) return;
    f32x4 acc[2][2][4][2];
#pragma unroll
    for (int a = 0; a < 2; ++a)
#pragma unroll
        for (int b = 0; b < 2; ++b)
#pragma unroll
            for (int m = 0; m < 4; ++m)
#pragma unroll
                for (int n = 0; n < 2; ++n) acc[a][b][m][n] = (f32x4){0.f, 0.f, 0.f, 0.f};
    bf16x8 At[4][2], B0[2][2], B1[2][2];
    const char* cA = (const char*)g.A + (size_t)cur.pm * tstep; const char* cB = (const char*)g.Bt + (size_t)cur.pn * tstep;
    S.a_ready(cur);
    if constexpr (SP2) {
        PG8_STAGE(PG8_SB(0, 0), cB, voffB); PG8_STAGE(PG8_SB(0, 1), cB + hstep, voffB); PG8_STAGE(PG8_SA(0, 0), cA, voffA); PG8_STAGE(PG8_SA(0, 1), cA + hstep, voffA);
        if (wr == 1) PG8_BAR;
        PG8_WAIT_V(2); PG8_BAR;
        PG8_STAGE(PG8_SB(1, 0), cB + kstep, voffB); PG8_STAGE(PG8_SA(1, 0), cA + kstep, voffA); PG8_STAGE(PG8_SB(1, 1), cB + hstep + kstep, voffB);
        PG8_WAIT_V(6); PG8_BAR;
    } else {
        PG8_STAGE(PG8_SB(0, 0), cB, voffB); PG8_STAGE(PG8_SA(0, 0), cA, voffA); PG8_STAGE(PG8_SB(0, 1), cB + hstep, voffB); PG8_STAGE(PG8_SA(0, 1), cA + hstep, voffA);
        if (wr == 1) PG8_BAR;
        PG8_WAIT_V(4); PG8_BAR;
        PG8_STAGE(PG8_SB(1, 0), cB + kstep, voffB); PG8_STAGE(PG8_SA(1, 0), cA + kstep, voffA); PG8_STAGE(PG8_SB(1, 1), cB + hstep + kstep, voffB);
        PG8_WAIT_V(6); PG8_BAR;
    }
    for (;;) {
        const bool has_next = S.next(ui + 1, nxt);
        const char* nA = has_next ? (const char*)g.A + (size_t)nxt.pm * tstep : cA; const char* nB = has_next ? (const char*)g.Bt + (size_t)nxt.pn * tstep : cB;
#ifdef DBG_KLOOP_T
        if (ui == DBG_KLOOP_UNIT + 1 && blockIdx.x == DBG_T_BLK && tid == 0 && ((volatile PG8_LAS unsigned*)(lds + 147456 + 320 + 200))[0] == 1u) { ((volatile PG8_LAS unsigned long long*)(lds + 147456 + 320 + 256))[8] = __builtin_amdgcn_s_memtime(); }
        if (ui == DBG_KLOOP_UNIT && blockIdx.x == DBG_T_BLK && tid == 0 && ((volatile PG8_LAS unsigned*)(lds + 147456 + 320 + 200))[0] == 1u) { ((volatile PG8_LAS unsigned long long*)(lds + 147456 + 320 + 256))[4] = __builtin_amdgcn_s_memtime(); ((volatile PG8_LAS unsigned long long*)(lds + 147456 + 320 + 256))[5] = __builtin_amdgcn_s_memrealtime(); }
#endif
        for (int t = 0; t < nt; t += 2) {
            const bool last = (t == nt - 2);
            if constexpr (Epi::RSTD_LDS) {
                if (t == 2 || t == 4) { PG8_WAIT_V(8);
                    const f32x4 v = *(const PG8_LAS f32x4*)(lds + RSTD_RAW_OFF + ldsw + lane * 16);
                    float s = (v[0] + v[1]) + (v[2] + v[3]); s += __shfl_xor(s, 1); s += __shfl_xor(s, 2);
                    if (!(tid & 3)) *(PG8_LAS float*)(lds + RSTD_LDS_OFF + ((t - 2) * 64 + (tid >> 2)) * 4) = __builtin_amdgcn_rsqf(s * (1.0f / 1024.0f) + 1e-6f);
                    PG8_WAIT_L(0); }
                if (t == 0 || t == 2) __builtin_amdgcn_global_load_lds((const unsigned*)(E.ssq + ((size_t)(tid & 3) * 17408 + (size_t)cur.pm * BM + t * 64 + (tid >> 2)) * 4), (PG8_LAS unsigned*)(lds + RSTD_RAW_OFF + ldsw), 16, 0, 0);
            }
            if constexpr (Epi::XPREFETCH) { if (t == nt - XPF_LEAD) E.prefetch(cur, lds + RSTD_RAW_OFF + ldsw, tid); }
            const char* a1 = cA + (size_t)(t + 1) * kstep;
            const char* a2 = last ? nA : cA + (size_t)(t + 2) * kstep; const char* b2 = last ? nB : cB + (size_t)(t + 2) * kstep;
            const char* a3 = a2 + kstep; const char* b3 = b2 + kstep;
            if (last && has_next) S.a_ready(nxt);
            if constexpr (SP2) {
            PG8_LDB(B0, 0, 0); PG8_LDB(B1, 0, 1); PG8_SCHED; PG8_LDA(At, 0, 0); PG8_STAGE(PG8_SA(1, 1), a1 + hstep, voffA);
            PG8_WAIT_V(8); PG8_WAIT_L(0); PG8_BAR; PG8_MMA(0, 0, At, B0); PG8_MMA(0, 1, At, B1); PG8_BAR; PG8_SCHED;
            PG8_LDA(At, 0, 1); PG8_STAGE(PG8_SB(0, 0), b2, voffB); PG8_STAGE(PG8_SB(0, 1), b2 + hstep, voffB); PG8_STAGE(PG8_SA(0, 0), a2, voffA);
            PG8_WAIT_V(8); PG8_WAIT_L(0); PG8_BAR; PG8_MMA(1, 0, At, B0); PG8_MMA(1, 1, At, B1); PG8_BAR; PG8_SCHED;
            PG8_LDB(B0, 1, 0); PG8_LDB(B1, 1, 1); PG8_SCHED; PG8_LDA(At, 1, 0); PG8_STAGE(PG8_SA(0, 1), a2 + hstep, voffA);
            PG8_WAIT_V(8); PG8_WAIT_L(0); PG8_BAR; PG8_MMA(0, 0, At, B0); PG8_MMA(0, 1, At, B1); PG8_BAR; PG8_SCHED;
            PG8_LDA(At, 1, 1); PG8_STAGE(PG8_SB(1, 0), b3, voffB); PG8_STAGE(PG8_SB(1, 1), b3 + hstep, voffB); PG8_STAGE(PG8_SA(1, 0), a3, voffA);
            PG8_WAIT_V(8); PG8_WAIT_L(0); PG8_BAR; PG8_MMA(1, 0, At, B0); PG8_MMA(1, 1, At, B1); PG8_BAR; PG8_SCHED;
            } else {
            PG8_LDB(B0, 0, 0); PG8_SCHED; PG8_LDA(At, 0, 0); PG8_STAGE(PG8_SA(1, 1), a1 + hstep, voffA);
            PG8_WAIT_L(8); PG8_BAR; PG8_WAIT_L(0); PG8_MMA(0, 0, At, B0); PG8_BAR; PG8_SCHED;
            PG8_LDB(B1, 0, 1); PG8_STAGE(PG8_SB(0, 0), b2, voffB);
            PG8_BAR; PG8_WAIT_L(0); PG8_MMA(0, 1, At, B1); PG8_BAR;
            PG8_LDA(At, 0, 1); PG8_STAGE(PG8_SA(0, 0), a2, voffA);
            PG8_BAR; PG8_WAIT_L(0); PG8_MMA(1, 0, At, B0); PG8_BAR; PG8_SCHED;
            PG8_STAGE(PG8_SB(0, 1), b2 + hstep, voffB);
            PG8_WAIT_V(6); PG8_BAR; PG8_MMA(1, 1, At, B1); PG8_BAR;
            PG8_LDB(B0, 1, 0); PG8_SCHED; PG8_LDA(At, 1, 0); PG8_STAGE(PG8_SA(0, 1), a2 + hstep, voffA);
            PG8_WAIT_L(8); PG8_BAR; PG8_WAIT_L(0); PG8_MMA(0, 0, At, B0); PG8_BAR; PG8_SCHED;
            PG8_LDB(B1, 1, 1); PG8_STAGE(PG8_SB(1, 0), b3, voffB);
            PG8_BAR; PG8_WAIT_L(0); PG8_MMA(0, 1, At, B1); PG8_BAR;
            PG8_LDA(At, 1, 1); PG8_STAGE(PG8_SA(1, 0), a3, voffA);
            PG8_BAR; PG8_WAIT_L(0); PG8_MMA(1, 0, At, B0); PG8_BAR; PG8_SCHED;
            PG8_STAGE(PG8_SB(1, 1), b3 + hstep, voffB);
            PG8_WAIT_V(6); PG8_BAR; PG8_MMA(1, 1, At, B1); PG8_BAR;
            }
        }
#ifdef DBG_KLOOP_T
        if (ui == DBG_KLOOP_UNIT && blockIdx.x == DBG_T_BLK && tid == 0 && ((volatile PG8_LAS unsigned*)(lds + 147456 + 320 + 200))[0] == 1u) { ((volatile PG8_LAS unsigned long long*)(lds + 147456 + 320 + 256))[6] = __builtin_amdgcn_s_memtime(); ((volatile PG8_LAS unsigned long long*)(lds + 147456 + 320 + 256))[7] = __builtin_amdgcn_s_memrealtime(); }
#endif
        if constexpr (ALIGN_EPI) { if (wr == 0) PG8_BAR; }
        if constexpr (!Epi::AFTER_DRAIN) { E(acc, cur, wr, wc, fr, fq); S.done(cur); }
        if (!has_next) break;
#pragma unroll
        for (int a = 0; a < 2; ++a)
#pragma unroll
            for (int b = 0; b < 2; ++b)
#pragma unroll
                for (int m = 0; m < 4; ++m)
#pragma unroll
                    for (int n = 0; n < 2; ++n) acc[a][b][m][n] = (f32x4){0.f, 0.f, 0.f, 0.f};
        cur = nxt; cA = nA; cB = nB; ++ui;
        if constexpr (ALIGN_EPI) { if (wr == 1) PG8_BAR; }
    }
    PG8_WAIT_V(0);
    if constexpr (!ALIGN_EPI) { if (wr == 0) PG8_BAR; }
    PG8_BAR;
    if constexpr (Epi::AFTER_DRAIN) { E.fused(acc, cur, wr, wc, fr, fq, lds, wid, lane); S.done(cur); }
#undef PG8_SA
#undef PG8_SB
#undef PG8_STAGE
#undef PG8_LDA
#undef PG8_LDB
#undef PG8_MMA
#undef PG8_WAIT_V
#undef PG8_WAIT_L
#undef PG8_BAR
#undef PG8_SCHED
}
}
constexpr int D = 1024, MP = 16384, MS = 1024, M = MP + MS, NLAYER = 4, MIXW = 256, INC = 5888, PMC = 1792, GTC = 4096, FF = 2816;
constexpr int SEQ = 2048, NB = 8, DB = 128, DSEQ = 8, NCH = SEQ / 64;
constexpr int NPHASE = 2 + 7 * NLAYER;
#ifndef MK_PER_PHASE
#define MK_PER_PHASE 0
#endif
constexpr size_t O_Y = 0, O_POOLP = 17825792, O_POOLS = 17948672, O_SREP = 19914752, O_SRES = 19947520, O_SIMP = 20471808, O_SIMS = 20504576,
                 O_SCP = 21028864, O_SCS = 21045248, O_CFP = 21307392, O_CFS = 21553152, O_END = 25485312;
constexpr size_t MiB = 1u << 20;
constexpr size_t WS_CTL = 0, CTL_ZERO_BYTES = 64 * 1024;
constexpr size_t WS_SSQ = 1 * MiB;
constexpr size_t WS_E = 3 * MiB;
constexpr size_t WS_TAB = 5 * MiB;
constexpr size_t TAB_LB = 0, TAB_LP = 8192, TAB_BBT = 16384, TAB_CM = TAB_BBT + 65536, TAB_PW = TAB_CM + 65536, TAB_STRIDE = TAB_PW + 32768;
constexpr size_t WS_WIN = 6 * MiB;
constexpr size_t WS_WFI = WS_WIN + (size_t)NLAYER * INC * D * 2;
constexpr size_t WS_WOUT = WS_WFI + (size_t)NLAYER * 2 * FF * D * 2;
constexpr size_t WS_WFO = WS_WOUT + (size_t)NLAYER * D * D * 2;
constexpr size_t WS_WBR = WS_WFO + (size_t)NLAYER * D * FF * 2;
constexpr size_t WS_WGLU = WS_WBR + (size_t)NLAYER * 4 * D * MIXW * 2;
constexpr size_t WS_ACT1 = WS_WGLU + (size_t)NLAYER * MIXW * MIXW * 2;
constexpr size_t WS_PM = WS_ACT1 + (size_t)M * D * 2;
constexpr size_t WS_GT = WS_PM + (size_t)M * PMC * 2;
constexpr size_t WS_END = WS_GT + (size_t)M * GTC * 2;
static_assert(WS_TAB + NLAYER * TAB_STRIDE <= WS_WIN && WS_E + (size_t)NB * NCH * 1024 * 8 <= WS_TAB && WS_SSQ + (size_t)M * 64 <= WS_E, "d_ws map");
constexpr int CW_Q = 8192;
constexpr int CW_BAR = 1024;
constexpr int RING_OFF = 0, RING_BYTES = 147456;
constexpr int LDSCTL_OFF = RING_BYTES, MISC_OFF = LDSCTL_OFF + 320;
constexpr int LDS_BYTES = 163840;
constexpr int NWAVES = 8;

#define GAS __attribute__((address_space(1)))
#define LAS __attribute__((address_space(3)))
typedef unsigned short bf16;
typedef unsigned short bf16_t;
typedef unsigned v4u __attribute__((ext_vector_type(4)));
typedef unsigned v2u __attribute__((ext_vector_type(2)));
typedef float f32x4 __attribute__((ext_vector_type(4)));
typedef float f32x2 __attribute__((ext_vector_type(2)));
typedef short bf16x8 __attribute__((ext_vector_type(8)));
#define LDS_WAIT() asm volatile("s_waitcnt lgkmcnt(0)" ::: "memory")
#define VM_WAIT() asm volatile("s_waitcnt vmcnt(0)" ::: "memory")
__device__ __forceinline__ unsigned pk2(float lo, float hi) { return pg8::cvt_pk_bf16(lo, hi); }
__device__ __forceinline__ float bflo(unsigned u) { return __builtin_bit_cast(float, u << 16); }
__device__ __forceinline__ float bfhi(unsigned u) { return __builtin_bit_cast(float, u & 0xffff0000u); }
__device__ __forceinline__ float bf1(bf16_t b) { return __builtin_bit_cast(float, (unsigned)b << 16); }
__device__ __forceinline__ void unpack8(const v4u v, float (&f)[8]) { f[0] = bflo(v.x); f[1] = bfhi(v.x); f[2] = bflo(v.y); f[3] = bfhi(v.y); f[4] = bflo(v.z); f[5] = bfhi(v.z); f[6] = bflo(v.w); f[7] = bfhi(v.w); }
__device__ __forceinline__ v4u pack8(const float (&f)[8]) { v4u w; w.x = pk2(f[0], f[1]); w.y = pk2(f[2], f[3]); w.z = pk2(f[4], f[5]); w.w = pk2(f[6], f[7]); return w; }
__device__ __forceinline__ float sigm(float x) { return pg8::sigm(x); }
__device__ __forceinline__ float gelu_tanh(float y) { const float in2 = 1.5957691216057308f * (y + 0.044715f * y * y * y); const float e = __builtin_amdgcn_exp2f(1.4426950408889634f * in2); return 0.5f * y * (2.0f - 2.0f * __builtin_amdgcn_rcpf(e + 1.0f)); }
__device__ __forceinline__ float wave_sum(float v) {
#pragma unroll
    for (int o = 1; o < 64; o <<= 1) v += __shfl_xor(v, o);
    return v;
}

#define XB_TMO      128
#define XB_XCNT(j)  (256  + 64 * (j))
#define XB_XSUB(j)  (1280 + 64 * (j))
#define XB_XGEN(j)  (2304 + 64 * (j))
#define XB_TOP      3328
#define XB_TOPGEN   3392
#define XCD_BAR_WORDS 3456
#define XB_SPIN_CAP (1u << 18)

__device__ __forceinline__ unsigned xb_ld(unsigned* p)              { return __hip_atomic_load(p, __ATOMIC_RELAXED, __HIP_MEMORY_SCOPE_AGENT); }
__device__ __forceinline__ unsigned xb_add(unsigned* p, unsigned v) { return __hip_atomic_fetch_add(p, v, __ATOMIC_RELAXED, __HIP_MEMORY_SCOPE_AGENT); }
__device__ __forceinline__ unsigned xb_xcc_id() { return (unsigned)__builtin_amdgcn_s_getreg((3 << 11) | 20) & 0xFu; }
#define XB_SPIN(cond, bar) do { unsigned _sp = 0; while (cond) { __builtin_amdgcn_s_sleep(1); \
    if ((++_sp & 255u) == 0u) { if (xb_ld(&(bar)[XB_TMO])) break; if (_sp > XB_SPIN_CAP) { atomicAdd(&(bar)[XB_TMO], 1u); break; } } } } while (0)

struct XcdBarrier {
    unsigned* bar; unsigned x;
    volatile LAS unsigned* st;
};

__device__ __forceinline__ XcdBarrier xcd_barrier_post(unsigned* bar, volatile LAS unsigned* st) {
    XcdBarrier b; b.bar = bar; b.x = xb_xcc_id(); b.st = st;
    if (threadIdx.x == 0) (void)xb_add(&bar[XB_XCNT(b.x)], 1u);
    return b;
}
__device__ __forceinline__ void xcd_barrier_complete(unsigned* bar, unsigned x, unsigned& nloc, unsigned& nx) {
    const unsigned G = gridDim.x * gridDim.y * gridDim.z;
    unsigned sum, cnt, mine, sp = 0u;
    for (;;) {
        sum = 0u; cnt = 0u; mine = 0u;
#pragma unroll
        for (unsigned j = 0; j < 16; ++j) { const unsigned c = xb_ld(&bar[XB_XCNT(j)]); sum += c; cnt += (c > 0u) ? 1u : 0u; mine = (j == x) ? c : mine; }
        if (sum == G) break;
        __builtin_amdgcn_s_sleep(1);
        if ((++sp & 255u) == 0u) { if (xb_ld(&bar[XB_TMO])) break; if (sp > XB_SPIN_CAP) { atomicAdd(&bar[XB_TMO], 1u); break; } }
    }
    nloc = mine > 0u ? mine : 1u; nx = cnt > 0u ? cnt : 1u;
}

__device__ __forceinline__ void xcd_barrier_leader(const XcdBarrier& b) {
    {
        unsigned* bar = b.bar;
        __builtin_amdgcn_s_waitcnt(0);
        unsigned nloc = b.st[0], nx = b.st[1];
        if (nloc == 0u) { xcd_barrier_complete(bar, b.x, nloc, nx); b.st[0] = nloc; b.st[1] = nx; }
        const unsigned old = xb_add(&bar[XB_XSUB(b.x)], 1u);
        const unsigned gen = old / nloc;
        if (old + 1u == (gen + 1u) * nloc) {
            __builtin_amdgcn_fence(__ATOMIC_RELEASE, "agent");
            asm volatile("s_waitcnt vmcnt(0)" ::: "memory");
            const unsigned og = xb_add(&bar[XB_TOP], 1u);
            const unsigned tg = og / nx;
            if (og + 1u == (tg + 1u) * nx) xb_add(&bar[XB_TOPGEN], 1u);
            else XB_SPIN(xb_ld(&bar[XB_TOPGEN]) == tg, bar);
            __builtin_amdgcn_fence(__ATOMIC_ACQUIRE, "agent");
            xb_add(&bar[XB_XGEN(b.x)], 1u);
            asm volatile("s_waitcnt vmcnt(0)" ::: "memory");
        } else {
            XB_SPIN(xb_ld(&bar[XB_XGEN(b.x)]) == gen, bar);
            __builtin_amdgcn_fence(__ATOMIC_ACQUIRE, "agent");
            asm volatile("s_waitcnt vmcnt(0)" ::: "memory");
        }
    }
}
__device__ __forceinline__ void xcd_barrier(const XcdBarrier& b, bool leader) {
    asm volatile("s_waitcnt vmcnt(0)" ::: "memory");
    __syncthreads();
    if (leader) xcd_barrier_leader(b);
    __syncthreads();
}
struct Args { const float* in[32]; float* out; unsigned char* ws; int ph_lo, ph_hi; };
enum { I_XP = 0, I_XS, I_STPOOL, I_STRE, I_STIM, I_STSC, I_STCF, I_N1G, I_N2G, I_FING, I_WIN, I_BGATE, I_POOLW, I_POOLSC, I_LAMRE, I_LAMIM, I_LOGDT,
       I_BRE, I_BIM, I_CRE, I_CIM, I_DSKIP, I_WGLU, I_BGLU, I_SCW, I_CFW, I_CFLNG, I_CFLNB, I_WBR, I_WOUT, I_WFI, I_WFO };

__device__ __forceinline__ void p0_item(const float* W, int ldw, int src_col0, const float* kscale, int k0, bf16* WTrow0, int K, LAS float* scr, int lane) {
    float wv[32];
#pragma unroll
    for (int i = 0; i < 32; ++i) { const int kk = 2 * i + (lane >> 5); wv[i] = W[(size_t)(k0 + kk) * ldw + src_col0 + (lane & 31)]; }
#pragma unroll
    for (int i = 0; i < 32; ++i) { const int kk = 2 * i + (lane >> 5); scr[kk * 33 + (lane & 31)] = wv[i]; }
    LDS_WAIT(); asm volatile("" ::: "memory");
    const int c = lane & 7;
    f32x4 ks0 = (f32x4){1.f, 1.f, 1.f, 1.f}, ks1 = ks0;
    if (kscale) { ks0 = *(const f32x4*)(kscale + k0 + 8 * c); ks1 = *(const f32x4*)(kscale + k0 + 8 * c + 4); }
#pragma unroll
    for (int j = 0; j < 4; ++j) { const int n = (lane >> 3) + 8 * j; const LAS float* s = scr + (8 * c) * 33 + n;
        v4u o; o.x = pk2(s[0 * 33] * ks0[0], s[1 * 33] * ks0[1]); o.y = pk2(s[2 * 33] * ks0[2], s[3 * 33] * ks0[3]); o.z = pk2(s[4 * 33] * ks1[0], s[5 * 33] * ks1[1]); o.w = pk2(s[6 * 33] * ks1[2], s[7 * 33] * ks1[3]);
        *(GAS v4u*)(WTrow0 + (size_t)n * K + k0 + 8 * c) = o; }
    LDS_WAIT(); asm volatile("" ::: "memory");
}
constexpr int P0_IT_IN = 16 * (INC / 32), P0_IT_FI = 16 * (2 * FF / 32), P0_IT_OUT = 16 * 32, P0_IT_FO = (FF / 64) * 32, P0_IT_BR = 4 * 4 * 32, P0_IT_GLU = 4 * 8;
constexpr int P0_IT_LAYER = P0_IT_IN + P0_IT_FI + P0_IT_OUT + P0_IT_FO + P0_IT_BR + P0_IT_GLU;
__device__ __forceinline__ void p0_weight_item(const Args& a, int L, int r, LAS float* scr, int lane) {
    unsigned char* ws = a.ws;
    if (r < P0_IT_IN) { const int nblk = INC / 32, kb = r / nblk, nb = r % nblk;
        p0_item(a.in[I_WIN] + (size_t)L * D * INC, INC, 32 * nb, a.in[I_N1G] + L * D, 64 * kb, (bf16*)(ws + WS_WIN) + ((size_t)L * INC + 32 * nb) * D, D, scr, lane); return; } r -= P0_IT_IN;
    if (r < P0_IT_FI) { const int nblk = 2 * FF / 32, kb = r / nblk, nb = r % nblk; const int nd = 32 * nb, pn = nd >> 8, rr = nd & 255;
        const int src = rr < 128 ? 128 * pn + rr : FF + 128 * pn + (rr - 128);
        p0_item(a.in[I_WFI] + (size_t)L * D * 2 * FF, 2 * FF, src, a.in[I_N2G] + L * D, 64 * kb, (bf16*)(ws + WS_WFI) + ((size_t)L * 2 * FF + nd) * D, D, scr, lane); return; } r -= P0_IT_FI;
    if (r < P0_IT_OUT) { const int kb = r / 32, nb = r % 32;
        p0_item(a.in[I_WOUT] + (size_t)L * D * D, D, 32 * nb, nullptr, 64 * kb, (bf16*)(ws + WS_WOUT) + ((size_t)L * D + 32 * nb) * D, D, scr, lane); return; } r -= P0_IT_OUT;
    if (r < P0_IT_FO) { const int kb = r / 32, nb = r % 32;
        p0_item(a.in[I_WFO] + (size_t)L * FF * D, D, 32 * nb, nullptr, 64 * kb, (bf16*)(ws + WS_WFO) + ((size_t)L * D + 32 * nb) * FF, FF, scr, lane); return; } r -= P0_IT_FO;
    if (r < P0_IT_BR) { const int br = r / 128, q = r % 128, kb = q / 32, nb = q % 32;
        p0_item(a.in[I_WBR] + (size_t)(L * 4 + br) * MIXW * D, D, 32 * nb, nullptr, 64 * kb, (bf16*)(ws + WS_WBR) + ((size_t)(L * 4 + br) * D + 32 * nb) * MIXW, MIXW, scr, lane); return; } r -= P0_IT_BR;
    { const int kb = r / 8, nb = r % 8;
        p0_item(a.in[I_WGLU] + (size_t)L * MIXW * MIXW, MIXW, 32 * nb, nullptr, 64 * kb, (bf16*)(ws + WS_WGLU) + ((size_t)L * MIXW + 32 * nb) * MIXW, MIXW, scr, lane); }
}
constexpr int P0_SLICES = 6, P0_F_PER = 7, P0_A_PER = 2, P0_F_BID0 = 216, P0_A_BID0 = 192;
__device__ __forceinline__ int p0_items_A(int G) { return 0; }
__device__ __forceinline__ int p0_items_F(int G) { return G == 256 ? (256 - P0_F_BID0) * NWAVES * P0_F_PER : 0; }
__device__ __forceinline__ void p0_idle_items(const Args& a, LAS unsigned char* lds, int lane, int wave, int bid, int L, int base, int bid0, int per) {
    LAS float* scr = (LAS float*)(lds + RING_OFF + wave * 16384);
    const int nw = (256 - bid0) * NWAVES, w = (bid - bid0) * NWAVES + wave;
    for (int q = 0; q < per; ++q) p0_weight_item(a, L, base + w + q * nw, scr, lane);
}
__device__ __forceinline__ void p0_slice(const Args& a, LAS unsigned char* lds, int lane, int wave, int G, int bid, int L, int slice) {
    LAS float* scr = (LAS float*)(lds + RING_OFF + wave * 16384);
    const int first = p0_items_A(G) + p0_items_F(G), per = (P0_IT_LAYER - first + P0_SLICES - 1) / P0_SLICES;
    const int lo = first + slice * per, hi = (lo + per < P0_IT_LAYER) ? lo + per : P0_IT_LAYER;
    for (int r = lo + bid * (NWAVES - 1) + (wave - 1); r < hi; r += G * (NWAVES - 1)) p0_weight_item(a, L, r, scr, lane);
}
__device__ __forceinline__ void p0_prologue(const Args& a, LAS unsigned char* lds, int tid, int lane, int wave, int G, int bid) {
    LAS float* scr = (LAS float*)(lds + RING_OFF + wave * 16384);
    const int gw = bid * NWAVES + wave, NGW = G * NWAVES;
    unsigned char* ws = a.ws;
    for (int it = gw; it < (MK_PER_PHASE ? NLAYER : 1) * P0_IT_LAYER; it += NGW) p0_weight_item(a, it / P0_IT_LAYER, it % P0_IT_LAYER, scr, lane);
    for (int m = gw; m < M; m += NGW) {
        const float* xrow = m < MP ? a.in[I_XP] + (size_t)m * D : a.in[I_XS] + (size_t)(m - MP) * D;
        const GAS f32x4* xr = (const GAS f32x4*)xrow + lane; f32x4 v[4]; float s = 0.f;
#pragma unroll
        for (int j = 0; j < 4; ++j) { v[j] = xr[64 * j]; s += (v[j][0] * v[j][0] + v[j][1] * v[j][1]) + (v[j][2] * v[j][2] + v[j][3] * v[j][3]); }
        s = wave_sum(s);
        GAS v2u* o8 = (GAS v2u*)((bf16*)(ws + WS_ACT1) + (size_t)m * D) + lane;
#pragma unroll
        for (int j = 0; j < 4; ++j) { v2u w; w.x = pk2(v[j][0], v[j][1]); w.y = pk2(v[j][2], v[j][3]); o8[64 * j] = w; }
        if (lane < 16) ((float*)(ws + WS_SSQ))[((size_t)(lane >> 2) * M + m) * 4 + (lane & 3)] = lane == 0 ? s : 0.f;
    }
    for (int idx = bid * 512 + tid; idx < NLAYER * 1024; idx += G * 512) {
        const int L = idx >> 10, gp = idx & 1023, g = gp >> 6, p = gp & 63;
        unsigned char* tab = ws + WS_TAB + (size_t)L * TAB_STRIDE;
        const float lre = a.in[I_LAMRE][idx], lim = a.in[I_LAMIM][idx], dt = expf(a.in[I_LOGDT][L * 16 + g]);
        const float ar = lre * dt, br_ = lim * dt, ea = expf(ar), cb = cosf(br_), sb = sinf(br_), sh = sinf(0.5f * br_);
        const float lbr = ea * cb, lbi = ea * sb;
        const float m1r = expm1f(ar) * cb - 2.0f * sh * sh, m1i = lbi;
        const float den = 1.0f / (lre * lre + lim * lim);
        const float qr = (m1r * lre + m1i * lim) * den, qi = (m1i * lre - m1r * lim) * den;
        ((f32x2*)(tab + TAB_LB))[gp] = (f32x2){lbr, lbi};
        float pr = lbr, pi = lbi;
#pragma unroll
        for (int s = 0; s < 6; ++s) { const float nr = pr * pr - pi * pi, ni = 2.0f * pr * pi; pr = nr; pi = ni; }
        ((f32x2*)(tab + TAB_LP))[gp] = (f32x2){pr, pi};
        bf16* bbt = (bf16*)(tab + TAB_BBT); bf16* cm = (bf16*)(tab + TAB_CM);
        const float* bre = a.in[I_BRE] + (size_t)idx * 16; const float* bim = a.in[I_BIM] + (size_t)idx * 16;
#pragma unroll
        for (int c = 0; c < 16; ++c) { const float Br = bre[c], Bi = bim[c];
            bbt[(g * 128 + p) * 16 + c] = (bf16)(pk2(qr * Br - qi * Bi, 0.f) & 0xffffu);
            bbt[(g * 128 + 64 + p) * 16 + c] = (bf16)(pk2(qr * Bi + qi * Br, 0.f) & 0xffffu);
            cm[(g * 16 + c) * 128 + p] = (bf16)(pk2(a.in[I_CRE][((size_t)(L * 16 + g) * 16 + c) * 64 + p], 0.f) & 0xffffu);
            cm[(g * 16 + c) * 128 + 64 + p] = (bf16)(pk2(-a.in[I_CIM][((size_t)(L * 16 + g) * 16 + c) * 64 + p], 0.f) & 0xffffu); }
    }
    for (int idx = bid * 512 + tid; idx < NLAYER * 4 * 64 * 64; idx += G * 512) {
        const int L = idx >> 14, r = idx & 16383, k = r >> 12, o = (r >> 6) & 63, c = r & 63;
        ((bf16*)(ws + WS_TAB + (size_t)L * TAB_STRIDE + TAB_PW))[r] = (bf16)(pk2(a.in[I_POOLW][((size_t)(L * 4 + k) * 64 + c) * 64 + o], 0.f) & 0xffffu);
    }
}
__device__ __forceinline__ void final_norm(const Args& a, int lane, int wave, int G, int bid) {
    const int gw = bid * NWAVES + wave, NGW = G * NWAVES;
    const float* ssq = (const float*)(a.ws + WS_SSQ);
    f32x4 gv[4];
#pragma unroll
    for (int j = 0; j < 4; ++j) gv[j] = ((const f32x4*)a.in[I_FING])[lane + 64 * j];
    for (int m = gw; m < M; m += NGW) {
        float s = lane < 16 ? ssq[((size_t)(lane >> 2) * M + m) * 4 + (lane & 3)] : 0.f; s = wave_sum(s);
        const float rs = __builtin_amdgcn_rsqf(s * (1.0f / 1024.0f) + 1e-6f);
        const GAS v2u* xb = (const GAS v2u*)((const bf16*)(a.ws + WS_ACT1) + (size_t)m * D) + lane;
        GAS f32x4* yr = (GAS f32x4*)(a.out + (size_t)m * D) + lane;
#pragma unroll
#ifdef DBG_HASH_Y
        for (int j = 0; j < 4; ++j) { const v2u q = xb[64 * j]; f32x4 v = (f32x4){bflo(q.x), bfhi(q.x), bflo(q.y), bfhi(q.y)}; v = v * rs * gv[j]; f32x4 h;
            for (int qq = 0; qq < 4; ++qq) { const unsigned b = __float_as_uint(v[qq]); const unsigned hh = (b * 2654435761u) ^ (b >> 15); h[qq] = (float)(hh >> 8) * (1.0f / 16777216.0f); }
            yr[64 * j] = h; }
#else
        for (int j = 0; j < 4; ++j) { const v2u q = xb[64 * j]; const f32x4 v = (f32x4){bflo(q.x), bfhi(q.x), bflo(q.y), bfhi(q.y)}; yr[64 * j] = v * rs * gv[j]; }
#endif
    }
}

typedef float f32x4_t __attribute__((ext_vector_type(4)));
#ifdef DBG_MIX_T
#define MIX_STAMP(i) do { if (((i) == DBG_TA || (i) == DBG_TB) && !SAMPLE && layer == 1 && blockIdx.x == DBG_T_BLK && wave == 0) { const unsigned long long t__ = __builtin_amdgcn_s_memrealtime(); if (lane == 0) ((volatile LAS unsigned long long*)(lds + 131072 + 320 + 256))[16 + (i)] = t__; } } while (0)
#else
#define MIX_STAMP(i) do {} while (0)
#endif
__device__ __forceinline__ float fma_s(float a, float b, float c) { float r; asm("v_fma_f32 %0, %1, %2, %3" : "=v"(r) : "v"(a), "v"(b), "v"(c)); return r; }
template <bool SAMPLE>
__device__ __forceinline__ void mix_unit(const Args& a, int layer, int uidx, LAS unsigned char* lds, int tid_in, int lane_in, int wave_in, int stages) {
    int tid = tid_in; asm volatile("" : "+v"(tid));
    const int lane = tid & 63, wave = __builtin_amdgcn_readfirstlane(tid >> 6);
#ifdef DBG_EXTRA_SYNC
    asm volatile("s_waitcnt vmcnt(0) lgkmcnt(0)" ::: "memory"); __syncthreads();
#endif
    constexpr int L = SAMPLE ? 8 : 64, NSEG = SAMPLE ? 2 : 1, R = NSEG * L;
    const bf16* PMb = (const bf16*)(a.ws + WS_PM); bf16* BR = (bf16*)a.out;
    const int s = uidx >> 5, c = uidx & 31, q0 = 2 * uidx;
    const int row0 = SAMPLE ? MP + q0 * 8 : s * SEQ + 64 * c;
    const bool last = SAMPLE || c == NCH - 1;
    LAS float* V = (LAS float*)lds;
    MIX_STAMP(0);
    if (stages & 1) {
        constexpr int TR = NSEG * (30 + L);
        LAS float* WCF = (LAS float*)(lds + 96256);
        {
            constexpr int NIT = (TR * 32 + 511) / 512;
            v4u qa[NIT], qb[NIT]; int kind[NIT];
#pragma unroll
            for (int it = 0; it < NIT; ++it) {
                const int idx = tid + it * 512; kind[it] = 0; qa[it] = (v4u){0u, 0u, 0u, 0u}; qb[it] = (v4u){0u, 0u, 0u, 0u};
                if (idx < TR * 32) {
                    const int rr = idx >> 5, c8 = (idx & 31) * 8, seg = rr / (30 + L), e = rr % (30 + L);
                    int srow = -1;
                    if (SAMPLE) { if (e >= 30) srow = MP + (q0 + seg) * 8 + (e - 30); }
                    else { const int tabs = c * 64 + e - 30; if (tabs >= 0) srow = s * SEQ + tabs; }
                    if (srow >= 0) { kind[it] = 1; qa[it] = *(const v4u*)(PMb + (size_t)srow * PMC + 1280 + c8); qb[it] = *(const v4u*)(PMb + (size_t)srow * PMC + 1536 + c8); }
                    else if (SAMPLE) { kind[it] = 2; const float* st = a.in[I_STCF] + ((size_t)(layer * DB + q0 + seg) * 30 + e) * MIXW + c8; qa[it] = *(const v4u*)st; qb[it] = *(const v4u*)(st + 4); }
                }
            }
#pragma unroll
            for (int it = 0; it < NIT; ++it) {
                const int idx = tid + it * 512;
                if (idx < TR * 32) {
                    const int rr = idx >> 5, c8 = (idx & 31) * 8;
                    float v[8];
                    if (kind[it] == 1) { float av[8], bv[8]; unpack8(qa[it], av); unpack8(qb[it], bv);
#pragma unroll
                        for (int j = 0; j < 8; ++j) v[j] = av[j] * sigm(bv[j]); }
                    else { v[0] = __uint_as_float(qa[it].x); v[1] = __uint_as_float(qa[it].y); v[2] = __uint_as_float(qa[it].z); v[3] = __uint_as_float(qa[it].w);
                           v[4] = __uint_as_float(qb[it].x); v[5] = __uint_as_float(qb[it].y); v[6] = __uint_as_float(qb[it].z); v[7] = __uint_as_float(qb[it].w); }
                    *(LAS f32x4*)(V + rr * 256 + c8) = (f32x4){v[0], v[1], v[2], v[3]}; *(LAS f32x4*)(V + rr * 256 + c8 + 4) = (f32x4){v[4], v[5], v[6], v[7]};
                }
            }
        }
        { f32x4 wq[4];
#pragma unroll
            for (int it = 0; it < 4; ++it) { const int idx = tid + it * 512; wq[it] = idx < 31 * 64 ? *(const f32x4*)(a.in[I_CFW] + (size_t)layer * 31 * MIXW + idx * 4) : (f32x4){0.f, 0.f, 0.f, 0.f}; }
#pragma unroll
            for (int it = 0; it < 4; ++it) { const int idx = tid + it * 512; if (idx < 31 * 64) *(LAS f32x4*)(WCF + idx * 4) = wq[it]; } }
        __syncthreads();
        MIX_STAMP(1);
        if (last) {
            for (int idx = tid; idx < NSEG * 30 * 64; idx += 512) { const int seg = idx / (30 * 64), r = idx % (30 * 64), j = r >> 6, c4 = (r & 63) * 4;
                float* dst = a.out + (SAMPLE ? O_CFS + ((size_t)(layer * DB + q0 + seg) * 30 + j) * MIXW : O_CFP + ((size_t)(layer * NB + s) * 30 + j) * MIXW) + c4;
                *(f32x4*)dst = *(LAS f32x4*)(V + (seg * (30 + L) + L + j) * 256 + c4); }
        }
        const f32x4 lg = *(const f32x4*)(a.in[I_CFLNG] + layer * MIXW + 4 * lane), lb = *(const f32x4*)(a.in[I_CFLNB] + layer * MIXW + 4 * lane);
        {
            constexpr int NT = R / NWAVES, TG = NT >= 4 ? 4 : NT;
#pragma unroll 1
            for (int g0 = 0; g0 < NT; g0 += TG) {
                f32x4 acc[TG]; int base[TG];
#pragma unroll
                for (int i = 0; i < TG; ++i) { const int tt = wave + NWAVES * (g0 + i), seg = tt / L, t = tt % L; base[i] = (seg * (30 + L) + t) * 256 + 4 * lane; acc[i] = (f32x4){0.f, 0.f, 0.f, 0.f}; }
#pragma unroll 4
                for (int j = 0; j < 31; ++j) { const f32x4 w = *(LAS f32x4*)(WCF + j * 256 + 4 * lane);
#pragma unroll
                    for (int i = 0; i < TG; ++i) acc[i] += w * *(LAS f32x4*)(V + base[i] + j * 256); }
                float s1[TG];
#pragma unroll
                for (int i = 0; i < TG; ++i) s1[i] = (acc[i][0] + acc[i][1]) + (acc[i][2] + acc[i][3]);
#pragma unroll
                for (int o = 1; o < 64; o <<= 1) {
#pragma unroll
                    for (int i = 0; i < TG; ++i) s1[i] += __shfl_xor(s1[i], o); }
                f32x4 d[TG]; float s2[TG];
#pragma unroll
                for (int i = 0; i < TG; ++i) { d[i] = acc[i] - s1[i] * (1.0f / 256.0f); s2[i] = (d[i][0] * d[i][0] + d[i][1] * d[i][1]) + (d[i][2] * d[i][2] + d[i][3] * d[i][3]); }
#pragma unroll
                for (int o = 1; o < 64; o <<= 1) {
#pragma unroll
                    for (int i = 0; i < TG; ++i) s2[i] += __shfl_xor(s2[i], o); }
#pragma unroll
                for (int i = 0; i < TG; ++i) { const int tt = wave + NWAVES * (g0 + i);
                    const float rstd = __builtin_amdgcn_rsqf(s2[i] * (1.0f / 256.0f) + 1e-5f);
                    const f32x4 yn = d[i] * rstd * lg + lb;
                    v2u w; w.x = pk2(yn[0] * sigm(yn[0]), yn[1] * sigm(yn[1])); w.y = pk2(yn[2] * sigm(yn[2]), yn[3] * sigm(yn[3]));
                    *(v2u*)(BR + (size_t)(row0 + tt) * D + 768 + 4 * lane) = w; }
            }
        }
        __syncthreads();
    }
    MIX_STAMP(2);
    if (stages & 2) {
        constexpr int TR = NSEG * (15 + L);
        LAS bf16* Dt = (LAS bf16*)(lds + 81920);
        {
            constexpr int NIT = (TR * 32 + 511) / 512;
            v4u qa[NIT], qb[NIT]; int kind[NIT];
#pragma unroll
            for (int it = 0; it < NIT; ++it) {
                const int idx = tid + it * 512; kind[it] = 0; qa[it] = (v4u){0u, 0u, 0u, 0u}; qb[it] = (v4u){0u, 0u, 0u, 0u};
                if (idx < TR * 32) {
                    const int rr = idx >> 5, c8 = (idx & 31) * 8, seg = rr / (15 + L), e = rr % (15 + L);
                    int srow = -1;
                    if (SAMPLE) { if (e >= 15) srow = MP + (q0 + seg) * 8 + (e - 15); }
                    else { const int tabs = c * 64 + e - 15; if (tabs >= 0) srow = s * SEQ + tabs; }
                    if (srow >= 0) { kind[it] = 1; qa[it] = *(const v4u*)(PMb + (size_t)srow * PMC + c8); }
                    else if (SAMPLE) { kind[it] = 2; const float* st = a.in[I_STPOOL] + ((size_t)(layer * DB + q0 + seg) * 15 + e) * MIXW + c8; qa[it] = *(const v4u*)st; qb[it] = *(const v4u*)(st + 4); }
                }
            }
#pragma unroll
            for (int it = 0; it < NIT; ++it) {
                const int idx = tid + it * 512;
                if (idx < TR * 32) {
                    const int rr = idx >> 5, c8 = (idx & 31) * 8;
                    float v[8];
                    if (kind[it] == 1) unpack8(qa[it], v);
                    else { v[0] = __uint_as_float(qa[it].x); v[1] = __uint_as_float(qa[it].y); v[2] = __uint_as_float(qa[it].z); v[3] = __uint_as_float(qa[it].w);
                           v[4] = __uint_as_float(qb[it].x); v[5] = __uint_as_float(qb[it].y); v[6] = __uint_as_float(qb[it].z); v[7] = __uint_as_float(qb[it].w); }
                    *(LAS f32x4*)(V + rr * 256 + c8) = (f32x4){v[0], v[1], v[2], v[3]}; *(LAS f32x4*)(V + rr * 256 + c8 + 4) = (f32x4){v[4], v[5], v[6], v[7]};
                }
            }
        }
        __syncthreads();
        MIX_STAMP(3);
        if (last) {
            for (int idx = tid; idx < NSEG * 15 * 64; idx += 512) { const int seg = idx / (15 * 64), r = idx % (15 * 64), j = r >> 6, c4 = (r & 63) * 4;
                float* dst = a.out + (SAMPLE ? O_POOLS + ((size_t)(layer * DB + q0 + seg) * 15 + j) * MIXW : O_POOLP + ((size_t)(layer * NB + s) * 15 + j) * MIXW) + c4;
                *(f32x4*)dst = *(LAS f32x4*)(V + (seg * (15 + L) + L + j) * 256 + c4); }
        }
        for (int idx = tid; idx < R * 32; idx += 512) {
            const int tt = idx >> 5, c8 = (idx & 31) * 8, seg = tt / L, t = tt % L, base = seg * (15 + L) + t + 15, win = 2 << (c8 >> 6);
            float sm[8];
#pragma unroll
            for (int j = 0; j < 8; ++j) sm[j] = 0.f;
            for (int w = 0; w < win; ++w) { const f32x4 x0 = *(LAS f32x4*)(V + (base - w) * 256 + c8), x1 = *(LAS f32x4*)(V + (base - w) * 256 + c8 + 4);
                sm[0] += x0[0]; sm[1] += x0[1]; sm[2] += x0[2]; sm[3] += x0[3]; sm[4] += x1[0]; sm[5] += x1[1]; sm[6] += x1[2]; sm[7] += x1[3]; }
            const int cnt = SAMPLE ? win : min(c * 64 + t + 1, win);
            const float inv = 1.0f / (float)cnt;
            const f32x4 c0 = *(LAS f32x4*)(V + base * 256 + c8), c1 = *(LAS f32x4*)(V + base * 256 + c8 + 4);
            float dd[8];
#pragma unroll
            for (int j = 0; j < 4; ++j) { dd[j] = sm[j] * inv - c0[j]; dd[4 + j] = sm[4 + j] * inv - c1[j]; }
            *(LAS v4u*)(Dt + tt * 264 + c8) = pack8(dd);
        }
        __syncthreads();
        MIX_STAMP(4);
        {
            const bf16* PW = (const bf16*)(a.ws + WS_TAB + (size_t)layer * TAB_STRIDE + TAB_PW);
            const int k = wave >> 1, fr = lane & 15, fq = lane >> 4;
            constexpr int NMT = R / 16;
            for (int mt = (NMT >= 4 ? (wave & 1) * 2 : (wave & 1)); mt < (NMT >= 4 ? (wave & 1) * 2 + 2 : ((wave & 1) == 0 ? NMT : 0)); ++mt) {
                const bf16x8 b0 = *(LAS bf16x8*)(Dt + (16 * mt + fr) * 264 + 64 * k + 8 * fq), b1 = *(LAS bf16x8*)(Dt + (16 * mt + fr) * 264 + 64 * k + 32 + 8 * fq);
#pragma unroll
                for (int ot = 0; ot < 4; ++ot) {
                    f32x4 acc = (f32x4){0.f, 0.f, 0.f, 0.f};
                    const bf16x8 a0 = *(const bf16x8*)(PW + ((size_t)(k * 64 + 16 * ot + fr)) * 64 + 8 * fq), a1 = *(const bf16x8*)(PW + ((size_t)(k * 64 + 16 * ot + fr)) * 64 + 32 + 8 * fq);
                    acc = __builtin_amdgcn_mfma_f32_16x16x32_bf16(a0, b0, acc, 0, 0, 0);
                    acc = __builtin_amdgcn_mfma_f32_16x16x32_bf16(a1, b1, acc, 0, 0, 0);
                    const int o = 64 * k + 16 * ot + 4 * fq, tt = 16 * mt + fr;
                    const f32x4 sc = *(const f32x4*)(a.in[I_POOLSC] + layer * MIXW + o);
                    v2u w; w.x = pk2(acc[0] * sc[0], acc[1] * sc[1]); w.y = pk2(acc[2] * sc[2], acc[3] * sc[3]);
                    *(v2u*)(BR + (size_t)(row0 + tt) * D + o) = w;
                }
            }
        }
        __syncthreads();
    }
    MIX_STAMP(5);
    if (stages & 4) {
        const float* scw = a.in[I_SCW] + (size_t)layer * 3 * MIXW;
#pragma unroll
        for (int it_ = 0; it_ < R * 32 / 512; ++it_) { const int idx = tid + it_ * 512;
            const int tt = idx >> 5, c8 = (idx & 31) * 8, seg = tt / L, t = tt % L;
            float z[3][8];
#pragma unroll
            for (int dj = 0; dj < 3; ++dj) { const int tp = t - 2 + dj;
                int srow = -1;
                if (SAMPLE) { if (tp >= 0) srow = MP + (q0 + seg) * 8 + tp; } else { const int tabs = c * 64 + tp; if (tabs >= 0) srow = s * SEQ + tabs; }
                if (srow >= 0) { float cg[8], hx[8]; unpack8(*(const v4u*)(PMb + (size_t)srow * PMC + 768 + c8), cg); unpack8(*(const v4u*)(PMb + (size_t)srow * PMC + 1024 + c8), hx);
#pragma unroll
                    for (int j = 0; j < 8; ++j) z[dj][j] = cg[j] * hx[j]; }
                else if (SAMPLE) { const float* st = a.in[I_STSC] + ((size_t)(layer * DB + q0 + seg) * 2 + (2 + tp)) * MIXW + c8; const f32x4 x0 = *(const f32x4*)st, x1 = *(const f32x4*)(st + 4);
                    z[dj][0] = x0[0]; z[dj][1] = x0[1]; z[dj][2] = x0[2]; z[dj][3] = x0[3]; z[dj][4] = x1[0]; z[dj][5] = x1[1]; z[dj][6] = x1[2]; z[dj][7] = x1[3]; }
                else {
#pragma unroll
                    for (int j = 0; j < 8; ++j) z[dj][j] = 0.f; } }
            float bg[8], o[8]; unpack8(*(const v4u*)(PMb + (size_t)(row0 + tt) * PMC + 512 + c8), bg);
#pragma unroll
            for (int j = 0; j < 8; ++j) o[j] = bg[j] * (scw[c8 + j] * z[0][j] + scw[MIXW + c8 + j] * z[1][j] + scw[2 * MIXW + c8 + j] * z[2][j]);
            *(v4u*)(BR + (size_t)(row0 + tt) * D + 512 + c8) = pack8(o);
            if (last && t >= L - 2) { float* dst = a.out + (SAMPLE ? O_SCS + ((size_t)(layer * DB + q0 + seg) * 2 + (t - (L - 2))) * MIXW : O_SCP + ((size_t)(layer * NB + s) * 2 + (t - (L - 2))) * MIXW) + c8;
                *(f32x4*)dst = (f32x4){z[2][0], z[2][1], z[2][2], z[2][3]}; *(f32x4*)(dst + 4) = (f32x4){z[2][4], z[2][5], z[2][6], z[2][7]}; }
        }
    }
    MIX_STAMP(6);
}

template <int MODE>
__device__ __forceinline__ void ssm_unit(const Args& a, int layer, int uidx, LAS unsigned char* lds, int tid_in, int lane_in, int wave_in) {
    int tid = tid_in; asm volatile("" : "+v"(tid));
    const int lane = tid & 63, wave = __builtin_amdgcn_readfirstlane(tid >> 6);
    const bf16* PMb = (const bf16*)(a.ws + WS_PM); bf16* BR = (bf16*)a.out;
    const unsigned char* tab = a.ws + WS_TAB + (size_t)layer * TAB_STRIDE;
    const f32x2* LB = (const f32x2*)(tab + TAB_LB); const f32x2* LP = (const f32x2*)(tab + TAB_LP);
    const bf16* BBT = (const bf16*)(tab + TAB_BBT); const bf16* CM = (const bf16*)(tab + TAB_CM);
    f32x2* E = (f32x2*)(a.ws + WS_E);
    const int s = uidx >> 5, c = uidx & 31;
    const int row0 = MODE == 2 ? MP + 64 * uidx : s * SEQ + 64 * c;
    const int fr = lane & 15, fq = lane >> 4;
    LAS float* BU = (LAS float*)(lds + wave * 8448);
    LAS bf16* Zt = (LAS bf16*)(lds + 67584);
    const bf16x8 zf = (bf16x8){0, 0, 0, 0, 0, 0, 0, 0};
    for (int gi = 0; gi < 2; ++gi) {
        const int g = 2 * wave + gi;
        const f32x2 lam = LB[g * 64 + lane]; const float nlam1 = -lam[1];
        float hr = 0.f, hi = 0.f;
        bf16x8 bb[8];
#pragma unroll
        for (int nt = 0; nt < 8; ++nt) bb[nt] = fq < 2 ? *(const bf16x8*)(BBT + ((size_t)(g * 128 + 16 * nt + fr)) * 16 + 8 * fq) : zf;
        bf16x8 cmf[4]; float dsk = 0.f;
        if (MODE >= 1) {
#pragma unroll
            for (int ks = 0; ks < 4; ++ks) cmf[ks] = *(const bf16x8*)(CM + ((size_t)(g * 16 + fr)) * 128 + 32 * ks + 8 * fq);
            dsk = a.in[I_DSKIP][layer * MIXW + 16 * g + fr]; }
        bf16x8 ufa[4];
#pragma unroll
        for (int sub = 0; sub < 4; ++sub) ufa[sub] = fq < 2 ? *(const bf16x8*)(PMb + (size_t)(row0 + 16 * sub + fr) * PMC + 256 + 16 * g + 8 * fq) : zf;
        bf16 uva[4][4];
        if (MODE >= 1) {
#pragma unroll
            for (int sub = 0; sub < 4; ++sub)
#pragma unroll
                for (int r = 0; r < 4; ++r) uva[sub][r] = PMb[(size_t)(row0 + 16 * sub + 4 * fq + r) * PMC + 256 + 16 * g + fr]; }
        if (MODE == 1) { const f32x2 lp = LP[g * 64 + lane];
            const float nlp1 = -lp[1];
#pragma unroll 1
            for (int j = 0; j < c; j += 16) { f32x2 e16[16]; const int nq = c - j;
#pragma unroll
                for (int q = 0; q < 16; ++q) if (q < nq) e16[q] = E[((size_t)(s * NCH + j + q) * 16 + g) * 64 + lane];
#pragma unroll
                for (int q = 0; q < 16; ++q) if (q < nq) { const float nr = fma_s(lp[0], hr, fma_s(nlp1, hi, e16[q][0])), ni = fma_s(lp[0], hi, fma_s(lp[1], hr, e16[q][1])); hr = nr; hi = ni; } } }
#pragma unroll
        for (int sub = 0; sub < 4; ++sub) {
            const int rowb = row0 + 16 * sub;
            const bf16x8 uf = ufa[sub];
#pragma unroll
            for (int nt = 0; nt < 8; ++nt) { const f32x4 d = __builtin_amdgcn_mfma_f32_16x16x32_bf16(uf, bb[nt], (f32x4){0.f, 0.f, 0.f, 0.f}, 0, 0, 0);
#pragma unroll
                for (int r = 0; r < 4; ++r) BU[(4 * fq + r) * 132 + 16 * nt + fr] = d[r]; }
            asm volatile("s_waitcnt lgkmcnt(0)" ::: "memory");
            {
                float bre_[16], bim_[16];
#pragma unroll
                for (int t = 0; t < 16; ++t) { bre_[t] = BU[t * 132 + lane]; bim_[t] = BU[t * 132 + 64 + lane]; }
                float sre_[2] = {0.f, 0.f}, sim_[2] = {0.f, 0.f};
                if (MODE == 2) {
#pragma unroll
                    for (int hq = 0; hq < 2; ++hq) { const int q = 8 * uidx + 2 * sub + hq; const size_t si = ((size_t)(layer * DB + q) * 16 + g) * 64 + lane; sre_[hq] = a.in[I_STRE][si]; sim_[hq] = a.in[I_STIM][si]; } }
                asm volatile("s_waitcnt lgkmcnt(0)" ::: "memory");
#pragma unroll
                for (int t = 0; t < 16; ++t) {
                    if (MODE == 2 && (t & 7) == 0) { hr = sre_[t >> 3]; hi = sim_[t >> 3]; }
                    const float nr = fma_s(lam[0], hr, fma_s(nlam1, hi, bre_[t])), ni = fma_s(lam[0], hi, fma_s(lam[1], hr, bim_[t])); hr = nr; hi = ni;
                    bre_[t] = hr; bim_[t] = hi;
                    if (MODE == 2 && (t & 7) == 7) { const int q = 8 * uidx + 2 * sub + (t >> 3); const size_t si = ((size_t)(layer * DB + q) * 16 + g) * 64 + lane; a.out[O_SRES + si] = hr; a.out[O_SIMS + si] = hi; }
                }
#pragma unroll
                for (int t = 0; t < 16; ++t) { BU[t * 132 + lane] = bre_[t]; BU[t * 132 + 64 + lane] = bim_[t]; }
            }
            if (MODE >= 1) {
                asm volatile("s_waitcnt lgkmcnt(0)" ::: "memory");
                f32x4 y = (f32x4){0.f, 0.f, 0.f, 0.f};
#pragma unroll
                for (int ks = 0; ks < 4; ++ks) { const f32x4 h0 = *(LAS f32x4*)(BU + fr * 132 + 32 * ks + 8 * fq), h1 = *(LAS f32x4*)(BU + fr * 132 + 32 * ks + 8 * fq + 4);
                    v4u hw; hw.x = pk2(h0[0], h0[1]); hw.y = pk2(h0[2], h0[3]); hw.z = pk2(h1[0], h1[1]); hw.w = pk2(h1[2], h1[3]);
                    y = __builtin_amdgcn_mfma_f32_16x16x32_bf16(__builtin_bit_cast(bf16x8, hw), cmf[ks], y, 0, 0, 0); }
#pragma unroll
                for (int r = 0; r < 4; ++r) { const int t = 4 * fq + r; const float uv = bf1(uva[sub][r]);
                    const float z = gelu_tanh(y[r] + dsk * uv);
                    Zt[(16 * sub + t) * 264 + 16 * g + fr] = (bf16)(pk2(z, 0.f) & 0xffffu); }
                asm volatile("s_waitcnt lgkmcnt(0)" ::: "memory");
            }
            if (MODE == 0) { asm volatile("s_waitcnt lgkmcnt(0)" ::: "memory"); }
        }
        if (MODE == 0) E[((size_t)(s * NCH + c) * 16 + g) * 64 + lane] = (f32x2){hr, hi};
        if (MODE == 1 && c == NCH - 1) { const size_t si = ((size_t)(layer * NB + s) * 16 + g) * 64 + lane; a.out[O_SREP + si] = hr; a.out[O_SIMP + si] = hi; }
    }
    if (MODE == 0) __syncthreads();
    if (MODE >= 1) {
        __syncthreads();
        const bf16* WG = (const bf16*)(a.ws + WS_WGLU) + (size_t)layer * MIXW * MIXW;
        f32x4 acc[4][2];
#pragma unroll
        for (int mt = 0; mt < 4; ++mt) { acc[mt][0] = (f32x4){0.f, 0.f, 0.f, 0.f}; acc[mt][1] = (f32x4){0.f, 0.f, 0.f, 0.f}; }
#pragma unroll
        for (int ks = 0; ks < 8; ++ks) {
            const bf16x8 w0 = *(const bf16x8*)(WG + (size_t)(32 * wave + fr) * MIXW + 32 * ks + 8 * fq), w1 = *(const bf16x8*)(WG + (size_t)(32 * wave + 16 + fr) * MIXW + 32 * ks + 8 * fq);
#pragma unroll
            for (int mt = 0; mt < 4; ++mt) { const bf16x8 zb = *(LAS bf16x8*)(Zt + (16 * mt + fr) * 264 + 32 * ks + 8 * fq);
                acc[mt][0] = __builtin_amdgcn_mfma_f32_16x16x32_bf16(w0, zb, acc[mt][0], 0, 0, 0);
                acc[mt][1] = __builtin_amdgcn_mfma_f32_16x16x32_bf16(w1, zb, acc[mt][1], 0, 0, 0); }
        }
#pragma unroll
        for (int nl = 0; nl < 2; ++nl) { const int n0 = 32 * wave + 16 * nl + 4 * fq; const f32x4 bgl = *(const f32x4*)(a.in[I_BGLU] + layer * MIXW + n0);
#pragma unroll
            for (int mt = 0; mt < 4; ++mt) { const int tt = 16 * mt + fr; const v2u zz = *(LAS v2u*)(Zt + tt * 264 + n0);
                const float z0 = bflo(zz.x), z1 = bfhi(zz.x), z2 = bflo(zz.y), z3 = bfhi(zz.y);
                v2u w; w.x = pk2(z0 * sigm(acc[mt][nl][0] + bgl[0]), z1 * sigm(acc[mt][nl][1] + bgl[1])); w.y = pk2(z2 * sigm(acc[mt][nl][2] + bgl[2]), z3 * sigm(acc[mt][nl][3] + bgl[3]));
                *(v2u*)(BR + (size_t)(row0 + tt) * D + 256 + n0) = w; } }
        __syncthreads();
    }
}

__device__ __forceinline__ void gemm2_phase(LAS unsigned char* lds, const bf16* BRp, const bf16* WBT, const unsigned char* GT, bf16* MG, int G, int bid, int tidp) {
    using namespace pg8;
    int tid_ = tidp; asm volatile("" : "+v"(tid_));
    const int tid = tid_, wid = __builtin_amdgcn_readfirstlane(tid >> 6), lane = tid & 63, wr = wid >> 2, wc = wid & 3, fr = lane & 15, fq = lane >> 4;
    unsigned voffA0, voffB0;
    { int R, C; stage_rc(tid * 16, R, C); const int Rb = (R & ~31) + perm32(R & 31); voffA0 = (unsigned)(R * D + C) * 2u; voffB0 = (unsigned)(Rb * MIXW + C) * 2u; }
    const unsigned ldsw = (unsigned)wid * 1024u;
    const int aoff = lds_byte(wr * 64 + fr, fq * 8), boff = lds_byte(wc * 32 + fr, fq * 8);
    const unsigned gvoff = (unsigned)(fr * GTC + 8 * fq);
    constexpr int STG = 49152;
#define G2_STAGE(it_, so_) do { const int kb_ = (it_) >> 2, kt_ = (it_) & 3; \
        const char* as_ = Abase + (size_t)(kb_ * 256 + kt_ * 64) * 2; const char* bs_ = Bbase + (size_t)kb_ * (D * MIXW * 2) + (size_t)kt_ * 128; \
        _Pragma("unroll") for (int _i = 0; _i < 2; ++_i) __builtin_amdgcn_global_load_lds((const unsigned*)(as_ + (size_t)_i * (64 * D * 2) + voffA0), (PG8_LAS unsigned*)(lds + (so_) + ldsw + _i * 8192), 16, 0, 0); \
        _Pragma("unroll") for (int _i = 0; _i < 2; ++_i) __builtin_amdgcn_global_load_lds((const unsigned*)(bs_ + (size_t)_i * (64 * MIXW * 2) + voffB0), (PG8_LAS unsigned*)(lds + (so_) + 16384 + ldsw + _i * 8192), 16, 0, 0); \
        _Pragma("unroll") for (int _i = 0; _i < 2; ++_i) __builtin_amdgcn_global_load_lds((const unsigned*)(bs_ + (size_t)(128 + 64 * _i) * MIXW * 2 + voffB0), (PG8_LAS unsigned*)(lds + (so_) + 32768 + ldsw + _i * 8192), 16, 0, 0); } while (0)
    const int vb = (G % 8 == 0) ? (bid % 8) * (G / 8) + bid / 8 : bid;
    constexpr int NUN = (MP / 128) * 4;
    const bool xmap = G == 256;
    for (int ui = xmap ? (bid & 7) * 64 + (bid >> 3) : vb; ui < NUN; ui += xmap ? ((ui & 63) < 32 ? 32 : NUN) : G) {
        const int pm = ui >> 2, pn = ui & 3;
        const char* Abase = (const char*)BRp + (size_t)pm * 128 * D * 2;
        const char* Bbase = (const char*)WBT + (size_t)pn * 256 * MIXW * 2;
        G2_STAGE(0, 0); G2_STAGE(1, STG);
        f32x4 mg[2][4][2], acc[2][4][2];
#pragma unroll
        for (int b = 0; b < 2; ++b)
#pragma unroll
            for (int m = 0; m < 4; ++m)
#pragma unroll
                for (int n = 0; n < 2; ++n) { mg[b][m][n] = (f32x4){0.f, 0.f, 0.f, 0.f}; acc[b][m][n] = (f32x4){0.f, 0.f, 0.f, 0.f}; }
        v2u gq[2][4];
        int so = 0, so2 = 2 * STG;
#pragma unroll 1
        for (int kb = 0; kb < 4; ++kb) {
#pragma unroll
            for (int kt = 0; kt < 4; ++kt) {
                if (kt < 2) asm volatile("s_waitcnt vmcnt(6)" ::: "memory");
                else if (kt == 3 && kb == 3) asm volatile("s_waitcnt vmcnt(8)" ::: "memory");
                else asm volatile("s_waitcnt vmcnt(14)" ::: "memory");
                __builtin_amdgcn_s_barrier(); asm volatile("" ::: "memory");
                if (kt < 2 || kb < 3) G2_STAGE(4 * kb + kt + 2, so2);
#pragma unroll
                for (int kk = 0; kk < 2; ++kk) {
                    bf16x8 At[4], B0[2], B1[2];
#pragma unroll
                    for (int m = 0; m < 4; ++m) At[m] = *(const PG8_LAS bf16x8*)(lds + so + aoff + m * 2048 + kk * 1024);
#pragma unroll
                    for (int n = 0; n < 2; ++n) { B0[n] = *(const PG8_LAS bf16x8*)(lds + so + 16384 + boff + n * 2048 + kk * 1024); B1[n] = *(const PG8_LAS bf16x8*)(lds + so + 32768 + boff + n * 2048 + kk * 1024); }
                    asm volatile("s_waitcnt lgkmcnt(0)" ::: "memory"); __builtin_amdgcn_sched_barrier(0);
#pragma unroll
                    for (int m = 0; m < 4; ++m)
#pragma unroll
                        for (int n = 0; n < 2; ++n) { acc[0][m][n] = __builtin_amdgcn_mfma_f32_16x16x32_bf16(B0[n], At[m], acc[0][m][n], 0, 0, 0);
                                                      acc[1][m][n] = __builtin_amdgcn_mfma_f32_16x16x32_bf16(B1[n], At[m], acc[1][m][n], 0, 0, 0); }
                }
                if (kt == 1) {
#pragma unroll
                    for (int m = 0; m < 4; ++m) { const unsigned char* gs = GT + (size_t)(pm * 128 + wr * 64 + m * 16) * GTC + kb * D + pn * 256 + wc * 32;
                        asm volatile("global_load_dwordx2 %0, %1, %2" : "=v"(gq[0][m]) : "v"(gvoff), "s"(gs) : "memory");
                        asm volatile("global_load_dwordx2 %0, %1, %2 offset:128" : "=v"(gq[1][m]) : "v"(gvoff), "s"(gs) : "memory"); }
                }
                so = so == 2 * STG ? 0 : so + STG; so2 = so2 == 2 * STG ? 0 : so2 + STG;
            }
            if (kb == 3) asm volatile("s_waitcnt vmcnt(0)" ::: "memory"); else asm volatile("s_waitcnt vmcnt(12)" ::: "memory");
            asm volatile("" : "+v"(gq[0][0]), "+v"(gq[0][1]), "+v"(gq[0][2]), "+v"(gq[0][3]), "+v"(gq[1][0]), "+v"(gq[1][1]), "+v"(gq[1][2]), "+v"(gq[1][3]));
#pragma unroll
            for (int b = 0; b < 2; ++b)
#pragma unroll
                for (int m = 0; m < 4; ++m) { const v2u q_ = gq[b][m];
#pragma unroll
                    for (int j = 0; j < 4; ++j) { mg[b][m][0][j] += (float)((q_.x >> (8 * j)) & 0xffu) * acc[b][m][0][j]; mg[b][m][1][j] += (float)((q_.y >> (8 * j)) & 0xffu) * acc[b][m][1][j]; }
                    acc[b][m][0] = (f32x4){0.f, 0.f, 0.f, 0.f}; acc[b][m][1] = (f32x4){0.f, 0.f, 0.f, 0.f}; }
        }
        asm volatile("" ::: "memory"); __builtin_amdgcn_s_barrier(); asm volatile("" ::: "memory");
#pragma unroll
        for (int b = 0; b < 2; ++b)
#pragma unroll
            for (int m = 0; m < 4; ++m) { const int row = pm * 128 + wr * 64 + m * 16 + fr, col = pn * 256 + b * 128 + wc * 32 + 8 * fq;
                const f32x4 m0 = mg[b][m][0] * (1.0f / 255.0f), m1 = mg[b][m][1] * (1.0f / 255.0f);
                v4u w; w.x = pk2(m0[0], m0[1]); w.y = pk2(m0[2], m0[3]); w.z = pk2(m1[0], m1[1]); w.w = pk2(m1[2], m1[3]);
                *(v4u*)(MG + (size_t)row * D + col) = w; }
    }
#undef G2_STAGE
}


#define TL_GLDS(src_, dst_) __builtin_amdgcn_global_load_lds((const unsigned*)(src_), (PG8_LAS unsigned*)(dst_), 16, 0, 0)
#define TL_STAGE(kt_, A_PTR, B_PTR) do { const int s_ = (kt_) & 3; const char* ap_ = A_PTR(kt_); const char* bp_ = B_PTR(kt_); \
        TL_GLDS(ap_ + voffA, lds + s_ * 32768 + ldsw); TL_GLDS(ap_ + voffA + 128, lds + s_ * 32768 + 8192 + ldsw); \
        TL_GLDS(bp_ + voffB, lds + s_ * 32768 + 16384 + ldsw); TL_GLDS(bp_ + voffB + 128, lds + s_ * 32768 + 24576 + ldsw); } while (0)
#define TL_LOOP(NK, A_PTR, B_PTR, AFTER_STEP) do { \
        TL_STAGE(0, A_PTR, B_PTR); if ((NK) > 1) TL_STAGE(1, A_PTR, B_PTR); if ((NK) > 2) TL_STAGE(2, A_PTR, B_PTR); \
        _Pragma("unroll 1") for (int kt = 0; kt < (NK); ++kt) { \
            if (kt + 2 < (NK)) asm volatile("s_waitcnt vmcnt(8)" ::: "memory"); else if (kt + 1 < (NK)) asm volatile("s_waitcnt vmcnt(4)" ::: "memory"); else asm volatile("s_waitcnt vmcnt(0)" ::: "memory"); \
            __builtin_amdgcn_s_barrier(); asm volatile("" ::: "memory"); \
            if (kt + 3 < (NK)) TL_STAGE(kt + 3, A_PTR, B_PTR); \
            const int sb_ = (kt & 3) * 32768; \
            _Pragma("unroll") for (int h_ = 0; h_ < 2; ++h_) { \
                const bf16x8 a0 = *(const PG8_LAS bf16x8*)(lds + sb_ + h_ * 8192 + aoff), a1 = *(const PG8_LAS bf16x8*)(lds + sb_ + h_ * 8192 + aoff + 1024); \
                const bf16x8 b00 = *(const PG8_LAS bf16x8*)(lds + sb_ + 16384 + h_ * 8192 + boff), b01 = *(const PG8_LAS bf16x8*)(lds + sb_ + 16384 + h_ * 8192 + boff + 1024); \
                const bf16x8 b10 = *(const PG8_LAS bf16x8*)(lds + sb_ + 16384 + h_ * 8192 + boff + 2048), b11 = *(const PG8_LAS bf16x8*)(lds + sb_ + 16384 + h_ * 8192 + boff + 3072); \
                asm volatile("s_waitcnt lgkmcnt(0)" ::: "memory"); __builtin_amdgcn_sched_barrier(0); \
                acc[0] = __builtin_amdgcn_mfma_f32_16x16x32_bf16(b00, a0, acc[0], 0, 0, 0); acc[1] = __builtin_amdgcn_mfma_f32_16x16x32_bf16(b10, a0, acc[1], 0, 0, 0); \
                acc[0] = __builtin_amdgcn_mfma_f32_16x16x32_bf16(b01, a1, acc[0], 0, 0, 0); acc[1] = __builtin_amdgcn_mfma_f32_16x16x32_bf16(b11, a1, acc[1], 0, 0, 0); } \
            AFTER_STEP(kt); } \
        asm volatile("s_waitcnt lgkmcnt(0)" ::: "memory"); __builtin_amdgcn_s_barrier(); asm volatile("" ::: "memory"); } while (0)
#define TL_SETUP(LDA, LDB) using namespace pg8; int tid_ = tidp; asm volatile("" : "+v"(tid_)); \
    const int tid = tid_, wid = __builtin_amdgcn_readfirstlane(tid >> 6), lane = tid & 63, fr = lane & 15, fq = lane >> 4, mt = wid >> 1, nh = wid & 1; \
    int R_, C_; stage_rc(tid * 16, R_, C_); \
    const unsigned voffA = (unsigned)(R_ * (LDA) + C_) * 2u, voffB = (unsigned)(R_ * (LDB) + C_) * 2u, ldsw = (unsigned)wid * 1024u; \
    const int aoff = lds_byte(mt * 16 + fr, fq * 8), boff = lds_byte(nh * 32 + fr, fq * 8); (void)lane
#define TL_NOP(kt_) do {} while (0)

struct CappedOrder : pg8::StaticOrder {
    int cap;
    __device__ bool next(int i, pg8::Unit& u) const { if ((long)i * G + c >= cap) return false; return pg8::StaticOrder::next(i, u); }
};
__device__ __forceinline__ void proj_tail_phase(LAS unsigned char* lds, const bf16* A, const bf16* Bt, int cap, const float* ssq, const float* bgate, bf16* PMp, unsigned char* GTp, int G, int bid, int tidp, unsigned* qctr) {
    TL_SETUP(D, D);
    StaticOrder S1; S1.init(M, INC, 1, 0);
    const int nsub = (S1.nwg - cap) * 16;
    volatile LAS int* qslot = (volatile LAS int*)(lds + MISC_OFF + 192);
    for (int t = bid; t < nsub; ) {
        Unit u; S1.next(cap + (t >> 4), u);
        const int rb = (t >> 2) & 3, cb = t & 3, r0 = u.pm * 256 + 64 * rb, c0 = u.pn * 256 + 64 * cb;
        const char* Ab = (const char*)A + (size_t)r0 * D * 2; const char* Bb = (const char*)Bt + (size_t)c0 * D * 2;
        f32x4 acc[2] = {(f32x4){0.f, 0.f, 0.f, 0.f}, (f32x4){0.f, 0.f, 0.f, 0.f}};
        const int row = r0 + 16 * mt + fr;
        const float rs = pg8::row_rstd(ssq, row);
        const bool isg = u.pn >= 7;
        f32x4 bvv[2];
#pragma unroll
        for (int n = 0; n < 2; ++n) bvv[n] = isg ? *(const f32x4*)(bgate + (c0 + 32 * nh + 16 * n + 4 * fq - PMC)) : (f32x4){0.f, 0.f, 0.f, 0.f};
#define PT_A(kt_) (Ab + (size_t)(kt_) * 256)
#define PT_B(kt_) (Bb + (size_t)(kt_) * 256)
        TL_LOOP(D / 128, PT_A, PT_B, TL_NOP);
#undef PT_A
#undef PT_B
        unsigned got = 0u;
        if (tid == 0) got = __hip_atomic_fetch_add(qctr, 1u, __ATOMIC_RELAXED, __HIP_MEMORY_SCOPE_AGENT);
#pragma unroll
        for (int n = 0; n < 2; ++n) { const int col = c0 + 32 * nh + 16 * n + 4 * fq; f32x4 v = acc[n] * rs;
            if (isg) { const f32x4 tt = (v + bvv[n]) * -1.4426950408889634f;
                *(unsigned*)(GTp + (size_t)row * GTC + (col - PMC)) = pg8::pack_u8x4(pg8::sig255(tt[0]), pg8::sig255(tt[1]), pg8::sig255(tt[2]), pg8::sig255(tt[3])); }
            else { v2u w; w.x = pk2(v[0], v[1]); w.y = pk2(v[2], v[3]); *(v2u*)(PMp + (size_t)row * PMC + col) = w; } }
        if (tid == 0) *qslot = G + (int)got;
        __syncthreads();
        t = *qslot;
        __syncthreads();
    }
}

__device__ __forceinline__ void gemm2_tail_phase(LAS unsigned char* lds, const bf16* BRp, const bf16* WBT, const unsigned char* GT, bf16* MG, int G, int bid, int tidp) {
    TL_SETUP(D, MIXW);
    for (int ui = bid; ui < 256; ui += G) {
        const int rb = ((ui & 7) >> 1) * 4 + (ui >> 6), cb = (ui & 1) * 8 + ((ui >> 3) & 7);
        const char* Ab = (const char*)BRp + (size_t)(MP + 64 * rb) * D * 2; const char* Bb = (const char*)WBT + (size_t)(64 * cb) * MIXW * 2;
        f32x4 acc[2] = {(f32x4){0.f, 0.f, 0.f, 0.f}, (f32x4){0.f, 0.f, 0.f, 0.f}}, mg[2] = {(f32x4){0.f, 0.f, 0.f, 0.f}, (f32x4){0.f, 0.f, 0.f, 0.f}};
        const int row = MP + 64 * rb + 16 * mt + fr;
#define G2T_A(kt_) (Ab + (size_t)(((kt_) >> 1) * 256 + ((kt_) & 1) * 128) * 2)
#define G2T_B(kt_) (Bb + (size_t)((kt_) >> 1) * (D * MIXW * 2) + (size_t)((kt_) & 1) * 256)
        unsigned gwp[4][2];
#pragma unroll
        for (int kb = 0; kb < 4; ++kb)
#pragma unroll
            for (int n = 0; n < 2; ++n) gwp[kb][n] = *(const unsigned*)(GT + (size_t)row * GTC + kb * D + 64 * cb + 32 * nh + 16 * n + 4 * fq);
#define G2T_AFTER(kt_) do { if ((kt_) & 1) { const int kb_ = (kt_) >> 1; \
            _Pragma("unroll") for (int n = 0; n < 2; ++n) { const unsigned gw = kb_ == 0 ? gwp[0][n] : (kb_ == 1 ? gwp[1][n] : (kb_ == 2 ? gwp[2][n] : gwp[3][n])); \
                mg[n][0] += (float)(gw & 0xffu) * acc[n][0]; mg[n][1] += (float)((gw >> 8) & 0xffu) * acc[n][1]; mg[n][2] += (float)((gw >> 16) & 0xffu) * acc[n][2]; mg[n][3] += (float)(gw >> 24) * acc[n][3]; \
                acc[n] = (f32x4){0.f, 0.f, 0.f, 0.f}; } } } while (0)
        TL_LOOP(8, G2T_A, G2T_B, G2T_AFTER);
#undef G2T_A
#undef G2T_B
#undef G2T_AFTER
#pragma unroll
        for (int n = 0; n < 2; ++n) { const f32x4 mm = mg[n] * (1.0f / 255.0f); v2u w; w.x = pk2(mm[0], mm[1]); w.y = pk2(mm[2], mm[3]); *(v2u*)(MG + (size_t)row * D + 64 * cb + 32 * nh + 16 * n + 4 * fq) = w; }
    }
}

__device__ __forceinline__ void resid_tail_phase(LAS unsigned char* lds, const bf16* A, const bf16* Bt, int K, bf16* XBp, float* ssq, int G, int bid, int tidp) {
    TL_SETUP(K, K);
    const int nk = K / 128;
    for (int ui = bid; ui < 256; ui += G) {
        const int rb = ((ui & 7) >> 1) * 4 + (ui >> 6), cb = (ui & 1) * 8 + ((ui >> 3) & 7);
        const char* Ab = (const char*)A + (size_t)(MP + 64 * rb) * K * 2; const char* Bb = (const char*)Bt + (size_t)(64 * cb) * K * 2;
        f32x4 acc[2] = {(f32x4){0.f, 0.f, 0.f, 0.f}, (f32x4){0.f, 0.f, 0.f, 0.f}};
        const int rowl = 16 * mt + fr, row = MP + 64 * rb + rowl; float ss = 0.f;
        f32x4 xold[2];
#pragma unroll
        for (int n = 0; n < 2; ++n) { const int col = 64 * cb + 32 * nh + 16 * n + 4 * fq;
            const v2u q = *(const v2u*)(XBp + (size_t)row * D + col); xold[n] = (f32x4){bflo(q.x), bfhi(q.x), bflo(q.y), bfhi(q.y)}; }
#define RT_A(kt_) (Ab + (size_t)(kt_) * 256)
#define RT_B(kt_) (Bb + (size_t)(kt_) * 256)
        TL_LOOP(nk, RT_A, RT_B, TL_NOP);
#undef RT_A
#undef RT_B
#pragma unroll
        for (int n = 0; n < 2; ++n) { const int col = 64 * cb + 32 * nh + 16 * n + 4 * fq;
            const f32x4 o = xold[n] + acc[n];
            v2u w; w.x = pk2(o[0], o[1]); w.y = pk2(o[2], o[3]); *(v2u*)(XBp + (size_t)row * D + col) = w;
            ss += (o[0] * o[0] + o[1] * o[1]) + (o[2] * o[2] + o[3] * o[3]); }
        ss += __shfl_xor(ss, 16); ss += __shfl_xor(ss, 32);
        LAS float* red = (LAS float*)lds;
        if (fq == 0) red[rowl * 2 + nh] = ss;
        __syncthreads();
        if (tid < 64) ssq[((size_t)(cb >> 2) * M + MP + 64 * rb + tid) * 4 + (cb & 3)] = red[tid * 2] + red[tid * 2 + 1];
        __syncthreads();
    }
}

#ifndef PROBE_REP_B
#define PROBE_REP_B 1
#endif
#ifndef PROBE_REP_C
#define PROBE_REP_C 1
#endif
#ifndef PROBE_REP_D
#define PROBE_REP_D 1
#endif
#ifndef PROBE_REP_P0
#define PROBE_REP_P0 1
#endif
__global__ void __launch_bounds__(NWAVES * 64, 2) hybrid_fwd(Args args) {
    extern __shared__ __attribute__((aligned(16))) unsigned char lds_raw[];
    LAS unsigned char* lds = (LAS unsigned char*)lds_raw;
    volatile LAS unsigned* MISC = (volatile LAS unsigned*)(lds + MISC_OFF);
    const int tid0 = threadIdx.x, wave0 = __builtin_amdgcn_readfirstlane(tid0 >> 6);
    const int G0 = gridDim.x, bid = blockIdx.x;
    unsigned char* ws = args.ws;
    for (int u = tid0; u < (LDS_BYTES - LDSCTL_OFF) / 4; u += NWAVES * 64) ((LAS unsigned*)(lds + LDSCTL_OFF))[u] = 0u;
    __syncthreads();
    const int lo = args.ph_lo, hi = args.ph_hi;
    XcdBarrier bar; bar.bar = (unsigned*)(ws + WS_CTL) + CW_BAR; bar.x = 0; bar.st = nullptr;
    if (hi - lo > 1) bar = xcd_barrier_post((unsigned*)(ws + WS_CTL) + CW_BAR, MISC + 8);
    bf16* XB = (bf16*)(ws + WS_ACT1); bf16* PMb = (bf16*)(ws + WS_PM); unsigned char* GTb = ws + WS_GT;
    bf16* MGb = (bf16*)(ws + WS_PM); bf16* ACTb = (bf16*)(ws + WS_GT);
    float* ssq = (float*)(ws + WS_SSQ);
    for (int ph_i = lo; ph_i < hi; ++ph_i) {
#ifdef DBG_T_PH
        if (bid == DBG_T_BLK && wave0 == 0 && __builtin_amdgcn_mbcnt_lo(~0u, 0u) == 0u) ((volatile LAS unsigned*)(lds + MISC_OFF + 200))[0] = (ph_i == DBG_T_PH) ? 1u : 0u;
        if (ph_i == DBG_T_PH && bid == DBG_T_BLK && wave0 == 0 && __builtin_amdgcn_mbcnt_lo(~0u, 0u) == 0u) { ((volatile LAS unsigned long long*)(lds + MISC_OFF + 256))[0] = __builtin_amdgcn_s_memtime(); ((volatile LAS unsigned long long*)(lds + MISC_OFF + 256))[1] = __builtin_amdgcn_s_memrealtime(); }
#endif
        int ph = ph_i, G = G0; asm volatile("" : "+s"(ph), "+s"(G));
        unsigned z_ = 0u; asm volatile("" : "+v"(z_));
        int tid = wave0 * 64 + (int)__builtin_amdgcn_mbcnt_hi(~0u, __builtin_amdgcn_mbcnt_lo(~0u, z_)); asm volatile("" : "+v"(tid)); const int lane = tid & 63, wave = __builtin_amdgcn_readfirstlane(tid >> 6);
        const int layer = (ph - 1) / 7, k = ph == 0 ? -1 : (ph == NPHASE - 1 ? 7 : (ph - 1) % 7);
        if (k == -1) for (int rep_ = 0; rep_ < PROBE_REP_P0; ++rep_) p0_prologue(args, lds, tid, lane, wave, G, bid);
        else if (k == 7) final_norm(args, lane, wave, G, bid);
        else if (k == 0) {
            pg8::Gemm g{XB, (const bf16*)(ws + WS_WIN) + (size_t)layer * INC * D, M, INC, D}; CappedOrder S; S.init(M, INC, G, bid); S.cap = (S.nwg / G) * G;
            pg8::EpiProj E{PMb, GTb, ssq, args.in[I_BGATE] + (size_t)layer * GTC, (const LAS float*)(lds + RING_OFF + pg8::RSTD_LDS_OFF)};
            pg8::gemm_phase<pg8::EpiProj, CappedOrder, true, true>(lds + RING_OFF, g, S, E, tid);
            proj_tail_phase(lds + RING_OFF, XB, (const bf16*)(ws + WS_WIN) + (size_t)layer * INC * D, S.cap, ssq, args.in[I_BGATE] + (size_t)layer * GTC, PMb, GTb, G, bid, tid, (unsigned*)(ws + WS_CTL) + CW_Q + 64 * layer);
#ifdef PROBE_A_SAME
            { SameTileOrder S2; S2.init(M, INC, G, bid); pg8::EpiNull EN_; pg8::gemm_phase<pg8::EpiNull, SameTileOrder, true, true>(lds + RING_OFF, g, S2, EN_, tid); }
#endif
#ifdef PROBE_A_NULL
            { pg8::EpiNull EN_; pg8::gemm_phase<pg8::EpiNull, CappedOrder, true, true>(lds + RING_OFF, g, S, EN_, tid); }
#endif
#ifdef PROBE_A_FULL
            pg8::gemm_phase<pg8::EpiProj, CappedOrder, true, true>(lds + RING_OFF, g, S, E, tid);
#endif
        } else if (k == 1) for (int rep_ = 0; rep_ < PROBE_REP_B; ++rep_) {
            for (int s_ = 0; ; ++s_) { int u; bool donor = false;
                if (G == 256) { if (s_ > 2) break;
                    donor = bid < 16 || (bid >= 80 && bid < 152);
                    if (s_ == 0) u = 272 + ((bid + 240) & 255);
                    else if (bid < 16) { if (s_ == 2) break; u = 256 + bid; }
                    else if (bid < 80) { if (s_ == 2) break; u = 528 + (bid - 16); }
                    else if (s_ == 1 || bid < 152) { const int v = (s_ == 1 ? 0 : 176) + (bid - 80); u = (v / 31) * 32 + v % 31; }
                    else if (bid < 240) { const int t_ = bid - 152, db = t_ < 16 ? t_ : 80 + (t_ - 16); u = 592 + ((db + 240) & 255); }
                    else break; }
                else { u = bid + s_ * G; if (u >= 256 + 16 + 256 + 64) break; }
                if (u < 256) { if ((u & 31) != NCH - 1) ssm_unit<0>(args, layer, u, lds, tid, lane, wave); }
                else if (u < 272) ssm_unit<2>(args, layer, u - 256, lds, tid, lane, wave);
                else if (u < 528 || u >= 592) mix_unit<false>(args, layer, u < 528 ? u - 272 : u - 592, lds, tid, lane, wave, u >= 592 ? 4 : (donor ? 3 : 7));
                else mix_unit<true>(args, layer, u - 528, lds, tid, lane, wave, 7);
            }
        } else if (k == 2) for (int rep_ = 0; rep_ < PROBE_REP_C; ++rep_) {
            for (int u = bid; u < 256; u += G) ssm_unit<1>(args, layer, u, lds, tid, lane, wave);
        } else if (k == 3) for (int rep_ = 0; rep_ < PROBE_REP_D; ++rep_) {
            gemm2_phase(lds + RING_OFF, (const bf16*)args.out, (const bf16*)(ws + WS_WBR) + (size_t)layer * 4 * D * MIXW, GTb, MGb, G, bid, tid);
            gemm2_tail_phase(lds + RING_OFF, (const bf16*)args.out, (const bf16*)(ws + WS_WBR) + (size_t)layer * 4 * D * MIXW, GTb, MGb, G, bid, tid);
        } else if (k == 5) {
            pg8::Gemm g{XB, (const bf16*)(ws + WS_WFI) + (size_t)layer * 2 * FF * D, M, 2 * FF, D}; pg8::StaticOrder S; S.init(M, 2 * FF, G, bid);
            pg8::EpiSwiGLU E{ACTb, ssq, (const LAS float*)(lds + RING_OFF + pg8::RSTD_LDS_OFF)};
            pg8::gemm_phase<pg8::EpiSwiGLU, pg8::StaticOrder, true, true>(lds + RING_OFF, g, S, E, tid);
            if (!MK_PER_PHASE && G == 256 && bid >= P0_F_BID0 && layer + 1 < NLAYER) p0_idle_items(args, lds, lane, wave, bid, layer + 1, p0_items_A(G), P0_F_BID0, P0_F_PER);
        } else {
            const bool isE = k == 4; const int K = isE ? D : FF;
            const bf16* Ap = isE ? MGb : ACTb; const bf16* Bp = isE ? (const bf16*)(ws + WS_WOUT) + (size_t)layer * D * D : (const bf16*)(ws + WS_WFO) + (size_t)layer * D * FF;
            { pg8::Gemm g{Ap, Bp, MP, D, K}; pg8::StaticOrder S; S.init(MP, D, G, bid);
              pg8::EpiResid E{XB, ssq};
              pg8::gemm_phase<pg8::EpiResid, pg8::StaticOrder, true, true>(lds + RING_OFF, g, S, E, tid); }
#ifdef DBG_T_TAIL
            if (ph == DBG_T_PH && bid == DBG_T_BLK && tid == 0) ((volatile LAS unsigned long long*)(lds + MISC_OFF + 256))[9] = __builtin_amdgcn_s_memrealtime();
#endif
            resid_tail_phase(lds + RING_OFF, Ap, Bp, K, XB, ssq, G, bid, tid);
#ifdef DBG_T_TAIL
            if (ph == DBG_T_PH && bid == DBG_T_BLK && tid == 0) ((volatile LAS unsigned long long*)(lds + MISC_OFF + 256))[10] = __builtin_amdgcn_s_memrealtime();
#endif
        }
#ifdef DBG_T_PH
        if (ph == DBG_T_PH && bid == DBG_T_BLK && tid == 0) { ((volatile LAS unsigned long long*)(lds + MISC_OFF + 256))[2] = __builtin_amdgcn_s_memtime(); ((volatile LAS unsigned long long*)(lds + MISC_OFF + 256))[3] = __builtin_amdgcn_s_memrealtime(); }
#endif
        if (ph_i + 1 < hi) {
            asm volatile("s_waitcnt vmcnt(0)" ::: "memory"); __syncthreads();
            if (tid == 0) xcd_barrier_leader(bar);
            else if (wave != 0) {
                if (k == 3 || k == 5) {
                    const char* wb = k == 3 ? (const char*)((const bf16*)(ws + WS_WOUT) + (size_t)layer * D * D) : (const char*)((const bf16*)(ws + WS_WFO) + (size_t)layer * D * FF);
                    const int rowb = k == 3 ? D * 2 : FF * 2;
                    for (int l = (((bid >> 3) * (NWAVES - 1) + (wave - 1)) << 6) + lane; l < 16384; l += ((G >> 3) * (NWAVES - 1)) << 6)
                        __builtin_amdgcn_global_load_lds((const unsigned*)(wb + (size_t)(l >> 4) * rowb + (l & 15) * 128), (LAS unsigned*)(lds + RING_OFF + pg8::RSTD_RAW_OFF + wave * 1024), 4, 0, 0);
                }
                if (!MK_PER_PHASE && k >= 0 && k < P0_SLICES && layer + 1 < NLAYER) p0_slice(args, lds, lane, wave, G, bid, layer + 1, k);
            }
            __syncthreads();
        }
#ifdef PROBE_XBAR
        if (ph_i == 8) for (int i_ = 0; i_ < PROBE_XBAR; ++i_) xcd_barrier(bar, tid == 0);
#endif
#if defined(DBG_T_PH) && defined(DBG_T_AFTERBAR)
        if (ph == DBG_T_PH && bid == DBG_T_BLK && tid == 0) { ((volatile LAS unsigned long long*)(lds + MISC_OFF + 256))[2] = __builtin_amdgcn_s_memtime(); ((volatile LAS unsigned long long*)(lds + MISC_OFF + 256))[3] = __builtin_amdgcn_s_memrealtime(); }
#endif
    }
#ifdef DBG_T_PH
    if (bid == DBG_T_BLK && wave0 == 0 && __builtin_amdgcn_mbcnt_lo(~0u, 0u) == 0u) {
        volatile LAS unsigned long long* ts_ = (volatile LAS unsigned long long*)(lds + MISC_OFF + 256);
        const unsigned long long dc = ts_[2] - ts_[0], dr = ts_[3] - ts_[1];
        unsigned long long val = DBG_T_MODE == 11 ? (ts_[16 + DBG_TB] - ts_[16 + DBG_TA]) : DBG_T_MODE == 8 ? (ts_[5] - ts_[1])   : DBG_T_MODE == 9 ? (ts_[3] - ts_[7])   : DBG_T_MODE == 10 ? (ts_[7] - ts_[5])   : DBG_T_MODE == 7 ? (ts_[10] - ts_[9])   : DBG_T_MODE == 5 ? (ts_[8] - ts_[4]) / 16ull   : DBG_T_MODE == 3 ? (ts_[6] - ts_[4]) / 16ull   : DBG_T_MODE == 4 ? (ts_[7] - ts_[5]) * 10ull   : DBG_T_MODE == 0 ? (dc * 100ull) / (dr ? dr : 1ull)      : DBG_T_MODE == 1 ? dr   : dc / 1000ull;
        const unsigned long long t0 = __builtin_amdgcn_s_memrealtime();
        while (__builtin_amdgcn_s_memrealtime() - t0 < val * 100ull) __builtin_amdgcn_s_sleep(16);
    }
#endif
}

extern "C" void kernel_launch(void* const* d_in, const int* in_sizes, int n_in, void* d_out, int out_size, void* d_ws, size_t ws_size, hipStream_t stream) {
    static int grid = 0;
    if (grid == 0) {
        if (n_in != 32 || out_size != (int)O_END || ws_size < WS_END) { fprintf(stderr, "kernel_launch: expected 32 inputs, %zu outputs, >= %zu bytes of workspace; got %d, %d, %zu; nothing launched\n", (size_t)O_END, (size_t)WS_END, n_in, out_size, ws_size); grid = -1; return; }
        int dev = 0, cus = 0, per_cu = 0;
        if (hipGetDevice(&dev) != hipSuccess || hipDeviceGetAttribute(&cus, hipDeviceAttributeMultiprocessorCount, dev) != hipSuccess) { grid = -1; return; }
        if (hipFuncSetAttribute((const void*)hybrid_fwd, hipFuncAttributeMaxDynamicSharedMemorySize, LDS_BYTES) != hipSuccess) { fprintf(stderr, "kernel_launch: hipFuncSetAttribute failed\n"); grid = -1; return; }
        if (hipOccupancyMaxActiveBlocksPerMultiprocessor(&per_cu, (const void*)hybrid_fwd, NWAVES * 64, LDS_BYTES) != hipSuccess || per_cu < 1) { fprintf(stderr, "kernel_launch: occupancy query says %d blocks per CU; nothing launched\n", per_cu); (void)hipGetLastError(); grid = -1; return; }
        grid = cus;
    }
    if (grid < 0) return;
    (void)hipMemsetAsync((char*)d_ws + WS_CTL, 0, CTL_ZERO_BYTES, stream);
    Args a{};
    for (int i = 0; i < 32; ++i) a.in[i] = (const float*)d_in[i];
    a.out = (float*)d_out; a.ws = (unsigned char*)d_ws;
#if MK_PER_PHASE
    for (int k = 0; k < NPHASE; ++k) { a.ph_lo = k; a.ph_hi = k + 1; hipLaunchKernelGGL(hybrid_fwd, dim3(grid), dim3(NWAVES * 64), LDS_BYTES, stream, a); }
#else
    a.ph_lo = 0; a.ph_hi = NPHASE;
    hipLaunchKernelGGL(hybrid_fwd, dim3(grid), dim3(NWAVES * 64), LDS_BYTES, stream, a);
#endif
}
```

```cpp
#include <hip/hip_runtime.h>
#include <cstdio>
#include <cstdint>
#ifndef XPF_LEAD
#define XPF_LEAD 2
#endif
namespace pg8 {
#define PG8_LAS __attribute__((address_space(3)))
typedef unsigned short bf16_t;
typedef short bf16x8 __attribute__((ext_vector_type(8)));
typedef float f32x4 __attribute__((ext_vector_type(4)));
typedef unsigned u32x4 __attribute__((ext_vector_type(4)));
constexpr int BM = 256, BK = 64, HALF = 128, HTB = HALF * BK * 2  , STAGE_BYTES = 8 * HTB, NXCD = 8, WGM = 8, RSTD_LDS_OFF = 147456 + 320 + 1024  , RSTD_RAW_OFF = RSTD_LDS_OFF + 1024  , BIAS_LDS_OFF = RSTD_RAW_OFF + 8192  ;

__host__ __device__ __forceinline__ int lds_byte(int r, int c) { const int st = (r >> 4) * 2 + (c >> 5), rr = r & 15, cc = c & 31, ob = rr * 64 + cc * 2; return st * 1024 + (ob ^ (((ob >> 9) & 1) << 5)); }
__host__ __device__ __forceinline__ void stage_rc(int b, int& R, int& C) { const int st = b / 1024, sb = b % 1024, swz = sb ^ (((sb >> 9) & 1) << 5); R = (st >> 1) * 16 + swz / 64; C = (st & 1) * 32 + (swz % 64) / 2; }
__host__ __device__ __forceinline__ int perm32(int rho) { const int n = rho >> 4, i = rho & 15; return 8 * (i >> 2) + 4 * n + (i & 3); }

struct Unit { int pm, pn; };
struct Gemm { const bf16_t* A; const bf16_t* Bt; int M, N, K; };

struct StaticOrder {
    int nM, nN, nwg, G, c;
    __host__ __device__ void init(int M, int N, int G_, int c_) { nM = M / BM; nN = N / BM; nwg = nM * nN; G = G_; c = c_; }
    __host__ __device__ bool next(int i, Unit& u) const {
        const long L = (long)i * G + c; if (L >= nwg) return false;
        int wgid = (int)L; { const int q = nwg / NXCD, r = nwg % NXCD, xcd = wgid % NXCD, off = wgid / NXCD; wgid = (xcd < r ? xcd * (q + 1) : r * (q + 1) + (xcd - r) * q) + off; }
        const int nig = WGM * nN, gid = wgid / nig, fm = gid * WGM, gsz = (nM - fm) < WGM ? (nM - fm) : WGM;
        u.pm = fm + ((wgid % nig) % gsz); u.pn = (wgid % nig) / gsz; return true;
    }
    __device__ __forceinline__ void a_ready(const Unit&) const {}
    __device__ __forceinline__ void done(const Unit&) const {}
};
typedef float f32x2 __attribute__((ext_vector_type(2)));
typedef __bf16 bf16x2_t __attribute__((ext_vector_type(2)));
__device__ __forceinline__ unsigned cvt_pk_bf16(float lo, float hi) { f32x2 v = {lo, hi}; bf16x2_t b = __builtin_convertvector(v, bf16x2_t); return __builtin_bit_cast(unsigned, b); }
__device__ __forceinline__ float sigm(float x) { return __builtin_amdgcn_rcpf(1.0f + __builtin_amdgcn_exp2f(-1.4426950408889634f * x)); }
__device__ __forceinline__ float row_rstd(const float* ssq, int row) {
    const f32x4 a = *(const f32x4*)(ssq + ((size_t)0 * 17408 + row) * 4), b = *(const f32x4*)(ssq + ((size_t)1 * 17408 + row) * 4),
                c = *(const f32x4*)(ssq + ((size_t)2 * 17408 + row) * 4), d = *(const f32x4*)(ssq + ((size_t)3 * 17408 + row) * 4);
    const float s = (((a[0] + a[1]) + (a[2] + a[3])) + ((b[0] + b[1]) + (b[2] + b[3]))) + (((c[0] + c[1]) + (c[2] + c[3])) + ((d[0] + d[1]) + (d[2] + d[3])));
    return __builtin_amdgcn_rsqf(s * (1.0f / 1024.0f) + 1e-6f);
}
__device__ __forceinline__ void rows_rstd(const float* ssq, int row0, int fq, float (&rs)[2][4]) {
#pragma unroll
    for (int ai = 0; ai < 2; ++ai)
#pragma unroll
        for (int m = 0; m < 4; ++m) { const f32x4 p = *(const f32x4*)(ssq + ((size_t)fq * 17408 + row0 + ai * HALF + m * 16) * 4); rs[ai][m] = (p[0] + p[1]) + (p[2] + p[3]); }
#pragma unroll
    for (int ai = 0; ai < 2; ++ai)
#pragma unroll
        for (int m = 0; m < 4; ++m) { float s = rs[ai][m]; s += __shfl_xor(s, 16); s += __shfl_xor(s, 32); rs[ai][m] = __builtin_amdgcn_rsqf(s * (1.0f / 1024.0f) + 1e-6f); }
}
__device__ __forceinline__ void rows_rstd_lds(const PG8_LAS float* rl, int r0, float (&rs)[2][4]) {
#pragma unroll
    for (int ai = 0; ai < 2; ++ai)
#pragma unroll
        for (int m = 0; m < 4; ++m) rs[ai][m] = rl[r0 + ai * HALF + m * 16];
}
struct EpiNull {
    static constexpr bool PERM = true, AFTER_DRAIN = false, RSTD_LDS = false, XPREFETCH = false;
    __device__ __forceinline__ void operator()(const f32x4 (&acc)[2][2][4][2], const Unit& u, int wr, int wc, int fr, int fq) const {
#pragma unroll
        for (int ai = 0; ai < 2; ++ai)
#pragma unroll
            for (int bj = 0; bj < 2; ++bj)
#pragma unroll
                for (int m = 0; m < 4; ++m) { asm volatile("" :: "v"(acc[ai][bj][m][0]), "v"(acc[ai][bj][m][1])); }
    }
};
__device__ __forceinline__ unsigned pack_u8x4(float a, float b, float c, float d) {
    unsigned w = 0u; w = __builtin_amdgcn_cvt_pk_u8_f32(a, 0u, w); w = __builtin_amdgcn_cvt_pk_u8_f32(b, 1u, w); w = __builtin_amdgcn_cvt_pk_u8_f32(c, 2u, w); w = __builtin_amdgcn_cvt_pk_u8_f32(d, 3u, w); return w; }
__device__ __forceinline__ float sig255(float t) { return __builtin_amdgcn_rcpf(__builtin_fmaf(__builtin_amdgcn_exp2f(t), 1.0f / 255.0f, 1.0f / 255.0f)); }
struct EpiProj {
    static constexpr bool PERM = true, AFTER_DRAIN = false, RSTD_LDS = true, XPREFETCH = false;
    bf16_t* PM; unsigned char* GT; const float* ssq; const float* bgate; const PG8_LAS float* rl;
    __device__ __forceinline__ void operator()(const f32x4 (&acc)[2][2][4][2], const Unit& u, int wr, int wc, int fr, int fq) const {
        const int row0 = u.pm * BM + wr * 64 + fr;
        float rsv[2][4]; rows_rstd_lds(rl, wr * 64 + fr, rsv);
        if (u.pn >= 7) {
            constexpr float NL2E = -1.4426950408889634f;
            const int lc0 = (u.pn - 7) * BM + wc * 32 + 8 * fq;
            f32x4 bv[2][2];
#pragma unroll
            for (int bj = 0; bj < 2; ++bj)
#pragma unroll
                for (int n = 0; n < 2; ++n) bv[bj][n] = *(const f32x4*)(bgate + lc0 + bj * HALF + 4 * n) * NL2E;
#pragma unroll
            for (int ai = 0; ai < 2; ++ai)
#pragma unroll
                for (int m = 0; m < 4; ++m) { const int row = row0 + ai * HALF + m * 16;
                    const float rs = rsv[ai][m] * NL2E;
                    unsigned char* rowp = GT + (size_t)row * 4096 + lc0;
#pragma unroll
                    for (int bj = 0; bj < 2; ++bj) { const f32x4 v0 = acc[ai][bj][m][0] * rs + bv[bj][0], v1 = acc[ai][bj][m][1] * rs + bv[bj][1];
                        typedef unsigned u32x2_t __attribute__((ext_vector_type(2)));
                        u32x2_t w; w.x = pack_u8x4(sig255(v0[0]), sig255(v0[1]), sig255(v0[2]), sig255(v0[3])); w.y = pack_u8x4(sig255(v1[0]), sig255(v1[1]), sig255(v1[2]), sig255(v1[3]));
                        *(u32x2_t*)(rowp + bj * HALF) = w; } }
        } else {
            const int lc0 = u.pn * BM + wc * 32 + 8 * fq;
#pragma unroll
            for (int ai = 0; ai < 2; ++ai)
#pragma unroll
                for (int m = 0; m < 4; ++m) { const int row = row0 + ai * HALF + m * 16;
                    const float rs = rsv[ai][m];
                    bf16_t* rowp = PM + (size_t)row * 1792 + lc0;
#pragma unroll
                    for (int bj = 0; bj < 2; ++bj) { const f32x4 v0 = acc[ai][bj][m][0] * rs, v1 = acc[ai][bj][m][1] * rs;
                        u32x4 w; w.x = cvt_pk_bf16(v0[0], v0[1]); w.y = cvt_pk_bf16(v0[2], v0[3]); w.z = cvt_pk_bf16(v1[0], v1[1]); w.w = cvt_pk_bf16(v1[2], v1[3]);
                        *(u32x4*)(rowp + bj * HALF) = w; } }
        }
    }
};
struct EpiResid {
    static constexpr bool PERM = true, AFTER_DRAIN = false, RSTD_LDS = false, XPREFETCH = true;
    bf16_t* XB; float* ssq;
    __device__ __forceinline__ void prefetch(const Unit& u, PG8_LAS unsigned char* dump, int tid) const {
        const unsigned vo = (unsigned)(tid >> 2) * 2048u + (unsigned)(tid & 3) * 128u;
        const char* base = (const char*)(XB + (size_t)u.pm * BM * 1024 + u.pn * BM);
        __builtin_amdgcn_global_load_lds((const unsigned*)(base + vo), (PG8_LAS unsigned*)dump, 4, 0, 0);
        __builtin_amdgcn_global_load_lds((const unsigned*)(base + (size_t)128 * 2048 + vo), (PG8_LAS unsigned*)dump, 4, 0, 0);
    }
    __device__ __forceinline__ void operator()(const f32x4 (&acc)[2][2][4][2], const Unit& u, int wr, int wc, int fr, int fq) const {
        const int row0 = u.pm * BM + wr * 64 + fr, col0 = u.pn * BM + wc * 32 + 8 * fq;
#pragma unroll
        for (int ai = 0; ai < 2; ++ai)
#pragma unroll
            for (int m = 0; m < 4; ++m) { const int row = row0 + ai * HALF + m * 16;
                bf16_t* dstb = XB + (size_t)row * 1024 + col0; float ss = 0.f;
                f32x4 x0[2], x1[2];
                {
#pragma unroll
                    for (int bj = 0; bj < 2; ++bj) { const u32x4 q = *(const u32x4*)(dstb + bj * HALF);
                        x0[bj] = (f32x4){__builtin_bit_cast(float, q.x << 16), __builtin_bit_cast(float, q.x & 0xffff0000u), __builtin_bit_cast(float, q.y << 16), __builtin_bit_cast(float, q.y & 0xffff0000u)};
                        x1[bj] = (f32x4){__builtin_bit_cast(float, q.z << 16), __builtin_bit_cast(float, q.z & 0xffff0000u), __builtin_bit_cast(float, q.w << 16), __builtin_bit_cast(float, q.w & 0xffff0000u)}; } }
#pragma unroll
                for (int bj = 0; bj < 2; ++bj) { const f32x4 o0 = x0[bj] + acc[ai][bj][m][0], o1 = x1[bj] + acc[ai][bj][m][1];
                    u32x4 w; w.x = cvt_pk_bf16(o0[0], o0[1]); w.y = cvt_pk_bf16(o0[2], o0[3]); w.z = cvt_pk_bf16(o1[0], o1[1]); w.w = cvt_pk_bf16(o1[2], o1[3]);
                    *(u32x4*)(dstb + bj * HALF) = w;
                    ss += ((o0[0] * o0[0] + o0[1] * o0[1]) + (o0[2] * o0[2] + o0[3] * o0[3])) + ((o1[0] * o1[0] + o1[1] * o1[1]) + (o1[2] * o1[2] + o1[3] * o1[3])); }
                ss += __shfl_xor(ss, 16); ss += __shfl_xor(ss, 32);
                if (fq == 0) ssq[((size_t)u.pn * 17408 + row) * 4 + wc] = ss; }
    }
};
struct EpiSwiGLU {
    static constexpr bool PERM = true, AFTER_DRAIN = false, RSTD_LDS = true, XPREFETCH = false;
    bf16_t* ACT; const float* ssq; const PG8_LAS float* rl;
    __device__ __forceinline__ void operator()(const f32x4 (&acc)[2][2][4][2], const Unit& u, int wr, int wc, int fr, int fq) const {
        const int row0 = u.pm * BM + wr * 64 + fr, col0 = u.pn * HALF + wc * 32 + 8 * fq;
        float rsv[2][4]; rows_rstd_lds(rl, wr * 64 + fr, rsv);
#pragma unroll
        for (int ai = 0; ai < 2; ++ai)
#pragma unroll
            for (int m = 0; m < 4; ++m) { const int row = row0 + ai * HALF + m * 16;
                const float rs = rsv[ai][m], rsn = rs * -1.4426950408889634f, rs2 = rs * rs;
                float o[8];
#pragma unroll
                for (int j = 0; j < 4; ++j) { const float a0 = acc[ai][0][m][0][j], a1 = acc[ai][0][m][1][j];
                    o[j] = (a0 * acc[ai][1][m][0][j]) * (__builtin_amdgcn_rcpf(1.0f + __builtin_amdgcn_exp2f(a0 * rsn)) * rs2); o[4 + j] = (a1 * acc[ai][1][m][1][j]) * (__builtin_amdgcn_rcpf(1.0f + __builtin_amdgcn_exp2f(a1 * rsn)) * rs2); }
                u32x4 w; w.x = cvt_pk_bf16(o[0], o[1]); w.y = cvt_pk_bf16(o[2], o[3]); w.z = cvt_pk_bf16(o[4], o[5]); w.w = cvt_pk_bf16(o[6], o[7]);
                *(u32x4*)(ACT + (size_t)row * 2816 + col0) = w; }
    }
};

template <class Epi, class Sched, bool ALIGN_EPI = false, bool SP2 = false>
__device__ __forceinline__ void gemm_phase(PG8_LAS unsigned char* lds, const Gemm g, const Sched& S, const Epi& E, int tidp) {
    int tid_ = tidp; asm volatile("" : "+v"(tid_));
    const int tid = tid_, wid = __builtin_amdgcn_readfirstlane(tid >> 6), lane = tid & 63, wr = wid >> 2, wc = wid & 3, fr = lane & 15, fq = lane >> 4;
    const int K = g.K, nt = K / BK;
    unsigned voffA[2], voffB[2];
#pragma unroll
    for (int i = 0; i < 2; ++i) { int R, C; stage_rc(tid * 16 + i * 8192, R, C); const int Rb = Epi::PERM ? ((R & ~31) + perm32(R & 31)) : R;
        voffA[i] = (unsigned)(R * K + C) * 2u; voffB[i] = (unsigned)(Rb * K + C) * 2u; }
    const size_t kstep = (size_t)(BK * 2);
    const size_t hstep = (size_t)HALF * K * 2;
    const size_t tstep = 2 * hstep;
    const unsigned ldsw = (unsigned)wid * 1024u;
    const int aoff = lds_byte(wr * 64 + fr, fq * 8), boff = lds_byte(wc * 32 + fr, fq * 8);
#define PG8_SA(b, h) (((b) * 2 + (h)) * HTB)
#define PG8_SB(b, h) ((4 + (b) * 2 + (h)) * HTB)
#define PG8_STAGE(bufoff, gbase, voff) do { _Pragma("unroll") for (int _i = 0; _i < 2; ++_i) \
        __builtin_amdgcn_global_load_lds((const unsigned*)((const char*)(gbase) + (voff)[_i]), (PG8_LAS unsigned*)(lds + (bufoff) + ldsw + _i * 8192), 16, 0, 0); } while (0)
#define PG8_LDA(dst, b, h) do { _Pragma("unroll") for (int m = 0; m < 4; ++m) _Pragma("unroll") for (int k = 0; k < 2; ++k) dst[m][k] = *(const PG8_LAS bf16x8*)(lds + PG8_SA(b, h) + aoff + m * 2048 + k * 1024); } while (0)
#define PG8_LDB(dst, b, h) do { _Pragma("unroll") for (int n = 0; n < 2; ++n) _Pragma("unroll") for (int k = 0; k < 2; ++k) dst[n][k] = *(const PG8_LAS bf16x8*)(lds + PG8_SB(b, h) + boff + n * 2048 + k * 1024); } while (0)
#define PG8_MMA(ai, bj, At, Bt) do { __builtin_amdgcn_s_setprio(1); _Pragma("unroll") for (int m = 0; m < 4; ++m) _Pragma("unroll") for (int n = 0; n < 2; ++n) _Pragma("unroll") for (int k = 0; k < 2; ++k) \
        acc[ai][bj][m][n] = __builtin_amdgcn_mfma_f32_16x16x32_bf16(Bt[n][k], At[m][k], acc[ai][bj][m][n], 0, 0, 0); __builtin_amdgcn_s_setprio(0); } while (0)
#define PG8_WAIT_V(n) asm volatile("s_waitcnt vmcnt(" #n ")" ::: "memory")
#define PG8_WAIT_L(n) asm volatile("s_waitcnt lgkmcnt(" #n ")" ::: "memory")
#define PG8_BAR __builtin_amdgcn_s_barrier()
#define PG8_SCHED __builtin_amdgcn_sched_barrier(0)
    Unit cur, nxt; int ui = 0;
    if (!S.next(0, cur)) return;
    f32x4 acc[2][2][4][2];
#pragma unroll
    for (int a = 0; a < 2; ++a)
#pragma unroll
        for (int b = 0; b < 2; ++b)
#pragma unroll
            for (int m = 0; m < 4; ++m)
#pragma unroll
                for (int n = 0; n < 2; ++n) acc[a][b][m][n] = (f32x4){0.f, 0.f, 0.f, 0.f};
    bf16x8 At[4][2], B0[2][2], B1[2][2];
    const char* cA = (const char*)g.A + (size_t)cur.pm * tstep; const char* cB = (const char*)g.Bt + (size_t)cur.pn * tstep;
    S.a_ready(cur);
    if constexpr (SP2) {
        PG8_STAGE(PG8_SB(0, 0), cB, voffB); PG8_STAGE(PG8_SB(0, 1), cB + hstep, voffB); PG8_STAGE(PG8_SA(0, 0), cA, voffA); PG8_STAGE(PG8_SA(0, 1), cA + hstep, voffA);
        if (wr == 1) PG8_BAR;
        PG8_WAIT_V(2); PG8_BAR;
        PG8_STAGE(PG8_SB(1, 0), cB + kstep, voffB); PG8_STAGE(PG8_SA(1, 0), cA + kstep, voffA); PG8_STAGE(PG8_SB(1, 1), cB + hstep + kstep, voffB);
        PG8_WAIT_V(6); PG8_BAR;
    } else {
        PG8_STAGE(PG8_SB(0, 0), cB, voffB); PG8_STAGE(PG8_SA(0, 0), cA, voffA); PG8_STAGE(PG8_SB(0, 1), cB + hstep, voffB); PG8_STAGE(PG8_SA(0, 1), cA + hstep, voffA);
        if (wr == 1) PG8_BAR;
        PG8_WAIT_V(4); PG8_BAR;
        PG8_STAGE(PG8_SB(1, 0), cB + kstep, voffB); PG8_STAGE(PG8_SA(1, 0), cA + kstep, voffA); PG8_STAGE(PG8_SB(1, 1), cB + hstep + kstep, voffB);
        PG8_WAIT_V(6); PG8_BAR;
    }
    for (;;) {
        const bool has_next = S.next(ui + 1, nxt);
        const char* nA = has_next ? (const char*)g.A + (size_t)nxt.pm * tstep : cA; const char* nB = has_next ? (const char*)g.Bt + (size_t)nxt.pn * tstep : cB;
        for (int t = 0; t < nt; t += 2) {
            const bool last = (t == nt - 2);
            if constexpr (Epi::RSTD_LDS) {
                if (t == 2 || t == 4) { PG8_WAIT_V(8);
                    const f32x4 v = *(const PG8_LAS f32x4*)(lds + RSTD_RAW_OFF + ldsw + lane * 16);
                    float s = (v[0] + v[1]) + (v[2] + v[3]); s += __shfl_xor(s, 1); s += __shfl_xor(s, 2);
                    if (!(tid & 3)) *(PG8_LAS float*)(lds + RSTD_LDS_OFF + ((t - 2) * 64 + (tid >> 2)) * 4) = __builtin_amdgcn_rsqf(s * (1.0f / 1024.0f) + 1e-6f);
                    PG8_WAIT_L(0); }
                if (t == 0 || t == 2) __builtin_amdgcn_global_load_lds((const unsigned*)(E.ssq + ((size_t)(tid & 3) * 17408 + (size_t)cur.pm * BM + t * 64 + (tid >> 2)) * 4), (PG8_LAS unsigned*)(lds + RSTD_RAW_OFF + ldsw), 16, 0, 0);
            }
            if constexpr (Epi::XPREFETCH) { if (t == nt - XPF_LEAD) E.prefetch(cur, lds + RSTD_RAW_OFF + ldsw, tid); }
            const char* a1 = cA + (size_t)(t + 1) * kstep;
            const char* a2 = last ? nA : cA + (size_t)(t + 2) * kstep; const char* b2 = last ? nB : cB + (size_t)(t + 2) * kstep;
            const char* a3 = a2 + kstep; const char* b3 = b2 + kstep;
            if (last && has_next) S.a_ready(nxt);
            if constexpr (SP2) {
            PG8_LDB(B0, 0, 0); PG8_LDB(B1, 0, 1); PG8_SCHED; PG8_LDA(At, 0, 0); PG8_STAGE(PG8_SA(1, 1), a1 + hstep, voffA);
            PG8_WAIT_V(8); PG8_WAIT_L(0); PG8_BAR; PG8_MMA(0, 0, At, B0); PG8_MMA(0, 1, At, B1); PG8_BAR; PG8_SCHED;
            PG8_LDA(At, 0, 1); PG8_STAGE(PG8_SB(0, 0), b2, voffB); PG8_STAGE(PG8_SB(0, 1), b2 + hstep, voffB); PG8_STAGE(PG8_SA(0, 0), a2, voffA);
            PG8_WAIT_V(8); PG8_WAIT_L(0); PG8_BAR; PG8_MMA(1, 0, At, B0); PG8_MMA(1, 1, At, B1); PG8_BAR; PG8_SCHED;
            PG8_LDB(B0, 1, 0); PG8_LDB(B1, 1, 1); PG8_SCHED; PG8_LDA(At, 1, 0); PG8_STAGE(PG8_SA(0, 1), a2 + hstep, voffA);
            PG8_WAIT_V(8); PG8_WAIT_L(0); PG8_BAR; PG8_MMA(0, 0, At, B0); PG8_MMA(0, 1, At, B1); PG8_BAR; PG8_SCHED;
            PG8_LDA(At, 1, 1); PG8_STAGE(PG8_SB(1, 0), b3, voffB); PG8_STAGE(PG8_SB(1, 1), b3 + hstep, voffB); PG8_STAGE(PG8_SA(1, 0), a3, voffA);
            PG8_WAIT_V(8); PG8_WAIT_L(0); PG8_BAR; PG8_MMA(1, 0, At, B0); PG8_MMA(1, 1, At, B1); PG8_BAR; PG8_SCHED;
            } else {
            PG8_LDB(B0, 0, 0); PG8_SCHED; PG8_LDA(At, 0, 0); PG8_STAGE(PG8_SA(1, 1), a1 + hstep, voffA);
            PG8_WAIT_L(8); PG8_BAR; PG8_WAIT_L(0); PG8_MMA(0, 0, At, B0); PG8_BAR; PG8_SCHED;
            PG8_LDB(B1, 0, 1); PG8_STAGE(PG8_SB(0, 0), b2, voffB);
            PG8_BAR; PG8_WAIT_L(0); PG8_MMA(0, 1, At, B1); PG8_BAR;
            PG8_LDA(At, 0, 1); PG8_STAGE(PG8_SA(0, 0), a2, voffA);
            PG8_BAR; PG8_WAIT_L(0); PG8_MMA(1, 0, At, B0); PG8_BAR; PG8_SCHED;
            PG8_STAGE(PG8_SB(0, 1), b2 + hstep, voffB);
            PG8_WAIT_V(6); PG8_BAR; PG8_MMA(1, 1, At, B1); PG8_BAR;
            PG8_LDB(B0, 1, 0); PG8_SCHED; PG8_LDA(At, 1, 0); PG8_STAGE(PG8_SA(0, 1), a2 + hstep, voffA);
            PG8_WAIT_L(8); PG8_BAR; PG8_WAIT_L(0); PG8_MMA(0, 0, At, B0); PG8_BAR; PG8_SCHED;
            PG8_LDB(B1, 1, 1); PG8_STAGE(PG8_SB(1, 0), b3, voffB);
            PG8_BAR; PG8_WAIT_L(0); PG8_MMA(0, 1, At, B1); PG8_BAR;
            PG8_LDA(At, 1, 1); PG8_STAGE(PG8_SA(1, 0), a3, voffA);
            PG8_BAR; PG8_WAIT_L(0); PG8_MMA(1, 0, At, B0); PG8_BAR; PG8_SCHED;
            PG8_STAGE(PG8_SB(1, 1), b3 + hstep, voffB);
            PG8_WAIT_V(6); PG8_BAR; PG8_MMA(1, 1, At, B1); PG8_BAR;
            }
        }
        if constexpr (ALIGN_EPI) { if (wr == 0) PG8_BAR; }
        if constexpr (!Epi::AFTER_DRAIN) { E(acc, cur, wr, wc, fr, fq); S.done(cur); }
        if (!has_next) break;
#pragma unroll
        for (int a = 0; a < 2; ++a)
#pragma unroll
            for (int b = 0; b < 2; ++b)
#pragma unroll
                for (int m = 0; m < 4; ++m)
#pragma unroll
                    for (int n = 0; n < 2; ++n) acc[a][b][m][n] = (f32x4){0.f, 0.f, 0.f, 0.f};
        cur = nxt; cA = nA; cB = nB; ++ui;
        if constexpr (ALIGN_EPI) { if (wr == 1) PG8_BAR; }
    }
    PG8_WAIT_V(0);
    if constexpr (!ALIGN_EPI) { if (wr == 0) PG8_BAR; }
    PG8_BAR;
    if constexpr (Epi::AFTER_DRAIN) { E.fused(acc, cur, wr, wc, fr, fq, lds, wid, lane); S.done(cur); }
#undef PG8_SA
#undef PG8_SB
#undef PG8_STAGE
#undef PG8_LDA
#undef PG8_LDB
#undef PG8_MMA
#undef PG8_WAIT_V
#undef PG8_WAIT_L
#undef PG8_BAR
#undef PG8_SCHED
}
}
constexpr int D = 1024, MP = 16384, MS = 1024, M = MP + MS, NLAYER = 4, MIXW = 256, INC = 5888, PMC = 1792, GTC = 4096, FF = 2816;
constexpr int SEQ = 2048, NB = 8, DB = 128, DSEQ = 8, NCH = SEQ / 64;
constexpr int NPHASE = 2 + 7 * NLAYER;
#ifndef MK_PER_PHASE
#define MK_PER_PHASE 0
#endif
constexpr size_t O_Y = 0, O_POOLP = 17825792, O_POOLS = 17948672, O_SREP = 19914752, O_SRES = 19947520, O_SIMP = 20471808, O_SIMS = 20504576,
                 O_SCP = 21028864, O_SCS = 21045248, O_CFP = 21307392, O_CFS = 21553152, O_END = 25485312;
constexpr size_t MiB = 1u << 20;
constexpr size_t WS_CTL = 0, CTL_ZERO_BYTES = 64 * 1024;
constexpr size_t WS_SSQ = 1 * MiB;
constexpr size_t WS_E = 3 * MiB;
constexpr size_t WS_TAB = 5 * MiB;
constexpr size_t TAB_LB = 0, TAB_LP = 8192, TAB_BBT = 16384, TAB_CM = TAB_BBT + 65536, TAB_PW = TAB_CM + 65536, TAB_STRIDE = TAB_PW + 32768;
constexpr size_t WS_WIN = 6 * MiB;
constexpr size_t WS_WFI = WS_WIN + (size_t)NLAYER * INC * D * 2;
constexpr size_t WS_WOUT = WS_WFI + (size_t)NLAYER * 2 * FF * D * 2;
constexpr size_t WS_WFO = WS_WOUT + (size_t)NLAYER * D * D * 2;
constexpr size_t WS_WBR = WS_WFO + (size_t)NLAYER * D * FF * 2;
constexpr size_t WS_WGLU = WS_WBR + (size_t)NLAYER * 4 * D * MIXW * 2;
constexpr size_t WS_ACT1 = WS_WGLU + (size_t)NLAYER * MIXW * MIXW * 2;
constexpr size_t WS_PM = WS_ACT1 + (size_t)M * D * 2;
constexpr size_t WS_GT = WS_PM + (size_t)M * PMC * 2;
constexpr size_t WS_END = WS_GT + (size_t)M * GTC * 2;
static_assert(WS_TAB + NLAYER * TAB_STRIDE <= WS_WIN && WS_E + (size_t)NB * NCH * 1024 * 8 <= WS_TAB && WS_SSQ + (size_t)M * 64 <= WS_E, "d_ws map");
constexpr int CW_Q = 8192;
constexpr int CW_BAR = 1024;
constexpr int RING_OFF = 0, RING_BYTES = 147456;
constexpr int LDSCTL_OFF = RING_BYTES, MISC_OFF = LDSCTL_OFF + 320;
constexpr int LDS_BYTES = 163840;
constexpr int NWAVES = 8;

#define GAS __attribute__((address_space(1)))
#define LAS __attribute__((address_space(3)))
typedef unsigned short bf16;
typedef unsigned short bf16_t;
typedef unsigned v4u __attribute__((ext_vector_type(4)));
typedef unsigned v2u __attribute__((ext_vector_type(2)));
typedef float f32x4 __attribute__((ext_vector_type(4)));
typedef float f32x2 __attribute__((ext_vector_type(2)));
typedef short bf16x8 __attribute__((ext_vector_type(8)));
#define LDS_WAIT() asm volatile("s_waitcnt lgkmcnt(0)" ::: "memory")
#define VM_WAIT() asm volatile("s_waitcnt vmcnt(0)" ::: "memory")
__device__ __forceinline__ unsigned pk2(float lo, float hi) { return pg8::cvt_pk_bf16(lo, hi); }
__device__ __forceinline__ float bflo(unsigned u) { return __builtin_bit_cast(float, u << 16); }
__device__ __forceinline__ float bfhi(unsigned u) { return __builtin_bit_cast(float, u & 0xffff0000u); }
__device__ __forceinline__ float bf1(bf16_t b) { return __builtin_bit_cast(float, (unsigned)b << 16); }
__device__ __forceinline__ void unpack8(const v4u v, float (&f)[8]) { f[0] = bflo(v.x); f[1] = bfhi(v.x); f[2] = bflo(v.y); f[3] = bfhi(v.y); f[4] = bflo(v.z); f[5] = bfhi(v.z); f[6] = bflo(v.w); f[7] = bfhi(v.w); }
__device__ __forceinline__ v4u pack8(const float (&f)[8]) { v4u w; w.x = pk2(f[0], f[1]); w.y = pk2(f[2], f[3]); w.z = pk2(f[4], f[5]); w.w = pk2(f[6], f[7]); return w; }
__device__ __forceinline__ float sigm(float x) { return pg8::sigm(x); }
__device__ __forceinline__ float gelu_tanh(float y) { const float in2 = 1.5957691216057308f * (y + 0.044715f * y * y * y); const float e = __builtin_amdgcn_exp2f(1.4426950408889634f * in2); return 0.5f * y * (2.0f - 2.0f * __builtin_amdgcn_rcpf(e + 1.0f)); }
__device__ __forceinline__ float wave_sum(float v) {
#pragma unroll
    for (int o = 1; o < 64; o <<= 1) v += __shfl_xor(v, o);
    return v;
}

#define XB_TMO      128
#define XB_XCNT(j)  (256  + 64 * (j))
#define XB_XSUB(j)  (1280 + 64 * (j))
#define XB_XGEN(j)  (2304 + 64 * (j))
#define XB_TOP      3328
#define XB_TOPGEN   3392
#define XCD_BAR_WORDS 3456
#define XB_SPIN_CAP (1u << 18)

__device__ __forceinline__ unsigned xb_ld(unsigned* p)              { return __hip_atomic_load(p, __ATOMIC_RELAXED, __HIP_MEMORY_SCOPE_AGENT); }
__device__ __forceinline__ unsigned xb_add(unsigned* p, unsigned v) { return __hip_atomic_fetch_add(p, v, __ATOMIC_RELAXED, __HIP_MEMORY_SCOPE_AGENT); }
__device__ __forceinline__ unsigned xb_xcc_id() { return (unsigned)__builtin_amdgcn_s_getreg((3 << 11) | 20) & 0xFu; }
#define XB_SPIN(cond, bar) do { unsigned _sp = 0; while (cond) { __builtin_amdgcn_s_sleep(1); \
    if ((++_sp & 255u) == 0u) { if (xb_ld(&(bar)[XB_TMO])) break; if (_sp > XB_SPIN_CAP) { atomicAdd(&(bar)[XB_TMO], 1u); break; } } } } while (0)

struct XcdBarrier {
    unsigned* bar; unsigned x;
    volatile LAS unsigned* st;
};

__device__ __forceinline__ XcdBarrier xcd_barrier_post(unsigned* bar, volatile LAS unsigned* st) {
    XcdBarrier b; b.bar = bar; b.x = xb_xcc_id(); b.st = st;
    if (threadIdx.x == 0) (void)xb_add(&bar[XB_XCNT(b.x)], 1u);
    return b;
}
__device__ __forceinline__ void xcd_barrier_complete(unsigned* bar, unsigned x, unsigned& nloc, unsigned& nx) {
    const unsigned G = gridDim.x * gridDim.y * gridDim.z;
    unsigned sum, cnt, mine, sp = 0u;
    for (;;) {
        sum = 0u; cnt = 0u; mine = 0u;
#pragma unroll
        for (unsigned j = 0; j < 16; ++j) { const unsigned c = xb_ld(&bar[XB_XCNT(j)]); sum += c; cnt += (c > 0u) ? 1u : 0u; mine = (j == x) ? c : mine; }
        if (sum == G) break;
        __builtin_amdgcn_s_sleep(1);
        if ((++sp & 255u) == 0u) { if (xb_ld(&bar[XB_TMO])) break; if (sp > XB_SPIN_CAP) { atomicAdd(&bar[XB_TMO], 1u); break; } }
    }
    nloc = mine > 0u ? mine : 1u; nx = cnt > 0u ? cnt : 1u;
}

__device__ __forceinline__ void xcd_barrier_leader(const XcdBarrier& b) {
    {
        unsigned* bar = b.bar;
        __builtin_amdgcn_s_waitcnt(0);
        unsigned nloc = b.st[0], nx = b.st[1];
        if (nloc == 0u) { xcd_barrier_complete(bar, b.x, nloc, nx); b.st[0] = nloc; b.st[1] = nx; }
        const unsigned old = xb_add(&bar[XB_XSUB(b.x)], 1u);
        const unsigned gen = old / nloc;
        if (old + 1u == (gen + 1u) * nloc) {
            __builtin_amdgcn_fence(__ATOMIC_RELEASE, "agent");
            asm volatile("s_waitcnt vmcnt(0)" ::: "memory");
            const unsigned og = xb_add(&bar[XB_TOP], 1u);
            const unsigned tg = og / nx;
            if (og + 1u == (tg + 1u) * nx) xb_add(&bar[XB_TOPGEN], 1u);
            else XB_SPIN(xb_ld(&bar[XB_TOPGEN]) == tg, bar);
            __builtin_amdgcn_fence(__ATOMIC_ACQUIRE, "agent");
            xb_add(&bar[XB_XGEN(b.x)], 1u);
            asm volatile("s_waitcnt vmcnt(0)" ::: "memory");
        } else {
            XB_SPIN(xb_ld(&bar[XB_XGEN(b.x)]) == gen, bar);
            __builtin_amdgcn_fence(__ATOMIC_ACQUIRE, "agent");
            asm volatile("s_waitcnt vmcnt(0)" ::: "memory");
        }
    }
}
__device__ __forceinline__ void xcd_barrier(const XcdBarrier& b, bool leader) {
    asm volatile("s_waitcnt vmcnt(0)" ::: "memory");
    __syncthreads();
    if (leader) xcd_barrier_leader(b);
    __syncthreads();
}
struct Args { const float* in[32]; float* out; unsigned char* ws; int ph_lo, ph_hi; };
enum { I_XP = 0, I_XS, I_STPOOL, I_STRE, I_STIM, I_STSC, I_STCF, I_N1G, I_N2G, I_FING, I_WIN, I_BGATE, I_POOLW, I_POOLSC, I_LAMRE, I_LAMIM, I_LOGDT,
       I_BRE, I_BIM, I_CRE, I_CIM, I_DSKIP, I_WGLU, I_BGLU, I_SCW, I_CFW, I_CFLNG, I_CFLNB, I_WBR, I_WOUT, I_WFI, I_WFO };

__device__ __forceinline__ void p0_item(const float* W, int ldw, int src_col0, const float* kscale, int k0, bf16* WTrow0, int K, LAS float* scr, int lane) {
    float wv[32];
#pragma unroll
    for (int i = 0; i < 32; ++i) { const int kk = 2 * i + (lane >> 5); wv[i] = W[(size_t)(k0 + kk) * ldw + src_col0 + (lane & 31)]; }
#pragma unroll
    for (int i = 0; i < 32; ++i) { const int kk = 2 * i + (lane >> 5); scr[kk * 33 + (lane & 31)] = wv[i]; }
    LDS_WAIT(); asm volatile("" ::: "memory");
    const int c = lane & 7;
    f32x4 ks0 = (f32x4){1.f, 1.f, 1.f, 1.f}, ks1 = ks0;
    if (kscale) { ks0 = *(const f32x4*)(kscale + k0 + 8 * c); ks1 = *(const f32x4*)(kscale + k0 + 8 * c + 4); }
#pragma unroll
    for (int j = 0; j < 4; ++j) { const int n = (lane >> 3) + 8 * j; const LAS float* s = scr + (8 * c) * 33 + n;
        v4u o; o.x = pk2(s[0 * 33] * ks0[0], s[1 * 33] * ks0[1]); o.y = pk2(s[2 * 33] * ks0[2], s[3 * 33] * ks0[3]); o.z = pk2(s[4 * 33] * ks1[0], s[5 * 33] * ks1[1]); o.w = pk2(s[6 * 33] * ks1[2], s[7 * 33] * ks1[3]);
        *(GAS v4u*)(WTrow0 + (size_t)n * K + k0 + 8 * c) = o; }
    LDS_WAIT(); asm volatile("" ::: "memory");
}
constexpr int P0_IT_IN = 16 * (INC / 32), P0_IT_FI = 16 * (2 * FF / 32), P0_IT_OUT = 16 * 32, P0_IT_FO = (FF / 64) * 32, P0_IT_BR = 4 * 4 * 32, P0_IT_GLU = 4 * 8;
constexpr int P0_IT_LAYER = P0_IT_IN + P0_IT_FI + P0_IT_OUT + P0_IT_FO + P0_IT_BR + P0_IT_GLU;
__device__ __forceinline__ void p0_weight_item(const Args& a, int L, int r, LAS float* scr, int lane) {
    unsigned char* ws = a.ws;
    if (r < P0_IT_IN) { const int nblk = INC / 32, kb = r / nblk, nb = r % nblk;
        p0_item(a.in[I_WIN] + (size_t)L * D * INC, INC, 32 * nb, a.in[I_N1G] + L * D, 64 * kb, (bf16*)(ws + WS_WIN) + ((size_t)L * INC + 32 * nb) * D, D, scr, lane); return; } r -= P0_IT_IN;
    if (r < P0_IT_FI) { const int nblk = 2 * FF / 32, kb = r / nblk, nb = r % nblk; const int nd = 32 * nb, pn = nd >> 8, rr = nd & 255;
        const int src = rr < 128 ? 128 * pn + rr : FF + 128 * pn + (rr - 128);
        p0_item(a.in[I_WFI] + (size_t)L * D * 2 * FF, 2 * FF, src, a.in[I_N2G] + L * D, 64 * kb, (bf16*)(ws + WS_WFI) + ((size_t)L * 2 * FF + nd) * D, D, scr, lane); return; } r -= P0_IT_FI;
    if (r < P0_IT_OUT) { const int kb = r / 32, nb = r % 32;
        p0_item(a.in[I_WOUT] + (size_t)L * D * D, D, 32 * nb, nullptr, 64 * kb, (bf16*)(ws + WS_WOUT) + ((size_t)L * D + 32 * nb) * D, D, scr, lane); return; } r -= P0_IT_OUT;
    if (r < P0_IT_FO) { const int kb = r / 32, nb = r % 32;
        p0_item(a.in[I_WFO] + (size_t)L * FF * D, D, 32 * nb, nullptr, 64 * kb, (bf16*)(ws + WS_WFO) + ((size_t)L * D + 32 * nb) * FF, FF, scr, lane); return; } r -= P0_IT_FO;
    if (r < P0_IT_BR) { const int br = r / 128, q = r % 128, kb = q / 32, nb = q % 32;
        p0_item(a.in[I_WBR] + (size_t)(L * 4 + br) * MIXW * D, D, 32 * nb, nullptr, 64 * kb, (bf16*)(ws + WS_WBR) + ((size_t)(L * 4 + br) * D + 32 * nb) * MIXW, MIXW, scr, lane); return; } r -= P0_IT_BR;
    { const int kb = r / 8, nb = r % 8;
        p0_item(a.in[I_WGLU] + (size_t)L * MIXW * MIXW, MIXW, 32 * nb, nullptr, 64 * kb, (bf16*)(ws + WS_WGLU) + ((size_t)L * MIXW + 32 * nb) * MIXW, MIXW, scr, lane); }
}
constexpr int P0_SLICES = 6, P0_F_PER = 7, P0_A_PER = 2, P0_F_BID0 = 216, P0_A_BID0 = 192;
__device__ __forceinline__ int p0_items_A(int G) { return 0; }
__device__ __forceinline__ int p0_items_F(int G) { return G == 256 ? (256 - P0_F_BID0) * NWAVES * P0_F_PER : 0; }
__device__ __forceinline__ void p0_idle_items(const Args& a, LAS unsigned char* lds, int lane, int wave, int bid, int L, int base, int bid0, int per) {
    LAS float* scr = (LAS float*)(lds + RING_OFF + wave * 16384);
    const int nw = (256 - bid0) * NWAVES, w = (bid - bid0) * NWAVES + wave;
    for (int q = 0; q < per; ++q) p0_weight_item(a, L, base + w + q * nw, scr, lane);
}
__device__ __forceinline__ void p0_slice(const Args& a, LAS unsigned char* lds, int lane, int wave, int G, int bid, int L, int slice) {
    LAS float* scr = (LAS float*)(lds + RING_OFF + wave * 16384);
    const int first = p0_items_A(G) + p0_items_F(G), per = (P0_IT_LAYER - first + P0_SLICES - 1) / P0_SLICES;
    const int lo = first + slice * per, hi = (lo + per < P0_IT_LAYER) ? lo + per : P0_IT_LAYER;
    for (int r = lo + bid * (NWAVES - 1) + (wave - 1); r < hi; r += G * (NWAVES - 1)) p0_weight_item(a, L, r, scr, lane);
}
__device__ __forceinline__ void p0_prologue(const Args& a, LAS unsigned char* lds, int tid, int lane, int wave, int G, int bid) {
    LAS float* scr = (LAS float*)(lds + RING_OFF + wave * 16384);
    const int gw = bid * NWAVES + wave, NGW = G * NWAVES;
    unsigned char* ws = a.ws;
    for (int it = gw; it < (MK_PER_PHASE ? NLAYER : 1) * P0_IT_LAYER; it += NGW) p0_weight_item(a, it / P0_IT_LAYER, it % P0_IT_LAYER, scr, lane);
    for (int m = gw; m < M; m += NGW) {
        const float* xrow = m < MP ? a.in[I_XP] + (size_t)m * D : a.in[I_XS] + (size_t)(m - MP) * D;
        const GAS f32x4* xr = (const GAS f32x4*)xrow + lane; f32x4 v[4]; float s = 0.f;
#pragma unroll
        for (int j = 0; j < 4; ++j) { v[j] = xr[64 * j]; s += (v[j][0] * v[j][0] + v[j][1] * v[j][1]) + (v[j][2] * v[j][2] + v[j][3] * v[j][3]); }
        s = wave_sum(s);
        GAS v2u* o8 = (GAS v2u*)((bf16*)(ws + WS_ACT1) + (size_t)m * D) + lane;
#pragma unroll
        for (int j = 0; j < 4; ++j) { v2u w; w.x = pk2(v[j][0], v[j][1]); w.y = pk2(v[j][2], v[j][3]); o8[64 * j] = w; }
        if (lane < 16) ((float*)(ws + WS_SSQ))[((size_t)(lane >> 2) * M + m) * 4 + (lane & 3)] = lane == 0 ? s : 0.f;
    }
    for (int idx = bid * 512 + tid; idx < NLAYER * 1024; idx += G * 512) {
        const int L = idx >> 10, gp = idx & 1023, g = gp >> 6, p = gp & 63;
        unsigned char* tab = ws + WS_TAB + (size_t)L * TAB_STRIDE;
        const float lre = a.in[I_LAMRE][idx], lim = a.in[I_LAMIM][idx], dt = expf(a.in[I_LOGDT][L * 16 + g]);
        const float ar = lre * dt, br_ = lim * dt, ea = expf(ar), cb = cosf(br_), sb = sinf(br_), sh = sinf(0.5f * br_);
        const float lbr = ea * cb, lbi = ea * sb;
        const float m1r = expm1f(ar) * cb - 2.0f * sh * sh, m1i = lbi;
        const float den = 1.0f / (lre * lre + lim * lim);
        const float qr = (m1r * lre + m1i * lim) * den, qi = (m1i * lre - m1r * lim) * den;
        ((f32x2*)(tab + TAB_LB))[gp] = (f32x2){lbr, lbi};
        float pr = lbr, pi = lbi;
#pragma unroll
        for (int s = 0; s < 6; ++s) { const float nr = pr * pr - pi * pi, ni = 2.0f * pr * pi; pr = nr; pi = ni; }
        ((f32x2*)(tab + TAB_LP))[gp] = (f32x2){pr, pi};
        bf16* bbt = (bf16*)(tab + TAB_BBT); bf16* cm = (bf16*)(tab + TAB_CM);
        const float* bre = a.in[I_BRE] + (size_t)idx * 16; const float* bim = a.in[I_BIM] + (size_t)idx * 16;
#pragma unroll
        for (int c = 0; c < 16; ++c) { const float Br = bre[c], Bi = bim[c];
            bbt[(g * 128 + p) * 16 + c] = (bf16)(pk2(qr * Br - qi * Bi, 0.f) & 0xffffu);
            bbt[(g * 128 + 64 + p) * 16 + c] = (bf16)(pk2(qr * Bi + qi * Br, 0.f) & 0xffffu);
            cm[(g * 16 + c) * 128 + p] = (bf16)(pk2(a.in[I_CRE][((size_t)(L * 16 + g) * 16 + c) * 64 + p], 0.f) & 0xffffu);
            cm[(g * 16 + c) * 128 + 64 + p] = (bf16)(pk2(-a.in[I_CIM][((size_t)(L * 16 + g) * 16 + c) * 64 + p], 0.f) & 0xffffu); }
    }
    for (int idx = bid * 512 + tid; idx < NLAYER * 4 * 64 * 64; idx += G * 512) {
        const int L = idx >> 14, r = idx & 16383, k = r >> 12, o = (r >> 6) & 63, c = r & 63;
        ((bf16*)(ws + WS_TAB + (size_t)L * TAB_STRIDE + TAB_PW))[r] = (bf16)(pk2(a.in[I_POOLW][((size_t)(L * 4 + k) * 64 + c) * 64 + o], 0.f) & 0xffffu);
    }
}
__device__ __forceinline__ void final_norm(const Args& a, int lane, int wave, int G, int bid) {
    const int gw = bid * NWAVES + wave, NGW = G * NWAVES;
    const float* ssq = (const float*)(a.ws + WS_SSQ);
    f32x4 gv[4];
#pragma unroll
    for (int j = 0; j < 4; ++j) gv[j] = ((const f32x4*)a.in[I_FING])[lane + 64 * j];
    for (int m = gw; m < M; m += NGW) {
        float s = lane < 16 ? ssq[((size_t)(lane >> 2) * M + m) * 4 + (lane & 3)] : 0.f; s = wave_sum(s);
        const float rs = __builtin_amdgcn_rsqf(s * (1.0f / 1024.0f) + 1e-6f);
        const GAS v2u* xb = (const GAS v2u*)((const bf16*)(a.ws + WS_ACT1) + (size_t)m * D) + lane;
        GAS f32x4* yr = (GAS f32x4*)(a.out + (size_t)m * D) + lane;
#pragma unroll
        for (int j = 0; j < 4; ++j) { const v2u q = xb[64 * j]; const f32x4 v = (f32x4){bflo(q.x), bfhi(q.x), bflo(q.y), bfhi(q.y)}; yr[64 * j] = v * rs * gv[j]; }
    }
}

typedef float f32x4_t __attribute__((ext_vector_type(4)));
__device__ __forceinline__ float fma_s(float a, float b, float c) { float r; asm("v_fma_f32 %0, %1, %2, %3" : "=v"(r) : "v"(a), "v"(b), "v"(c)); return r; }
template <bool SAMPLE>
__device__ __forceinline__ void mix_unit(const Args& a, int layer, int uidx, LAS unsigned char* lds, int tid_in, int lane_in, int wave_in, int stages) {
    int tid = tid_in; asm volatile("" : "+v"(tid));
    const int lane = tid & 63, wave = __builtin_amdgcn_readfirstlane(tid >> 6);
    constexpr int L = SAMPLE ? 8 : 64, NSEG = SAMPLE ? 2 : 1, R = NSEG * L;
    const bf16* PMb = (const bf16*)(a.ws + WS_PM); bf16* BR = (bf16*)a.out;
    const int s = uidx >> 5, c = uidx & 31, q0 = 2 * uidx;
    const int row0 = SAMPLE ? MP + q0 * 8 : s * SEQ + 64 * c;
    const bool last = SAMPLE || c == NCH - 1;
    LAS float* V = (LAS float*)lds;
    if (stages & 1) {
        constexpr int TR = NSEG * (30 + L);
        LAS float* WCF = (LAS float*)(lds + 96256);
        {
            constexpr int NIT = (TR * 32 + 511) / 512;
            v4u qa[NIT], qb[NIT]; int kind[NIT];
#pragma unroll
            for (int it = 0; it < NIT; ++it) {
                const int idx = tid + it * 512; kind[it] = 0; qa[it] = (v4u){0u, 0u, 0u, 0u}; qb[it] = (v4u){0u, 0u, 0u, 0u};
                if (idx < TR * 32) {
                    const int rr = idx >> 5, c8 = (idx & 31) * 8, seg = rr / (30 + L), e = rr % (30 + L);
                    int srow = -1;
                    if (SAMPLE) { if (e >= 30) srow = MP + (q0 + seg) * 8 + (e - 30); }
                    else { const int tabs = c * 64 + e - 30; if (tabs >= 0) srow = s * SEQ + tabs; }
                    if (srow >= 0) { kind[it] = 1; qa[it] = *(const v4u*)(PMb + (size_t)srow * PMC + 1280 + c8); qb[it] = *(const v4u*)(PMb + (size_t)srow * PMC + 1536 + c8); }
                    else if (SAMPLE) { kind[it] = 2; const float* st = a.in[I_STCF] + ((size_t)(layer * DB + q0 + seg) * 30 + e) * MIXW + c8; qa[it] = *(const v4u*)st; qb[it] = *(const v4u*)(st + 4); }
                }
            }
#pragma unroll
            for (int it = 0; it < NIT; ++it) {
                const int idx = tid + it * 512;
                if (idx < TR * 32) {
                    const int rr = idx >> 5, c8 = (idx & 31) * 8;
                    float v[8];
                    if (kind[it] == 1) { float av[8], bv[8]; unpack8(qa[it], av); unpack8(qb[it], bv);
#pragma unroll
                        for (int j = 0; j < 8; ++j) v[j] = av[j] * sigm(bv[j]); }
                    else { v[0] = __uint_as_float(qa[it].x); v[1] = __uint_as_float(qa[it].y); v[2] = __uint_as_float(qa[it].z); v[3] = __uint_as_float(qa[it].w);
                           v[4] = __uint_as_float(qb[it].x); v[5] = __uint_as_float(qb[it].y); v[6] = __uint_as_float(qb[it].z); v[7] = __uint_as_float(qb[it].w); }
                    *(LAS f32x4*)(V + rr * 256 + c8) = (f32x4){v[0], v[1], v[2], v[3]}; *(LAS f32x4*)(V + rr * 256 + c8 + 4) = (f32x4){v[4], v[5], v[6], v[7]};
                }
            }
        }
        { f32x4 wq[4];
#pragma unroll
            for (int it = 0; it < 4; ++it) { const int idx = tid + it * 512; wq[it] = idx < 31 * 64 ? *(const f32x4*)(a.in[I_CFW] + (size_t)layer * 31 * MIXW + idx * 4) : (f32x4){0.f, 0.f, 0.f, 0.f}; }
#pragma unroll
            for (int it = 0; it < 4; ++it) { const int idx = tid + it * 512; if (idx < 31 * 64) *(LAS f32x4*)(WCF + idx * 4) = wq[it]; } }
        __syncthreads();
        if (last) {
            for (int idx = tid; idx < NSEG * 30 * 64; idx += 512) { const int seg = idx / (30 * 64), r = idx % (30 * 64), j = r >> 6, c4 = (r & 63) * 4;
                float* dst = a.out + (SAMPLE ? O_CFS + ((size_t)(layer * DB + q0 + seg) * 30 + j) * MIXW : O_CFP + ((size_t)(layer * NB + s) * 30 + j) * MIXW) + c4;
                *(f32x4*)dst = *(LAS f32x4*)(V + (seg * (30 + L) + L + j) * 256 + c4); }
        }
        const f32x4 lg = *(const f32x4*)(a.in[I_CFLNG] + layer * MIXW + 4 * lane), lb = *(const f32x4*)(a.in[I_CFLNB] + layer * MIXW + 4 * lane);
        {
            constexpr int NT = R / NWAVES, TG = NT >= 4 ? 4 : NT;
#pragma unroll 1
            for (int g0 = 0; g0 < NT; g0 += TG) {
                f32x4 acc[TG]; int base[TG];
#pragma unroll
                for (int i = 0; i < TG; ++i) { const int tt = wave + NWAVES * (g0 + i), seg = tt / L, t = tt % L; base[i] = (seg * (30 + L) + t) * 256 + 4 * lane; acc[i] = (f32x4){0.f, 0.f, 0.f, 0.f}; }
#pragma unroll 4
                for (int j = 0; j < 31; ++j) { const f32x4 w = *(LAS f32x4*)(WCF + j * 256 + 4 * lane);
#pragma unroll
                    for (int i = 0; i < TG; ++i) acc[i] += w * *(LAS f32x4*)(V + base[i] + j * 256); }
                float s1[TG];
#pragma unroll
                for (int i = 0; i < TG; ++i) s1[i] = (acc[i][0] + acc[i][1]) + (acc[i][2] + acc[i][3]);
#pragma unroll
                for (int o = 1; o < 64; o <<= 1) {
#pragma unroll
                    for (int i = 0; i < TG; ++i) s1[i] += __shfl_xor(s1[i], o); }
                f32x4 d[TG]; float s2[TG];
#pragma unroll
                for (int i = 0; i < TG; ++i) { d[i] = acc[i] - s1[i] * (1.0f / 256.0f); s2[i] = (d[i][0] * d[i][0] + d[i][1] * d[i][1]) + (d[i][2] * d[i][2] + d[i][3] * d[i][3]); }
#pragma unroll
                for (int o = 1; o < 64; o <<= 1) {
#pragma unroll
                    for (int i = 0; i < TG; ++i) s2[i] += __shfl_xor(s2[i], o); }
#pragma unroll
                for (int i = 0; i < TG; ++i) { const int tt = wave + NWAVES * (g0 + i);
                    const float rstd = __builtin_amdgcn_rsqf(s2[i] * (1.0f / 256.0f) + 1e-5f);
                    const f32x4 yn = d[i] * rstd * lg + lb;
                    v2u w; w.x = pk2(yn[0] * sigm(yn[0]), yn[1] * sigm(yn[1])); w.y = pk2(yn[2] * sigm(yn[2]), yn[3] * sigm(yn[3]));
                    *(v2u*)(BR + (size_t)(row0 + tt) * D + 768 + 4 * lane) = w; }
            }
        }
        __syncthreads();
    }
    if (stages & 2) {
        constexpr int TR = NSEG * (15 + L);
        LAS bf16* Dt = (LAS bf16*)(lds + 81920);
        {
            constexpr int NIT = (TR * 32 + 511) / 512;
            v4u qa[NIT], qb[NIT]; int kind[NIT];
#pragma unroll
            for (int it = 0; it < NIT; ++it) {
                const int idx = tid + it * 512; kind[it] = 0; qa[it] = (v4u){0u, 0u, 0u, 0u}; qb[it] = (v4u){0u, 0u, 0u, 0u};
                if (idx < TR * 32) {
                    const int rr = idx >> 5, c8 = (idx & 31) * 8, seg = rr / (15 + L), e = rr % (15 + L);
                    int srow = -1;
                    if (SAMPLE) { if (e >= 15) srow = MP + (q0 + seg) * 8 + (e - 15); }
                    else { const int tabs = c * 64 + e - 15; if (tabs >= 0) srow = s * SEQ + tabs; }
                    if (srow >= 0) { kind[it] = 1; qa[it] = *(const v4u*)(PMb + (size_t)srow * PMC + c8); }
                    else if (SAMPLE) { kind[it] = 2; const float* st = a.in[I_STPOOL] + ((size_t)(layer * DB + q0 + seg) * 15 + e) * MIXW + c8; qa[it] = *(const v4u*)st; qb[it] = *(const v4u*)(st + 4); }
                }
            }
#pragma unroll
            for (int it = 0; it < NIT; ++it) {
                const int idx = tid + it * 512;
                if (idx < TR * 32) {
                    const int rr = idx >> 5, c8 = (idx & 31) * 8;
                    float v[8];
                    if (kind[it] == 1) unpack8(qa[it], v);
                    else { v[0] = __uint_as_float(qa[it].x); v[1] = __uint_as_float(qa[it].y); v[2] = __uint_as_float(qa[it].z); v[3] = __uint_as_float(qa[it].w);
                           v[4] = __uint_as_float(qb[it].x); v[5] = __uint_as_float(qb[it].y); v[6] = __uint_as_float(qb[it].z); v[7] = __uint_as_float(qb[it].w); }
                    *(LAS f32x4*)(V + rr * 256 + c8) = (f32x4){v[0], v[1], v[2], v[3]}; *(LAS f32x4*)(V + rr * 256 + c8 + 4) = (f32x4){v[4], v[5], v[6], v[7]};
                }
            }
        }
        __syncthreads();
        if (last) {
            for (int idx = tid; idx < NSEG * 15 * 64; idx += 512) { const int seg = idx / (15 * 64), r = idx % (15 * 64), j = r >> 6, c4 = (r & 63) * 4;
                float* dst = a.out + (SAMPLE ? O_POOLS + ((size_t)(layer * DB + q0 + seg) * 15 + j) * MIXW : O_POOLP + ((size_t)(layer * NB + s) * 15 + j) * MIXW) + c4;
                *(f32x4*)dst = *(LAS f32x4*)(V + (seg * (15 + L) + L + j) * 256 + c4); }
        }
        for (int idx = tid; idx < R * 32; idx += 512) {
            const int tt = idx >> 5, c8 = (idx & 31) * 8, seg = tt / L, t = tt % L, base = seg * (15 + L) + t + 15, win = 2 << (c8 >> 6);
            float sm[8];
#pragma unroll
            for (int j = 0; j < 8; ++j) sm[j] = 0.f;
            for (int w = 0; w < win; ++w) { const f32x4 x0 = *(LAS f32x4*)(V + (base - w) * 256 + c8), x1 = *(LAS f32x4*)(V + (base - w) * 256 + c8 + 4);
                sm[0] += x0[0]; sm[1] += x0[1]; sm[2] += x0[2]; sm[3] += x0[3]; sm[4] += x1[0]; sm[5] += x1[1]; sm[6] += x1[2]; sm[7] += x1[3]; }
            const int cnt = SAMPLE ? win : min(c * 64 + t + 1, win);
            const float inv = 1.0f / (float)cnt;
            const f32x4 c0 = *(LAS f32x4*)(V + base * 256 + c8), c1 = *(LAS f32x4*)(V + base * 256 + c8 + 4);
            float dd[8];
#pragma unroll
            for (int j = 0; j < 4; ++j) { dd[j] = sm[j] * inv - c0[j]; dd[4 + j] = sm[4 + j] * inv - c1[j]; }
            *(LAS v4u*)(Dt + tt * 264 + c8) = pack8(dd);
        }
        __syncthreads();
        {
            const bf16* PW = (const bf16*)(a.ws + WS_TAB + (size_t)layer * TAB_STRIDE + TAB_PW);
            const int k = wave >> 1, fr = lane & 15, fq = lane >> 4;
            constexpr int NMT = R / 16;
            for (int mt = (NMT >= 4 ? (wave & 1) * 2 : (wave & 1)); mt < (NMT >= 4 ? (wave & 1) * 2 + 2 : ((wave & 1) == 0 ? NMT : 0)); ++mt) {
                const bf16x8 b0 = *(LAS bf16x8*)(Dt + (16 * mt + fr) * 264 + 64 * k + 8 * fq), b1 = *(LAS bf16x8*)(Dt + (16 * mt + fr) * 264 + 64 * k + 32 + 8 * fq);
#pragma unroll
                for (int ot = 0; ot < 4; ++ot) {
                    f32x4 acc = (f32x4){0.f, 0.f, 0.f, 0.f};
                    const bf16x8 a0 = *(const bf16x8*)(PW + ((size_t)(k * 64 + 16 * ot + fr)) * 64 + 8 * fq), a1 = *(const bf16x8*)(PW + ((size_t)(k * 64 + 16 * ot + fr)) * 64 + 32 + 8 * fq);
                    acc = __builtin_amdgcn_mfma_f32_16x16x32_bf16(a0, b0, acc, 0, 0, 0);
                    acc = __builtin_amdgcn_mfma_f32_16x16x32_bf16(a1, b1, acc, 0, 0, 0);
                    const int o = 64 * k + 16 * ot + 4 * fq, tt = 16 * mt + fr;
                    const f32x4 sc = *(const f32x4*)(a.in[I_POOLSC] + layer * MIXW + o);
                    v2u w; w.x = pk2(acc[0] * sc[0], acc[1] * sc[1]); w.y = pk2(acc[2] * sc[2], acc[3] * sc[3]);
                    *(v2u*)(BR + (size_t)(row0 + tt) * D + o) = w;
                }
            }
        }
        __syncthreads();
    }
    if (stages & 4) {
        const float* scw = a.in[I_SCW] + (size_t)layer * 3 * MIXW;
#pragma unroll
        for (int it_ = 0; it_ < R * 32 / 512; ++it_) { const int idx = tid + it_ * 512;
            const int tt = idx >> 5, c8 = (idx & 31) * 8, seg = tt / L, t = tt % L;
            float z[3][8];
#pragma unroll
            for (int dj = 0; dj < 3; ++dj) { const int tp = t - 2 + dj;
                int srow = -1;
                if (SAMPLE) { if (tp >= 0) srow = MP + (q0 + seg) * 8 + tp; } else { const int tabs = c * 64 + tp; if (tabs >= 0) srow = s * SEQ + tabs; }
                if (srow >= 0) { float cg[8], hx[8]; unpack8(*(const v4u*)(PMb + (size_t)srow * PMC + 768 + c8), cg); unpack8(*(const v4u*)(PMb + (size_t)srow * PMC + 1024 + c8), hx);
#pragma unroll
                    for (int j = 0; j < 8; ++j) z[dj][j] = cg[j] * hx[j]; }
                else if (SAMPLE) { const float* st = a.in[I_STSC] + ((size_t)(layer * DB + q0 + seg) * 2 + (2 + tp)) * MIXW + c8; const f32x4 x0 = *(const f32x4*)st, x1 = *(const f32x4*)(st + 4);
                    z[dj][0] = x0[0]; z[dj][1] = x0[1]; z[dj][2] = x0[2]; z[dj][3] = x0[3]; z[dj][4] = x1[0]; z[dj][5] = x1[1]; z[dj][6] = x1[2]; z[dj][7] = x1[3]; }
                else {
#pragma unroll
                    for (int j = 0; j < 8; ++j) z[dj][j] = 0.f; } }
            float bg[8], o[8]; unpack8(*(const v4u*)(PMb + (size_t)(row0 + tt) * PMC + 512 + c8), bg);
#pragma unroll
            for (int j = 0; j < 8; ++j) o[j] = bg[j] * (scw[c8 + j] * z[0][j] + scw[MIXW + c8 + j] * z[1][j] + scw[2 * MIXW + c8 + j] * z[2][j]);
            *(v4u*)(BR + (size_t)(row0 + tt) * D + 512 + c8) = pack8(o);
            if (last && t >= L - 2) { float* dst = a.out + (SAMPLE ? O_SCS + ((size_t)(layer * DB + q0 + seg) * 2 + (t - (L - 2))) * MIXW : O_SCP + ((size_t)(layer * NB + s) * 2 + (t - (L - 2))) * MIXW) + c8;
                *(f32x4*)dst = (f32x4){z[2][0], z[2][1], z[2][2], z[2][3]}; *(f32x4*)(dst + 4) = (f32x4){z[2][4], z[2][5], z[2][6], z[2][7]}; }
        }
    }
}

template <int MODE>
__device__ __forceinline__ void ssm_unit(const Args& a, int layer, int uidx, LAS unsigned char* lds, int tid_in, int lane_in, int wave_in) {
    int tid = tid_in; asm volatile("" : "+v"(tid));
    const int lane = tid & 63, wave = __builtin_amdgcn_readfirstlane(tid >> 6);
    const bf16* PMb = (const bf16*)(a.ws + WS_PM); bf16* BR = (bf16*)a.out;
    const unsigned char* tab = a.ws + WS_TAB + (size_t)layer * TAB_STRIDE;
    const f32x2* LB = (const f32x2*)(tab + TAB_LB); const f32x2* LP = (const f32x2*)(tab + TAB_LP);
    const bf16* BBT = (const bf16*)(tab + TAB_BBT); const bf16* CM = (const bf16*)(tab + TAB_CM);
    f32x2* E = (f32x2*)(a.ws + WS_E);
    const int s = uidx >> 5, c = uidx & 31;
    const int row0 = MODE == 2 ? MP + 64 * uidx : s * SEQ + 64 * c;
    const int fr = lane & 15, fq = lane >> 4;
    LAS float* BU = (LAS float*)(lds + wave * 8448);
    LAS bf16* Zt = (LAS bf16*)(lds + 67584);
    const bf16x8 zf = (bf16x8){0, 0, 0, 0, 0, 0, 0, 0};
    for (int gi = 0; gi < 2; ++gi) {
        const int g = 2 * wave + gi;
        const f32x2 lam = LB[g * 64 + lane]; const float nlam1 = -lam[1];
        float hr = 0.f, hi = 0.f;
        bf16x8 bb[8];
#pragma unroll
        for (int nt = 0; nt < 8; ++nt) bb[nt] = fq < 2 ? *(const bf16x8*)(BBT + ((size_t)(g * 128 + 16 * nt + fr)) * 16 + 8 * fq) : zf;
        bf16x8 cmf[4]; float dsk = 0.f;
        if (MODE >= 1) {
#pragma unroll
            for (int ks = 0; ks < 4; ++ks) cmf[ks] = *(const bf16x8*)(CM + ((size_t)(g * 16 + fr)) * 128 + 32 * ks + 8 * fq);
            dsk = a.in[I_DSKIP][layer * MIXW + 16 * g + fr]; }
        bf16x8 ufa[4];
#pragma unroll
        for (int sub = 0; sub < 4; ++sub) ufa[sub] = fq < 2 ? *(const bf16x8*)(PMb + (size_t)(row0 + 16 * sub + fr) * PMC + 256 + 16 * g + 8 * fq) : zf;
        bf16 uva[4][4];
        if (MODE >= 1) {
#pragma unroll
            for (int sub = 0; sub < 4; ++sub)
#pragma unroll
                for (int r = 0; r < 4; ++r) uva[sub][r] = PMb[(size_t)(row0 + 16 * sub + 4 * fq + r) * PMC + 256 + 16 * g + fr]; }
        if (MODE == 1) { const f32x2 lp = LP[g * 64 + lane];
            const float nlp1 = -lp[1];
#pragma unroll 1
            for (int j = 0; j < c; j += 16) { f32x2 e16[16]; const int nq = c - j;
#pragma unroll
                for (int q = 0; q < 16; ++q) if (q < nq) e16[q] = E[((size_t)(s * NCH + j + q) * 16 + g) * 64 + lane];
#pragma unroll
                for (int q = 0; q < 16; ++q) if (q < nq) { const float nr = fma_s(lp[0], hr, fma_s(nlp1, hi, e16[q][0])), ni = fma_s(lp[0], hi, fma_s(lp[1], hr, e16[q][1])); hr = nr; hi = ni; } } }
#pragma unroll
        for (int sub = 0; sub < 4; ++sub) {
            const int rowb = row0 + 16 * sub;
            const bf16x8 uf = ufa[sub];
#pragma unroll
            for (int nt = 0; nt < 8; ++nt) { const f32x4 d = __builtin_amdgcn_mfma_f32_16x16x32_bf16(uf, bb[nt], (f32x4){0.f, 0.f, 0.f, 0.f}, 0, 0, 0);
#pragma unroll
                for (int r = 0; r < 4; ++r) BU[(4 * fq + r) * 132 + 16 * nt + fr] = d[r]; }
            asm volatile("s_waitcnt lgkmcnt(0)" ::: "memory");
            {
                float bre_[16], bim_[16];
#pragma unroll
                for (int t = 0; t < 16; ++t) { bre_[t] = BU[t * 132 + lane]; bim_[t] = BU[t * 132 + 64 + lane]; }
                float sre_[2] = {0.f, 0.f}, sim_[2] = {0.f, 0.f};
                if (MODE == 2) {
#pragma unroll
                    for (int hq = 0; hq < 2; ++hq) { const int q = 8 * uidx + 2 * sub + hq; const size_t si = ((size_t)(layer * DB + q) * 16 + g) * 64 + lane; sre_[hq] = a.in[I_STRE][si]; sim_[hq] = a.in[I_STIM][si]; } }
                asm volatile("s_waitcnt lgkmcnt(0)" ::: "memory");
#pragma unroll
                for (int t = 0; t < 16; ++t) {
                    if (MODE == 2 && (t & 7) == 0) { hr = sre_[t >> 3]; hi = sim_[t >> 3]; }
                    const float nr = fma_s(lam[0], hr, fma_s(nlam1, hi, bre_[t])), ni = fma_s(lam[0], hi, fma_s(lam[1], hr, bim_[t])); hr = nr; hi = ni;
                    bre_[t] = hr; bim_[t] = hi;
                    if (MODE == 2 && (t & 7) == 7) { const int q = 8 * uidx + 2 * sub + (t >> 3); const size_t si = ((size_t)(layer * DB + q) * 16 + g) * 64 + lane; a.out[O_SRES + si] = hr; a.out[O_SIMS + si] = hi; }
                }
#pragma unroll
                for (int t = 0; t < 16; ++t) { BU[t * 132 + lane] = bre_[t]; BU[t * 132 + 64 + lane] = bim_[t]; }
            }
            if (MODE >= 1) {
                asm volatile("s_waitcnt lgkmcnt(0)" ::: "memory");
                f32x4 y = (f32x4){0.f, 0.f, 0.f, 0.f};
#pragma unroll
                for (int ks = 0; ks < 4; ++ks) { const f32x4 h0 = *(LAS f32x4*)(BU + fr * 132 + 32 * ks + 8 * fq), h1 = *(LAS f32x4*)(BU + fr * 132 + 32 * ks + 8 * fq + 4);
                    v4u hw; hw.x = pk2(h0[0], h0[1]); hw.y = pk2(h0[2], h0[3]); hw.z = pk2(h1[0], h1[1]); hw.w = pk2(h1[2], h1[3]);
                    y = __builtin_amdgcn_mfma_f32_16x16x32_bf16(__builtin_bit_cast(bf16x8, hw), cmf[ks], y, 0, 0, 0); }
#pragma unroll
                for (int r = 0; r < 4; ++r) { const int t = 4 * fq + r; const float uv = bf1(uva[sub][r]);
                    const float z = gelu_tanh(y[r] + dsk * uv);
                    Zt[(16 * sub + t) * 264 + 16 * g + fr] = (bf16)(pk2(z, 0.f) & 0xffffu); }
                asm volatile("s_waitcnt lgkmcnt(0)" ::: "memory");
            }
            if (MODE == 0) { asm volatile("s_waitcnt lgkmcnt(0)" ::: "memory"); }
        }
        if (MODE == 0) E[((size_t)(s * NCH + c) * 16 + g) * 64 + lane] = (f32x2){hr, hi};
        if (MODE == 1 && c == NCH - 1) { const size_t si = ((size_t)(layer * NB + s) * 16 + g) * 64 + lane; a.out[O_SREP + si] = hr; a.out[O_SIMP + si] = hi; }
    }
    if (MODE == 0) __syncthreads();
    if (MODE >= 1) {
        __syncthreads();
        const bf16* WG = (const bf16*)(a.ws + WS_WGLU) + (size_t)layer * MIXW * MIXW;
        f32x4 acc[4][2];
#pragma unroll
        for (int mt = 0; mt < 4; ++mt) { acc[mt][0] = (f32x4){0.f, 0.f, 0.f, 0.f}; acc[mt][1] = (f32x4){0.f, 0.f, 0.f, 0.f}; }
#pragma unroll
        for (int ks = 0; ks < 8; ++ks) {
            const bf16x8 w0 = *(const bf16x8*)(WG + (size_t)(32 * wave + fr) * MIXW + 32 * ks + 8 * fq), w1 = *(const bf16x8*)(WG + (size_t)(32 * wave + 16 + fr) * MIXW + 32 * ks + 8 * fq);
#pragma unroll
            for (int mt = 0; mt < 4; ++mt) { const bf16x8 zb = *(LAS bf16x8*)(Zt + (16 * mt + fr) * 264 + 32 * ks + 8 * fq);
                acc[mt][0] = __builtin_amdgcn_mfma_f32_16x16x32_bf16(w0, zb, acc[mt][0], 0, 0, 0);
                acc[mt][1] = __builtin_amdgcn_mfma_f32_16x16x32_bf16(w1, zb, acc[mt][1], 0, 0, 0); }
        }
#pragma unroll
        for (int nl = 0; nl < 2; ++nl) { const int n0 = 32 * wave + 16 * nl + 4 * fq; const f32x4 bgl = *(const f32x4*)(a.in[I_BGLU] + layer * MIXW + n0);
#pragma unroll
            for (int mt = 0; mt < 4; ++mt) { const int tt = 16 * mt + fr; const v2u zz = *(LAS v2u*)(Zt + tt * 264 + n0);
                const float z0 = bflo(zz.x), z1 = bfhi(zz.x), z2 = bflo(zz.y), z3 = bfhi(zz.y);
                v2u w; w.x = pk2(z0 * sigm(acc[mt][nl][0] + bgl[0]), z1 * sigm(acc[mt][nl][1] + bgl[1])); w.y = pk2(z2 * sigm(acc[mt][nl][2] + bgl[2]), z3 * sigm(acc[mt][nl][3] + bgl[3]));
                *(v2u*)(BR + (size_t)(row0 + tt) * D + 256 + n0) = w; } }
        __syncthreads();
    }
}

__device__ __forceinline__ void gemm2_phase(LAS unsigned char* lds, const bf16* BRp, const bf16* WBT, const unsigned char* GT, bf16* MG, int G, int bid, int tidp) {
    using namespace pg8;
    int tid_ = tidp; asm volatile("" : "+v"(tid_));
    const int tid = tid_, wid = __builtin_amdgcn_readfirstlane(tid >> 6), lane = tid & 63, wr = wid >> 2, wc = wid & 3, fr = lane & 15, fq = lane >> 4;
    unsigned voffA0, voffB0;
    { int R, C; stage_rc(tid * 16, R, C); const int Rb = (R & ~31) + perm32(R & 31); voffA0 = (unsigned)(R * D + C) * 2u; voffB0 = (unsigned)(Rb * MIXW + C) * 2u; }
    const unsigned ldsw = (unsigned)wid * 1024u;
    const int aoff = lds_byte(wr * 64 + fr, fq * 8), boff = lds_byte(wc * 32 + fr, fq * 8);
    const unsigned gvoff = (unsigned)(fr * GTC + 8 * fq);
    constexpr int STG = 49152;
#define G2_STAGE(it_, so_) do { const int kb_ = (it_) >> 2, kt_ = (it_) & 3; \
        const char* as_ = Abase + (size_t)(kb_ * 256 + kt_ * 64) * 2; const char* bs_ = Bbase + (size_t)kb_ * (D * MIXW * 2) + (size_t)kt_ * 128; \
        _Pragma("unroll") for (int _i = 0; _i < 2; ++_i) __builtin_amdgcn_global_load_lds((const unsigned*)(as_ + (size_t)_i * (64 * D * 2) + voffA0), (PG8_LAS unsigned*)(lds + (so_) + ldsw + _i * 8192), 16, 0, 0); \
        _Pragma("unroll") for (int _i = 0; _i < 2; ++_i) __builtin_amdgcn_global_load_lds((const unsigned*)(bs_ + (size_t)_i * (64 * MIXW * 2) + voffB0), (PG8_LAS unsigned*)(lds + (so_) + 16384 + ldsw + _i * 8192), 16, 0, 0); \
        _Pragma("unroll") for (int _i = 0; _i < 2; ++_i) __builtin_amdgcn_global_load_lds((const unsigned*)(bs_ + (size_t)(128 + 64 * _i) * MIXW * 2 + voffB0), (PG8_LAS unsigned*)(lds + (so_) + 32768 + ldsw + _i * 8192), 16, 0, 0); } while (0)
    const int vb = (G % 8 == 0) ? (bid % 8) * (G / 8) + bid / 8 : bid;
    constexpr int NUN = (MP / 128) * 4;
    const bool xmap = G == 256;
    for (int ui = xmap ? (bid & 7) * 64 + (bid >> 3) : vb; ui < NUN; ui += xmap ? ((ui & 63) < 32 ? 32 : NUN) : G) {
        const int pm = ui >> 2, pn = ui & 3;
        const char* Abase = (const char*)BRp + (size_t)pm * 128 * D * 2;
        const char* Bbase = (const char*)WBT + (size_t)pn * 256 * MIXW * 2;
        G2_STAGE(0, 0); G2_STAGE(1, STG);
        f32x4 mg[2][4][2], acc[2][4][2];
#pragma unroll
        for (int b = 0; b < 2; ++b)
#pragma unroll
            for (int m = 0; m < 4; ++m)
#pragma unroll
                for (int n = 0; n < 2; ++n) { mg[b][m][n] = (f32x4){0.f, 0.f, 0.f, 0.f}; acc[b][m][n] = (f32x4){0.f, 0.f, 0.f, 0.f}; }
        v2u gq[2][4];
        int so = 0, so2 = 2 * STG;
#pragma unroll 1
        for (int kb = 0; kb < 4; ++kb) {
#pragma unroll
            for (int kt = 0; kt < 4; ++kt) {
                if (kt < 2) asm volatile("s_waitcnt vmcnt(6)" ::: "memory");
                else if (kt == 3 && kb == 3) asm volatile("s_waitcnt vmcnt(8)" ::: "memory");
                else asm volatile("s_waitcnt vmcnt(14)" ::: "memory");
                __builtin_amdgcn_s_barrier(); asm volatile("" ::: "memory");
                if (kt < 2 || kb < 3) G2_STAGE(4 * kb + kt + 2, so2);
#pragma unroll
                for (int kk = 0; kk < 2; ++kk) {
                    bf16x8 At[4], B0[2], B1[2];
#pragma unroll
                    for (int m = 0; m < 4; ++m) At[m] = *(const PG8_LAS bf16x8*)(lds + so + aoff + m * 2048 + kk * 1024);
#pragma unroll
                    for (int n = 0; n < 2; ++n) { B0[n] = *(const PG8_LAS bf16x8*)(lds + so + 16384 + boff + n * 2048 + kk * 1024); B1[n] = *(const PG8_LAS bf16x8*)(lds + so + 32768 + boff + n * 2048 + kk * 1024); }
                    asm volatile("s_waitcnt lgkmcnt(0)" ::: "memory"); __builtin_amdgcn_sched_barrier(0);
#pragma unroll
                    for (int m = 0; m < 4; ++m)
#pragma unroll
                        for (int n = 0; n < 2; ++n) { acc[0][m][n] = __builtin_amdgcn_mfma_f32_16x16x32_bf16(B0[n], At[m], acc[0][m][n], 0, 0, 0);
                                                      acc[1][m][n] = __builtin_amdgcn_mfma_f32_16x16x32_bf16(B1[n], At[m], acc[1][m][n], 0, 0, 0); }
                }
                if (kt == 1) {
#pragma unroll
                    for (int m = 0; m < 4; ++m) { const unsigned char* gs = GT + (size_t)(pm * 128 + wr * 64 + m * 16) * GTC + kb * D + pn * 256 + wc * 32;
                        asm volatile("global_load_dwordx2 %0, %1, %2" : "=v"(gq[0][m]) : "v"(gvoff), "s"(gs) : "memory");
                        asm volatile("global_load_dwordx2 %0, %1, %2 offset:128" : "=v"(gq[1][m]) : "v"(gvoff), "s"(gs) : "memory"); }
                }
                so = so == 2 * STG ? 0 : so + STG; so2 = so2 == 2 * STG ? 0 : so2 + STG;
            }
            if (kb == 3) asm volatile("s_waitcnt vmcnt(0)" ::: "memory"); else asm volatile("s_waitcnt vmcnt(12)" ::: "memory");
            asm volatile("" : "+v"(gq[0][0]), "+v"(gq[0][1]), "+v"(gq[0][2]), "+v"(gq[0][3]), "+v"(gq[1][0]), "+v"(gq[1][1]), "+v"(gq[1][2]), "+v"(gq[1][3]));
#pragma unroll
            for (int b = 0; b < 2; ++b)
#pragma unroll
                for (int m = 0; m < 4; ++m) { const v2u q_ = gq[b][m];
#pragma unroll
                    for (int j = 0; j < 4; ++j) { mg[b][m][0][j] += (float)((q_.x >> (8 * j)) & 0xffu) * acc[b][m][0][j]; mg[b][m][1][j] += (float)((q_.y >> (8 * j)) & 0xffu) * acc[b][m][1][j]; }
                    acc[b][m][0] = (f32x4){0.f, 0.f, 0.f, 0.f}; acc[b][m][1] = (f32x4){0.f, 0.f, 0.f, 0.f}; }
        }
        asm volatile("" ::: "memory"); __builtin_amdgcn_s_barrier(); asm volatile("" ::: "memory");
#pragma unroll
        for (int b = 0; b < 2; ++b)
#pragma unroll
            for (int m = 0; m < 4; ++m) { const int row = pm * 128 + wr * 64 + m * 16 + fr, col = pn * 256 + b * 128 + wc * 32 + 8 * fq;
                const f32x4 m0 = mg[b][m][0] * (1.0f / 255.0f), m1 = mg[b][m][1] * (1.0f / 255.0f);
                v4u w; w.x = pk2(m0[0], m0[1]); w.y = pk2(m0[2], m0[3]); w.z = pk2(m1[0], m1[1]); w.w = pk2(m1[2], m1[3]);
                *(v4u*)(MG + (size_t)row * D + col) = w; }
    }
#undef G2_STAGE
}


#define TL_GLDS(src_, dst_) __builtin_amdgcn_global_load_lds((const unsigned*)(src_), (PG8_LAS unsigned*)(dst_), 16, 0, 0)
#define TL_STAGE(kt_, A_PTR, B_PTR) do { const int s_ = (kt_) & 3; const char* ap_ = A_PTR(kt_); const char* bp_ = B_PTR(kt_); \
        TL_GLDS(ap_ + voffA, lds + s_ * 32768 + ldsw); TL_GLDS(ap_ + voffA + 128, lds + s_ * 32768 + 8192 + ldsw); \
        TL_GLDS(bp_ + voffB, lds + s_ * 32768 + 16384 + ldsw); TL_GLDS(bp_ + voffB + 128, lds + s_ * 32768 + 24576 + ldsw); } while (0)
#define TL_LOOP(NK, A_PTR, B_PTR, AFTER_STEP) do { \
        TL_STAGE(0, A_PTR, B_PTR); if ((NK) > 1) TL_STAGE(1, A_PTR, B_PTR); if ((NK) > 2) TL_STAGE(2, A_PTR, B_PTR); \
        _Pragma("unroll 1") for (int kt = 0; kt < (NK); ++kt) { \
            if (kt + 2 < (NK)) asm volatile("s_waitcnt vmcnt(8)" ::: "memory"); else if (kt + 1 < (NK)) asm volatile("s_waitcnt vmcnt(4)" ::: "memory"); else asm volatile("s_waitcnt vmcnt(0)" ::: "memory"); \
            __builtin_amdgcn_s_barrier(); asm volatile("" ::: "memory"); \
            if (kt + 3 < (NK)) TL_STAGE(kt + 3, A_PTR, B_PTR); \
            const int sb_ = (kt & 3) * 32768; \
            _Pragma("unroll") for (int h_ = 0; h_ < 2; ++h_) { \
                const bf16x8 a0 = *(const PG8_LAS bf16x8*)(lds + sb_ + h_ * 8192 + aoff), a1 = *(const PG8_LAS bf16x8*)(lds + sb_ + h_ * 8192 + aoff + 1024); \
                const bf16x8 b00 = *(const PG8_LAS bf16x8*)(lds + sb_ + 16384 + h_ * 8192 + boff), b01 = *(const PG8_LAS bf16x8*)(lds + sb_ + 16384 + h_ * 8192 + boff + 1024); \
                const bf16x8 b10 = *(const PG8_LAS bf16x8*)(lds + sb_ + 16384 + h_ * 8192 + boff + 2048), b11 = *(const PG8_LAS bf16x8*)(lds + sb_ + 16384 + h_ * 8192 + boff + 3072); \
                asm volatile("s_waitcnt lgkmcnt(0)" ::: "memory"); __builtin_amdgcn_sched_barrier(0); \
                acc[0] = __builtin_amdgcn_mfma_f32_16x16x32_bf16(b00, a0, acc[0], 0, 0, 0); acc[1] = __builtin_amdgcn_mfma_f32_16x16x32_bf16(b10, a0, acc[1], 0, 0, 0); \
                acc[0] = __builtin_amdgcn_mfma_f32_16x16x32_bf16(b01, a1, acc[0], 0, 0, 0); acc[1] = __builtin_amdgcn_mfma_f32_16x16x32_bf16(b11, a1, acc[1], 0, 0, 0); } \
            AFTER_STEP(kt); } \
        asm volatile("s_waitcnt lgkmcnt(0)" ::: "memory"); __builtin_amdgcn_s_barrier(); asm volatile("" ::: "memory"); } while (0)
#define TL_SETUP(LDA, LDB) using namespace pg8; int tid_ = tidp; asm volatile("" : "+v"(tid_)); \
    const int tid = tid_, wid = __builtin_amdgcn_readfirstlane(tid >> 6), lane = tid & 63, fr = lane & 15, fq = lane >> 4, mt = wid >> 1, nh = wid & 1; \
    int R_, C_; stage_rc(tid * 16, R_, C_); \
    const unsigned voffA = (unsigned)(R_ * (LDA) + C_) * 2u, voffB = (unsigned)(R_ * (LDB) + C_) * 2u, ldsw = (unsigned)wid * 1024u; \
    const int aoff = lds_byte(mt * 16 + fr, fq * 8), boff = lds_byte(nh * 32 + fr, fq * 8); (void)lane
#define TL_NOP(kt_) do {} while (0)

struct CappedOrder : pg8::StaticOrder {
    int cap;
    __device__ bool next(int i, pg8::Unit& u) const { if ((long)i * G + c >= cap) return false; return pg8::StaticOrder::next(i, u); }
};
__device__ __forceinline__ void proj_tail_phase(LAS unsigned char* lds, const bf16* A, const bf16* Bt, int cap, const float* ssq, const float* bgate, bf16* PMp, unsigned char* GTp, int G, int bid, int tidp, unsigned* qctr) {
    TL_SETUP(D, D);
    StaticOrder S1; S1.init(M, INC, 1, 0);
    const int nsub = (S1.nwg - cap) * 16;
    volatile LAS int* qslot = (volatile LAS int*)(lds + MISC_OFF + 192);
    for (int t = bid; t < nsub; ) {
        Unit u; S1.next(cap + (t >> 4), u);
        const int rb = (t >> 2) & 3, cb = t & 3, r0 = u.pm * 256 + 64 * rb, c0 = u.pn * 256 + 64 * cb;
        const char* Ab = (const char*)A + (size_t)r0 * D * 2; const char* Bb = (const char*)Bt + (size_t)c0 * D * 2;
        f32x4 acc[2] = {(f32x4){0.f, 0.f, 0.f, 0.f}, (f32x4){0.f, 0.f, 0.f, 0.f}};
        const int row = r0 + 16 * mt + fr;
        const float rs = pg8::row_rstd(ssq, row);
        const bool isg = u.pn >= 7;
        f32x4 bvv[2];
#pragma unroll
        for (int n = 0; n < 2; ++n) bvv[n] = isg ? *(const f32x4*)(bgate + (c0 + 32 * nh + 16 * n + 4 * fq - PMC)) : (f32x4){0.f, 0.f, 0.f, 0.f};
#define PT_A(kt_) (Ab + (size_t)(kt_) * 256)
#define PT_B(kt_) (Bb + (size_t)(kt_) * 256)
        TL_LOOP(D / 128, PT_A, PT_B, TL_NOP);
#undef PT_A
#undef PT_B
        unsigned got = 0u;
        if (tid == 0) got = __hip_atomic_fetch_add(qctr, 1u, __ATOMIC_RELAXED, __HIP_MEMORY_SCOPE_AGENT);
#pragma unroll
        for (int n = 0; n < 2; ++n) { const int col = c0 + 32 * nh + 16 * n + 4 * fq; f32x4 v = acc[n] * rs;
            if (isg) { const f32x4 tt = (v + bvv[n]) * -1.4426950408889634f;
                *(unsigned*)(GTp + (size_t)row * GTC + (col - PMC)) = pg8::pack_u8x4(pg8::sig255(tt[0]), pg8::sig255(tt[1]), pg8::sig255(tt[2]), pg8::sig255(tt[3])); }
            else { v2u w; w.x = pk2(v[0], v[1]); w.y = pk2(v[2], v[3]); *(v2u*)(PMp + (size_t)row * PMC + col) = w; } }
        if (tid == 0) *qslot = G + (int)got;
        __syncthreads();
        t = *qslot;
        __syncthreads();
    }
}

__device__ __forceinline__ void gemm2_tail_phase(LAS unsigned char* lds, const bf16* BRp, const bf16* WBT, const unsigned char* GT, bf16* MG, int G, int bid, int tidp) {
    TL_SETUP(D, MIXW);
    for (int ui = bid; ui < 256; ui += G) {
        const int rb = ((ui & 7) >> 1) * 4 + (ui >> 6), cb = (ui & 1) * 8 + ((ui >> 3) & 7);
        const char* Ab = (const char*)BRp + (size_t)(MP + 64 * rb) * D * 2; const char* Bb = (const char*)WBT + (size_t)(64 * cb) * MIXW * 2;
        f32x4 acc[2] = {(f32x4){0.f, 0.f, 0.f, 0.f}, (f32x4){0.f, 0.f, 0.f, 0.f}}, mg[2] = {(f32x4){0.f, 0.f, 0.f, 0.f}, (f32x4){0.f, 0.f, 0.f, 0.f}};
        const int row = MP + 64 * rb + 16 * mt + fr;
#define G2T_A(kt_) (Ab + (size_t)(((kt_) >> 1) * 256 + ((kt_) & 1) * 128) * 2)
#define G2T_B(kt_) (Bb + (size_t)((kt_) >> 1) * (D * MIXW * 2) + (size_t)((kt_) & 1) * 256)
        unsigned gwp[4][2];
#pragma unroll
        for (int kb = 0; kb < 4; ++kb)
#pragma unroll
            for (int n = 0; n < 2; ++n) gwp[kb][n] = *(const unsigned*)(GT + (size_t)row * GTC + kb * D + 64 * cb + 32 * nh + 16 * n + 4 * fq);
#define G2T_AFTER(kt_) do { if ((kt_) & 1) { const int kb_ = (kt_) >> 1; \
            _Pragma("unroll") for (int n = 0; n < 2; ++n) { const unsigned gw = kb_ == 0 ? gwp[0][n] : (kb_ == 1 ? gwp[1][n] : (kb_ == 2 ? gwp[2][n] : gwp[3][n])); \
                mg[n][0] += (float)(gw & 0xffu) * acc[n][0]; mg[n][1] += (float)((gw >> 8) & 0xffu) * acc[n][1]; mg[n][2] += (float)((gw >> 16) & 0xffu) * acc[n][2]; mg[n][3] += (float)(gw >> 24) * acc[n][3]; \
                acc[n] = (f32x4){0.f, 0.f, 0.f, 0.f}; } } } while (0)
        TL_LOOP(8, G2T_A, G2T_B, G2T_AFTER);
#undef G2T_A
#undef G2T_B
#undef G2T_AFTER
#pragma unroll
        for (int n = 0; n < 2; ++n) { const f32x4 mm = mg[n] * (1.0f / 255.0f); v2u w; w.x = pk2(mm[0], mm[1]); w.y = pk2(mm[2], mm[3]); *(v2u*)(MG + (size_t)row * D + 64 * cb + 32 * nh + 16 * n + 4 * fq) = w; }
    }
}

__device__ __forceinline__ void resid_tail_phase(LAS unsigned char* lds, const bf16* A, const bf16* Bt, int K, bf16* XBp, float* ssq, int G, int bid, int tidp) {
    TL_SETUP(K, K);
    const int nk = K / 128;
    for (int ui = bid; ui < 256; ui += G) {
        const int rb = ((ui & 7) >> 1) * 4 + (ui >> 6), cb = (ui & 1) * 8 + ((ui >> 3) & 7);
        const char* Ab = (const char*)A + (size_t)(MP + 64 * rb) * K * 2; const char* Bb = (const char*)Bt + (size_t)(64 * cb) * K * 2;
        f32x4 acc[2] = {(f32x4){0.f, 0.f, 0.f, 0.f}, (f32x4){0.f, 0.f, 0.f, 0.f}};
        const int rowl = 16 * mt + fr, row = MP + 64 * rb + rowl; float ss = 0.f;
        f32x4 xold[2];
#pragma unroll
        for (int n = 0; n < 2; ++n) { const int col = 64 * cb + 32 * nh + 16 * n + 4 * fq;
            const v2u q = *(const v2u*)(XBp + (size_t)row * D + col); xold[n] = (f32x4){bflo(q.x), bfhi(q.x), bflo(q.y), bfhi(q.y)}; }
#define RT_A(kt_) (Ab + (size_t)(kt_) * 256)
#define RT_B(kt_) (Bb + (size_t)(kt_) * 256)
        TL_LOOP(nk, RT_A, RT_B, TL_NOP);
#undef RT_A
#undef RT_B
#pragma unroll
        for (int n = 0; n < 2; ++n) { const int col = 64 * cb + 32 * nh + 16 * n + 4 * fq;
            const f32x4 o = xold[n] + acc[n];
            v2u w; w.x = pk2(o[0], o[1]); w.y = pk2(o[2], o[3]); *(v2u*)(XBp + (size_t)row * D + col) = w;
            ss += (o[0] * o[0] + o[1] * o[1]) + (o[2] * o[2] + o[3] * o[3]); }
        ss += __shfl_xor(ss, 16); ss += __shfl_xor(ss, 32);
        LAS float* red = (LAS float*)lds;
        if (fq == 0) red[rowl * 2 + nh] = ss;
        __syncthreads();
        if (tid < 64) ssq[((size_t)(cb >> 2) * M + MP + 64 * rb + tid) * 4 + (cb & 3)] = red[tid * 2] + red[tid * 2 + 1];
        __syncthreads();
    }
}

__global__ void __launch_bounds__(NWAVES * 64, 2) hybrid_fwd(Args args) {
    extern __shared__ __attribute__((aligned(16))) unsigned char lds_raw[];
    LAS unsigned char* lds = (LAS unsigned char*)lds_raw;
    volatile LAS unsigned* MISC = (volatile LAS unsigned*)(lds + MISC_OFF);
    const int tid0 = threadIdx.x, wave0 = __builtin_amdgcn_readfirstlane(tid0 >> 6);
    const int G0 = gridDim.x, bid = blockIdx.x;
    unsigned char* ws = args.ws;
    for (int u = tid0; u < (LDS_BYTES - LDSCTL_OFF) / 4; u += NWAVES * 64) ((LAS unsigned*)(lds + LDSCTL_OFF))[u] = 0u;
    __syncthreads();
    const int lo = args.ph_lo, hi = args.ph_hi;
    XcdBarrier bar; bar.bar = (unsigned*)(ws + WS_CTL) + CW_BAR; bar.x = 0; bar.st = nullptr;
    if (hi - lo > 1) bar = xcd_barrier_post((unsigned*)(ws + WS_CTL) + CW_BAR, MISC + 8);
    bf16* XB = (bf16*)(ws + WS_ACT1); bf16* PMb = (bf16*)(ws + WS_PM); unsigned char* GTb = ws + WS_GT;
    bf16* MGb = (bf16*)(ws + WS_PM); bf16* ACTb = (bf16*)(ws + WS_GT);
    float* ssq = (float*)(ws + WS_SSQ);
    for (int ph_i = lo; ph_i < hi; ++ph_i) {
        int ph = ph_i, G = G0; asm volatile("" : "+s"(ph), "+s"(G));
        unsigned z_ = 0u; asm volatile("" : "+v"(z_));
        int tid = wave0 * 64 + (int)__builtin_amdgcn_mbcnt_hi(~0u, __builtin_amdgcn_mbcnt_lo(~0u, z_)); asm volatile("" : "+v"(tid)); const int lane = tid & 63, wave = __builtin_amdgcn_readfirstlane(tid >> 6);
        const int layer = (ph - 1) / 7, k = ph == 0 ? -1 : (ph == NPHASE - 1 ? 7 : (ph - 1) % 7);
        if (k == -1) p0_prologue(args, lds, tid, lane, wave, G, bid);
        else if (k == 7) final_norm(args, lane, wave, G, bid);
        else if (k == 0) {
            pg8::Gemm g{XB, (const bf16*)(ws + WS_WIN) + (size_t)layer * INC * D, M, INC, D}; CappedOrder S; S.init(M, INC, G, bid); S.cap = (S.nwg / G) * G;
            pg8::EpiProj E{PMb, GTb, ssq, args.in[I_BGATE] + (size_t)layer * GTC, (const LAS float*)(lds + RING_OFF + pg8::RSTD_LDS_OFF)};
            pg8::gemm_phase<pg8::EpiProj, CappedOrder, true, true>(lds + RING_OFF, g, S, E, tid);
            proj_tail_phase(lds + RING_OFF, XB, (const bf16*)(ws + WS_WIN) + (size_t)layer * INC * D, S.cap, ssq, args.in[I_BGATE] + (size_t)layer * GTC, PMb, GTb, G, bid, tid, (unsigned*)(ws + WS_CTL) + CW_Q + 64 * layer);
        } else if (k == 1) {
            for (int s_ = 0; ; ++s_) { int u; bool donor = false;
                if (G == 256) { if (s_ > 2) break;
                    donor = bid < 16 || (bid >= 80 && bid < 152);
                    if (s_ == 0) u = 272 + ((bid + 240) & 255);
                    else if (bid < 16) { if (s_ == 2) break; u = 256 + bid; }
                    else if (bid < 80) { if (s_ == 2) break; u = 528 + (bid - 16); }
                    else if (s_ == 1 || bid < 152) { const int v = (s_ == 1 ? 0 : 176) + (bid - 80); u = (v / 31) * 32 + v % 31; }
                    else if (bid < 240) { const int t_ = bid - 152, db = t_ < 16 ? t_ : 80 + (t_ - 16); u = 592 + ((db + 240) & 255); }
                    else break; }
                else { u = bid + s_ * G; if (u >= 256 + 16 + 256 + 64) break; }
                if (u < 256) { if ((u & 31) != NCH - 1) ssm_unit<0>(args, layer, u, lds, tid, lane, wave); }
                else if (u < 272) ssm_unit<2>(args, layer, u - 256, lds, tid, lane, wave);
                else if (u < 528 || u >= 592) mix_unit<false>(args, layer, u < 528 ? u - 272 : u - 592, lds, tid, lane, wave, u >= 592 ? 4 : (donor ? 3 : 7));
                else mix_unit<true>(args, layer, u - 528, lds, tid, lane, wave, 7);
            }
        } else if (k == 2) {
            for (int u = bid; u < 256; u += G) ssm_unit<1>(args, layer, u, lds, tid, lane, wave);
        } else if (k == 3) {
            gemm2_phase(lds + RING_OFF, (const bf16*)args.out, (const bf16*)(ws + WS_WBR) + (size_t)layer * 4 * D * MIXW, GTb, MGb, G, bid, tid);
            gemm2_tail_phase(lds + RING_OFF, (const bf16*)args.out, (const bf16*)(ws + WS_WBR) + (size_t)layer * 4 * D * MIXW, GTb, MGb, G, bid, tid);
        } else if (k == 5) {
            pg8::Gemm g{XB, (const bf16*)(ws + WS_WFI) + (size_t)layer * 2 * FF * D, M, 2 * FF, D}; pg8::StaticOrder S; S.init(M, 2 * FF, G, bid);
            pg8::EpiSwiGLU E{ACTb, ssq, (const LAS float*)(lds + RING_OFF + pg8::RSTD_LDS_OFF)};
            pg8::gemm_phase<pg8::EpiSwiGLU, pg8::StaticOrder, true, true>(lds + RING_OFF, g, S, E, tid);
            if (!MK_PER_PHASE && G == 256 && bid >= P0_F_BID0 && layer + 1 < NLAYER) p0_idle_items(args, lds, lane, wave, bid, layer + 1, p0_items_A(G), P0_F_BID0, P0_F_PER);
        } else {
            const bool isE = k == 4; const int K = isE ? D : FF;
            const bf16* Ap = isE ? MGb : ACTb; const bf16* Bp = isE ? (const bf16*)(ws + WS_WOUT) + (size_t)layer * D * D : (const bf16*)(ws + WS_WFO) + (size_t)layer * D * FF;
            { pg8::Gemm g{Ap, Bp, MP, D, K}; pg8::StaticOrder S; S.init(MP, D, G, bid);
              pg8::EpiResid E{XB, ssq};
              pg8::gemm_phase<pg8::EpiResid, pg8::StaticOrder, true, true>(lds + RING_OFF, g, S, E, tid); }
            resid_tail_phase(lds + RING_OFF, Ap, Bp, K, XB, ssq, G, bid, tid);
        }
        if (ph_i + 1 < hi) {
            asm volatile("s_waitcnt vmcnt(0)" ::: "memory"); __syncthreads();
            if (tid == 0) xcd_barrier_leader(bar);
            else if (wave != 0) {
                if (k == 3 || k == 5) {
                    const char* wb = k == 3 ? (const char*)((const bf16*)(ws + WS_WOUT) + (size_t)layer * D * D) : (const char*)((const bf16*)(ws + WS_WFO) + (size_t)layer * D * FF);
                    const int rowb = k == 3 ? D * 2 : FF * 2;
                    for (int l = (((bid >> 3) * (NWAVES - 1) + (wave - 1)) << 6) + lane; l < 16384; l += ((G >> 3) * (NWAVES - 1)) << 6)
                        __builtin_amdgcn_global_load_lds((const unsigned*)(wb + (size_t)(l >> 4) * rowb + (l & 15) * 128), (LAS unsigned*)(lds + RING_OFF + pg8::RSTD_RAW_OFF + wave * 1024), 4, 0, 0);
                }
                if (!MK_PER_PHASE && k >= 0 && k < P0_SLICES && layer + 1 < NLAYER) p0_slice(args, lds, lane, wave, G, bid, layer + 1, k);
            }
            __syncthreads();
        }
    }
}

extern "C" void kernel_launch(void* const* d_in, const int* in_sizes, int n_in, void* d_out, int out_size, void* d_ws, size_t ws_size, hipStream_t stream) {
    static int grid = 0;
    if (grid == 0) {
        if (n_in != 32 || out_size != (int)O_END || ws_size < WS_END) { fprintf(stderr, "kernel_launch: expected 32 inputs, %zu outputs, >= %zu bytes of workspace; got %d, %d, %zu; nothing launched\n", (size_t)O_END, (size_t)WS_END, n_in, out_size, ws_size); grid = -1; return; }
        int dev = 0, cus = 0, per_cu = 0;
        if (hipGetDevice(&dev) != hipSuccess || hipDeviceGetAttribute(&cus, hipDeviceAttributeMultiprocessorCount, dev) != hipSuccess) { grid = -1; return; }
        if (hipFuncSetAttribute((const void*)hybrid_fwd, hipFuncAttributeMaxDynamicSharedMemorySize, LDS_BYTES) != hipSuccess) { fprintf(stderr, "kernel_launch: hipFuncSetAttribute failed\n"); grid = -1; return; }
        if (hipOccupancyMaxActiveBlocksPerMultiprocessor(&per_cu, (const void*)hybrid_fwd, NWAVES * 64, LDS_BYTES) != hipSuccess || per_cu < 1) { fprintf(stderr, "kernel_launch: occupancy query says %d blocks per CU; nothing launched\n", per_cu); (void)hipGetLastError(); grid = -1; return; }
        grid = cus;
    }
    if (grid < 0) return;
    (void)hipMemsetAsync((char*)d_ws + WS_CTL, 0, CTL_ZERO_BYTES, stream);
    Args a{};
    for (int i = 0; i < 32; ++i) a.in[i] = (const float*)d_in[i];
    a.out = (float*)d_out; a.ws = (unsigned char*)d_ws;
#if MK_PER_PHASE
    for (int k = 0; k < NPHASE; ++k) { a.ph_lo = k; a.ph_hi = k + 1; hipLaunchKernelGGL(hybrid_fwd, dim3(grid), dim3(NWAVES * 64), LDS_BYTES, stream, a); }
#else
    a.ph_lo = 0; a.ph_hi = NPHASE;
    hipLaunchKernelGGL(hybrid_fwd, dim3(grid), dim3(NWAVES * 64), LDS_BYTES, stream, a);
#endif
}
```

```cpp
#include <hip/hip_runtime.h>
#include <cstdio>
#include <cstdint>
#ifndef XPF_LEAD
#define XPF_LEAD 2
#endif
namespace pg8 {
#define PG8_LAS __attribute__((address_space(3)))
typedef unsigned short bf16_t;
typedef short bf16x8 __attribute__((ext_vector_type(8)));
typedef float f32x4 __attribute__((ext_vector_type(4)));
typedef unsigned u32x4 __attribute__((ext_vector_type(4)));
constexpr int BM = 256, BK = 64, HALF = 128, HTB = HALF * BK * 2  , STAGE_BYTES = 8 * HTB, NXCD = 8, WGM = 8, RSTD_LDS_OFF = 147456 + 320 + 1024  , RSTD_RAW_OFF = RSTD_LDS_OFF + 1024  , BIAS_LDS_OFF = RSTD_RAW_OFF + 8192  ;

__host__ __device__ __forceinline__ int lds_byte(int r, int c) { const int st = (r >> 4) * 2 + (c >> 5), rr = r & 15, cc = c & 31, ob = rr * 64 + cc * 2; return st * 1024 + (ob ^ (((ob >> 9) & 1) << 5)); }
__host__ __device__ __forceinline__ void stage_rc(int b, int& R, int& C) { const int st = b / 1024, sb = b % 1024, swz = sb ^ (((sb >> 9) & 1) << 5); R = (st >> 1) * 16 + swz / 64; C = (st & 1) * 32 + (swz % 64) / 2; }
__host__ __device__ __forceinline__ int perm32(int rho) { const int n = rho >> 4, i = rho & 15; return 8 * (i >> 2) + 4 * n + (i & 3); }

struct Unit { int pm, pn; };
struct Gemm { const bf16_t* A; const bf16_t* Bt; int M, N, K; };

struct StaticOrder {
    int nM, nN, nwg, G, c;
    __host__ __device__ void init(int M, int N, int G_, int c_) { nM = M / BM; nN = N / BM; nwg = nM * nN; G = G_; c = c_; }
    __host__ __device__ bool next(int i, Unit& u) const {
        const long L = (long)i * G + c; if (L >= nwg) return false;
        int wgid = (int)L; { const int q = nwg / NXCD, r = nwg % NXCD, xcd = wgid % NXCD, off = wgid / NXCD; wgid = (xcd < r ? xcd * (q + 1) : r * (q + 1) + (xcd - r) * q) + off; }
        const int nig = WGM * nN, gid = wgid / nig, fm = gid * WGM, gsz = (nM - fm) < WGM ? (nM - fm) : WGM;
        u.pm = fm + ((wgid % nig) % gsz); u.pn = (wgid % nig) / gsz; return true;
    }
    __device__ __forceinline__ void a_ready(const Unit&) const {}
    __device__ __forceinline__ void done(const Unit&) const {}
};
typedef float f32x2 __attribute__((ext_vector_type(2)));
typedef __bf16 bf16x2_t __attribute__((ext_vector_type(2)));
__device__ __forceinline__ unsigned cvt_pk_bf16(float lo, float hi) { f32x2 v = {lo, hi}; bf16x2_t b = __builtin_convertvector(v, bf16x2_t); return __builtin_bit_cast(unsigned, b); }
__device__ __forceinline__ float sigm(float x) { return __builtin_amdgcn_rcpf(1.0f + __builtin_amdgcn_exp2f(-1.4426950408889634f * x)); }
__device__ __forceinline__ float row_rstd(const float* ssq, int row) {
    const f32x4 a = *(const f32x4*)(ssq + ((size_t)0 * 17408 + row) * 4), b = *(const f32x4*)(ssq + ((size_t)1 * 17408 + row) * 4),
                c = *(const f32x4*)(ssq + ((size_t)2 * 17408 + row) * 4), d = *(const f32x4*)(ssq + ((size_t)3 * 17408 + row) * 4);
    const float s = (((a[0] + a[1]) + (a[2] + a[3])) + ((b[0] + b[1]) + (b[2] + b[3]))) + (((c[0] + c[1]) + (c[2] + c[3])) + ((d[0] + d[1]) + (d[2] + d[3])));
    return __builtin_amdgcn_rsqf(s * (1.0f / 1024.0f) + 1e-6f);
}
__device__ __forceinline__ void rows_rstd(const float* ssq, int row0, int fq, float (&rs)[2][4]) {
#pragma unroll
    for (int ai = 0; ai < 2; ++ai)
#pragma unroll
        for (int m = 0; m < 4; ++m) { const f32x4 p = *(const f32x4*)(ssq + ((size_t)fq * 17408 + row0 + ai * HALF + m * 16) * 4); rs[ai][m] = (p[0] + p[1]) + (p[2] + p[3]); }
#pragma unroll
    for (int ai = 0; ai < 2; ++ai)
#pragma unroll
        for (int m = 0; m < 4; ++m) { float s = rs[ai][m]; s += __shfl_xor(s, 16); s += __shfl_xor(s, 32); rs[ai][m] = __builtin_amdgcn_rsqf(s * (1.0f / 1024.0f) + 1e-6f); }
}
__device__ __forceinline__ void rows_rstd_lds(const PG8_LAS float* rl, int r0, float (&rs)[2][4]) {
#pragma unroll
    for (int ai = 0; ai < 2; ++ai)
#pragma unroll
        for (int m = 0; m < 4; ++m) rs[ai][m] = rl[r0 + ai * HALF + m * 16];
}
struct EpiNull {
    static constexpr bool PERM = true, AFTER_DRAIN = false, RSTD_LDS = false, XPREFETCH = false;
    __device__ __forceinline__ void operator()(const f32x4 (&acc)[2][2][4][2], const Unit& u, int wr, int wc, int fr, int fq) const {
#pragma unroll
        for (int ai = 0; ai < 2; ++ai)
#pragma unroll
            for (int bj = 0; bj < 2; ++bj)
#pragma unroll
                for (int m = 0; m < 4; ++m) { asm volatile("" :: "v"(acc[ai][bj][m][0]), "v"(acc[ai][bj][m][1])); }
    }
};
__device__ __forceinline__ unsigned pack_u8x4(float a, float b, float c, float d) {
    unsigned w = 0u; w = __builtin_amdgcn_cvt_pk_u8_f32(a, 0u, w); w = __builtin_amdgcn_cvt_pk_u8_f32(b, 1u, w); w = __builtin_amdgcn_cvt_pk_u8_f32(c, 2u, w); w = __builtin_amdgcn_cvt_pk_u8_f32(d, 3u, w); return w; }
__device__ __forceinline__ float sig255(float t) { return __builtin_amdgcn_rcpf(__builtin_fmaf(__builtin_amdgcn_exp2f(t), 1.0f / 255.0f, 1.0f / 255.0f)); }
struct EpiProj {
    static constexpr bool PERM = true, AFTER_DRAIN = false, RSTD_LDS = true, XPREFETCH = false;
    bf16_t* PM; unsigned char* GT; const float* ssq; const float* bgate; const PG8_LAS float* rl;
    __device__ __forceinline__ void operator()(const f32x4 (&acc)[2][2][4][2], const Unit& u, int wr, int wc, int fr, int fq) const {
        const int row0 = u.pm * BM + wr * 64 + fr;
        float rsv[2][4]; rows_rstd_lds(rl, wr * 64 + fr, rsv);
        if (u.pn >= 7) {
            constexpr float NL2E = -1.4426950408889634f;
            const int lc0 = (u.pn - 7) * BM + wc * 32 + 8 * fq;
            f32x4 bv[2][2];
#pragma unroll
            for (int bj = 0; bj < 2; ++bj)
#pragma unroll
                for (int n = 0; n < 2; ++n) bv[bj][n] = *(const f32x4*)(bgate + lc0 + bj * HALF + 4 * n) * NL2E;
#pragma unroll
            for (int ai = 0; ai < 2; ++ai)
#pragma unroll
                for (int m = 0; m < 4; ++m) { const int row = row0 + ai * HALF + m * 16;
                    const float rs = rsv[ai][m] * NL2E;
                    unsigned char* rowp = GT + (size_t)row * 4096 + lc0;
#pragma unroll
                    for (int bj = 0; bj < 2; ++bj) { const f32x4 v0 = acc[ai][bj][m][0] * rs + bv[bj][0], v1 = acc[ai][bj][m][1] * rs + bv[bj][1];
                        typedef unsigned u32x2_t __attribute__((ext_vector_type(2)));
                        u32x2_t w; w.x = pack_u8x4(sig255(v0[0]), sig255(v0[1]), sig255(v0[2]), sig255(v0[3])); w.y = pack_u8x4(sig255(v1[0]), sig255(v1[1]), sig255(v1[2]), sig255(v1[3]));
                        *(u32x2_t*)(rowp + bj * HALF) = w; } }
        } else {
            const int lc0 = u.pn * BM + wc * 32 + 8 * fq;
#pragma unroll
            for (int ai = 0; ai < 2; ++ai)
#pragma unroll
                for (int m = 0; m < 4; ++m) { const int row = row0 + ai * HALF + m * 16;
                    const float rs = rsv[ai][m];
                    bf16_t* rowp = PM + (size_t)row * 1792 + lc0;
#pragma unroll
                    for (int bj = 0; bj < 2; ++bj) { const f32x4 v0 = acc[ai][bj][m][0] * rs, v1 = acc[ai][bj][m][1] * rs;
                        u32x4 w; w.x = cvt_pk_bf16(v0[0], v0[1]); w.y = cvt_pk_bf16(v0[2], v0[3]); w.z = cvt_pk_bf16(v1[0], v1[1]); w.w = cvt_pk_bf16(v1[2], v1[3]);
                        *(u32x4*)(rowp + bj * HALF) = w; } }
        }
    }
};
struct EpiResid {
    static constexpr bool PERM = true, AFTER_DRAIN = false, RSTD_LDS = false, XPREFETCH = true;
    bf16_t* XB; float* ssq;
    __device__ __forceinline__ void prefetch(const Unit& u, PG8_LAS unsigned char* dump, int tid) const {
        const unsigned vo = (unsigned)(tid >> 2) * 2048u + (unsigned)(tid & 3) * 128u;
        const char* base = (const char*)(XB + (size_t)u.pm * BM * 1024 + u.pn * BM);
        __builtin_amdgcn_global_load_lds((const unsigned*)(base + vo), (PG8_LAS unsigned*)dump, 4, 0, 0);
        __builtin_amdgcn_global_load_lds((const unsigned*)(base + (size_t)128 * 2048 + vo), (PG8_LAS unsigned*)dump, 4, 0, 0);
    }
    __device__ __forceinline__ void operator()(const f32x4 (&acc)[2][2][4][2], const Unit& u, int wr, int wc, int fr, int fq) const {
        const int row0 = u.pm * BM + wr * 64 + fr, col0 = u.pn * BM + wc * 32 + 8 * fq;
#pragma unroll
        for (int ai = 0; ai < 2; ++ai)
#pragma unroll
            for (int m = 0; m < 4; ++m) { const int row = row0 + ai * HALF + m * 16;
                bf16_t* dstb = XB + (size_t)row * 1024 + col0; float ss = 0.f;
                f32x4 x0[2], x1[2];
                {
#pragma unroll
                    for (int bj = 0; bj < 2; ++bj) { const u32x4 q = *(const u32x4*)(dstb + bj * HALF);
                        x0[bj] = (f32x4){__builtin_bit_cast(float, q.x << 16), __builtin_bit_cast(float, q.x & 0xffff0000u), __builtin_bit_cast(float, q.y << 16), __builtin_bit_cast(float, q.y & 0xffff0000u)};
                        x1[bj] = (f32x4){__builtin_bit_cast(float, q.z << 16), __builtin_bit_cast(float, q.z & 0xffff0000u), __builtin_bit_cast(float, q.w << 16), __builtin_bit_cast(float, q.w & 0xffff0000u)}; } }
#pragma unroll
                for (int bj = 0; bj < 2; ++bj) { const f32x4 o0 = x0[bj] + acc[ai][bj][m][0], o1 = x1[bj] + acc[ai][bj][m][1];
                    u32x4 w; w.x = cvt_pk_bf16(o0[0], o0[1]); w.y = cvt_pk_bf16(o0[2], o0[3]); w.z = cvt_pk_bf16(o1[0], o1[1]); w.w = cvt_pk_bf16(o1[2], o1[3]);
                    *(u32x4*)(dstb + bj * HALF) = w;
                    ss += ((o0[0] * o0[0] + o0[1] * o0[1]) + (o0[2] * o0[2] + o0[3] * o0[3])) + ((o1[0] * o1[0] + o1[1] * o1[1]) + (o1[2] * o1[2] + o1[3] * o1[3])); }
                ss += __shfl_xor(ss, 16); ss += __shfl_xor(ss, 32);
                if (fq == 0) ssq[((size_t)u.pn * 17408 + row) * 4 + wc] = ss; }
    }
};
struct EpiSwiGLU {
    static constexpr bool PERM = true, AFTER_DRAIN = false, RSTD_LDS = true, XPREFETCH = false;
    bf16_t* ACT; const float* ssq; const PG8_LAS float* rl;
    __device__ __forceinline__ void operator()(const f32x4 (&acc)[2][2][4][2], const Unit& u, int wr, int wc, int fr, int fq) const {
        const int row0 = u.pm * BM + wr * 64 + fr, col0 = u.pn * HALF + wc * 32 + 8 * fq;
        float rsv[2][4]; rows_rstd_lds(rl, wr * 64 + fr, rsv);
#pragma unroll
        for (int ai = 0; ai < 2; ++ai)
#pragma unroll
            for (int m = 0; m < 4; ++m) { const int row = row0 + ai * HALF + m * 16;
                const float rs = rsv[ai][m], rsn = rs * -1.4426950408889634f, rs2 = rs * rs;
                float o[8];
#pragma unroll
                for (int j = 0; j < 4; ++j) { const float a0 = acc[ai][0][m][0][j], a1 = acc[ai][0][m][1][j];
                    o[j] = (a0 * acc[ai][1][m][0][j]) * (__builtin_amdgcn_rcpf(1.0f + __builtin_amdgcn_exp2f(a0 * rsn)) * rs2); o[4 + j] = (a1 * acc[ai][1][m][1][j]) * (__builtin_amdgcn_rcpf(1.0f + __builtin_amdgcn_exp2f(a1 * rsn)) * rs2); }
                u32x4 w; w.x = cvt_pk_bf16(o[0], o[1]); w.y = cvt_pk_bf16(o[2], o[3]); w.z = cvt_pk_bf16(o[4], o[5]); w.w = cvt_pk_bf16(o[6], o[7]);
                *(u32x4*)(ACT + (size_t)row * 2816 + col0) = w; }
    }
};

template <class Epi, class Sched, bool ALIGN_EPI = false, bool SP2 = false>
__device__ __forceinline__ void gemm_phase(PG8_LAS unsigned char* lds, const Gemm g, const Sched& S, const Epi& E, int tidp) {
    int tid_ = tidp; asm volatile("" : "+v"(tid_));
    const int tid = tid_, wid = __builtin_amdgcn_readfirstlane(tid >> 6), lane = tid & 63, wr = wid >> 2, wc = wid & 3, fr = lane & 15, fq = lane >> 4;
    const int K = g.K, nt = K / BK;
    unsigned voffA[2], voffB[2];
#pragma unroll
    for (int i = 0; i < 2; ++i) { int R, C; stage_rc(tid * 16 + i * 8192, R, C); const int Rb = Epi::PERM ? ((R & ~31) + perm32(R & 31)) : R;
        voffA[i] = (unsigned)(R * K + C) * 2u; voffB[i] = (unsigned)(Rb * K + C) * 2u; }
    const size_t kstep = (size_t)(BK * 2);
    const size_t hstep = (size_t)HALF * K * 2;
    const size_t tstep = 2 * hstep;
    const unsigned ldsw = (unsigned)wid * 1024u;
    const int aoff = lds_byte(wr * 64 + fr, fq * 8), boff = lds_byte(wc * 32 + fr, fq * 8);
#define PG8_SA(b, h) (((b) * 2 + (h)) * HTB)
#define PG8_SB(b, h) ((4 + (b) * 2 + (h)) * HTB)
#define PG8_STAGE(bufoff, gbase, voff) do { _Pragma("unroll") for (int _i = 0; _i < 2; ++_i) \
        __builtin_amdgcn_global_load_lds((const unsigned*)((const char*)(gbase) + (voff)[_i]), (PG8_LAS unsigned*)(lds + (bufoff) + ldsw + _i * 8192), 16, 0, 0); } while (0)
#define PG8_LDA(dst, b, h) do { _Pragma("unroll") for (int m = 0; m < 4; ++m) _Pragma("unroll") for (int k = 0; k < 2; ++k) dst[m][k] = *(const PG8_LAS bf16x8*)(lds + PG8_SA(b, h) + aoff + m * 2048 + k * 1024); } while (0)
#define PG8_LDB(dst, b, h) do { _Pragma("unroll") for (int n = 0; n < 2; ++n) _Pragma("unroll") for (int k = 0; k < 2; ++k) dst[n][k] = *(const PG8_LAS bf16x8*)(lds + PG8_SB(b, h) + boff + n * 2048 + k * 1024); } while (0)
#define PG8_MMA(ai, bj, At, Bt) do { __builtin_amdgcn_s_setprio(1); _Pragma("unroll") for (int m = 0; m < 4; ++m) _Pragma("unroll") for (int n = 0; n < 2; ++n) _Pragma("unroll") for (int k = 0; k < 2; ++k) \
        acc[ai][bj][m][n] = __builtin_amdgcn_mfma_f32_16x16x32_bf16(Bt[n][k], At[m][k], acc[ai][bj][m][n], 0, 0, 0); __builtin_amdgcn_s_setprio(0); } while (0)
#define PG8_WAIT_V(n) asm volatile("s_waitcnt vmcnt(" #n ")" ::: "memory")
#define PG8_WAIT_L(n) asm volatile("s_waitcnt lgkmcnt(" #n ")" ::: "memory")
#define PG8_BAR __builtin_amdgcn_s_barrier()
#define PG8_SCHED __builtin_amdgcn_sched_barrier(0)
    Unit cur, nxt; int ui = 0;
    if (!S.next(0, cur)) return;
    f32x4 acc[2][2][4][2];
#pragma unroll
    for (int a = 0; a < 2; ++a)
#pragma unroll
        for (int b = 0; b < 2; ++b)
#pragma unroll
            for (int m = 0; m < 4; ++m)
#pragma unroll
                for (int n = 0; n < 2; ++n) acc[a][b][m][n] = (f32x4){0.f, 0.f, 0.f, 0.f};
    bf16x8 At[4][2], B0[2][2], B1[2][2];
    const char* cA = (const char*)g.A + (size_t)cur.pm * tstep; const char* cB = (const char*)g.Bt + (size_t)cur.pn * tstep;
    S.a_ready(cur);
    if constexpr (SP2) {
        PG8_STAGE(PG8_SB(0, 0), cB, voffB); PG8_STAGE(PG8_SB(0, 1), cB + hstep, voffB); PG8_STAGE(PG8_SA(0, 0), cA, voffA); PG8_STAGE(PG8_SA(0, 1), cA + hstep, voffA);
        if (wr == 1) PG8_BAR;
        PG8_WAIT_V(2); PG8_BAR;
        PG8_STAGE(PG8_SB(1, 0), cB + kstep, voffB); PG8_STAGE(PG8_SA(1, 0), cA + kstep, voffA); PG8_STAGE(PG8_SB(1, 1), cB + hstep + kstep, voffB);
        PG8_WAIT_V(6); PG8_BAR;
    } else {
        PG8_STAGE(PG8_SB(0, 0), cB, voffB); PG8_STAGE(PG8_SA(0, 0), cA, voffA); PG8_STAGE(PG8_SB(0, 1), cB + hstep, voffB); PG8_STAGE(PG8_SA(0, 1), cA + hstep, voffA);
        if (wr == 1) PG8_BAR;
        PG8_WAIT_V(4); PG8_BAR;
        PG8_STAGE(PG8_SB(1, 0), cB + kstep, voffB); PG8_STAGE(PG8_SA(1, 0), cA + kstep, voffA); PG8_STAGE(PG8_SB(1, 1), cB + hstep + kstep, voffB);
        PG8_WAIT_V(6); PG8_BAR;
    }
    for (;;) {
        const bool has_next = S.next(ui + 1, nxt);
        const char* nA = has_next ? (const char*)g.A + (size_t)nxt.pm * tstep : cA; const char* nB = has_next ? (const char*)g.Bt + (size_t)nxt.pn * tstep : cB;
#ifdef DBG_KLOOP_T
        if (ui == DBG_KLOOP_UNIT + 1 && blockIdx.x == DBG_T_BLK && tid == 0 && ((volatile PG8_LAS unsigned*)(lds + 147456 + 320 + 200))[0] == 1u) { ((volatile PG8_LAS unsigned long long*)(lds + 147456 + 320 + 256))[8] = __builtin_amdgcn_s_memtime(); }
        if (ui == DBG_KLOOP_UNIT && blockIdx.x == DBG_T_BLK && tid == 0 && ((volatile PG8_LAS unsigned*)(lds + 147456 + 320 + 200))[0] == 1u) { ((volatile PG8_LAS unsigned long long*)(lds + 147456 + 320 + 256))[4] = __builtin_amdgcn_s_memtime(); ((volatile PG8_LAS unsigned long long*)(lds + 147456 + 320 + 256))[5] = __builtin_amdgcn_s_memrealtime(); }
#endif
        for (int t = 0; t < nt; t += 2) {
            const bool last = (t == nt - 2);
            if constexpr (Epi::RSTD_LDS) {
                if (t == 2 || t == 4) { PG8_WAIT_V(8);
                    const f32x4 v = *(const PG8_LAS f32x4*)(lds + RSTD_RAW_OFF + ldsw + lane * 16);
                    float s = (v[0] + v[1]) + (v[2] + v[3]); s += __shfl_xor(s, 1); s += __shfl_xor(s, 2);
                    if (!(tid & 3)) *(PG8_LAS float*)(lds + RSTD_LDS_OFF + ((t - 2) * 64 + (tid >> 2)) * 4) = __builtin_amdgcn_rsqf(s * (1.0f / 1024.0f) + 1e-6f);
                    PG8_WAIT_L(0); }
                if (t == 0 || t == 2) __builtin_amdgcn_global_load_lds((const unsigned*)(E.ssq + ((size_t)(tid & 3) * 17408 + (size_t)cur.pm * BM + t * 64 + (tid >> 2)) * 4), (PG8_LAS unsigned*)(lds + RSTD_RAW_OFF + ldsw), 16, 0, 0);
            }
            if constexpr (Epi::XPREFETCH) { if (t == nt - XPF_LEAD) E.prefetch(cur, lds + RSTD_RAW_OFF + ldsw, tid); }
            const char* a1 = cA + (size_t)(t + 1) * kstep;
            const char* a2 = last ? nA : cA + (size_t)(t + 2) * kstep; const char* b2 = last ? nB : cB + (size_t)(t + 2) * kstep;
            const char* a3 = a2 + kstep; const char* b3 = b2 + kstep;
            if (last && has_next) S.a_ready(nxt);
            if constexpr (SP2) {
            PG8_LDB(B0, 0, 0); PG8_LDB(B1, 0, 1); PG8_SCHED; PG8_LDA(At, 0, 0); PG8_STAGE(PG8_SA(1, 1), a1 + hstep, voffA);
            PG8_WAIT_V(8); PG8_WAIT_L(0); PG8_BAR; PG8_MMA(0, 0, At, B0); PG8_MMA(0, 1, At, B1); PG8_BAR; PG8_SCHED;
            PG8_LDA(At, 0, 1); PG8_STAGE(PG8_SB(0, 0), b2, voffB); PG8_STAGE(PG8_SB(0, 1), b2 + hstep, voffB); PG8_STAGE(PG8_SA(0, 0), a2, voffA);
            PG8_WAIT_V(8); PG8_WAIT_L(0); PG8_BAR; PG8_MMA(1, 0, At, B0); PG8_MMA(1, 1, At, B1); PG8_BAR; PG8_SCHED;
            PG8_LDB(B0, 1, 0); PG8_LDB(B1, 1, 1); PG8_SCHED; PG8_LDA(At, 1, 0); PG8_STAGE(PG8_SA(0, 1), a2 + hstep, voffA);
            PG8_WAIT_V(8); PG8_WAIT_L(0); PG8_BAR; PG8_MMA(0, 0, At, B0); PG8_MMA(0, 1, At, B1); PG8_BAR; PG8_SCHED;
            PG8_LDA(At, 1, 1); PG8_STAGE(PG8_SB(1, 0), b3, voffB); PG8_STAGE(PG8_SB(1, 1), b3 + hstep, voffB); PG8_STAGE(PG8_SA(1, 0), a3, voffA);
            PG8_WAIT_V(8); PG8_WAIT_L(0); PG8_BAR; PG8_MMA(1, 0, At, B0); PG8_MMA(1, 1, At, B1); PG8_BAR; PG8_SCHED;
            } else {
            PG8_LDB(B0, 0, 0); PG8_SCHED; PG8_LDA(At, 0, 0); PG8_STAGE(PG8_SA(1, 1), a1 + hstep, voffA);
            PG8_WAIT_L(8); PG8_BAR; PG8_WAIT_L(0); PG8_MMA(0, 0, At, B0); PG8_BAR; PG8_SCHED;
            PG8_LDB(B1, 0, 1); PG8_STAGE(PG8_SB(0, 0), b2, voffB);
            PG8_BAR; PG8_WAIT_L(0); PG8_MMA(0, 1, At, B1); PG8_BAR;
            PG8_LDA(At, 0, 1); PG8_STAGE(PG8_SA(0, 0), a2, voffA);
            PG8_BAR; PG8_WAIT_L(0); PG8_MMA(1, 0, At, B0); PG8_BAR; PG8_SCHED;
            PG8_STAGE(PG8_SB(0, 1), b2 + hstep, voffB);
            PG8_WAIT_V(6); PG8_BAR; PG8_MMA(1, 1, At, B1); PG8_BAR;
            PG8_LDB(B0, 1, 0); PG8_SCHED; PG8_LDA(At, 1, 0); PG8_STAGE(PG8_SA(0, 1), a2 + hstep, voffA);
            PG8_WAIT_L(8); PG8_BAR; PG8_WAIT_L(0); PG8_MMA(0, 0, At, B0); PG8_BAR; PG8_SCHED;
            PG8_LDB(B1, 1, 1); PG8_STAGE(PG8_SB(1, 0), b3, voffB);
            PG8_BAR; PG8_WAIT_L(0); PG8_MMA(0, 1, At, B1); PG8_BAR;
            PG8_LDA(At, 1, 1); PG8_STAGE(PG8_SA(1, 0), a3, voffA);
            PG8_BAR; PG8_WAIT_L(0); PG8_MMA(1, 0, At, B0); PG8_BAR; PG8_SCHED;
            PG8_STAGE(PG8_SB(1, 1), b3 + hstep, voffB);
            PG8_WAIT_V(6); PG8_BAR; PG8_MMA(1, 1, At, B1); PG8_BAR;
            }
        }
#ifdef DBG_KLOOP_T
        if (ui == DBG_KLOOP_UNIT && blockIdx.x == DBG_T_BLK && tid == 0 && ((volatile PG8_LAS unsigned*)(lds + 147456 + 320 + 200))[0] == 1u) { ((volatile PG8_LAS unsigned long long*)(lds + 147456 + 320 + 256))[6] = __builtin_amdgcn_s_memtime(); ((volatile PG8_LAS unsigned long long*)(lds + 147456 + 320 + 256))[7] = __builtin_amdgcn_s_memrealtime(); }
#endif
        if constexpr (ALIGN_EPI) { if (wr == 0) PG8_BAR; }
        if constexpr (!Epi::AFTER_DRAIN) { E(acc, cur, wr, wc, fr, fq); S.done(cur); }
        if (!has_next) break;
#pragma unroll
        for (int a = 0; a < 2; ++a)
#pragma unroll
            for (int b = 0; b < 2; ++b)
#pragma unroll
                for (int m = 0; m < 4; ++m)
#pragma unroll
                    for (int n = 0; n < 2; ++n) acc[a][b][m][n] = (f32x4){0.f, 0.f, 0.f, 0.f};
        cur = nxt; cA = nA; cB = nB; ++ui;
        if constexpr (ALIGN_EPI) { if (wr == 1) PG8_BAR; }
    }
    PG8_WAIT_V(0);
    if constexpr (!ALIGN_EPI) { if (wr == 0) PG8_BAR; }
    PG8_BAR;
    if constexpr (Epi::AFTER_DRAIN) { E.fused(acc, cur, wr, wc, fr, fq, lds, wid, lane); S.done(cur); }
#undef PG8_SA
#undef PG8_SB
#undef PG8_STAGE
#undef PG8_LDA
#undef PG8_LDB
#undef PG8_MMA
#undef PG8_WAIT_V
#undef PG8_WAIT_L
#undef PG8_BAR
#undef PG8_SCHED
}
}
constexpr int D = 1024, MP = 16384, MS = 1024, M = MP + MS, NLAYER = 4, MIXW = 256, INC = 5888, PMC = 1792, GTC = 4096, FF = 2816;
constexpr int SEQ = 2048, NB = 8, DB = 128, DSEQ = 8, NCH = SEQ / 64;
constexpr int NPHASE = 2 + 7 * NLAYER;
#ifndef MK_PER_PHASE
#define MK_PER_PHASE 0
#endif
constexpr size_t O_Y = 0, O_POOLP = 17825792, O_POOLS = 17948672, O_SREP = 19914752, O_SRES = 19947520, O_SIMP = 20471808, O_SIMS = 20504576,
                 O_SCP = 21028864, O_SCS = 21045248, O_CFP = 21307392, O_CFS = 21553152, O_END = 25485312;
constexpr size_t MiB = 1u << 20;
constexpr size_t WS_CTL = 0, CTL_ZERO_BYTES = 64 * 1024;
constexpr size_t WS_SSQ = 1 * MiB;
constexpr size_t WS_E = 3 * MiB;
constexpr size_t WS_TAB = 5 * MiB;
constexpr size_t TAB_LB = 0, TAB_LP = 8192, TAB_BBT = 16384, TAB_CM = TAB_BBT + 65536, TAB_PW = TAB_CM + 65536, TAB_STRIDE = TAB_PW + 32768;
constexpr size_t WS_WIN = 6 * MiB;
constexpr size_t WS_WFI = WS_WIN + (size_t)NLAYER * INC * D * 2;
constexpr size_t WS_WOUT = WS_WFI + (size_t)NLAYER * 2 * FF * D * 2;
constexpr size_t WS_WFO = WS_WOUT + (size_t)NLAYER * D * D * 2;
constexpr size_t WS_WBR = WS_WFO + (size_t)NLAYER * D * FF * 2;
constexpr size_t WS_WGLU = WS_WBR + (size_t)NLAYER * 4 * D * MIXW * 2;
constexpr size_t WS_ACT1 = WS_WGLU + (size_t)NLAYER * MIXW * MIXW * 2;
constexpr size_t WS_PM = WS_ACT1 + (size_t)M * D * 2;
constexpr size_t WS_GT = WS_PM + (size_t)M * PMC * 2;
constexpr size_t WS_END = WS_GT + (size_t)M * GTC * 2;
static_assert(WS_TAB + NLAYER * TAB_STRIDE <= WS_WIN && WS_E + (size_t)NB * NCH * 1024 * 8 <= WS_TAB && WS_SSQ + (size_t)M * 64 <= WS_E, "d_ws map");
constexpr int CW_Q = 8192;
constexpr int CW_BAR = 1024;
constexpr int RING_OFF = 0, RING_BYTES = 147456;
constexpr int LDSCTL_OFF = RING_BYTES, MISC_OFF = LDSCTL_OFF + 320;
constexpr int LDS_BYTES = 163840;
constexpr int NWAVES = 8;

#define GAS __attribute__((address_space(1)))
#define LAS __attribute__((address_space(3)))
typedef unsigned short bf16;
typedef unsigned short bf16_t;
typedef unsigned v4u __attribute__((ext_vector_type(4)));
typedef unsigned v2u __attribute__((ext_vector_type(2)));
typedef float f32x4 __attribute__((ext_vector_type(4)));
typedef float f32x2 __attribute__((ext_vector_type(2)));
typedef short bf16x8 __attribute__((ext_vector_type(8)));
#define LDS_WAIT() asm volatile("s_waitcnt lgkmcnt(0)" ::: "memory")
#define VM_WAIT() asm volatile("s_waitcnt vmcnt(0)" ::: "memory")
__device__ __forceinline__ unsigned pk2(float lo, float hi) { return pg8::cvt_pk_bf16(lo, hi); }
__device__ __forceinline__ float bflo(unsigned u) { return __builtin_bit_cast(float, u << 16); }
__device__ __forceinline__ float bfhi(unsigned u) { return __builtin_bit_cast(float, u & 0xffff0000u); }
__device__ __forceinline__ float bf1(bf16_t b) { return __builtin_bit_cast(float, (unsigned)b << 16); }
__device__ __forceinline__ void unpack8(const v4u v, float (&f)[8]) { f[0] = bflo(v.x); f[1] = bfhi(v.x); f[2] = bflo(v.y); f[3] = bfhi(v.y); f[4] = bflo(v.z); f[5] = bfhi(v.z); f[6] = bflo(v.w); f[7] = bfhi(v.w); }
__device__ __forceinline__ v4u pack8(const float (&f)[8]) { v4u w; w.x = pk2(f[0], f[1]); w.y = pk2(f[2], f[3]); w.z = pk2(f[4], f[5]); w.w = pk2(f[6], f[7]); return w; }
__device__ __forceinline__ float sigm(float x) { return pg8::sigm(x); }
__device__ __forceinline__ float gelu_tanh(float y) { const float in2 = 1.5957691216057308f * (y + 0.044715f * y * y * y); const float e = __builtin_amdgcn_exp2f(1.4426950408889634f * in2); return 0.5f * y * (2.0f - 2.0f * __builtin_amdgcn_rcpf(e + 1.0f)); }
__device__ __forceinline__ float wave_sum(float v) {
#pragma unroll
    for (int o = 1; o < 64; o <<= 1) v += __shfl_xor(v, o);
    return v;
}

#define XB_TMO      128
#define XB_XCNT(j)  (256  + 64 * (j))
#define XB_XSUB(j)  (1280 + 64 * (j))
#define XB_XGEN(j)  (2304 + 64 * (j))
#define XB_TOP      3328
#define XB_TOPGEN   3392
#define XCD_BAR_WORDS 3456
#define XB_SPIN_CAP (1u << 18)

__device__ __forceinline__ unsigned xb_ld(unsigned* p)              { return __hip_atomic_load(p, __ATOMIC_RELAXED, __HIP_MEMORY_SCOPE_AGENT); }
__device__ __forceinline__ unsigned xb_add(unsigned* p, unsigned v) { return __hip_atomic_fetch_add(p, v, __ATOMIC_RELAXED, __HIP_MEMORY_SCOPE_AGENT); }
__device__ __forceinline__ unsigned xb_xcc_id() { return (unsigned)__builtin_amdgcn_s_getreg((3 << 11) | 20) & 0xFu; }
#define XB_SPIN(cond, bar) do { unsigned _sp = 0; while (cond) { __builtin_amdgcn_s_sleep(1); \
    if ((++_sp & 255u) == 0u) { if (xb_ld(&(bar)[XB_TMO])) break; if (_sp > XB_SPIN_CAP) { atomicAdd(&(bar)[XB_TMO], 1u); break; } } } } while (0)

struct XcdBarrier {
    unsigned* bar; unsigned x;
    volatile LAS unsigned* st;
};

__device__ __forceinline__ XcdBarrier xcd_barrier_post(unsigned* bar, volatile LAS unsigned* st) {
    XcdBarrier b; b.bar = bar; b.x = xb_xcc_id(); b.st = st;
    if (threadIdx.x == 0) (void)xb_add(&bar[XB_XCNT(b.x)], 1u);
    return b;
}
__device__ __forceinline__ void xcd_barrier_complete(unsigned* bar, unsigned x, unsigned& nloc, unsigned& nx) {
    const unsigned G = gridDim.x * gridDim.y * gridDim.z;
    unsigned sum, cnt, mine, sp = 0u;
    for (;;) {
        sum = 0u; cnt = 0u; mine = 0u;
#pragma unroll
        for (unsigned j = 0; j < 16; ++j) { const unsigned c = xb_ld(&bar[XB_XCNT(j)]); sum += c; cnt += (c > 0u) ? 1u : 0u; mine = (j == x) ? c : mine; }
        if (sum == G) break;
        __builtin_amdgcn_s_sleep(1);
        if ((++sp & 255u) == 0u) { if (xb_ld(&bar[XB_TMO])) break; if (sp > XB_SPIN_CAP) { atomicAdd(&bar[XB_TMO], 1u); break; } }
    }
    nloc = mine > 0u ? mine : 1u; nx = cnt > 0u ? cnt : 1u;
}

__device__ __forceinline__ void xcd_barrier_leader(const XcdBarrier& b) {
    {
        unsigned* bar = b.bar;
        __builtin_amdgcn_s_waitcnt(0);
        unsigned nloc = b.st[0], nx = b.st[1];
        if (nloc == 0u) { xcd_barrier_complete(bar, b.x, nloc, nx); b.st[0] = nloc; b.st[1] = nx; }
        const unsigned old = xb_add(&bar[XB_XSUB(b.x)], 1u);
        const unsigned gen = old / nloc;
        if (old + 1u == (gen + 1u) * nloc) {
            __builtin_amdgcn_fence(__ATOMIC_RELEASE, "agent");
            asm volatile("s_waitcnt vmcnt(0)" ::: "memory");
            const unsigned og = xb_add(&bar[XB_TOP], 1u);
            const unsigned tg = og / nx;
            if (og + 1u == (tg + 1u) * nx) xb_add(&bar[XB_TOPGEN], 1u);
            else XB_SPIN(xb_ld(&bar[XB_TOPGEN]) == tg, bar);
            __builtin_amdgcn_fence(__ATOMIC_ACQUIRE, "agent");
            xb_add(&bar[XB_XGEN(b.x)], 1u);
            asm volatile("s_waitcnt vmcnt(0)" ::: "memory");
        } else {
            XB_SPIN(xb_ld(&bar[XB_XGEN(b.x)]) == gen, bar);
            __builtin_amdgcn_fence(__ATOMIC_ACQUIRE, "agent");
            asm volatile("s_waitcnt vmcnt(0)" ::: "memory");
        }
    }
}
__device__ __forceinline__ void xcd_barrier(const XcdBarrier& b, bool leader) {
    asm volatile("s_waitcnt vmcnt(0)" ::: "memory");
    __syncthreads();
    if (leader) xcd_barrier_leader(b);
    __syncthreads();
}
struct Args { const float* in[32]; float* out; unsigned char* ws; int ph_lo, ph_hi; };
enum { I_XP = 0, I_XS, I_STPOOL, I_STRE, I_STIM, I_STSC, I_STCF, I_N1G, I_N2G, I_FING, I_WIN, I_BGATE, I_POOLW, I_POOLSC, I_LAMRE, I_LAMIM, I_LOGDT,
       I_BRE, I_BIM, I_CRE, I_CIM, I_DSKIP, I_WGLU, I_BGLU, I_SCW, I_CFW, I_CFLNG, I_CFLNB, I_WBR, I_WOUT, I_WFI, I_WFO };

__device__ __forceinline__ void p0_item(const float* W, int ldw, int src_col0, const float* kscale, int k0, bf16* WTrow0, int K, LAS float* scr, int lane) {
    float wv[32];
#pragma unroll
    for (int i = 0; i < 32; ++i) { const int kk = 2 * i + (lane >> 5); wv[i] = W[(size_t)(k0 + kk) * ldw + src_col0 + (lane & 31)]; }
#pragma unroll
    for (int i = 0; i < 32; ++i) { const int kk = 2 * i + (lane >> 5); scr[kk * 33 + (lane & 31)] = wv[i]; }
    LDS_WAIT(); asm volatile("" ::: "memory");
    const int c = lane & 7;
    f32x4 ks0 = (f32x4){1.f, 1.f, 1.f, 1.f}, ks1 = ks0;
    if (kscale) { ks0 = *(const f32x4*)(kscale + k0 + 8 * c); ks1 = *(const f32x4*)(kscale + k0 + 8 * c + 4); }
#pragma unroll
    for (int j = 0; j < 4; ++j) { const int n = (lane >> 3) + 8 * j; const LAS float* s = scr + (8 * c) * 33 + n;
        v4u o; o.x = pk2(s[0 * 33] * ks0[0], s[1 * 33] * ks0[1]); o.y = pk2(s[2 * 33] * ks0[2], s[3 * 33] * ks0[3]); o.z = pk2(s[4 * 33] * ks1[0], s[5 * 33] * ks1[1]); o.w = pk2(s[6 * 33] * ks1[2], s[7 * 33] * ks1[3]);
        *(GAS v4u*)(WTrow0 + (size_t)n * K + k0 + 8 * c) = o; }
    LDS_WAIT(); asm volatile("" ::: "memory");
}
constexpr int P0_IT_IN = 16 * (INC / 32), P0_IT_FI = 16 * (2 * FF / 32), P0_IT_OUT = 16 * 32, P0_IT_FO = (FF / 64) * 32, P0_IT_BR = 4 * 4 * 32, P0_IT_GLU = 4 * 8;
constexpr int P0_IT_LAYER = P0_IT_IN + P0_IT_FI + P0_IT_OUT + P0_IT_FO + P0_IT_BR + P0_IT_GLU;
__device__ __forceinline__ void p0_weight_item(const Args& a, int L, int r, LAS float* scr, int lane) {
    unsigned char* ws = a.ws;
    if (r < P0_IT_IN) { const int nblk = INC / 32, kb = r / nblk, nb = r % nblk;
        p0_item(a.in[I_WIN] + (size_t)L * D * INC, INC, 32 * nb, a.in[I_N1G] + L * D, 64 * kb, (bf16*)(ws + WS_WIN) + ((size_t)L * INC + 32 * nb) * D, D, scr, lane); return; } r -= P0_IT_IN;
    if (r < P0_IT_FI) { const int nblk = 2 * FF / 32, kb = r / nblk, nb = r % nblk; const int nd = 32 * nb, pn = nd >> 8, rr = nd & 255;
        const int src = rr < 128 ? 128 * pn + rr : FF + 128 * pn + (rr - 128);
        p0_item(a.in[I_WFI] + (size_t)L * D * 2 * FF, 2 * FF, src, a.in[I_N2G] + L * D, 64 * kb, (bf16*)(ws + WS_WFI) + ((size_t)L * 2 * FF + nd) * D, D, scr, lane); return; } r -= P0_IT_FI;
    if (r < P0_IT_OUT) { const int kb = r / 32, nb = r % 32;
        p0_item(a.in[I_WOUT] + (size_t)L * D * D, D, 32 * nb, nullptr, 64 * kb, (bf16*)(ws + WS_WOUT) + ((size_t)L * D + 32 * nb) * D, D, scr, lane); return; } r -= P0_IT_OUT;
    if (r < P0_IT_FO) { const int kb = r / 32, nb = r % 32;
        p0_item(a.in[I_WFO] + (size_t)L * FF * D, D, 32 * nb, nullptr, 64 * kb, (bf16*)(ws + WS_WFO) + ((size_t)L * D + 32 * nb) * FF, FF, scr, lane); return; } r -= P0_IT_FO;
    if (r < P0_IT_BR) { const int br = r / 128, q = r % 128, kb = q / 32, nb = q % 32;
        p0_item(a.in[I_WBR] + (size_t)(L * 4 + br) * MIXW * D, D, 32 * nb, nullptr, 64 * kb, (bf16*)(ws + WS_WBR) + ((size_t)(L * 4 + br) * D + 32 * nb) * MIXW, MIXW, scr, lane); return; } r -= P0_IT_BR;
    { const int kb = r / 8, nb = r % 8;
        p0_item(a.in[I_WGLU] + (size_t)L * MIXW * MIXW, MIXW, 32 * nb, nullptr, 64 * kb, (bf16*)(ws + WS_WGLU) + ((size_t)L * MIXW + 32 * nb) * MIXW, MIXW, scr, lane); }
}
constexpr int P0_SLICES = 6, P0_F_PER = 7, P0_A_PER = 2, P0_F_BID0 = 216, P0_A_BID0 = 192;
__device__ __forceinline__ int p0_items_A(int G) { return 0; }
__device__ __forceinline__ int p0_items_F(int G) { return G == 256 ? (256 - P0_F_BID0) * NWAVES * P0_F_PER : 0; }
__device__ __forceinline__ void p0_idle_items(const Args& a, LAS unsigned char* lds, int lane, int wave, int bid, int L, int base, int bid0, int per) {
    LAS float* scr = (LAS float*)(lds + RING_OFF + wave * 16384);
    const int nw = (256 - bid0) * NWAVES, w = (bid - bid0) * NWAVES + wave;
    for (int q = 0; q < per; ++q) p0_weight_item(a, L, base + w + q * nw, scr, lane);
}
__device__ __forceinline__ void p0_slice(const Args& a, LAS unsigned char* lds, int lane, int wave, int G, int bid, int L, int slice) {
    LAS float* scr = (LAS float*)(lds + RING_OFF + wave * 16384);
    const int first = p0_items_A(G) + p0_items_F(G), per = (P0_IT_LAYER - first + P0_SLICES - 1) / P0_SLICES;
    const int lo = first + slice * per, hi = (lo + per < P0_IT_LAYER) ? lo + per : P0_IT_LAYER;
    for (int r = lo + bid * (NWAVES - 1) + (wave - 1); r < hi; r += G * (NWAVES - 1)) p0_weight_item(a, L, r, scr, lane);
}
__device__ __forceinline__ void p0_prologue(const Args& a, LAS unsigned char* lds, int tid, int lane, int wave, int G, int bid) {
    LAS float* scr = (LAS float*)(lds + RING_OFF + wave * 16384);
    const int gw = bid * NWAVES + wave, NGW = G * NWAVES;
    unsigned char* ws = a.ws;
    for (int it = gw; it < (MK_PER_PHASE ? NLAYER : 1) * P0_IT_LAYER; it += NGW) p0_weight_item(a, it / P0_IT_LAYER, it % P0_IT_LAYER, scr, lane);
    for (int m = gw; m < M; m += NGW) {
        const float* xrow = m < MP ? a.in[I_XP] + (size_t)m * D : a.in[I_XS] + (size_t)(m - MP) * D;
        const GAS f32x4* xr = (const GAS f32x4*)xrow + lane; f32x4 v[4]; float s = 0.f;
#pragma unroll
        for (int j = 0; j < 4; ++j) { v[j] = xr[64 * j]; s += (v[j][0] * v[j][0] + v[j][1] * v[j][1]) + (v[j][2] * v[j][2] + v[j][3] * v[j][3]); }
        s = wave_sum(s);
        GAS v2u* o8 = (GAS v2u*)((bf16*)(ws + WS_ACT1) + (size_t)m * D) + lane;
#pragma unroll
        for (int j = 0; j < 4; ++j) { v2u w; w.x = pk2(v[j][0], v[j][1]); w.y = pk2(v[j][2], v[j][3]); o8[64 * j] = w; }
        if (lane < 16) ((float*)(ws + WS_SSQ))[((size_t)(lane >> 2) * M + m) * 4 + (lane & 3)] = lane == 0 ? s : 0.f;
    }
    for (int idx = bid * 512 + tid; idx < NLAYER * 1024; idx += G * 512) {
        const int L = idx >> 10, gp = idx & 1023, g = gp >> 6, p = gp & 63;
        unsigned char* tab = ws + WS_TAB + (size_t)L * TAB_STRIDE;
        const float lre = a.in[I_LAMRE][idx], lim = a.in[I_LAMIM][idx], dt = expf(a.in[I_LOGDT][L * 16 + g]);
        const float ar = lre * dt, br_ = lim * dt, ea = expf(ar), cb = cosf(br_), sb = sinf(br_), sh = sinf(0.5f * br_);
        const float lbr = ea * cb, lbi = ea * sb;
        const float m1r = expm1f(ar) * cb - 2.0f * sh * sh, m1i = lbi;
        const float den = 1.0f / (lre * lre + lim * lim);
        const float qr = (m1r * lre + m1i * lim) * den, qi = (m1i * lre - m1r * lim) * den;
        ((f32x2*)(tab + TAB_LB))[gp] = (f32x2){lbr, lbi};
        float pr = lbr, pi = lbi;
#pragma unroll
        for (int s = 0; s < 6; ++s) { const float nr = pr * pr - pi * pi, ni = 2.0f * pr * pi; pr = nr; pi = ni; }
        ((f32x2*)(tab + TAB_LP))[gp] = (f32x2){pr, pi};
        bf16* bbt = (bf16*)(tab + TAB_BBT); bf16* cm = (bf16*)(tab + TAB_CM);
        const float* bre = a.in[I_BRE] + (size_t)idx * 16; const float* bim = a.in[I_BIM] + (size_t)idx * 16;
#pragma unroll
        for (int c = 0; c < 16; ++c) { const float Br = bre[c], Bi = bim[c];
            bbt[(g * 128 + p) * 16 + c] = (bf16)(pk2(qr * Br - qi * Bi, 0.f) & 0xffffu);
            bbt[(g * 128 + 64 + p) * 16 + c] = (bf16)(pk2(qr * Bi + qi * Br, 0.f) & 0xffffu);
            cm[(g * 16 + c) * 128 + p] = (bf16)(pk2(a.in[I_CRE][((size_t)(L * 16 + g) * 16 + c) * 64 + p], 0.f) & 0xffffu);
            cm[(g * 16 + c) * 128 + 64 + p] = (bf16)(pk2(-a.in[I_CIM][((size_t)(L * 16 + g) * 16 + c) * 64 + p], 0.f) & 0xffffu); }
    }
    for (int idx = bid * 512 + tid; idx < NLAYER * 4 * 64 * 64; idx += G * 512) {
        const int L = idx >> 14, r = idx & 16383, k = r >> 12, o = (r >> 6) & 63, c = r & 63;
        ((bf16*)(ws + WS_TAB + (size_t)L * TAB_STRIDE + TAB_PW))[r] = (bf16)(pk2(a.in[I_POOLW][((size_t)(L * 4 + k) * 64 + c) * 64 + o], 0.f) & 0xffffu);
    }
}
__device__ __forceinline__ void final_norm(const Args& a, int lane, int wave, int G, int bid) {
    const int gw = bid * NWAVES + wave, NGW = G * NWAVES;
    const float* ssq = (const float*)(a.ws + WS_SSQ);
    f32x4 gv[4];
#pragma unroll
    for (int j = 0; j < 4; ++j) gv[j] = ((const f32x4*)a.in[I_FING])[lane + 64 * j];
    for (int m = gw; m < M; m += NGW) {
        float s = lane < 16 ? ssq[((size_t)(lane >> 2) * M + m) * 4 + (lane & 3)] : 0.f; s = wave_sum(s);
        const float rs = __builtin_amdgcn_rsqf(s * (1.0f / 1024.0f) + 1e-6f);
        const GAS v2u* xb = (const GAS v2u*)((const bf16*)(a.ws + WS_ACT1) + (size_t)m * D) + lane;
        GAS f32x4* yr = (GAS f32x4*)(a.out + (size_t)m * D) + lane;
#pragma unroll
#ifdef DBG_HASH_Y
        for (int j = 0; j < 4; ++j) { const v2u q = xb[64 * j]; f32x4 v = (f32x4){bflo(q.x), bfhi(q.x), bflo(q.y), bfhi(q.y)}; v = v * rs * gv[j]; f32x4 h;
            for (int qq = 0; qq < 4; ++qq) { const unsigned b = __float_as_uint(v[qq]); const unsigned hh = (b * 2654435761u) ^ (b >> 15); h[qq] = (float)(hh >> 8) * (1.0f / 16777216.0f); }
            yr[64 * j] = h; }
#else
        for (int j = 0; j < 4; ++j) { const v2u q = xb[64 * j]; const f32x4 v = (f32x4){bflo(q.x), bfhi(q.x), bflo(q.y), bfhi(q.y)}; yr[64 * j] = v * rs * gv[j]; }
#endif
    }
}

typedef float f32x4_t __attribute__((ext_vector_type(4)));
#ifdef DBG_MIX_T
#define MIX_STAMP(i) do { if (((i) == DBG_TA || (i) == DBG_TB) && !SAMPLE && layer == 1 && blockIdx.x == DBG_T_BLK && wave == 0) { const unsigned long long t__ = __builtin_amdgcn_s_memrealtime(); if (lane == 0) ((volatile LAS unsigned long long*)(lds + 131072 + 320 + 256))[16 + (i)] = t__; } } while (0)
#else
#define MIX_STAMP(i) do {} while (0)
#endif
__device__ __forceinline__ float fma_s(float a, float b, float c) { float r; asm("v_fma_f32 %0, %1, %2, %3" : "=v"(r) : "v"(a), "v"(b), "v"(c)); return r; }
template <bool SAMPLE>
__device__ __forceinline__ void mix_unit(const Args& a, int layer, int uidx, LAS unsigned char* lds, int tid_in, int lane_in, int wave_in, int stages) {
    int tid = tid_in; asm volatile("" : "+v"(tid));
    const int lane = tid & 63, wave = __builtin_amdgcn_readfirstlane(tid >> 6);
#ifdef DBG_EXTRA_SYNC
    asm volatile("s_waitcnt vmcnt(0) lgkmcnt(0)" ::: "memory"); __syncthreads();
#endif
    constexpr int L = SAMPLE ? 8 : 64, NSEG = SAMPLE ? 2 : 1, R = NSEG * L;
    const bf16* PMb = (const bf16*)(a.ws + WS_PM); bf16* BR = (bf16*)a.out;
    const int s = uidx >> 5, c = uidx & 31, q0 = 2 * uidx;
    const int row0 = SAMPLE ? MP + q0 * 8 : s * SEQ + 64 * c;
    const bool last = SAMPLE || c == NCH - 1;
    LAS float* V = (LAS float*)lds;
    MIX_STAMP(0);
    if (stages & 1) {
        constexpr int TR = NSEG * (30 + L);
        LAS float* WCF = (LAS float*)(lds + 96256);
        {
            constexpr int NIT = (TR * 32 + 511) / 512;
            v4u qa[NIT], qb[NIT]; int kind[NIT];
#pragma unroll
            for (int it = 0; it < NIT; ++it) {
                const int idx = tid + it * 512; kind[it] = 0; qa[it] = (v4u){0u, 0u, 0u, 0u}; qb[it] = (v4u){0u, 0u, 0u, 0u};
                if (idx < TR * 32) {
                    const int rr = idx >> 5, c8 = (idx & 31) * 8, seg = rr / (30 + L), e = rr % (30 + L);
                    int srow = -1;
                    if (SAMPLE) { if (e >= 30) srow = MP + (q0 + seg) * 8 + (e - 30); }
                    else { const int tabs = c * 64 + e - 30; if (tabs >= 0) srow = s * SEQ + tabs; }
                    if (srow >= 0) { kind[it] = 1; qa[it] = *(const v4u*)(PMb + (size_t)srow * PMC + 1280 + c8); qb[it] = *(const v4u*)(PMb + (size_t)srow * PMC + 1536 + c8); }
                    else if (SAMPLE) { kind[it] = 2; const float* st = a.in[I_STCF] + ((size_t)(layer * DB + q0 + seg) * 30 + e) * MIXW + c8; qa[it] = *(const v4u*)st; qb[it] = *(const v4u*)(st + 4); }
                }
            }
#pragma unroll
            for (int it = 0; it < NIT; ++it) {
                const int idx = tid + it * 512;
                if (idx < TR * 32) {
                    const int rr = idx >> 5, c8 = (idx & 31) * 8;
                    float v[8];
                    if (kind[it] == 1) { float av[8], bv[8]; unpack8(qa[it], av); unpack8(qb[it], bv);
#pragma unroll
                        for (int j = 0; j < 8; ++j) v[j] = av[j] * sigm(bv[j]); }
                    else { v[0] = __uint_as_float(qa[it].x); v[1] = __uint_as_float(qa[it].y); v[2] = __uint_as_float(qa[it].z); v[3] = __uint_as_float(qa[it].w);
                           v[4] = __uint_as_float(qb[it].x); v[5] = __uint_as_float(qb[it].y); v[6] = __uint_as_float(qb[it].z); v[7] = __uint_as_float(qb[it].w); }
                    *(LAS f32x4*)(V + rr * 256 + c8) = (f32x4){v[0], v[1], v[2], v[3]}; *(LAS f32x4*)(V + rr * 256 + c8 + 4) = (f32x4){v[4], v[5], v[6], v[7]};
                }
            }
        }
        { f32x4 wq[4];
#pragma unroll
            for (int it = 0; it < 4; ++it) { const int idx = tid + it * 512; wq[it] = idx < 31 * 64 ? *(const f32x4*)(a.in[I_CFW] + (size_t)layer * 31 * MIXW + idx * 4) : (f32x4){0.f, 0.f, 0.f, 0.f}; }
#pragma unroll
            for (int it = 0; it < 4; ++it) { const int idx = tid + it * 512; if (idx < 31 * 64) *(LAS f32x4*)(WCF + idx * 4) = wq[it]; } }
        __syncthreads();
        MIX_STAMP(1);
        if (last) {
            for (int idx = tid; idx < NSEG * 30 * 64; idx += 512) { const int seg = idx / (30 * 64), r = idx % (30 * 64), j = r >> 6, c4 = (r & 63) * 4;
                float* dst = a.out + (SAMPLE ? O_CFS + ((size_t)(layer * DB + q0 + seg) * 30 + j) * MIXW : O_CFP + ((size_t)(layer * NB + s) * 30 + j) * MIXW) + c4;
                *(f32x4*)dst = *(LAS f32x4*)(V + (seg * (30 + L) + L + j) * 256 + c4); }
        }
        const f32x4 lg = *(const f32x4*)(a.in[I_CFLNG] + layer * MIXW + 4 * lane), lb = *(const f32x4*)(a.in[I_CFLNB] + layer * MIXW + 4 * lane);
        {
            constexpr int NT = R / NWAVES;
            const int tt0 = wave * NT, seg0 = tt0 / L, t0 = tt0 % L, base = (seg0 * (30 + L) + t0) * 256 + 4 * lane;
            f32x4 acc[NT], win[NT];
#pragma unroll
            for (int i = 0; i < NT; ++i) acc[i] = (f32x4){0.f, 0.f, 0.f, 0.f};
#pragma unroll
            for (int i = 0; i + 1 < NT; ++i) win[i] = *(LAS f32x4*)(V + base + i * 256);
#pragma unroll
            for (int j = 0; j < 31; ++j) {
                win[(j + NT - 1) % NT] = *(LAS f32x4*)(V + base + (j + NT - 1) * 256);
                const f32x4 w = *(LAS f32x4*)(WCF + j * 256 + 4 * lane);
#pragma unroll
                for (int i = 0; i < NT; ++i) acc[i] += w * win[(j + i) % NT];
            }
            float s1[NT];
#pragma unroll
            for (int i = 0; i < NT; ++i) s1[i] = (acc[i][0] + acc[i][1]) + (acc[i][2] + acc[i][3]);
#pragma unroll
            for (int o = 1; o < 64; o <<= 1) {
#pragma unroll
                for (int i = 0; i < NT; ++i) s1[i] += __shfl_xor(s1[i], o); }
            float s2[NT];
#pragma unroll
            for (int i = 0; i < NT; ++i) { acc[i] = acc[i] - s1[i] * (1.0f / 256.0f); s2[i] = (acc[i][0] * acc[i][0] + acc[i][1] * acc[i][1]) + (acc[i][2] * acc[i][2] + acc[i][3] * acc[i][3]); }
#pragma unroll
            for (int o = 1; o < 64; o <<= 1) {
#pragma unroll
                for (int i = 0; i < NT; ++i) s2[i] += __shfl_xor(s2[i], o); }
#pragma unroll
            for (int i = 0; i < NT; ++i) { const int tt = tt0 + i;
                const float rstd = __builtin_amdgcn_rsqf(s2[i] * (1.0f / 256.0f) + 1e-5f);
                const f32x4 yn = acc[i] * rstd * lg + lb;
                v2u w; w.x = pk2(yn[0] * sigm(yn[0]), yn[1] * sigm(yn[1])); w.y = pk2(yn[2] * sigm(yn[2]), yn[3] * sigm(yn[3]));
                *(v2u*)(BR + (size_t)(row0 + tt) * D + 768 + 4 * lane) = w; }
        }
        __syncthreads();
    }
    MIX_STAMP(2);
    if (stages & 2) {
        constexpr int TR = NSEG * (15 + L);
        LAS bf16* Dt = (LAS bf16*)(lds + 81920);
        {
            constexpr int NIT = (TR * 32 + 511) / 512;
            v4u qa[NIT], qb[NIT]; int kind[NIT];
#pragma unroll
            for (int it = 0; it < NIT; ++it) {
                const int idx = tid + it * 512; kind[it] = 0; qa[it] = (v4u){0u, 0u, 0u, 0u}; qb[it] = (v4u){0u, 0u, 0u, 0u};
                if (idx < TR * 32) {
                    const int rr = idx >> 5, c8 = (idx & 31) * 8, seg = rr / (15 + L), e = rr % (15 + L);
                    int srow = -1;
                    if (SAMPLE) { if (e >= 15) srow = MP + (q0 + seg) * 8 + (e - 15); }
                    else { const int tabs = c * 64 + e - 15; if (tabs >= 0) srow = s * SEQ + tabs; }
                    if (srow >= 0) { kind[it] = 1; qa[it] = *(const v4u*)(PMb + (size_t)srow * PMC + c8); }
                    else if (SAMPLE) { kind[it] = 2; const float* st = a.in[I_STPOOL] + ((size_t)(layer * DB + q0 + seg) * 15 + e) * MIXW + c8; qa[it] = *(const v4u*)st; qb[it] = *(const v4u*)(st + 4); }
                }
            }
#pragma unroll
            for (int it = 0; it < NIT; ++it) {
                const int idx = tid + it * 512;
                if (idx < TR * 32) {
                    const int rr = idx >> 5, c8 = (idx & 31) * 8;
                    float v[8];
                    if (kind[it] == 1) unpack8(qa[it], v);
                    else { v[0] = __uint_as_float(qa[it].x); v[1] = __uint_as_float(qa[it].y); v[2] = __uint_as_float(qa[it].z); v[3] = __uint_as_float(qa[it].w);
                           v[4] = __uint_as_float(qb[it].x); v[5] = __uint_as_float(qb[it].y); v[6] = __uint_as_float(qb[it].z); v[7] = __uint_as_float(qb[it].w); }
                    *(LAS f32x4*)(V + rr * 256 + c8) = (f32x4){v[0], v[1], v[2], v[3]}; *(LAS f32x4*)(V + rr * 256 + c8 + 4) = (f32x4){v[4], v[5], v[6], v[7]};
                }
            }
        }
        __syncthreads();
        MIX_STAMP(3);
        if (last) {
            for (int idx = tid; idx < NSEG * 15 * 64; idx += 512) { const int seg = idx / (15 * 64), r = idx % (15 * 64), j = r >> 6, c4 = (r & 63) * 4;
                float* dst = a.out + (SAMPLE ? O_POOLS + ((size_t)(layer * DB + q0 + seg) * 15 + j) * MIXW : O_POOLP + ((size_t)(layer * NB + s) * 15 + j) * MIXW) + c4;
                *(f32x4*)dst = *(LAS f32x4*)(V + (seg * (15 + L) + L + j) * 256 + c4); }
        }
        for (int idx = tid; idx < R * 32; idx += 512) {
            const int tt = idx >> 5, c8 = (idx & 31) * 8, seg = tt / L, t = tt % L, base = seg * (15 + L) + t + 15, win = 2 << (c8 >> 6);
            float sm[8];
#pragma unroll
            for (int j = 0; j < 8; ++j) sm[j] = 0.f;
            for (int w = 0; w < win; ++w) { const f32x4 x0 = *(LAS f32x4*)(V + (base - w) * 256 + c8), x1 = *(LAS f32x4*)(V + (base - w) * 256 + c8 + 4);
                sm[0] += x0[0]; sm[1] += x0[1]; sm[2] += x0[2]; sm[3] += x0[3]; sm[4] += x1[0]; sm[5] += x1[1]; sm[6] += x1[2]; sm[7] += x1[3]; }
            const int cnt = SAMPLE ? win : min(c * 64 + t + 1, win);
            const float inv = 1.0f / (float)cnt;
            const f32x4 c0 = *(LAS f32x4*)(V + base * 256 + c8), c1 = *(LAS f32x4*)(V + base * 256 + c8 + 4);
            float dd[8];
#pragma unroll
            for (int j = 0; j < 4; ++j) { dd[j] = sm[j] * inv - c0[j]; dd[4 + j] = sm[4 + j] * inv - c1[j]; }
            *(LAS v4u*)(Dt + tt * 264 + c8) = pack8(dd);
        }
        __syncthreads();
        MIX_STAMP(4);
        {
            const bf16* PW = (const bf16*)(a.ws + WS_TAB + (size_t)layer * TAB_STRIDE + TAB_PW);
            const int k = wave >> 1, fr = lane & 15, fq = lane >> 4;
            constexpr int NMT = R / 16;
            for (int mt = (NMT >= 4 ? (wave & 1) * 2 : (wave & 1)); mt < (NMT >= 4 ? (wave & 1) * 2 + 2 : ((wave & 1) == 0 ? NMT : 0)); ++mt) {
                const bf16x8 b0 = *(LAS bf16x8*)(Dt + (16 * mt + fr) * 264 + 64 * k + 8 * fq), b1 = *(LAS bf16x8*)(Dt + (16 * mt + fr) * 264 + 64 * k + 32 + 8 * fq);
#pragma unroll
                for (int ot = 0; ot < 4; ++ot) {
                    f32x4 acc = (f32x4){0.f, 0.f, 0.f, 0.f};
                    const bf16x8 a0 = *(const bf16x8*)(PW + ((size_t)(k * 64 + 16 * ot + fr)) * 64 + 8 * fq), a1 = *(const bf16x8*)(PW + ((size_t)(k * 64 + 16 * ot + fr)) * 64 + 32 + 8 * fq);
                    acc = __builtin_amdgcn_mfma_f32_16x16x32_bf16(a0, b0, acc, 0, 0, 0);
                    acc = __builtin_amdgcn_mfma_f32_16x16x32_bf16(a1, b1, acc, 0, 0, 0);
                    const int o = 64 * k + 16 * ot + 4 * fq, tt = 16 * mt + fr;
                    const f32x4 sc = *(const f32x4*)(a.in[I_POOLSC] + layer * MIXW + o);
                    v2u w; w.x = pk2(acc[0] * sc[0], acc[1] * sc[1]); w.y = pk2(acc[2] * sc[2], acc[3] * sc[3]);
                    *(v2u*)(BR + (size_t)(row0 + tt) * D + o) = w;
                }
            }
        }
        __syncthreads();
    }
    MIX_STAMP(5);
    if (stages & 4) {
        const float* scw = a.in[I_SCW] + (size_t)layer * 3 * MIXW;
#pragma unroll
        for (int it_ = 0; it_ < R * 32 / 512; ++it_) { const int idx = tid + it_ * 512;
            const int tt = idx >> 5, c8 = (idx & 31) * 8, seg = tt / L, t = tt % L;
            float z[3][8];
#pragma unroll
            for (int dj = 0; dj < 3; ++dj) { const int tp = t - 2 + dj;
                int srow = -1;
                if (SAMPLE) { if (tp >= 0) srow = MP + (q0 + seg) * 8 + tp; } else { const int tabs = c * 64 + tp; if (tabs >= 0) srow = s * SEQ + tabs; }
                if (srow >= 0) { float cg[8], hx[8]; unpack8(*(const v4u*)(PMb + (size_t)srow * PMC + 768 + c8), cg); unpack8(*(const v4u*)(PMb + (size_t)srow * PMC + 1024 + c8), hx);
#pragma unroll
                    for (int j = 0; j < 8; ++j) z[dj][j] = cg[j] * hx[j]; }
                else if (SAMPLE) { const float* st = a.in[I_STSC] + ((size_t)(layer * DB + q0 + seg) * 2 + (2 + tp)) * MIXW + c8; const f32x4 x0 = *(const f32x4*)st, x1 = *(const f32x4*)(st + 4);
                    z[dj][0] = x0[0]; z[dj][1] = x0[1]; z[dj][2] = x0[2]; z[dj][3] = x0[3]; z[dj][4] = x1[0]; z[dj][5] = x1[1]; z[dj][6] = x1[2]; z[dj][7] = x1[3]; }
                else {
#pragma unroll
                    for (int j = 0; j < 8; ++j) z[dj][j] = 0.f; } }
            float bg[8], o[8]; unpack8(*(const v4u*)(PMb + (size_t)(row0 + tt) * PMC + 512 + c8), bg);
#pragma unroll
            for (int j = 0; j < 8; ++j) o[j] = bg[j] * (scw[c8 + j] * z[0][j] + scw[MIXW + c8 + j] * z[1][j] + scw[2 * MIXW + c8 + j] * z[2][j]);
            *(v4u*)(BR + (size_t)(row0 + tt) * D + 512 + c8) = pack8(o);
            if (last && t >= L - 2) { float* dst = a.out + (SAMPLE ? O_SCS + ((size_t)(layer * DB + q0 + seg) * 2 + (t - (L - 2))) * MIXW : O_SCP + ((size_t)(layer * NB + s) * 2 + (t - (L - 2))) * MIXW) + c8;
                *(f32x4*)dst = (f32x4){z[2][0], z[2][1], z[2][2], z[2][3]}; *(f32x4*)(dst + 4) = (f32x4){z[2][4], z[2][5], z[2][6], z[2][7]}; }
        }
    }
    MIX_STAMP(6);
}

template <int MODE>
__device__ __forceinline__ void ssm_unit(const Args& a, int layer, int uidx, LAS unsigned char* lds, int tid_in, int lane_in, int wave_in) {
    int tid = tid_in; asm volatile("" : "+v"(tid));
    const int lane = tid & 63, wave = __builtin_amdgcn_readfirstlane(tid >> 6);
    const bf16* PMb = (const bf16*)(a.ws + WS_PM); bf16* BR = (bf16*)a.out;
    const unsigned char* tab = a.ws + WS_TAB + (size_t)layer * TAB_STRIDE;
    const f32x2* LB = (const f32x2*)(tab + TAB_LB); const f32x2* LP = (const f32x2*)(tab + TAB_LP);
    const bf16* BBT = (const bf16*)(tab + TAB_BBT); const bf16* CM = (const bf16*)(tab + TAB_CM);
    f32x2* E = (f32x2*)(a.ws + WS_E);
    const int s = uidx >> 5, c = uidx & 31;
    const int row0 = MODE == 2 ? MP + 64 * uidx : s * SEQ + 64 * c;
    const int fr = lane & 15, fq = lane >> 4;
    LAS float* BU = (LAS float*)(lds + wave * 8448);
    LAS bf16* Zt = (LAS bf16*)(lds + 67584);
    const bf16x8 zf = (bf16x8){0, 0, 0, 0, 0, 0, 0, 0};
    for (int gi = 0; gi < 2; ++gi) {
        const int g = 2 * wave + gi;
        const f32x2 lam = LB[g * 64 + lane]; const float nlam1 = -lam[1];
        float hr = 0.f, hi = 0.f;
        bf16x8 bb[8];
#pragma unroll
        for (int nt = 0; nt < 8; ++nt) bb[nt] = fq < 2 ? *(const bf16x8*)(BBT + ((size_t)(g * 128 + 16 * nt + fr)) * 16 + 8 * fq) : zf;
        bf16x8 cmf[4]; float dsk = 0.f;
        if (MODE >= 1) {
#pragma unroll
            for (int ks = 0; ks < 4; ++ks) cmf[ks] = *(const bf16x8*)(CM + ((size_t)(g * 16 + fr)) * 128 + 32 * ks + 8 * fq);
            dsk = a.in[I_DSKIP][layer * MIXW + 16 * g + fr]; }
        bf16x8 ufa[4];
#pragma unroll
        for (int sub = 0; sub < 4; ++sub) ufa[sub] = fq < 2 ? *(const bf16x8*)(PMb + (size_t)(row0 + 16 * sub + fr) * PMC + 256 + 16 * g + 8 * fq) : zf;
        bf16 uva[4][4];
        if (MODE >= 1) {
#pragma unroll
            for (int sub = 0; sub < 4; ++sub)
#pragma unroll
                for (int r = 0; r < 4; ++r) uva[sub][r] = PMb[(size_t)(row0 + 16 * sub + 4 * fq + r) * PMC + 256 + 16 * g + fr]; }
        if (MODE == 1) { const f32x2 lp = LP[g * 64 + lane];
            const float nlp1 = -lp[1];
#pragma unroll 1
            for (int j = 0; j < c; j += 16) { f32x2 e16[16]; const int nq = c - j;
#pragma unroll
                for (int q = 0; q < 16; ++q) if (q < nq) e16[q] = E[((size_t)(s * NCH + j + q) * 16 + g) * 64 + lane];
#pragma unroll
                for (int q = 0; q < 16; ++q) if (q < nq) { const float nr = fma_s(lp[0], hr, fma_s(nlp1, hi, e16[q][0])), ni = fma_s(lp[0], hi, fma_s(lp[1], hr, e16[q][1])); hr = nr; hi = ni; } } }
#pragma unroll
        for (int sub = 0; sub < 4; ++sub) {
            const int rowb = row0 + 16 * sub;
            const bf16x8 uf = ufa[sub];
#pragma unroll
            for (int nt = 0; nt < 8; ++nt) { const f32x4 d = __builtin_amdgcn_mfma_f32_16x16x32_bf16(uf, bb[nt], (f32x4){0.f, 0.f, 0.f, 0.f}, 0, 0, 0);
#pragma unroll
                for (int r = 0; r < 4; ++r) BU[(4 * fq + r) * 132 + 16 * nt + fr] = d[r]; }
            asm volatile("s_waitcnt lgkmcnt(0)" ::: "memory");
            {
                float bre_[16], bim_[16];
#pragma unroll
                for (int t = 0; t < 16; ++t) { bre_[t] = BU[t * 132 + lane]; bim_[t] = BU[t * 132 + 64 + lane]; }
                float sre_[2] = {0.f, 0.f}, sim_[2] = {0.f, 0.f};
                if (MODE == 2) {
#pragma unroll
                    for (int hq = 0; hq < 2; ++hq) { const int q = 8 * uidx + 2 * sub + hq; const size_t si = ((size_t)(layer * DB + q) * 16 + g) * 64 + lane; sre_[hq] = a.in[I_STRE][si]; sim_[hq] = a.in[I_STIM][si]; } }
                asm volatile("s_waitcnt lgkmcnt(0)" ::: "memory");
#pragma unroll
                for (int t = 0; t < 16; ++t) {
                    if (MODE == 2 && (t & 7) == 0) { hr = sre_[t >> 3]; hi = sim_[t >> 3]; }
                    const float nr = fma_s(lam[0], hr, fma_s(nlam1, hi, bre_[t])), ni = fma_s(lam[0], hi, fma_s(lam[1], hr, bim_[t])); hr = nr; hi = ni;
                    bre_[t] = hr; bim_[t] = hi;
                    if (MODE == 2 && (t & 7) == 7) { const int q = 8 * uidx + 2 * sub + (t >> 3); const size_t si = ((size_t)(layer * DB + q) * 16 + g) * 64 + lane; a.out[O_SRES + si] = hr; a.out[O_SIMS + si] = hi; }
                }
#pragma unroll
                for (int t = 0; t < 16; ++t) { BU[t * 132 + lane] = bre_[t]; BU[t * 132 + 64 + lane] = bim_[t]; }
            }
            if (MODE >= 1) {
                asm volatile("s_waitcnt lgkmcnt(0)" ::: "memory");
                f32x4 y = (f32x4){0.f, 0.f, 0.f, 0.f};
#pragma unroll
                for (int ks = 0; ks < 4; ++ks) { const f32x4 h0 = *(LAS f32x4*)(BU + fr * 132 + 32 * ks + 8 * fq), h1 = *(LAS f32x4*)(BU + fr * 132 + 32 * ks + 8 * fq + 4);
                    v4u hw; hw.x = pk2(h0[0], h0[1]); hw.y = pk2(h0[2], h0[3]); hw.z = pk2(h1[0], h1[1]); hw.w = pk2(h1[2], h1[3]);
                    y = __builtin_amdgcn_mfma_f32_16x16x32_bf16(__builtin_bit_cast(bf16x8, hw), cmf[ks], y, 0, 0, 0); }
#pragma unroll
                for (int r = 0; r < 4; ++r) { const int t = 4 * fq + r; const float uv = bf1(uva[sub][r]);
                    const float z = gelu_tanh(y[r] + dsk * uv);
                    Zt[(16 * sub + t) * 264 + 16 * g + fr] = (bf16)(pk2(z, 0.f) & 0xffffu); }
                asm volatile("s_waitcnt lgkmcnt(0)" ::: "memory");
            }
            if (MODE == 0) { asm volatile("s_waitcnt lgkmcnt(0)" ::: "memory"); }
        }
        if (MODE == 0) E[((size_t)(s * NCH + c) * 16 + g) * 64 + lane] = (f32x2){hr, hi};
        if (MODE == 1 && c == NCH - 1) { const size_t si = ((size_t)(layer * NB + s) * 16 + g) * 64 + lane; a.out[O_SREP + si] = hr; a.out[O_SIMP + si] = hi; }
    }
    if (MODE == 0) __syncthreads();
    if (MODE >= 1) {
        __syncthreads();
        const bf16* WG = (const bf16*)(a.ws + WS_WGLU) + (size_t)layer * MIXW * MIXW;
        f32x4 acc[4][2];
#pragma unroll
        for (int mt = 0; mt < 4; ++mt) { acc[mt][0] = (f32x4){0.f, 0.f, 0.f, 0.f}; acc[mt][1] = (f32x4){0.f, 0.f, 0.f, 0.f}; }
#pragma unroll
        for (int ks = 0; ks < 8; ++ks) {
            const bf16x8 w0 = *(const bf16x8*)(WG + (size_t)(32 * wave + fr) * MIXW + 32 * ks + 8 * fq), w1 = *(const bf16x8*)(WG + (size_t)(32 * wave + 16 + fr) * MIXW + 32 * ks + 8 * fq);
#pragma unroll
            for (int mt = 0; mt < 4; ++mt) { const bf16x8 zb = *(LAS bf16x8*)(Zt + (16 * mt + fr) * 264 + 32 * ks + 8 * fq);
                acc[mt][0] = __builtin_amdgcn_mfma_f32_16x16x32_bf16(w0, zb, acc[mt][0], 0, 0, 0);
                acc[mt][1] = __builtin_amdgcn_mfma_f32_16x16x32_bf16(w1, zb, acc[mt][1], 0, 0, 0); }
        }
#pragma unroll
        for (int nl = 0; nl < 2; ++nl) { const int n0 = 32 * wave + 16 * nl + 4 * fq; const f32x4 bgl = *(const f32x4*)(a.in[I_BGLU] + layer * MIXW + n0);
#pragma unroll
            for (int mt = 0; mt < 4; ++mt) { const int tt = 16 * mt + fr; const v2u zz = *(LAS v2u*)(Zt + tt * 264 + n0);
                const float z0 = bflo(zz.x), z1 = bfhi(zz.x), z2 = bflo(zz.y), z3 = bfhi(zz.y);
                v2u w; w.x = pk2(z0 * sigm(acc[mt][nl][0] + bgl[0]), z1 * sigm(acc[mt][nl][1] + bgl[1])); w.y = pk2(z2 * sigm(acc[mt][nl][2] + bgl[2]), z3 * sigm(acc[mt][nl][3] + bgl[3]));
                *(v2u*)(BR + (size_t)(row0 + tt) * D + 256 + n0) = w; } }
        __syncthreads();
    }
}

__device__ __forceinline__ void gemm2_phase(LAS unsigned char* lds, const bf16* BRp, const bf16* WBT, const unsigned char* GT, bf16* MG, int G, int bid, int tidp) {
    using namespace pg8;
    int tid_ = tidp; asm volatile("" : "+v"(tid_));
    const int tid = tid_, wid = __builtin_amdgcn_readfirstlane(tid >> 6), lane = tid & 63, wr = wid >> 2, wc = wid & 3, fr = lane & 15, fq = lane >> 4;
    unsigned voffA0, voffB0;
    { int R, C; stage_rc(tid * 16, R, C); const int Rb = (R & ~31) + perm32(R & 31); voffA0 = (unsigned)(R * D + C) * 2u; voffB0 = (unsigned)(Rb * MIXW + C) * 2u; }
    const unsigned ldsw = (unsigned)wid * 1024u;
    const int aoff = lds_byte(wr * 64 + fr, fq * 8), boff = lds_byte(wc * 32 + fr, fq * 8);
    const unsigned gvoff = (unsigned)(fr * GTC + 8 * fq);
    constexpr int STG = 49152;
#define G2_STAGE(it_, so_) do { const int kb_ = (it_) >> 2, kt_ = (it_) & 3; \
        const char* as_ = Abase + (size_t)(kb_ * 256 + kt_ * 64) * 2; const char* bs_ = Bbase + (size_t)kb_ * (D * MIXW * 2) + (size_t)kt_ * 128; \
        _Pragma("unroll") for (int _i = 0; _i < 2; ++_i) __builtin_amdgcn_global_load_lds((const unsigned*)(as_ + (size_t)_i * (64 * D * 2) + voffA0), (PG8_LAS unsigned*)(lds + (so_) + ldsw + _i * 8192), 16, 0, 0); \
        _Pragma("unroll") for (int _i = 0; _i < 2; ++_i) __builtin_amdgcn_global_load_lds((const unsigned*)(bs_ + (size_t)_i * (64 * MIXW * 2) + voffB0), (PG8_LAS unsigned*)(lds + (so_) + 16384 + ldsw + _i * 8192), 16, 0, 0); \
        _Pragma("unroll") for (int _i = 0; _i < 2; ++_i) __builtin_amdgcn_global_load_lds((const unsigned*)(bs_ + (size_t)(128 + 64 * _i) * MIXW * 2 + voffB0), (PG8_LAS unsigned*)(lds + (so_) + 32768 + ldsw + _i * 8192), 16, 0, 0); } while (0)
    const int vb = (G % 8 == 0) ? (bid % 8) * (G / 8) + bid / 8 : bid;
    constexpr int NUN = (MP / 128) * 4;
    const bool xmap = G == 256;
    for (int ui = xmap ? (bid & 7) * 64 + (bid >> 3) : vb; ui < NUN; ui += xmap ? ((ui & 63) < 32 ? 32 : NUN) : G) {
        const int pm = ui >> 2, pn = ui & 3;
        const char* Abase = (const char*)BRp + (size_t)pm * 128 * D * 2;
        const char* Bbase = (const char*)WBT + (size_t)pn * 256 * MIXW * 2;
        G2_STAGE(0, 0); G2_STAGE(1, STG);
        f32x4 mg[2][4][2], acc[2][4][2];
#pragma unroll
        for (int b = 0; b < 2; ++b)
#pragma unroll
            for (int m = 0; m < 4; ++m)
#pragma unroll
                for (int n = 0; n < 2; ++n) { mg[b][m][n] = (f32x4){0.f, 0.f, 0.f, 0.f}; acc[b][m][n] = (f32x4){0.f, 0.f, 0.f, 0.f}; }
        v2u gq[2][4];
        int so = 0, so2 = 2 * STG;
#pragma unroll 1
        for (int kb = 0; kb < 4; ++kb) {
#pragma unroll
            for (int kt = 0; kt < 4; ++kt) {
                if (kt < 2) asm volatile("s_waitcnt vmcnt(6)" ::: "memory");
                else if (kt == 3 && kb == 3) asm volatile("s_waitcnt vmcnt(8)" ::: "memory");
                else asm volatile("s_waitcnt vmcnt(14)" ::: "memory");
                __builtin_amdgcn_s_barrier(); asm volatile("" ::: "memory");
                if (kt < 2 || kb < 3) G2_STAGE(4 * kb + kt + 2, so2);
#pragma unroll
                for (int kk = 0; kk < 2; ++kk) {
                    bf16x8 At[4], B0[2], B1[2];
#pragma unroll
                    for (int m = 0; m < 4; ++m) At[m] = *(const PG8_LAS bf16x8*)(lds + so + aoff + m * 2048 + kk * 1024);
#pragma unroll
                    for (int n = 0; n < 2; ++n) { B0[n] = *(const PG8_LAS bf16x8*)(lds + so + 16384 + boff + n * 2048 + kk * 1024); B1[n] = *(const PG8_LAS bf16x8*)(lds + so + 32768 + boff + n * 2048 + kk * 1024); }
                    asm volatile("s_waitcnt lgkmcnt(0)" ::: "memory"); __builtin_amdgcn_sched_barrier(0);
#pragma unroll
                    for (int m = 0; m < 4; ++m)
#pragma unroll
                        for (int n = 0; n < 2; ++n) { acc[0][m][n] = __builtin_amdgcn_mfma_f32_16x16x32_bf16(B0[n], At[m], acc[0][m][n], 0, 0, 0);
                                                      acc[1][m][n] = __builtin_amdgcn_mfma_f32_16x16x32_bf16(B1[n], At[m], acc[1][m][n], 0, 0, 0); }
                }
                if (kt == 1) {
#pragma unroll
                    for (int m = 0; m < 4; ++m) { const unsigned char* gs = GT + (size_t)(pm * 128 + wr * 64 + m * 16) * GTC + kb * D + pn * 256 + wc * 32;
                        asm volatile("global_load_dwordx2 %0, %1, %2" : "=v"(gq[0][m]) : "v"(gvoff), "s"(gs) : "memory");
                        asm volatile("global_load_dwordx2 %0, %1, %2 offset:128" : "=v"(gq[1][m]) : "v"(gvoff), "s"(gs) : "memory"); }
                }
                so = so == 2 * STG ? 0 : so + STG; so2 = so2 == 2 * STG ? 0 : so2 + STG;
            }
            if (kb == 3) asm volatile("s_waitcnt vmcnt(0)" ::: "memory"); else asm volatile("s_waitcnt vmcnt(12)" ::: "memory");
            asm volatile("" : "+v"(gq[0][0]), "+v"(gq[0][1]), "+v"(gq[0][2]), "+v"(gq[0][3]), "+v"(gq[1][0]), "+v"(gq[1][1]), "+v"(gq[1][2]), "+v"(gq[1][3]));
#pragma unroll
            for (int b = 0; b < 2; ++b)
#pragma unroll
                for (int m = 0; m < 4; ++m) { const v2u q_ = gq[b][m];
#pragma unroll
                    for (int j = 0; j < 4; ++j) { mg[b][m][0][j] += (float)((q_.x >> (8 * j)) & 0xffu) * acc[b][m][0][j]; mg[b][m][1][j] += (float)((q_.y >> (8 * j)) & 0xffu) * acc[b][m][1][j]; }
                    acc[b][m][0] = (f32x4){0.f, 0.f, 0.f, 0.f}; acc[b][m][1] = (f32x4){0.f, 0.f, 0.f, 0.f}; }
        }
        asm volatile("" ::: "memory"); __builtin_amdgcn_s_barrier(); asm volatile("" ::: "memory");
#pragma unroll
        for (int b = 0; b < 2; ++b)
#pragma unroll
            for (int m = 0; m < 4; ++m) { const int row = pm * 128 + wr * 64 + m * 16 + fr, col = pn * 256 + b * 128 + wc * 32 + 8 * fq;
                const f32x4 m0 = mg[b][m][0] * (1.0f / 255.0f), m1 = mg[b][m][1] * (1.0f / 255.0f);
                v4u w; w.x = pk2(m0[0], m0[1]); w.y = pk2(m0[2], m0[3]); w.z = pk2(m1[0], m1[1]); w.w = pk2(m1[2], m1[3]);
                *(v4u*)(MG + (size_t)row * D + col) = w; }
    }
#undef G2_STAGE
}


#define TL_GLDS(src_, dst_) __builtin_amdgcn_global_load_lds((const unsigned*)(src_), (PG8_LAS unsigned*)(dst_), 16, 0, 0)
#define TL_STAGE(kt_, A_PTR, B_PTR) do { const int s_ = (kt_) & 3; const char* ap_ = A_PTR(kt_); const char* bp_ = B_PTR(kt_); \
        TL_GLDS(ap_ + voffA, lds + s_ * 32768 + ldsw); TL_GLDS(ap_ + voffA + 128, lds + s_ * 32768 + 8192 + ldsw); \
        TL_GLDS(bp_ + voffB, lds + s_ * 32768 + 16384 + ldsw); TL_GLDS(bp_ + voffB + 128, lds + s_ * 32768 + 24576 + ldsw); } while (0)
#define TL_LOOP(NK, A_PTR, B_PTR, AFTER_STEP) do { \
        TL_STAGE(0, A_PTR, B_PTR); if ((NK) > 1) TL_STAGE(1, A_PTR, B_PTR); if ((NK) > 2) TL_STAGE(2, A_PTR, B_PTR); \
        _Pragma("unroll 1") for (int kt = 0; kt < (NK); ++kt) { \
            if (kt + 2 < (NK)) asm volatile("s_waitcnt vmcnt(8)" ::: "memory"); else if (kt + 1 < (NK)) asm volatile("s_waitcnt vmcnt(4)" ::: "memory"); else asm volatile("s_waitcnt vmcnt(0)" ::: "memory"); \
            __builtin_amdgcn_s_barrier(); asm volatile("" ::: "memory"); \
            if (kt + 3 < (NK)) TL_STAGE(kt + 3, A_PTR, B_PTR); \
            const int sb_ = (kt & 3) * 32768; \
            _Pragma("unroll") for (int h_ = 0; h_ < 2; ++h_) { \
                const bf16x8 a0 = *(const PG8_LAS bf16x8*)(lds + sb_ + h_ * 8192 + aoff), a1 = *(const PG8_LAS bf16x8*)(lds + sb_ + h_ * 8192 + aoff + 1024); \
                const bf16x8 b00 = *(const PG8_LAS bf16x8*)(lds + sb_ + 16384 + h_ * 8192 + boff), b01 = *(const PG8_LAS bf16x8*)(lds + sb_ + 16384 + h_ * 8192 + boff + 1024); \
                const bf16x8 b10 = *(const PG8_LAS bf16x8*)(lds + sb_ + 16384 + h_ * 8192 + boff + 2048), b11 = *(const PG8_LAS bf16x8*)(lds + sb_ + 16384 + h_ * 8192 + boff + 3072); \
                asm volatile("s_waitcnt lgkmcnt(0)" ::: "memory"); __builtin_amdgcn_sched_barrier(0); \
                acc[0] = __builtin_amdgcn_mfma_f32_16x16x32_bf16(b00, a0, acc[0], 0, 0, 0); acc[1] = __builtin_amdgcn_mfma_f32_16x16x32_bf16(b10, a0, acc[1], 0, 0, 0); \
                acc[0] = __builtin_amdgcn_mfma_f32_16x16x32_bf16(b01, a1, acc[0], 0, 0, 0); acc[1] = __builtin_amdgcn_mfma_f32_16x16x32_bf16(b11, a1, acc[1], 0, 0, 0); } \
            AFTER_STEP(kt); } \
        asm volatile("s_waitcnt lgkmcnt(0)" ::: "memory"); __builtin_amdgcn_s_barrier(); asm volatile("" ::: "memory"); } while (0)
#define TL_SETUP(LDA, LDB) using namespace pg8; int tid_ = tidp; asm volatile("" : "+v"(tid_)); \
    const int tid = tid_, wid = __builtin_amdgcn_readfirstlane(tid >> 6), lane = tid & 63, fr = lane & 15, fq = lane >> 4, mt = wid >> 1, nh = wid & 1; \
    int R_, C_; stage_rc(tid * 16, R_, C_); \
    const unsigned voffA = (unsigned)(R_ * (LDA) + C_) * 2u, voffB = (unsigned)(R_ * (LDB) + C_) * 2u, ldsw = (unsigned)wid * 1024u; \
    const int aoff = lds_byte(mt * 16 + fr, fq * 8), boff = lds_byte(nh * 32 + fr, fq * 8); (void)lane
#define TL_NOP(kt_) do {} while (0)

struct CappedOrder : pg8::StaticOrder {
    int cap;
    __device__ bool next(int i, pg8::Unit& u) const { if ((long)i * G + c >= cap) return false; return pg8::StaticOrder::next(i, u); }
};
__device__ __forceinline__ void proj_tail_phase(LAS unsigned char* lds, const bf16* A, const bf16* Bt, int cap, const float* ssq, const float* bgate, bf16* PMp, unsigned char* GTp, int G, int bid, int tidp, unsigned* qctr) {
    TL_SETUP(D, D);
    StaticOrder S1; S1.init(M, INC, 1, 0);
    const int nsub = (S1.nwg - cap) * 16;
    volatile LAS int* qslot = (volatile LAS int*)(lds + MISC_OFF + 192);
    for (int t = bid; t < nsub; ) {
        Unit u; S1.next(cap + (t >> 4), u);
        const int rb = (t >> 2) & 3, cb = t & 3, r0 = u.pm * 256 + 64 * rb, c0 = u.pn * 256 + 64 * cb;
        const char* Ab = (const char*)A + (size_t)r0 * D * 2; const char* Bb = (const char*)Bt + (size_t)c0 * D * 2;
        f32x4 acc[2] = {(f32x4){0.f, 0.f, 0.f, 0.f}, (f32x4){0.f, 0.f, 0.f, 0.f}};
        const int row = r0 + 16 * mt + fr;
        const float rs = pg8::row_rstd(ssq, row);
        const bool isg = u.pn >= 7;
        f32x4 bvv[2];
#pragma unroll
        for (int n = 0; n < 2; ++n) bvv[n] = isg ? *(const f32x4*)(bgate + (c0 + 32 * nh + 16 * n + 4 * fq - PMC)) : (f32x4){0.f, 0.f, 0.f, 0.f};
#define PT_A(kt_) (Ab + (size_t)(kt_) * 256)
#define PT_B(kt_) (Bb + (size_t)(kt_) * 256)
        TL_LOOP(D / 128, PT_A, PT_B, TL_NOP);
#undef PT_A
#undef PT_B
        unsigned got = 0u;
        if (tid == 0) got = __hip_atomic_fetch_add(qctr, 1u, __ATOMIC_RELAXED, __HIP_MEMORY_SCOPE_AGENT);
#pragma unroll
        for (int n = 0; n < 2; ++n) { const int col = c0 + 32 * nh + 16 * n + 4 * fq; f32x4 v = acc[n] * rs;
            if (isg) { const f32x4 tt = (v + bvv[n]) * -1.4426950408889634f;
                *(unsigned*)(GTp + (size_t)row * GTC + (col - PMC)) = pg8::pack_u8x4(pg8::sig255(tt[0]), pg8::sig255(tt[1]), pg8::sig255(tt[2]), pg8::sig255(tt[3])); }
            else { v2u w; w.x = pk2(v[0], v[1]); w.y = pk2(v[2], v[3]); *(v2u*)(PMp + (size_t)row * PMC + col) = w; } }
        if (tid == 0) *qslot = G + (int)got;
        __syncthreads();
        t = *qslot;
        __syncthreads();
    }
}

__device__ __forceinline__ void gemm2_tail_phase(LAS unsigned char* lds, const bf16* BRp, const bf16* WBT, const unsigned char* GT, bf16* MG, int G, int bid, int tidp) {
    TL_SETUP(D, MIXW);
    for (int ui = bid; ui < 256; ui += G) {
        const int rb = ((ui & 7) >> 1) * 4 + (ui >> 6), cb = (ui & 1) * 8 + ((ui >> 3) & 7);
        const char* Ab = (const char*)BRp + (size_t)(MP + 64 * rb) * D * 2; const char* Bb = (const char*)WBT + (size_t)(64 * cb) * MIXW * 2;
        f32x4 acc[2] = {(f32x4){0.f, 0.f, 0.f, 0.f}, (f32x4){0.f, 0.f, 0.f, 0.f}}, mg[2] = {(f32x4){0.f, 0.f, 0.f, 0.f}, (f32x4){0.f, 0.f, 0.f, 0.f}};
        const int row = MP + 64 * rb + 16 * mt + fr;
#define G2T_A(kt_) (Ab + (size_t)(((kt_) >> 1) * 256 + ((kt_) & 1) * 128) * 2)
#define G2T_B(kt_) (Bb + (size_t)((kt_) >> 1) * (D * MIXW * 2) + (size_t)((kt_) & 1) * 256)
        unsigned gwp[4][2];
#pragma unroll
        for (int kb = 0; kb < 4; ++kb)
#pragma unroll
            for (int n = 0; n < 2; ++n) gwp[kb][n] = *(const unsigned*)(GT + (size_t)row * GTC + kb * D + 64 * cb + 32 * nh + 16 * n + 4 * fq);
#define G2T_AFTER(kt_) do { if ((kt_) & 1) { const int kb_ = (kt_) >> 1; \
            _Pragma("unroll") for (int n = 0; n < 2; ++n) { const unsigned gw = kb_ == 0 ? gwp[0][n] : (kb_ == 1 ? gwp[1][n] : (kb_ == 2 ? gwp[2][n] : gwp[3][n])); \
                mg[n][0] += (float)(gw & 0xffu) * acc[n][0]; mg[n][1] += (float)((gw >> 8) & 0xffu) * acc[n][1]; mg[n][2] += (float)((gw >> 16) & 0xffu) * acc[n][2]; mg[n][3] += (float)(gw >> 24) * acc[n][3]; \
                acc[n] = (f32x4){0.f, 0.f, 0.f, 0.f}; } } } while (0)
        TL_LOOP(8, G2T_A, G2T_B, G2T_AFTER);
#undef G2T_A
#undef G2T_B
#undef G2T_AFTER
#pragma unroll
        for (int n = 0; n < 2; ++n) { const f32x4 mm = mg[n] * (1.0f / 255.0f); v2u w; w.x = pk2(mm[0], mm[1]); w.y = pk2(mm[2], mm[3]); *(v2u*)(MG + (size_t)row * D + 64 * cb + 32 * nh + 16 * n + 4 * fq) = w; }
    }
}

__device__ __forceinline__ void resid_tail_phase(LAS unsigned char* lds, const bf16* A, const bf16* Bt, int K, bf16* XBp, float* ssq, int G, int bid, int tidp) {
    TL_SETUP(K, K);
    const int nk = K / 128;
    for (int ui = bid; ui < 256; ui += G) {
        const int rb = ((ui & 7) >> 1) * 4 + (ui >> 6), cb = (ui & 1) * 8 + ((ui >> 3) & 7);
        const char* Ab = (const char*)A + (size_t)(MP + 64 * rb) * K * 2; const char* Bb = (const char*)Bt + (size_t)(64 * cb) * K * 2;
        f32x4 acc[2] = {(f32x4){0.f, 0.f, 0.f, 0.f}, (f32x4){0.f, 0.f, 0.f, 0.f}};
        const int rowl = 16 * mt + fr, row = MP + 64 * rb + rowl; float ss = 0.f;
        f32x4 xold[2];
#pragma unroll
        for (int n = 0; n < 2; ++n) { const int col = 64 * cb + 32 * nh + 16 * n + 4 * fq;
            const v2u q = *(const v2u*)(XBp + (size_t)row * D + col); xold[n] = (f32x4){bflo(q.x), bfhi(q.x), bflo(q.y), bfhi(q.y)}; }
#define RT_A(kt_) (Ab + (size_t)(kt_) * 256)
#define RT_B(kt_) (Bb + (size_t)(kt_) * 256)
        TL_LOOP(nk, RT_A, RT_B, TL_NOP);
#undef RT_A
#undef RT_B
#pragma unroll
        for (int n = 0; n < 2; ++n) { const int col = 64 * cb + 32 * nh + 16 * n + 4 * fq;
            const f32x4 o = xold[n] + acc[n];
            v2u w; w.x = pk2(o[0], o[1]); w.y = pk2(o[2], o[3]); *(v2u*)(XBp + (size_t)row * D + col) = w;
            ss += (o[0] * o[0] + o[1] * o[1]) + (o[2] * o[2] + o[3] * o[3]); }
        ss += __shfl_xor(ss, 16); ss += __shfl_xor(ss, 32);
        LAS float* red = (LAS float*)lds;
        if (fq == 0) red[rowl * 2 + nh] = ss;
        __syncthreads();
        if (tid < 64) ssq[((size_t)(cb >> 2) * M + MP + 64 * rb + tid) * 4 + (cb & 3)] = red[tid * 2] + red[tid * 2 + 1];
        __syncthreads();
    }
}

#ifndef PROBE_REP_B
#define PROBE_REP_B 1
#endif
#ifndef PROBE_REP_C
#define PROBE_REP_C 1
#endif
#ifndef PROBE_REP_D
#define PROBE_REP_D 1
#endif
#ifndef PROBE_REP_P0
#define PROBE_REP_P0 1
#endif
__global__ void __launch_bounds__(NWAVES * 64, 2) hybrid_fwd(Args args) {
    extern __shared__ __attribute__((aligned(16))) unsigned char lds_raw[];
    LAS unsigned char* lds = (LAS unsigned char*)lds_raw;
    volatile LAS unsigned* MISC = (volatile LAS unsigned*)(lds + MISC_OFF);
    const int tid0 = threadIdx.x, wave0 = __builtin_amdgcn_readfirstlane(tid0 >> 6);
    const int G0 = gridDim.x, bid = blockIdx.x;
    unsigned char* ws = args.ws;
    for (int u = tid0; u < (LDS_BYTES - LDSCTL_OFF) / 4; u += NWAVES * 64) ((LAS unsigned*)(lds + LDSCTL_OFF))[u] = 0u;
    __syncthreads();
    const int lo = args.ph_lo, hi = args.ph_hi;
    XcdBarrier bar; bar.bar = (unsigned*)(ws + WS_CTL) + CW_BAR; bar.x = 0; bar.st = nullptr;
    if (hi - lo > 1) bar = xcd_barrier_post((unsigned*)(ws + WS_CTL) + CW_BAR, MISC + 8);
    bf16* XB = (bf16*)(ws + WS_ACT1); bf16* PMb = (bf16*)(ws + WS_PM); unsigned char* GTb = ws + WS_GT;
    bf16* MGb = (bf16*)(ws + WS_PM); bf16* ACTb = (bf16*)(ws + WS_GT);
    float* ssq = (float*)(ws + WS_SSQ);
    for (int ph_i = lo; ph_i < hi; ++ph_i) {
#ifdef DBG_T_PH
        if (bid == DBG_T_BLK && wave0 == 0 && __builtin_amdgcn_mbcnt_lo(~0u, 0u) == 0u) ((volatile LAS unsigned*)(lds + MISC_OFF + 200))[0] = (ph_i == DBG_T_PH) ? 1u : 0u;
        if (ph_i == DBG_T_PH && bid == DBG_T_BLK && wave0 == 0 && __builtin_amdgcn_mbcnt_lo(~0u, 0u) == 0u) { ((volatile LAS unsigned long long*)(lds + MISC_OFF + 256))[0] = __builtin_amdgcn_s_memtime(); ((volatile LAS unsigned long long*)(lds + MISC_OFF + 256))[1] = __builtin_amdgcn_s_memrealtime(); }
#endif
        int ph = ph_i, G = G0; asm volatile("" : "+s"(ph), "+s"(G));
        unsigned z_ = 0u; asm volatile("" : "+v"(z_));
        int tid = wave0 * 64 + (int)__builtin_amdgcn_mbcnt_hi(~0u, __builtin_amdgcn_mbcnt_lo(~0u, z_)); asm volatile("" : "+v"(tid)); const int lane = tid & 63, wave = __builtin_amdgcn_readfirstlane(tid >> 6);
        const int layer = (ph - 1) / 7, k = ph == 0 ? -1 : (ph == NPHASE - 1 ? 7 : (ph - 1) % 7);
        if (k == -1) for (int rep_ = 0; rep_ < PROBE_REP_P0; ++rep_) p0_prologue(args, lds, tid, lane, wave, G, bid);
        else if (k == 7) final_norm(args, lane, wave, G, bid);
        else if (k == 0) {
            pg8::Gemm g{XB, (const bf16*)(ws + WS_WIN) + (size_t)layer * INC * D, M, INC, D}; CappedOrder S; S.init(M, INC, G, bid); S.cap = (S.nwg / G) * G;
            pg8::EpiProj E{PMb, GTb, ssq, args.in[I_BGATE] + (size_t)layer * GTC, (const LAS float*)(lds + RING_OFF + pg8::RSTD_LDS_OFF)};
            pg8::gemm_phase<pg8::EpiProj, CappedOrder, true, true>(lds + RING_OFF, g, S, E, tid);
            proj_tail_phase(lds + RING_OFF, XB, (const bf16*)(ws + WS_WIN) + (size_t)layer * INC * D, S.cap, ssq, args.in[I_BGATE] + (size_t)layer * GTC, PMb, GTb, G, bid, tid, (unsigned*)(ws + WS_CTL) + CW_Q + 64 * layer);
#ifdef PROBE_A_SAME
            { SameTileOrder S2; S2.init(M, INC, G, bid); pg8::EpiNull EN_; pg8::gemm_phase<pg8::EpiNull, SameTileOrder, true, true>(lds + RING_OFF, g, S2, EN_, tid); }
#endif
#ifdef PROBE_A_NULL
            { pg8::EpiNull EN_; pg8::gemm_phase<pg8::EpiNull, CappedOrder, true, true>(lds + RING_OFF, g, S, EN_, tid); }
#endif
#ifdef PROBE_A_FULL
            pg8::gemm_phase<pg8::EpiProj, CappedOrder, true, true>(lds + RING_OFF, g, S, E, tid);
#endif
        } else if (k == 1) for (int rep_ = 0; rep_ < PROBE_REP_B; ++rep_) {
            for (int s_ = 0; ; ++s_) { int u; bool donor = false;
                if (G == 256) { if (s_ > 2) break;
                    donor = bid < 16 || (bid >= 80 && bid < 152);
                    if (s_ == 0) u = 272 + ((bid + 240) & 255);
                    else if (bid < 16) { if (s_ == 2) break; u = 256 + bid; }
                    else if (bid < 80) { if (s_ == 2) break; u = 528 + (bid - 16); }
                    else if (s_ == 1 || bid < 152) { const int v = (s_ == 1 ? 0 : 176) + (bid - 80); u = (v / 31) * 32 + v % 31; }
                    else if (bid < 240) { const int t_ = bid - 152, db = t_ < 16 ? t_ : 80 + (t_ - 16); u = 592 + ((db + 240) & 255); }
                    else break; }
                else { u = bid + s_ * G; if (u >= 256 + 16 + 256 + 64) break; }
                if (u < 256) { if ((u & 31) != NCH - 1) ssm_unit<0>(args, layer, u, lds, tid, lane, wave); }
                else if (u < 272) ssm_unit<2>(args, layer, u - 256, lds, tid, lane, wave);
                else if (u < 528 || u >= 592) mix_unit<false>(args, layer, u < 528 ? u - 272 : u - 592, lds, tid, lane, wave, u >= 592 ? 4 : (donor ? 3 : 7));
                else mix_unit<true>(args, layer, u - 528, lds, tid, lane, wave, 7);
            }
        } else if (k == 2) for (int rep_ = 0; rep_ < PROBE_REP_C; ++rep_) {
            for (int u = bid; u < 256; u += G) ssm_unit<1>(args, layer, u, lds, tid, lane, wave);
        } else if (k == 3) for (int rep_ = 0; rep_ < PROBE_REP_D; ++rep_) {
            gemm2_phase(lds + RING_OFF, (const bf16*)args.out, (const bf16*)(ws + WS_WBR) + (size_t)layer * 4 * D * MIXW, GTb, MGb, G, bid, tid);
            gemm2_tail_phase(lds + RING_OFF, (const bf16*)args.out, (const bf16*)(ws + WS_WBR) + (size_t)layer * 4 * D * MIXW, GTb, MGb, G, bid, tid);
        } else if (k == 5) {
            pg8::Gemm g{XB, (const bf16*)(ws + WS_WFI) + (size_t)layer * 2 * FF * D, M, 2 * FF, D}; pg8::StaticOrder S; S.init(M, 2 * FF, G, bid);
            pg8::EpiSwiGLU E{ACTb, ssq, (const LAS float*)(lds + RING_OFF + pg8::RSTD_LDS_OFF)};
            pg8::gemm_phase<pg8::EpiSwiGLU, pg8::StaticOrder, true, true>(lds + RING_OFF, g, S, E, tid);
            if (!MK_PER_PHASE && G == 256 && bid >= P0_F_BID0 && layer + 1 < NLAYER) p0_idle_items(args, lds, lane, wave, bid, layer + 1, p0_items_A(G), P0_F_BID0, P0_F_PER);
        } else {
            const bool isE = k == 4; const int K = isE ? D : FF;
            const bf16* Ap = isE ? MGb : ACTb; const bf16* Bp = isE ? (const bf16*)(ws + WS_WOUT) + (size_t)layer * D * D : (const bf16*)(ws + WS_WFO) + (size_t)layer * D * FF;
            { pg8::Gemm g{Ap, Bp, MP, D, K}; pg8::StaticOrder S; S.init(MP, D, G, bid);
              pg8::EpiResid E{XB, ssq};
              pg8::gemm_phase<pg8::EpiResid, pg8::StaticOrder, true, true>(lds + RING_OFF, g, S, E, tid); }
#ifdef DBG_T_TAIL
            if (ph == DBG_T_PH && bid == DBG_T_BLK && tid == 0) ((volatile LAS unsigned long long*)(lds + MISC_OFF + 256))[9] = __builtin_amdgcn_s_memrealtime();
#endif
            resid_tail_phase(lds + RING_OFF, Ap, Bp, K, XB, ssq, G, bid, tid);
#ifdef DBG_T_TAIL
            if (ph == DBG_T_PH && bid == DBG_T_BLK && tid == 0) ((volatile LAS unsigned long long*)(lds + MISC_OFF + 256))[10] = __builtin_amdgcn_s_memrealtime();
#endif
        }
#ifdef DBG_T_PH
        if (ph == DBG_T_PH && bid == DBG_T_BLK && tid == 0) { ((volatile LAS unsigned long long*)(lds + MISC_OFF + 256))[2] = __builtin_amdgcn_s_memtime(); ((volatile LAS unsigned long long*)(lds + MISC_OFF + 256))[3] = __builtin_amdgcn_s_memrealtime(); }
#endif
        if (ph_i + 1 < hi) {
            asm volatile("s_waitcnt vmcnt(0)" ::: "memory"); __syncthreads();
            if (tid == 0) xcd_barrier_leader(bar);
            else if (wave != 0) {
                if (k == 3 || k == 5) {
                    const char* wb = k == 3 ? (const char*)((const bf16*)(ws + WS_WOUT) + (size_t)layer * D * D) : (const char*)((const bf16*)(ws + WS_WFO) + (size_t)layer * D * FF);
                    const int rowb = k == 3 ? D * 2 : FF * 2;
                    for (int l = (((bid >> 3) * (NWAVES - 1) + (wave - 1)) << 6) + lane; l < 16384; l += ((G >> 3) * (NWAVES - 1)) << 6)
                        __builtin_amdgcn_global_load_lds((const unsigned*)(wb + (size_t)(l >> 4) * rowb + (l & 15) * 128), (LAS unsigned*)(lds + RING_OFF + pg8::RSTD_RAW_OFF + wave * 1024), 4, 0, 0);
                }
                if (!MK_PER_PHASE && k >= 0 && k < P0_SLICES && layer + 1 < NLAYER) p0_slice(args, lds, lane, wave, G, bid, layer + 1, k);
            }
            __syncthreads();
        }
#ifdef PROBE_XBAR
        if (ph_i == 8) for (int i_ = 0; i_ < PROBE_XBAR; ++i_) xcd_barrier(bar, tid == 0);
#endif
#if defined(DBG_T_PH) && defined(DBG_T_AFTERBAR)
        if (ph == DBG_T_PH && bid == DBG_T_BLK && tid == 0) { ((volatile LAS unsigned long long*)(lds + MISC_OFF + 256))[2] = __builtin_amdgcn_s_memtime(); ((volatile LAS unsigned long long*)(lds + MISC_OFF + 256))[3] = __builtin_amdgcn_s_memrealtime(); }
#endif
    }
#ifdef DBG_T_PH
    if (bid == DBG_T_BLK && wave0 == 0 && __builtin_amdgcn_mbcnt_lo(~0u, 0u) == 0u) {
        volatile LAS unsigned long long* ts_ = (volatile LAS unsigned long long*)(lds + MISC_OFF + 256);
        const unsigned long long dc = ts_[2] - ts_[0], dr = ts_[3] - ts_[1];
        unsigned long long val = DBG_T_MODE == 11 ? (ts_[16 + DBG_TB] - ts_[16 + DBG_TA]) : DBG_T_MODE == 8 ? (ts_[5] - ts_[1])   : DBG_T_MODE == 9 ? (ts_[3] - ts_[7])   : DBG_T_MODE == 10 ? (ts_[7] - ts_[5])   : DBG_T_MODE == 7 ? (ts_[10] - ts_[9])   : DBG_T_MODE == 5 ? (ts_[8] - ts_[4]) / 16ull   : DBG_T_MODE == 3 ? (ts_[6] - ts_[4]) / 16ull   : DBG_T_MODE == 4 ? (ts_[7] - ts_[5]) * 10ull   : DBG_T_MODE == 0 ? (dc * 100ull) / (dr ? dr : 1ull)      : DBG_T_MODE == 1 ? dr   : dc / 1000ull;
        const unsigned long long t0 = __builtin_amdgcn_s_memrealtime();
        while (__builtin_amdgcn_s_memrealtime() - t0 < val * 100ull) __builtin_amdgcn_s_sleep(16);
    }
#endif
}

extern "C" void kernel_launch(void* const* d_in, const int* in_sizes, int n_in, void* d_out, int out_size, void* d_ws, size_t ws_size, hipStream_t stream) {
    static int grid = 0;
    if (grid == 0) {
        if (n_in != 32 || out_size != (int)O_END || ws_size < WS_END) { fprintf(stderr, "kernel_launch: expected 32 inputs, %zu outputs, >= %zu bytes of workspace; got %d, %d, %zu; nothing launched\n", (size_t)O_END, (size_t)WS_END, n_in, out_size, ws_size); grid = -1; return; }
        int dev = 0, cus = 0, per_cu = 0;
        if (hipGetDevice(&dev) != hipSuccess || hipDeviceGetAttribute(&cus, hipDeviceAttributeMultiprocessorCount, dev) != hipSuccess) { grid = -1; return; }
        if (hipFuncSetAttribute((const void*)hybrid_fwd, hipFuncAttributeMaxDynamicSharedMemorySize, LDS_BYTES) != hipSuccess) { fprintf(stderr, "kernel_launch: hipFuncSetAttribute failed\n"); grid = -1; return; }
        if (hipOccupancyMaxActiveBlocksPerMultiprocessor(&per_cu, (const void*)hybrid_fwd, NWAVES * 64, LDS_BYTES) != hipSuccess || per_cu < 1) { fprintf(stderr, "kernel_launch: occupancy query says %d blocks per CU; nothing launched\n", per_cu); (void)hipGetLastError(); grid = -1; return; }
        grid = cus;
    }
    if (grid < 0) return;
    (void)hipMemsetAsync((char*)d_ws + WS_CTL, 0, CTL_ZERO_BYTES, stream);
    Args a{};
    for (int i = 0; i < 32; ++i) a.in[i] = (const float*)d_in[i];
    a.out = (float*)d_out; a.ws = (unsigned char*)d_ws;
#if MK_PER_PHASE
    for (int k = 0; k < NPHASE; ++k) { a.ph_lo = k; a.ph_hi = k + 1; hipLaunchKernelGGL(hybrid_fwd, dim3(grid), dim3(NWAVES * 64), LDS_BYTES, stream, a); }
#else
    a.ph_lo = 0; a.ph_hi = NPHASE;
    hipLaunchKernelGGL(hybrid_fwd, dim3(grid), dim3(NWAVES * 64), LDS_BYTES, stream, a);
#endif
}
```

```cpp
#include <hip/hip_runtime.h>
#include <cstdio>
#include <cstdint>
#ifndef XPF_LEAD
#define XPF_LEAD 2
#endif
namespace pg8 {
#define PG8_LAS __attribute__((address_space(3)))
typedef unsigned short bf16_t;
typedef short bf16x8 __attribute__((ext_vector_type(8)));
typedef float f32x4 __attribute__((ext_vector_type(4)));
typedef unsigned u32x4 __attribute__((ext_vector_type(4)));
constexpr int BM = 256, BK = 64, HALF = 128, HTB = HALF * BK * 2  , STAGE_BYTES = 8 * HTB, NXCD = 8, WGM = 8, RSTD_LDS_OFF = 147456 + 320 + 1024  , RSTD_RAW_OFF = RSTD_LDS_OFF + 1024  , BIAS_LDS_OFF = RSTD_RAW_OFF + 8192  , RSTD_LDS2_OFF = BIAS_LDS_OFF + 1024  , BIAS_LDS2_OFF = RSTD_LDS2_OFF + 1024  ;

__host__ __device__ __forceinline__ int lds_byte(int r, int c) { const int st = (r >> 4) * 2 + (c >> 5), rr = r & 15, cc = c & 31, ob = rr * 64 + cc * 2; return st * 1024 + (ob ^ (((ob >> 9) & 1) << 5)); }
__host__ __device__ __forceinline__ void stage_rc(int b, int& R, int& C) { const int st = b / 1024, sb = b % 1024, swz = sb ^ (((sb >> 9) & 1) << 5); R = (st >> 1) * 16 + swz / 64; C = (st & 1) * 32 + (swz % 64) / 2; }
__host__ __device__ __forceinline__ int perm32(int rho) { const int n = rho >> 4, i = rho & 15; return 8 * (i >> 2) + 4 * n + (i & 3); }

struct Unit { int pm, pn; };
struct Gemm { const bf16_t* A; const bf16_t* Bt; int M, N, K; };

struct StaticOrder {
    int nM, nN, nwg, G, c;
    __host__ __device__ void init(int M, int N, int G_, int c_) { nM = M / BM; nN = N / BM; nwg = nM * nN; G = G_; c = c_; }
    __host__ __device__ bool next(int i, Unit& u) const {
        const long L = (long)i * G + c; if (L >= nwg) return false;
        int wgid = (int)L; { const int q = nwg / NXCD, r = nwg % NXCD, xcd = wgid % NXCD, off = wgid / NXCD; wgid = (xcd < r ? xcd * (q + 1) : r * (q + 1) + (xcd - r) * q) + off; }
        const int nig = WGM * nN, gid = wgid / nig, fm = gid * WGM, gsz = (nM - fm) < WGM ? (nM - fm) : WGM;
        u.pm = fm + ((wgid % nig) % gsz); u.pn = (wgid % nig) / gsz; return true;
    }
    __device__ __forceinline__ void a_ready(const Unit&) const {}
    __device__ __forceinline__ void done(const Unit&) const {}
};
typedef float f32x2 __attribute__((ext_vector_type(2)));
typedef __bf16 bf16x2_t __attribute__((ext_vector_type(2)));
__device__ __forceinline__ unsigned cvt_pk_bf16(float lo, float hi) { f32x2 v = {lo, hi}; bf16x2_t b = __builtin_convertvector(v, bf16x2_t); return __builtin_bit_cast(unsigned, b); }
__device__ __forceinline__ float sigm(float x) { return __builtin_amdgcn_rcpf(1.0f + __builtin_amdgcn_exp2f(-1.4426950408889634f * x)); }
__device__ __forceinline__ float row_rstd(const float* ssq, int row) {
    const f32x4 a = *(const f32x4*)(ssq + ((size_t)0 * 17408 + row) * 4), b = *(const f32x4*)(ssq + ((size_t)1 * 17408 + row) * 4),
                c = *(const f32x4*)(ssq + ((size_t)2 * 17408 + row) * 4), d = *(const f32x4*)(ssq + ((size_t)3 * 17408 + row) * 4);
    const float s = (((a[0] + a[1]) + (a[2] + a[3])) + ((b[0] + b[1]) + (b[2] + b[3]))) + (((c[0] + c[1]) + (c[2] + c[3])) + ((d[0] + d[1]) + (d[2] + d[3])));
    return __builtin_amdgcn_rsqf(s * (1.0f / 1024.0f) + 1e-6f);
}
__device__ __forceinline__ void rows_rstd(const float* ssq, int row0, int fq, float (&rs)[2][4]) {
#pragma unroll
    for (int ai = 0; ai < 2; ++ai)
#pragma unroll
        for (int m = 0; m < 4; ++m) { const f32x4 p = *(const f32x4*)(ssq + ((size_t)fq * 17408 + row0 + ai * HALF + m * 16) * 4); rs[ai][m] = (p[0] + p[1]) + (p[2] + p[3]); }
#pragma unroll
    for (int ai = 0; ai < 2; ++ai)
#pragma unroll
        for (int m = 0; m < 4; ++m) { float s = rs[ai][m]; s += __shfl_xor(s, 16); s += __shfl_xor(s, 32); rs[ai][m] = __builtin_amdgcn_rsqf(s * (1.0f / 1024.0f) + 1e-6f); }
}
__device__ __forceinline__ void rows_rstd_lds(const PG8_LAS float* rl, int r0, float (&rs)[2][4]) {
#pragma unroll
    for (int ai = 0; ai < 2; ++ai)
#pragma unroll
        for (int m = 0; m < 4; ++m) rs[ai][m] = rl[r0 + ai * HALF + m * 16];
}
struct EpiNull {
    static constexpr bool PERM = true, AFTER_DRAIN = false, RSTD_LDS = false, XPREFETCH = false, BIAS_LDS = false;
    __device__ __forceinline__ void operator()(const f32x4 (&acc)[2][2][4][2], const Unit& u, int wr, int wc, int fr, int fq) const {
#pragma unroll
        for (int ai = 0; ai < 2; ++ai)
#pragma unroll
            for (int bj = 0; bj < 2; ++bj)
#pragma unroll
                for (int m = 0; m < 4; ++m) { asm volatile("" :: "v"(acc[ai][bj][m][0]), "v"(acc[ai][bj][m][1])); }
    }
};
__device__ __forceinline__ unsigned pack_u8x4(float a, float b, float c, float d) {
    unsigned w = 0u; w = __builtin_amdgcn_cvt_pk_u8_f32(a, 0u, w); w = __builtin_amdgcn_cvt_pk_u8_f32(b, 1u, w); w = __builtin_amdgcn_cvt_pk_u8_f32(c, 2u, w); w = __builtin_amdgcn_cvt_pk_u8_f32(d, 3u, w); return w; }
__device__ __forceinline__ float sig255(float t) { return __builtin_amdgcn_rcpf(__builtin_fmaf(__builtin_amdgcn_exp2f(t), 1.0f / 255.0f, 1.0f / 255.0f)); }
struct EpiProj {
    static constexpr bool PERM = true, AFTER_DRAIN = false, RSTD_LDS = true, XPREFETCH = false, BIAS_LDS = true;
    bf16_t* PM; unsigned char* GT; const float* ssq; const float* bgate; const PG8_LAS float* rl; const PG8_LAS float* bl;
    __device__ __forceinline__ void operator()(const f32x4 (&acc)[2][2][4][2], const Unit& u, int wr, int wc, int fr, int fq) const {
        const int row0 = u.pm * BM + wr * 64 + fr;
        float rsv[2][4]; rows_rstd_lds(rl, wr * 64 + fr, rsv);
        if (u.pn >= 7) {
            constexpr float NL2E = -1.4426950408889634f;
            const int lc0 = (u.pn - 7) * BM + wc * 32 + 8 * fq;
            f32x4 bv[2][2];
#pragma unroll
            for (int bj = 0; bj < 2; ++bj)
#pragma unroll
                for (int n = 0; n < 2; ++n) bv[bj][n] = *(const PG8_LAS f32x4*)(bl + bj * HALF + wc * 32 + 8 * fq + 4 * n) * NL2E;
#pragma unroll
            for (int ai = 0; ai < 2; ++ai)
#pragma unroll
                for (int m = 0; m < 4; ++m) { const int row = row0 + ai * HALF + m * 16;
                    const float rs = rsv[ai][m] * NL2E;
                    unsigned char* rowp = GT + (size_t)row * 4096 + lc0;
#pragma unroll
                    for (int bj = 0; bj < 2; ++bj) { const f32x4 v0 = acc[ai][bj][m][0] * rs + bv[bj][0], v1 = acc[ai][bj][m][1] * rs + bv[bj][1];
                        typedef unsigned u32x2_t __attribute__((ext_vector_type(2)));
                        u32x2_t w; w.x = pack_u8x4(sig255(v0[0]), sig255(v0[1]), sig255(v0[2]), sig255(v0[3])); w.y = pack_u8x4(sig255(v1[0]), sig255(v1[1]), sig255(v1[2]), sig255(v1[3]));
                        *(u32x2_t*)(rowp + bj * HALF) = w; } }
        } else {
            const int lc0 = u.pn * BM + wc * 32 + 8 * fq;
#pragma unroll
            for (int ai = 0; ai < 2; ++ai)
#pragma unroll
                for (int m = 0; m < 4; ++m) { const int row = row0 + ai * HALF + m * 16;
                    const float rs = rsv[ai][m];
                    bf16_t* rowp = PM + (size_t)row * 1792 + lc0;
#pragma unroll
                    for (int bj = 0; bj < 2; ++bj) { const f32x4 v0 = acc[ai][bj][m][0] * rs, v1 = acc[ai][bj][m][1] * rs;
                        u32x4 w; w.x = cvt_pk_bf16(v0[0], v0[1]); w.y = cvt_pk_bf16(v0[2], v0[3]); w.z = cvt_pk_bf16(v1[0], v1[1]); w.w = cvt_pk_bf16(v1[2], v1[3]);
                        *(u32x4*)(rowp + bj * HALF) = w; } }
        }
    }
};
struct EpiResid {
    static constexpr bool PERM = true, AFTER_DRAIN = false, RSTD_LDS = false, XPREFETCH = true, BIAS_LDS = false;
    bf16_t* XB; float* ssq; bool pf;
    __device__ __forceinline__ void prefetch(const Unit& u, PG8_LAS unsigned char* dump, int tid) const {
        if (!pf) return;
        const unsigned vo = (unsigned)(tid >> 2) * 2048u + (unsigned)(tid & 3) * 128u;
        const char* base = (const char*)(XB + (size_t)u.pm * BM * 1024 + u.pn * BM);
        __builtin_amdgcn_global_load_lds((const unsigned*)(base + vo), (PG8_LAS unsigned*)dump, 4, 0, 0);
        __builtin_amdgcn_global_load_lds((const unsigned*)(base + (size_t)128 * 2048 + vo), (PG8_LAS unsigned*)dump, 4, 0, 0);
    }
    __device__ __forceinline__ void operator()(const f32x4 (&acc)[2][2][4][2], const Unit& u, int wr, int wc, int fr, int fq) const {
        const int row0 = u.pm * BM + wr * 64 + fr, col0 = u.pn * BM + wc * 32 + 8 * fq;
#pragma unroll
        for (int ai = 0; ai < 2; ++ai)
#pragma unroll
            for (int m = 0; m < 4; ++m) { const int row = row0 + ai * HALF + m * 16;
                bf16_t* dstb = XB + (size_t)row * 1024 + col0; float ss = 0.f;
                f32x4 x0[2], x1[2];
                {
#pragma unroll
                    for (int bj = 0; bj < 2; ++bj) { const u32x4 q = *(const u32x4*)(dstb + bj * HALF);
                        x0[bj] = (f32x4){__builtin_bit_cast(float, q.x << 16), __builtin_bit_cast(float, q.x & 0xffff0000u), __builtin_bit_cast(float, q.y << 16), __builtin_bit_cast(float, q.y & 0xffff0000u)};
                        x1[bj] = (f32x4){__builtin_bit_cast(float, q.z << 16), __builtin_bit_cast(float, q.z & 0xffff0000u), __builtin_bit_cast(float, q.w << 16), __builtin_bit_cast(float, q.w & 0xffff0000u)}; } }
#pragma unroll
                for (int bj = 0; bj < 2; ++bj) { const f32x4 o0 = x0[bj] + acc[ai][bj][m][0], o1 = x1[bj] + acc[ai][bj][m][1];
                    u32x4 w; w.x = cvt_pk_bf16(o0[0], o0[1]); w.y = cvt_pk_bf16(o0[2], o0[3]); w.z = cvt_pk_bf16(o1[0], o1[1]); w.w = cvt_pk_bf16(o1[2], o1[3]);
                    *(u32x4*)(dstb + bj * HALF) = w;
                    ss += ((o0[0] * o0[0] + o0[1] * o0[1]) + (o0[2] * o0[2] + o0[3] * o0[3])) + ((o1[0] * o1[0] + o1[1] * o1[1]) + (o1[2] * o1[2] + o1[3] * o1[3])); }
                ss += __shfl_xor(ss, 16); ss += __shfl_xor(ss, 32);
                if (fq == 0) ssq[((size_t)u.pn * 17408 + row) * 4 + wc] = ss; }
    }
};
struct EpiSwiGLU {
    static constexpr bool PERM = true, AFTER_DRAIN = false, RSTD_LDS = true, XPREFETCH = false, BIAS_LDS = false;
    bf16_t* ACT; const float* ssq; const PG8_LAS float* rl;
    __device__ __forceinline__ void operator()(const f32x4 (&acc)[2][2][4][2], const Unit& u, int wr, int wc, int fr, int fq) const {
        const int row0 = u.pm * BM + wr * 64 + fr, col0 = u.pn * HALF + wc * 32 + 8 * fq;
        float rsv[2][4]; rows_rstd_lds(rl, wr * 64 + fr, rsv);
#pragma unroll
        for (int ai = 0; ai < 2; ++ai)
#pragma unroll
            for (int m = 0; m < 4; ++m) { const int row = row0 + ai * HALF + m * 16;
                const float rs = rsv[ai][m], rsn = rs * -1.4426950408889634f, rs2 = rs * rs;
                float o[8];
#pragma unroll
                for (int j = 0; j < 4; ++j) { const float a0 = acc[ai][0][m][0][j], a1 = acc[ai][0][m][1][j];
                    o[j] = (a0 * acc[ai][1][m][0][j]) * (__builtin_amdgcn_rcpf(1.0f + __builtin_amdgcn_exp2f(a0 * rsn)) * rs2); o[4 + j] = (a1 * acc[ai][1][m][1][j]) * (__builtin_amdgcn_rcpf(1.0f + __builtin_amdgcn_exp2f(a1 * rsn)) * rs2); }
                u32x4 w; w.x = cvt_pk_bf16(o[0], o[1]); w.y = cvt_pk_bf16(o[2], o[3]); w.z = cvt_pk_bf16(o[4], o[5]); w.w = cvt_pk_bf16(o[6], o[7]);
                *(u32x4*)(ACT + (size_t)row * 2816 + col0) = w; }
    }
};

template <class Epi, class Sched, bool ALIGN_EPI = false, bool SP2 = false>
__device__ __forceinline__ void gemm_phase(PG8_LAS unsigned char* lds, const Gemm g, const Sched& S, const Epi& E, int tidp) {
    int tid_ = tidp; asm volatile("" : "+v"(tid_));
    const int tid = tid_, wid = __builtin_amdgcn_readfirstlane(tid >> 6), lane = tid & 63, wr = wid >> 2, wc = wid & 3, fr = lane & 15, fq = lane >> 4;
    const int K = g.K, nt = K / BK;
    unsigned voffA, voffB;
    { int R, C; stage_rc(tid * 16, R, C); const int Rb = Epi::PERM ? ((R & ~31) + perm32(R & 31)) : R; voffA = (unsigned)(R * K + C) * 2u; voffB = (unsigned)(Rb * K + C) * 2u; }
    const size_t step64 = (size_t)64 * K * 2;
    const size_t kstep = (size_t)(BK * 2);
    const size_t hstep = (size_t)HALF * K * 2;
    const size_t tstep = 2 * hstep;
    const unsigned ldsw = (unsigned)wid * 1024u;
    const int aoff = lds_byte(wr * 64 + fr, fq * 8), boff = lds_byte(wc * 32 + fr, fq * 8);
#define PG8_SA(b, h) (((b) * 2 + (h)) * HTB)
#define PG8_SB(b, h) ((4 + (b) * 2 + (h)) * HTB)
#define PG8_STAGE(bufoff, gbase, voff) do { _Pragma("unroll") for (int _i = 0; _i < 2; ++_i) \
        __builtin_amdgcn_global_load_lds((const unsigned*)((const char*)(gbase) + _i * step64 + (voff)), (PG8_LAS unsigned*)(lds + (bufoff) + ldsw + _i * 8192), 16, 0, 0); } while (0)
#define PG8_LDA(dst, b, h) do { _Pragma("unroll") for (int m = 0; m < 4; ++m) _Pragma("unroll") for (int k = 0; k < 2; ++k) dst[m][k] = *(const PG8_LAS bf16x8*)(lds + PG8_SA(b, h) + aoff + m * 2048 + k * 1024); } while (0)
#define PG8_LDB(dst, b, h) do { _Pragma("unroll") for (int n = 0; n < 2; ++n) _Pragma("unroll") for (int k = 0; k < 2; ++k) dst[n][k] = *(const PG8_LAS bf16x8*)(lds + PG8_SB(b, h) + boff + n * 2048 + k * 1024); } while (0)
#define PG8_MMA(ai, bj, At, Bt) do { __builtin_amdgcn_s_setprio(1); _Pragma("unroll") for (int m = 0; m < 4; ++m) _Pragma("unroll") for (int n = 0; n < 2; ++n) _Pragma("unroll") for (int k = 0; k < 2; ++k) \
        acc[ai][bj][m][n] = __builtin_amdgcn_mfma_f32_16x16x32_bf16(Bt[n][k], At[m][k], acc[ai][bj][m][n], 0, 0, 0); __builtin_amdgcn_s_setprio(0); } while (0)
#define PG8_WAIT_V(n) asm volatile("s_waitcnt vmcnt(" #n ")" ::: "memory")
#define PG8_WAIT_L(n) asm volatile("s_waitcnt lgkmcnt(" #n ")" ::: "memory")
#define PG8_BAR __builtin_amdgcn_s_barrier()
#define PG8_SCHED __builtin_amdgcn_sched_barrier(0)
    Unit cur, nxt; int ui = 0;
    if (!S.next(0, cur)) return;
    f32x4 acc[2][2][4][2];
#pragma unroll
    for (int a = 0; a < 2; ++a)
#pragma unroll
        for (int b = 0; b < 2; ++b)
#pragma unroll
            for (int m = 0; m < 4; ++m)
#pragma unroll
                for (int n = 0; n < 2; ++n) acc[a][b][m][n] = (f32x4){0.f, 0.f, 0.f, 0.f};
    bf16x8 At[4][2], B0[2][2], B1[2][2];
    const char* cA = (const char*)g.A + (size_t)cur.pm * tstep; const char* cB = (const char*)g.Bt + (size_t)cur.pn * tstep;
    S.a_ready(cur);
    f32x4 rq0 = {0.f, 0.f, 0.f, 0.f}, rq1 = rq0;
#define PG8_RSTD_LOAD(u_) do { const float* sp_ = E.ssq + ((size_t)((tid & 1) * 2) * 17408 + (size_t)(u_).pm * BM + (tid >> 1)) * 4; rq0 = *(const f32x4*)sp_; rq1 = *(const f32x4*)(sp_ + (size_t)17408 * 4); } while (0)
#define PG8_RSTD_PUT(par_) do { float s_ = ((rq0[0] + rq0[1]) + (rq0[2] + rq0[3])) + ((rq1[0] + rq1[1]) + (rq1[2] + rq1[3])); s_ += __shfl_xor(s_, 1); \
        if (!(tid & 1)) *(PG8_LAS float*)(lds + ((par_) ? RSTD_LDS2_OFF : RSTD_LDS_OFF) + (tid >> 1) * 4) = __builtin_amdgcn_rsqf(s_ * (1.0f / 1024.0f) + 1e-6f); } while (0)
    if constexpr (Epi::RSTD_LDS) PG8_RSTD_LOAD(cur);
#define PG8_BIAS_DMA(u_, par_) do { if (wid == 0 && (u_).pn >= 7) __builtin_amdgcn_global_load_lds((const unsigned*)(E.bgate + ((u_).pn - 7) * BM + (tid & 63) * 4), (PG8_LAS unsigned*)(lds + ((par_) ? BIAS_LDS2_OFF : BIAS_LDS_OFF)), 16, 0, 0); } while (0)
    if constexpr (Epi::BIAS_LDS) PG8_BIAS_DMA(cur, 0);
    if constexpr (SP2) {
        PG8_STAGE(PG8_SB(0, 0), cB, voffB); PG8_STAGE(PG8_SB(0, 1), cB + hstep, voffB); PG8_STAGE(PG8_SA(0, 0), cA, voffA); PG8_STAGE(PG8_SA(0, 1), cA + hstep, voffA);
        if (wr == 1) PG8_BAR;
        PG8_WAIT_V(2); PG8_BAR;
        PG8_STAGE(PG8_SB(1, 0), cB + kstep, voffB); PG8_STAGE(PG8_SA(1, 0), cA + kstep, voffA); PG8_STAGE(PG8_SB(1, 1), cB + hstep + kstep, voffB);
        PG8_WAIT_V(6); PG8_BAR;
    } else {
        PG8_STAGE(PG8_SB(0, 0), cB, voffB); PG8_STAGE(PG8_SA(0, 0), cA, voffA); PG8_STAGE(PG8_SB(0, 1), cB + hstep, voffB); PG8_STAGE(PG8_SA(0, 1), cA + hstep, voffA);
        if (wr == 1) PG8_BAR;
        PG8_WAIT_V(4); PG8_BAR;
        PG8_STAGE(PG8_SB(1, 0), cB + kstep, voffB); PG8_STAGE(PG8_SA(1, 0), cA + kstep, voffA); PG8_STAGE(PG8_SB(1, 1), cB + hstep + kstep, voffB);
        PG8_WAIT_V(6); PG8_BAR;
    }
    if constexpr (Epi::RSTD_LDS) PG8_RSTD_PUT(0);
    for (;;) {
        const bool has_next = S.next(ui + 1, nxt);
        const char* nA = has_next ? (const char*)g.A + (size_t)nxt.pm * tstep : cA; const char* nB = has_next ? (const char*)g.Bt + (size_t)nxt.pn * tstep : cB;
        for (int t = 0; t < nt; t += 2) {
            const bool last = (t == nt - 2);
            if constexpr (Epi::XPREFETCH) { if (t == nt - XPF_LEAD) E.prefetch(cur, lds + RSTD_RAW_OFF + ldsw, tid); }
            const char* a1 = cA + (size_t)(t + 1) * kstep;
            const char* a2 = last ? nA : cA + (size_t)(t + 2) * kstep; const char* b2 = last ? nB : cB + (size_t)(t + 2) * kstep;
            const char* a3 = a2 + kstep; const char* b3 = b2 + kstep;
            if (last && has_next) S.a_ready(nxt);
            if constexpr (SP2) {
            PG8_LDB(B0, 0, 0); PG8_LDB(B1, 0, 1); PG8_SCHED; PG8_LDA(At, 0, 0); PG8_STAGE(PG8_SA(1, 1), a1 + hstep, voffA);
            PG8_WAIT_V(8); PG8_WAIT_L(0); PG8_BAR; PG8_MMA(0, 0, At, B0); PG8_MMA(0, 1, At, B1); PG8_BAR; PG8_SCHED;
            PG8_LDA(At, 0, 1); PG8_STAGE(PG8_SB(0, 0), b2, voffB); PG8_STAGE(PG8_SB(0, 1), b2 + hstep, voffB); PG8_STAGE(PG8_SA(0, 0), a2, voffA);
            PG8_WAIT_V(8); PG8_WAIT_L(0); PG8_BAR; PG8_MMA(1, 0, At, B0); PG8_MMA(1, 1, At, B1); PG8_BAR; PG8_SCHED;
            PG8_LDB(B0, 1, 0); PG8_LDB(B1, 1, 1); PG8_SCHED; PG8_LDA(At, 1, 0); PG8_STAGE(PG8_SA(0, 1), a2 + hstep, voffA);
            PG8_WAIT_V(8); PG8_WAIT_L(0); PG8_BAR; PG8_MMA(0, 0, At, B0); PG8_MMA(0, 1, At, B1); PG8_BAR; PG8_SCHED;
            PG8_LDA(At, 1, 1); PG8_STAGE(PG8_SB(1, 0), b3, voffB); PG8_STAGE(PG8_SB(1, 1), b3 + hstep, voffB); PG8_STAGE(PG8_SA(1, 0), a3, voffA);
            PG8_WAIT_V(8); PG8_WAIT_L(0); PG8_BAR; PG8_MMA(1, 0, At, B0); PG8_MMA(1, 1, At, B1); PG8_BAR; PG8_SCHED;
            } else {
            PG8_LDB(B0, 0, 0); PG8_SCHED; PG8_LDA(At, 0, 0); PG8_STAGE(PG8_SA(1, 1), a1 + hstep, voffA);
            PG8_WAIT_L(8); PG8_BAR; PG8_WAIT_L(0); PG8_MMA(0, 0, At, B0); PG8_BAR; PG8_SCHED;
            PG8_LDB(B1, 0, 1); PG8_STAGE(PG8_SB(0, 0), b2, voffB);
            PG8_BAR; PG8_WAIT_L(0); PG8_MMA(0, 1, At, B1); PG8_BAR;
            PG8_LDA(At, 0, 1); PG8_STAGE(PG8_SA(0, 0), a2, voffA);
            PG8_BAR; PG8_WAIT_L(0); PG8_MMA(1, 0, At, B0); PG8_BAR; PG8_SCHED;
            PG8_STAGE(PG8_SB(0, 1), b2 + hstep, voffB);
            PG8_WAIT_V(6); PG8_BAR; PG8_MMA(1, 1, At, B1); PG8_BAR;
            PG8_LDB(B0, 1, 0); PG8_SCHED; PG8_LDA(At, 1, 0); PG8_STAGE(PG8_SA(0, 1), a2 + hstep, voffA);
            PG8_WAIT_L(8); PG8_BAR; PG8_WAIT_L(0); PG8_MMA(0, 0, At, B0); PG8_BAR; PG8_SCHED;
            PG8_LDB(B1, 1, 1); PG8_STAGE(PG8_SB(1, 0), b3, voffB);
            PG8_BAR; PG8_WAIT_L(0); PG8_MMA(0, 1, At, B1); PG8_BAR;
            PG8_LDA(At, 1, 1); PG8_STAGE(PG8_SA(1, 0), a3, voffA);
            PG8_BAR; PG8_WAIT_L(0); PG8_MMA(1, 0, At, B0); PG8_BAR; PG8_SCHED;
            PG8_STAGE(PG8_SB(1, 1), b3 + hstep, voffB);
            PG8_WAIT_V(6); PG8_BAR; PG8_MMA(1, 1, At, B1); PG8_BAR;
            }
        }
        if constexpr (ALIGN_EPI) { if (wr == 0) PG8_BAR; }
        if constexpr (Epi::RSTD_LDS) {
            if (has_next) PG8_RSTD_LOAD(nxt);
            Epi Eu = E; Eu.rl = (const PG8_LAS float*)(lds + ((ui & 1) ? RSTD_LDS2_OFF : RSTD_LDS_OFF));
            if constexpr (Epi::BIAS_LDS) { if (has_next) PG8_BIAS_DMA(nxt, (ui + 1) & 1); Eu.bl = (const PG8_LAS float*)(lds + ((ui & 1) ? BIAS_LDS2_OFF : BIAS_LDS_OFF)); }
            Eu(acc, cur, wr, wc, fr, fq); S.done(cur);
            if (has_next) PG8_RSTD_PUT((ui + 1) & 1);
        } else
        if constexpr (!Epi::AFTER_DRAIN) { E(acc, cur, wr, wc, fr, fq); S.done(cur); }
        if (!has_next) break;
#pragma unroll
        for (int a = 0; a < 2; ++a)
#pragma unroll
            for (int b = 0; b < 2; ++b)
#pragma unroll
                for (int m = 0; m < 4; ++m)
#pragma unroll
                    for (int n = 0; n < 2; ++n) acc[a][b][m][n] = (f32x4){0.f, 0.f, 0.f, 0.f};
        cur = nxt; cA = nA; cB = nB; ++ui;
        if constexpr (ALIGN_EPI) { if (wr == 1) PG8_BAR; }
    }
    PG8_WAIT_V(0);
    if constexpr (!ALIGN_EPI) { if (wr == 0) PG8_BAR; }
    PG8_BAR;
    if constexpr (Epi::AFTER_DRAIN) { E.fused(acc, cur, wr, wc, fr, fq, lds, wid, lane); S.done(cur); }
#undef PG8_SA
#undef PG8_SB
#undef PG8_STAGE
#undef PG8_LDA
#undef PG8_LDB
#undef PG8_MMA
#undef PG8_RSTD_LOAD
#undef PG8_BIAS_DMA
#undef PG8_RSTD_PUT
#undef PG8_WAIT_V
#undef PG8_WAIT_L
#undef PG8_BAR
#undef PG8_SCHED
}
}
constexpr int D = 1024, MP = 16384, MS = 1024, M = MP + MS, NLAYER = 4, MIXW = 256, INC = 5888, PMC = 1792, GTC = 4096, FF = 2816;
constexpr int SEQ = 2048, NB = 8, DB = 128, DSEQ = 8, NCH = SEQ / 64;
constexpr int NPHASE = 2 + 7 * NLAYER;
#ifndef MK_PER_PHASE
#define MK_PER_PHASE 0
#endif
constexpr size_t O_Y = 0, O_POOLP = 17825792, O_POOLS = 17948672, O_SREP = 19914752, O_SRES = 19947520, O_SIMP = 20471808, O_SIMS = 20504576,
                 O_SCP = 21028864, O_SCS = 21045248, O_CFP = 21307392, O_CFS = 21553152, O_END = 25485312;
constexpr size_t MiB = 1u << 20;
constexpr size_t WS_CTL = 0, CTL_ZERO_BYTES = 64 * 1024;
constexpr size_t WS_SSQ = 1 * MiB;
constexpr size_t WS_E = 3 * MiB;
constexpr size_t WS_TAB = 5 * MiB;
constexpr size_t TAB_LB = 0, TAB_LP = 8192, TAB_BBT = 16384, TAB_CM = TAB_BBT + 65536, TAB_PW = TAB_CM + 65536, TAB_STRIDE = TAB_PW + 32768;
constexpr size_t WS_WIN = 6 * MiB;
constexpr size_t WS_WFI = WS_WIN + (size_t)NLAYER * INC * D * 2;
constexpr size_t WS_WOUT = WS_WFI + (size_t)NLAYER * 2 * FF * D * 2;
constexpr size_t WS_WFO = WS_WOUT + (size_t)NLAYER * D * D * 2;
constexpr size_t WS_WBR = WS_WFO + (size_t)NLAYER * D * FF * 2;
constexpr size_t WS_WGLU = WS_WBR + (size_t)NLAYER * 4 * D * MIXW * 2;
constexpr size_t WS_ACT1 = WS_WGLU + (size_t)NLAYER * MIXW * MIXW * 2;
constexpr size_t WS_PM = WS_ACT1 + (size_t)M * D * 2;
constexpr size_t WS_GT = WS_PM + (size_t)M * PMC * 2;
constexpr size_t WS_END = WS_GT + (size_t)M * GTC * 2;
static_assert(WS_TAB + NLAYER * TAB_STRIDE <= WS_WIN && WS_E + (size_t)NB * NCH * 1024 * 8 <= WS_TAB && WS_SSQ + (size_t)M * 64 <= WS_E, "d_ws map");
constexpr int CW_Q = 8192;
constexpr int CW_BAR = 1024;
constexpr int RING_OFF = 0, RING_BYTES = 147456;
constexpr int LDSCTL_OFF = RING_BYTES, MISC_OFF = LDSCTL_OFF + 320;
constexpr int LDS_BYTES = 163840;
constexpr int NWAVES = 8;

#define GAS __attribute__((address_space(1)))
#define LAS __attribute__((address_space(3)))
typedef unsigned short bf16;
typedef unsigned short bf16_t;
typedef unsigned v4u __attribute__((ext_vector_type(4)));
typedef unsigned v2u __attribute__((ext_vector_type(2)));
typedef float f32x4 __attribute__((ext_vector_type(4)));
typedef float f32x2 __attribute__((ext_vector_type(2)));
typedef short bf16x8 __attribute__((ext_vector_type(8)));
#define LDS_WAIT() asm volatile("s_waitcnt lgkmcnt(0)" ::: "memory")
#define VM_WAIT() asm volatile("s_waitcnt vmcnt(0)" ::: "memory")
__device__ __forceinline__ unsigned pk2(float lo, float hi) { return pg8::cvt_pk_bf16(lo, hi); }
__device__ __forceinline__ float bflo(unsigned u) { return __builtin_bit_cast(float, u << 16); }
__device__ __forceinline__ float bfhi(unsigned u) { return __builtin_bit_cast(float, u & 0xffff0000u); }
__device__ __forceinline__ float bf1(bf16_t b) { return __builtin_bit_cast(float, (unsigned)b << 16); }
__device__ __forceinline__ void unpack8(const v4u v, float (&f)[8]) { f[0] = bflo(v.x); f[1] = bfhi(v.x); f[2] = bflo(v.y); f[3] = bfhi(v.y); f[4] = bflo(v.z); f[5] = bfhi(v.z); f[6] = bflo(v.w); f[7] = bfhi(v.w); }
__device__ __forceinline__ v4u pack8(const float (&f)[8]) { v4u w; w.x = pk2(f[0], f[1]); w.y = pk2(f[2], f[3]); w.z = pk2(f[4], f[5]); w.w = pk2(f[6], f[7]); return w; }
__device__ __forceinline__ float sigm(float x) { return pg8::sigm(x); }
__device__ __forceinline__ float gelu_tanh(float y) { const float in2 = 1.5957691216057308f * (y + 0.044715f * y * y * y); const float e = __builtin_amdgcn_exp2f(1.4426950408889634f * in2); return 0.5f * y * (2.0f - 2.0f * __builtin_amdgcn_rcpf(e + 1.0f)); }
__device__ __forceinline__ float wave_sum(float v) {
#pragma unroll
    for (int o = 1; o < 64; o <<= 1) v += __shfl_xor(v, o);
    return v;
}

#define XB_TMO      128
#define XB_XCNT(j)  (256  + 64 * (j))
#define XB_XSUB(j)  (1280 + 64 * (j))
#define XB_XGEN(j)  (2304 + 64 * (j))
#define XB_TOP      3328
#define XB_TOPGEN   3392
#define XCD_BAR_WORDS 3456
#define XB_SPIN_CAP (1u << 18)

__device__ __forceinline__ unsigned xb_ld(unsigned* p)              { return __hip_atomic_load(p, __ATOMIC_RELAXED, __HIP_MEMORY_SCOPE_AGENT); }
__device__ __forceinline__ unsigned xb_add(unsigned* p, unsigned v) { return __hip_atomic_fetch_add(p, v, __ATOMIC_RELAXED, __HIP_MEMORY_SCOPE_AGENT); }
__device__ __forceinline__ unsigned xb_xcc_id() { return (unsigned)__builtin_amdgcn_s_getreg((3 << 11) | 20) & 0xFu; }
#define XB_SPIN(cond, bar) do { unsigned _sp = 0; while (cond) { __builtin_amdgcn_s_sleep(1); \
    if ((++_sp & 255u) == 0u) { if (xb_ld(&(bar)[XB_TMO])) break; if (_sp > XB_SPIN_CAP) { atomicAdd(&(bar)[XB_TMO], 1u); break; } } } } while (0)

struct XcdBarrier {
    unsigned* bar; unsigned x;
    volatile LAS unsigned* st;
};

__device__ __forceinline__ XcdBarrier xcd_barrier_post(unsigned* bar, volatile LAS unsigned* st) {
    XcdBarrier b; b.bar = bar; b.x = xb_xcc_id(); b.st = st;
    if (threadIdx.x == 0) (void)xb_add(&bar[XB_XCNT(b.x)], 1u);
    return b;
}
__device__ __forceinline__ void xcd_barrier_complete(unsigned* bar, unsigned x, unsigned& nloc, unsigned& nx) {
    const unsigned G = gridDim.x * gridDim.y * gridDim.z;
    unsigned sum, cnt, mine, sp = 0u;
    for (;;) {
        sum = 0u; cnt = 0u; mine = 0u;
#pragma unroll
        for (unsigned j = 0; j < 16; ++j) { const unsigned c = xb_ld(&bar[XB_XCNT(j)]); sum += c; cnt += (c > 0u) ? 1u : 0u; mine = (j == x) ? c : mine; }
        if (sum == G) break;
        __builtin_amdgcn_s_sleep(1);
        if ((++sp & 255u) == 0u) { if (xb_ld(&bar[XB_TMO])) break; if (sp > XB_SPIN_CAP) { atomicAdd(&bar[XB_TMO], 1u); break; } }
    }
    nloc = mine > 0u ? mine : 1u; nx = cnt > 0u ? cnt : 1u;
}

__device__ __forceinline__ void xcd_barrier_leader(const XcdBarrier& b) {
    {
        unsigned* bar = b.bar;
        __builtin_amdgcn_s_waitcnt(0);
        unsigned nloc = b.st[0], nx = b.st[1];
        if (nloc == 0u) { xcd_barrier_complete(bar, b.x, nloc, nx); b.st[0] = nloc; b.st[1] = nx; }
        const unsigned old = xb_add(&bar[XB_XSUB(b.x)], 1u);
        const unsigned gen = old / nloc;
        if (old + 1u == (gen + 1u) * nloc) {
            __builtin_amdgcn_fence(__ATOMIC_RELEASE, "agent");
            asm volatile("s_waitcnt vmcnt(0)" ::: "memory");
            const unsigned og = xb_add(&bar[XB_TOP], 1u);
            const unsigned tg = og / nx;
            if (og + 1u == (tg + 1u) * nx) xb_add(&bar[XB_TOPGEN], 1u);
            else XB_SPIN(xb_ld(&bar[XB_TOPGEN]) == tg, bar);
            __builtin_amdgcn_fence(__ATOMIC_ACQUIRE, "agent");
            xb_add(&bar[XB_XGEN(b.x)], 1u);
            asm volatile("s_waitcnt vmcnt(0)" ::: "memory");
        } else {
            XB_SPIN(xb_ld(&bar[XB_XGEN(b.x)]) == gen, bar);
            __builtin_amdgcn_fence(__ATOMIC_ACQUIRE, "agent");
            asm volatile("s_waitcnt vmcnt(0)" ::: "memory");
        }
    }
}
__device__ __forceinline__ void xcd_barrier(const XcdBarrier& b, bool leader) {
    asm volatile("s_waitcnt vmcnt(0)" ::: "memory");
    __syncthreads();
    if (leader) xcd_barrier_leader(b);
    __syncthreads();
}
struct Args { const float* in[32]; float* out; unsigned char* ws; int ph_lo, ph_hi; };
enum { I_XP = 0, I_XS, I_STPOOL, I_STRE, I_STIM, I_STSC, I_STCF, I_N1G, I_N2G, I_FING, I_WIN, I_BGATE, I_POOLW, I_POOLSC, I_LAMRE, I_LAMIM, I_LOGDT,
       I_BRE, I_BIM, I_CRE, I_CIM, I_DSKIP, I_WGLU, I_BGLU, I_SCW, I_CFW, I_CFLNG, I_CFLNB, I_WBR, I_WOUT, I_WFI, I_WFO };

__device__ __forceinline__ void p0_item(const float* W, int ldw, int src_col0, const float* kscale, int k0, bf16* WTrow0, int K, LAS float* scr, int lane) {
    float wv[32];
#pragma unroll
    for (int i = 0; i < 32; ++i) { const int kk = 2 * i + (lane >> 5); wv[i] = W[(size_t)(k0 + kk) * ldw + src_col0 + (lane & 31)]; }
#pragma unroll
    for (int i = 0; i < 32; ++i) { const int kk = 2 * i + (lane >> 5); scr[kk * 33 + (lane & 31)] = wv[i]; }
    LDS_WAIT(); asm volatile("" ::: "memory");
    const int c = lane & 7;
    f32x4 ks0 = (f32x4){1.f, 1.f, 1.f, 1.f}, ks1 = ks0;
    if (kscale) { ks0 = *(const f32x4*)(kscale + k0 + 8 * c); ks1 = *(const f32x4*)(kscale + k0 + 8 * c + 4); }
#pragma unroll
    for (int j = 0; j < 4; ++j) { const int n = (lane >> 3) + 8 * j; const LAS float* s = scr + (8 * c) * 33 + n;
        v4u o; o.x = pk2(s[0 * 33] * ks0[0], s[1 * 33] * ks0[1]); o.y = pk2(s[2 * 33] * ks0[2], s[3 * 33] * ks0[3]); o.z = pk2(s[4 * 33] * ks1[0], s[5 * 33] * ks1[1]); o.w = pk2(s[6 * 33] * ks1[2], s[7 * 33] * ks1[3]);
        *(GAS v4u*)(WTrow0 + (size_t)n * K + k0 + 8 * c) = o; }
    LDS_WAIT(); asm volatile("" ::: "memory");
}
constexpr int P0_IT_IN = 16 * (INC / 32), P0_IT_FI = 16 * (2 * FF / 32), P0_IT_OUT = 16 * 32, P0_IT_FO = (FF / 64) * 32, P0_IT_BR = 4 * 4 * 32, P0_IT_GLU = 4 * 8;
constexpr int P0_IT_LAYER = P0_IT_IN + P0_IT_FI + P0_IT_OUT + P0_IT_FO + P0_IT_BR + P0_IT_GLU;
__device__ __forceinline__ void p0_weight_item(const Args& a, int L, int r, LAS float* scr, int lane) {
    unsigned char* ws = a.ws;
    if (r < P0_IT_IN) { const int nblk = INC / 32, kb = r / nblk, nb = r % nblk;
        p0_item(a.in[I_WIN] + (size_t)L * D * INC, INC, 32 * nb, a.in[I_N1G] + L * D, 64 * kb, (bf16*)(ws + WS_WIN) + ((size_t)L * INC + 32 * nb) * D, D, scr, lane); return; } r -= P0_IT_IN;
    if (r < P0_IT_FI) { const int nblk = 2 * FF / 32, kb = r / nblk, nb = r % nblk; const int nd = 32 * nb, pn = nd >> 8, rr = nd & 255;
        const int src = rr < 128 ? 128 * pn + rr : FF + 128 * pn + (rr - 128);
        p0_item(a.in[I_WFI] + (size_t)L * D * 2 * FF, 2 * FF, src, a.in[I_N2G] + L * D, 64 * kb, (bf16*)(ws + WS_WFI) + ((size_t)L * 2 * FF + nd) * D, D, scr, lane); return; } r -= P0_IT_FI;
    if (r < P0_IT_OUT) { const int kb = r / 32, nb = r % 32;
        p0_item(a.in[I_WOUT] + (size_t)L * D * D, D, 32 * nb, nullptr, 64 * kb, (bf16*)(ws + WS_WOUT) + ((size_t)L * D + 32 * nb) * D, D, scr, lane); return; } r -= P0_IT_OUT;
    if (r < P0_IT_FO) { const int kb = r / 32, nb = r % 32;
        p0_item(a.in[I_WFO] + (size_t)L * FF * D, D, 32 * nb, nullptr, 64 * kb, (bf16*)(ws + WS_WFO) + ((size_t)L * D + 32 * nb) * FF, FF, scr, lane); return; } r -= P0_IT_FO;
    if (r < P0_IT_BR) { const int br = r / 128, q = r % 128, kb = q / 32, nb = q % 32;
        p0_item(a.in[I_WBR] + (size_t)(L * 4 + br) * MIXW * D, D, 32 * nb, nullptr, 64 * kb, (bf16*)(ws + WS_WBR) + ((size_t)(L * 4 + br) * D + 32 * nb) * MIXW, MIXW, scr, lane); return; } r -= P0_IT_BR;
    { const int kb = r / 8, nb = r % 8;
        p0_item(a.in[I_WGLU] + (size_t)L * MIXW * MIXW, MIXW, 32 * nb, nullptr, 64 * kb, (bf16*)(ws + WS_WGLU) + ((size_t)L * MIXW + 32 * nb) * MIXW, MIXW, scr, lane); }
}
constexpr int P0_SLICES = 6, P0_F_PER = 7, P0_A_PER = 2, P0_F_BID0 = 216, P0_A_BID0 = 192;
__device__ __forceinline__ int p0_items_A(int G) { return 0; }
__device__ __forceinline__ int p0_items_F(int G) { return G == 256 ? (256 - P0_F_BID0) * NWAVES * P0_F_PER : 0; }
__device__ __forceinline__ void p0_idle_items(const Args& a, LAS unsigned char* lds, int lane, int wave, int bid, int L, int base, int bid0, int per) {
    LAS float* scr = (LAS float*)(lds + RING_OFF + wave * 16384);
    const int nw = (256 - bid0) * NWAVES, w = (bid - bid0) * NWAVES + wave;
    for (int q = 0; q < per; ++q) p0_weight_item(a, L, base + w + q * nw, scr, lane);
}
__device__ __forceinline__ void p0_slice(const Args& a, LAS unsigned char* lds, int lane, int wave, int G, int bid, int L, int slice) {
    LAS float* scr = (LAS float*)(lds + RING_OFF + wave * 16384);
    const int first = p0_items_A(G) + p0_items_F(G), per = (P0_IT_LAYER - first + P0_SLICES - 1) / P0_SLICES;
    const int lo = first + slice * per, hi = (lo + per < P0_IT_LAYER) ? lo + per : P0_IT_LAYER;
    for (int r = lo + bid * (NWAVES - 1) + (wave - 1); r < hi; r += G * (NWAVES - 1)) p0_weight_item(a, L, r, scr, lane);
}
__device__ __forceinline__ void p0_prologue(const Args& a, LAS unsigned char* lds, int tid, int lane, int wave, int G, int bid) {
    LAS float* scr = (LAS float*)(lds + RING_OFF + wave * 16384);
    const int gw = bid * NWAVES + wave, NGW = G * NWAVES;
    unsigned char* ws = a.ws;
    for (int it = gw; it < (MK_PER_PHASE ? NLAYER : 1) * P0_IT_LAYER; it += NGW) p0_weight_item(a, it / P0_IT_LAYER, it % P0_IT_LAYER, scr, lane);
    for (int m = gw; m < M; m += NGW) {
        const float* xrow = m < MP ? a.in[I_XP] + (size_t)m * D : a.in[I_XS] + (size_t)(m - MP) * D;
        const GAS f32x4* xr = (const GAS f32x4*)xrow + lane; f32x4 v[4]; float s = 0.f;
#pragma unroll
        for (int j = 0; j < 4; ++j) { v[j] = xr[64 * j]; s += (v[j][0] * v[j][0] + v[j][1] * v[j][1]) + (v[j][2] * v[j][2] + v[j][3] * v[j][3]); }
        s = wave_sum(s);
        GAS v2u* o8 = (GAS v2u*)((bf16*)(ws + WS_ACT1) + (size_t)m * D) + lane;
#pragma unroll
        for (int j = 0; j < 4; ++j) { v2u w; w.x = pk2(v[j][0], v[j][1]); w.y = pk2(v[j][2], v[j][3]); o8[64 * j] = w; }
        if (lane < 16) ((float*)(ws + WS_SSQ))[((size_t)(lane >> 2) * M + m) * 4 + (lane & 3)] = lane == 0 ? s : 0.f;
    }
    for (int idx = bid * 16 + tid; tid < 16 && idx < NLAYER * 1024; idx += G * 16) {
        const int L = idx >> 10, gp = idx & 1023, g = gp >> 6, p = gp & 63;
        unsigned char* tab = ws + WS_TAB + (size_t)L * TAB_STRIDE;
        const float lre = a.in[I_LAMRE][idx], lim = a.in[I_LAMIM][idx], dt = expf(a.in[I_LOGDT][L * 16 + g]);
        const float ar = lre * dt, br_ = lim * dt, ea = expf(ar), cb = cosf(br_), sb = sinf(br_), sh = sinf(0.5f * br_);
        const float lbr = ea * cb, lbi = ea * sb;
        const float m1r = expm1f(ar) * cb - 2.0f * sh * sh, m1i = lbi;
        const float den = 1.0f / (lre * lre + lim * lim);
        const float qr = (m1r * lre + m1i * lim) * den, qi = (m1i * lre - m1r * lim) * den;
        ((f32x2*)(tab + TAB_LB))[gp] = (f32x2){lbr, lbi};
        float pr = lbr, pi = lbi;
#pragma unroll
        for (int s = 0; s < 6; ++s) { const float nr = pr * pr - pi * pi, ni = 2.0f * pr * pi; pr = nr; pi = ni; }
        ((f32x2*)(tab + TAB_LP))[gp] = (f32x2){pr, pi};
        bf16* bbt = (bf16*)(tab + TAB_BBT); bf16* cm = (bf16*)(tab + TAB_CM);
        const float* bre = a.in[I_BRE] + (size_t)idx * 16; const float* bim = a.in[I_BIM] + (size_t)idx * 16;
#pragma unroll
        for (int c = 0; c < 16; ++c) { const float Br = bre[c], Bi = bim[c];
            bbt[(g * 128 + p) * 16 + c] = (bf16)(pk2(qr * Br - qi * Bi, 0.f) & 0xffffu);
            bbt[(g * 128 + 64 + p) * 16 + c] = (bf16)(pk2(qr * Bi + qi * Br, 0.f) & 0xffffu);
            cm[(g * 16 + c) * 128 + p] = (bf16)(pk2(a.in[I_CRE][((size_t)(L * 16 + g) * 16 + c) * 64 + p], 0.f) & 0xffffu);
            cm[(g * 16 + c) * 128 + 64 + p] = (bf16)(pk2(-a.in[I_CIM][((size_t)(L * 16 + g) * 16 + c) * 64 + p], 0.f) & 0xffffu); }
    }
    for (int idx = bid * 512 + tid; idx < NLAYER * 4 * 64 * 64; idx += G * 512) {
        const int L = idx >> 14, r = idx & 16383, k = r >> 12, o = (r >> 6) & 63, c = r & 63;
        ((bf16*)(ws + WS_TAB + (size_t)L * TAB_STRIDE + TAB_PW))[r] = (bf16)(pk2(a.in[I_POOLW][((size_t)(L * 4 + k) * 64 + c) * 64 + o], 0.f) & 0xffffu);
    }
}
__device__ __forceinline__ void final_norm(const Args& a, int lane, int wave, int G, int bid) {
    const int gw = bid * NWAVES + wave, NGW = G * NWAVES;
    const float* ssq = (const float*)(a.ws + WS_SSQ);
    f32x4 gv[4];
#pragma unroll
    for (int j = 0; j < 4; ++j) gv[j] = ((const f32x4*)a.in[I_FING])[lane + 64 * j];
    for (int m0 = gw; m0 < M; m0 += 4 * NGW) {
        float s4[4]; v2u q4[4][4];
#pragma unroll
        for (int h = 0; h < 4; ++h) { const int m = m0 + h * NGW; s4[h] = 0.f;
            if (m < M) { if (lane < 16) s4[h] = ssq[((size_t)(lane >> 2) * M + m) * 4 + (lane & 3)];
                const GAS v2u* xb = (const GAS v2u*)((const bf16*)(a.ws + WS_ACT1) + (size_t)m * D) + lane;
#pragma unroll
                for (int j = 0; j < 4; ++j) q4[h][j] = xb[64 * j]; } }
#pragma unroll
        for (int o = 1; o < 64; o <<= 1) {
#pragma unroll
            for (int h = 0; h < 4; ++h) s4[h] += __shfl_xor(s4[h], o); }
#pragma unroll
        for (int h = 0; h < 4; ++h) { const int m = m0 + h * NGW;
            if (m < M) { const float rs = __builtin_amdgcn_rsqf(s4[h] * (1.0f / 1024.0f) + 1e-6f);
                GAS f32x4* yr = (GAS f32x4*)(a.out + (size_t)m * D) + lane;
#pragma unroll
                for (int j = 0; j < 4; ++j) { const v2u q = q4[h][j]; const f32x4 v = (f32x4){bflo(q.x), bfhi(q.x), bflo(q.y), bfhi(q.y)}; yr[64 * j] = v * rs * gv[j]; } } }
    }
}

typedef float f32x4_t __attribute__((ext_vector_type(4)));
__device__ __forceinline__ float fma_s(float a, float b, float c) { float r; asm("v_fma_f32 %0, %1, %2, %3" : "=v"(r) : "v"(a), "v"(b), "v"(c)); return r; }
template <bool SAMPLE>
__device__ __forceinline__ void mix_unit(const Args& a, int layer, int uidx, LAS unsigned char* lds, int tid_in, int lane_in, int wave_in, int stages) {
    int tid = tid_in; asm volatile("" : "+v"(tid));
    const int lane = tid & 63, wave = __builtin_amdgcn_readfirstlane(tid >> 6);
    constexpr int L = SAMPLE ? 8 : 64, NSEG = SAMPLE ? 2 : 1, R = NSEG * L;
    const bf16* PMb = (const bf16*)(a.ws + WS_PM); bf16* BR = (bf16*)a.out;
    const int s = uidx >> 5, c = uidx & 31, q0 = 2 * uidx;
    const int row0 = SAMPLE ? MP + q0 * 8 : s * SEQ + 64 * c;
    const bool last = SAMPLE || c == NCH - 1;
    LAS float* V = (LAS float*)lds;
    if (stages & 1) {
        constexpr int TR = NSEG * (30 + L);
        LAS float* WCF = (LAS float*)(lds + 96256);
        {
            constexpr int NIT = (TR * 32 + 511) / 512;
            v4u qa[NIT], qb[NIT]; int kind[NIT];
#pragma unroll
            for (int it = 0; it < NIT; ++it) {
                const int idx = tid + it * 512; kind[it] = 0; qa[it] = (v4u){0u, 0u, 0u, 0u}; qb[it] = (v4u){0u, 0u, 0u, 0u};
                if (idx < TR * 32) {
                    const int rr = idx >> 5, c8 = (idx & 31) * 8, seg = rr / (30 + L), e = rr % (30 + L);
                    int srow = -1;
                    if (SAMPLE) { if (e >= 30) srow = MP + (q0 + seg) * 8 + (e - 30); }
                    else { const int tabs = c * 64 + e - 30; if (tabs >= 0) srow = s * SEQ + tabs; }
                    if (srow >= 0) { kind[it] = 1; qa[it] = *(const v4u*)(PMb + (size_t)srow * PMC + 1280 + c8); qb[it] = *(const v4u*)(PMb + (size_t)srow * PMC + 1536 + c8); }
                    else if (SAMPLE) { kind[it] = 2; const float* st = a.in[I_STCF] + ((size_t)(layer * DB + q0 + seg) * 30 + e) * MIXW + c8; qa[it] = *(const v4u*)st; qb[it] = *(const v4u*)(st + 4); }
                }
            }
#pragma unroll
            for (int it = 0; it < NIT; ++it) {
                const int idx = tid + it * 512;
                if (idx < TR * 32) {
                    const int rr = idx >> 5, c8 = (idx & 31) * 8;
                    float v[8];
                    if (kind[it] == 1) { float av[8], bv[8]; unpack8(qa[it], av); unpack8(qb[it], bv);
#pragma unroll
                        for (int j = 0; j < 8; ++j) v[j] = av[j] * sigm(bv[j]); }
                    else { v[0] = __uint_as_float(qa[it].x); v[1] = __uint_as_float(qa[it].y); v[2] = __uint_as_float(qa[it].z); v[3] = __uint_as_float(qa[it].w);
                           v[4] = __uint_as_float(qb[it].x); v[5] = __uint_as_float(qb[it].y); v[6] = __uint_as_float(qb[it].z); v[7] = __uint_as_float(qb[it].w); }
                    *(LAS f32x4*)(V + rr * 256 + c8) = (f32x4){v[0], v[1], v[2], v[3]}; *(LAS f32x4*)(V + rr * 256 + c8 + 4) = (f32x4){v[4], v[5], v[6], v[7]};
                }
            }
        }
        { f32x4 wq[4];
#pragma unroll
            for (int it = 0; it < 4; ++it) { const int idx = tid + it * 512; wq[it] = idx < 31 * 64 ? *(const f32x4*)(a.in[I_CFW] + (size_t)layer * 31 * MIXW + idx * 4) : (f32x4){0.f, 0.f, 0.f, 0.f}; }
#pragma unroll
            for (int it = 0; it < 4; ++it) { const int idx = tid + it * 512; if (idx < 31 * 64) *(LAS f32x4*)(WCF + idx * 4) = wq[it]; } }
        __syncthreads();
        if (last) {
            for (int idx = tid; idx < NSEG * 30 * 64; idx += 512) { const int seg = idx / (30 * 64), r = idx % (30 * 64), j = r >> 6, c4 = (r & 63) * 4;
                float* dst = a.out + (SAMPLE ? O_CFS + ((size_t)(layer * DB + q0 + seg) * 30 + j) * MIXW : O_CFP + ((size_t)(layer * NB + s) * 30 + j) * MIXW) + c4;
                *(f32x4*)dst = *(LAS f32x4*)(V + (seg * (30 + L) + L + j) * 256 + c4); }
        }
        const f32x4 lg = *(const f32x4*)(a.in[I_CFLNG] + layer * MIXW + 4 * lane), lb = *(const f32x4*)(a.in[I_CFLNB] + layer * MIXW + 4 * lane);
        {
            constexpr int NT = R / NWAVES;
            const int tt0 = wave * NT, seg0 = tt0 / L, t0 = tt0 % L, base = (seg0 * (30 + L) + t0) * 256 + 4 * lane;
            f32x4 acc[NT], win[NT];
#pragma unroll
            for (int i = 0; i < NT; ++i) acc[i] = (f32x4){0.f, 0.f, 0.f, 0.f};
#pragma unroll
            for (int i = 0; i + 1 < NT; ++i) win[i] = *(LAS f32x4*)(V + base + i * 256);
#pragma unroll
            for (int j = 0; j < 31; ++j) {
                win[(j + NT - 1) % NT] = *(LAS f32x4*)(V + base + (j + NT - 1) * 256);
                const f32x4 w = *(LAS f32x4*)(WCF + j * 256 + 4 * lane);
#pragma unroll
                for (int i = 0; i < NT; ++i) acc[i] += w * win[(j + i) % NT];
            }
            float s1[NT];
#pragma unroll
            for (int i = 0; i < NT; ++i) s1[i] = (acc[i][0] + acc[i][1]) + (acc[i][2] + acc[i][3]);
#pragma unroll
            for (int o = 1; o < 64; o <<= 1) {
#pragma unroll
                for (int i = 0; i < NT; ++i) s1[i] += __shfl_xor(s1[i], o); }
            float s2[NT];
#pragma unroll
            for (int i = 0; i < NT; ++i) { acc[i] = acc[i] - s1[i] * (1.0f / 256.0f); s2[i] = (acc[i][0] * acc[i][0] + acc[i][1] * acc[i][1]) + (acc[i][2] * acc[i][2] + acc[i][3] * acc[i][3]); }
#pragma unroll
            for (int o = 1; o < 64; o <<= 1) {
#pragma unroll
                for (int i = 0; i < NT; ++i) s2[i] += __shfl_xor(s2[i], o); }
#pragma unroll
            for (int i = 0; i < NT; ++i) { const int tt = tt0 + i;
                const float rstd = __builtin_amdgcn_rsqf(s2[i] * (1.0f / 256.0f) + 1e-5f);
                const f32x4 yn = acc[i] * rstd * lg + lb;
                v2u w; w.x = pk2(yn[0] * sigm(yn[0]), yn[1] * sigm(yn[1])); w.y = pk2(yn[2] * sigm(yn[2]), yn[3] * sigm(yn[3]));
                *(v2u*)(BR + (size_t)(row0 + tt) * D + 768 + 4 * lane) = w; }
        }
        __syncthreads();
    }
    if (stages & 2) {
        constexpr int TR = NSEG * (15 + L);
        LAS bf16* Dt = (LAS bf16*)(lds + 81920);
        {
            constexpr int NIT = (TR * 32 + 511) / 512;
            v4u qa[NIT], qb[NIT]; int kind[NIT];
#pragma unroll
            for (int it = 0; it < NIT; ++it) {
                const int idx = tid + it * 512; kind[it] = 0; qa[it] = (v4u){0u, 0u, 0u, 0u}; qb[it] = (v4u){0u, 0u, 0u, 0u};
                if (idx < TR * 32) {
                    const int rr = idx >> 5, c8 = (idx & 31) * 8, seg = rr / (15 + L), e = rr % (15 + L);
                    int srow = -1;
                    if (SAMPLE) { if (e >= 15) srow = MP + (q0 + seg) * 8 + (e - 15); }
                    else { const int tabs = c * 64 + e - 15; if (tabs >= 0) srow = s * SEQ + tabs; }
                    if (srow >= 0) { kind[it] = 1; qa[it] = *(const v4u*)(PMb + (size_t)srow * PMC + c8); }
                    else if (SAMPLE) { kind[it] = 2; const float* st = a.in[I_STPOOL] + ((size_t)(layer * DB + q0 + seg) * 15 + e) * MIXW + c8; qa[it] = *(const v4u*)st; qb[it] = *(const v4u*)(st + 4); }
                }
            }
#pragma unroll
            for (int it = 0; it < NIT; ++it) {
                const int idx = tid + it * 512;
                if (idx < TR * 32) {
                    const int rr = idx >> 5, c8 = (idx & 31) * 8;
                    float v[8];
                    if (kind[it] == 1) unpack8(qa[it], v);
                    else { v[0] = __uint_as_float(qa[it].x); v[1] = __uint_as_float(qa[it].y); v[2] = __uint_as_float(qa[it].z); v[3] = __uint_as_float(qa[it].w);
                           v[4] = __uint_as_float(qb[it].x); v[5] = __uint_as_float(qb[it].y); v[6] = __uint_as_float(qb[it].z); v[7] = __uint_as_float(qb[it].w); }
                    *(LAS f32x4*)(V + rr * 256 + c8) = (f32x4){v[0], v[1], v[2], v[3]}; *(LAS f32x4*)(V + rr * 256 + c8 + 4) = (f32x4){v[4], v[5], v[6], v[7]};
                }
            }
        }
        __syncthreads();
        if (last) {
            for (int idx = tid; idx < NSEG * 15 * 64; idx += 512) { const int seg = idx / (15 * 64), r = idx % (15 * 64), j = r >> 6, c4 = (r & 63) * 4;
                float* dst = a.out + (SAMPLE ? O_POOLS + ((size_t)(layer * DB + q0 + seg) * 15 + j) * MIXW : O_POOLP + ((size_t)(layer * NB + s) * 15 + j) * MIXW) + c4;
                *(f32x4*)dst = *(LAS f32x4*)(V + (seg * (15 + L) + L + j) * 256 + c4); }
        }
        for (int idx = tid; idx < R * 32; idx += 512) {
            const int tt = idx >> 5, c8 = (idx & 31) * 8, seg = tt / L, t = tt % L, base = seg * (15 + L) + t + 15, win = 2 << (c8 >> 6);
            float sm[8];
#pragma unroll
            for (int j = 0; j < 8; ++j) sm[j] = 0.f;
            for (int w = 0; w < win; ++w) { const f32x4 x0 = *(LAS f32x4*)(V + (base - w) * 256 + c8), x1 = *(LAS f32x4*)(V + (base - w) * 256 + c8 + 4);
                sm[0] += x0[0]; sm[1] += x0[1]; sm[2] += x0[2]; sm[3] += x0[3]; sm[4] += x1[0]; sm[5] += x1[1]; sm[6] += x1[2]; sm[7] += x1[3]; }
            const int cnt = SAMPLE ? win : min(c * 64 + t + 1, win);
            const float inv = 1.0f / (float)cnt;
            const f32x4 c0 = *(LAS f32x4*)(V + base * 256 + c8), c1 = *(LAS f32x4*)(V + base * 256 + c8 + 4);
            float dd[8];
#pragma unroll
            for (int j = 0; j < 4; ++j) { dd[j] = sm[j] * inv - c0[j]; dd[4 + j] = sm[4 + j] * inv - c1[j]; }
            *(LAS v4u*)(Dt + tt * 264 + c8) = pack8(dd);
        }
        __syncthreads();
        {
            const bf16* PW = (const bf16*)(a.ws + WS_TAB + (size_t)layer * TAB_STRIDE + TAB_PW);
            const int k = wave >> 1, fr = lane & 15, fq = lane >> 4;
            constexpr int NMT = R / 16;
            for (int mt = (NMT >= 4 ? (wave & 1) * 2 : (wave & 1)); mt < (NMT >= 4 ? (wave & 1) * 2 + 2 : ((wave & 1) == 0 ? NMT : 0)); ++mt) {
                const bf16x8 b0 = *(LAS bf16x8*)(Dt + (16 * mt + fr) * 264 + 64 * k + 8 * fq), b1 = *(LAS bf16x8*)(Dt + (16 * mt + fr) * 264 + 64 * k + 32 + 8 * fq);
#pragma unroll
                for (int ot = 0; ot < 4; ++ot) {
                    f32x4 acc = (f32x4){0.f, 0.f, 0.f, 0.f};
                    const bf16x8 a0 = *(const bf16x8*)(PW + ((size_t)(k * 64 + 16 * ot + fr)) * 64 + 8 * fq), a1 = *(const bf16x8*)(PW + ((size_t)(k * 64 + 16 * ot + fr)) * 64 + 32 + 8 * fq);
                    acc = __builtin_amdgcn_mfma_f32_16x16x32_bf16(a0, b0, acc, 0, 0, 0);
                    acc = __builtin_amdgcn_mfma_f32_16x16x32_bf16(a1, b1, acc, 0, 0, 0);
                    const int o = 64 * k + 16 * ot + 4 * fq, tt = 16 * mt + fr;
                    const f32x4 sc = *(const f32x4*)(a.in[I_POOLSC] + layer * MIXW + o);
                    v2u w; w.x = pk2(acc[0] * sc[0], acc[1] * sc[1]); w.y = pk2(acc[2] * sc[2], acc[3] * sc[3]);
                    *(v2u*)(BR + (size_t)(row0 + tt) * D + o) = w;
                }
            }
        }
        __syncthreads();
    }
    if (stages & 4) {
        const float* scw = a.in[I_SCW] + (size_t)layer * 3 * MIXW;
        if constexpr (!SAMPLE) {
            const int c8 = (tid & 31) * 8, t0 = 4 * (tid >> 5);
            v4u qc[6], qh[6], qg[4];
#pragma unroll
            for (int r = 0; r < 6; ++r) { const int tabs = c * 64 + t0 - 2 + r;
                if (tabs >= 0) { const bf16* src = PMb + (size_t)(s * SEQ + tabs) * PMC + c8; qc[r] = *(const v4u*)(src + 768); qh[r] = *(const v4u*)(src + 1024); }
                else { qc[r] = (v4u){0u, 0u, 0u, 0u}; qh[r] = (v4u){0u, 0u, 0u, 0u}; } }
#pragma unroll
            for (int i = 0; i < 4; ++i) qg[i] = *(const v4u*)(PMb + (size_t)(row0 + t0 + i) * PMC + 512 + c8);
            float wt[3][8];
#pragma unroll
            for (int dj = 0; dj < 3; ++dj) { const f32x4 w0 = *(const f32x4*)(scw + dj * MIXW + c8), w1 = *(const f32x4*)(scw + dj * MIXW + c8 + 4);
                wt[dj][0] = w0[0]; wt[dj][1] = w0[1]; wt[dj][2] = w0[2]; wt[dj][3] = w0[3]; wt[dj][4] = w1[0]; wt[dj][5] = w1[1]; wt[dj][6] = w1[2]; wt[dj][7] = w1[3]; }
            float z[6][8];
#pragma unroll
            for (int r = 0; r < 6; ++r) { float cg[8], hx[8]; unpack8(qc[r], cg); unpack8(qh[r], hx);
#pragma unroll
                for (int j = 0; j < 8; ++j) z[r][j] = cg[j] * hx[j]; }
#pragma unroll
            for (int i = 0; i < 4; ++i) { float bg[8], o[8]; unpack8(qg[i], bg);
#pragma unroll
                for (int j = 0; j < 8; ++j) o[j] = bg[j] * (wt[0][j] * z[i][j] + wt[1][j] * z[i + 1][j] + wt[2][j] * z[i + 2][j]);
                *(v4u*)(BR + (size_t)(row0 + t0 + i) * D + 512 + c8) = pack8(o);
                if (last && t0 + i >= L - 2) { float* dst = a.out + O_SCP + ((size_t)(layer * NB + s) * 2 + (t0 + i - (L - 2))) * MIXW + c8;
                    *(f32x4*)dst = (f32x4){z[i + 2][0], z[i + 2][1], z[i + 2][2], z[i + 2][3]}; *(f32x4*)(dst + 4) = (f32x4){z[i + 2][4], z[i + 2][5], z[i + 2][6], z[i + 2][7]}; } }
        } else
#pragma unroll
        for (int it_ = 0; it_ < R * 32 / 512; ++it_) { const int idx = tid + it_ * 512;
            const int tt = idx >> 5, c8 = (idx & 31) * 8, seg = tt / L, t = tt % L;
            float z[3][8];
#pragma unroll
            for (int dj = 0; dj < 3; ++dj) { const int tp = t - 2 + dj;
                int srow = -1;
                if (SAMPLE) { if (tp >= 0) srow = MP + (q0 + seg) * 8 + tp; } else { const int tabs = c * 64 + tp; if (tabs >= 0) srow = s * SEQ + tabs; }
                if (srow >= 0) { float cg[8], hx[8]; unpack8(*(const v4u*)(PMb + (size_t)srow * PMC + 768 + c8), cg); unpack8(*(const v4u*)(PMb + (size_t)srow * PMC + 1024 + c8), hx);
#pragma unroll
                    for (int j = 0; j < 8; ++j) z[dj][j] = cg[j] * hx[j]; }
                else if (SAMPLE) { const float* st = a.in[I_STSC] + ((size_t)(layer * DB + q0 + seg) * 2 + (2 + tp)) * MIXW + c8; const f32x4 x0 = *(const f32x4*)st, x1 = *(const f32x4*)(st + 4);
                    z[dj][0] = x0[0]; z[dj][1] = x0[1]; z[dj][2] = x0[2]; z[dj][3] = x0[3]; z[dj][4] = x1[0]; z[dj][5] = x1[1]; z[dj][6] = x1[2]; z[dj][7] = x1[3]; }
                else {
#pragma unroll
                    for (int j = 0; j < 8; ++j) z[dj][j] = 0.f; } }
            float bg[8], o[8]; unpack8(*(const v4u*)(PMb + (size_t)(row0 + tt) * PMC + 512 + c8), bg);
#pragma unroll
            for (int j = 0; j < 8; ++j) o[j] = bg[j] * (scw[c8 + j] * z[0][j] + scw[MIXW + c8 + j] * z[1][j] + scw[2 * MIXW + c8 + j] * z[2][j]);
            *(v4u*)(BR + (size_t)(row0 + tt) * D + 512 + c8) = pack8(o);
            if (last && t >= L - 2) { float* dst = a.out + (SAMPLE ? O_SCS + ((size_t)(layer * DB + q0 + seg) * 2 + (t - (L - 2))) * MIXW : O_SCP + ((size_t)(layer * NB + s) * 2 + (t - (L - 2))) * MIXW) + c8;
                *(f32x4*)dst = (f32x4){z[2][0], z[2][1], z[2][2], z[2][3]}; *(f32x4*)(dst + 4) = (f32x4){z[2][4], z[2][5], z[2][6], z[2][7]}; }
        }
    }
}

template <int MODE>
__device__ __forceinline__ void ssm_unit(const Args& a, int layer, int uidx, LAS unsigned char* lds, int tid_in, int lane_in, int wave_in) {
    int tid = tid_in; asm volatile("" : "+v"(tid));
    const int lane = tid & 63, wave = __builtin_amdgcn_readfirstlane(tid >> 6);
    const bf16* PMb = (const bf16*)(a.ws + WS_PM); bf16* BR = (bf16*)a.out;
    const unsigned char* tab = a.ws + WS_TAB + (size_t)layer * TAB_STRIDE;
    const f32x2* LB = (const f32x2*)(tab + TAB_LB); const f32x2* LP = (const f32x2*)(tab + TAB_LP);
    const bf16* BBT = (const bf16*)(tab + TAB_BBT); const bf16* CM = (const bf16*)(tab + TAB_CM);
    f32x2* E = (f32x2*)(a.ws + WS_E);
    const int s = uidx >> 5, c = uidx & 31;
    const int row0 = MODE == 2 ? MP + 64 * uidx : s * SEQ + 64 * c;
    const int fr = lane & 15, fq = lane >> 4;
    LAS float* BU = (LAS float*)(lds + wave * 8448);
    LAS bf16* Zt = (LAS bf16*)(lds + 67584);
    const bf16x8 zf = (bf16x8){0, 0, 0, 0, 0, 0, 0, 0};
    for (int gi = 0; gi < 2; ++gi) {
        const int g = 2 * wave + gi;
        const f32x2 lam = LB[g * 64 + lane]; const float nlam1 = -lam[1];
        float hr = 0.f, hi = 0.f;
        bf16x8 bb[8];
#pragma unroll
        for (int nt = 0; nt < 8; ++nt) bb[nt] = fq < 2 ? *(const bf16x8*)(BBT + ((size_t)(g * 128 + 16 * nt + fr)) * 16 + 8 * fq) : zf;
        bf16x8 cmf[4]; float dsk = 0.f;
        if (MODE >= 1) {
#pragma unroll
            for (int ks = 0; ks < 4; ++ks) cmf[ks] = *(const bf16x8*)(CM + ((size_t)(g * 16 + fr)) * 128 + 32 * ks + 8 * fq);
            dsk = a.in[I_DSKIP][layer * MIXW + 16 * g + fr]; }
        bf16x8 ufa[4];
#pragma unroll
        for (int sub = 0; sub < 4; ++sub) ufa[sub] = fq < 2 ? *(const bf16x8*)(PMb + (size_t)(row0 + 16 * sub + fr) * PMC + 256 + 16 * g + 8 * fq) : zf;
        bf16 uva[4][4];
        if (MODE >= 1) {
#pragma unroll
            for (int sub = 0; sub < 4; ++sub)
#pragma unroll
                for (int r = 0; r < 4; ++r) uva[sub][r] = PMb[(size_t)(row0 + 16 * sub + 4 * fq + r) * PMC + 256 + 16 * g + fr]; }
        if (MODE == 1) { const f32x2 lp = LP[g * 64 + lane];
            const float nlp1 = -lp[1];
#pragma unroll 1
            for (int j = 0; j < c; j += 16) { f32x2 e16[16]; const int nq = c - j;
#pragma unroll
                for (int q = 0; q < 16; ++q) if (q < nq) e16[q] = E[((size_t)(s * NCH + j + q) * 16 + g) * 64 + lane];
#pragma unroll
                for (int q = 0; q < 16; ++q) if (q < nq) { const float nr = fma_s(lp[0], hr, fma_s(nlp1, hi, e16[q][0])), ni = fma_s(lp[0], hi, fma_s(lp[1], hr, e16[q][1])); hr = nr; hi = ni; } } }
#pragma unroll
        for (int sub = 0; sub < 4; ++sub) {
            const int rowb = row0 + 16 * sub;
            const bf16x8 uf = ufa[sub];
#pragma unroll
            for (int nt = 0; nt < 8; ++nt) { const f32x4 d = __builtin_amdgcn_mfma_f32_16x16x32_bf16(uf, bb[nt], (f32x4){0.f, 0.f, 0.f, 0.f}, 0, 0, 0);
#pragma unroll
                for (int r = 0; r < 4; ++r) BU[(4 * fq + r) * 132 + 16 * nt + fr] = d[r]; }
            asm volatile("s_waitcnt lgkmcnt(0)" ::: "memory");
            {
                float bre_[16], bim_[16];
#pragma unroll
                for (int t = 0; t < 16; ++t) { bre_[t] = BU[t * 132 + lane]; bim_[t] = BU[t * 132 + 64 + lane]; }
                float sre_[2] = {0.f, 0.f}, sim_[2] = {0.f, 0.f};
                if (MODE == 2) {
#pragma unroll
                    for (int hq = 0; hq < 2; ++hq) { const int q = 8 * uidx + 2 * sub + hq; const size_t si = ((size_t)(layer * DB + q) * 16 + g) * 64 + lane; sre_[hq] = a.in[I_STRE][si]; sim_[hq] = a.in[I_STIM][si]; } }
                asm volatile("s_waitcnt lgkmcnt(0)" ::: "memory");
#pragma unroll
                for (int t = 0; t < 16; ++t) {
                    if (MODE == 2 && (t & 7) == 0) { hr = sre_[t >> 3]; hi = sim_[t >> 3]; }
                    const float nr = fma_s(lam[0], hr, fma_s(nlam1, hi, bre_[t])), ni = fma_s(lam[0], hi, fma_s(lam[1], hr, bim_[t])); hr = nr; hi = ni;
                    bre_[t] = hr; bim_[t] = hi;
                    if (MODE == 2 && (t & 7) == 7) { const int q = 8 * uidx + 2 * sub + (t >> 3); const size_t si = ((size_t)(layer * DB + q) * 16 + g) * 64 + lane; a.out[O_SRES + si] = hr; a.out[O_SIMS + si] = hi; }
                }
#pragma unroll
                for (int t = 0; t < 16; ++t) { BU[t * 132 + lane] = bre_[t]; BU[t * 132 + 64 + lane] = bim_[t]; }
            }
            if (MODE >= 1) {
                asm volatile("s_waitcnt lgkmcnt(0)" ::: "memory");
                f32x4 y = (f32x4){0.f, 0.f, 0.f, 0.f};
#pragma unroll
                for (int ks = 0; ks < 4; ++ks) { const f32x4 h0 = *(LAS f32x4*)(BU + fr * 132 + 32 * ks + 8 * fq), h1 = *(LAS f32x4*)(BU + fr * 132 + 32 * ks + 8 * fq + 4);
                    v4u hw; hw.x = pk2(h0[0], h0[1]); hw.y = pk2(h0[2], h0[3]); hw.z = pk2(h1[0], h1[1]); hw.w = pk2(h1[2], h1[3]);
                    y = __builtin_amdgcn_mfma_f32_16x16x32_bf16(__builtin_bit_cast(bf16x8, hw), cmf[ks], y, 0, 0, 0); }
#pragma unroll
                for (int r = 0; r < 4; ++r) { const int t = 4 * fq + r; const float uv = bf1(uva[sub][r]);
                    const float z = gelu_tanh(y[r] + dsk * uv);
                    Zt[(16 * sub + t) * 264 + 16 * g + fr] = (bf16)(pk2(z, 0.f) & 0xffffu); }
                asm volatile("s_waitcnt lgkmcnt(0)" ::: "memory");
            }
            if (MODE == 0) { asm volatile("s_waitcnt lgkmcnt(0)" ::: "memory"); }
        }
        if (MODE == 0) E[((size_t)(s * NCH + c) * 16 + g) * 64 + lane] = (f32x2){hr, hi};
        if (MODE == 1 && c == NCH - 1) { const size_t si = ((size_t)(layer * NB + s) * 16 + g) * 64 + lane; a.out[O_SREP + si] = hr; a.out[O_SIMP + si] = hi; }
    }
    if (MODE == 0) __syncthreads();
    if (MODE >= 1) {
        __syncthreads();
        const bf16* WG = (const bf16*)(a.ws + WS_WGLU) + (size_t)layer * MIXW * MIXW;
        f32x4 acc[4][2];
#pragma unroll
        for (int mt = 0; mt < 4; ++mt) { acc[mt][0] = (f32x4){0.f, 0.f, 0.f, 0.f}; acc[mt][1] = (f32x4){0.f, 0.f, 0.f, 0.f}; }
#pragma unroll
        for (int ks = 0; ks < 8; ++ks) {
            const bf16x8 w0 = *(const bf16x8*)(WG + (size_t)(32 * wave + fr) * MIXW + 32 * ks + 8 * fq), w1 = *(const bf16x8*)(WG + (size_t)(32 * wave + 16 + fr) * MIXW + 32 * ks + 8 * fq);
#pragma unroll
            for (int mt = 0; mt < 4; ++mt) { const bf16x8 zb = *(LAS bf16x8*)(Zt + (16 * mt + fr) * 264 + 32 * ks + 8 * fq);
                acc[mt][0] = __builtin_amdgcn_mfma_f32_16x16x32_bf16(w0, zb, acc[mt][0], 0, 0, 0);
                acc[mt][1] = __builtin_amdgcn_mfma_f32_16x16x32_bf16(w1, zb, acc[mt][1], 0, 0, 0); }
        }
#pragma unroll
        for (int nl = 0; nl < 2; ++nl) { const int n0 = 32 * wave + 16 * nl + 4 * fq; const f32x4 bgl = *(const f32x4*)(a.in[I_BGLU] + layer * MIXW + n0);
#pragma unroll
            for (int mt = 0; mt < 4; ++mt) { const int tt = 16 * mt + fr; const v2u zz = *(LAS v2u*)(Zt + tt * 264 + n0);
                const float z0 = bflo(zz.x), z1 = bfhi(zz.x), z2 = bflo(zz.y), z3 = bfhi(zz.y);
                v2u w; w.x = pk2(z0 * sigm(acc[mt][nl][0] + bgl[0]), z1 * sigm(acc[mt][nl][1] + bgl[1])); w.y = pk2(z2 * sigm(acc[mt][nl][2] + bgl[2]), z3 * sigm(acc[mt][nl][3] + bgl[3]));
                *(v2u*)(BR + (size_t)(row0 + tt) * D + 256 + n0) = w; } }
        __syncthreads();
    }
}

__device__ __forceinline__ void gemm2_phase(LAS unsigned char* lds, const bf16* BRp, const bf16* WBT, const unsigned char* GT, bf16* MG, int G, int bid, int tidp) {
    using namespace pg8;
    int tid_ = tidp; asm volatile("" : "+v"(tid_));
    const int tid = tid_, wid = __builtin_amdgcn_readfirstlane(tid >> 6), lane = tid & 63, wr = wid >> 2, wc = wid & 3, fr = lane & 15, fq = lane >> 4;
    unsigned voffA0, voffB0;
    { int R, C; stage_rc(tid * 16, R, C); const int Rb = (R & ~31) + perm32(R & 31); voffA0 = (unsigned)(R * D + C) * 2u; voffB0 = (unsigned)(Rb * MIXW + C) * 2u; }
    const unsigned ldsw = (unsigned)wid * 1024u;
    const int aoff = lds_byte(wr * 64 + fr, fq * 8), boff = lds_byte(wc * 32 + fr, fq * 8);
    const unsigned gvoff = (unsigned)(fr * GTC + 8 * fq);
    constexpr int STG = 49152;
#define G2_STAGE(it_, so_) do { const int kb_ = (it_) >> 2, kt_ = (it_) & 3; \
        const char* as_ = Abase + (size_t)(kb_ * 256 + kt_ * 64) * 2; const char* bs_ = Bbase + (size_t)kb_ * (D * MIXW * 2) + (size_t)kt_ * 128; \
        _Pragma("unroll") for (int _i = 0; _i < 2; ++_i) __builtin_amdgcn_global_load_lds((const unsigned*)(as_ + (size_t)_i * (64 * D * 2) + voffA0), (PG8_LAS unsigned*)(lds + (so_) + ldsw + _i * 8192), 16, 0, 0); \
        _Pragma("unroll") for (int _i = 0; _i < 2; ++_i) __builtin_amdgcn_global_load_lds((const unsigned*)(bs_ + (size_t)_i * (64 * MIXW * 2) + voffB0), (PG8_LAS unsigned*)(lds + (so_) + 16384 + ldsw + _i * 8192), 16, 0, 0); \
        _Pragma("unroll") for (int _i = 0; _i < 2; ++_i) __builtin_amdgcn_global_load_lds((const unsigned*)(bs_ + (size_t)(128 + 64 * _i) * MIXW * 2 + voffB0), (PG8_LAS unsigned*)(lds + (so_) + 32768 + ldsw + _i * 8192), 16, 0, 0); } while (0)
    const int vb = (G % 8 == 0) ? (bid % 8) * (G / 8) + bid / 8 : bid;
    constexpr int NUN = (MP / 128) * 4;
    const bool xmap = G == 256;
    for (int ui = xmap ? (bid & 7) * 64 + (bid >> 3) : vb; ui < NUN; ui += xmap ? ((ui & 63) < 32 ? 32 : NUN) : G) {
        const int pm = ui >> 2, pn = ui & 3;
        const char* Abase = (const char*)BRp + (size_t)pm * 128 * D * 2;
        const char* Bbase = (const char*)WBT + (size_t)pn * 256 * MIXW * 2;
        G2_STAGE(0, 0); G2_STAGE(1, STG);
        f32x4 mg[2][4][2], acc[2][4][2];
#pragma unroll
        for (int b = 0; b < 2; ++b)
#pragma unroll
            for (int m = 0; m < 4; ++m)
#pragma unroll
                for (int n = 0; n < 2; ++n) { mg[b][m][n] = (f32x4){0.f, 0.f, 0.f, 0.f}; acc[b][m][n] = (f32x4){0.f, 0.f, 0.f, 0.f}; }
        v2u gq[2][4];
        int so = 0, so2 = 2 * STG;
#pragma unroll 1
        for (int kb = 0; kb < 4; ++kb) {
#pragma unroll
            for (int kt = 0; kt < 4; ++kt) {
                if (kt < 2) asm volatile("s_waitcnt vmcnt(6)" ::: "memory");
                else if (kt == 3 && kb == 3) asm volatile("s_waitcnt vmcnt(8)" ::: "memory");
                else asm volatile("s_waitcnt vmcnt(14)" ::: "memory");
                __builtin_amdgcn_s_barrier(); asm volatile("" ::: "memory");
                if (kt < 2 || kb < 3) G2_STAGE(4 * kb + kt + 2, so2);
#pragma unroll
                for (int kk = 0; kk < 2; ++kk) {
                    bf16x8 At[4], B0[2], B1[2];
#pragma unroll
                    for (int m = 0; m < 4; ++m) At[m] = *(const PG8_LAS bf16x8*)(lds + so + aoff + m * 2048 + kk * 1024);
#pragma unroll
                    for (int n = 0; n < 2; ++n) { B0[n] = *(const PG8_LAS bf16x8*)(lds + so + 16384 + boff + n * 2048 + kk * 1024); B1[n] = *(const PG8_LAS bf16x8*)(lds + so + 32768 + boff + n * 2048 + kk * 1024); }
                    asm volatile("s_waitcnt lgkmcnt(0)" ::: "memory"); __builtin_amdgcn_sched_barrier(0);
#pragma unroll
                    for (int m = 0; m < 4; ++m)
#pragma unroll
                        for (int n = 0; n < 2; ++n) { acc[0][m][n] = __builtin_amdgcn_mfma_f32_16x16x32_bf16(B0[n], At[m], acc[0][m][n], 0, 0, 0);
                                                      acc[1][m][n] = __builtin_amdgcn_mfma_f32_16x16x32_bf16(B1[n], At[m], acc[1][m][n], 0, 0, 0); }
                }
                if (kt == 1) {
#pragma unroll
                    for (int m = 0; m < 4; ++m) { const unsigned char* gs = GT + (size_t)(pm * 128 + wr * 64 + m * 16) * GTC + kb * D + pn * 256 + wc * 32;
                        asm volatile("global_load_dwordx2 %0, %1, %2" : "=v"(gq[0][m]) : "v"(gvoff), "s"(gs) : "memory");
                        asm volatile("global_load_dwordx2 %0, %1, %2 offset:128" : "=v"(gq[1][m]) : "v"(gvoff), "s"(gs) : "memory"); }
                }
                so = so == 2 * STG ? 0 : so + STG; so2 = so2 == 2 * STG ? 0 : so2 + STG;
            }
            if (kb == 3) asm volatile("s_waitcnt vmcnt(0)" ::: "memory"); else asm volatile("s_waitcnt vmcnt(12)" ::: "memory");
            asm volatile("" : "+v"(gq[0][0]), "+v"(gq[0][1]), "+v"(gq[0][2]), "+v"(gq[0][3]), "+v"(gq[1][0]), "+v"(gq[1][1]), "+v"(gq[1][2]), "+v"(gq[1][3]));
#pragma unroll
            for (int b = 0; b < 2; ++b)
#pragma unroll
                for (int m = 0; m < 4; ++m) { const v2u q_ = gq[b][m];
#pragma unroll
                    for (int j = 0; j < 4; ++j) { mg[b][m][0][j] += (float)((q_.x >> (8 * j)) & 0xffu) * acc[b][m][0][j]; mg[b][m][1][j] += (float)((q_.y >> (8 * j)) & 0xffu) * acc[b][m][1][j]; }
                    acc[b][m][0] = (f32x4){0.f, 0.f, 0.f, 0.f}; acc[b][m][1] = (f32x4){0.f, 0.f, 0.f, 0.f}; }
        }
        asm volatile("" ::: "memory"); __builtin_amdgcn_s_barrier(); asm volatile("" ::: "memory");
#pragma unroll
        for (int b = 0; b < 2; ++b)
#pragma unroll
            for (int m = 0; m < 4; ++m) { const int row = pm * 128 + wr * 64 + m * 16 + fr, col = pn * 256 + b * 128 + wc * 32 + 8 * fq;
                const f32x4 m0 = mg[b][m][0] * (1.0f / 255.0f), m1 = mg[b][m][1] * (1.0f / 255.0f);
                v4u w; w.x = pk2(m0[0], m0[1]); w.y = pk2(m0[2], m0[3]); w.z = pk2(m1[0], m1[1]); w.w = pk2(m1[2], m1[3]);
                *(v4u*)(MG + (size_t)row * D + col) = w; }
    }
#undef G2_STAGE
}


#define TL_GLDS(src_, dst_) __builtin_amdgcn_global_load_lds((const unsigned*)(src_), (PG8_LAS unsigned*)(dst_), 16, 0, 0)
#define TL_STAGE(kt_, A_PTR, B_PTR) do { const int s_ = (kt_) & 3; const char* ap_ = A_PTR(kt_); const char* bp_ = B_PTR(kt_); \
        TL_GLDS(ap_ + voffA, lds + s_ * 32768 + ldsw); TL_GLDS(ap_ + voffA + 128, lds + s_ * 32768 + 8192 + ldsw); \
        TL_GLDS(bp_ + voffB, lds + s_ * 32768 + 16384 + ldsw); TL_GLDS(bp_ + voffB + 128, lds + s_ * 32768 + 24576 + ldsw); } while (0)
#define TL_LOOP(NK, A_PTR, B_PTR, AFTER_STEP) do { \
        TL_STAGE(0, A_PTR, B_PTR); if ((NK) > 1) TL_STAGE(1, A_PTR, B_PTR); if ((NK) > 2) TL_STAGE(2, A_PTR, B_PTR); \
        _Pragma("unroll 1") for (int kt = 0; kt < (NK); ++kt) { \
            if (kt + 2 < (NK)) asm volatile("s_waitcnt vmcnt(8)" ::: "memory"); else if (kt + 1 < (NK)) asm volatile("s_waitcnt vmcnt(4)" ::: "memory"); else asm volatile("s_waitcnt vmcnt(0)" ::: "memory"); \
            __builtin_amdgcn_s_barrier(); asm volatile("" ::: "memory"); \
            if (kt + 3 < (NK)) TL_STAGE(kt + 3, A_PTR, B_PTR); \
            const int sb_ = (kt & 3) * 32768; \
            _Pragma("unroll") for (int h_ = 0; h_ < 2; ++h_) { \
                const bf16x8 a0 = *(const PG8_LAS bf16x8*)(lds + sb_ + h_ * 8192 + aoff), a1 = *(const PG8_LAS bf16x8*)(lds + sb_ + h_ * 8192 + aoff + 1024); \
                const bf16x8 b00 = *(const PG8_LAS bf16x8*)(lds + sb_ + 16384 + h_ * 8192 + boff), b01 = *(const PG8_LAS bf16x8*)(lds + sb_ + 16384 + h_ * 8192 + boff + 1024); \
                const bf16x8 b10 = *(const PG8_LAS bf16x8*)(lds + sb_ + 16384 + h_ * 8192 + boff + 2048), b11 = *(const PG8_LAS bf16x8*)(lds + sb_ + 16384 + h_ * 8192 + boff + 3072); \
                asm volatile("s_waitcnt lgkmcnt(0)" ::: "memory"); __builtin_amdgcn_sched_barrier(0); \
                acc[0] = __builtin_amdgcn_mfma_f32_16x16x32_bf16(b00, a0, acc[0], 0, 0, 0); acc[1] = __builtin_amdgcn_mfma_f32_16x16x32_bf16(b10, a0, acc[1], 0, 0, 0); \
                acc[0] = __builtin_amdgcn_mfma_f32_16x16x32_bf16(b01, a1, acc[0], 0, 0, 0); acc[1] = __builtin_amdgcn_mfma_f32_16x16x32_bf16(b11, a1, acc[1], 0, 0, 0); } \
            AFTER_STEP(kt); } \
        asm volatile("s_waitcnt lgkmcnt(0)" ::: "memory"); __builtin_amdgcn_s_barrier(); asm volatile("" ::: "memory"); } while (0)
#define TL_SETUP(LDA, LDB) using namespace pg8; int tid_ = tidp; asm volatile("" : "+v"(tid_)); \
    const int tid = tid_, wid = __builtin_amdgcn_readfirstlane(tid >> 6), lane = tid & 63, fr = lane & 15, fq = lane >> 4, mt = wid >> 1, nh = wid & 1; \
    int R_, C_; stage_rc(tid * 16, R_, C_); \
    const unsigned voffA = (unsigned)(R_ * (LDA) + C_) * 2u, voffB = (unsigned)(R_ * (LDB) + C_) * 2u, ldsw = (unsigned)wid * 1024u; \
    const int aoff = lds_byte(mt * 16 + fr, fq * 8), boff = lds_byte(nh * 32 + fr, fq * 8); (void)lane
#define TL_NOP(kt_) do {} while (0)

struct CappedOrder : pg8::StaticOrder {
    int cap;
    __device__ bool next(int i, pg8::Unit& u) const { if ((long)i * G + c >= cap) return false; return pg8::StaticOrder::next(i, u); }
};
__device__ __forceinline__ void proj_tail_phase(LAS unsigned char* lds, const bf16* A, const bf16* Bt, int cap, const float* ssq, const float* bgate, bf16* PMp, unsigned char* GTp, int G, int bid, int tidp, unsigned* qctr) {
    TL_SETUP(D, D);
    StaticOrder S1; S1.init(M, INC, 1, 0);
    const int nsub = (S1.nwg - cap) * 16;
    volatile LAS int* qslot = (volatile LAS int*)(lds + MISC_OFF + 192);
    for (int t = bid; t < nsub; ) {
        Unit u; S1.next(cap + (t >> 4), u);
        const int rb = (t >> 2) & 3, cb = t & 3, r0 = u.pm * 256 + 64 * rb, c0 = u.pn * 256 + 64 * cb;
        const char* Ab = (const char*)A + (size_t)r0 * D * 2; const char* Bb = (const char*)Bt + (size_t)c0 * D * 2;
        f32x4 acc[2] = {(f32x4){0.f, 0.f, 0.f, 0.f}, (f32x4){0.f, 0.f, 0.f, 0.f}};
        const int row = r0 + 16 * mt + fr;
        const float rs = pg8::row_rstd(ssq, row);
        const bool isg = u.pn >= 7;
        f32x4 bvv[2];
#pragma unroll
        for (int n = 0; n < 2; ++n) bvv[n] = isg ? *(const f32x4*)(bgate + (c0 + 32 * nh + 16 * n + 4 * fq - PMC)) : (f32x4){0.f, 0.f, 0.f, 0.f};
#define PT_A(kt_) (Ab + (size_t)(kt_) * 256)
#define PT_B(kt_) (Bb + (size_t)(kt_) * 256)
        TL_LOOP(D / 128, PT_A, PT_B, TL_NOP);
#undef PT_A
#undef PT_B
        unsigned got = 0u;
        if (tid == 0) got = __hip_atomic_fetch_add(qctr, 1u, __ATOMIC_RELAXED, __HIP_MEMORY_SCOPE_AGENT);
#pragma unroll
        for (int n = 0; n < 2; ++n) { const int col = c0 + 32 * nh + 16 * n + 4 * fq; f32x4 v = acc[n] * rs;
            if (isg) { const f32x4 tt = (v + bvv[n]) * -1.4426950408889634f;
                *(unsigned*)(GTp + (size_t)row * GTC + (col - PMC)) = pg8::pack_u8x4(pg8::sig255(tt[0]), pg8::sig255(tt[1]), pg8::sig255(tt[2]), pg8::sig255(tt[3])); }
            else { v2u w; w.x = pk2(v[0], v[1]); w.y = pk2(v[2], v[3]); *(v2u*)(PMp + (size_t)row * PMC + col) = w; } }
        if (tid == 0) *qslot = G + (int)got;
        __syncthreads();
        t = *qslot;
        __syncthreads();
    }
}

__device__ __forceinline__ void gemm2_tail_phase(LAS unsigned char* lds, const bf16* BRp, const bf16* WBT, const unsigned char* GT, bf16* MG, int G, int bid, int tidp) {
    TL_SETUP(D, MIXW);
    for (int ui = bid; ui < 256; ui += G) {
        const int rb = ((ui & 7) >> 1) * 4 + (ui >> 6), cb = (ui & 1) * 8 + ((ui >> 3) & 7);
        const char* Ab = (const char*)BRp + (size_t)(MP + 64 * rb) * D * 2; const char* Bb = (const char*)WBT + (size_t)(64 * cb) * MIXW * 2;
        f32x4 acc[2] = {(f32x4){0.f, 0.f, 0.f, 0.f}, (f32x4){0.f, 0.f, 0.f, 0.f}}, mg[2] = {(f32x4){0.f, 0.f, 0.f, 0.f}, (f32x4){0.f, 0.f, 0.f, 0.f}};
        const int row = MP + 64 * rb + 16 * mt + fr;
#define G2T_A(kt_) (Ab + (size_t)(((kt_) >> 1) * 256 + ((kt_) & 1) * 128) * 2)
#define G2T_B(kt_) (Bb + (size_t)((kt_) >> 1) * (D * MIXW * 2) + (size_t)((kt_) & 1) * 256)
        unsigned gwp[4][2];
#pragma unroll
        for (int kb = 0; kb < 4; ++kb)
#pragma unroll
            for (int n = 0; n < 2; ++n) gwp[kb][n] = *(const unsigned*)(GT + (size_t)row * GTC + kb * D + 64 * cb + 32 * nh + 16 * n + 4 * fq);
#define G2T_AFTER(kt_) do { if ((kt_) & 1) { const int kb_ = (kt_) >> 1; \
            _Pragma("unroll") for (int n = 0; n < 2; ++n) { const unsigned gw = kb_ == 0 ? gwp[0][n] : (kb_ == 1 ? gwp[1][n] : (kb_ == 2 ? gwp[2][n] : gwp[3][n])); \
                mg[n][0] += (float)(gw & 0xffu) * acc[n][0]; mg[n][1] += (float)((gw >> 8) & 0xffu) * acc[n][1]; mg[n][2] += (float)((gw >> 16) & 0xffu) * acc[n][2]; mg[n][3] += (float)(gw >> 24) * acc[n][3]; \
                acc[n] = (f32x4){0.f, 0.f, 0.f, 0.f}; } } } while (0)
        TL_LOOP(8, G2T_A, G2T_B, G2T_AFTER);
#undef G2T_A
#undef G2T_B
#undef G2T_AFTER
#pragma unroll
        for (int n = 0; n < 2; ++n) { const f32x4 mm = mg[n] * (1.0f / 255.0f); v2u w; w.x = pk2(mm[0], mm[1]); w.y = pk2(mm[2], mm[3]); *(v2u*)(MG + (size_t)row * D + 64 * cb + 32 * nh + 16 * n + 4 * fq) = w; }
    }
}

__device__ __forceinline__ void resid_tail_phase(LAS unsigned char* lds, const bf16* A, const bf16* Bt, int K, bf16* XBp, float* ssq, int G, int bid, int tidp) {
    TL_SETUP(K, K);
    const int nk = K / 128;
    for (int ui = bid; ui < 256; ui += G) {
        const int rb = ((ui & 7) >> 1) * 4 + (ui >> 6), cb = (ui & 1) * 8 + ((ui >> 3) & 7);
        const char* Ab = (const char*)A + (size_t)(MP + 64 * rb) * K * 2; const char* Bb = (const char*)Bt + (size_t)(64 * cb) * K * 2;
        f32x4 acc[2] = {(f32x4){0.f, 0.f, 0.f, 0.f}, (f32x4){0.f, 0.f, 0.f, 0.f}};
        const int rowl = 16 * mt + fr, row = MP + 64 * rb + rowl; float ss = 0.f;
        f32x4 xold[2];
#pragma unroll
        for (int n = 0; n < 2; ++n) { const int col = 64 * cb + 32 * nh + 16 * n + 4 * fq;
            const v2u q = *(const v2u*)(XBp + (size_t)row * D + col); xold[n] = (f32x4){bflo(q.x), bfhi(q.x), bflo(q.y), bfhi(q.y)}; }
#define RT_A(kt_) (Ab + (size_t)(kt_) * 256)
#define RT_B(kt_) (Bb + (size_t)(kt_) * 256)
        TL_LOOP(nk, RT_A, RT_B, TL_NOP);
#undef RT_A
#undef RT_B
#pragma unroll
        for (int n = 0; n < 2; ++n) { const int col = 64 * cb + 32 * nh + 16 * n + 4 * fq;
            const f32x4 o = xold[n] + acc[n];
            v2u w; w.x = pk2(o[0], o[1]); w.y = pk2(o[2], o[3]); *(v2u*)(XBp + (size_t)row * D + col) = w;
            ss += (o[0] * o[0] + o[1] * o[1]) + (o[2] * o[2] + o[3] * o[3]); }
        ss += __shfl_xor(ss, 16); ss += __shfl_xor(ss, 32);
        LAS float* red = (LAS float*)lds;
        if (fq == 0) red[rowl * 2 + nh] = ss;
        __syncthreads();
        if (tid < 64) ssq[((size_t)(cb >> 2) * M + MP + 64 * rb + tid) * 4 + (cb & 3)] = red[tid * 2] + red[tid * 2 + 1];
        __syncthreads();
    }
}

__global__ void __launch_bounds__(NWAVES * 64, 2) hybrid_fwd(Args args) {
    extern __shared__ __attribute__((aligned(16))) unsigned char lds_raw[];
    LAS unsigned char* lds = (LAS unsigned char*)lds_raw;
    volatile LAS unsigned* MISC = (volatile LAS unsigned*)(lds + MISC_OFF);
    const int tid0 = threadIdx.x, wave0 = __builtin_amdgcn_readfirstlane(tid0 >> 6);
    const int G0 = gridDim.x, bid = blockIdx.x;
    unsigned char* ws = args.ws;
    for (int u = tid0; u < (LDS_BYTES - LDSCTL_OFF) / 4; u += NWAVES * 64) ((LAS unsigned*)(lds + LDSCTL_OFF))[u] = 0u;
    __syncthreads();
    const int lo = args.ph_lo, hi = args.ph_hi;
    XcdBarrier bar; bar.bar = (unsigned*)(ws + WS_CTL) + CW_BAR; bar.x = 0; bar.st = nullptr;
    if (hi - lo > 1) bar = xcd_barrier_post((unsigned*)(ws + WS_CTL) + CW_BAR, MISC + 8);
    bf16* XB = (bf16*)(ws + WS_ACT1); bf16* PMb = (bf16*)(ws + WS_PM); unsigned char* GTb = ws + WS_GT;
    bf16* MGb = (bf16*)(ws + WS_PM); bf16* ACTb = (bf16*)(ws + WS_GT);
    float* ssq = (float*)(ws + WS_SSQ);
    for (int ph_i = lo; ph_i < hi; ++ph_i) {
        int ph = ph_i, G = G0; asm volatile("" : "+s"(ph), "+s"(G));
        unsigned z_ = 0u; asm volatile("" : "+v"(z_));
        int tid = wave0 * 64 + (int)__builtin_amdgcn_mbcnt_hi(~0u, __builtin_amdgcn_mbcnt_lo(~0u, z_)); asm volatile("" : "+v"(tid)); const int lane = tid & 63, wave = __builtin_amdgcn_readfirstlane(tid >> 6);
        const int layer = (ph - 1) / 7, k = ph == 0 ? -1 : (ph == NPHASE - 1 ? 7 : (ph - 1) % 7);
        if (k == -1) p0_prologue(args, lds, tid, lane, wave, G, bid);
        else if (k == 7) final_norm(args, lane, wave, G, bid);
        else if (k == 0) {
            pg8::Gemm g{XB, (const bf16*)(ws + WS_WIN) + (size_t)layer * INC * D, M, INC, D}; CappedOrder S; S.init(M, INC, G, bid); S.cap = (S.nwg / G) * G;
            pg8::EpiProj E{PMb, GTb, ssq, args.in[I_BGATE] + (size_t)layer * GTC, (const LAS float*)(lds + RING_OFF + pg8::RSTD_LDS_OFF), (const LAS float*)(lds + RING_OFF + pg8::BIAS_LDS_OFF)};
            pg8::gemm_phase<pg8::EpiProj, CappedOrder, true, true>(lds + RING_OFF, g, S, E, tid);
            proj_tail_phase(lds + RING_OFF, XB, (const bf16*)(ws + WS_WIN) + (size_t)layer * INC * D, S.cap, ssq, args.in[I_BGATE] + (size_t)layer * GTC, PMb, GTb, G, bid, tid, (unsigned*)(ws + WS_CTL) + CW_Q + 64 * layer);
        } else if (k == 1) {
            for (int s_ = 0; ; ++s_) { int u; bool donor = false;
                if (G == 256) { if (s_ > 2) break;
                    donor = bid < 16 || (bid >= 80 && bid < 152);
                    if (s_ == 0) u = 272 + ((bid + 240) & 255);
                    else if (bid < 16) { if (s_ == 2) break; u = 256 + bid; }
                    else if (bid < 80) { if (s_ == 2) break; u = 528 + (bid - 16); }
                    else if (s_ == 1 || bid < 152) { const int v = (s_ == 1 ? 0 : 176) + (bid - 80); u = (v / 31) * 32 + v % 31; }
                    else if (bid < 240) { const int t_ = bid - 152, db = t_ < 16 ? t_ : 80 + (t_ - 16); u = 592 + ((db + 240) & 255); }
                    else break; }
                else { u = bid + s_ * G; if (u >= 256 + 16 + 256 + 64) break; }
                if (u < 256) { if ((u & 31) != NCH - 1) ssm_unit<0>(args, layer, u, lds, tid, lane, wave); }
                else if (u < 272) ssm_unit<2>(args, layer, u - 256, lds, tid, lane, wave);
                else if (u < 528 || u >= 592) mix_unit<false>(args, layer, u < 528 ? u - 272 : u - 592, lds, tid, lane, wave, u >= 592 ? 4 : (donor ? 3 : 7));
                else mix_unit<true>(args, layer, u - 528, lds, tid, lane, wave, 7);
            }
        } else if (k == 2) {
            for (int u = bid; u < 256; u += G) ssm_unit<1>(args, layer, u, lds, tid, lane, wave);
        } else if (k == 3) {
            gemm2_phase(lds + RING_OFF, (const bf16*)args.out, (const bf16*)(ws + WS_WBR) + (size_t)layer * 4 * D * MIXW, GTb, MGb, G, bid, tid);
            gemm2_tail_phase(lds + RING_OFF, (const bf16*)args.out, (const bf16*)(ws + WS_WBR) + (size_t)layer * 4 * D * MIXW, GTb, MGb, G, bid, tid);
        } else if (k == 5) {
            pg8::Gemm g{XB, (const bf16*)(ws + WS_WFI) + (size_t)layer * 2 * FF * D, M, 2 * FF, D}; pg8::StaticOrder S; S.init(M, 2 * FF, G, bid);
            pg8::EpiSwiGLU E{ACTb, ssq, (const LAS float*)(lds + RING_OFF + pg8::RSTD_LDS_OFF)};
            pg8::gemm_phase<pg8::EpiSwiGLU, pg8::StaticOrder, true, true>(lds + RING_OFF, g, S, E, tid);
            if (!MK_PER_PHASE && G == 256 && bid >= P0_F_BID0 && layer + 1 < NLAYER) p0_idle_items(args, lds, lane, wave, bid, layer + 1, p0_items_A(G), P0_F_BID0, P0_F_PER);
        } else {
            const bool isE = k == 4; const int K = isE ? D : FF;
            const bf16* Ap = isE ? MGb : ACTb; const bf16* Bp = isE ? (const bf16*)(ws + WS_WOUT) + (size_t)layer * D * D : (const bf16*)(ws + WS_WFO) + (size_t)layer * D * FF;
            { pg8::Gemm g{Ap, Bp, MP, D, K}; pg8::StaticOrder S; S.init(MP, D, G, bid);
              pg8::EpiResid E{XB, ssq, isE};
              pg8::gemm_phase<pg8::EpiResid, pg8::StaticOrder, true, true>(lds + RING_OFF, g, S, E, tid); }
            resid_tail_phase(lds + RING_OFF, Ap, Bp, K, XB, ssq, G, bid, tid);
        }
        if (ph_i + 1 < hi) {
            asm volatile("s_waitcnt vmcnt(0)" ::: "memory"); __syncthreads();
            if (tid == 0) xcd_barrier_leader(bar);
            else if (wave != 0) {
                if (k == 2 || k == 3 || k == 5) {
                    const char* wb = k == 2 ? (const char*)((const bf16*)(ws + WS_WBR) + (size_t)layer * 4 * D * MIXW) : k == 3 ? (const char*)((const bf16*)(ws + WS_WOUT) + (size_t)layer * D * D) : (const char*)((const bf16*)(ws + WS_WFO) + (size_t)layer * D * FF);
                    const int rowb = k == 5 ? FF * 2 : D * 2;
                    for (int l = (((bid >> 3) * (NWAVES - 1) + (wave - 1)) << 6) + lane; l < 16384; l += ((G >> 3) * (NWAVES - 1)) << 6)
                        __builtin_amdgcn_global_load_lds((const unsigned*)(wb + (size_t)(l >> 4) * rowb + (l & 15) * 128), (LAS unsigned*)(lds + RING_OFF + pg8::RSTD_RAW_OFF + wave * 1024), 4, 0, 0);
                }
                if (k == 0) {
                    const char* t0_ = (const char*)(ws + WS_TAB + (size_t)layer * TAB_STRIDE); const char* t1_ = (const char*)((const bf16*)(ws + WS_WGLU) + (size_t)layer * MIXW * MIXW);
                    constexpr int NL0 = (int)(TAB_STRIDE / 128), NL1 = MIXW * MIXW * 2 / 128;
                    for (int l = (((bid >> 3) * (NWAVES - 1) + (wave - 1)) << 6) + lane; l < NL0 + NL1; l += ((G >> 3) * (NWAVES - 1)) << 6)
                        __builtin_amdgcn_global_load_lds((const unsigned*)(l < NL0 ? t0_ + (size_t)l * 128 : t1_ + (size_t)(l - NL0) * 128), (LAS unsigned*)(lds + RING_OFF + pg8::RSTD_RAW_OFF + wave * 1024), 4, 0, 0);
                }
                if (!MK_PER_PHASE && k >= 0 && k < P0_SLICES && layer + 1 < NLAYER) p0_slice(args, lds, lane, wave, G, bid, layer + 1, k);
            }
            __syncthreads();
        }
    }
}

extern "C" void kernel_launch(void* const* d_in, const int* in_sizes, int n_in, void* d_out, int out_size, void* d_ws, size_t ws_size, hipStream_t stream) {
    static int grid = 0;
    if (grid == 0) {
        if (n_in != 32 || out_size != (int)O_END || ws_size < WS_END) { fprintf(stderr, "kernel_launch: expected 32 inputs, %zu outputs, >= %zu bytes of workspace; got %d, %d, %zu; nothing launched\n", (size_t)O_END, (size_t)WS_END, n_in, out_size, ws_size); grid = -1; return; }
        int dev = 0, cus = 0, per_cu = 0;
        if (hipGetDevice(&dev) != hipSuccess || hipDeviceGetAttribute(&cus, hipDeviceAttributeMultiprocessorCount, dev) != hipSuccess) { grid = -1; return; }
        if (hipFuncSetAttribute((const void*)hybrid_fwd, hipFuncAttributeMaxDynamicSharedMemorySize, LDS_BYTES) != hipSuccess) { fprintf(stderr, "kernel_launch: hipFuncSetAttribute failed\n"); grid = -1; return; }
        if (hipOccupancyMaxActiveBlocksPerMultiprocessor(&per_cu, (const void*)hybrid_fwd, NWAVES * 64, LDS_BYTES) != hipSuccess || per_cu < 1) { fprintf(stderr, "kernel_launch: occupancy query says %d blocks per CU; nothing launched\n", per_cu); (void)hipGetLastError(); grid = -1; return; }
        grid = cus;
    }
    if (grid < 0) return;
    (void)hipMemsetAsync((char*)d_ws + WS_CTL, 0, CTL_ZERO_BYTES, stream);
    Args a{};
    for (int i = 0; i < 32; ++i) a.in[i] = (const float*)d_in[i];
    a.out = (float*)d_out; a.ws = (unsigned char*)d_ws;
#if MK_PER_PHASE
    for (int k = 0; k < NPHASE; ++k) { a.ph_lo = k; a.ph_hi = k + 1; hipLaunchKernelGGL(hybrid_fwd, dim3(grid), dim3(NWAVES * 64), LDS_BYTES, stream, a); }
#else
    a.ph_lo = 0; a.ph_hi = NPHASE;
    hipLaunchKernelGGL(hybrid_fwd, dim3(grid), dim3(NWAVES * 64), LDS_BYTES, stream, a);
#endif
}
```
